# Optimizing an MI355X kernel written in HIP

```python
import math
import jax, jax.numpy as jnp
from jax import lax
import numpy as np

D_MODEL = 1024
BATCH = 32
SEQ = 2048
DEPTH = 1

CHUNK = 64
Q_BLOCK = 128
EPS = 1e-6
D_MIX = D_MODEL
M_HEADS = 4
M_WIDTH = D_MIX // 2
M_HEAD_DIM = M_WIDTH // M_HEADS
CONV_WIDTH = 4
A_HEADS = 4
A_WIDTH = D_MIX - M_WIDTH
A_HEAD_DIM = A_WIDTH // A_HEADS
A_QK_DIM = A_HEAD_DIM // 2
IN_SIZES = (2 * M_WIDTH, M_WIDTH, M_WIDTH, M_HEADS, M_HEADS, A_WIDTH, A_WIDTH, A_WIDTH)
IN_COLS = sum(IN_SIZES)
IN_SPLITS = tuple(int(s) for s in np.cumsum(IN_SIZES)[:-1])
N_GROUPS = 4
EXPERTS_PER_GROUP = 8
N_EXPERTS = N_GROUPS * EXPERTS_PER_GROUP
TOP_K = 2
D_EXPERT = D_MODEL // 2
MOE_BLOCK = 256

kernel_name = 'hymba_mlstm_diffattn_hmoe_block'


def rms_norm(x, w):
    xf = x.astype(jnp.float32)
    y = xf * lax.rsqrt(jnp.mean(xf * xf, axis=-1, keepdims=True) + EPS)
    return (y * w.astype(jnp.float32)).astype(x.dtype)


def causal_conv(x, w, b):
    S = x.shape[1]
    xp = jnp.pad(x, ((0, 0), (CONV_WIDTH - 1, 0), (0, 0)))
    out = b
    for j in range(CONV_WIDTH):
        out = out + xp[:, j:j + S] * w[j]
    return out


def mlstm_chunkwise(q, k, v, i_pre, f_pre):
    Bn, S, H, Dh = q.shape
    NC = S // CHUNK

    def to_chunks(t):
        t = t.astype(jnp.float32).reshape((Bn, NC, CHUNK) + t.shape[2:])
        return jnp.moveaxis(jnp.moveaxis(t, 1, 0), 3, 2)

    qc = to_chunks(q)
    kc = to_chunks(k) * (Dh ** -0.5)
    vc = to_chunks(v)
    ic = to_chunks(i_pre)
    fc = jax.nn.log_sigmoid(to_chunks(f_pre))
    causal = jnp.tril(jnp.ones((CHUNK, CHUNK), dtype=bool))

    def step(carry, inp):
        C, n, m = carry
        q_c, k_c, v_c, i_c, lf_c = inp
        b = jnp.cumsum(lf_c, axis=-1)
        log_d = jnp.where(causal, b[..., :, None] - b[..., None, :] + i_c[..., None, :], -jnp.inf)
        log_inter = b + m[..., None]
        m_t = jnp.maximum(log_inter, jnp.max(log_d, axis=-1))
        d = jnp.exp(log_d - m_t[..., None])
        inter = jnp.exp(log_inter - m_t)
        s = jnp.einsum('bhtd,bhsd->bhts', q_c, k_c) * d
        num = jnp.einsum('bhts,bhse->bhte', s, v_c) + inter[..., None] * jnp.einsum('bhtd,bhde->bhte', q_c, C)
        den = jnp.sum(s, axis=-1) + inter * jnp.einsum('bhtd,bhd->bht', q_c, n)
        h = num / jnp.maximum(jnp.abs(den), jnp.exp(-m_t))[..., None]
        b_end = b[..., -1]
        log_w = b_end[..., None] - b + i_c
        m_new = jnp.maximum(b_end + m, jnp.max(log_w, axis=-1))
        w = jnp.exp(log_w - m_new[..., None])
        decay = jnp.exp(b_end + m - m_new)
        C_new = decay[..., None, None] * C + jnp.einsum('bhs,bhsd,bhse->bhde', w, k_c, v_c)
        n_new = decay[..., None] * n + jnp.einsum('bhs,bhsd->bhd', w, k_c)
        return (C_new, n_new, m_new), h

    init = (jnp.zeros((Bn, H, Dh, Dh), jnp.float32),
            jnp.zeros((Bn, H, Dh), jnp.float32),
            jnp.zeros((Bn, H), jnp.float32))
    _, h = lax.scan(step, init, (qc, kc, vc, ic, fc))
    h = jnp.moveaxis(jnp.moveaxis(h, 0, 1), 2, 3)
    return h.reshape(Bn, S, H, Dh)


def diff_attention(q, k, v, q_norm_w, k_norm_w, lq1, lk1, lq2, lk2, a_norm_w, lambda_init):
    Bn, S = q.shape[:2]
    NQ = S // Q_BLOCK
    q = rms_norm(q, q_norm_w)
    k = rms_norm(k, k_norm_w)
    f32 = jnp.float32
    lam = (jnp.exp(jnp.sum(lq1.astype(f32) * lk1.astype(f32)))
           - jnp.exp(jnp.sum(lq2.astype(f32) * lk2.astype(f32))) + lambda_init)
    kt = jnp.transpose(k, (0, 2, 3, 1, 4))
    vt = jnp.transpose(v, (0, 2, 1, 3))
    qb = q.reshape(Bn, NQ, Q_BLOCK, A_HEADS, 2, A_QK_DIM).transpose(1, 0, 3, 4, 2, 5)
    key_chunk = jnp.arange(S) // CHUNK
    scale = A_QK_DIM ** -0.5

    def block(args):
        q_blk, idx = args
        q_chunk = (idx * Q_BLOCK + jnp.arange(Q_BLOCK)) // CHUNK
        mask = key_chunk[None, :] <= q_chunk[:, None]
        s = jnp.einsum('bhcqd,bhcsd->bhcqs', q_blk, kt).astype(f32) * scale
        p = jax.nn.softmax(jnp.where(mask, s, -jnp.inf), axis=-1)
        attn = p[:, :, 0] - lam * p[:, :, 1]
        return jnp.einsum('bhqs,bhsd->bhqd', attn.astype(v.dtype), vt)

    o = lax.map(block, (qb, jnp.arange(NQ)))
    o = o.transpose(1, 0, 3, 2, 4).reshape(Bn, S, A_HEADS, A_HEAD_DIM)
    o = rms_norm(o, a_norm_w) * (1.0 - lambda_init)
    return o.reshape(Bn, S, A_WIDTH)


def hybrid_mixer(h, w_in, b_igate, b_fgate, conv_w, conv_b, m_norm_w, q_norm_w, k_norm_w,
                 lq1, lk1, lq2, lk2, a_norm_w, w_out, lambda_init):
    Bn, S, _ = h.shape
    proj = h @ w_in
    mqk, mv, mo, mi, mf, aq, ak, av = jnp.split(proj, IN_SPLITS, axis=-1)
    qk = jax.nn.silu(causal_conv(mqk, conv_w, conv_b))
    mq, mk = jnp.split(qk, 2, axis=-1)
    shp = (Bn, S, M_HEADS, M_HEAD_DIM)
    hm = mlstm_chunkwise(mq.reshape(shp), mk.reshape(shp), mv.reshape(shp), mi + b_igate, mf + b_fgate)
    hm = jax.nn.sigmoid(mo).reshape(shp) * hm.astype(h.dtype)
    hm = rms_norm(hm, m_norm_w).reshape(Bn, S, M_WIDTH)
    ha = diff_attention(aq.reshape(Bn, S, A_HEADS, 2, A_QK_DIM), ak.reshape(Bn, S, A_HEADS, 2, A_QK_DIM),
                        av.reshape(Bn, S, A_HEADS, A_HEAD_DIM), q_norm_w, k_norm_w,
                        lq1, lk1, lq2, lk2, a_norm_w, lambda_init)
    return jnp.concatenate([hm, ha], axis=-1) @ w_out


def hierarchical_moe(h, w_group, b_group, w_expert, b_expert, w_gate, w_up, w_down):
    Bn, S, D = h.shape
    T = Bn * S
    xt = h.reshape(T, D)
    f32 = jnp.float32
    g_logits = (xt @ w_group).astype(f32) + b_group.astype(f32)
    g_prob = jax.nn.softmax(g_logits, axis=-1)
    g_sel = jnp.argmax(g_logits, axis=-1)
    g_w = jnp.take_along_axis(g_prob, g_sel[:, None], axis=1)[:, 0]
    e_logits = ((xt @ w_expert).astype(f32) + b_expert.astype(f32)).reshape(T, N_GROUPS, EXPERTS_PER_GROUP)
    e_in = jnp.take_along_axis(e_logits, g_sel[:, None, None], axis=1)[:, 0]
    top_vals, top_idx = lax.top_k(e_in, TOP_K)
    weights = g_w[:, None] * jax.nn.softmax(top_vals, axis=-1)
    eid = (g_sel[:, None] * EXPERTS_PER_GROUP + top_idx).reshape(-1)
    A = T * TOP_K
    tok = jnp.arange(A) // TOP_K
    counts = jax.ops.segment_sum(jnp.ones_like(eid), eid, num_segments=N_EXPERTS)
    padded = ((counts + MOE_BLOCK - 1) // MOE_BLOCK) * MOE_BLOCK
    pad_end = jnp.cumsum(padded)
    pad_start = pad_end - padded
    start = jnp.cumsum(counts) - counts
    order = jnp.argsort(eid)
    eid_sorted = eid[order]
    dest_sorted = pad_start[eid_sorted] + (jnp.arange(A) - start[eid_sorted])
    dest = jnp.zeros((A,), jnp.int32).at[order].set(dest_sorted.astype(jnp.int32))
    P = ((A + MOE_BLOCK - 1) // MOE_BLOCK) * MOE_BLOCK + N_EXPERTS * MOE_BLOCK
    NB = P // MOE_BLOCK
    block_start = jnp.arange(NB) * MOE_BLOCK
    block_expert = jnp.minimum(jnp.sum(pad_end[None, :] <= block_start[:, None], axis=1), N_EXPERTS - 1)
    x_buf = jnp.zeros((P, D), h.dtype).at[dest].set(xt[tok])

    def expert_block(args):
        xb, e = args
        hid = jax.nn.silu(xb @ w_gate[e]) * (xb @ w_up[e])
        return hid @ w_down[e]

    y_buf = lax.map(expert_block, (x_buf.reshape(NB, MOE_BLOCK, D), block_expert)).reshape(P, D)
    y = jnp.sum(y_buf[dest].reshape(T, TOP_K, D) * weights[..., None].astype(h.dtype), axis=1)
    return y.reshape(Bn, S, D)


def setup_inputs(seed: int = 0) -> dict:
    key = jax.random.key(seed)
    ks = jax.random.split(key, 24)
    nrm = jax.random.normal
    f32 = jnp.float32
    L = DEPTH
    gain = lambda k, n: 1.0 + 0.01 * nrm(k, (L, n), f32)
    return {
        'x': nrm(ks[0], (BATCH, SEQ, D_MODEL), f32),
        'norm1_w': gain(ks[1], D_MODEL),
        'w_in': nrm(ks[2], (L, D_MODEL, IN_COLS), f32) * D_MODEL ** -0.5,
        'b_igate': 0.1 * nrm(ks[3], (L, M_HEADS), f32),
        'b_fgate': jnp.linspace(3.0, 6.0, M_HEADS, dtype=f32)[None, :] + 0.1 * nrm(ks[4], (L, M_HEADS), f32),
        'conv_w': nrm(ks[5], (L, CONV_WIDTH, 2 * M_WIDTH), f32) * CONV_WIDTH ** -0.5,
        'conv_b': 0.01 * nrm(ks[6], (L, 2 * M_WIDTH), f32),
        'm_norm_w': gain(ks[7], M_HEAD_DIM),
        'q_norm_w': gain(ks[8], A_QK_DIM),
        'k_norm_w': gain(ks[9], A_QK_DIM),
        'lambda_q1': 0.1 * nrm(ks[10], (L, A_QK_DIM), f32),
        'lambda_k1': 0.1 * nrm(ks[11], (L, A_QK_DIM), f32),
        'lambda_q2': 0.1 * nrm(ks[12], (L, A_QK_DIM), f32),
        'lambda_k2': 0.1 * nrm(ks[13], (L, A_QK_DIM), f32),
        'a_norm_w': gain(ks[14], A_HEAD_DIM),
        'w_out': nrm(ks[15], (L, D_MIX, D_MODEL), f32) * D_MIX ** -0.5,
        'norm2_w': gain(ks[16], D_MODEL),
        'w_group': nrm(ks[17], (L, D_MODEL, N_GROUPS), f32) * D_MODEL ** -0.5,
        'b_group': 0.01 * nrm(ks[18], (L, N_GROUPS), f32),
        'w_expert': nrm(ks[19], (L, D_MODEL, N_EXPERTS), f32) * D_MODEL ** -0.5,
        'b_expert': 0.01 * nrm(ks[20], (L, N_EXPERTS), f32),
        'w_gate': nrm(ks[21], (L, N_EXPERTS, D_MODEL, D_EXPERT), f32) * D_MODEL ** -0.5,
        'w_up': nrm(ks[22], (L, N_EXPERTS, D_MODEL, D_EXPERT), f32) * D_MODEL ** -0.5,
        'w_down': nrm(ks[23], (L, N_EXPERTS, D_EXPERT, D_MODEL), f32) * D_EXPERT ** -0.5,
    }


def reference(x, norm1_w, w_in, b_igate, b_fgate, conv_w, conv_b, m_norm_w, q_norm_w, k_norm_w,
              lambda_q1, lambda_k1, lambda_q2, lambda_k2, a_norm_w, w_out, norm2_w,
              w_group, b_group, w_expert, b_expert, w_gate, w_up, w_down):
    for l in range(DEPTH):
        lambda_init = 0.8 - 0.6 * math.exp(-0.3 * l)
        h = rms_norm(x, norm1_w[l])
        x = x + hybrid_mixer(h, w_in[l], b_igate[l], b_fgate[l], conv_w[l], conv_b[l], m_norm_w[l],
                             q_norm_w[l], k_norm_w[l], lambda_q1[l], lambda_k1[l], lambda_q2[l],
                             lambda_k2[l], a_norm_w[l], w_out[l], lambda_init)
        h = rms_norm(x, norm2_w[l])
        x = x + hierarchical_moe(h, w_group[l], b_group[l], w_expert[l], b_expert[l],
                                 w_gate[l], w_up[l], w_down[l])
    return x
```

```cpp
#include <hip/hip_runtime.h>
#include <cstdio>
#include <cstdint>

#define GAS __attribute__((address_space(1)))
#define LAS __attribute__((address_space(3)))
typedef unsigned short bf16;
typedef unsigned u32x4 __attribute__((ext_vector_type(4)));
typedef unsigned u32x2 __attribute__((ext_vector_type(2)));
typedef float f32x4 __attribute__((ext_vector_type(4)));
typedef float f32x2 __attribute__((ext_vector_type(2)));
typedef short bf16x8 __attribute__((ext_vector_type(8)));

constexpr int T_ = 65536, DM = 1024, SEQ = 2048, NBATCH = 32, NCOL = 3584, INCOLS = 3592;
constexpr int C_MQ = 0, C_MK = 512, C_MV = 1024, C_MO = 1536, C_AQ = 2048, C_AK = 2560, C_AV = 3072;
constexpr int NEXP = 32, DEXP = 512, PMAX = 131072 + NEXP * 256;
constexpr float EPS = 1e-6f;
constexpr float LAMBDA_INIT = 0.2f;
constexpr int NWAVES = 8, NTHR = 512;

constexpr size_t MiB = 1u << 20;
constexpr size_t WS_CTL = 0, CTL_ZERO_BYTES = 1 * MiB;
constexpr size_t WS_W1T = 1 * MiB, WS_W2T = 8 * MiB, WS_WGU = 10 * MiB, WS_WD = 74 * MiB, WS_GATES = 106 * MiB;
constexpr size_t WS_ASGE = 108 * MiB, WS_ASGW = 109 * MiB, WS_ROWTOK = 110 * MiB, WS_ROWW = 111 * MiB;
constexpr size_t WS_H1 = 112 * MiB, WS_MIX = 240 * MiB, WS_PROJ = 368 * MiB, WS_END = 816 * MiB;
constexpr size_t WS_YBUF = 112 * MiB;
constexpr size_t WS_H2 = 384 * MiB, WS_HID = 512 * MiB;
constexpr size_t WS_MO = 112 * MiB;
constexpr size_t WS_POSA = 108 * MiB + 512 * 1024;
constexpr int CW_BAR = 4096, CW_QUEUE = 8192, CW_CNT = 16384, CW_META = 32768;

constexpr int LDS_SCRATCH = 155648;
constexpr int LDSCTL_OFF = LDS_SCRATCH;
constexpr int LDS_BYTES = LDS_SCRATCH + 1024;

__device__ __forceinline__ unsigned f2bf(float f) { unsigned u = __builtin_bit_cast(unsigned, f); return (u + 0x7fffu + ((u >> 16) & 1u)) >> 16; }
__device__ __forceinline__ unsigned pk2(float lo, float hi) { return f2bf(lo) | (f2bf(hi) << 16); }
__device__ __forceinline__ float bf2f(bf16 v) { return __uint_as_float(((unsigned)v) << 16); }
__device__ __forceinline__ float bflo(unsigned u) { return __uint_as_float(u << 16); }
__device__ __forceinline__ float bfhi(unsigned u) { return __uint_as_float(u & 0xffff0000u); }
__device__ __forceinline__ float wave_sum(float v) {
#pragma unroll
    for (int o = 1; o < 64; o <<= 1) v += __shfl_xor(v, o);
    return v;
}
__device__ __forceinline__ float wave_max(float v) {
#pragma unroll
    for (int o = 1; o < 64; o <<= 1) v = fmaxf(v, __shfl_xor(v, o));
    return v;
}
__device__ __forceinline__ float sigmoidf_(float x) { return 1.f / (1.f + __expf(-x)); }
__device__ __forceinline__ float siluf_(float x) { return x / (1.f + __expf(-x)); }
#define LDS_WAIT() asm volatile("s_waitcnt lgkmcnt(0)" ::: "memory")
#define VM_WAIT() asm volatile("s_waitcnt vmcnt(0)" ::: "memory")

namespace pg8 {
#define PG8_LAS __attribute__((address_space(3)))
constexpr int BM = 256, BK = 64, HALF = 128, HTB = HALF * BK * 2, STAGE_BYTES = 8 * HTB, NXCD = 8, WGM = 8;
__host__ __device__ __forceinline__ int lds_byte(int r, int c) { const int st = (r >> 4) * 2 + (c >> 5), rr = r & 15, cc = c & 31, ob = rr * 64 + cc * 2; return st * 1024 + (ob ^ (((ob >> 9) & 1) << 5)); }
__host__ __device__ __forceinline__ void stage_rc(int b, int& R, int& C) { const int st = b / 1024, sb = b % 1024, swz = sb ^ (((sb >> 9) & 1) << 5); R = (st >> 1) * 16 + swz / 64; C = (st & 1) * 32 + (swz % 64) / 2; }
__host__ __device__ __forceinline__ int perm32(int rho) { const int n = rho >> 4, i = rho & 15; return 8 * (i >> 2) + 4 * n + (i & 3); }

struct Unit { int pm, pn, e; };
struct TileOrder {
    int nM, nN, nwg, G, c;
    __device__ __forceinline__ void init(int nM_, int nN_, int G_, int c_) { nM = nM_; nN = nN_; nwg = nM * nN; G = G_; c = c_; }
    __device__ __forceinline__ bool map(int i, int& pm, int& pn) const {
        const long L = (long)i * G + c; if (L >= nwg) return false;
        int wgid = (int)L; { const int q = nwg / NXCD, r = nwg % NXCD, xcd = wgid % NXCD, off = wgid / NXCD; wgid = (xcd < r ? xcd * (q + 1) : r * (q + 1) + (xcd - r) * q) + off; }
        const int nig = WGM * nN, gid = wgid / nig, fm = gid * WGM, gsz = (nM - fm) < WGM ? (nM - fm) : WGM;
        pm = fm + ((wgid % nig) % gsz); pn = (wgid % nig) / gsz; return true;
    }
};
struct DenseSched {
    static constexpr bool GATHER = false;
    TileOrder o; const char* A; const char* Bt; int K;
    __device__ __forceinline__ bool next(int i, Unit& u) const { u.e = 0; return o.map(i, u.pm, u.pn); }
    __device__ __forceinline__ const char* a_base(const Unit& u) const { return A + (size_t)u.pm * BM * K * 2; }
    __device__ __forceinline__ const char* b_base(const Unit& u) const { return Bt + (size_t)u.pn * BM * K * 2; }
    __device__ __forceinline__ void a_voff(const Unit&, const int (&R)[2], const int (&C)[2], unsigned (&v)[2][2]) const {
#pragma unroll
        for (int h = 0; h < 2; ++h)
#pragma unroll
            for (int i = 0; i < 2; ++i) v[h][i] = (unsigned)((h * HALF + R[i]) * K + C[i]) * 2u;
    }
};

__device__ __forceinline__ unsigned cvt_pk_bf16(float lo, float hi) { unsigned r; asm volatile("v_cvt_pk_bf16_f32 %0, %1, %2" : "=v"(r) : "v"(lo), "v"(hi)); return r; }

struct EpiBf16 {
    static constexpr bool PERM = true;
    bf16* O; int ldc;
    __device__ __forceinline__ void operator()(const f32x4 (&acc)[2][2][4][2], const Unit& u, int wr, int wc, int fr, int fq) const {
        const int row0 = u.pm * BM + wr * 64 + fr, col0 = u.pn * BM + wc * 32 + 8 * fq;
#pragma unroll
        for (int ai = 0; ai < 2; ++ai)
#pragma unroll
            for (int m = 0; m < 4; ++m) { bf16* rowp = O + (size_t)(row0 + ai * HALF + m * 16) * ldc + col0;
#pragma unroll
                for (int bj = 0; bj < 2; ++bj) { const f32x4 v0 = acc[ai][bj][m][0], v1 = acc[ai][bj][m][1];
                    u32x4 w; w.x = cvt_pk_bf16(v0[0], v0[1]); w.y = cvt_pk_bf16(v0[2], v0[3]); w.z = cvt_pk_bf16(v1[0], v1[1]); w.w = cvt_pk_bf16(v1[2], v1[3]);
                    *(u32x4*)(rowp + bj * HALF) = w; } }
    }
};
struct EpiProj {
    static constexpr bool PERM = true;
    bf16* O; int ldc; const float* qw; const float* kw;
    __device__ __forceinline__ void operator()(const f32x4 (&acc)[2][2][4][2], const Unit& u, int wr, int wc, int fr, int fq) const {
        const int row0 = u.pm * BM + wr * 64 + fr;
        if (u.pn >= 8 && u.pn < 12) {
            const float* wsrc = (u.pn < 10) ? qw : kw; const float post = (u.pn < 10) ? 0.18033688011112042f : 1.0f;
            f32x4 wv[2][2];
#pragma unroll
            for (int bj = 0; bj < 2; ++bj)
#pragma unroll
                for (int n = 0; n < 2; ++n) wv[bj][n] = *(const f32x4*)(wsrc + 32 * bj + 8 * fq + 4 * n) * post;
            const int col0 = u.pn * BM + wc * 64 + 8 * fq;
#pragma unroll
            for (int ai = 0; ai < 2; ++ai)
#pragma unroll
                for (int m = 0; m < 4; ++m) {
                    float ss = 0.f;
#pragma unroll
                    for (int bj = 0; bj < 2; ++bj)
#pragma unroll
                        for (int n = 0; n < 2; ++n) { const f32x4 x = acc[ai][bj][m][n]; ss += (x[0] * x[0] + x[1] * x[1]) + (x[2] * x[2] + x[3] * x[3]); }
                    ss += __shfl_xor(ss, 16); ss += __shfl_xor(ss, 32);
                    const float r = rsqrtf(ss * (1.f / 64.f) + 1e-6f);
                    bf16* rowp = O + (size_t)(row0 + ai * HALF + m * 16) * ldc + col0;
#pragma unroll
                    for (int bj = 0; bj < 2; ++bj) { const f32x4 v0 = acc[ai][bj][m][0] * r * wv[bj][0], v1 = acc[ai][bj][m][1] * r * wv[bj][1];
                        u32x4 w; w.x = cvt_pk_bf16(v0[0], v0[1]); w.y = cvt_pk_bf16(v0[2], v0[3]); w.z = cvt_pk_bf16(v1[0], v1[1]); w.w = cvt_pk_bf16(v1[2], v1[3]);
                        *(u32x4*)(rowp + bj * 32) = w; } }
        } else {
            const int col0 = u.pn * BM + wc * 32 + 8 * fq; const bool sig = (u.pn == 6 || u.pn == 7);
#pragma unroll
            for (int ai = 0; ai < 2; ++ai)
#pragma unroll
                for (int m = 0; m < 4; ++m) { bf16* rowp = O + (size_t)(row0 + ai * HALF + m * 16) * ldc + col0;
#pragma unroll
                    for (int bj = 0; bj < 2; ++bj) { f32x4 v0 = acc[ai][bj][m][0], v1 = acc[ai][bj][m][1];
                        if (sig) {
#pragma unroll
                            for (int j = 0; j < 4; ++j) { v0[j] = __builtin_amdgcn_rcpf(1.f + __builtin_amdgcn_exp2f(v0[j] * -1.4426950408889634f)); v1[j] = __builtin_amdgcn_rcpf(1.f + __builtin_amdgcn_exp2f(v1[j] * -1.4426950408889634f)); } }
                        u32x4 w; w.x = cvt_pk_bf16(v0[0], v0[1]); w.y = cvt_pk_bf16(v0[2], v0[3]); w.z = cvt_pk_bf16(v1[0], v1[1]); w.w = cvt_pk_bf16(v1[2], v1[3]);
                        *(u32x4*)(rowp + bj * HALF) = w; } }
        }
    }
};
struct EpiResF32 {
    static constexpr bool PERM = true;
    const float* X; float* O; int ldc; bf16* OB;
    __device__ __forceinline__ void operator()(const f32x4 (&acc)[2][2][4][2], const Unit& u, int wr, int wc, int fr, int fq) const {
        const int row0 = u.pm * BM + wr * 64 + fr, col0 = u.pn * BM + wc * 32 + 8 * fq;
#pragma unroll
        for (int ai = 0; ai < 2; ++ai) {
            f32x4 xv[4][2][2];
#pragma unroll
            for (int m = 0; m < 4; ++m) { const size_t off = (size_t)(row0 + ai * HALF + m * 16) * ldc + col0;
#pragma unroll
                for (int bj = 0; bj < 2; ++bj) { xv[m][bj][0] = *(const f32x4*)(X + off + bj * HALF); xv[m][bj][1] = *(const f32x4*)(X + off + bj * HALF + 4); } }
#pragma unroll
            for (int m = 0; m < 4; ++m) { const size_t off = (size_t)(row0 + ai * HALF + m * 16) * ldc + col0;
#pragma unroll
                for (int bj = 0; bj < 2; ++bj) {
                    const f32x4 r0 = xv[m][bj][0] + acc[ai][bj][m][0], r1 = xv[m][bj][1] + acc[ai][bj][m][1];
                    *(f32x4*)(O + off + bj * HALF) = r0; *(f32x4*)(O + off + bj * HALF + 4) = r1;
                    u32x4 w; w.x = cvt_pk_bf16(r0[0], r0[1]); w.y = cvt_pk_bf16(r0[2], r0[3]); w.z = cvt_pk_bf16(r1[0], r1[1]); w.w = cvt_pk_bf16(r1[2], r1[3]);
                    *(u32x4*)(OB + off + bj * HALF) = w; } }
            asm volatile("" ::: "memory");
        }
    }
};

__device__ __forceinline__ int expert_of_row_l(const PG8_LAS int* pst, int row) { int e = 0;
#pragma unroll 1
    for (int i = 1; i < 32; ++i) e += (pst[i] <= row) ? 1 : 0;
    return e; }
struct MoeGuSched {
    static constexpr bool GATHER = true;
    TileOrder o; const char* A; const char* Bt; const int* rowtok; const PG8_LAS int* pst; int K;
    __device__ __forceinline__ bool next(int i, Unit& u) const { if (!o.map(i, u.pm, u.pn)) return false; u.e = expert_of_row_l(pst, u.pm * BM); return true; }
    __device__ __forceinline__ const char* a_base(const Unit&) const { return A; }
    __device__ __forceinline__ const char* b_base(const Unit& u) const { return Bt + ((size_t)u.e * 1024 + (size_t)u.pn * BM) * K * 2; }
    __device__ __forceinline__ void a_voff(const Unit& u, const int (&R)[2], const int (&C)[2], unsigned (&v)[2][2]) const {
#pragma unroll
        for (int h = 0; h < 2; ++h)
#pragma unroll
            for (int i = 0; i < 2; ++i) { const int tk = rowtok[u.pm * BM + h * HALF + R[i]]; const unsigned tok = tk < 0 ? 0u : (unsigned)(tk >> 1); v[h][i] = (tok * (unsigned)K + (unsigned)C[i]) * 2u; }
    }
};
struct MoeDownSched {
    static constexpr bool GATHER = false;
    TileOrder o; const char* A; const char* Bt; const PG8_LAS int* pst; int K;
    __device__ __forceinline__ bool next(int i, Unit& u) const { if (!o.map(i, u.pm, u.pn)) return false; u.e = expert_of_row_l(pst, u.pm * BM); return true; }
    __device__ __forceinline__ const char* a_base(const Unit& u) const { return A + (size_t)u.pm * BM * K * 2; }
    __device__ __forceinline__ const char* b_base(const Unit& u) const { return Bt + ((size_t)u.e * 1024 + (size_t)u.pn * BM) * K * 2; }
    __device__ __forceinline__ void a_voff(const Unit&, const int (&R)[2], const int (&C)[2], unsigned (&v)[2][2]) const {
#pragma unroll
        for (int h = 0; h < 2; ++h)
#pragma unroll
            for (int i = 0; i < 2; ++i) v[h][i] = (unsigned)((h * HALF + R[i]) * K + C[i]) * 2u;
    }
};
struct EpiSwiglu {
    static constexpr bool PERM = true;
    bf16* O; const float* rowr;
    __device__ __forceinline__ void operator()(const f32x4 (&acc)[2][2][4][2], const Unit& u, int wr, int wc, int fr, int fq) const {
        const int row0 = u.pm * BM + wr * 64 + fr, col0 = u.pn * HALF + wc * 32 + 8 * fq;
#pragma unroll
        for (int ai = 0; ai < 2; ++ai)
#pragma unroll
            for (int m = 0; m < 4; ++m) { bf16* rowp = O + (size_t)(row0 + ai * HALF + m * 16) * 512 + col0; const float rs = rowr[row0 + ai * HALF + m * 16];
                float hv[8];
#pragma unroll
                for (int n = 0; n < 2; ++n)
#pragma unroll
                    for (int j = 0; j < 4; ++j) { const float g = acc[ai][0][m][n][j] * rs, up = acc[ai][1][m][n][j] * rs; hv[n * 4 + j] = g * up * __builtin_amdgcn_rcpf(1.f + __expf(-g)); }
                u32x4 w; w.x = cvt_pk_bf16(hv[0], hv[1]); w.y = cvt_pk_bf16(hv[2], hv[3]); w.z = cvt_pk_bf16(hv[4], hv[5]); w.w = cvt_pk_bf16(hv[6], hv[7]);
                *(u32x4*)rowp = w; }
    }
};
struct EpiDown {
    static constexpr bool PERM = true;
    bf16* Y; const int* rowtok; const float* roww;
    __device__ __forceinline__ void operator()(const f32x4 (&acc)[2][2][4][2], const Unit& u, int wr, int wc, int fr, int fq) const {
        const int row0 = u.pm * BM + wr * 64 + fr, col0 = u.pn * BM + wc * 32 + 8 * fq;
#pragma unroll
        for (int ai = 0; ai < 2; ++ai)
#pragma unroll
            for (int m = 0; m < 4; ++m) { const int pos = row0 + ai * HALF + m * 16; const int tk = rowtok[pos]; const float w = roww[pos];
                if (tk >= 0) { bf16* rowp = Y + ((size_t)(tk & 1) * 65536 + (size_t)(tk >> 1)) * 1024 + col0;
#pragma unroll
                    for (int bj = 0; bj < 2; ++bj) { const f32x4 v0 = acc[ai][bj][m][0] * w, v1 = acc[ai][bj][m][1] * w;
                        u32x4 o; o.x = cvt_pk_bf16(v0[0], v0[1]); o.y = cvt_pk_bf16(v0[2], v0[3]); o.z = cvt_pk_bf16(v1[0], v1[1]); o.w = cvt_pk_bf16(v1[2], v1[3]);
                        *(u32x4*)(rowp + bj * HALF) = o; } } }
    }
};

template <class Epi, class Sched, bool ALIGN_EPI = true>
__device__ __forceinline__ void gemm_phase(PG8_LAS unsigned char* lds, const int K, const Sched& S, const Epi& E) {
    int tid = threadIdx.x; asm volatile("" : "+v"(tid));
    const int wid = __builtin_amdgcn_readfirstlane(tid >> 6), lane = tid & 63, wr = wid >> 2, wc = wid & 3, fr = lane & 15, fq = lane >> 4;
    const int nt = K / BK;
    int Rr[2], Cc[2]; unsigned voffB[2];
#pragma unroll
    for (int i = 0; i < 2; ++i) { int R, C; stage_rc(tid * 16 + i * 8192, R, C); const int Rb = Epi::PERM ? ((R & ~31) + perm32(R & 31)) : R;
        Rr[i] = R; Cc[i] = C; voffB[i] = (unsigned)(Rb * K + C) * 2u; }
    const size_t kstep = (size_t)(BK * 2);
    const size_t hstep = (size_t)HALF * K * 2;
    const unsigned ldsw = (unsigned)wid * 1024u;
    const int aoff = lds_byte(wr * 64 + fr, fq * 8), boff = lds_byte(wc * 32 + fr, fq * 8);
#define PG8_SA(b, h) (((b) * 2 + (h)) * HTB)
#define PG8_SB(b, h) ((4 + (b) * 2 + (h)) * HTB)
#define PG8_STAGE(bufoff, gbase, voff) do { _Pragma("unroll") for (int _i = 0; _i < 2; ++_i) \
        __builtin_amdgcn_global_load_lds((const unsigned*)((const char*)(gbase) + (voff)[_i]), (PG8_LAS unsigned*)(lds + (bufoff) + ldsw + _i * 8192), 16, 0, 0); } while (0)
#define PG8_LDA(dst, b, h) do { _Pragma("unroll") for (int m = 0; m < 4; ++m) _Pragma("unroll") for (int k = 0; k < 2; ++k) dst[m][k] = *(const PG8_LAS bf16x8*)(lds + PG8_SA(b, h) + aoff + m * 2048 + k * 1024); } while (0)
#define PG8_LDB(dst, b, h) do { _Pragma("unroll") for (int n = 0; n < 2; ++n) _Pragma("unroll") for (int k = 0; k < 2; ++k) dst[n][k] = *(const PG8_LAS bf16x8*)(lds + PG8_SB(b, h) + boff + n * 2048 + k * 1024); } while (0)
#define PG8_MMA(ai, bj, At, Bt) do { __builtin_amdgcn_s_setprio(1); _Pragma("unroll") for (int m = 0; m < 4; ++m) _Pragma("unroll") for (int n = 0; n < 2; ++n) _Pragma("unroll") for (int k = 0; k < 2; ++k) \
        acc[ai][bj][m][n] = __builtin_amdgcn_mfma_f32_16x16x32_bf16(Bt[n][k], At[m][k], acc[ai][bj][m][n], 0, 0, 0); __builtin_amdgcn_s_setprio(0); } while (0)
#define PG8_WAIT_V(n) asm volatile("s_waitcnt vmcnt(" #n ")" ::: "memory")
#define PG8_WAIT_L(n) asm volatile("s_waitcnt lgkmcnt(" #n ")" ::: "memory")
#define PG8_BAR __builtin_amdgcn_s_barrier()
#define PG8_SCHED __builtin_amdgcn_sched_barrier(0)
    Unit cur, nxt; int ui = 0;
    if (!S.next(0, cur)) return;
    f32x4 acc[2][2][4][2];
#pragma unroll
    for (int a = 0; a < 2; ++a)
#pragma unroll
        for (int b = 0; b < 2; ++b)
#pragma unroll
            for (int m = 0; m < 4; ++m)
#pragma unroll
                for (int n = 0; n < 2; ++n) acc[a][b][m][n] = (f32x4){0.f, 0.f, 0.f, 0.f};
    bf16x8 At[4][2], B0[2][2], B1[2][2];
    unsigned cv[2][2], nv[2][2];
    S.a_voff(cur, Rr, Cc, cv);
    if constexpr (Sched::GATHER) { PG8_WAIT_V(0); }
#pragma unroll
    for (int h = 0; h < 2; ++h)
#pragma unroll
        for (int i = 0; i < 2; ++i) nv[h][i] = cv[h][i];
    const char* cA = S.a_base(cur); const char* cB = S.b_base(cur);
    PG8_STAGE(PG8_SB(0, 0), cB, voffB); PG8_STAGE(PG8_SB(0, 1), cB + hstep, voffB); PG8_STAGE(PG8_SA(0, 0), cA, cv[0]); PG8_STAGE(PG8_SA(0, 1), cA, cv[1]);
    if (wr == 1) PG8_BAR;
    PG8_WAIT_V(2); PG8_BAR;
    PG8_STAGE(PG8_SB(1, 0), cB + kstep, voffB); PG8_STAGE(PG8_SA(1, 0), cA + kstep, cv[0]); PG8_STAGE(PG8_SB(1, 1), cB + hstep + kstep, voffB);
    PG8_WAIT_V(6); PG8_BAR;
    for (;;) {
        const bool has_next = S.next(ui + 1, nxt);
        const char* nA = has_next ? S.a_base(nxt) : cA; const char* nB = has_next ? S.b_base(nxt) : cB;
        for (int t = 0; t < nt; t += 2) {
            const bool last = (t == nt - 2);
            const char* a1 = cA + (size_t)(t + 1) * kstep;
            const char* a2 = last ? nA : cA + (size_t)(t + 2) * kstep; const char* b2 = last ? nB : cB + (size_t)(t + 2) * kstep;
            const char* a3 = a2 + kstep; const char* b3 = b2 + kstep;
            unsigned v2[2][2];
            if constexpr (Sched::GATHER) {
                if (last && has_next) { S.a_voff(nxt, Rr, Cc, nv); PG8_WAIT_V(0); }
#pragma unroll
                for (int h = 0; h < 2; ++h)
#pragma unroll
                    for (int i = 0; i < 2; ++i) v2[h][i] = last ? nv[h][i] : cv[h][i];
            } else {
#pragma unroll
                for (int h = 0; h < 2; ++h)
#pragma unroll
                    for (int i = 0; i < 2; ++i) v2[h][i] = cv[h][i];
            }
            PG8_LDB(B0, 0, 0); PG8_LDB(B1, 0, 1); PG8_SCHED; PG8_LDA(At, 0, 0); PG8_STAGE(PG8_SA(1, 1), a1, cv[1]);
            PG8_WAIT_V(8); PG8_WAIT_L(0); PG8_BAR; PG8_MMA(0, 0, At, B0); PG8_MMA(0, 1, At, B1); PG8_BAR; PG8_SCHED;
            PG8_LDA(At, 0, 1); PG8_STAGE(PG8_SB(0, 0), b2, voffB); PG8_STAGE(PG8_SB(0, 1), b2 + hstep, voffB); PG8_STAGE(PG8_SA(0, 0), a2, v2[0]);
            PG8_WAIT_V(8); PG8_WAIT_L(0); PG8_BAR; PG8_MMA(1, 0, At, B0); PG8_MMA(1, 1, At, B1); PG8_BAR; PG8_SCHED;
            PG8_LDB(B0, 1, 0); PG8_LDB(B1, 1, 1); PG8_SCHED; PG8_LDA(At, 1, 0); PG8_STAGE(PG8_SA(0, 1), a2, v2[1]);
            PG8_WAIT_V(8); PG8_WAIT_L(0); PG8_BAR; PG8_MMA(0, 0, At, B0); PG8_MMA(0, 1, At, B1); PG8_BAR; PG8_SCHED;
            PG8_LDA(At, 1, 1); PG8_STAGE(PG8_SB(1, 0), b3, voffB); PG8_STAGE(PG8_SB(1, 1), b3 + hstep, voffB); PG8_STAGE(PG8_SA(1, 0), a3, v2[0]);
            PG8_WAIT_V(8); PG8_WAIT_L(0); PG8_BAR; PG8_MMA(1, 0, At, B0); PG8_MMA(1, 1, At, B1); PG8_BAR; PG8_SCHED;
        }
        if constexpr (ALIGN_EPI) { if (wr == 0) PG8_BAR; }
        E(acc, cur, wr, wc, fr, fq);
        if (!has_next) break;
#pragma unroll
        for (int a = 0; a < 2; ++a)
#pragma unroll
            for (int b = 0; b < 2; ++b)
#pragma unroll
                for (int m = 0; m < 4; ++m)
#pragma unroll
                    for (int n = 0; n < 2; ++n) acc[a][b][m][n] = (f32x4){0.f, 0.f, 0.f, 0.f};
        cur = nxt; cA = nA; cB = nB; ++ui;
#pragma unroll
        for (int h = 0; h < 2; ++h)
#pragma unroll
            for (int i = 0; i < 2; ++i) cv[h][i] = nv[h][i];
        if constexpr (ALIGN_EPI) { if (wr == 1) PG8_BAR; }
    }
    PG8_WAIT_V(0);
    if constexpr (!ALIGN_EPI) { if (wr == 0) PG8_BAR; }
    PG8_BAR;
#undef PG8_SA
#undef PG8_SB
#undef PG8_STAGE
#undef PG8_LDA
#undef PG8_LDB
#undef PG8_MMA
#undef PG8_WAIT_V
#undef PG8_WAIT_L
#undef PG8_BAR
#undef PG8_SCHED
}
}

#define XB_TMO      128
#define XB_XCNT(j)  (256  + 64 * (j))
#define XB_XSUB(j)  (1280 + 64 * (j))
#define XB_XGEN(j)  (2304 + 64 * (j))
#define XB_TOP      3328
#define XB_TOPGEN   3392
#define XCD_BAR_WORDS 3456
#define XB_SPIN_CAP (1u << 22)

__device__ __forceinline__ unsigned xb_ld(unsigned* p)              { return __hip_atomic_load(p, __ATOMIC_RELAXED, __HIP_MEMORY_SCOPE_AGENT); }
__device__ __forceinline__ unsigned xb_add(unsigned* p, unsigned v) { return __hip_atomic_fetch_add(p, v, __ATOMIC_RELAXED, __HIP_MEMORY_SCOPE_AGENT); }
__device__ __forceinline__ unsigned xb_xcc_id() { return (unsigned)__builtin_amdgcn_s_getreg((3 << 11) | 20) & 0xFu; }
#define XB_SPIN(cond, bar) do { unsigned _sp = 0; while (cond) { __builtin_amdgcn_s_sleep(1); \
    if ((++_sp & 255u) == 0u) { if (xb_ld(&(bar)[XB_TMO])) break; if (_sp > XB_SPIN_CAP) { atomicAdd(&(bar)[XB_TMO], 1u); break; } } } } while (0)

struct XcdBarrier { unsigned* bar; unsigned x; volatile LAS unsigned* st; };

__device__ __forceinline__ XcdBarrier xcd_barrier_post(unsigned* bar, volatile LAS unsigned* st) {
    XcdBarrier b; b.bar = bar; b.x = xb_xcc_id(); b.st = st;
    if (threadIdx.x == 0) (void)xb_add(&bar[XB_XCNT(b.x)], 1u);
    return b;
}
__device__ __forceinline__ void xcd_barrier_complete(unsigned* bar, unsigned x, unsigned& nloc, unsigned& nx) {
    const unsigned G = gridDim.x * gridDim.y * gridDim.z;
    unsigned sum, cnt, mine, sp = 0u;
    for (;;) {
        sum = 0u; cnt = 0u; mine = 0u;
#pragma unroll
        for (unsigned j = 0; j < 16; ++j) { const unsigned c = xb_ld(&bar[XB_XCNT(j)]); sum += c; cnt += (c > 0u) ? 1u : 0u; mine = (j == x) ? c : mine; }
        if (sum == G) break;
        __builtin_amdgcn_s_sleep(1);
        if ((++sp & 255u) == 0u) { if (xb_ld(&bar[XB_TMO])) break; if (sp > XB_SPIN_CAP) { atomicAdd(&bar[XB_TMO], 1u); break; } }
    }
    nloc = mine > 0u ? mine : 1u; nx = cnt > 0u ? cnt : 1u;
}
__device__ __forceinline__ void xcd_barrier(const XcdBarrier& b) {
    asm volatile("s_waitcnt vmcnt(0)" ::: "memory");
    __syncthreads();
    if (threadIdx.x == 0) {
        unsigned* bar = b.bar;
        __builtin_amdgcn_s_waitcnt(0);
        unsigned nloc = b.st[0], nx = b.st[1];
        if (nloc == 0u) { xcd_barrier_complete(bar, b.x, nloc, nx); b.st[0] = nloc; b.st[1] = nx; }
        const unsigned old = xb_add(&bar[XB_XSUB(b.x)], 1u);
        const unsigned gen = old / nloc;
        if (old + 1u == (gen + 1u) * nloc) {
            __builtin_amdgcn_fence(__ATOMIC_RELEASE, "agent");
            asm volatile("s_waitcnt vmcnt(0)" ::: "memory");
            const unsigned og = xb_add(&bar[XB_TOP], 1u);
            const unsigned tg = og / nx;
            if (og + 1u == (tg + 1u) * nx) xb_add(&bar[XB_TOPGEN], 1u);
            else XB_SPIN(xb_ld(&bar[XB_TOPGEN]) == tg, bar);
            __builtin_amdgcn_fence(__ATOMIC_ACQUIRE, "agent");
            xb_add(&bar[XB_XGEN(b.x)], 1u);
            asm volatile("s_waitcnt vmcnt(0)" ::: "memory");
        } else {
            XB_SPIN(xb_ld(&bar[XB_XGEN(b.x)]) == gen, bar);
            __builtin_amdgcn_fence(__ATOMIC_ACQUIRE, "agent");
            asm volatile("s_waitcnt vmcnt(0)" ::: "memory");
        }
    }
    __syncthreads();
}

struct Args {
    const float* in[24];
    float* out;
    unsigned char* ws;
    int ph_lo, ph_hi;
};

struct TrItem { const float* src; int ldsrc, k0, n0s; bf16* dst; int ldd, drow0; const float* kscale; };
__device__ __forceinline__ void tr_load(const TrItem& t, f32x4 (&v)[8], int lane) {
#pragma unroll
    for (int i = 0; i < 8; ++i) v[i] = *(const f32x4*)(t.src + (size_t)(t.k0 + (lane >> 3) + 8 * i) * t.ldsrc + t.n0s + 4 * (lane & 7));
}
__device__ __forceinline__ void tr_finish(const TrItem& t, const f32x4 (&v)[8], LAS float* scr, int lane) {
#pragma unroll
    for (int i = 0; i < 8; ++i) { const int kk = (lane >> 3) + 8 * i; f32x4 x = v[i]; if (t.kscale) x = x * t.kscale[t.k0 + kk];
        LAS float* d = scr + kk * 33 + 4 * (lane & 7); d[0] = x.x; d[1] = x.y; d[2] = x.z; d[3] = x.w; }
    LDS_WAIT();
    const int c = lane & 7;
#pragma unroll
    for (int j = 0; j < 4; ++j) { const int n = (lane >> 3) + 8 * j; const LAS float* s = scr + (8 * c) * 33 + n;
        u32x4 o; o.x = pk2(s[0 * 33], s[1 * 33]); o.y = pk2(s[2 * 33], s[3 * 33]); o.z = pk2(s[4 * 33], s[5 * 33]); o.w = pk2(s[6 * 33], s[7 * 33]);
        *(u32x4*)(t.dst + (size_t)(t.drow0 + n) * t.ldd + t.k0 + 8 * c) = o; }
    LDS_WAIT();
}

__device__ __forceinline__ void p0_prologue(const Args& a, LAS unsigned char* lds, int tid, int lane, int wave, int wg, int G) {
    unsigned char* ws = a.ws;
    const float* x = a.in[0]; const float* norm1_w = a.in[1]; const float* w_in = a.in[2]; const float* b_ig = a.in[3]; const float* b_fg = a.in[4];
    const float* w_out = a.in[15]; const float* w_gate = a.in[21]; const float* w_up = a.in[22]; const float* w_down = a.in[23];
    bf16* W1T = (bf16*)(ws + WS_W1T); bf16* W2T = (bf16*)(ws + WS_W2T); bf16* WGU = (bf16*)(ws + WS_WGU); bf16* WD = (bf16*)(ws + WS_WD);
    bf16* H1 = (bf16*)(ws + WS_H1); float* GATES = (float*)(ws + WS_GATES);
    LAS float* scr = (LAS float*)(lds + wave * 8448);
    LAS float* gwl = (LAS float*)(lds + 73728);
    for (int idx = tid; idx < 1024 * 8; idx += NTHR) { const int k = idx >> 3, c = idx & 7; gwl[idx] = w_in[(size_t)k * INCOLS + 2048 + c]; }
    __syncthreads();
    const int gw = wg * NWAVES + wave, NGW = G * NWAVES;
    constexpr int I_1 = 16 * 112, I_2 = 16 * 32, I_GU = NEXP * 16 * 32, I_D = NEXP * 8 * 32, NITEMS = I_1 + I_2 + I_GU + I_D;
    auto item_desc = [&](int it) -> TrItem {
        int r = it;
        if (r < I_1) { const int kb = r / 112, nb = r % 112, n0 = nb * 32; int sc_ = n0;
            if (n0 >= 2048 && n0 < 3072) { const int p0 = n0 & 255; sc_ = (n0 & ~255) + 64 * ((p0 >> 5) & 3) + 32 * (p0 >> 7); }
            return TrItem{w_in, INCOLS, kb * 64, sc_ < 2048 ? sc_ : sc_ + 8, W1T, 1024, n0, nullptr}; } r -= I_1;
        if (r < I_2) { const int kb = r / 32, nb = r % 32; return TrItem{w_out, 1024, kb * 64, nb * 32, W2T, 1024, nb * 32, nullptr}; } r -= I_2;
        if (r < I_GU) { const int e = r / 512, q = r % 512, kb = q / 32, nb = q % 32, j0 = nb * 32, pn = j0 >> 8, rr = j0 & 255;
            const float* s_ = (rr < 128 ? w_gate : w_up) + (size_t)e * 1024 * 512;
            return TrItem{s_, 512, kb * 64, pn * 128 + (rr & 127), WGU + (size_t)e * 1024 * 1024, 1024, j0, a.in[16]}; } r -= I_GU;
        { const int e = r / 256, q = r % 256, kb = q / 32, nb = q % 32;
            return TrItem{w_down + (size_t)e * 512 * 1024, 1024, kb * 64, nb * 32, WD + (size_t)e * 1024 * 512, 512, nb * 32, nullptr}; }
    };
    if (gw < NITEMS) {
        TrItem cur = item_desc(gw); f32x4 tv[8]; tr_load(cur, tv, lane);
#pragma unroll 1
        for (int it = gw; it < NITEMS; it += NGW) {
            f32x4 cv_[8];
#pragma unroll
            for (int i = 0; i < 8; ++i) cv_[i] = tv[i];
            const TrItem me = cur;
            if (it + NGW < NITEMS) { cur = item_desc(it + NGW); tr_load(cur, tv, lane); }
            tr_finish(me, cv_, scr, lane);
        }
    }
    f32x4 w1v[4];
#pragma unroll
    for (int j = 0; j < 4; ++j) w1v[j] = ((const f32x4*)norm1_w)[lane + 64 * j];
    f32x4 nx[4], nx2[4];
#pragma unroll
    for (int j = 0; j < 4; ++j) { nx[j] = ((const f32x4*)(x + (size_t)gw * DM))[lane + 64 * j]; nx2[j] = ((const f32x4*)(x + (size_t)(gw + NGW) * DM))[lane + 64 * j]; }
    const int gc = ((lane >> 5) & 1) * 4 + ((lane >> 4) & 1) * 2 + ((lane >> 3) & 1), gh = gc & 3;
    const float gbias = (gc < 4) ? b_ig[gh] : b_fg[gh];
#pragma unroll 1
    for (int m = gw; m < T_; m += NGW) {
        f32x4 v[4]; float ss = 0.f;
#pragma unroll
        for (int j = 0; j < 4; ++j) { v[j] = nx[j]; nx[j] = nx2[j]; ss += (v[j].x * v[j].x + v[j].y * v[j].y) + (v[j].z * v[j].z + v[j].w * v[j].w); }
        if (m + 2 * NGW < T_) {
#pragma unroll
            for (int j = 0; j < 4; ++j) nx2[j] = ((const f32x4*)(x + (size_t)(m + 2 * NGW) * DM))[lane + 64 * j]; }
        const float r = rsqrtf(wave_sum(ss) * (1.f / DM) + EPS);
        float g[8];
#pragma unroll
        for (int c = 0; c < 8; ++c) g[c] = 0.f;
        u32x2* o8 = (u32x2*)(H1 + (size_t)m * DM) + lane;
#pragma unroll
        for (int j = 0; j < 4; ++j) {
            const f32x4 hv = v[j] * r * w1v[j];
            u32x2 o; o.x = pk2(hv.x, hv.y); o.y = pk2(hv.z, hv.w); o8[64 * j] = o;
#pragma unroll
            for (int i = 0; i < 4; ++i) { const int k = 256 * j + 4 * lane + i; const f32x4 ga = *(const LAS f32x4*)(gwl + k * 8), gb = *(const LAS f32x4*)(gwl + k * 8 + 4);
                const float hh = hv[i];
                g[0] += hh * ga.x; g[1] += hh * ga.y; g[2] += hh * ga.z; g[3] += hh * ga.w; g[4] += hh * gb.x; g[5] += hh * gb.y; g[6] += hh * gb.z; g[7] += hh * gb.w; }
        }
        float k4[4], k2[2], k1;
        { const bool up = (lane & 32) != 0;
#pragma unroll
          for (int i = 0; i < 4; ++i) { const float send = up ? g[i] : g[i + 4]; const float recv = __shfl_xor(send, 32); k4[i] = (up ? g[i + 4] : g[i]) + recv; } }
        { const bool up = (lane & 16) != 0;
#pragma unroll
          for (int i = 0; i < 2; ++i) { const float send = up ? k4[i] : k4[i + 2]; const float recv = __shfl_xor(send, 16); k2[i] = (up ? k4[i + 2] : k4[i]) + recv; } }
        { const bool up = (lane & 8) != 0; const float send = up ? k2[0] : k2[1]; const float recv = __shfl_xor(send, 8); k1 = (up ? k2[1] : k2[0]) + recv; }
        k1 += __shfl_xor(k1, 4); k1 += __shfl_xor(k1, 2); k1 += __shfl_xor(k1, 1);
        if ((lane & 7) == 0) {
            float res = k1 + gbias;
            if (gc >= 4) res = fminf(res, 0.f) - log1pf(__expf(-fabsf(res)));
            GATES[(size_t)m * 8 + gc] = res;
        }
    }
}

__device__ __forceinline__ void mlstm_naive(const Args& a, LAS unsigned char* lds, int item, int tid, int lane, int wave) {
    unsigned char* ws = a.ws;
    const bf16* PROJ = (const bf16*)(ws + WS_PROJ); const float* GATES = (const float*)(ws + WS_GATES); bf16* MIX = (bf16*)(ws + WS_MIX);
    const float* conv_w = a.in[5]; const float* conv_b = a.in[6]; const float* m_norm_w = a.in[7];
    LAS float* qs = (LAS float*)lds; LAS float* ks = qs + 8192; LAS float* vs = ks + 8192; LAS float* hb = vs + 8192;
    LAS float* red = hb + 8192; LAS float* dred = red + 1024; LAS float* igs = dred + 16; LAS float* lfs = igs + 64;
    const int b = item >> 2, h = item & 3, e = tid & 127, dq = tid >> 7;
    float Cr[32], nr[32];
#pragma unroll
    for (int j = 0; j < 32; ++j) { Cr[j] = 0.f; nr[j] = 0.f; }
    float m = 0.f;
    const float mw0 = m_norm_w[lane], mw1 = m_norm_w[lane + 64];
    for (int c = 0; c < SEQ / 64; ++c) {
        const int t0 = c * 64;
        for (int idx = tid; idx < 8192; idx += NTHR) {
            const int tt = idx >> 7, d = idx & 127, t = t0 + tt, colq = C_MQ + h * 128 + d, colk = C_MK + h * 128 + d;
            float aq = conv_b[colq], ak = conv_b[colk];
#pragma unroll
            for (int j = 0; j < 4; ++j) { const int ts = t - 3 + j; if (ts >= 0) { const bf16* row = PROJ + (size_t)(b * SEQ + ts) * NCOL; aq += bf2f(row[colq]) * conv_w[j * 1024 + colq]; ak += bf2f(row[colk]) * conv_w[j * 1024 + colk]; } }
            qs[idx] = siluf_(aq); ks[idx] = siluf_(ak) * 0.08838834764831845f;
            vs[idx] = bf2f(PROJ[(size_t)(b * SEQ + t) * NCOL + C_MV + h * 128 + d]);
        }
        if (tid < 64) { igs[tid] = GATES[(size_t)(b * SEQ + t0 + tid) * 8 + h]; lfs[tid] = GATES[(size_t)(b * SEQ + t0 + tid) * 8 + 4 + h]; }
        __syncthreads();
        for (int tt = 0; tt < 64; ++tt) {
            const float lf = lfs[tt], ig = igs[tt];
            const float mnew = fmaxf(lf + m, ig), fd = __expf(lf + m - mnew), iw = __expf(ig - mnew); m = mnew;
            const float ve = vs[tt * 128 + e] * iw;
            float num = 0.f, den = 0.f;
#pragma unroll
            for (int j = 0; j < 32; ++j) { const int d = dq * 32 + j; const float kd = ks[tt * 128 + d], qd = qs[tt * 128 + d];
                Cr[j] = fd * Cr[j] + kd * ve; nr[j] = fd * nr[j] + iw * kd; num += qd * Cr[j]; den += qd * nr[j]; }
            const int p = tt & 1;
            red[(p * 4 + dq) * 128 + e] = num; if (e == 0) dred[p * 4 + dq] = den;
            __syncthreads();
            if (dq == 0) { const float ntot = (red[(p * 4 + 0) * 128 + e] + red[(p * 4 + 1) * 128 + e]) + (red[(p * 4 + 2) * 128 + e] + red[(p * 4 + 3) * 128 + e]);
                const float dtot = (dred[p * 4 + 0] + dred[p * 4 + 1]) + (dred[p * 4 + 2] + dred[p * 4 + 3]);
                hb[tt * 128 + e] = ntot / fmaxf(fabsf(dtot), __expf(-mnew)); }
        }
        __syncthreads();
#pragma unroll 1
        for (int rr = 0; rr < 8; ++rr) {
            const int tt = wave * 8 + rr, t = t0 + tt; const bf16* rowp = PROJ + (size_t)(b * SEQ + t) * NCOL + C_MO + h * 128;
            const float y0 = hb[tt * 128 + lane] * sigmoidf_(bf2f(rowp[lane])), y1 = hb[tt * 128 + lane + 64] * sigmoidf_(bf2f(rowp[lane + 64]));
            const float r = rsqrtf(wave_sum(y0 * y0 + y1 * y1) * (1.f / 128.f) + EPS);
            bf16* orow = MIX + (size_t)(b * SEQ + t) * DM + h * 128;
            orow[lane] = (bf16)f2bf(y0 * r * mw0); orow[lane + 64] = (bf16)f2bf(y1 * r * mw1);
        }
        __syncthreads();
    }
}

__device__ __forceinline__ void attn_naive_row(const Args& a, LAS float* sc, LAS float* qsl, int ridx, int lane, float lam) {
    unsigned char* ws = a.ws;
    const bf16* PROJ = (const bf16*)(ws + WS_PROJ); bf16* MIX = (bf16*)(ws + WS_MIX);
    const float* qnw = a.in[8]; const float* knw = a.in[9]; const float* anw = a.in[14];
    const int h = ridx & 3, bt = ridx >> 2, t = bt & (SEQ - 1), b = bt >> 11;
    {
        const unsigned u = *(const unsigned*)(PROJ + (size_t)bt * NCOL + C_AQ + h * 128 + 2 * lane);
        const float q0 = bflo(u), q1 = bfhi(u); float ss = q0 * q0 + q1 * q1;
#pragma unroll
        for (int o = 1; o < 32; o <<= 1) ss += __shfl_xor(ss, o);
        const float rq = rsqrtf(ss * (1.f / 64.f) + EPS) * 0.125f; const int dd = (2 * lane) & 63;
        qsl[2 * lane] = q0 * rq * qnw[dd] * knw[dd]; qsl[2 * lane + 1] = q1 * rq * qnw[dd + 1] * knw[dd + 1];
    }
    LDS_WAIT();
    const int nk = ((t >> 6) + 1) * 64;
    float m0 = -1e30f, m1 = -1e30f;
    for (int j = lane; j < nk; j += 64) {
        const u32x4* krow = (const u32x4*)(PROJ + (size_t)(b * SEQ + j) * NCOL + C_AK + h * 128);
        float s0 = 0.f, ss0 = 0.f, s1 = 0.f, ss1 = 0.f;
#pragma unroll
        for (int q = 0; q < 8; ++q) { const u32x4 kv = krow[q]; const f32x4 qa = *(const LAS f32x4*)(qsl + q * 8), qb = *(const LAS f32x4*)(qsl + q * 8 + 4);
            const float k0 = bflo(kv.x), k1 = bfhi(kv.x), k2 = bflo(kv.y), k3 = bfhi(kv.y), k4 = bflo(kv.z), k5 = bfhi(kv.z), k6 = bflo(kv.w), k7 = bfhi(kv.w);
            s0 += qa.x * k0 + qa.y * k1 + qa.z * k2 + qa.w * k3 + qb.x * k4 + qb.y * k5 + qb.z * k6 + qb.w * k7;
            ss0 += k0 * k0 + k1 * k1 + k2 * k2 + k3 * k3 + k4 * k4 + k5 * k5 + k6 * k6 + k7 * k7; }
#pragma unroll
        for (int q = 8; q < 16; ++q) { const u32x4 kv = krow[q]; const f32x4 qa = *(const LAS f32x4*)(qsl + q * 8), qb = *(const LAS f32x4*)(qsl + q * 8 + 4);
            const float k0 = bflo(kv.x), k1 = bfhi(kv.x), k2 = bflo(kv.y), k3 = bfhi(kv.y), k4 = bflo(kv.z), k5 = bfhi(kv.z), k6 = bflo(kv.w), k7 = bfhi(kv.w);
            s1 += qa.x * k0 + qa.y * k1 + qa.z * k2 + qa.w * k3 + qb.x * k4 + qb.y * k5 + qb.z * k6 + qb.w * k7;
            ss1 += k0 * k0 + k1 * k1 + k2 * k2 + k3 * k3 + k4 * k4 + k5 * k5 + k6 * k6 + k7 * k7; }
        s0 *= rsqrtf(ss0 * (1.f / 64.f) + EPS); s1 *= rsqrtf(ss1 * (1.f / 64.f) + EPS);
        sc[j] = s0; sc[2048 + j] = s1; m0 = fmaxf(m0, s0); m1 = fmaxf(m1, s1);
    }
    m0 = wave_max(m0); m1 = wave_max(m1);
    float l0 = 0.f, l1 = 0.f;
    for (int j = lane; j < nk; j += 64) { const float e0 = __expf(sc[j] - m0), e1 = __expf(sc[2048 + j] - m1); sc[j] = e0; sc[2048 + j] = e1; l0 += e0; l1 += e1; }
    l0 = wave_sum(l0); l1 = wave_sum(l1);
    const float c0 = 1.f / l0, c1 = lam / l1;
    LDS_WAIT();
    float o0 = 0.f, o1 = 0.f;
    const bf16* vb = PROJ + (size_t)(b * SEQ) * NCOL + C_AV + h * 128 + 2 * lane;
    for (int j = 0; j < nk; ++j) { const float p = sc[j] * c0 - sc[2048 + j] * c1; const unsigned u = *(const unsigned*)(vb + (size_t)j * NCOL); o0 += p * bflo(u); o1 += p * bfhi(u); }
    const float r = rsqrtf(wave_sum(o0 * o0 + o1 * o1) * (1.f / 128.f) + EPS) * (1.f - LAMBDA_INIT);
    *(unsigned*)(MIX + (size_t)bt * DM + 512 + h * 128 + 2 * lane) = pk2(o0 * r * anw[2 * lane], o1 * r * anw[2 * lane + 1]);
    LDS_WAIT();
}

__device__ __forceinline__ void p2_naive(const Args& a, LAS unsigned char* lds, int tid, int lane, int wave, int wg, int G) {
    if (wg < NBATCH * 4) mlstm_naive(a, lds, wg, tid, lane, wave);
    __syncthreads();
    const float* lq1 = a.in[10]; const float* lk1 = a.in[11]; const float* lq2 = a.in[12]; const float* lk2 = a.in[13];
    const float lam = __expf(wave_sum(lq1[lane] * lk1[lane])) - __expf(wave_sum(lq2[lane] * lk2[lane])) + LAMBDA_INIT;
    LAS float* sc = (LAS float*)(lds + wave * 16896); LAS float* qsl = sc + 4096;
    unsigned* queue = (unsigned*)(a.ws + WS_CTL) + CW_QUEUE;
    constexpr int NUNITS = T_ * 4 / 8;
    for (;;) {
        unsigned u = 0; if (lane == 0) u = __hip_atomic_fetch_add(queue, 1u, __ATOMIC_RELAXED, __HIP_MEMORY_SCOPE_AGENT);
        u = (unsigned)__builtin_amdgcn_readfirstlane((int)u);
        if (u >= (unsigned)NUNITS) break;
        const int base = (NUNITS - 1 - (int)u) * 8;
        for (int k = 0; k < 8; ++k) attn_naive_row(a, sc, qsl, base + k, lane, lam);
    }
}


namespace ml {
constexpr int QL = 0, KL = 17408, KWT = 34816, VT = 53248, SD = 71680, AV = 80896, MV = 89088, WV = 97280, IT = 105472, FL = 113664;
constexpr int MC = 121856, BEND = 121984, AMAX = 122112, DEC = 122240, NL = 122368, RS = 122880, QN = 123392, PSQ = 123648;
constexpr int QS = 272, TS = 144;
constexpr float L2E = 1.4426950408889634f;
#define LBAR() do { asm volatile("s_waitcnt lgkmcnt(0)" ::: "memory"); __builtin_amdgcn_s_barrier(); asm volatile("" ::: "memory"); } while (0)
__device__ __forceinline__ f32x4 mfma16(bf16x8 a, bf16x8 b, f32x4 c) { return __builtin_amdgcn_mfma_f32_16x16x32_bf16(a, b, c, 0, 0, 0); }
__device__ __forceinline__ unsigned cvtpk(float lo, float hi) { unsigned r; asm volatile("v_cvt_pk_bf16_f32 %0, %1, %2" : "=v"(r) : "v"(lo), "v"(hi)); return r; }
__device__ __forceinline__ f32x2 silu2(f32x2 o) { f32x2 e = o * (-L2E); e.x = __builtin_amdgcn_exp2f(e.x); e.y = __builtin_amdgcn_exp2f(e.y); e = e + 1.0f; e.x = __builtin_amdgcn_rcpf(e.x); e.y = __builtin_amdgcn_rcpf(e.y); return o * e; }

__device__ __forceinline__ void mlstm_item(const Args& a, LAS unsigned char* lds, const int item, const int tid) {
    unsigned char* ws = a.ws;
    const bf16* PROJ = (const bf16*)(ws + WS_PROJ); const float* GATES = (const float*)(ws + WS_GATES); bf16* MIX = (bf16*)(ws + WS_MIX);
    const float* conv_w = a.in[5]; const float* conv_b = a.in[6]; const float* m_norm_w = a.in[7];
    const int wid = __builtin_amdgcn_readfirstlane(tid >> 6), lane = tid & 63, fr = lane & 15, fq = lane >> 4;
    const int b = item >> 2, h = item & 3, e0 = 16 * wid;
    LAS float* AVl = (LAS float*)(lds + AV); LAS float* MVl = (LAS float*)(lds + MV); LAS float* WVl = (LAS float*)(lds + WV); LAS float* ITl = (LAS float*)(lds + IT); LAS float* FLl = (LAS float*)(lds + FL);
    LAS float* MCl = (LAS float*)(lds + MC); LAS float* BENDl = (LAS float*)(lds + BEND); LAS float* AMAXl = (LAS float*)(lds + AMAX); LAS float* DECl = (LAS float*)(lds + DEC);
    LAS float* NLl = (LAS float*)(lds + NL); LAS float* RSl = (LAS float*)(lds + RS); LAS float* QNl = (LAS float*)(lds + QN); LAS float* PSQl = (LAS float*)(lds + PSQ);
#pragma unroll 1
    for (int cc = 0; cc < 4; ++cc) {
        const int c = 4 * wid + cc, t = 64 * c + lane; const float* g = GATES + (size_t)(b * SEQ + t) * 8;
        float bs = g[4 + h]; const float ig = g[h];
#pragma unroll
        for (int o = 1; o < 64; o <<= 1) { const float v = __shfl_up(bs, o); if (lane >= o) bs += v; }
        const float av = ig - bs; float pm = av;
#pragma unroll
        for (int o = 1; o < 64; o <<= 1) { const float v = __shfl_up(pm, o); if (lane >= o) pm = fmaxf(pm, v); }
        AVl[t] = av; MVl[t] = pm; FLl[t] = bs;
        if (lane == 63) { BENDl[c] = bs; AMAXl[c] = pm; }
    }
    if (tid < 128) NLl[tid] = 0.f;
    __syncthreads();
    if (tid == 0) { float m = 0.f; for (int c = 0; c < 32; ++c) { MCl[c] = m; m = BENDl[c] + fmaxf(m, AMAXl[c]); } }
    __syncthreads();
    {
        float av_[4], pm_[4], bs_[4], m63_[4], mc_[4];
#pragma unroll
        for (int k = 0; k < 4; ++k) { const int t = tid + NTHR * k, c = t >> 6; av_[k] = AVl[t]; pm_[k] = MVl[t]; bs_[k] = FLl[t]; mc_[k] = MCl[c]; m63_[k] = fmaxf(mc_[k], MVl[64 * c + 63]); }
        __syncthreads();
#pragma unroll
        for (int k = 0; k < 4; ++k) { const int t = tid + NTHR * k; const float M = fmaxf(mc_[k], pm_[k]);
            AVl[t] = av_[k] * L2E; MVl[t] = M * L2E; WVl[t] = __expf(av_[k] - m63_[k]); ITl[t] = __expf(mc_[k] - M); FLl[t] = __expf(-(bs_[k] + M)); }
        if (tid < 32) DECl[tid] = __expf(MCl[tid] - fmaxf(MCl[tid], AMAXl[tid]));
    }
    __syncthreads();
    const int isk = wid >> 2, r0 = (wid & 3) * 16;
    const int ccol = (isk ? C_MK : C_MQ) + h * 128 + 2 * lane;
    f32x2 cw2[4], cb2;
#pragma unroll
    for (int j = 0; j < 4; ++j) { cw2[j].x = conv_w[j * 1024 + ccol]; cw2[j].y = conv_w[j * 1024 + ccol + 1]; }
    cb2.x = conv_b[ccol]; cb2.y = conv_b[ccol + 1];
    const bf16* qkbase = PROJ + (size_t)(b * SEQ) * NCOL + ccol;
    const bf16* vbase = PROJ + (size_t)(b * SEQ) * NCOL + C_MV + h * 128 + 2 * lane;
    const bf16* obase = PROJ + (size_t)(b * SEQ) * NCOL + C_MO + h * 128 + e0 + 4 * fq;
    const f32x4 mw = *(const f32x4*)(m_norm_w + e0 + 4 * fq);
    unsigned raw[19], vraw[8];
#define ML_LOADS(c_) do { _Pragma("unroll") for (int i = 0; i < 19; ++i) { const int t = 64 * (c_) + r0 - 3 + i; raw[i] = (t >= 0) ? *(const unsigned*)(qkbase + (size_t)(t < 0 ? 0 : t) * NCOL) : 0u; } \
        _Pragma("unroll") for (int i = 0; i < 8; ++i) vraw[i] = *(const unsigned*)(vbase + (size_t)(64 * (c_) + 8 * wid + i) * NCOL); } while (0)
    ML_LOADS(0);
    f32x4 Cacc[8];
#pragma unroll
    for (int i = 0; i < 8; ++i) Cacc[i] = (f32x4){0.f, 0.f, 0.f, 0.f};
#pragma unroll 1
    for (int c = 0; c < SEQ / 64; ++c) {
        {
            f32x2 xx[19];
#pragma unroll
            for (int i = 0; i < 19; ++i) { xx[i].x = bflo(raw[i]); xx[i].y = bfhi(raw[i]); }
            if (!isk) {
#pragma unroll
                for (int i = 0; i < 16; ++i) { f32x2 o = cb2;
#pragma unroll
                    for (int j = 0; j < 4; ++j) o = xx[i + j] * cw2[j] + o;
                    o = silu2(o);
                    *(LAS unsigned*)(lds + QL + (r0 + i) * QS + 4 * lane) = cvtpk(o.x, o.y); }
            } else {
                f32x2 kv[16];
#pragma unroll
                for (int i = 0; i < 16; ++i) { f32x2 o = cb2;
#pragma unroll
                    for (int j = 0; j < 4; ++j) o = xx[i + j] * cw2[j] + o;
                    o = silu2(o) * 0.08838834764831845f;
                    *(LAS unsigned*)(lds + KL + (r0 + i) * QS + 4 * lane) = cvtpk(o.x, o.y);
                    kv[i] = o; }
                u32x4 k0a, k0b, k1a, k1b;
#pragma unroll
                for (int q = 0; q < 4; ++q) { const f32x4 w4 = *(const LAS f32x4*)(WVl + 64 * c + r0 + 4 * q);
                    const f32x2 e0_ = kv[4 * q] * w4.x, e1_ = kv[4 * q + 1] * w4.y, e2_ = kv[4 * q + 2] * w4.z, e3_ = kv[4 * q + 3] * w4.w;
                    const unsigned a0 = cvtpk(e0_.x, e1_.x), a1 = cvtpk(e2_.x, e3_.x), b0 = cvtpk(e0_.y, e1_.y), b1 = cvtpk(e2_.y, e3_.y);
                    if (q == 0) { k0a.x = a0; k0a.y = a1; k1a.x = b0; k1a.y = b1; } else if (q == 1) { k0a.z = a0; k0a.w = a1; k1a.z = b0; k1a.w = b1; }
                    else if (q == 2) { k0b.x = a0; k0b.y = a1; k1b.x = b0; k1b.y = b1; } else { k0b.z = a0; k0b.w = a1; k1b.z = b0; k1b.w = b1; } }
                *(LAS u32x4*)(lds + KWT + (2 * lane) * TS + r0 * 2) = k0a; *(LAS u32x4*)(lds + KWT + (2 * lane) * TS + r0 * 2 + 16) = k0b;
                *(LAS u32x4*)(lds + KWT + (2 * lane + 1) * TS + r0 * 2) = k1a; *(LAS u32x4*)(lds + KWT + (2 * lane + 1) * TS + r0 * 2 + 16) = k1b;
            }
            u32x4 v0, v1;
            v0.x = (vraw[0] & 0xffffu) | (vraw[1] << 16); v0.y = (vraw[2] & 0xffffu) | (vraw[3] << 16); v0.z = (vraw[4] & 0xffffu) | (vraw[5] << 16); v0.w = (vraw[6] & 0xffffu) | (vraw[7] << 16);
            v1.x = (vraw[0] >> 16) | (vraw[1] & 0xffff0000u); v1.y = (vraw[2] >> 16) | (vraw[3] & 0xffff0000u); v1.z = (vraw[4] >> 16) | (vraw[5] & 0xffff0000u); v1.w = (vraw[6] >> 16) | (vraw[7] & 0xffff0000u);
            *(LAS u32x4*)(lds + VT + (2 * lane) * TS + 16 * wid) = v0;
            *(LAS u32x4*)(lds + VT + (2 * lane + 1) * TS + 16 * wid) = v1;
        }
        if (c + 1 < SEQ / 64) ML_LOADS(c + 1);
        u32x2 og[4];
#pragma unroll
        for (int ti = 0; ti < 4; ++ti) og[ti] = *(const u32x2*)(obase + (size_t)(64 * c + 16 * ti + fr) * NCOL);
        LBAR();
        {
            const int ti = wid >> 1, half = wid & 1; float rsum = 0.f;
            const float Mt = MVl[64 * c + 16 * ti + fr];
#pragma unroll
            for (int sx = 0; sx < 2; ++sx) {
                const int si = 2 * half + sx; f32x4 acc = (f32x4){0.f, 0.f, 0.f, 0.f};
                if (si <= ti) {
#pragma unroll
                    for (int kb = 0; kb < 4; ++kb) {
                        const bf16x8 kf = *(const LAS bf16x8*)(lds + KL + (16 * si + fr) * QS + (32 * kb + 8 * fq) * 2);
                        const bf16x8 qf = *(const LAS bf16x8*)(lds + QL + (16 * ti + fr) * QS + (32 * kb + 8 * fq) * 2);
                        acc = mfma16(kf, qf, acc); }
                    const f32x4 av = *(const LAS f32x4*)(AVl + 64 * c + 16 * si + 4 * fq);
#pragma unroll
                    for (int j = 0; j < 4; ++j) { const int s = 16 * si + 4 * fq + j, t = 16 * ti + fr; const float dd = (s <= t) ? __builtin_amdgcn_exp2f(av[j] - Mt) : 0.f; acc[j] *= dd; rsum += acc[j]; }
                }
                u32x2 o; o.x = cvtpk(acc[0], acc[1]); o.y = cvtpk(acc[2], acc[3]);
                *(LAS u32x2*)(lds + SD + (16 * ti + fr) * TS + (16 * si + 4 * fq) * 2) = o;
            }
            rsum += __shfl_xor(rsum, 16); rsum += __shfl_xor(rsum, 32);
            if (fq == 0) RSl[(16 * ti + fr) * 2 + half] = rsum;
        }
        {
            const int t = tid >> 3, part = tid & 7;
            const u32x4 qa = *(const LAS u32x4*)(lds + QL + t * QS + part * 32), qb = *(const LAS u32x4*)(lds + QL + t * QS + part * 32 + 16);
            const f32x4 n0 = *(const LAS f32x4*)(NLl + 16 * part), n1 = *(const LAS f32x4*)(NLl + 16 * part + 4), n2 = *(const LAS f32x4*)(NLl + 16 * part + 8), n3 = *(const LAS f32x4*)(NLl + 16 * part + 12);
            float s = bflo(qa.x) * n0.x + bfhi(qa.x) * n0.y + bflo(qa.y) * n0.z + bfhi(qa.y) * n0.w + bflo(qa.z) * n1.x + bfhi(qa.z) * n1.y + bflo(qa.w) * n1.z + bfhi(qa.w) * n1.w
                    + bflo(qb.x) * n2.x + bfhi(qb.x) * n2.y + bflo(qb.y) * n2.z + bfhi(qb.y) * n2.w + bflo(qb.z) * n3.x + bfhi(qb.z) * n3.y + bflo(qb.w) * n3.z + bfhi(qb.w) * n3.w;
            s += __shfl_xor(s, 1); s += __shfl_xor(s, 2); s += __shfl_xor(s, 4);
            if (part == 0) QNl[t] = s;
        }
        LBAR();
        f32x4 hacc[4]; float inter[4];
        {
            bf16x8 cf[4];
#pragma unroll
            for (int kb = 0; kb < 4; ++kb) { u32x4 w; w.x = cvtpk(Cacc[2 * kb][0], Cacc[2 * kb][1]); w.y = cvtpk(Cacc[2 * kb][2], Cacc[2 * kb][3]); w.z = cvtpk(Cacc[2 * kb + 1][0], Cacc[2 * kb + 1][1]); w.w = cvtpk(Cacc[2 * kb + 1][2], Cacc[2 * kb + 1][3]);
                cf[kb] = __builtin_bit_cast(bf16x8, w); }
#pragma unroll
            for (int ti = 0; ti < 4; ++ti) {
                hacc[ti] = (f32x4){0.f, 0.f, 0.f, 0.f};
#pragma unroll
                for (int kb = 0; kb < 4; ++kb) {
                    const u32x2 lo = *(const LAS u32x2*)(lds + QL + (16 * ti + fr) * QS + (32 * kb + 4 * fq) * 2), hi = *(const LAS u32x2*)(lds + QL + (16 * ti + fr) * QS + (32 * kb + 16 + 4 * fq) * 2);
                    const u32x4 qq = (u32x4){lo.x, lo.y, hi.x, hi.y};
                    hacc[ti] = mfma16(cf[kb], __builtin_bit_cast(bf16x8, qq), hacc[ti]); }
                inter[ti] = ITl[64 * c + 16 * ti + fr];
                hacc[ti] = hacc[ti] * inter[ti];
            }
        }
        {
            bf16x8 vf[2];
#pragma unroll
            for (int ks = 0; ks < 2; ++ks) vf[ks] = *(const LAS bf16x8*)(lds + VT + (e0 + fr) * TS + (32 * ks + 8 * fq) * 2);
#pragma unroll
            for (int ti = 0; ti < 4; ++ti)
#pragma unroll
                for (int ks = 0; ks < 2; ++ks) if (ks == 0 || ti >= 2) {
                    const bf16x8 sf = *(const LAS bf16x8*)(lds + SD + (16 * ti + fr) * TS + (32 * ks + 8 * fq) * 2);
                    hacc[ti] = mfma16(vf[ks], sf, hacc[ti]); }
            const float decay = DECl[c];
            float nsum = 0.f;
#pragma unroll
            for (int i = 0; i < 8; ++i) {
                Cacc[i] = Cacc[i] * decay;
#pragma unroll
                for (int ks = 0; ks < 2; ++ks) {
                    const bf16x8 kwf = *(const LAS bf16x8*)(lds + KWT + (16 * i + fr) * TS + (32 * ks + 8 * fq) * 2);
                    Cacc[i] = mfma16(kwf, vf[ks], Cacc[i]);
                    if (i == wid) { const u32x4 kk = __builtin_bit_cast(u32x4, kwf);
                        nsum += (bflo(kk.x) + bfhi(kk.x)) + (bflo(kk.y) + bfhi(kk.y)) + (bflo(kk.z) + bfhi(kk.z)) + (bflo(kk.w) + bfhi(kk.w)); }
                }
            }
            nsum += __shfl_xor(nsum, 16); nsum += __shfl_xor(nsum, 32);
            if (fq == 0) NLl[16 * wid + fr] = decay * NLl[16 * wid + fr] + nsum;
        }
        f32x4 hm[4];
#pragma unroll
        for (int ti = 0; ti < 4; ++ti) {
            const int t = 16 * ti + fr;
            const float den = RSl[2 * t] + RSl[2 * t + 1] + inter[ti] * QNl[t];
            const float rd = __builtin_amdgcn_rcpf(fmaxf(fabsf(den), FLl[64 * c + t]));
            const f32x4 gg = (f32x4){bflo(og[ti].x), bfhi(og[ti].x), bflo(og[ti].y), bfhi(og[ti].y)};
            hm[ti] = hacc[ti] * gg * rd;
            float psq = (hm[ti][0] * hm[ti][0] + hm[ti][1] * hm[ti][1]) + (hm[ti][2] * hm[ti][2] + hm[ti][3] * hm[ti][3]);
            psq += __shfl_xor(psq, 16); psq += __shfl_xor(psq, 32);
            if (fq == 0) PSQl[t * 8 + wid] = psq;
        }
        LBAR();
#pragma unroll
        for (int ti = 0; ti < 4; ++ti) {
            const int t = 16 * ti + fr;
            const f32x4 p0 = *(const LAS f32x4*)(PSQl + t * 8), p1 = *(const LAS f32x4*)(PSQl + t * 8 + 4);
            const float r = rsqrtf(((p0.x + p0.y) + (p0.z + p0.w) + (p1.x + p1.y) + (p1.z + p1.w)) * (1.f / 128.f) + EPS);
            const f32x4 ov = hm[ti] * mw * r;
            u32x2 o; o.x = cvtpk(ov[0], ov[1]); o.y = cvtpk(ov[2], ov[3]);
            *(u32x2*)(MIX + (size_t)(b * SEQ + 64 * c + t) * DM + h * 128 + e0 + 4 * fq) = o;
        }
        LBAR();
    }
#undef ML_LOADS
}
}

namespace att {
using s16x4  = __attribute__((ext_vector_type(4))) short;
using f32x16 = __attribute__((ext_vector_type(16))) float;
constexpr int SHM_V = 16384, SHM_K = 16384;
constexpr float THR2 = 11.5415603f;
#define KSWZ(row, colB) ((row) * 256 + ((colB) ^ (((row) & 7) << 4)))
#define SBAR() __builtin_amdgcn_sched_barrier(0)
__device__ __forceinline__ int crow(int r, int hi) { return (r & 3) + 8 * (r >> 2) + 4 * hi; }
__device__ __forceinline__ unsigned cvtpk(float lo, float hi) { unsigned r; asm volatile("v_cvt_pk_bf16_f32 %0, %1, %2" : "=v"(r) : "v"(lo), "v"(hi)); return r; }
__device__ __forceinline__ void partialSM(f32x16& p0, f32x16& p1, float& m_reg, float& mn, float& alpha) {
  float pmax = p0[0];
#pragma unroll
  for (int r = 1; r < 16; ++r) pmax = fmaxf(pmax, p0[r]);
#pragma unroll
  for (int r = 0; r < 16; ++r) pmax = fmaxf(pmax, p1[r]);
  { auto rr = __builtin_amdgcn_permlane32_swap(__float_as_uint(pmax), __float_as_uint(pmax), false, false);
    pmax = fmaxf(__uint_as_float(rr[0]), __uint_as_float(rr[1])); }
  if (__builtin_expect(__all(pmax - m_reg <= THR2), 1)) { mn = m_reg; alpha = 1.f; }
  else { mn = fmaxf(m_reg, pmax); alpha = __builtin_amdgcn_exp2f(m_reg - mn); m_reg = mn; }
#pragma unroll
  for (int r = 0; r < 16; ++r) p0[r] = p0[r] - mn;
#pragma unroll
  for (int r = 0; r < 16; ++r) p1[r] = p1[r] - mn;
#pragma unroll
  for (int r = 0; r < 16; ++r) p0[r] = __builtin_amdgcn_exp2f(p0[r]);
}
__device__ __forceinline__ void finishSM(f32x16& p0, f32x16& p1, float alpha, float& l_reg, bf16x8& pa0, bf16x8& pa1, bf16x8& pa2, bf16x8& pa3) {
#pragma unroll
  for (int r = 0; r < 16; ++r) p1[r] = __builtin_amdgcn_exp2f(p1[r]);
  float ps = 0;
#pragma unroll
  for (int r = 0; r < 16; ++r) ps += p0[r];
#pragma unroll
  for (int r = 0; r < 16; ++r) ps += p1[r];
  { auto rr = __builtin_amdgcn_permlane32_swap(__float_as_uint(ps), __float_as_uint(ps), false, false);
    ps = __uint_as_float(rr[0]) + __uint_as_float(rr[1]); }
  l_reg = l_reg * alpha + ps;
#define PK4(P, BASE, OUT) do { unsigned a0 = cvtpk(P[BASE + 0], P[BASE + 1]), a1 = cvtpk(P[BASE + 2], P[BASE + 3]);   \
    unsigned b0 = cvtpk(P[BASE + 4], P[BASE + 5]), b1 = cvtpk(P[BASE + 6], P[BASE + 7]);                              \
    auto r0 = __builtin_amdgcn_permlane32_swap(a0, b0, false, false); auto r1 = __builtin_amdgcn_permlane32_swap(a1, b1, false, false); \
    u32x4 w = {r0[0], r1[0], r0[1], r1[1]}; OUT = __builtin_bit_cast(bf16x8, w); } while (0)
  PK4(p0, 0, pa0); PK4(p0, 8, pa1); PK4(p1, 0, pa2); PK4(p1, 8, pa3);
#undef PK4
}
__device__ __forceinline__ void partialFX(f32x16& p0) {
#pragma unroll
  for (int r = 0; r < 16; ++r) p0[r] = __builtin_amdgcn_exp2f(p0[r]);
}
__device__ __forceinline__ void finishFX(f32x16& p0, f32x16& p1, float& l_reg, bf16x8& pa0, bf16x8& pa1, bf16x8& pa2, bf16x8& pa3) {
#pragma unroll
  for (int r = 0; r < 16; ++r) p1[r] = __builtin_amdgcn_exp2f(p1[r]);
  float ps = 0;
#pragma unroll
  for (int r = 0; r < 16; ++r) ps += p0[r];
#pragma unroll
  for (int r = 0; r < 16; ++r) ps += p1[r];
  l_reg += ps;
#define PK4(P, BASE, OUT) do { unsigned a0 = cvtpk(P[BASE + 0], P[BASE + 1]), a1 = cvtpk(P[BASE + 2], P[BASE + 3]);   \
    unsigned b0 = cvtpk(P[BASE + 4], P[BASE + 5]), b1 = cvtpk(P[BASE + 6], P[BASE + 7]);                              \
    auto r0 = __builtin_amdgcn_permlane32_swap(a0, b0, false, false); auto r1 = __builtin_amdgcn_permlane32_swap(a1, b1, false, false); \
    u32x4 w = {r0[0], r1[0], r0[1], r1[1]}; OUT = __builtin_bit_cast(bf16x8, w); } while (0)
  PK4(p0, 0, pa0); PK4(p0, 8, pa1); PK4(p1, 0, pa2); PK4(p1, 8, pa3);
#undef PK4
}
__device__ __forceinline__ void qkt(f32x16& p0, f32x16& p1, const LAS unsigned char* Ks, const bf16x8 (&qr)[4], int c, int r32, int hi) {
  p0 = f32x16{}; p1 = f32x16{};
#pragma unroll
  for (int d0 = 0; d0 < 4; ++d0) { const int cb = (c * 64 + d0 * 16 + hi * 8) * 2;
    const bf16x8 b0 = *(const LAS bf16x8*)(Ks + KSWZ(r32, cb));
    const bf16x8 b1 = *(const LAS bf16x8*)(Ks + KSWZ(32 + r32, cb));
    p0 = __builtin_amdgcn_mfma_f32_32x32x16_bf16(b0, qr[d0], p0, 0, 0, 0);
    p1 = __builtin_amdgcn_mfma_f32_32x32x16_bf16(b1, qr[d0], p1, 0, 0, 0); }
}
__device__ __forceinline__ int v_st(int k, int c) { const int kk = (k & ~0xC) | ((k & 4) << 1) | ((k & 8) >> 1); return ((kk >> 3) * 4 + (c >> 5)) * 512 + ((kk & 7) * 32 + (c & 31)) * 2; }
__device__ __forceinline__ int v_rd_base(int lane) { return ((lane & 3) << 3) | (((lane >> 2) & 3) << 6) | (((lane >> 4) & 1) << 5) | (((lane >> 5) & 1) << 8); }
constexpr int v_rd_off(int d0, int ks, int half) { return d0 * 512 + ks * 4096 + half * 2048; }
template <int OFF> __device__ __forceinline__ s16x4 tr_read(int vb) {
  s16x4 r; asm volatile("ds_read_b64_tr_b16 %0, %1 offset:%2" : "=&v"(r) : "v"(vb), "i"(OFF) : "memory"); return r;
}
template <int D0> __device__ __forceinline__ void pv_one(f32x16& od, int vb, bf16x8 pa0, bf16x8 pa1, bf16x8 pa2, bf16x8 pa3) {
  const s16x4 l0 = tr_read<v_rd_off(D0, 0, 0)>(vb), h0 = tr_read<v_rd_off(D0, 0, 1)>(vb), l1 = tr_read<v_rd_off(D0, 1, 0)>(vb), h1 = tr_read<v_rd_off(D0, 1, 1)>(vb);
  const s16x4 l2 = tr_read<v_rd_off(D0, 2, 0)>(vb), h2 = tr_read<v_rd_off(D0, 2, 1)>(vb), l3 = tr_read<v_rd_off(D0, 3, 0)>(vb), h3 = tr_read<v_rd_off(D0, 3, 1)>(vb);
  asm volatile("s_waitcnt lgkmcnt(0)" ::: "memory"); SBAR();
#define PK(L, H) (bf16x8){L[0], L[1], L[2], L[3], H[0], H[1], H[2], H[3]}
  od = __builtin_amdgcn_mfma_f32_32x32x16_bf16(pa0, PK(l0, h0), od, 0, 0, 0);
  od = __builtin_amdgcn_mfma_f32_32x32x16_bf16(pa1, PK(l1, h1), od, 0, 0, 0);
  od = __builtin_amdgcn_mfma_f32_32x32x16_bf16(pa2, PK(l2, h2), od, 0, 0, 0);
  od = __builtin_amdgcn_mfma_f32_32x32x16_bf16(pa3, PK(l3, h3), od, 0, 0, 0);
#undef PK
}
#define PVRD(D0) const s16x4 l0_##D0 = tr_read<v_rd_off(D0, 0, 0)>(vb), h0_##D0 = tr_read<v_rd_off(D0, 0, 1)>(vb), l1_##D0 = tr_read<v_rd_off(D0, 1, 0)>(vb), h1_##D0 = tr_read<v_rd_off(D0, 1, 1)>(vb), \
    l2_##D0 = tr_read<v_rd_off(D0, 2, 0)>(vb), h2_##D0 = tr_read<v_rd_off(D0, 2, 1)>(vb), l3_##D0 = tr_read<v_rd_off(D0, 3, 0)>(vb), h3_##D0 = tr_read<v_rd_off(D0, 3, 1)>(vb)
#define PVPK(L, H) (bf16x8){L[0], L[1], L[2], L[3], H[0], H[1], H[2], H[3]}
#define PVMM(D0, N) do { asm volatile("s_waitcnt lgkmcnt(" #N ")" ::: "memory"); SBAR(); \
    o[D0] = __builtin_amdgcn_mfma_f32_32x32x16_bf16(pa0, PVPK(l0_##D0, h0_##D0), o[D0], 0, 0, 0); o[D0] = __builtin_amdgcn_mfma_f32_32x32x16_bf16(pa1, PVPK(l1_##D0, h1_##D0), o[D0], 0, 0, 0); \
    o[D0] = __builtin_amdgcn_mfma_f32_32x32x16_bf16(pa2, PVPK(l2_##D0, h2_##D0), o[D0], 0, 0, 0); o[D0] = __builtin_amdgcn_mfma_f32_32x32x16_bf16(pa3, PVPK(l3_##D0, h3_##D0), o[D0], 0, 0, 0); } while (0)
__device__ __forceinline__ void pv_d0(f32x16* o, int vb, bf16x8 pa0, bf16x8 pa1, bf16x8 pa2, bf16x8 pa3) {
  PVRD(0); PVRD(1); PVMM(0, 8); PVRD(2); PVMM(1, 8); PVRD(3); PVMM(2, 8); PVMM(3, 0);
}
#undef PVRD
#undef PVPK
#undef PVMM

template <bool FX>
__device__ __forceinline__ void attn_unit(const bf16* __restrict__ PROJ, bf16* __restrict__ MIX, const float* __restrict__ anw, const float lam, const float nb, const int b, const int h, const int qb,
                                          LAS unsigned char* lds, const int tid) {
  const int wid = __builtin_amdgcn_readfirstlane(tid >> 6), lane = tid & 63, r32 = lane & 31, hi = lane >> 5, g = wid >> 1, c = wid & 1;
  const int q0 = qb * 128, NT = 2 * qb + 2; const bool masked_last = (g < 2);
  int hcol = h * 128; asm volatile("" : "+s"(hcol));
  const char* Kg = (const char*)(PROJ + (size_t)(b * SEQ) * NCOL + C_AK + hcol);
  const char* Vg = (const char*)(PROJ + (size_t)(b * SEQ) * NCOL + C_AV + hcol);
  LAS float* wsf = (LAS float*)(lds + 131072) + wid * 64; LAS float* li_l = wsf; LAS float* al_l = wsf + 32;
  unsigned koff[2], voff[2];
#pragma unroll
  for (int p = 0; p < 2; ++p) { const int s = (wid * 2 + p) * 64 + lane, row = s >> 4, ch = (s & 15) ^ (row & 7); koff[p] = (unsigned)(row * NCOL + ch * 8) * 2u;
    const int o = s * 16, sub = o >> 9, within = o & 511, kk = (sub >> 2) * 8 + (within >> 6), k = (kk & ~0xC) | ((kk & 4) << 1) | ((kk & 8) >> 1), cc = (sub & 3) * 32 + ((within & 63) >> 4) * 8;
    voff[p] = (unsigned)(k * NCOL + cc) * 2u; }
#define DMA(tile, slot) do { const char* kt_ = Kg + (size_t)(tile) * (64 * NCOL * 2); const char* vt_ = Vg + (size_t)(tile) * (64 * NCOL * 2); LAS unsigned char* sl_ = lds + (slot) * 32768 + wid * 2048; \
    _Pragma("unroll") for (int p_ = 0; p_ < 2; ++p_) __builtin_amdgcn_global_load_lds((const unsigned*)(kt_ + koff[p_]), (LAS unsigned*)(sl_ + p_ * 1024), 16, 0, 0); \
    _Pragma("unroll") for (int p_ = 0; p_ < 2; ++p_) __builtin_amdgcn_global_load_lds((const unsigned*)(vt_ + voff[p_]), (LAS unsigned*)(sl_ + 16384 + p_ * 1024), 16, 0, 0); } while (0)
#define WB4() do { asm volatile("s_waitcnt vmcnt(4)" ::: "memory"); __builtin_amdgcn_s_barrier(); asm volatile("" ::: "memory"); } while (0)
#define WB8() do { asm volatile("s_waitcnt vmcnt(8)" ::: "memory"); __builtin_amdgcn_s_barrier(); asm volatile("" ::: "memory"); } while (0)
#define KSLOT(j) (lds + ((j) & 3) * 32768)
#define VSLOT(j) (vb0 + ((j) & 3) * 32768)
  float m_reg = -1e30f, l_reg = 0; f32x16 o[4] = {}; bf16x8 qr[4];
  { const bf16* Qw = PROJ + (size_t)(b * SEQ + q0 + 32 * g + r32) * NCOL + C_AQ + hcol + c * 64 + hi * 8;
#pragma unroll
    for (int d0 = 0; d0 < 4; ++d0) qr[d0] = *(const bf16x8*)(Qw + d0 * 16); }
  const int vb0 = (int)(unsigned)(uintptr_t)lds + 16384 + v_rd_base(lane);
#define RESC(a) do { if (__any((a) < 1.f)) { if (hi == 0) al_l[r32] = (a); asm volatile("s_waitcnt lgkmcnt(0)" ::: "memory"); \
    _Pragma("unroll") for (int d = 0; d < 4; ++d) _Pragma("unroll") for (int r = 0; r < 16; ++r) o[d][r] *= al_l[crow(r, hi)]; } } while (0)
  f32x16 p0, p1; float mn, al; bf16x8 pa0, pa1, pa2, pa3;
  DMA(0, 0); DMA(1, 1);
#pragma unroll 1
  for (int j = 0; j < NT; ++j) {
    WB4();
    DMA((j + 2 < NT ? j + 2 : NT - 1), (j + 2) & 3);
    SBAR(); qkt(p0, p1, KSLOT(j), qr, c, r32, hi);
    if (masked_last && j == NT - 1) {
#pragma unroll
      for (int r = 0; r < 16; ++r) { p0[r] = -1e30f; p1[r] = -1e30f; } }
    if constexpr (FX) { SBAR(); partialFX(p0); finishFX(p0, p1, l_reg, pa0, pa1, pa2, pa3); SBAR(); }
    else { partialSM(p0, p1, m_reg, mn, al); RESC(al); finishSM(p0, p1, al, l_reg, pa0, pa1, pa2, pa3); SBAR(); }
    pv_d0(o, VSLOT(j), pa0, pa1, pa2, pa3);
  }
  if constexpr (FX) l_reg += __shfl_xor(l_reg, 32);
  asm volatile("s_waitcnt vmcnt(0)" ::: "memory");
#undef DMA
#undef WB4
#undef WB8
#undef KSLOT
#undef VSLOT
  if (hi == 0) li_l[r32] = l_reg; asm volatile("s_waitcnt lgkmcnt(0)" ::: "memory");
  int lane2 = lane; asm volatile("" : "+v"(lane2));
  const int r32b = lane2 & 31, hib = lane2 >> 5;
  float rli[16];
#pragma unroll
  for (int r = 0; r < 16; ++r) rli[r] = __builtin_amdgcn_rcpf(li_l[(r & 3) + 8 * (r >> 2) + 4 * hib]);
  __syncthreads();
  LAS float* X = (LAS float*)(lds + g * 16384) + hib * 512 + r32b;
  if (c == 1) {
#pragma unroll
    for (int r = 0; r < 16; ++r)
#pragma unroll
      for (int d0 = 0; d0 < 4; ++d0) X[((r & 3) + 8 * (r >> 2)) * 128 + d0 * 32] = o[d0][r] * (rli[r] * lam);
  }
  __syncthreads();
  if (c == 0) {
    float ss[16];
#pragma unroll
    for (int r = 0; r < 16; ++r) { ss[r] = 0.f;
#pragma unroll
      for (int d0 = 0; d0 < 4; ++d0) { const float v = o[d0][r] * rli[r] - X[((r & 3) + 8 * (r >> 2)) * 128 + d0 * 32]; o[d0][r] = v; ss[r] += v * v; } }
#pragma unroll
    for (int r = 0; r < 16; ++r) {
#pragma unroll
      for (int s = 1; s < 32; s <<= 1) ss[r] += __shfl_xor(ss[r], s);
      ss[r] = rsqrtf(ss[r] * (1.f / 128.f) + EPS) * (1.f - LAMBDA_INIT); }
    float aw[4];
#pragma unroll
    for (int d0 = 0; d0 < 4; ++d0) aw[d0] = anw[d0 * 32 + r32b];
    asm volatile("s_waitcnt lgkmcnt(0)" ::: "memory");
    LAS bf16* Ost = (LAS bf16*)(lds + g * 16384);
    LAS bf16* Ow = Ost + hib * 512 + r32b;
#pragma unroll
    for (int r = 0; r < 16; ++r)
#pragma unroll
      for (int d0 = 0; d0 < 4; ++d0) Ow[((r & 3) + 8 * (r >> 2)) * 128 + d0 * 32] = (bf16)f2bf(o[d0][r] * ss[r] * aw[d0]);
    asm volatile("s_waitcnt lgkmcnt(0)" ::: "memory");
    const int rowb = lane2 >> 4, c16 = lane2 & 15;
    bf16* Ob = MIX + (size_t)(b * SEQ + q0 + 32 * g + rowb) * DM + 512 + h * 128 + c16 * 8;
    const LAS bf16* Os = Ost + rowb * 128 + c16 * 8;
#pragma unroll
    for (int k = 0; k < 8; ++k) *(u32x4*)(Ob + (size_t)k * 4 * DM) = *(const LAS u32x4*)(Os + k * 512);
  }
  __syncthreads();
#undef RESC
}

template <int C, int HALF_> __device__ __forceinline__ void half_scores(f32x16& p, const LAS unsigned char* Ks, const bf16x8 (&qr)[8], const int kaddr) {
  p = f32x16{};
#pragma unroll
  for (int d0 = 0; d0 < 4; ++d0) { const bf16x8 kf = *(const LAS bf16x8*)(Ks + (kaddr ^ (d0 * 32)) + C * 128 + HALF_ * 8192);
    p = __builtin_amdgcn_mfma_f32_32x32x16_bf16(kf, qr[C * 4 + d0], p, 0, 0, 0); }
}
__device__ __forceinline__ void half_softmax(f32x16& p, float& l_reg, bf16x8& pa, bf16x8& pb) {
#pragma unroll
  for (int r = 0; r < 16; ++r) p[r] = __builtin_amdgcn_exp2f(p[r]);
  float ps = 0;
#pragma unroll
  for (int r = 0; r < 16; ++r) ps += p[r];
  l_reg += ps;
#define PK4(P, BASE, OUT) do { unsigned a0 = cvtpk(P[BASE + 0], P[BASE + 1]), a1 = cvtpk(P[BASE + 2], P[BASE + 3]);   \
    unsigned b0 = cvtpk(P[BASE + 4], P[BASE + 5]), b1 = cvtpk(P[BASE + 6], P[BASE + 7]);                              \
    auto r0 = __builtin_amdgcn_permlane32_swap(a0, b0, false, false); auto r1 = __builtin_amdgcn_permlane32_swap(a1, b1, false, false); \
    u32x4 w = {r0[0], r1[0], r0[1], r1[1]}; OUT = __builtin_bit_cast(bf16x8, w); } while (0)
  PK4(p, 0, pa); PK4(p, 8, pb);
#undef PK4
  SBAR();
}
template <int D0, int HALF_> __device__ __forceinline__ void pv_half(f32x16& oa, f32x16& ob, int vb, bf16x8 a0, bf16x8 a1, bf16x8 b0, bf16x8 b1) {
  const s16x4 l0 = tr_read<v_rd_off(D0, 2 * HALF_, 0)>(vb), h0 = tr_read<v_rd_off(D0, 2 * HALF_, 1)>(vb), l1 = tr_read<v_rd_off(D0, 2 * HALF_ + 1, 0)>(vb), h1 = tr_read<v_rd_off(D0, 2 * HALF_ + 1, 1)>(vb);
  asm volatile("s_waitcnt lgkmcnt(0)" ::: "memory"); SBAR();
#define PK(L, H) (bf16x8){L[0], L[1], L[2], L[3], H[0], H[1], H[2], H[3]}
  oa = __builtin_amdgcn_mfma_f32_32x32x16_bf16(a0, PK(l0, h0), oa, 0, 0, 0);
  ob = __builtin_amdgcn_mfma_f32_32x32x16_bf16(b0, PK(l0, h0), ob, 0, 0, 0);
  oa = __builtin_amdgcn_mfma_f32_32x32x16_bf16(a1, PK(l1, h1), oa, 0, 0, 0);
  ob = __builtin_amdgcn_mfma_f32_32x32x16_bf16(b1, PK(l1, h1), ob, 0, 0, 0);
#undef PK
  SBAR();
}
__device__ __forceinline__ void attn2_setup(LAS unsigned char* lds, const int tid) {
  const int wid = __builtin_amdgcn_readfirstlane(tid >> 6), lane = tid & 63;
  unsigned koff[2], voff[2];
#pragma unroll
  for (int p = 0; p < 2; ++p) { const int s = (wid * 2 + p) * 64 + lane, row = s >> 4, ch = (s & 15) ^ (row & 7); koff[p] = (unsigned)(row * NCOL + ch * 8) * 2u;
    const int o = s * 16, sub = o >> 9, within = o & 511, kk = (sub >> 2) * 8 + (within >> 6), k = (kk & ~0xC) | ((kk & 4) << 1) | ((kk & 8) >> 1), cc = (sub & 3) * 32 + ((within & 63) >> 4) * 8;
    voff[p] = (unsigned)(k * NCOL + cc) * 2u; }
  *((LAS u32x4*)(lds + 133120 + wid * 1024) + lane) = (u32x4){koff[0], koff[1], voff[0], voff[1]};
  asm volatile("s_waitcnt lgkmcnt(0)" ::: "memory");
}
__device__ __forceinline__ void attn_unit2(const bf16* __restrict__ PROJ, bf16* __restrict__ MIX, const float* __restrict__ anw, const float lam, const int b, const int h, const int qb,
                                           LAS unsigned char* lds, const int tid) {
  const int wid = __builtin_amdgcn_readfirstlane(tid >> 6), lane = tid & 63, r32 = lane & 31, hi = lane >> 5;
  const int q0 = qb * 256, NT = 4 * qb + 4, jlast = 4 * qb + (wid >> 1);
  int hcol = h * 128; asm volatile("" : "+s"(hcol));
  const char* Kg = (const char*)(PROJ + (size_t)(b * SEQ) * NCOL + C_AK + hcol);
  const char* Vg = (const char*)(PROJ + (size_t)(b * SEQ) * NCOL + C_AV + hcol);
  LAS float* wsf = (LAS float*)(lds + 131072) + wid * 64;
  LAS u32x4* offt = (LAS u32x4*)(lds + 133120 + wid * 1024) + lane;
#define DMA(tile, slot) do { const char* kt_ = Kg + (size_t)(tile) * (64 * NCOL * 2); const char* vt_ = Vg + (size_t)(tile) * (64 * NCOL * 2); LAS unsigned char* sl_ = lds + (slot) * 32768 + wid * 2048; const u32x4 of_ = *offt; \
    __builtin_amdgcn_global_load_lds((const unsigned*)(kt_ + of_.x), (LAS unsigned*)(sl_), 16, 0, 0); __builtin_amdgcn_global_load_lds((const unsigned*)(kt_ + of_.y), (LAS unsigned*)(sl_ + 1024), 16, 0, 0); \
    __builtin_amdgcn_global_load_lds((const unsigned*)(vt_ + of_.z), (LAS unsigned*)(sl_ + 16384), 16, 0, 0); __builtin_amdgcn_global_load_lds((const unsigned*)(vt_ + of_.w), (LAS unsigned*)(sl_ + 16384 + 1024), 16, 0, 0); } while (0)
#define WB4() do { asm volatile("s_waitcnt vmcnt(4)" ::: "memory"); __builtin_amdgcn_s_barrier(); asm volatile("" ::: "memory"); } while (0)
  float l0 = 0.f, l1 = 0.f; f32x16 oa[4] = {}, ob[4] = {}; bf16x8 qr[8];
  { const bf16* Qw = PROJ + (size_t)(b * SEQ + q0 + 32 * wid + r32) * NCOL + C_AQ + hcol + hi * 8;
#pragma unroll
    for (int d = 0; d < 8; ++d) qr[d] = *(const bf16x8*)(Qw + d * 16); }
  const int vb0 = (int)(unsigned)(uintptr_t)lds + 16384 + v_rd_base(lane);
  const int kaddr = r32 * 256 + ((hi * 16) ^ ((r32 & 7) << 4));
  DMA(0, 0); DMA(1, 1);
#pragma unroll 1
  for (int j = 0; j < NT; ++j) {
    WB4();
    DMA((j + 2 < NT ? j + 2 : NT - 1), (j + 2) & 3);
    if (j <= jlast) {
      const LAS unsigned char* Ks = lds + (j & 3) * 32768; const int vb = vb0 + (j & 3) * 32768;
      f32x16 p; bf16x8 a0, a1, b0, b1;
      SBAR(); half_scores<0, 0>(p, Ks, qr, kaddr); half_softmax(p, l0, a0, a1);
      SBAR(); half_scores<1, 0>(p, Ks, qr, kaddr); half_softmax(p, l1, b0, b1); SBAR();
      pv_half<0, 0>(oa[0], ob[0], vb, a0, a1, b0, b1); pv_half<1, 0>(oa[1], ob[1], vb, a0, a1, b0, b1); pv_half<2, 0>(oa[2], ob[2], vb, a0, a1, b0, b1); pv_half<3, 0>(oa[3], ob[3], vb, a0, a1, b0, b1);
      SBAR(); half_scores<0, 1>(p, Ks, qr, kaddr); half_softmax(p, l0, a0, a1);
      SBAR(); half_scores<1, 1>(p, Ks, qr, kaddr); half_softmax(p, l1, b0, b1); SBAR();
      pv_half<0, 1>(oa[0], ob[0], vb, a0, a1, b0, b1); pv_half<1, 1>(oa[1], ob[1], vb, a0, a1, b0, b1); pv_half<2, 1>(oa[2], ob[2], vb, a0, a1, b0, b1); pv_half<3, 1>(oa[3], ob[3], vb, a0, a1, b0, b1);
    }
  }
  l0 += __shfl_xor(l0, 32); l1 += __shfl_xor(l1, 32);
  asm volatile("s_waitcnt vmcnt(0)" ::: "memory");
  if (hi == 0) { wsf[r32] = l0; wsf[32 + r32] = l1; } asm volatile("s_waitcnt lgkmcnt(0)" ::: "memory");
  int lane2 = lane; asm volatile("" : "+v"(lane2));
  const int r32b = lane2 & 31, hib = lane2 >> 5;
  __syncthreads();
  float ss[16];
#pragma unroll
  for (int r = 0; r < 16; ++r) { const int row = (r & 3) + 8 * (r >> 2) + 4 * hib; const float c0 = __builtin_amdgcn_rcpf(wsf[row]), c1 = lam * __builtin_amdgcn_rcpf(wsf[32 + row]); ss[r] = 0.f;
#pragma unroll
    for (int d0 = 0; d0 < 4; ++d0) { const float v = oa[d0][r] * c0 - ob[d0][r] * c1; oa[d0][r] = v; ss[r] += v * v; } }
#pragma unroll
  for (int r = 0; r < 16; ++r) {
#pragma unroll
    for (int s = 1; s < 32; s <<= 1) ss[r] += __shfl_xor(ss[r], s);
    ss[r] = rsqrtf(ss[r] * (1.f / 128.f) + EPS) * (1.f - LAMBDA_INIT); }
  float aw[4];
#pragma unroll
  for (int d0 = 0; d0 < 4; ++d0) aw[d0] = anw[d0 * 32 + r32b];
  LAS bf16* Ost = (LAS bf16*)(lds + wid * 8192);
  LAS bf16* Ow = Ost + hib * 512 + r32b;
#pragma unroll
  for (int r = 0; r < 16; ++r)
#pragma unroll
    for (int d0 = 0; d0 < 4; ++d0) Ow[((r & 3) + 8 * (r >> 2)) * 128 + d0 * 32] = (bf16)f2bf(oa[d0][r] * ss[r] * aw[d0]);
  asm volatile("s_waitcnt lgkmcnt(0)" ::: "memory");
  const int rowb = lane2 >> 4, c16 = lane2 & 15;
  bf16* Ob = MIX + (size_t)(b * SEQ + q0 + 32 * wid + rowb) * DM + 512 + h * 128 + c16 * 8;
  const LAS bf16* Os = Ost + rowb * 128 + c16 * 8;
#pragma unroll
  for (int k = 0; k < 8; ++k) *(u32x4*)(Ob + (size_t)k * 4 * DM) = *(const LAS u32x4*)(Os + k * 512);
  __syncthreads();
#undef DMA
#undef WB4
}
}

template <bool FX>
__device__ __forceinline__ void attn_queue(const bf16* PROJ, bf16* MIX, const float* anw, const float lam, const float nb, unsigned* queue, LAS unsigned char* lds, int tid) {
    LAS unsigned* slot = (LAS unsigned*)(lds + LDSCTL_OFF + 64);
    const int x0 = (int)(xb_xcc_id() & 7u);
    if constexpr (FX) att::attn2_setup(lds, tid);
#pragma unroll 1
    for (int k = 0; k < 8; ++k) {
        const int x = (x0 + k) & 7;
        if (tid == 0) *slot = __hip_atomic_fetch_add(queue + 64 * x, 1u, __ATOMIC_RELAXED, __HIP_MEMORY_SCOPE_AGENT);
        __syncthreads();
        for (;;) {
            const unsigned l = *slot;
            __syncthreads();
            if (l >= 128u) break;
            unsigned nxt = 0u;
            if (tid == 0) nxt = __hip_atomic_fetch_add(queue + 64 * x, 1u, __ATOMIC_RELAXED, __HIP_MEMORY_SCOPE_AGENT);
            const int bh = ((int)l >> 3) * 8 + x, p = (int)l & 7;
            if constexpr (FX) { const int bh2 = ((int)l & 15) * 8 + x, qb2 = 7 - ((int)l >> 4); att::attn_unit2(PROJ, MIX, anw, lam, bh2 >> 2, bh2 & 3, qb2, lds, tid); }
            else {
#pragma unroll 1
                for (int s = 0; s < 2; ++s) att::attn_unit<false>(PROJ, MIX, anw, lam, nb, bh >> 2, bh & 3, s ? p : 15 - p, lds, tid); }
            if (tid == 0) *slot = nxt;
            __syncthreads();
        }
    }
}
__device__ __forceinline__ void p2_fast_attn(const Args& a, LAS unsigned char* lds, int tid, int lane, int wave, int wg, int G, int rep) {
    const float* lq1 = a.in[10]; const float* lk1 = a.in[11]; const float* lq2 = a.in[12]; const float* lk2 = a.in[13];
    const float lam = __expf(wave_sum(lq1[lane] * lk1[lane])) - __expf(wave_sum(lq2[lane] * lk2[lane])) + LAMBDA_INIT;
    const float bound2 = 8.f * 1.4426950408889634f * 1.01f * wave_max(fabsf(a.in[8][lane])) * wave_max(fabsf(a.in[9][lane]));
    const bool fixedmax = bound2 <= 40.f;
    const bf16* PROJ = (const bf16*)(a.ws + WS_PROJ); bf16* MIX = (bf16*)(a.ws + WS_MIX);
    unsigned* queue = (unsigned*)(a.ws + WS_CTL) + CW_QUEUE + 1024 * rep;
    if (fixedmax) attn_queue<true>(PROJ, MIX, a.in[14], lam, -bound2, queue, lds, tid);
    else attn_queue<false>(PROJ, MIX, a.in[14], lam, 0.f, queue, lds, tid);
}

__device__ __forceinline__ void p4_router(const Args& a, LAS unsigned char* lds, int tid, int lane, int wave, int wg, int G) {
    unsigned char* ws = a.ws;
    const float* norm2_w = a.in[16]; const float* w_group = a.in[17]; const float* b_group = a.in[18]; const float* w_expert = a.in[19]; const float* b_expert = a.in[20];
    const float* X1 = a.out; bf16* H2 = (bf16*)(ws + WS_H2);
    int* ASGE = (int*)(ws + WS_ASGE); float* ASGW = (float*)(ws + WS_ASGW); int* CNT = (int*)(ws + WS_CTL) + CW_CNT;
    LAS float* wl = (LAS float*)lds;
    LAS int* hist = (LAS int*)(lds + LDSCTL_OFF + 128);
    for (int idx = tid; idx < 4096; idx += NTHR) { const int k = idx >> 2, c = idx & 3; wl[c * 1024 + k] = w_group[idx]; }
    for (int idx = tid; idx < 32768; idx += NTHR) { const int k = idx >> 5, c = idx & 31; wl[(4 + c) * 1024 + k] = w_expert[idx]; }
    if (tid < 32) hist[tid] = 0;
    __syncthreads();
    f32x4 w2v[4];
#pragma unroll
    for (int j = 0; j < 4; ++j) w2v[j] = ((const f32x4*)norm2_w)[lane + 64 * j];
    const int tpw = T_ / (G * NWAVES);
#pragma unroll 1
    for (int rr = 0; rr < tpw; ++rr) {
        const int t = (wg * NWAVES + wave) * tpw + rr;
        const f32x4* xr = (const f32x4*)(X1 + (size_t)t * DM) + lane;
        f32x4 hv[4]; float ss = 0.f;
#pragma unroll
        for (int j = 0; j < 4; ++j) { hv[j] = xr[64 * j]; ss += (hv[j].x * hv[j].x + hv[j].y * hv[j].y) + (hv[j].z * hv[j].z + hv[j].w * hv[j].w); }
        const float r2 = rsqrtf(wave_sum(ss) * (1.f / DM) + EPS);
        u32x2* o8 = (u32x2*)(H2 + (size_t)t * DM) + lane;
#pragma unroll
        for (int j = 0; j < 4; ++j) { hv[j] = hv[j] * r2 * w2v[j]; u32x2 o; o.x = pk2(hv[j].x, hv[j].y); o.y = pk2(hv[j].z, hv[j].w); o8[64 * j] = o; }
        float lg[36];
#pragma unroll
        for (int c = 0; c < 36; ++c) { float acc = 0.f;
#pragma unroll
            for (int j = 0; j < 4; ++j) { const f32x4 wv = *(const LAS f32x4*)(wl + c * 1024 + 256 * j + 4 * lane); acc += (hv[j].x * wv.x + hv[j].y * wv.y) + (hv[j].z * wv.z + hv[j].w * wv.w); }
            lg[c] = wave_sum(acc); }
        float gl[4];
#pragma unroll
        for (int g = 0; g < 4; ++g) gl[g] = lg[g] + b_group[g];
        int gsel = 0; float gmax = gl[0];
#pragma unroll
        for (int g = 1; g < 4; ++g) if (gl[g] > gmax) { gmax = gl[g]; gsel = g; }
        float gsum = 0.f;
#pragma unroll
        for (int g = 0; g < 4; ++g) gsum += __expf(gl[g] - gmax);
        const float gwt = 1.f / gsum;
        float el[8];
#pragma unroll
        for (int i = 0; i < 8; ++i) el[i] = 0.f;
#pragma unroll
        for (int g = 0; g < 4; ++g) if (gsel == g) {
#pragma unroll
            for (int i = 0; i < 8; ++i) el[i] = lg[4 + 8 * g + i] + b_expert[8 * g + i]; }
        int i1 = 0; float v1 = el[0];
#pragma unroll
        for (int i = 1; i < 8; ++i) if (el[i] > v1) { v1 = el[i]; i1 = i; }
        int i2 = -1; float v2 = -3.0e38f;
#pragma unroll
        for (int i = 0; i < 8; ++i) if (i != i1 && el[i] > v2) { v2 = el[i]; i2 = i; }
        const float p1 = 1.f / (1.f + __expf(v2 - v1)), p2 = 1.f - p1;
        if (lane == 0) {
            const int e1 = gsel * 8 + i1, e2 = gsel * 8 + i2;
            const int r1 = atomicAdd((int*)&hist[e1], 1), r2_ = atomicAdd((int*)&hist[e2], 1);
            ASGE[2 * t] = e1 | (r1 << 8); ASGE[2 * t + 1] = e2 | (r2_ << 8);
            ASGW[2 * t] = gwt * p1; ASGW[2 * t + 1] = gwt * p2;
        }
    }
    __syncthreads();
    if (tid < 32) CNT[wg * 32 + tid] = hist[tid];
}


__device__ __forceinline__ void p4_router_mfma(const Args& a, LAS unsigned char* lds, int tid, int lane, int wave, int wg, int G) {
    unsigned char* ws = a.ws;
    const float* norm2_w = a.in[16]; const float* w_group = a.in[17]; const float* b_group = a.in[18]; const float* w_expert = a.in[19]; const float* b_expert = a.in[20];
    const float* X1 = a.in[0]; const bf16* MO = (const bf16*)(ws + WS_MO); bf16* X1B = (bf16*)(ws + WS_H2);
    int* ASGE = (int*)(ws + WS_ASGE); float* ASGW = (float*)(ws + WS_ASGW); int* CNT = (int*)(ws + WS_CTL) + CW_CNT;
    constexpr int WST = 2064, WLO = 36 * WST;
    LAS int* hist = (LAS int*)(lds + LDSCTL_OFF + 128);
    for (int idx = tid; idx < 36864; idx += NTHR) {
        int k, c; float v;
        if (idx < 4096) { k = idx >> 2; c = idx & 3; v = w_group[idx]; } else { const int j = idx - 4096; k = j >> 5; c = 4 + (j & 31); v = w_expert[j]; }
        v *= norm2_w[k];
        const unsigned hi = f2bf(v), lo = f2bf(v - __uint_as_float(hi << 16));
        *(LAS bf16*)(lds + c * WST + k * 2) = (bf16)hi; *(LAS bf16*)(lds + WLO + c * WST + k * 2) = (bf16)lo;
    }
    if (tid < 32) hist[tid] = 0;
    __syncthreads();
    const int fr = lane & 15, fq = lane >> 4;
    const int t0 = (wg * NWAVES + wave) * 32;
    const float* xa = X1 + (size_t)(t0 + fr) * DM + 8 * fq; const float* xb = xa + (size_t)16 * DM;
    const bf16* moa = MO + (size_t)(t0 + fr) * DM + 8 * fq; const bf16* mob = moa + (size_t)16 * DM;
    bf16* x1a = X1B + (size_t)(t0 + fr) * DM + 8 * fq; bf16* x1b = x1a + (size_t)16 * DM;
    f32x4 acc[2][3];
#pragma unroll
    for (int tl = 0; tl < 2; ++tl)
#pragma unroll
        for (int nt = 0; nt < 3; ++nt) acc[tl][nt] = (f32x4){0.f, 0.f, 0.f, 0.f};
    float ss0 = 0.f, ss1 = 0.f;
    int wrow[3];
#pragma unroll
    for (int nt = 0; nt < 3; ++nt) { const int c = 16 * nt + fr; wrow[nt] = (c < 36 ? c : 35) * WST + 16 * fq; }
#pragma unroll 1
    for (int kg = 0; kg < 8; ++kg) {
        f32x4 xa_[4][2], xb_[4][2]; u32x4 ma_[4], mb_[4];
#pragma unroll
        for (int q = 0; q < 4; ++q) { const int ks = 4 * kg + q;
            xa_[q][0] = *(const f32x4*)(xa + 32 * ks); xa_[q][1] = *(const f32x4*)(xa + 32 * ks + 4); xb_[q][0] = *(const f32x4*)(xb + 32 * ks); xb_[q][1] = *(const f32x4*)(xb + 32 * ks + 4);
            ma_[q] = *(const u32x4*)(moa + 32 * ks); mb_[q] = *(const u32x4*)(mob + 32 * ks); }
#pragma unroll
        for (int q = 0; q < 4; ++q) { const int ks = 4 * kg + q;
            f32x4 a0 = xa_[q][0], a1 = xa_[q][1], b0 = xb_[q][0], b1 = xb_[q][1]; const u32x4 ma = ma_[q], mb = mb_[q];
            a0.x += bflo(ma.x); a0.y += bfhi(ma.x); a0.z += bflo(ma.y); a0.w += bfhi(ma.y); a1.x += bflo(ma.z); a1.y += bfhi(ma.z); a1.z += bflo(ma.w); a1.w += bfhi(ma.w);
            b0.x += bflo(mb.x); b0.y += bfhi(mb.x); b0.z += bflo(mb.y); b0.w += bfhi(mb.y); b1.x += bflo(mb.z); b1.y += bfhi(mb.z); b1.z += bflo(mb.w); b1.w += bfhi(mb.w);
            ss0 += (a0.x * a0.x + a0.y * a0.y) + (a0.z * a0.z + a0.w * a0.w) + (a1.x * a1.x + a1.y * a1.y) + (a1.z * a1.z + a1.w * a1.w);
            ss1 += (b0.x * b0.x + b0.y * b0.y) + (b0.z * b0.z + b0.w * b0.w) + (b1.x * b1.x + b1.y * b1.y) + (b1.z * b1.z + b1.w * b1.w);
            bf16x8 ah[2], al[2];
#define P4_SPLIT(v0, v1, H, L) do { u32x4 h_, l_; \
                h_.x = pg8::cvt_pk_bf16(v0.x, v0.y); h_.y = pg8::cvt_pk_bf16(v0.z, v0.w); h_.z = pg8::cvt_pk_bf16(v1.x, v1.y); h_.w = pg8::cvt_pk_bf16(v1.z, v1.w); \
                l_.x = pg8::cvt_pk_bf16(v0.x - bflo(h_.x), v0.y - bfhi(h_.x)); l_.y = pg8::cvt_pk_bf16(v0.z - bflo(h_.y), v0.w - bfhi(h_.y)); l_.z = pg8::cvt_pk_bf16(v1.x - bflo(h_.z), v1.y - bfhi(h_.z)); l_.w = pg8::cvt_pk_bf16(v1.z - bflo(h_.w), v1.w - bfhi(h_.w)); \
                H = __builtin_bit_cast(bf16x8, h_); L = __builtin_bit_cast(bf16x8, l_); } while (0)
            P4_SPLIT(a0, a1, ah[0], al[0]); P4_SPLIT(b0, b1, ah[1], al[1]);
#undef P4_SPLIT
            *(bf16x8*)(x1a + 32 * ks) = ah[0]; *(bf16x8*)(x1b + 32 * ks) = ah[1];
#pragma unroll
            for (int nt = 0; nt < 3; ++nt) {
                const bf16x8 wh = *(const LAS bf16x8*)(lds + wrow[nt] + ks * 64), wl = *(const LAS bf16x8*)(lds + WLO + wrow[nt] + ks * 64);
#pragma unroll
                for (int tl = 0; tl < 2; ++tl) {
                    acc[tl][nt] = __builtin_amdgcn_mfma_f32_16x16x32_bf16(wh, ah[tl], acc[tl][nt], 0, 0, 0);
                    acc[tl][nt] = __builtin_amdgcn_mfma_f32_16x16x32_bf16(wh, al[tl], acc[tl][nt], 0, 0, 0);
                    acc[tl][nt] = __builtin_amdgcn_mfma_f32_16x16x32_bf16(wl, ah[tl], acc[tl][nt], 0, 0, 0); }
            }
        }
    }
    float bg[4], be[32];
#pragma unroll
    for (int g = 0; g < 4; ++g) bg[g] = b_group[g];
#pragma unroll
    for (int i = 0; i < 32; ++i) be[i] = b_expert[i];
#pragma unroll
    for (int tl = 0; tl < 2; ++tl) {
        float ss = tl ? ss1 : ss0; ss += __shfl_xor(ss, 16); ss += __shfl_xor(ss, 32);
        const float r2 = rsqrtf(ss * (1.f / DM) + EPS);
        float lg[36];
#pragma unroll
        for (int nt = 0; nt < 3; ++nt)
#pragma unroll
            for (int q = 0; q < 4; ++q)
#pragma unroll
                for (int j = 0; j < 4; ++j) { const int c = 16 * nt + 4 * q + j; if (c < 36) lg[c] = __shfl(acc[tl][nt][j], fr + 16 * q) * r2; }
        float gl[4];
#pragma unroll
        for (int g = 0; g < 4; ++g) gl[g] = lg[g] + bg[g];
        int gsel = 0; float gmax = gl[0];
#pragma unroll
        for (int g = 1; g < 4; ++g) if (gl[g] > gmax) { gmax = gl[g]; gsel = g; }
        float gsum = 0.f;
#pragma unroll
        for (int g = 0; g < 4; ++g) gsum += __expf(gl[g] - gmax);
        const float gwt = 1.f / gsum;
        float el[8];
#pragma unroll
        for (int i = 0; i < 8; ++i) el[i] = 0.f;
#pragma unroll
        for (int g = 0; g < 4; ++g) if (gsel == g) {
#pragma unroll
            for (int i = 0; i < 8; ++i) el[i] = lg[4 + 8 * g + i] + be[8 * g + i]; }
        int i1 = 0; float v1 = el[0];
#pragma unroll
        for (int i = 1; i < 8; ++i) if (el[i] > v1) { v1 = el[i]; i1 = i; }
        int i2 = -1; float v2 = -3.0e38f;
#pragma unroll
        for (int i = 0; i < 8; ++i) if (i != i1 && el[i] > v2) { v2 = el[i]; i2 = i; }
        const float p1 = 1.f / (1.f + __expf(v2 - v1)), p2 = 1.f - p1;
        if (fq == 0) {
            const int t = t0 + 16 * tl + fr;
            const int e1 = gsel * 8 + i1, e2 = gsel * 8 + i2;
            const int r1 = atomicAdd((int*)&hist[e1], 1), r2_ = atomicAdd((int*)&hist[e2], 1);
            ASGE[2 * t] = e1 | (r1 << 8); ASGE[2 * t + 1] = e2 | (r2_ << 8);
            ASGW[2 * t] = gwt * p1; ASGW[2 * t + 1] = gwt * p2;
            ASGW[2 * T_ + 2 * t] = r2; ASGW[2 * T_ + 2 * t + 1] = r2;
        }
    }
    __syncthreads();
    if (tid < 32) CNT[wg * 32 + tid] = hist[tid];
}

__device__ __forceinline__ void p5_dispatch(const Args& a, LAS unsigned char* lds, int tid, int wg, int G) {
    unsigned char* ws = a.ws;
    const int* ASGE = (const int*)(ws + WS_ASGE); const float* ASGW = (const float*)(ws + WS_ASGW); const int* CNT = (const int*)(ws + WS_CTL) + CW_CNT;
    int* META = (int*)(ws + WS_CTL) + CW_META; int* ROWTOK = (int*)(ws + WS_ROWTOK); float* ROWW = (float*)(ws + WS_ROWW); float* ROWR = (float*)(ws + WS_GATES); int* POSA = (int*)(ws + WS_POSA);
    LAS int* tot = (LAS int*)lds; LAS int* pre = tot + 32; LAS int* pst = pre + 32;
    {
        LAS int* part = pst + 64;
        const int e = tid & 31, j = tid >> 5; int total = 0, prefix = 0;
#pragma unroll
        for (int q = 0; q < 16; ++q) { const int w = 16 * j + q; const int c = (w < G) ? CNT[w * 32 + e] : 0; total += c; prefix += (w < wg) ? c : 0; }
        part[j * 32 + e] = total; part[512 + j * 32 + e] = prefix;
        __syncthreads();
        if (tid < 32) { int t2 = 0, p2 = 0;
#pragma unroll
            for (int q = 0; q < 16; ++q) { t2 += part[q * 32 + tid]; p2 += part[512 + q * 32 + tid]; }
            tot[tid] = t2; pre[tid] = p2; }
    }
    __syncthreads();
    if (tid == 0) { int s = 0; for (int e = 0; e < 32; ++e) { pst[e] = s; s += (tot[e] + 255) & ~255; } pst[32] = s; }
    __syncthreads();
    if (wg == 0 && tid <= 32) META[tid] = pst[tid];
    const int apw = 2 * T_ / G;
    for (int q = tid; q < apw; q += NTHR) { const int idx = wg * apw + q; const int ev = ASGE[idx], e = ev & 255, rank = ev >> 8; const int pos = pst[e] + pre[e] + rank; ROWTOK[pos] = idx; ROWW[pos] = ASGW[idx]; ROWR[pos] = ASGW[2 * T_ + idx]; POSA[idx] = pos; }
    if (wg < 32) { const int e = wg; for (int p = pst[e] + tot[e] + tid; p < pst[e + 1]; p += NTHR) { ROWTOK[p] = -1; ROWW[p] = 0.f; ROWR[p] = 0.f; } }
}

__device__ __forceinline__ int expert_of_row(const LAS int* pst, int row) { int e = 0;
#pragma unroll 1
    for (int i = 1; i < 32; ++i) e += (pst[i] <= row) ? 1 : 0;
    return e; }

__device__ __forceinline__ void unpack8(const u32x4 v, float (&f)[8]) { f[0] = bflo(v.x); f[1] = bfhi(v.x); f[2] = bflo(v.y); f[3] = bfhi(v.y); f[4] = bflo(v.z); f[5] = bfhi(v.z); f[6] = bflo(v.w); f[7] = bfhi(v.w); }
__device__ __forceinline__ void p6_naive(const Args& a, LAS unsigned char* lds, int tid, int wg, int G) {
    unsigned char* ws = a.ws;
    const int* META = (const int*)(ws + WS_CTL) + CW_META; const int* ROWTOK = (const int*)(ws + WS_ROWTOK);
    const bf16* H2 = (const bf16*)(ws + WS_H2); const bf16* WGU = (const bf16*)(ws + WS_WGU); bf16* HID = (bf16*)(ws + WS_HID);
    LAS int* pst = (LAS int*)lds;
    if (tid <= 32) pst[tid] = META[tid];
    __syncthreads();
    const int npad = pst[32], ntile = (npad / 64) * 8, rg = tid >> 5, cg = tid & 31;
    for (int tile = wg; tile < ntile; tile += G) {
        const int rt = tile >> 3, ct = tile & 7, e = expert_of_row(pst, rt * 64);
        const bf16* ar[4];
#pragma unroll
        for (int i = 0; i < 4; ++i) { const int tk = ROWTOK[rt * 64 + rg * 4 + i]; ar[i] = H2 + (size_t)(tk < 0 ? 0 : (tk >> 1)) * DM; }
        const int c0 = ct * 64 + cg * 2;
        const bf16* bg[2]; const bf16* bu[2];
#pragma unroll
        for (int j = 0; j < 2; ++j) { const int c = c0 + j; bg[j] = WGU + ((size_t)e * 1024 + (c >> 7) * 256 + (c & 127)) * 1024; bu[j] = bg[j] + 128 * 1024; }
        float g[4][2], u[4][2];
#pragma unroll
        for (int i = 0; i < 4; ++i)
#pragma unroll
            for (int j = 0; j < 2; ++j) { g[i][j] = 0.f; u[i][j] = 0.f; }
#pragma unroll 1
        for (int k = 0; k < 1024; k += 8) {
            float af[4][8], gf[2][8], uf[2][8];
#pragma unroll
            for (int i = 0; i < 4; ++i) unpack8(*(const u32x4*)(ar[i] + k), af[i]);
#pragma unroll
            for (int j = 0; j < 2; ++j) { unpack8(*(const u32x4*)(bg[j] + k), gf[j]); unpack8(*(const u32x4*)(bu[j] + k), uf[j]); }
#pragma unroll
            for (int i = 0; i < 4; ++i)
#pragma unroll
                for (int j = 0; j < 2; ++j)
#pragma unroll
                    for (int q = 0; q < 8; ++q) { g[i][j] += af[i][q] * gf[j][q]; u[i][j] += af[i][q] * uf[j][q]; }
        }
#pragma unroll
        for (int i = 0; i < 4; ++i) *(unsigned*)(HID + (size_t)(rt * 64 + rg * 4 + i) * DEXP + c0) = pk2(siluf_(g[i][0]) * u[i][0], siluf_(g[i][1]) * u[i][1]);
    }
}

__device__ __forceinline__ void p7_naive(const Args& a, LAS unsigned char* lds, int tid, int wg, int G) {
    unsigned char* ws = a.ws;
    const int* META = (const int*)(ws + WS_CTL) + CW_META; const int* ROWTOK = (const int*)(ws + WS_ROWTOK); const float* ROWW = (const float*)(ws + WS_ROWW);
    const bf16* HID = (const bf16*)(ws + WS_HID); const bf16* WD = (const bf16*)(ws + WS_WD); bf16* YBUF = (bf16*)(ws + WS_YBUF);
    LAS int* pst = (LAS int*)lds;
    if (tid <= 32) pst[tid] = META[tid];
    __syncthreads();
    const int npad = pst[32], ntile = (npad / 64) * 8, rg = tid >> 5, cg = tid & 31;
    for (int tile = wg; tile < ntile; tile += G) {
        const int rt = tile >> 3, ct = tile & 7, e = expert_of_row(pst, rt * 64);
        const bf16* ar[4]; const bf16* br[4];
#pragma unroll
        for (int i = 0; i < 4; ++i) ar[i] = HID + (size_t)(rt * 64 + rg * 4 + i) * DEXP;
        const int c0 = ct * 128 + cg * 4;
#pragma unroll
        for (int j = 0; j < 4; ++j) br[j] = WD + ((size_t)e * 1024 + c0 + j) * DEXP;
        float acc[4][4];
#pragma unroll
        for (int i = 0; i < 4; ++i)
#pragma unroll
            for (int j = 0; j < 4; ++j) acc[i][j] = 0.f;
#pragma unroll 1
        for (int k = 0; k < DEXP; k += 8) {
            float af[4][8], bfv[4][8];
#pragma unroll
            for (int i = 0; i < 4; ++i) { unpack8(*(const u32x4*)(ar[i] + k), af[i]); unpack8(*(const u32x4*)(br[i] + k), bfv[i]); }
#pragma unroll
            for (int i = 0; i < 4; ++i)
#pragma unroll
                for (int j = 0; j < 4; ++j)
#pragma unroll
                    for (int q = 0; q < 8; ++q) acc[i][j] += af[i][q] * bfv[j][q];
        }
#pragma unroll
        for (int i = 0; i < 4; ++i) { const int pos = rt * 64 + rg * 4 + i; const int tk = ROWTOK[pos];
            if (tk >= 0) { const float w = ROWW[pos]; const int t = tk >> 1, kk = tk & 1;
                u32x2 o; o.x = pk2(acc[i][0] * w, acc[i][1] * w); o.y = pk2(acc[i][2] * w, acc[i][3] * w);
                *(u32x2*)(YBUF + ((size_t)kk * T_ + t) * DM + c0) = o; } }
    }
}

__device__ __forceinline__ void p8_combine(const Args& a, int tid, int wg, int G) {
    const bf16* Y = (const bf16*)(a.ws + WS_YBUF); const bf16* X1B = (const bf16*)(a.ws + WS_H2); float* O = a.out;
    const int* POSA = (const int*)(a.ws + WS_POSA); const float* ASGW = (const float*)(a.ws + WS_ASGW);
    const int lane = tid & 63, gw = wg * NWAVES + __builtin_amdgcn_readfirstlane(tid >> 6), NGW = G * NWAVES;
    u32x4 xb[2], y0[2], y1[2]; float w0 = 0.f, w1 = 0.f;
#define P8_LOAD(t_) do { const int t__ = __builtin_amdgcn_readfirstlane(t_); const int p0_ = POSA[2 * t__], p1_ = POSA[2 * t__ + 1]; w0 = ASGW[2 * t__]; w1 = ASGW[2 * t__ + 1]; \
        _Pragma("unroll") for (int q = 0; q < 2; ++q) { xb[q] = *(const u32x4*)(X1B + (size_t)t__ * DM + (lane + 64 * q) * 8); y0[q] = *(const u32x4*)(Y + (size_t)p0_ * DM + (lane + 64 * q) * 8); \
            y1[q] = *(const u32x4*)(Y + (size_t)p1_ * DM + (lane + 64 * q) * 8); } } while (0)
    P8_LOAD(gw);
#pragma unroll 1
    for (int t = gw; t < T_; t += NGW) {
        u32x4 cx[2], c0[2], c1[2]; const float cw0 = w0, cw1 = w1;
#pragma unroll
        for (int q = 0; q < 2; ++q) { cx[q] = xb[q]; c0[q] = y0[q]; c1[q] = y1[q]; }
        if (t + NGW < T_) P8_LOAD(t + NGW);
#pragma unroll
        for (int q = 0; q < 2; ++q) {
            f32x4 a0, a1;
            a0.x = bflo(cx[q].x) + cw0 * bflo(c0[q].x) + cw1 * bflo(c1[q].x); a0.y = bfhi(cx[q].x) + cw0 * bfhi(c0[q].x) + cw1 * bfhi(c1[q].x);
            a0.z = bflo(cx[q].y) + cw0 * bflo(c0[q].y) + cw1 * bflo(c1[q].y); a0.w = bfhi(cx[q].y) + cw0 * bfhi(c0[q].y) + cw1 * bfhi(c1[q].y);
            a1.x = bflo(cx[q].z) + cw0 * bflo(c0[q].z) + cw1 * bflo(c1[q].z); a1.y = bfhi(cx[q].z) + cw0 * bfhi(c0[q].z) + cw1 * bfhi(c1[q].z);
            a1.z = bflo(cx[q].w) + cw0 * bflo(c0[q].w) + cw1 * bflo(c1[q].w); a1.w = bfhi(cx[q].w) + cw0 * bfhi(c0[q].w) + cw1 * bfhi(c1[q].w);
            float* op = O + (size_t)t * DM + (lane + 64 * q) * 8;
            *(f32x4*)op = a0; *(f32x4*)(op + 4) = a1;
        }
    }
#undef P8_LOAD
}

__device__ __forceinline__ void p6_gemm(const Args& a, LAS unsigned char* lds, int tid, int wg, int G) {
    unsigned char* ws = a.ws;
    const int* META = (const int*)(ws + WS_CTL) + CW_META;
    LAS int* pst = (LAS int*)(lds + 131072);
    if (tid <= 32) pst[tid] = META[tid];
    __syncthreads();
    pg8::MoeGuSched S; S.o.init(pst[32] / 256, 4, G, wg); S.A = (const char*)(ws + WS_H2); S.Bt = (const char*)(ws + WS_WGU); S.rowtok = (const int*)(ws + WS_ROWTOK); S.pst = pst; S.K = DM;
    pg8::EpiSwiglu E{(bf16*)(ws + WS_HID), (const float*)(ws + WS_GATES)};
    pg8::gemm_phase<pg8::EpiSwiglu, pg8::MoeGuSched, true>(lds, DM, S, E);
}
__device__ __forceinline__ void p7_gemm(const Args& a, LAS unsigned char* lds, int tid, int wg, int G) {
    unsigned char* ws = a.ws;
    const int* META = (const int*)(ws + WS_CTL) + CW_META;
    LAS int* pst = (LAS int*)(lds + 131072);
    if (tid <= 32) pst[tid] = META[tid];
    __syncthreads();
    pg8::MoeDownSched S; S.o.init(pst[32] / 256, 4, G, wg); S.A = (const char*)(ws + WS_HID); S.Bt = (const char*)(ws + WS_WD); S.pst = pst; S.K = DEXP;
    pg8::EpiBf16 E{(bf16*)(ws + WS_YBUF), DM};
    pg8::gemm_phase<pg8::EpiBf16, pg8::MoeDownSched, true>(lds, DEXP, S, E);
}

__global__ void __launch_bounds__(NTHR, 2) fwd(Args args) {
    extern __shared__ __attribute__((aligned(16))) unsigned char lds_raw[];
    LAS unsigned char* lds = (LAS unsigned char*)lds_raw;
    const int tid0 = threadIdx.x, wg = blockIdx.x, G = gridDim.x;
#define PH_TID() int tid = threadIdx.x; asm volatile("" : "+v"(tid)); const int lane = tid & 63, wave = __builtin_amdgcn_readfirstlane(tid >> 6); (void)lane; (void)wave
    unsigned char* ws = args.ws;
    unsigned* ctl = (unsigned*)(ws + WS_CTL);
    for (int u = tid0; u < 256; u += NTHR) ((LAS unsigned*)(lds + LDSCTL_OFF))[u] = 0u;
    __syncthreads();
    const int lo = args.ph_lo, hi = args.ph_hi;
    XcdBarrier bar = xcd_barrier_post(ctl + CW_BAR, (volatile LAS unsigned*)(lds + LDSCTL_OFF));
#define IN(k) (lo <= (k) && (k) < hi)
#ifndef PROBE_PHASE
#define PROBE_PHASE -1
#endif
#define REPS(k) ((PROBE_PHASE == (k)) ? 2 : 1)
#define REPSEP(k) do { if (rep + 1 < REPS(k)) xcd_barrier(bar); } while (0)
#define SEAM(k) do { if (IN(k) && IN((k) + 1)) xcd_barrier(bar); } while (0)

    if (IN(0)) { for (int rep = 0; rep < REPS(0); ++rep) { PH_TID(); p0_prologue(args, lds, tid, lane, wave, wg, G);  REPSEP(0); } }
    SEAM(0);
    if (IN(1)) { for (int rep = 0; rep < REPS(1); ++rep) {
        pg8::DenseSched S; S.o.init(T_ / 256, NCOL / 256, G, wg); S.A = (const char*)(ws + WS_H1); S.Bt = (const char*)(ws + WS_W1T); S.K = DM;
        pg8::EpiProj E{(bf16*)(ws + WS_PROJ), NCOL, args.in[8], args.in[9]};
        pg8::gemm_phase<pg8::EpiProj, pg8::DenseSched, true>(lds, DM, S, E);
     REPSEP(1); } }
    SEAM(1);
    if (IN(2)) { for (int rep = 0; rep < REPS(2); ++rep) { { PH_TID(); if (wg < NBATCH * 4 || PROBE_PHASE == 23) { ml::mlstm_item(args, lds, wg & 127, tid); } } __syncthreads(); { PH_TID(); p2_fast_attn(args, lds, tid, lane, wave, wg, G, rep); if (PROBE_PHASE == 21) { __syncthreads(); p2_fast_attn(args, lds, tid, lane, wave, wg, G, 1); } }  REPSEP(2); } }
    SEAM(2);
    if (IN(3)) { for (int rep = 0; rep < REPS(3); ++rep) {
        pg8::DenseSched S; S.o.init(T_ / 256, DM / 256, G, wg); S.A = (const char*)(ws + WS_MIX); S.Bt = (const char*)(ws + WS_W2T); S.K = DM;
        pg8::EpiBf16 E{(bf16*)(ws + WS_MO), DM};
        pg8::gemm_phase<pg8::EpiBf16, pg8::DenseSched, true>(lds, DM, S, E);
     REPSEP(3); } }
    SEAM(3);
    if (IN(4)) { for (int rep = 0; rep < REPS(4); ++rep) { PH_TID(); p4_router_mfma(args, lds, tid, lane, wave, wg, G);  REPSEP(4); } }
    SEAM(4);
    if (IN(5)) { for (int rep = 0; rep < REPS(5); ++rep) { PH_TID(); p5_dispatch(args, lds, tid, wg, G);  REPSEP(5); } }
    SEAM(5);
    if (IN(6)) { for (int rep = 0; rep < REPS(6); ++rep) { PH_TID(); p6_gemm(args, lds, tid, wg, G);  REPSEP(6); } }
    SEAM(6);
    if (IN(7)) { for (int rep = 0; rep < REPS(7); ++rep) { PH_TID(); p7_gemm(args, lds, tid, wg, G);  REPSEP(7); } }
    SEAM(7);
    if (IN(8)) { PH_TID(); p8_combine(args, tid, wg, G); }
#undef IN
#undef SEAM
}

#ifndef MK_N_LAUNCHES
#define MK_N_LAUNCHES 1
#endif
extern "C" void kernel_launch(void* const* d_in, const int* in_sizes, int n_in, void* d_out, int out_size, void* d_ws, size_t ws_size, hipStream_t stream) {
    static int grid = 0;
    if (grid == 0) {
        if (n_in != 24 || in_sizes[0] != T_ * DM || out_size != T_ * DM || ws_size < WS_END) { fprintf(stderr, "kernel_launch: unexpected shapes (n_in %d, in0 %d, out %d, ws %zu); nothing launched\n", n_in, n_in > 0 ? in_sizes[0] : -1, out_size, ws_size); grid = -1; return; }
        int dev = 0, cus = 0, per_cu = 0;
        if (hipGetDevice(&dev) != hipSuccess || hipDeviceGetAttribute(&cus, hipDeviceAttributeMultiprocessorCount, dev) != hipSuccess) { grid = -1; return; }
        if (hipFuncSetAttribute((const void*)fwd, hipFuncAttributeMaxDynamicSharedMemorySize, LDS_BYTES) != hipSuccess) { fprintf(stderr, "kernel_launch: hipFuncSetAttribute failed\n"); grid = -1; return; }
        if (hipOccupancyMaxActiveBlocksPerMultiprocessor(&per_cu, (const void*)fwd, NTHR, LDS_BYTES) != hipSuccess || per_cu < 1) fprintf(stderr, "kernel_launch: occupancy query reports %d\n", per_cu);
        (void)hipGetLastError();
        grid = cus;
        if (grid != 256) { fprintf(stderr, "kernel_launch: built for 256 CUs, found %d; nothing launched\n", cus); grid = -1; return; }
    }
    if (grid < 0) return;
    if (hipMemsetAsync((char*)d_ws + WS_CTL, 0, CTL_ZERO_BYTES, stream) != hipSuccess) return;
    Args a{};
    for (int i = 0; i < 24; ++i) a.in[i] = (const float*)d_in[i];
    a.out = (float*)d_out; a.ws = (unsigned char*)d_ws;
    if (MK_N_LAUNCHES == 1) { a.ph_lo = 0; a.ph_hi = 9; hipLaunchKernelGGL(fwd, dim3(grid), dim3(NTHR), LDS_BYTES, stream, a); }
    else { for (int p = 0; p < 9; ++p) { a.ph_lo = p; a.ph_hi = p + 1; hipLaunchKernelGGL(fwd, dim3(grid), dim3(NTHR), LDS_BYTES, stream, a); } }
    const hipError_t le = hipPeekAtLastError();
    if (le != hipSuccess) fprintf(stderr, "kernel_launch: launch failed: %s\n", hipGetErrorName(le));
}
```

```cpp
#include <hip/hip_runtime.h>
#include <cstdio>
#include <cstdint>

#define GAS __attribute__((address_space(1)))
#define LAS __attribute__((address_space(3)))
typedef unsigned short bf16;
typedef unsigned u32x4 __attribute__((ext_vector_type(4)));
typedef unsigned u32x2 __attribute__((ext_vector_type(2)));
typedef float f32x4 __attribute__((ext_vector_type(4)));
typedef float f32x2 __attribute__((ext_vector_type(2)));
typedef short bf16x8 __attribute__((ext_vector_type(8)));

constexpr int T_ = 65536, DM = 1024, SEQ = 2048, NBATCH = 32, NCOL = 3584, INCOLS = 3592;
constexpr int C_MQ = 0, C_MK = 512, C_MV = 1024, C_MO = 1536, C_AQ = 2048, C_AK = 2560, C_AV = 3072;
constexpr int NEXP = 32, DEXP = 512, PMAX = 131072 + NEXP * 256;
constexpr float EPS = 1e-6f;
constexpr float LAMBDA_INIT = 0.2f;
constexpr int NWAVES = 8, NTHR = 512;

constexpr size_t MiB = 1u << 20;
constexpr size_t WS_CTL = 0, CTL_ZERO_BYTES = 64 * 1024;
constexpr size_t WS_W1T = 1 * MiB, WS_W2T = 8 * MiB, WS_WGU = 10 * MiB, WS_WD = 74 * MiB, WS_GATES = 106 * MiB;
constexpr size_t WS_ASGE = 108 * MiB, WS_ASGW = 109 * MiB, WS_ROWTOK = 110 * MiB, WS_ROWW = 111 * MiB;
constexpr size_t WS_H1 = 112 * MiB, WS_MIX = 240 * MiB, WS_PROJ = 368 * MiB, WS_END = 816 * MiB;
constexpr size_t WS_YBUF = 112 * MiB;
constexpr size_t WS_H2 = 384 * MiB, WS_HID = 512 * MiB;
constexpr size_t WS_MO = 112 * MiB;
constexpr size_t WS_X1F = 584 * MiB;
constexpr size_t WS_RIMG = 111 * MiB + 768 * 1024;
constexpr size_t WS_POSA = 108 * MiB + 512 * 1024;
constexpr int CW_BAR = 4096, CW_QUEUE = 8192, CW_CNT = 16384, CW_META = 32768;
constexpr int CW_CUR = 12288;
constexpr size_t WS_LIST = 700 * MiB; constexpr int LCAP = 2 * 65536;

constexpr int LDS_SCRATCH = 155648;
constexpr int LDSCTL_OFF = LDS_SCRATCH;
constexpr int LDS_BYTES = LDS_SCRATCH + 1024;

__device__ __forceinline__ unsigned f2bf(float f) { unsigned u = __builtin_bit_cast(unsigned, f); return (u + 0x7fffu + ((u >> 16) & 1u)) >> 16; }
__device__ __forceinline__ unsigned pk2(float lo, float hi) { return f2bf(lo) | (f2bf(hi) << 16); }
__device__ __forceinline__ float bf2f(bf16 v) { return __uint_as_float(((unsigned)v) << 16); }
__device__ __forceinline__ float bflo(unsigned u) { return __uint_as_float(u << 16); }
__device__ __forceinline__ float bfhi(unsigned u) { return __uint_as_float(u & 0xffff0000u); }
__device__ __forceinline__ float wave_sum(float v) {
#pragma unroll
    for (int o = 1; o < 64; o <<= 1) v += __shfl_xor(v, o);
    return v;
}
__device__ __forceinline__ float wave_max(float v) {
#pragma unroll
    for (int o = 1; o < 64; o <<= 1) v = fmaxf(v, __shfl_xor(v, o));
    return v;
}
__device__ __forceinline__ float sigmoidf_(float x) { return 1.f / (1.f + __expf(-x)); }
__device__ __forceinline__ float siluf_(float x) { return x / (1.f + __expf(-x)); }
__device__ __forceinline__ unsigned pk4_fp8(float a, float b, float c, float d) { int w = 0; w = __builtin_amdgcn_cvt_pk_fp8_f32(a, b, w, false); w = __builtin_amdgcn_cvt_pk_fp8_f32(c, d, w, true); return (unsigned)w; }
#define LDS_WAIT() asm volatile("s_waitcnt lgkmcnt(0)" ::: "memory")
#define VM_WAIT() asm volatile("s_waitcnt vmcnt(0)" ::: "memory")

namespace pg8 {
#define PG8_LAS __attribute__((address_space(3)))
constexpr int BM = 256, BK = 64, HALF = 128, HTB = HALF * BK * 2, STAGE_BYTES = 8 * HTB, NXCD = 8, WGM = 8;
__host__ __device__ __forceinline__ int lds_byte(int r, int c) { const int st = (r >> 4) * 2 + (c >> 5), rr = r & 15, cc = c & 31, ob = rr * 64 + cc * 2; return st * 1024 + (ob ^ (((ob >> 9) & 1) << 5)); }
__host__ __device__ __forceinline__ void stage_rc(int b, int& R, int& C) { const int st = b / 1024, sb = b % 1024, swz = sb ^ (((sb >> 9) & 1) << 5); R = (st >> 1) * 16 + swz / 64; C = (st & 1) * 32 + (swz % 64) / 2; }
__host__ __device__ __forceinline__ int perm32(int rho) { const int n = rho >> 4, i = rho & 15; return 8 * (i >> 2) + 4 * n + (i & 3); }

struct Unit { int pm, pn, e, li; };
struct TileOrder {
    int nM, nN, nwg, G, c;
    __device__ __forceinline__ void init(int nM_, int nN_, int G_, int c_) { nM = nM_; nN = nN_; nwg = nM * nN; G = G_; c = c_; }
    __device__ __forceinline__ bool map(int i, int& pm, int& pn) const {
        const long L = (long)i * G + c; if (L >= nwg) return false;
        int wgid = (int)L; { const int q = nwg / NXCD, r = nwg % NXCD, xcd = wgid % NXCD, off = wgid / NXCD; wgid = (xcd < r ? xcd * (q + 1) : r * (q + 1) + (xcd - r) * q) + off; }
        const int nig = WGM * nN, gid = wgid / nig, fm = gid * WGM, gsz = (nM - fm) < WGM ? (nM - fm) : WGM;
        pm = fm + ((wgid % nig) % gsz); pn = (wgid % nig) / gsz; return true;
    }
};
struct DenseSched {
    static constexpr bool GATHER = false;
    TileOrder o; const char* A; const char* Bt; int K;
    __device__ __forceinline__ bool next(int i, Unit& u) const { u.e = 0; u.li = i; return o.map(i, u.pm, u.pn); }
    __device__ __forceinline__ const char* a_base(const Unit& u) const { return A + (size_t)u.pm * BM * K * 2; }
    __device__ __forceinline__ const char* b_base(const Unit& u) const { return Bt + (size_t)u.pn * BM * K * 2; }
    __device__ __forceinline__ void a_voff(const Unit&, const int (&R)[2], const int (&C)[2], unsigned (&v)[2][2]) const {
#pragma unroll
        for (int h = 0; h < 2; ++h)
#pragma unroll
            for (int i = 0; i < 2; ++i) v[h][i] = (unsigned)((h * HALF + R[i]) * K + C[i]) * 2u;
    }
};

__device__ __forceinline__ unsigned cvt_pk_bf16(float lo, float hi) { unsigned r; asm volatile("v_cvt_pk_bf16_f32 %0, %1, %2" : "=v"(r) : "v"(lo), "v"(hi)); return r; }

struct EpiBf16 {
    static constexpr bool PERM = true;
    bf16* O; int ldc;
    __device__ __forceinline__ void operator()(const f32x4 (&acc)[2][2][4][2], const Unit& u, int wr, int wc, int fr, int fq) const {
        const int row0 = u.pm * BM + wr * 64 + fr, col0 = u.pn * BM + wc * 32 + 8 * fq;
#pragma unroll
        for (int ai = 0; ai < 2; ++ai)
#pragma unroll
            for (int m = 0; m < 4; ++m) { bf16* rowp = O + (size_t)(row0 + ai * HALF + m * 16) * ldc + col0;
#pragma unroll
                for (int bj = 0; bj < 2; ++bj) { const f32x4 v0 = acc[ai][bj][m][0], v1 = acc[ai][bj][m][1];
                    u32x4 w; w.x = cvt_pk_bf16(v0[0], v0[1]); w.y = cvt_pk_bf16(v0[2], v0[3]); w.z = cvt_pk_bf16(v1[0], v1[1]); w.w = cvt_pk_bf16(v1[2], v1[3]);
                    *(u32x4*)(rowp + bj * HALF) = w; } }
    }
};
struct EpiF8 {
    static constexpr bool PERM = true;
    unsigned char* O; int ldc;
    __device__ __forceinline__ void operator()(const f32x4 (&acc)[2][2][4][2], const Unit& u, int wr, int wc, int fr, int fq) const {
        const int row0 = u.pm * BM + wr * 64 + fr, col0 = u.pn * BM + wc * 32 + 8 * fq;
#pragma unroll
        for (int ai = 0; ai < 2; ++ai)
#pragma unroll
            for (int m = 0; m < 4; ++m) { unsigned char* rowp = O + (size_t)(row0 + ai * HALF + m * 16) * ldc + col0;
#pragma unroll
                for (int bj = 0; bj < 2; ++bj) { const f32x4 v0 = acc[ai][bj][m][0], v1 = acc[ai][bj][m][1];
                    u32x2 w; w.x = pk4_fp8(v0[0], v0[1], v0[2], v0[3]); w.y = pk4_fp8(v1[0], v1[1], v1[2], v1[3]);
                    *(u32x2*)(rowp + bj * HALF) = w; } }
    }
};
struct EpiProj {
    static constexpr bool PERM = true;
    bf16* O; int ldc; const float* qw; const float* kw;
    __device__ __forceinline__ void operator()(const f32x4 (&acc)[2][2][4][2], const Unit& u, int wr, int wc, int fr, int fq) const {
        const int row0 = u.pm * BM + wr * 64 + fr;
        if (u.pn >= 8 && u.pn < 12) {
            const float* wsrc = (u.pn < 10) ? qw : kw; const float post = (u.pn < 10) ? 0.18033688011112042f : 1.0f;
            f32x4 wv[2][2];
#pragma unroll
            for (int bj = 0; bj < 2; ++bj)
#pragma unroll
                for (int n = 0; n < 2; ++n) wv[bj][n] = *(const f32x4*)(wsrc + 32 * bj + 8 * fq + 4 * n) * post;
            const int col0 = u.pn * BM + wc * 64 + 8 * fq;
#pragma unroll
            for (int ai = 0; ai < 2; ++ai)
#pragma unroll
                for (int m = 0; m < 4; ++m) {
                    float ss = 0.f;
#pragma unroll
                    for (int bj = 0; bj < 2; ++bj)
#pragma unroll
                        for (int n = 0; n < 2; ++n) { const f32x4 x = acc[ai][bj][m][n]; ss += (x[0] * x[0] + x[1] * x[1]) + (x[2] * x[2] + x[3] * x[3]); }
                    ss += __shfl_xor(ss, 16); ss += __shfl_xor(ss, 32);
                    const float r = rsqrtf(ss * (1.f / 64.f) + 1e-6f);
                    bf16* rowp = O + (size_t)(row0 + ai * HALF + m * 16) * ldc + col0;
#pragma unroll
                    for (int bj = 0; bj < 2; ++bj) { const f32x4 v0 = acc[ai][bj][m][0] * r * wv[bj][0], v1 = acc[ai][bj][m][1] * r * wv[bj][1];
                        u32x4 w; w.x = cvt_pk_bf16(v0[0], v0[1]); w.y = cvt_pk_bf16(v0[2], v0[3]); w.z = cvt_pk_bf16(v1[0], v1[1]); w.w = cvt_pk_bf16(v1[2], v1[3]);
                        *(u32x4*)(rowp + bj * 32) = w; } }
        } else {
            const int col0 = u.pn * BM + wc * 32 + 8 * fq; const bool sig = (u.pn == 6 || u.pn == 7);
#pragma unroll
            for (int ai = 0; ai < 2; ++ai)
#pragma unroll
                for (int m = 0; m < 4; ++m) { bf16* rowp = O + (size_t)(row0 + ai * HALF + m * 16) * ldc + col0;
#pragma unroll
                    for (int bj = 0; bj < 2; ++bj) { f32x4 v0 = acc[ai][bj][m][0], v1 = acc[ai][bj][m][1];
                        if (sig) {
#pragma unroll
                            for (int j = 0; j < 4; ++j) { v0[j] = __builtin_amdgcn_rcpf(1.f + __builtin_amdgcn_exp2f(v0[j] * -1.4426950408889634f)); v1[j] = __builtin_amdgcn_rcpf(1.f + __builtin_amdgcn_exp2f(v1[j] * -1.4426950408889634f)); } }
                        u32x4 w; w.x = cvt_pk_bf16(v0[0], v0[1]); w.y = cvt_pk_bf16(v0[2], v0[3]); w.z = cvt_pk_bf16(v1[0], v1[1]); w.w = cvt_pk_bf16(v1[2], v1[3]);
                        *(u32x4*)(rowp + bj * HALF) = w; } }
        }
    }
};
struct EpiResF32 {
    static constexpr bool PERM = true;
    const float* X; float* O; int ldc; bf16* OB;
    __device__ __forceinline__ void operator()(const f32x4 (&acc)[2][2][4][2], const Unit& u, int wr, int wc, int fr, int fq) const {
        const int row0 = u.pm * BM + wr * 64 + fr, col0 = u.pn * BM + wc * 32 + 8 * fq;
#pragma unroll
        for (int ai = 0; ai < 2; ++ai) {
            f32x4 xv[4][2][2];
#pragma unroll
            for (int m = 0; m < 4; ++m) { const size_t off = (size_t)(row0 + ai * HALF + m * 16) * ldc + col0;
#pragma unroll
                for (int bj = 0; bj < 2; ++bj) { xv[m][bj][0] = *(const f32x4*)(X + off + bj * HALF); xv[m][bj][1] = *(const f32x4*)(X + off + bj * HALF + 4); } }
#pragma unroll
            for (int m = 0; m < 4; ++m) { const size_t off = (size_t)(row0 + ai * HALF + m * 16) * ldc + col0;
#pragma unroll
                for (int bj = 0; bj < 2; ++bj) {
                    const f32x4 r0 = xv[m][bj][0] + acc[ai][bj][m][0], r1 = xv[m][bj][1] + acc[ai][bj][m][1];
                    *(f32x4*)(O + off + bj * HALF) = r0; *(f32x4*)(O + off + bj * HALF + 4) = r1;
                    u32x4 w; w.x = cvt_pk_bf16(r0[0], r0[1]); w.y = cvt_pk_bf16(r0[2], r0[3]); w.z = cvt_pk_bf16(r1[0], r1[1]); w.w = cvt_pk_bf16(r1[2], r1[3]);
                    *(u32x4*)(OB + off + bj * HALF) = w; } }
            asm volatile("" ::: "memory");
        }
    }
};

__device__ __forceinline__ int expert_of_row_l(const PG8_LAS int* pst, int row) {
    const int lane = (int)__builtin_amdgcn_mbcnt_hi(~0u, __builtin_amdgcn_mbcnt_lo(~0u, 0u));
    const bool hit = (lane >= 1 && lane < 32) ? (pst[lane & 31] <= row) : false;
    return __builtin_popcountll(__ballot(hit)); }
struct MoeGuSched {
    static constexpr bool GATHER = true;
    TileOrder o; const char* A; const char* Bt; const int* rowtok; const PG8_LAS int* pst; int K; const PG8_LAS int* ltok;
    __device__ __forceinline__ bool next(int i, Unit& u) const { u.li = i; if (!o.map(i, u.pm, u.pn)) return false; u.e = expert_of_row_l(pst, u.pm * BM); return true; }
    __device__ __forceinline__ const char* a_base(const Unit&) const { return A; }
    __device__ __forceinline__ const char* b_base(const Unit& u) const { return Bt + ((size_t)u.e * 1024 + (size_t)u.pn * BM) * K * 2; }
    __device__ __forceinline__ void a_voff(const Unit& u, const int (&R)[2], const int (&C)[2], unsigned (&v)[2][2]) const {
#pragma unroll
        for (int h = 0; h < 2; ++h)
#pragma unroll
            for (int i = 0; i < 2; ++i) { const int tk = ltok[u.li * BM + h * HALF + R[i]]; const unsigned tok = tk < 0 ? 0u : (unsigned)(tk >> 1); v[h][i] = (tok * (unsigned)K + (unsigned)C[i]) * 2u; }
    }
};
struct MoeDownSched {
    static constexpr bool GATHER = false;
    TileOrder o; const char* A; const char* Bt; const PG8_LAS int* pst; int K;
    __device__ __forceinline__ bool next(int i, Unit& u) const { u.li = i; if (!o.map(i, u.pm, u.pn)) return false; u.e = expert_of_row_l(pst, u.pm * BM); return true; }
    __device__ __forceinline__ const char* a_base(const Unit& u) const { return A + (size_t)u.pm * BM * K * 2; }
    __device__ __forceinline__ const char* b_base(const Unit& u) const { return Bt + ((size_t)u.e * 1024 + (size_t)u.pn * BM) * K * 2; }
    __device__ __forceinline__ void a_voff(const Unit&, const int (&R)[2], const int (&C)[2], unsigned (&v)[2][2]) const {
#pragma unroll
        for (int h = 0; h < 2; ++h)
#pragma unroll
            for (int i = 0; i < 2; ++i) v[h][i] = (unsigned)((h * HALF + R[i]) * K + C[i]) * 2u;
    }
};
struct EpiSwiglu {
    static constexpr bool PERM = true;
    bf16* O; const PG8_LAS float* rowr;
    __device__ __forceinline__ void operator()(const f32x4 (&acc)[2][2][4][2], const Unit& u, int wr, int wc, int fr, int fq) const {
        const int row0 = u.pm * BM + wr * 64 + fr, col0 = u.pn * HALF + wc * 32 + 8 * fq;
#pragma unroll
        for (int ai = 0; ai < 2; ++ai)
#pragma unroll
            for (int m = 0; m < 4; ++m) { unsigned char* rowp = (unsigned char*)O + (size_t)(row0 + ai * HALF + m * 16) * 512 + col0;
                 const float rs = rowr[u.li * BM + wr * 64 + fr + ai * HALF + m * 16];
                float hv[8];
#pragma unroll
                for (int n = 0; n < 2; ++n)
#pragma unroll
                    for (int j = 0; j < 4; ++j) { const float g = acc[ai][0][m][n][j] * rs, up = acc[ai][1][m][n][j] * rs; hv[n * 4 + j] = g * up * __builtin_amdgcn_rcpf(1.f + __expf(-g)); }
                u32x2 w; w.x = pk4_fp8(hv[0], hv[1], hv[2], hv[3]); w.y = pk4_fp8(hv[4], hv[5], hv[6], hv[7]);
                *(u32x2*)rowp = w; }
    }
};
struct EpiDown {
    static constexpr bool PERM = true;
    bf16* Y; const int* rowtok; const float* roww;
    __device__ __forceinline__ void operator()(const f32x4 (&acc)[2][2][4][2], const Unit& u, int wr, int wc, int fr, int fq) const {
        const int row0 = u.pm * BM + wr * 64 + fr, col0 = u.pn * BM + wc * 32 + 8 * fq;
#pragma unroll
        for (int ai = 0; ai < 2; ++ai)
#pragma unroll
            for (int m = 0; m < 4; ++m) { const int pos = row0 + ai * HALF + m * 16; const int tk = rowtok[pos]; const float w = roww[pos];
                if (tk >= 0) { bf16* rowp = Y + ((size_t)(tk & 1) * 65536 + (size_t)(tk >> 1)) * 1024 + col0;
#pragma unroll
                    for (int bj = 0; bj < 2; ++bj) { const f32x4 v0 = acc[ai][bj][m][0] * w, v1 = acc[ai][bj][m][1] * w;
                        u32x4 o; o.x = cvt_pk_bf16(v0[0], v0[1]); o.y = cvt_pk_bf16(v0[2], v0[3]); o.z = cvt_pk_bf16(v1[0], v1[1]); o.w = cvt_pk_bf16(v1[2], v1[3]);
                        *(u32x4*)(rowp + bj * HALF) = o; } } }
    }
};

typedef int i32x4v __attribute__((ext_vector_type(4)));
typedef int i32x8v __attribute__((ext_vector_type(8)));
template <class Epi, class Sched, bool ALIGN_EPI = true, bool F8 = false>
__device__ __forceinline__ void gemm_phase(PG8_LAS unsigned char* lds, const int K, const Sched& S, const Epi& E) {
    int tid = threadIdx.x; asm volatile("" : "+v"(tid));
    const int wid = __builtin_amdgcn_readfirstlane(tid >> 6), lane = tid & 63, wr = wid >> 2, wc = wid & 3, fr = lane & 15, fq = lane >> 4;
    const int nt = K / BK;
    int Rr[2], Cc[2]; unsigned voffB[2];
#pragma unroll
    for (int i = 0; i < 2; ++i) { int R, C; stage_rc(tid * 16 + i * 8192, R, C); const int Rb = Epi::PERM ? ((R & ~31) + perm32(R & 31)) : R;
        Rr[i] = R; Cc[i] = C; voffB[i] = (unsigned)(Rb * K + C) * 2u; }
    const size_t kstep = (size_t)(BK * 2);
    const size_t hstep = (size_t)HALF * K * 2;
    const unsigned ldsw = (unsigned)wid * 1024u;
    const int aoff = lds_byte(wr * 64 + fr, fq * 8), boff = lds_byte(wc * 32 + fr, fq * 8);
#define PG8_SA(b, h) (((b) * 2 + (h)) * HTB)
#define PG8_SB(b, h) ((4 + (b) * 2 + (h)) * HTB)
#define PG8_STAGE(bufoff, gbase, voff) do { _Pragma("unroll") for (int _i = 0; _i < 2; ++_i) \
        __builtin_amdgcn_global_load_lds((const unsigned*)((const char*)(gbase) + (voff)[_i]), (PG8_LAS unsigned*)(lds + (bufoff) + ldsw + _i * 8192), 16, 0, 0); } while (0)
#define PG8_CAT(x0, x1) __builtin_shufflevector(__builtin_bit_cast(i32x4v, x0), __builtin_bit_cast(i32x4v, x1), 0, 1, 2, 3, 4, 5, 6, 7)
#define PG8_LDA(dst, b, h) do { if constexpr (F8) { _Pragma("unroll") for (int m = 0; m < 4; ++m) dst##8[m] = PG8_CAT(*(const PG8_LAS bf16x8*)(lds + PG8_SA(b, h) + aoff + m * 2048), *(const PG8_LAS bf16x8*)(lds + PG8_SA(b, h) + aoff + m * 2048 + 1024)); } \
        else { _Pragma("unroll") for (int m = 0; m < 4; ++m) _Pragma("unroll") for (int k = 0; k < 2; ++k) dst[m][k] = *(const PG8_LAS bf16x8*)(lds + PG8_SA(b, h) + aoff + m * 2048 + k * 1024); } } while (0)
#define PG8_LDB(dst, b, h) do { if constexpr (F8) { _Pragma("unroll") for (int n = 0; n < 2; ++n) dst##8[n] = PG8_CAT(*(const PG8_LAS bf16x8*)(lds + PG8_SB(b, h) + boff + n * 2048), *(const PG8_LAS bf16x8*)(lds + PG8_SB(b, h) + boff + n * 2048 + 1024)); } \
        else { _Pragma("unroll") for (int n = 0; n < 2; ++n) _Pragma("unroll") for (int k = 0; k < 2; ++k) dst[n][k] = *(const PG8_LAS bf16x8*)(lds + PG8_SB(b, h) + boff + n * 2048 + k * 1024); } } while (0)
#define PG8_MMA(ai, bj, At, Bt) do { __builtin_amdgcn_s_setprio(1); \
        if constexpr (F8) { __builtin_amdgcn_sched_barrier(0); _Pragma("unroll") for (int m = 0; m < 4; ++m) _Pragma("unroll") for (int n = 0; n < 2; ++n) \
            asm volatile("v_mfma_scale_f32_16x16x128_f8f6f4 %0, %1, %2, %0, %3, %3 op_sel_hi:[0,0,0]" : "+v"(acc[ai][bj][m][n]) : "v"(Bt##8[n]), "v"(At##8[m]), "v"(f8scale)); __builtin_amdgcn_sched_barrier(0); } \
        else { _Pragma("unroll") for (int m = 0; m < 4; ++m) _Pragma("unroll") for (int n = 0; n < 2; ++n) _Pragma("unroll") for (int k = 0; k < 2; ++k) \
            acc[ai][bj][m][n] = __builtin_amdgcn_mfma_f32_16x16x32_bf16(Bt[n][k], At[m][k], acc[ai][bj][m][n], 0, 0, 0); } \
        __builtin_amdgcn_s_setprio(0); } while (0)
#define PG8_WAIT_V(n) asm volatile("s_waitcnt vmcnt(" #n ")" ::: "memory")
#define PG8_WAIT_L(n) asm volatile("s_waitcnt lgkmcnt(" #n ")" ::: "memory")
#define PG8_BAR __builtin_amdgcn_s_barrier()
#define PG8_SCHED __builtin_amdgcn_sched_barrier(0)
    Unit cur, nxt; int ui = 0;
    if (!S.next(0, cur)) return;
    f32x4 acc[2][2][4][2];
#pragma unroll
    for (int a = 0; a < 2; ++a)
#pragma unroll
        for (int b = 0; b < 2; ++b)
#pragma unroll
            for (int m = 0; m < 4; ++m)
#pragma unroll
                for (int n = 0; n < 2; ++n) acc[a][b][m][n] = (f32x4){0.f, 0.f, 0.f, 0.f};
    bf16x8 At[4][2], B0[2][2], B1[2][2];
    i32x8v At8[4], B08[2], B18[2]; const int f8scale = 127;
    unsigned cv[2][2], nv[2][2];
    S.a_voff(cur, Rr, Cc, cv);
#pragma unroll
    for (int h = 0; h < 2; ++h)
#pragma unroll
        for (int i = 0; i < 2; ++i) nv[h][i] = cv[h][i];
    const char* cA = S.a_base(cur); const char* cB = S.b_base(cur);
    PG8_STAGE(PG8_SB(0, 0), cB, voffB); PG8_STAGE(PG8_SB(0, 1), cB + hstep, voffB); PG8_STAGE(PG8_SA(0, 0), cA, cv[0]); PG8_STAGE(PG8_SA(0, 1), cA, cv[1]);
    if (wr == 1) PG8_BAR;
    PG8_WAIT_V(2); PG8_BAR;
    PG8_STAGE(PG8_SB(1, 0), cB + kstep, voffB); PG8_STAGE(PG8_SA(1, 0), cA + kstep, cv[0]); PG8_STAGE(PG8_SB(1, 1), cB + hstep + kstep, voffB);
    PG8_WAIT_V(6); PG8_BAR;
    for (;;) {
        const bool has_next = S.next(ui + 1, nxt);
        const char* nA = has_next ? S.a_base(nxt) : cA; const char* nB = has_next ? S.b_base(nxt) : cB;
#pragma unroll 1
        for (int t = 0; t < nt; t += 2) {
            const bool last = (t == nt - 2);
            const char* a1 = cA + (size_t)(t + 1) * kstep;
            const char* a2 = last ? nA : cA + (size_t)(t + 2) * kstep; const char* b2 = last ? nB : cB + (size_t)(t + 2) * kstep;
            const char* a3 = a2 + kstep; const char* b3 = b2 + kstep;
            unsigned v2[2][2];
            if constexpr (Sched::GATHER) {
                if (last && has_next) { S.a_voff(nxt, Rr, Cc, nv); }
#pragma unroll
                for (int h = 0; h < 2; ++h)
#pragma unroll
                    for (int i = 0; i < 2; ++i) v2[h][i] = last ? nv[h][i] : cv[h][i];
            } else {
#pragma unroll
                for (int h = 0; h < 2; ++h)
#pragma unroll
                    for (int i = 0; i < 2; ++i) v2[h][i] = cv[h][i];
            }
            PG8_LDB(B0, 0, 0); PG8_LDB(B1, 0, 1); PG8_SCHED; PG8_LDA(At, 0, 0); PG8_STAGE(PG8_SA(1, 1), a1, cv[1]);
            PG8_WAIT_V(8); PG8_WAIT_L(0); PG8_BAR; PG8_MMA(0, 0, At, B0); PG8_MMA(0, 1, At, B1); PG8_BAR; PG8_SCHED;
            PG8_LDA(At, 0, 1); PG8_STAGE(PG8_SB(0, 0), b2, voffB); PG8_STAGE(PG8_SB(0, 1), b2 + hstep, voffB); PG8_STAGE(PG8_SA(0, 0), a2, v2[0]);
            PG8_WAIT_V(8); PG8_WAIT_L(0); PG8_BAR; PG8_MMA(1, 0, At, B0); PG8_MMA(1, 1, At, B1); PG8_BAR; PG8_SCHED;
            PG8_LDB(B0, 1, 0); PG8_LDB(B1, 1, 1); PG8_SCHED; PG8_LDA(At, 1, 0); PG8_STAGE(PG8_SA(0, 1), a2, v2[1]);
            PG8_WAIT_V(8); PG8_WAIT_L(0); PG8_BAR; PG8_MMA(0, 0, At, B0); PG8_MMA(0, 1, At, B1); PG8_BAR; PG8_SCHED;
            PG8_LDA(At, 1, 1); PG8_STAGE(PG8_SB(1, 0), b3, voffB); PG8_STAGE(PG8_SB(1, 1), b3 + hstep, voffB); PG8_STAGE(PG8_SA(1, 0), a3, v2[0]);
            PG8_WAIT_V(8); PG8_WAIT_L(0); PG8_BAR; PG8_MMA(1, 0, At, B0); PG8_MMA(1, 1, At, B1); PG8_BAR; PG8_SCHED;
        }
        if constexpr (ALIGN_EPI) { if (wr == 0) PG8_BAR; }
        if constexpr (F8) { asm volatile("s_nop 15\n\ts_nop 15" ::: "memory"); }
        E(acc, cur, wr, wc, fr, fq);
        if (!has_next) break;
#pragma unroll
        for (int a = 0; a < 2; ++a)
#pragma unroll
            for (int b = 0; b < 2; ++b)
#pragma unroll
                for (int m = 0; m < 4; ++m)
#pragma unroll
                    for (int n = 0; n < 2; ++n) acc[a][b][m][n] = (f32x4){0.f, 0.f, 0.f, 0.f};
        cur = nxt; cA = nA; cB = nB; ++ui;
#pragma unroll
        for (int h = 0; h < 2; ++h)
#pragma unroll
            for (int i = 0; i < 2; ++i) cv[h][i] = nv[h][i];
        if constexpr (ALIGN_EPI) { if (wr == 1) PG8_BAR; }
    }
    PG8_WAIT_V(0);
    if constexpr (!ALIGN_EPI) { if (wr == 0) PG8_BAR; }
    PG8_BAR;
#undef PG8_SA
#undef PG8_SB
#undef PG8_STAGE
#undef PG8_LDA
#undef PG8_LDB
#undef PG8_MMA
#undef PG8_CAT
#undef PG8_WAIT_V
#undef PG8_WAIT_L
#undef PG8_BAR
#undef PG8_SCHED
}
}

#define XB_TMO      128
#define XB_XCNT(j)  (256  + 64 * (j))
#define XB_XSUB(j)  (1280 + 64 * (j))
#define XB_XGEN(j)  (2304 + 64 * (j))
#define XB_TOP      3328
#define XB_TOPGEN   3392
#define XCD_BAR_WORDS 3456
#define XB_SPIN_CAP (1u << 22)

__device__ __forceinline__ unsigned xb_ld(unsigned* p)              { return __hip_atomic_load(p, __ATOMIC_RELAXED, __HIP_MEMORY_SCOPE_AGENT); }
__device__ __forceinline__ unsigned xb_add(unsigned* p, unsigned v) { return __hip_atomic_fetch_add(p, v, __ATOMIC_RELAXED, __HIP_MEMORY_SCOPE_AGENT); }
__device__ __forceinline__ unsigned xb_xcc_id() { return (unsigned)__builtin_amdgcn_s_getreg((3 << 11) | 20) & 0xFu; }
#define XB_SPIN(cond, bar) do { unsigned _sp = 0; while (cond) { __builtin_amdgcn_s_sleep(1); \
    if ((++_sp & 255u) == 0u) { if (xb_ld(&(bar)[XB_TMO])) break; if (_sp > XB_SPIN_CAP) { atomicAdd(&(bar)[XB_TMO], 1u); break; } } } } while (0)

struct XcdBarrier { unsigned* bar; unsigned x; volatile LAS unsigned* st; };

__device__ __forceinline__ XcdBarrier xcd_barrier_post(unsigned* bar, volatile LAS unsigned* st) {
    XcdBarrier b; b.bar = bar; b.x = xb_xcc_id(); b.st = st;
    if (threadIdx.x == 0) (void)xb_add(&bar[XB_XCNT(b.x)], 1u);
    return b;
}
__device__ __forceinline__ void xcd_barrier_complete(unsigned* bar, unsigned x, unsigned& nloc, unsigned& nx) {
    const unsigned G = gridDim.x * gridDim.y * gridDim.z;
    unsigned sum, cnt, mine, sp = 0u;
    for (;;) {
        sum = 0u; cnt = 0u; mine = 0u;
#pragma unroll
        for (unsigned j = 0; j < 16; ++j) { const unsigned c = xb_ld(&bar[XB_XCNT(j)]); sum += c; cnt += (c > 0u) ? 1u : 0u; mine = (j == x) ? c : mine; }
        if (sum == G) break;
        __builtin_amdgcn_s_sleep(1);
        if ((++sp & 255u) == 0u) { if (xb_ld(&bar[XB_TMO])) break; if (sp > XB_SPIN_CAP) { atomicAdd(&bar[XB_TMO], 1u); break; } }
    }
    nloc = mine > 0u ? mine : 1u; nx = cnt > 0u ? cnt : 1u;
}
__device__ __forceinline__ void xcd_barrier(const XcdBarrier& b) {
    asm volatile("s_waitcnt vmcnt(0)" ::: "memory");
    __syncthreads();
    if (threadIdx.x == 0) {
        unsigned* bar = b.bar;
        __builtin_amdgcn_s_waitcnt(0);
        unsigned nloc = b.st[0], nx = b.st[1];
        if (nloc == 0u) { xcd_barrier_complete(bar, b.x, nloc, nx); b.st[0] = nloc; b.st[1] = nx; }
        const unsigned old = xb_add(&bar[XB_XSUB(b.x)], 1u);
        const unsigned gen = old / nloc;
        if (old + 1u == (gen + 1u) * nloc) {
            __builtin_amdgcn_fence(__ATOMIC_RELEASE, "agent");
            asm volatile("s_waitcnt vmcnt(0)" ::: "memory");
            const unsigned og = xb_add(&bar[XB_TOP], 1u);
            const unsigned tg = og / nx;
            if (og + 1u == (tg + 1u) * nx) xb_add(&bar[XB_TOPGEN], 1u);
            else XB_SPIN(xb_ld(&bar[XB_TOPGEN]) == tg, bar);
            __builtin_amdgcn_fence(__ATOMIC_ACQUIRE, "agent");
            xb_add(&bar[XB_XGEN(b.x)], 1u);
            asm volatile("s_waitcnt vmcnt(0)" ::: "memory");
        } else {
            XB_SPIN(xb_ld(&bar[XB_XGEN(b.x)]) == gen, bar);
            __builtin_amdgcn_fence(__ATOMIC_ACQUIRE, "agent");
            asm volatile("s_waitcnt vmcnt(0)" ::: "memory");
        }
    }
    __syncthreads();
}

struct Args {
    const float* in[24];
    float* out;
    unsigned char* ws;
    int ph_lo, ph_hi;
};

struct TrItem { const float* src; int ldsrc, k0, n0s; bf16* dst; int ldd, drow0; const float* kscale; int f8; };
__device__ __forceinline__ void tr_load(const TrItem& t, f32x4 (&v)[8], int lane) {
#pragma unroll
    for (int i = 0; i < 8; ++i) v[i] = *(const f32x4*)(t.src + (size_t)(t.k0 + (lane >> 3) + 8 * i) * t.ldsrc + t.n0s + 4 * (lane & 7));
}
__device__ __forceinline__ void tr_finish(const TrItem& t, const f32x4 (&v)[8], LAS float* scr, int lane) {
#pragma unroll
    for (int i = 0; i < 8; ++i) { const int kk = (lane >> 3) + 8 * i; f32x4 x = v[i]; if (t.kscale) x = x * t.kscale[t.k0 + kk];
        LAS float* d = scr + kk * 33 + 4 * (lane & 7); d[0] = x.x; d[1] = x.y; d[2] = x.z; d[3] = x.w; }
    LDS_WAIT();
    const int c = lane & 7;
#pragma unroll
    for (int j = 0; j < 4; ++j) { const int n = (lane >> 3) + 8 * j; const LAS float* s = scr + (8 * c) * 33 + n;
        if (t.f8) { u32x2 o; o.x = pk4_fp8(s[0 * 33], s[1 * 33], s[2 * 33], s[3 * 33]); o.y = pk4_fp8(s[4 * 33], s[5 * 33], s[6 * 33], s[7 * 33]);
            *(u32x2*)((unsigned char*)t.dst + (size_t)(t.drow0 + n) * t.ldd + t.k0 + 8 * c) = o; }
        else { u32x4 o; o.x = pk2(s[0 * 33], s[1 * 33]); o.y = pk2(s[2 * 33], s[3 * 33]); o.z = pk2(s[4 * 33], s[5 * 33]); o.w = pk2(s[6 * 33], s[7 * 33]);
            *(u32x4*)(t.dst + (size_t)(t.drow0 + n) * t.ldd + t.k0 + 8 * c) = o; } }
    LDS_WAIT();
}

__device__ __forceinline__ void p0_prologue(const Args& a, LAS unsigned char* lds, int tid, int lane, int wave, int wg, int G) {
    unsigned char* ws = a.ws;
    const float* x = a.in[0]; const float* norm1_w = a.in[1]; const float* w_in = a.in[2]; const float* b_ig = a.in[3]; const float* b_fg = a.in[4];
    const float* w_out = a.in[15]; const float* w_gate = a.in[21]; const float* w_up = a.in[22]; const float* w_down = a.in[23];
    bf16* W1T = (bf16*)(ws + WS_W1T); bf16* W2T = (bf16*)(ws + WS_W2T); bf16* WGU = (bf16*)(ws + WS_WGU); bf16* WD = (bf16*)(ws + WS_WD);
    bf16* H1 = (bf16*)(ws + WS_H1); float* GATES = (float*)(ws + WS_GATES);
    LAS float* scr = (LAS float*)(lds + wave * 8448);
    LAS float* gwl = (LAS float*)(lds + 73728);
    {
        float gv[16];
#pragma unroll
        for (int q = 0; q < 16; ++q) { const int idx = tid + NTHR * q; gv[q] = w_in[(size_t)(idx >> 3) * INCOLS + 2048 + (idx & 7)]; }
#pragma unroll
        for (int q = 0; q < 16; ++q) gwl[tid + NTHR * q] = gv[q];
    }
    {
        const float* norm2_w = a.in[16]; const float* w_group = a.in[17]; const float* w_expert = a.in[19]; unsigned char* RIMG = ws + WS_RIMG;
        const int idx = wg * NTHR + tid;
        if (idx < 36864) { int k, c; float v;
            if (idx < 4096) { k = idx >> 2; c = idx & 3; v = w_group[idx]; } else { const int j = idx - 4096; k = j >> 5; c = 4 + (j & 31); v = w_expert[j]; }
            v *= norm2_w[k];
            const unsigned hi = f2bf(v), lo = f2bf(v - __uint_as_float(hi << 16));
            *(bf16*)(RIMG + c * 2064 + k * 2) = (bf16)hi; *(bf16*)(RIMG + 36 * 2064 + c * 2064 + k * 2) = (bf16)lo; }
    }
    __syncthreads();
    const int gw = wg * NWAVES + wave, NGW = G * NWAVES;
    constexpr int I_1 = 16 * 112, I_2 = 16 * 32, I_GU = NEXP * 16 * 32, NITEMS = I_1 + I_2 + I_GU;
    auto item_desc = [&](int it) -> TrItem {
        int r = it;
        if (r < I_1) { const int kb = r / 112, nb = r % 112, n0 = nb * 32; int sc_ = n0;
            if (n0 >= 2048 && n0 < 3072) { const int p0 = n0 & 255; sc_ = (n0 & ~255) + 64 * ((p0 >> 5) & 3) + 32 * (p0 >> 7); }
            return TrItem{w_in, INCOLS, kb * 64, sc_ < 2048 ? sc_ : sc_ + 8, W1T, 1024, n0, nullptr, 0}; } r -= I_1;
        if (r < I_2) { const int kb = r / 32, nb = r % 32; return TrItem{w_out, 1024, kb * 64, nb * 32, W2T, 1024, nb * 32, nullptr, 0}; } r -= I_2;
        { const int e = r / 512, q = r % 512, kb = q / 32, nb = q % 32, j0 = nb * 32, pn = j0 >> 8, rr = j0 & 255;
            const float* s_ = (rr < 128 ? w_gate : w_up) + (size_t)e * 1024 * 512;
            return TrItem{s_, 512, kb * 64, pn * 128 + (rr & 127), (bf16*)((unsigned char*)WGU + (size_t)e * 1024 * 1024), 1024, j0, a.in[16], 1}; }
    };
    if (gw < NITEMS) {
        TrItem cur = item_desc(gw); f32x4 tv[8]; tr_load(cur, tv, lane);
#pragma unroll 1
        for (int it = gw; it < NITEMS; it += NGW) {
            f32x4 cv_[8];
#pragma unroll
            for (int i = 0; i < 8; ++i) cv_[i] = tv[i];
            const TrItem me = cur;
            if (it + NGW < NITEMS) { cur = item_desc(it + NGW); tr_load(cur, tv, lane); }
            tr_finish(me, cv_, scr, lane);
        }
    }
    f32x4 w1v[4];
#pragma unroll
    for (int j = 0; j < 4; ++j) w1v[j] = ((const f32x4*)norm1_w)[lane + 64 * j];
    f32x4 nx[4], nx2[4];
#pragma unroll
    for (int j = 0; j < 4; ++j) { nx[j] = ((const f32x4*)(x + (size_t)gw * DM))[lane + 64 * j]; nx2[j] = ((const f32x4*)(x + (size_t)(gw + NGW) * DM))[lane + 64 * j]; }
    const int gc = ((lane >> 5) & 1) * 4 + ((lane >> 4) & 1) * 2 + ((lane >> 3) & 1), gh = gc & 3;
    const float gbias = (gc < 4) ? b_ig[gh] : b_fg[gh];
#pragma unroll 1
    for (int m = gw; m < T_; m += NGW) {
        f32x4 v[4]; float ss = 0.f;
#pragma unroll
        for (int j = 0; j < 4; ++j) { v[j] = nx[j]; nx[j] = nx2[j]; ss += (v[j].x * v[j].x + v[j].y * v[j].y) + (v[j].z * v[j].z + v[j].w * v[j].w); }
        if (m + 2 * NGW < T_) {
#pragma unroll
            for (int j = 0; j < 4; ++j) nx2[j] = ((const f32x4*)(x + (size_t)(m + 2 * NGW) * DM))[lane + 64 * j]; }
        const float r = rsqrtf(wave_sum(ss) * (1.f / DM) + EPS);
        float g[8];
#pragma unroll
        for (int c = 0; c < 8; ++c) g[c] = 0.f;
        u32x2* o8 = (u32x2*)(H1 + (size_t)m * DM) + lane;
#pragma unroll
        for (int j = 0; j < 4; ++j) {
            const f32x4 hv = v[j] * r * w1v[j];
            u32x2 o; o.x = pk2(hv.x, hv.y); o.y = pk2(hv.z, hv.w); o8[64 * j] = o;
#pragma unroll
            for (int i = 0; i < 4; ++i) { const int k = 256 * j + 4 * lane + i; const f32x4 ga = *(const LAS f32x4*)(gwl + k * 8), gb = *(const LAS f32x4*)(gwl + k * 8 + 4);
                const float hh = hv[i];
                g[0] += hh * ga.x; g[1] += hh * ga.y; g[2] += hh * ga.z; g[3] += hh * ga.w; g[4] += hh * gb.x; g[5] += hh * gb.y; g[6] += hh * gb.z; g[7] += hh * gb.w; }
        }
        float k4[4], k2[2], k1;
        { const bool up = (lane & 32) != 0;
#pragma unroll
          for (int i = 0; i < 4; ++i) { const float send = up ? g[i] : g[i + 4]; const float recv = __shfl_xor(send, 32); k4[i] = (up ? g[i + 4] : g[i]) + recv; } }
        { const bool up = (lane & 16) != 0;
#pragma unroll
          for (int i = 0; i < 2; ++i) { const float send = up ? k4[i] : k4[i + 2]; const float recv = __shfl_xor(send, 16); k2[i] = (up ? k4[i + 2] : k4[i]) + recv; } }
        { const bool up = (lane & 8) != 0; const float send = up ? k2[0] : k2[1]; const float recv = __shfl_xor(send, 8); k1 = (up ? k2[1] : k2[0]) + recv; }
        k1 += __shfl_xor(k1, 4); k1 += __shfl_xor(k1, 2); k1 += __shfl_xor(k1, 1);
        if ((lane & 7) == 0) {
            float res = k1 + gbias;
            if (gc >= 4) res = fminf(res, 0.f) - log1pf(__expf(-fabsf(res)));
            GATES[(size_t)m * 8 + gc] = res;
        }
    }
}

__device__ __forceinline__ void p1_stagger_work(const Args& a, LAS unsigned char* lds, int lane, int wave, int wg) {
    const int g = wg & 3; if (g == 0) return;
    const float* w_down = a.in[23]; bf16* WD = (bf16*)(a.ws + WS_WD);
    constexpr int NIT = NEXP * 8 * 32;
    const int lo = (g == 1) ? 0 : (g == 2) ? NIT / 6 : NIT / 2, hi = (g == 1) ? NIT / 6 : (g == 2) ? NIT / 2 : NIT;
    LAS float* scr = (LAS float*)(lds + wave * 8448);
    const int gw = (wg >> 2) * NWAVES + wave, NGW = 64 * NWAVES;
    auto desc = [&](int r) -> TrItem { const int e = r / 256, q = r % 256, kb = q / 32, nb = q % 32;
        return TrItem{w_down + (size_t)e * 512 * 1024, 1024, kb * 64, nb * 32, (bf16*)((unsigned char*)WD + (size_t)e * 1024 * 512), 512, nb * 32, nullptr, 1}; };
    if (lo + gw < hi) {
        TrItem cur = desc(lo + gw); f32x4 tv[8]; tr_load(cur, tv, lane);
#pragma unroll 1
        for (int it = lo + gw; it < hi; it += NGW) {
            f32x4 cv_[8];
#pragma unroll
            for (int i = 0; i < 8; ++i) cv_[i] = tv[i];
            const TrItem me = cur;
            if (it + NGW < hi) { cur = desc(it + NGW); tr_load(cur, tv, lane); }
            tr_finish(me, cv_, scr, lane);
        }
    }
}

__device__ __forceinline__ void mlstm_naive(const Args& a, LAS unsigned char* lds, int item, int tid, int lane, int wave) {
    unsigned char* ws = a.ws;
    const bf16* PROJ = (const bf16*)(ws + WS_PROJ); const float* GATES = (const float*)(ws + WS_GATES); bf16* MIX = (bf16*)(ws + WS_MIX);
    const float* conv_w = a.in[5]; const float* conv_b = a.in[6]; const float* m_norm_w = a.in[7];
    LAS float* qs = (LAS float*)lds; LAS float* ks = qs + 8192; LAS float* vs = ks + 8192; LAS float* hb = vs + 8192;
    LAS float* red = hb + 8192; LAS float* dred = red + 1024; LAS float* igs = dred + 16; LAS float* lfs = igs + 64;
    const int b = item >> 2, h = item & 3, e = tid & 127, dq = tid >> 7;
    float Cr[32], nr[32];
#pragma unroll
    for (int j = 0; j < 32; ++j) { Cr[j] = 0.f; nr[j] = 0.f; }
    float m = 0.f;
    const float mw0 = m_norm_w[lane], mw1 = m_norm_w[lane + 64];
    for (int c = 0; c < SEQ / 64; ++c) {
        const int t0 = c * 64;
        for (int idx = tid; idx < 8192; idx += NTHR) {
            const int tt = idx >> 7, d = idx & 127, t = t0 + tt, colq = C_MQ + h * 128 + d, colk = C_MK + h * 128 + d;
            float aq = conv_b[colq], ak = conv_b[colk];
#pragma unroll
            for (int j = 0; j < 4; ++j) { const int ts = t - 3 + j; if (ts >= 0) { const bf16* row = PROJ + (size_t)(b * SEQ + ts) * NCOL; aq += bf2f(row[colq]) * conv_w[j * 1024 + colq]; ak += bf2f(row[colk]) * conv_w[j * 1024 + colk]; } }
            qs[idx] = siluf_(aq); ks[idx] = siluf_(ak) * 0.08838834764831845f;
            vs[idx] = bf2f(PROJ[(size_t)(b * SEQ + t) * NCOL + C_MV + h * 128 + d]);
        }
        if (tid < 64) { igs[tid] = GATES[(size_t)(b * SEQ + t0 + tid) * 8 + h]; lfs[tid] = GATES[(size_t)(b * SEQ + t0 + tid) * 8 + 4 + h]; }
        __syncthreads();
        for (int tt = 0; tt < 64; ++tt) {
            const float lf = lfs[tt], ig = igs[tt];
            const float mnew = fmaxf(lf + m, ig), fd = __expf(lf + m - mnew), iw = __expf(ig - mnew); m = mnew;
            const float ve = vs[tt * 128 + e] * iw;
            float num = 0.f, den = 0.f;
#pragma unroll
            for (int j = 0; j < 32; ++j) { const int d = dq * 32 + j; const float kd = ks[tt * 128 + d], qd = qs[tt * 128 + d];
                Cr[j] = fd * Cr[j] + kd * ve; nr[j] = fd * nr[j] + iw * kd; num += qd * Cr[j]; den += qd * nr[j]; }
            const int p = tt & 1;
            red[(p * 4 + dq) * 128 + e] = num; if (e == 0) dred[p * 4 + dq] = den;
            __syncthreads();
            if (dq == 0) { const float ntot = (red[(p * 4 + 0) * 128 + e] + red[(p * 4 + 1) * 128 + e]) + (red[(p * 4 + 2) * 128 + e] + red[(p * 4 + 3) * 128 + e]);
                const float dtot = (dred[p * 4 + 0] + dred[p * 4 + 1]) + (dred[p * 4 + 2] + dred[p * 4 + 3]);
                hb[tt * 128 + e] = ntot / fmaxf(fabsf(dtot), __expf(-mnew)); }
        }
        __syncthreads();
#pragma unroll 1
        for (int rr = 0; rr < 8; ++rr) {
            const int tt = wave * 8 + rr, t = t0 + tt; const bf16* rowp = PROJ + (size_t)(b * SEQ + t) * NCOL + C_MO + h * 128;
            const float y0 = hb[tt * 128 + lane] * sigmoidf_(bf2f(rowp[lane])), y1 = hb[tt * 128 + lane + 64] * sigmoidf_(bf2f(rowp[lane + 64]));
            const float r = rsqrtf(wave_sum(y0 * y0 + y1 * y1) * (1.f / 128.f) + EPS);
            bf16* orow = MIX + (size_t)(b * SEQ + t) * DM + h * 128;
            orow[lane] = (bf16)f2bf(y0 * r * mw0); orow[lane + 64] = (bf16)f2bf(y1 * r * mw1);
        }
        __syncthreads();
    }
}

__device__ __forceinline__ void attn_naive_row(const Args& a, LAS float* sc, LAS float* qsl, int ridx, int lane, float lam) {
    unsigned char* ws = a.ws;
    const bf16* PROJ = (const bf16*)(ws + WS_PROJ); bf16* MIX = (bf16*)(ws + WS_MIX);
    const float* qnw = a.in[8]; const float* knw = a.in[9]; const float* anw = a.in[14];
    const int h = ridx & 3, bt = ridx >> 2, t = bt & (SEQ - 1), b = bt >> 11;
    {
        const unsigned u = *(const unsigned*)(PROJ + (size_t)bt * NCOL + C_AQ + h * 128 + 2 * lane);
        const float q0 = bflo(u), q1 = bfhi(u); float ss = q0 * q0 + q1 * q1;
#pragma unroll
        for (int o = 1; o < 32; o <<= 1) ss += __shfl_xor(ss, o);
        const float rq = rsqrtf(ss * (1.f / 64.f) + EPS) * 0.125f; const int dd = (2 * lane) & 63;
        qsl[2 * lane] = q0 * rq * qnw[dd] * knw[dd]; qsl[2 * lane + 1] = q1 * rq * qnw[dd + 1] * knw[dd + 1];
    }
    LDS_WAIT();
    const int nk = ((t >> 6) + 1) * 64;
    float m0 = -1e30f, m1 = -1e30f;
    for (int j = lane; j < nk; j += 64) {
        const u32x4* krow = (const u32x4*)(PROJ + (size_t)(b * SEQ + j) * NCOL + C_AK + h * 128);
        float s0 = 0.f, ss0 = 0.f, s1 = 0.f, ss1 = 0.f;
#pragma unroll
        for (int q = 0; q < 8; ++q) { const u32x4 kv = krow[q]; const f32x4 qa = *(const LAS f32x4*)(qsl + q * 8), qb = *(const LAS f32x4*)(qsl + q * 8 + 4);
            const float k0 = bflo(kv.x), k1 = bfhi(kv.x), k2 = bflo(kv.y), k3 = bfhi(kv.y), k4 = bflo(kv.z), k5 = bfhi(kv.z), k6 = bflo(kv.w), k7 = bfhi(kv.w);
            s0 += qa.x * k0 + qa.y * k1 + qa.z * k2 + qa.w * k3 + qb.x * k4 + qb.y * k5 + qb.z * k6 + qb.w * k7;
            ss0 += k0 * k0 + k1 * k1 + k2 * k2 + k3 * k3 + k4 * k4 + k5 * k5 + k6 * k6 + k7 * k7; }
#pragma unroll
        for (int q = 8; q < 16; ++q) { const u32x4 kv = krow[q]; const f32x4 qa = *(const LAS f32x4*)(qsl + q * 8), qb = *(const LAS f32x4*)(qsl + q * 8 + 4);
            const float k0 = bflo(kv.x), k1 = bfhi(kv.x), k2 = bflo(kv.y), k3 = bfhi(kv.y), k4 = bflo(kv.z), k5 = bfhi(kv.z), k6 = bflo(kv.w), k7 = bfhi(kv.w);
            s1 += qa.x * k0 + qa.y * k1 + qa.z * k2 + qa.w * k3 + qb.x * k4 + qb.y * k5 + qb.z * k6 + qb.w * k7;
            ss1 += k0 * k0 + k1 * k1 + k2 * k2 + k3 * k3 + k4 * k4 + k5 * k5 + k6 * k6 + k7 * k7; }
        s0 *= rsqrtf(ss0 * (1.f / 64.f) + EPS); s1 *= rsqrtf(ss1 * (1.f / 64.f) + EPS);
        sc[j] = s0; sc[2048 + j] = s1; m0 = fmaxf(m0, s0); m1 = fmaxf(m1, s1);
    }
    m0 = wave_max(m0); m1 = wave_max(m1);
    float l0 = 0.f, l1 = 0.f;
    for (int j = lane; j < nk; j += 64) { const float e0 = __expf(sc[j] - m0), e1 = __expf(sc[2048 + j] - m1); sc[j] = e0; sc[2048 + j] = e1; l0 += e0; l1 += e1; }
    l0 = wave_sum(l0); l1 = wave_sum(l1);
    const float c0 = 1.f / l0, c1 = lam / l1;
    LDS_WAIT();
    float o0 = 0.f, o1 = 0.f;
    const bf16* vb = PROJ + (size_t)(b * SEQ) * NCOL + C_AV + h * 128 + 2 * lane;
    for (int j = 0; j < nk; ++j) { const float p = sc[j] * c0 - sc[2048 + j] * c1; const unsigned u = *(const unsigned*)(vb + (size_t)j * NCOL); o0 += p * bflo(u); o1 += p * bfhi(u); }
    const float r = rsqrtf(wave_sum(o0 * o0 + o1 * o1) * (1.f / 128.f) + EPS) * (1.f - LAMBDA_INIT);
    *(unsigned*)(MIX + (size_t)bt * DM + 512 + h * 128 + 2 * lane) = pk2(o0 * r * anw[2 * lane], o1 * r * anw[2 * lane + 1]);
    LDS_WAIT();
}

__device__ __forceinline__ void p2_naive(const Args& a, LAS unsigned char* lds, int tid, int lane, int wave, int wg, int G) {
    if (wg < NBATCH * 4) mlstm_naive(a, lds, wg, tid, lane, wave);
    __syncthreads();
    const float* lq1 = a.in[10]; const float* lk1 = a.in[11]; const float* lq2 = a.in[12]; const float* lk2 = a.in[13];
    const float lam = __expf(wave_sum(lq1[lane] * lk1[lane])) - __expf(wave_sum(lq2[lane] * lk2[lane])) + LAMBDA_INIT;
    LAS float* sc = (LAS float*)(lds + wave * 16896); LAS float* qsl = sc + 4096;
    unsigned* queue = (unsigned*)(a.ws + WS_CTL) + CW_QUEUE;
    constexpr int NUNITS = T_ * 4 / 8;
    for (;;) {
        unsigned u = 0; if (lane == 0) u = __hip_atomic_fetch_add(queue, 1u, __ATOMIC_RELAXED, __HIP_MEMORY_SCOPE_AGENT);
        u = (unsigned)__builtin_amdgcn_readfirstlane((int)u);
        if (u >= (unsigned)NUNITS) break;
        const int base = (NUNITS - 1 - (int)u) * 8;
        for (int k = 0; k < 8; ++k) attn_naive_row(a, sc, qsl, base + k, lane, lam);
    }
}


namespace ml {
constexpr int QL = 0, KL = 17408, KWT = 34816, VT = 53248, SD = 71680, AV = 80896, MV = 89088, WV = 97280, IT = 105472, FL = 113664;
constexpr int MC = 121856, BEND = 121984, AMAX = 122112, DEC = 122240, NL = 122368, RS = 122880, QN = 123392, PSQ = 123648;
constexpr int QS = 272, TS = 144;
constexpr float L2E = 1.4426950408889634f;
#define LBAR() do { asm volatile("s_waitcnt lgkmcnt(0)" ::: "memory"); __builtin_amdgcn_s_barrier(); asm volatile("" ::: "memory"); } while (0)
__device__ __forceinline__ f32x4 mfma16(bf16x8 a, bf16x8 b, f32x4 c) { return __builtin_amdgcn_mfma_f32_16x16x32_bf16(a, b, c, 0, 0, 0); }
__device__ __forceinline__ unsigned cvtpk(float lo, float hi) { unsigned r; asm volatile("v_cvt_pk_bf16_f32 %0, %1, %2" : "=v"(r) : "v"(lo), "v"(hi)); return r; }
__device__ __forceinline__ unsigned cvtpk_nv(float lo, float hi) { unsigned r; asm("v_cvt_pk_bf16_f32 %0, %1, %2" : "=v"(r) : "v"(lo), "v"(hi)); return r; }
__device__ __forceinline__ f32x2 silu2(f32x2 o) { f32x2 e = o * (-L2E); e.x = __builtin_amdgcn_exp2f(e.x); e.y = __builtin_amdgcn_exp2f(e.y); e = e + 1.0f; e.x = __builtin_amdgcn_rcpf(e.x); e.y = __builtin_amdgcn_rcpf(e.y); return o * e; }

__device__ __forceinline__ void mlstm_item(const Args& a, LAS unsigned char* lds, const int item, const int tid) {
    unsigned char* ws = a.ws;
    const bf16* PROJ = (const bf16*)(ws + WS_PROJ); const float* GATES = (const float*)(ws + WS_GATES); bf16* MIX = (bf16*)(ws + WS_MIX);
    const float* conv_w = a.in[5]; const float* conv_b = a.in[6]; const float* m_norm_w = a.in[7];
    const int wid = __builtin_amdgcn_readfirstlane(tid >> 6), lane = tid & 63, fr = lane & 15, fq = lane >> 4;
    const int b = item >> 2, h = item & 3, e0 = 16 * wid;
    LAS float* AVl = (LAS float*)(lds + AV); LAS float* MVl = (LAS float*)(lds + MV); LAS float* WVl = (LAS float*)(lds + WV); LAS float* ITl = (LAS float*)(lds + IT); LAS float* FLl = (LAS float*)(lds + FL);
    LAS float* MCl = (LAS float*)(lds + MC); LAS float* BENDl = (LAS float*)(lds + BEND); LAS float* AMAXl = (LAS float*)(lds + AMAX); LAS float* DECl = (LAS float*)(lds + DEC);
    LAS float* NLl = (LAS float*)(lds + NL); LAS float* RSl = (LAS float*)(lds + RS); LAS float* QNl = (LAS float*)(lds + QN); LAS float* PSQl = (LAS float*)(lds + PSQ);
#pragma unroll 1
    for (int cc = 0; cc < 4; ++cc) {
        const int c = 4 * wid + cc, t = 64 * c + lane; const float* g = GATES + (size_t)(b * SEQ + t) * 8;
        float bs = g[4 + h]; const float ig = g[h];
#pragma unroll
        for (int o = 1; o < 64; o <<= 1) { const float v = __shfl_up(bs, o); if (lane >= o) bs += v; }
        const float av = ig - bs; float pm = av;
#pragma unroll
        for (int o = 1; o < 64; o <<= 1) { const float v = __shfl_up(pm, o); if (lane >= o) pm = fmaxf(pm, v); }
        AVl[t] = av; MVl[t] = pm; FLl[t] = bs;
        if (lane == 63) { BENDl[c] = bs; AMAXl[c] = pm; }
    }
    if (tid < 128) NLl[tid] = 0.f;
    __syncthreads();
    if (tid == 0) { float m = 0.f; for (int c = 0; c < 32; ++c) { MCl[c] = m; m = BENDl[c] + fmaxf(m, AMAXl[c]); } }
    __syncthreads();
    {
        float av_[4], pm_[4], bs_[4], m63_[4], mc_[4];
#pragma unroll
        for (int k = 0; k < 4; ++k) { const int t = tid + NTHR * k, c = t >> 6; av_[k] = AVl[t]; pm_[k] = MVl[t]; bs_[k] = FLl[t]; mc_[k] = MCl[c]; m63_[k] = fmaxf(mc_[k], MVl[64 * c + 63]); }
        __syncthreads();
#pragma unroll
        for (int k = 0; k < 4; ++k) { const int t = tid + NTHR * k; const float M = fmaxf(mc_[k], pm_[k]);
            AVl[t] = av_[k] * L2E; MVl[t] = M * L2E; WVl[t] = __expf(av_[k] - m63_[k]); ITl[t] = __expf(mc_[k] - M); FLl[t] = __expf(-(bs_[k] + M)); }
        if (tid < 32) DECl[tid] = __expf(MCl[tid] - fmaxf(MCl[tid], AMAXl[tid]));
    }
    __syncthreads();
    const int isk = wid >> 2, r0 = (wid & 3) * 16;
    const int ccol = (isk ? C_MK : C_MQ) + h * 128 + 2 * lane;
    f32x2 cw2[4], cb2;
#pragma unroll
    for (int j = 0; j < 4; ++j) { cw2[j].x = conv_w[j * 1024 + ccol]; cw2[j].y = conv_w[j * 1024 + ccol + 1]; }
    cb2.x = conv_b[ccol]; cb2.y = conv_b[ccol + 1];
    const bf16* qkbase = PROJ + (size_t)(b * SEQ) * NCOL + ccol;
    const bf16* vbase = PROJ + (size_t)(b * SEQ) * NCOL + C_MV + h * 128 + 2 * lane;
    const bf16* obase = PROJ + (size_t)(b * SEQ) * NCOL + C_MO + h * 128 + e0 + 4 * fq;
    const f32x4 mw = *(const f32x4*)(m_norm_w + e0 + 4 * fq);
    unsigned raw[19], vraw[8];
#define ML_LOADS(c_) do { _Pragma("unroll") for (int i = 0; i < 19; ++i) { const int t = 64 * (c_) + r0 - 3 + i; raw[i] = (t >= 0) ? *(const unsigned*)(qkbase + (size_t)(t < 0 ? 0 : t) * NCOL) : 0u; } \
        _Pragma("unroll") for (int i = 0; i < 8; ++i) vraw[i] = *(const unsigned*)(vbase + (size_t)(64 * (c_) + 8 * wid + i) * NCOL); } while (0)
    ML_LOADS(0);
    f32x4 Cacc[8];
#pragma unroll
    for (int i = 0; i < 8; ++i) Cacc[i] = (f32x4){0.f, 0.f, 0.f, 0.f};
#pragma unroll 1
    for (int c = 0; c < SEQ / 64; ++c) {
        {
            f32x2 xx[19];
#pragma unroll
            for (int i = 0; i < 19; ++i) { xx[i].x = bflo(raw[i]); xx[i].y = bfhi(raw[i]); }
            f32x2 oo[16], ee[16];
#pragma unroll
            for (int i = 0; i < 16; ++i) oo[i] = xx[i] * cw2[0] + cb2;
#pragma unroll
            for (int j = 1; j < 4; ++j)
#pragma unroll
                for (int i = 0; i < 16; ++i) oo[i] = xx[i + j] * cw2[j] + oo[i];
#pragma unroll
            for (int i = 0; i < 16; ++i) ee[i] = oo[i] * (-L2E);
#pragma unroll
            for (int i = 0; i < 16; ++i) { ee[i].x = __builtin_amdgcn_exp2f(ee[i].x); ee[i].y = __builtin_amdgcn_exp2f(ee[i].y); }
#pragma unroll
            for (int i = 0; i < 16; ++i) ee[i] = ee[i] + 1.0f;
#pragma unroll
            for (int i = 0; i < 16; ++i) { ee[i].x = __builtin_amdgcn_rcpf(ee[i].x); ee[i].y = __builtin_amdgcn_rcpf(ee[i].y); }
            if (!isk) {
#pragma unroll
                for (int i = 0; i < 16; ++i) oo[i] = oo[i] * ee[i];
#pragma unroll
                for (int i = 0; i < 16; ++i) *(LAS unsigned*)(lds + QL + (r0 + i) * QS + 4 * lane) = cvtpk_nv(oo[i].x, oo[i].y);
            } else {
                f32x2 kv[16];
#pragma unroll
                for (int i = 0; i < 16; ++i) kv[i] = oo[i] * ee[i] * 0.08838834764831845f;
#pragma unroll
                for (int i = 0; i < 16; ++i) *(LAS unsigned*)(lds + KL + (r0 + i) * QS + 4 * lane) = cvtpk_nv(kv[i].x, kv[i].y);
                u32x4 k0a, k0b, k1a, k1b;
#pragma unroll
                for (int q = 0; q < 4; ++q) { const f32x4 w4 = *(const LAS f32x4*)(WVl + 64 * c + r0 + 4 * q);
                    const f32x2 e0_ = kv[4 * q] * w4.x, e1_ = kv[4 * q + 1] * w4.y, e2_ = kv[4 * q + 2] * w4.z, e3_ = kv[4 * q + 3] * w4.w;
                    const unsigned a0 = cvtpk(e0_.x, e1_.x), a1 = cvtpk(e2_.x, e3_.x), b0 = cvtpk(e0_.y, e1_.y), b1 = cvtpk(e2_.y, e3_.y);
                    if (q == 0) { k0a.x = a0; k0a.y = a1; k1a.x = b0; k1a.y = b1; } else if (q == 1) { k0a.z = a0; k0a.w = a1; k1a.z = b0; k1a.w = b1; }
                    else if (q == 2) { k0b.x = a0; k0b.y = a1; k1b.x = b0; k1b.y = b1; } else { k0b.z = a0; k0b.w = a1; k1b.z = b0; k1b.w = b1; } }
                *(LAS u32x4*)(lds + KWT + (2 * lane) * TS + r0 * 2) = k0a; *(LAS u32x4*)(lds + KWT + (2 * lane) * TS + r0 * 2 + 16) = k0b;
                *(LAS u32x4*)(lds + KWT + (2 * lane + 1) * TS + r0 * 2) = k1a; *(LAS u32x4*)(lds + KWT + (2 * lane + 1) * TS + r0 * 2 + 16) = k1b;
            }
            u32x4 v0, v1;
            v0.x = (vraw[0] & 0xffffu) | (vraw[1] << 16); v0.y = (vraw[2] & 0xffffu) | (vraw[3] << 16); v0.z = (vraw[4] & 0xffffu) | (vraw[5] << 16); v0.w = (vraw[6] & 0xffffu) | (vraw[7] << 16);
            v1.x = (vraw[0] >> 16) | (vraw[1] & 0xffff0000u); v1.y = (vraw[2] >> 16) | (vraw[3] & 0xffff0000u); v1.z = (vraw[4] >> 16) | (vraw[5] & 0xffff0000u); v1.w = (vraw[6] >> 16) | (vraw[7] & 0xffff0000u);
            *(LAS u32x4*)(lds + VT + (2 * lane) * TS + 16 * wid) = v0;
            *(LAS u32x4*)(lds + VT + (2 * lane + 1) * TS + 16 * wid) = v1;
        }
        if (c + 1 < SEQ / 64) ML_LOADS(c + 1);
        u32x2 og[4];
#pragma unroll
        for (int ti = 0; ti < 4; ++ti) og[ti] = *(const u32x2*)(obase + (size_t)(64 * c + 16 * ti + fr) * NCOL);
        LBAR();
        {
            const int ti = wid >> 1, half = wid & 1; float rsum = 0.f;
            const float Mt = MVl[64 * c + 16 * ti + fr];
#pragma unroll
            for (int sx = 0; sx < 2; ++sx) {
                const int si = 2 * half + sx; f32x4 acc = (f32x4){0.f, 0.f, 0.f, 0.f};
                if (si <= ti) {
#pragma unroll
                    for (int kb = 0; kb < 4; ++kb) {
                        const bf16x8 kf = *(const LAS bf16x8*)(lds + KL + (16 * si + fr) * QS + (32 * kb + 8 * fq) * 2);
                        const bf16x8 qf = *(const LAS bf16x8*)(lds + QL + (16 * ti + fr) * QS + (32 * kb + 8 * fq) * 2);
                        acc = mfma16(kf, qf, acc); }
                    const f32x4 av = *(const LAS f32x4*)(AVl + 64 * c + 16 * si + 4 * fq);
#pragma unroll
                    for (int j = 0; j < 4; ++j) { const int s = 16 * si + 4 * fq + j, t = 16 * ti + fr; const float dd = (s <= t) ? __builtin_amdgcn_exp2f(av[j] - Mt) : 0.f; acc[j] *= dd; rsum += acc[j]; }
                }
                u32x2 o; o.x = cvtpk(acc[0], acc[1]); o.y = cvtpk(acc[2], acc[3]);
                *(LAS u32x2*)(lds + SD + (16 * ti + fr) * TS + (16 * si + 4 * fq) * 2) = o;
            }
            rsum += __shfl_xor(rsum, 16); rsum += __shfl_xor(rsum, 32);
            if (fq == 0) RSl[(16 * ti + fr) * 2 + half] = rsum;
        }
        {
            const int t = tid >> 3, part = tid & 7;
            const u32x4 qa = *(const LAS u32x4*)(lds + QL + t * QS + part * 32), qb = *(const LAS u32x4*)(lds + QL + t * QS + part * 32 + 16);
            const f32x4 n0 = *(const LAS f32x4*)(NLl + 16 * part), n1 = *(const LAS f32x4*)(NLl + 16 * part + 4), n2 = *(const LAS f32x4*)(NLl + 16 * part + 8), n3 = *(const LAS f32x4*)(NLl + 16 * part + 12);
            float s = bflo(qa.x) * n0.x + bfhi(qa.x) * n0.y + bflo(qa.y) * n0.z + bfhi(qa.y) * n0.w + bflo(qa.z) * n1.x + bfhi(qa.z) * n1.y + bflo(qa.w) * n1.z + bfhi(qa.w) * n1.w
                    + bflo(qb.x) * n2.x + bfhi(qb.x) * n2.y + bflo(qb.y) * n2.z + bfhi(qb.y) * n2.w + bflo(qb.z) * n3.x + bfhi(qb.z) * n3.y + bflo(qb.w) * n3.z + bfhi(qb.w) * n3.w;
            s += __shfl_xor(s, 1); s += __shfl_xor(s, 2); s += __shfl_xor(s, 4);
            if (part == 0) QNl[t] = s;
        }
        LBAR();
        f32x4 hacc[4]; float inter[4];
        {
            bf16x8 cf[4];
#pragma unroll
            for (int kb = 0; kb < 4; ++kb) { u32x4 w; w.x = cvtpk(Cacc[2 * kb][0], Cacc[2 * kb][1]); w.y = cvtpk(Cacc[2 * kb][2], Cacc[2 * kb][3]); w.z = cvtpk(Cacc[2 * kb + 1][0], Cacc[2 * kb + 1][1]); w.w = cvtpk(Cacc[2 * kb + 1][2], Cacc[2 * kb + 1][3]);
                cf[kb] = __builtin_bit_cast(bf16x8, w); }
#pragma unroll
            for (int ti = 0; ti < 4; ++ti) {
                hacc[ti] = (f32x4){0.f, 0.f, 0.f, 0.f};
#pragma unroll
                for (int kb = 0; kb < 4; ++kb) {
                    const u32x2 lo = *(const LAS u32x2*)(lds + QL + (16 * ti + fr) * QS + (32 * kb + 4 * fq) * 2), hi = *(const LAS u32x2*)(lds + QL + (16 * ti + fr) * QS + (32 * kb + 16 + 4 * fq) * 2);
                    const u32x4 qq = (u32x4){lo.x, lo.y, hi.x, hi.y};
                    hacc[ti] = mfma16(cf[kb], __builtin_bit_cast(bf16x8, qq), hacc[ti]); }
                inter[ti] = ITl[64 * c + 16 * ti + fr];
                hacc[ti] = hacc[ti] * inter[ti];
            }
        }
        {
            bf16x8 vf[2];
#pragma unroll
            for (int ks = 0; ks < 2; ++ks) vf[ks] = *(const LAS bf16x8*)(lds + VT + (e0 + fr) * TS + (32 * ks + 8 * fq) * 2);
#pragma unroll
            for (int ti = 0; ti < 4; ++ti)
#pragma unroll
                for (int ks = 0; ks < 2; ++ks) if (ks == 0 || ti >= 2) {
                    const bf16x8 sf = *(const LAS bf16x8*)(lds + SD + (16 * ti + fr) * TS + (32 * ks + 8 * fq) * 2);
                    hacc[ti] = mfma16(vf[ks], sf, hacc[ti]); }
            const float decay = DECl[c];
            float nsum = 0.f;
#pragma unroll
            for (int i = 0; i < 8; ++i) {
                Cacc[i] = Cacc[i] * decay;
#pragma unroll
                for (int ks = 0; ks < 2; ++ks) {
                    const bf16x8 kwf = *(const LAS bf16x8*)(lds + KWT + (16 * i + fr) * TS + (32 * ks + 8 * fq) * 2);
                    Cacc[i] = mfma16(kwf, vf[ks], Cacc[i]); }
            }
#pragma unroll
            for (int ks = 0; ks < 2; ++ks) {
                const u32x4 kk = *(const LAS u32x4*)(lds + KWT + (16 * wid + fr) * TS + (32 * ks + 8 * fq) * 2);
                nsum += (bflo(kk.x) + bfhi(kk.x)) + (bflo(kk.y) + bfhi(kk.y)) + (bflo(kk.z) + bfhi(kk.z)) + (bflo(kk.w) + bfhi(kk.w)); }
            nsum += __shfl_xor(nsum, 16); nsum += __shfl_xor(nsum, 32);
            if (fq == 0) NLl[16 * wid + fr] = decay * NLl[16 * wid + fr] + nsum;
        }
        f32x4 hm[4];
#pragma unroll
        for (int ti = 0; ti < 4; ++ti) {
            const int t = 16 * ti + fr;
            const float den = RSl[2 * t] + RSl[2 * t + 1] + inter[ti] * QNl[t];
            const float rd = __builtin_amdgcn_rcpf(fmaxf(fabsf(den), FLl[64 * c + t]));
            const f32x4 gg = (f32x4){bflo(og[ti].x), bfhi(og[ti].x), bflo(og[ti].y), bfhi(og[ti].y)};
            hm[ti] = hacc[ti] * gg * rd;
            float psq = (hm[ti][0] * hm[ti][0] + hm[ti][1] * hm[ti][1]) + (hm[ti][2] * hm[ti][2] + hm[ti][3] * hm[ti][3]);
            psq += __shfl_xor(psq, 16); psq += __shfl_xor(psq, 32);
            if (fq == 0) PSQl[t * 8 + wid] = psq;
        }
        LBAR();
#pragma unroll
        for (int ti = 0; ti < 4; ++ti) {
            const int t = 16 * ti + fr;
            const f32x4 p0 = *(const LAS f32x4*)(PSQl + t * 8), p1 = *(const LAS f32x4*)(PSQl + t * 8 + 4);
            const float r = rsqrtf(((p0.x + p0.y) + (p0.z + p0.w) + (p1.x + p1.y) + (p1.z + p1.w)) * (1.f / 128.f) + EPS);
            const f32x4 ov = hm[ti] * mw * r;
            u32x2 o; o.x = cvtpk(ov[0], ov[1]); o.y = cvtpk(ov[2], ov[3]);
            *(u32x2*)(MIX + (size_t)(b * SEQ + 64 * c + t) * DM + h * 128 + e0 + 4 * fq) = o;
        }
    }
#undef ML_LOADS
}
}

namespace att {
using s16x4  = __attribute__((ext_vector_type(4))) short;
using f32x16 = __attribute__((ext_vector_type(16))) float;
constexpr int SHM_V = 16384, SHM_K = 16384;
constexpr float THR2 = 11.5415603f;
#define KSWZ(row, colB) ((row) * 256 + ((colB) ^ (((row) & 7) << 4)))
#define SBAR() __builtin_amdgcn_sched_barrier(0)
__device__ __forceinline__ int crow(int r, int hi) { return (r & 3) + 8 * (r >> 2) + 4 * hi; }
__device__ __forceinline__ unsigned cvtpk(float lo, float hi) { unsigned r; asm volatile("v_cvt_pk_bf16_f32 %0, %1, %2" : "=v"(r) : "v"(lo), "v"(hi)); return r; }
__device__ __forceinline__ void partialSM(f32x16& p0, f32x16& p1, float& m_reg, float& mn, float& alpha) {
  float pmax = p0[0];
#pragma unroll
  for (int r = 1; r < 16; ++r) pmax = fmaxf(pmax, p0[r]);
#pragma unroll
  for (int r = 0; r < 16; ++r) pmax = fmaxf(pmax, p1[r]);
  { auto rr = __builtin_amdgcn_permlane32_swap(__float_as_uint(pmax), __float_as_uint(pmax), false, false);
    pmax = fmaxf(__uint_as_float(rr[0]), __uint_as_float(rr[1])); }
  if (__builtin_expect(__all(pmax - m_reg <= THR2), 1)) { mn = m_reg; alpha = 1.f; }
  else { mn = fmaxf(m_reg, pmax); alpha = __builtin_amdgcn_exp2f(m_reg - mn); m_reg = mn; }
#pragma unroll
  for (int r = 0; r < 16; ++r) p0[r] = p0[r] - mn;
#pragma unroll
  for (int r = 0; r < 16; ++r) p1[r] = p1[r] - mn;
#pragma unroll
  for (int r = 0; r < 16; ++r) p0[r] = __builtin_amdgcn_exp2f(p0[r]);
}
__device__ __forceinline__ void finishSM(f32x16& p0, f32x16& p1, float alpha, float& l_reg, bf16x8& pa0, bf16x8& pa1, bf16x8& pa2, bf16x8& pa3) {
#pragma unroll
  for (int r = 0; r < 16; ++r) p1[r] = __builtin_amdgcn_exp2f(p1[r]);
  float ps = 0;
#pragma unroll
  for (int r = 0; r < 16; ++r) ps += p0[r];
#pragma unroll
  for (int r = 0; r < 16; ++r) ps += p1[r];
  { auto rr = __builtin_amdgcn_permlane32_swap(__float_as_uint(ps), __float_as_uint(ps), false, false);
    ps = __uint_as_float(rr[0]) + __uint_as_float(rr[1]); }
  l_reg = l_reg * alpha + ps;
#define PK4(P, BASE, OUT) do { unsigned a0 = cvtpk(P[BASE + 0], P[BASE + 1]), a1 = cvtpk(P[BASE + 2], P[BASE + 3]);   \
    unsigned b0 = cvtpk(P[BASE + 4], P[BASE + 5]), b1 = cvtpk(P[BASE + 6], P[BASE + 7]);                              \
    auto r0 = __builtin_amdgcn_permlane32_swap(a0, b0, false, false); auto r1 = __builtin_amdgcn_permlane32_swap(a1, b1, false, false); \
    u32x4 w = {r0[0], r1[0], r0[1], r1[1]}; OUT = __builtin_bit_cast(bf16x8, w); } while (0)
  PK4(p0, 0, pa0); PK4(p0, 8, pa1); PK4(p1, 0, pa2); PK4(p1, 8, pa3);
#undef PK4
}
__device__ __forceinline__ void partialFX(f32x16& p0) {
#pragma unroll
  for (int r = 0; r < 16; ++r) p0[r] = __builtin_amdgcn_exp2f(p0[r]);
}
__device__ __forceinline__ void finishFX(f32x16& p0, f32x16& p1, float& l_reg, bf16x8& pa0, bf16x8& pa1, bf16x8& pa2, bf16x8& pa3) {
#pragma unroll
  for (int r = 0; r < 16; ++r) p1[r] = __builtin_amdgcn_exp2f(p1[r]);
  float ps = 0;
#pragma unroll
  for (int r = 0; r < 16; ++r) ps += p0[r];
#pragma unroll
  for (int r = 0; r < 16; ++r) ps += p1[r];
  l_reg += ps;
#define PK4(P, BASE, OUT) do { unsigned a0 = cvtpk(P[BASE + 0], P[BASE + 1]), a1 = cvtpk(P[BASE + 2], P[BASE + 3]);   \
    unsigned b0 = cvtpk(P[BASE + 4], P[BASE + 5]), b1 = cvtpk(P[BASE + 6], P[BASE + 7]);                              \
    auto r0 = __builtin_amdgcn_permlane32_swap(a0, b0, false, false); auto r1 = __builtin_amdgcn_permlane32_swap(a1, b1, false, false); \
    u32x4 w = {r0[0], r1[0], r0[1], r1[1]}; OUT = __builtin_bit_cast(bf16x8, w); } while (0)
  PK4(p0, 0, pa0); PK4(p0, 8, pa1); PK4(p1, 0, pa2); PK4(p1, 8, pa3);
#undef PK4
}
__device__ __forceinline__ void qkt(f32x16& p0, f32x16& p1, const LAS unsigned char* Ks, const bf16x8 (&qr)[4], int c, int r32, int hi) {
  p0 = f32x16{}; p1 = f32x16{};
#pragma unroll
  for (int d0 = 0; d0 < 4; ++d0) { const int cb = (c * 64 + d0 * 16 + hi * 8) * 2;
    const bf16x8 b0 = *(const LAS bf16x8*)(Ks + KSWZ(r32, cb));
    const bf16x8 b1 = *(const LAS bf16x8*)(Ks + KSWZ(32 + r32, cb));
    p0 = __builtin_amdgcn_mfma_f32_32x32x16_bf16(b0, qr[d0], p0, 0, 0, 0);
    p1 = __builtin_amdgcn_mfma_f32_32x32x16_bf16(b1, qr[d0], p1, 0, 0, 0); }
}
__device__ __forceinline__ int v_st(int k, int c) { const int kk = (k & ~0xC) | ((k & 4) << 1) | ((k & 8) >> 1); return ((kk >> 3) * 4 + (c >> 5)) * 512 + ((kk & 7) * 32 + (c & 31)) * 2; }
__device__ __forceinline__ int v_rd_base(int lane) { return ((lane & 3) << 3) | (((lane >> 2) & 3) << 6) | (((lane >> 4) & 1) << 5) | (((lane >> 5) & 1) << 8); }
constexpr int v_rd_off(int d0, int ks, int half) { return d0 * 512 + ks * 4096 + half * 2048; }
template <int OFF> __device__ __forceinline__ s16x4 tr_read(int vb) {
  s16x4 r; asm volatile("ds_read_b64_tr_b16 %0, %1 offset:%2" : "=&v"(r) : "v"(vb), "i"(OFF) : "memory"); return r;
}
template <int D0> __device__ __forceinline__ void pv_one(f32x16& od, int vb, bf16x8 pa0, bf16x8 pa1, bf16x8 pa2, bf16x8 pa3) {
  const s16x4 l0 = tr_read<v_rd_off(D0, 0, 0)>(vb), h0 = tr_read<v_rd_off(D0, 0, 1)>(vb), l1 = tr_read<v_rd_off(D0, 1, 0)>(vb), h1 = tr_read<v_rd_off(D0, 1, 1)>(vb);
  const s16x4 l2 = tr_read<v_rd_off(D0, 2, 0)>(vb), h2 = tr_read<v_rd_off(D0, 2, 1)>(vb), l3 = tr_read<v_rd_off(D0, 3, 0)>(vb), h3 = tr_read<v_rd_off(D0, 3, 1)>(vb);
  asm volatile("s_waitcnt lgkmcnt(0)" ::: "memory"); SBAR();
#define PK(L, H) (bf16x8){L[0], L[1], L[2], L[3], H[0], H[1], H[2], H[3]}
  od = __builtin_amdgcn_mfma_f32_32x32x16_bf16(pa0, PK(l0, h0), od, 0, 0, 0);
  od = __builtin_amdgcn_mfma_f32_32x32x16_bf16(pa1, PK(l1, h1), od, 0, 0, 0);
  od = __builtin_amdgcn_mfma_f32_32x32x16_bf16(pa2, PK(l2, h2), od, 0, 0, 0);
  od = __builtin_amdgcn_mfma_f32_32x32x16_bf16(pa3, PK(l3, h3), od, 0, 0, 0);
#undef PK
}
#define PVRD(D0) const s16x4 l0_##D0 = tr_read<v_rd_off(D0, 0, 0)>(vb), h0_##D0 = tr_read<v_rd_off(D0, 0, 1)>(vb), l1_##D0 = tr_read<v_rd_off(D0, 1, 0)>(vb), h1_##D0 = tr_read<v_rd_off(D0, 1, 1)>(vb), \
    l2_##D0 = tr_read<v_rd_off(D0, 2, 0)>(vb), h2_##D0 = tr_read<v_rd_off(D0, 2, 1)>(vb), l3_##D0 = tr_read<v_rd_off(D0, 3, 0)>(vb), h3_##D0 = tr_read<v_rd_off(D0, 3, 1)>(vb)
#define PVPK(L, H) (bf16x8){L[0], L[1], L[2], L[3], H[0], H[1], H[2], H[3]}
#define PVMM(D0, N) do { asm volatile("s_waitcnt lgkmcnt(" #N ")" ::: "memory"); SBAR(); \
    o[D0] = __builtin_amdgcn_mfma_f32_32x32x16_bf16(pa0, PVPK(l0_##D0, h0_##D0), o[D0], 0, 0, 0); o[D0] = __builtin_amdgcn_mfma_f32_32x32x16_bf16(pa1, PVPK(l1_##D0, h1_##D0), o[D0], 0, 0, 0); \
    o[D0] = __builtin_amdgcn_mfma_f32_32x32x16_bf16(pa2, PVPK(l2_##D0, h2_##D0), o[D0], 0, 0, 0); o[D0] = __builtin_amdgcn_mfma_f32_32x32x16_bf16(pa3, PVPK(l3_##D0, h3_##D0), o[D0], 0, 0, 0); } while (0)
__device__ __forceinline__ void pv_d0(f32x16* o, int vb, bf16x8 pa0, bf16x8 pa1, bf16x8 pa2, bf16x8 pa3) {
  PVRD(0); PVRD(1); PVMM(0, 8); PVRD(2); PVMM(1, 8); PVRD(3); PVMM(2, 8); PVMM(3, 0);
}
#undef PVRD
#undef PVPK
#undef PVMM

template <bool FX>
__device__ __forceinline__ void attn_unit(const bf16* __restrict__ PROJ, bf16* __restrict__ MIX, const float* __restrict__ anw, const float lam, const float nb, const int b, const int h, const int qb,
                                          LAS unsigned char* lds, const int tid) {
  const int wid = __builtin_amdgcn_readfirstlane(tid >> 6), lane = tid & 63, r32 = lane & 31, hi = lane >> 5, g = wid >> 1, c = wid & 1;
  const int q0 = qb * 128, NT = 2 * qb + 2; const bool masked_last = (g < 2);
  int hcol = h * 128; asm volatile("" : "+s"(hcol));
  const char* Kg = (const char*)(PROJ + (size_t)(b * SEQ) * NCOL + C_AK + hcol);
  const char* Vg = (const char*)(PROJ + (size_t)(b * SEQ) * NCOL + C_AV + hcol);
  LAS float* wsf = (LAS float*)(lds + 131072) + wid * 64; LAS float* li_l = wsf; LAS float* al_l = wsf + 32;
  unsigned koff[2], voff[2];
#pragma unroll
  for (int p = 0; p < 2; ++p) { const int s = (wid * 2 + p) * 64 + lane, row = s >> 4, ch = (s & 15) ^ (row & 7); koff[p] = (unsigned)(row * NCOL + ch * 8) * 2u;
    const int o = s * 16, sub = o >> 9, within = o & 511, kk = (sub >> 2) * 8 + (within >> 6), k = (kk & ~0xC) | ((kk & 4) << 1) | ((kk & 8) >> 1), cc = (sub & 3) * 32 + ((within & 63) >> 4) * 8;
    voff[p] = (unsigned)(k * NCOL + cc) * 2u; }
#define DMA(tile, slot) do { const char* kt_ = Kg + (size_t)(tile) * (64 * NCOL * 2); const char* vt_ = Vg + (size_t)(tile) * (64 * NCOL * 2); LAS unsigned char* sl_ = lds + (slot) * 32768 + wid * 2048; \
    _Pragma("unroll") for (int p_ = 0; p_ < 2; ++p_) __builtin_amdgcn_global_load_lds((const unsigned*)(kt_ + koff[p_]), (LAS unsigned*)(sl_ + p_ * 1024), 16, 0, 0); \
    _Pragma("unroll") for (int p_ = 0; p_ < 2; ++p_) __builtin_amdgcn_global_load_lds((const unsigned*)(vt_ + voff[p_]), (LAS unsigned*)(sl_ + 16384 + p_ * 1024), 16, 0, 0); } while (0)
#define WB4() do { asm volatile("s_waitcnt vmcnt(4)" ::: "memory"); __builtin_amdgcn_s_barrier(); asm volatile("" ::: "memory"); } while (0)
#define WB8() do { asm volatile("s_waitcnt vmcnt(8)" ::: "memory"); __builtin_amdgcn_s_barrier(); asm volatile("" ::: "memory"); } while (0)
#define KSLOT(j) (lds + ((j) & 3) * 32768)
#define VSLOT(j) (vb0 + ((j) & 3) * 32768)
  float m_reg = -1e30f, l_reg = 0; f32x16 o[4] = {}; bf16x8 qr[4];
  { const bf16* Qw = PROJ + (size_t)(b * SEQ + q0 + 32 * g + r32) * NCOL + C_AQ + hcol + c * 64 + hi * 8;
#pragma unroll
    for (int d0 = 0; d0 < 4; ++d0) qr[d0] = *(const bf16x8*)(Qw + d0 * 16); }
  const int vb0 = (int)(unsigned)(uintptr_t)lds + 16384 + v_rd_base(lane);
#define RESC(a) do { if (__any((a) < 1.f)) { if (hi == 0) al_l[r32] = (a); asm volatile("s_waitcnt lgkmcnt(0)" ::: "memory"); \
    _Pragma("unroll") for (int d = 0; d < 4; ++d) _Pragma("unroll") for (int r = 0; r < 16; ++r) o[d][r] *= al_l[crow(r, hi)]; } } while (0)
  f32x16 p0, p1; float mn, al; bf16x8 pa0, pa1, pa2, pa3;
  DMA(0, 0); DMA(1, 1);
#pragma unroll 1
  for (int j = 0; j < NT; ++j) {
    WB4();
    DMA((j + 2 < NT ? j + 2 : NT - 1), (j + 2) & 3);
    SBAR(); qkt(p0, p1, KSLOT(j), qr, c, r32, hi);
    if (masked_last && j == NT - 1) {
#pragma unroll
      for (int r = 0; r < 16; ++r) { p0[r] = -1e30f; p1[r] = -1e30f; } }
    if constexpr (FX) { SBAR(); partialFX(p0); finishFX(p0, p1, l_reg, pa0, pa1, pa2, pa3); SBAR(); }
    else { partialSM(p0, p1, m_reg, mn, al); RESC(al); finishSM(p0, p1, al, l_reg, pa0, pa1, pa2, pa3); SBAR(); }
    pv_d0(o, VSLOT(j), pa0, pa1, pa2, pa3);
  }
  if constexpr (FX) l_reg += __shfl_xor(l_reg, 32);
  asm volatile("s_waitcnt vmcnt(0)" ::: "memory");
#undef DMA
#undef WB4
#undef WB8
#undef KSLOT
#undef VSLOT
  if (hi == 0) li_l[r32] = l_reg; asm volatile("s_waitcnt lgkmcnt(0)" ::: "memory");
  int lane2 = lane; asm volatile("" : "+v"(lane2));
  const int r32b = lane2 & 31, hib = lane2 >> 5;
  float rli[16];
#pragma unroll
  for (int r = 0; r < 16; ++r) rli[r] = __builtin_amdgcn_rcpf(li_l[(r & 3) + 8 * (r >> 2) + 4 * hib]);
  __syncthreads();
  LAS float* X = (LAS float*)(lds + g * 16384) + hib * 512 + r32b;
  if (c == 1) {
#pragma unroll
    for (int r = 0; r < 16; ++r)
#pragma unroll
      for (int d0 = 0; d0 < 4; ++d0) X[((r & 3) + 8 * (r >> 2)) * 128 + d0 * 32] = o[d0][r] * (rli[r] * lam);
  }
  __syncthreads();
  if (c == 0) {
    float ss[16];
#pragma unroll
    for (int r = 0; r < 16; ++r) { ss[r] = 0.f;
#pragma unroll
      for (int d0 = 0; d0 < 4; ++d0) { const float v = o[d0][r] * rli[r] - X[((r & 3) + 8 * (r >> 2)) * 128 + d0 * 32]; o[d0][r] = v; ss[r] += v * v; } }
#pragma unroll
    for (int r = 0; r < 16; ++r) {
#pragma unroll
      for (int s = 1; s < 32; s <<= 1) ss[r] += __shfl_xor(ss[r], s);
      ss[r] = rsqrtf(ss[r] * (1.f / 128.f) + EPS) * (1.f - LAMBDA_INIT); }
    float aw[4];
#pragma unroll
    for (int d0 = 0; d0 < 4; ++d0) aw[d0] = anw[d0 * 32 + r32b];
    asm volatile("s_waitcnt lgkmcnt(0)" ::: "memory");
    LAS bf16* Ost = (LAS bf16*)(lds + g * 16384);
    LAS bf16* Ow = Ost + hib * 512 + r32b;
#pragma unroll
    for (int r = 0; r < 16; ++r)
#pragma unroll
      for (int d0 = 0; d0 < 4; ++d0) Ow[((r & 3) + 8 * (r >> 2)) * 128 + d0 * 32] = (bf16)f2bf(o[d0][r] * ss[r] * aw[d0]);
    asm volatile("s_waitcnt lgkmcnt(0)" ::: "memory");
    const int rowb = lane2 >> 4, c16 = lane2 & 15;
    bf16* Ob = MIX + (size_t)(b * SEQ + q0 + 32 * g + rowb) * DM + 512 + h * 128 + c16 * 8;
    const LAS bf16* Os = Ost + rowb * 128 + c16 * 8;
#pragma unroll
    for (int k = 0; k < 8; ++k) *(u32x4*)(Ob + (size_t)k * 4 * DM) = *(const LAS u32x4*)(Os + k * 512);
  }
  __syncthreads();
#undef RESC
}

template <int C, int HALF_> __device__ __forceinline__ void half_scores(f32x16& p, const LAS unsigned char* Ks, const bf16x8 (&qr)[8], const int kaddr) {
  p = f32x16{};
#pragma unroll
  for (int d0 = 0; d0 < 4; ++d0) { const bf16x8 kf = *(const LAS bf16x8*)(Ks + (kaddr ^ (d0 * 32)) + C * 128 + HALF_ * 8192);
    p = __builtin_amdgcn_mfma_f32_32x32x16_bf16(kf, qr[C * 4 + d0], p, 0, 0, 0); }
}
__device__ __forceinline__ void half_softmax(f32x16& p, float& l_reg, bf16x8& pa, bf16x8& pb) {
#pragma unroll
  for (int r = 0; r < 16; ++r) p[r] = __builtin_amdgcn_exp2f(p[r]);
  float ps = 0;
#pragma unroll
  for (int r = 0; r < 16; ++r) ps += p[r];
  l_reg += ps;
#define PK4(P, BASE, OUT) do { unsigned a0 = cvtpk(P[BASE + 0], P[BASE + 1]), a1 = cvtpk(P[BASE + 2], P[BASE + 3]);   \
    unsigned b0 = cvtpk(P[BASE + 4], P[BASE + 5]), b1 = cvtpk(P[BASE + 6], P[BASE + 7]);                              \
    auto r0 = __builtin_amdgcn_permlane32_swap(a0, b0, false, false); auto r1 = __builtin_amdgcn_permlane32_swap(a1, b1, false, false); \
    u32x4 w = {r0[0], r1[0], r0[1], r1[1]}; OUT = __builtin_bit_cast(bf16x8, w); } while (0)
  PK4(p, 0, pa); PK4(p, 8, pb);
#undef PK4
  SBAR();
}
template <int D0, int HALF_> __device__ __forceinline__ void pv_half(f32x16& oa, f32x16& ob, int vb, bf16x8 a0, bf16x8 a1, bf16x8 b0, bf16x8 b1) {
  const s16x4 l0 = tr_read<v_rd_off(D0, 2 * HALF_, 0)>(vb), h0 = tr_read<v_rd_off(D0, 2 * HALF_, 1)>(vb), l1 = tr_read<v_rd_off(D0, 2 * HALF_ + 1, 0)>(vb), h1 = tr_read<v_rd_off(D0, 2 * HALF_ + 1, 1)>(vb);
  asm volatile("s_waitcnt lgkmcnt(0)" ::: "memory"); SBAR();
#define PK(L, H) (bf16x8){L[0], L[1], L[2], L[3], H[0], H[1], H[2], H[3]}
  oa = __builtin_amdgcn_mfma_f32_32x32x16_bf16(a0, PK(l0, h0), oa, 0, 0, 0);
  ob = __builtin_amdgcn_mfma_f32_32x32x16_bf16(b0, PK(l0, h0), ob, 0, 0, 0);
  oa = __builtin_amdgcn_mfma_f32_32x32x16_bf16(a1, PK(l1, h1), oa, 0, 0, 0);
  ob = __builtin_amdgcn_mfma_f32_32x32x16_bf16(b1, PK(l1, h1), ob, 0, 0, 0);
#undef PK
  SBAR();
}
__device__ __forceinline__ void attn2_setup(LAS unsigned char* lds, const int tid) {
  const int wid = __builtin_amdgcn_readfirstlane(tid >> 6), lane = tid & 63;
  unsigned koff[2], voff[2];
#pragma unroll
  for (int p = 0; p < 2; ++p) { const int s = (wid * 2 + p) * 64 + lane, row = s >> 4, ch = (s & 15) ^ (row & 7); koff[p] = (unsigned)(row * NCOL + ch * 8) * 2u;
    const int o = s * 16, sub = o >> 9, within = o & 511, kk = (sub >> 2) * 8 + (within >> 6), k = (kk & ~0xC) | ((kk & 4) << 1) | ((kk & 8) >> 1), cc = (sub & 3) * 32 + ((within & 63) >> 4) * 8;
    voff[p] = (unsigned)(k * NCOL + cc) * 2u; }
  *((LAS u32x4*)(lds + 133120 + wid * 1024) + lane) = (u32x4){koff[0], koff[1], voff[0], voff[1]};
  asm volatile("s_waitcnt lgkmcnt(0)" ::: "memory");
}
__device__ __forceinline__ void attn_unit2(const bf16* __restrict__ PROJ, bf16* __restrict__ MIX, const float* __restrict__ anw, const float lam, const int b, const int h, const int qb,
                                           LAS unsigned char* lds, const int tid) {
  const int wid = __builtin_amdgcn_readfirstlane(tid >> 6), lane = tid & 63, r32 = lane & 31, hi = lane >> 5;
  const int q0 = qb * 256, NT = 4 * qb + 4, jlast = 4 * qb + (wid >> 1);
  int hcol = h * 128; asm volatile("" : "+s"(hcol));
  const char* Kg = (const char*)(PROJ + (size_t)(b * SEQ) * NCOL + C_AK + hcol);
  const char* Vg = (const char*)(PROJ + (size_t)(b * SEQ) * NCOL + C_AV + hcol);
  LAS float* wsf = (LAS float*)(lds + 131072) + wid * 64;
  LAS u32x4* offt = (LAS u32x4*)(lds + 133120 + wid * 1024) + lane;
#define DMA(tile, slot) do { const char* kt_ = Kg + (size_t)(tile) * (64 * NCOL * 2); const char* vt_ = Vg + (size_t)(tile) * (64 * NCOL * 2); LAS unsigned char* sl_ = lds + (slot) * 32768 + wid * 2048; const u32x4 of_ = *offt; \
    __builtin_amdgcn_global_load_lds((const unsigned*)(kt_ + of_.x), (LAS unsigned*)(sl_), 16, 0, 0); __builtin_amdgcn_global_load_lds((const unsigned*)(kt_ + of_.y), (LAS unsigned*)(sl_ + 1024), 16, 0, 0); \
    __builtin_amdgcn_global_load_lds((const unsigned*)(vt_ + of_.z), (LAS unsigned*)(sl_ + 16384), 16, 0, 0); __builtin_amdgcn_global_load_lds((const unsigned*)(vt_ + of_.w), (LAS unsigned*)(sl_ + 16384 + 1024), 16, 0, 0); } while (0)
#define WB4() do { asm volatile("s_waitcnt vmcnt(4)" ::: "memory"); __builtin_amdgcn_s_barrier(); asm volatile("" ::: "memory"); } while (0)
  float l0 = 0.f, l1 = 0.f; f32x16 oa[4] = {}, ob[4] = {}; bf16x8 qr[8];
  { const bf16* Qw = PROJ + (size_t)(b * SEQ + q0 + 32 * wid + r32) * NCOL + C_AQ + hcol + hi * 8;
#pragma unroll
    for (int d = 0; d < 8; ++d) qr[d] = *(const bf16x8*)(Qw + d * 16); }
  const int vb0 = (int)(unsigned)(uintptr_t)lds + 16384 + v_rd_base(lane);
  const int kaddr = r32 * 256 + ((hi * 16) ^ ((r32 & 7) << 4));
  DMA(0, 0); DMA(1, 1);
#pragma unroll 1
  for (int j = 0; j < NT; ++j) {
    WB4();
    DMA((j + 2 < NT ? j + 2 : NT - 1), (j + 2) & 3);
    if (j <= jlast) {
      const LAS unsigned char* Ks = lds + (j & 3) * 32768; const int vb = vb0 + (j & 3) * 32768;
      f32x16 p; bf16x8 a0, a1, b0, b1;
      SBAR(); half_scores<0, 0>(p, Ks, qr, kaddr); half_softmax(p, l0, a0, a1);
      SBAR(); half_scores<1, 0>(p, Ks, qr, kaddr); half_softmax(p, l1, b0, b1); SBAR();
      pv_half<0, 0>(oa[0], ob[0], vb, a0, a1, b0, b1); pv_half<1, 0>(oa[1], ob[1], vb, a0, a1, b0, b1); pv_half<2, 0>(oa[2], ob[2], vb, a0, a1, b0, b1); pv_half<3, 0>(oa[3], ob[3], vb, a0, a1, b0, b1);
      SBAR(); half_scores<0, 1>(p, Ks, qr, kaddr); half_softmax(p, l0, a0, a1);
      SBAR(); half_scores<1, 1>(p, Ks, qr, kaddr); half_softmax(p, l1, b0, b1); SBAR();
      pv_half<0, 1>(oa[0], ob[0], vb, a0, a1, b0, b1); pv_half<1, 1>(oa[1], ob[1], vb, a0, a1, b0, b1); pv_half<2, 1>(oa[2], ob[2], vb, a0, a1, b0, b1); pv_half<3, 1>(oa[3], ob[3], vb, a0, a1, b0, b1);
    }
  }
  l0 += __shfl_xor(l0, 32); l1 += __shfl_xor(l1, 32);
  asm volatile("s_waitcnt vmcnt(0)" ::: "memory");
  if (hi == 0) { wsf[r32] = l0; wsf[32 + r32] = l1; } asm volatile("s_waitcnt lgkmcnt(0)" ::: "memory");
  int lane2 = lane; asm volatile("" : "+v"(lane2));
  const int r32b = lane2 & 31, hib = lane2 >> 5;
  __syncthreads();
  float ss[16];
#pragma unroll
  for (int r = 0; r < 16; ++r) { const int row = (r & 3) + 8 * (r >> 2) + 4 * hib; const float c0 = __builtin_amdgcn_rcpf(wsf[row]), c1 = lam * __builtin_amdgcn_rcpf(wsf[32 + row]); ss[r] = 0.f;
#pragma unroll
    for (int d0 = 0; d0 < 4; ++d0) { const float v = oa[d0][r] * c0 - ob[d0][r] * c1; oa[d0][r] = v; ss[r] += v * v; } }
#pragma unroll
  for (int r = 0; r < 16; ++r) {
#pragma unroll
    for (int s = 1; s < 32; s <<= 1) ss[r] += __shfl_xor(ss[r], s);
    ss[r] = rsqrtf(ss[r] * (1.f / 128.f) + EPS) * (1.f - LAMBDA_INIT); }
  float aw[4];
#pragma unroll
  for (int d0 = 0; d0 < 4; ++d0) aw[d0] = anw[d0 * 32 + r32b];
  LAS bf16* Ost = (LAS bf16*)(lds + wid * 8192);
  LAS bf16* Ow = Ost + hib * 512 + r32b;
#pragma unroll
  for (int r = 0; r < 16; ++r)
#pragma unroll
    for (int d0 = 0; d0 < 4; ++d0) Ow[((r & 3) + 8 * (r >> 2)) * 128 + d0 * 32] = (bf16)f2bf(oa[d0][r] * ss[r] * aw[d0]);
  asm volatile("s_waitcnt lgkmcnt(0)" ::: "memory");
  const int rowb = lane2 >> 4, c16 = lane2 & 15;
  bf16* Ob = MIX + (size_t)(b * SEQ + q0 + 32 * wid + rowb) * DM + 512 + h * 128 + c16 * 8;
  const LAS bf16* Os = Ost + rowb * 128 + c16 * 8;
#pragma unroll
  for (int k = 0; k < 8; ++k) *(u32x4*)(Ob + (size_t)k * 4 * DM) = *(const LAS u32x4*)(Os + k * 512);
  __syncthreads();
#undef DMA
#undef WB4
}
}

template <bool FX>
__device__ __forceinline__ void attn_queue(const bf16* PROJ, bf16* MIX, const float* anw, const float lam, const float nb, unsigned* queue, LAS unsigned char* lds, int tid) {
    LAS unsigned* slot = (LAS unsigned*)(lds + LDSCTL_OFF + 64);
    const int x0 = (int)(xb_xcc_id() & 7u);
    LAS unsigned* peek = (LAS unsigned*)(lds + LDSCTL_OFF + 72);
    if constexpr (FX) att::attn2_setup(lds, tid);
#pragma unroll 1
    for (int k = 0; k < 8; ++k) {
        const int x = (x0 + k) & 7;
        if (k == 1) { if (tid < 8) peek[tid] = __hip_atomic_load(queue + 64 * tid, __ATOMIC_RELAXED, __HIP_MEMORY_SCOPE_AGENT); __syncthreads(); }
        if (k >= 1) { if (peek[x] >= 128u) continue; }
        if (tid == 0) *slot = __hip_atomic_fetch_add(queue + 64 * x, 1u, __ATOMIC_RELAXED, __HIP_MEMORY_SCOPE_AGENT);
        __syncthreads();
        for (;;) {
            const unsigned l = *slot;
            __syncthreads();
            if (l >= 128u) break;
            unsigned nxt = 0u;
            if (tid == 0) nxt = __hip_atomic_fetch_add(queue + 64 * x, 1u, __ATOMIC_RELAXED, __HIP_MEMORY_SCOPE_AGENT);
            const int bh = ((int)l >> 3) * 8 + x, p = (int)l & 7;
            if constexpr (FX) { const int bh2 = ((int)l & 15) * 8 + x, qb2 = 7 - ((int)l >> 4); att::attn_unit2(PROJ, MIX, anw, lam, bh2 >> 2, bh2 & 3, qb2, lds, tid); }
            else {
#pragma unroll 1
                for (int s = 0; s < 2; ++s) att::attn_unit<false>(PROJ, MIX, anw, lam, nb, bh >> 2, bh & 3, s ? p : 15 - p, lds, tid); }
            if (tid == 0) *slot = nxt;
            __syncthreads();
        }
    }
}
__device__ __forceinline__ void p2_fast_attn(const Args& a, LAS unsigned char* lds, int tid, int lane, int wave, int wg, int G, int rep) {
    const float* lq1 = a.in[10]; const float* lk1 = a.in[11]; const float* lq2 = a.in[12]; const float* lk2 = a.in[13];
    const float lam = __expf(wave_sum(lq1[lane] * lk1[lane])) - __expf(wave_sum(lq2[lane] * lk2[lane])) + LAMBDA_INIT;
    const float bound2 = 8.f * 1.4426950408889634f * 1.01f * wave_max(fabsf(a.in[8][lane])) * wave_max(fabsf(a.in[9][lane]));
    const bool fixedmax = bound2 <= 40.f;
    const bf16* PROJ = (const bf16*)(a.ws + WS_PROJ); bf16* MIX = (bf16*)(a.ws + WS_MIX);
    unsigned* queue = (unsigned*)(a.ws + WS_CTL) + CW_QUEUE + 1024 * rep;
    if (fixedmax) attn_queue<true>(PROJ, MIX, a.in[14], lam, -bound2, queue, lds, tid);
    else attn_queue<false>(PROJ, MIX, a.in[14], lam, 0.f, queue, lds, tid);
}

__device__ __forceinline__ void p4_router(const Args& a, LAS unsigned char* lds, int tid, int lane, int wave, int wg, int G) {
    unsigned char* ws = a.ws;
    const float* norm2_w = a.in[16]; const float* w_group = a.in[17]; const float* b_group = a.in[18]; const float* w_expert = a.in[19]; const float* b_expert = a.in[20];
    const float* X1 = a.out; bf16* H2 = (bf16*)(ws + WS_H2);
    int* ASGE = (int*)(ws + WS_ASGE); float* ASGW = (float*)(ws + WS_ASGW); int* CNT = (int*)(ws + WS_CTL) + CW_CNT;
    LAS float* wl = (LAS float*)lds;
    LAS int* hist = (LAS int*)(lds + LDSCTL_OFF + 128);
    for (int idx = tid; idx < 4096; idx += NTHR) { const int k = idx >> 2, c = idx & 3; wl[c * 1024 + k] = w_group[idx]; }
    for (int idx = tid; idx < 32768; idx += NTHR) { const int k = idx >> 5, c = idx & 31; wl[(4 + c) * 1024 + k] = w_expert[idx]; }
    if (tid < 32) hist[tid] = 0;
    __syncthreads();
    f32x4 w2v[4];
#pragma unroll
    for (int j = 0; j < 4; ++j) w2v[j] = ((const f32x4*)norm2_w)[lane + 64 * j];
    const int tpw = T_ / (G * NWAVES);
#pragma unroll 1
    for (int rr = 0; rr < tpw; ++rr) {
        const int t = (wg * NWAVES + wave) * tpw + rr;
        const f32x4* xr = (const f32x4*)(X1 + (size_t)t * DM) + lane;
        f32x4 hv[4]; float ss = 0.f;
#pragma unroll
        for (int j = 0; j < 4; ++j) { hv[j] = xr[64 * j]; ss += (hv[j].x * hv[j].x + hv[j].y * hv[j].y) + (hv[j].z * hv[j].z + hv[j].w * hv[j].w); }
        const float r2 = rsqrtf(wave_sum(ss) * (1.f / DM) + EPS);
        u32x2* o8 = (u32x2*)(H2 + (size_t)t * DM) + lane;
#pragma unroll
        for (int j = 0; j < 4; ++j) { hv[j] = hv[j] * r2 * w2v[j]; u32x2 o; o.x = pk2(hv[j].x, hv[j].y); o.y = pk2(hv[j].z, hv[j].w); o8[64 * j] = o; }
        float lg[36];
#pragma unroll
        for (int c = 0; c < 36; ++c) { float acc = 0.f;
#pragma unroll
            for (int j = 0; j < 4; ++j) { const f32x4 wv = *(const LAS f32x4*)(wl + c * 1024 + 256 * j + 4 * lane); acc += (hv[j].x * wv.x + hv[j].y * wv.y) + (hv[j].z * wv.z + hv[j].w * wv.w); }
            lg[c] = wave_sum(acc); }
        float gl[4];
#pragma unroll
        for (int g = 0; g < 4; ++g) gl[g] = lg[g] + b_group[g];
        int gsel = 0; float gmax = gl[0];
#pragma unroll
        for (int g = 1; g < 4; ++g) if (gl[g] > gmax) { gmax = gl[g]; gsel = g; }
        float gsum = 0.f;
#pragma unroll
        for (int g = 0; g < 4; ++g) gsum += __expf(gl[g] - gmax);
        const float gwt = 1.f / gsum;
        float el[8];
#pragma unroll
        for (int i = 0; i < 8; ++i) el[i] = 0.f;
#pragma unroll
        for (int g = 0; g < 4; ++g) if (gsel == g) {
#pragma unroll
            for (int i = 0; i < 8; ++i) el[i] = lg[4 + 8 * g + i] + b_expert[8 * g + i]; }
        int i1 = 0; float v1 = el[0];
#pragma unroll
        for (int i = 1; i < 8; ++i) if (el[i] > v1) { v1 = el[i]; i1 = i; }
        int i2 = -1; float v2 = -3.0e38f;
#pragma unroll
        for (int i = 0; i < 8; ++i) if (i != i1 && el[i] > v2) { v2 = el[i]; i2 = i; }
        const float p1 = 1.f / (1.f + __expf(v2 - v1)), p2 = 1.f - p1;
        if (lane == 0) {
            const int e1 = gsel * 8 + i1, e2 = gsel * 8 + i2;
            const int r1 = atomicAdd((int*)&hist[e1], 1), r2_ = atomicAdd((int*)&hist[e2], 1);
            ASGE[2 * t] = e1 | (r1 << 8); ASGE[2 * t + 1] = e2 | (r2_ << 8);
            ASGW[2 * t] = gwt * p1; ASGW[2 * t + 1] = gwt * p2;
        }
    }
    __syncthreads();
    if (tid < 32) CNT[wg * 32 + tid] = hist[tid];
}


__device__ __forceinline__ void p4_router_mfma(const Args& a, LAS unsigned char* lds, int tid, int lane, int wave, int wg, int G) {
    unsigned char* ws = a.ws;
    const float* b_group = a.in[18]; const float* b_expert = a.in[20];
    const float* X1 = a.in[0]; const bf16* MO = (const bf16*)(ws + WS_MO); bf16* X1B = (bf16*)(ws + WS_H2);
    int* ASGE = (int*)(ws + WS_ASGE); float* ASGW = (float*)(ws + WS_ASGW); int* CNT = (int*)(ws + WS_CTL) + CW_CNT;
    constexpr int WST = 2064, WLO = 36 * WST;
    LAS int* hist = (LAS int*)(lds + LDSCTL_OFF + 128);
    {
        const u32x4* RIMG = (const u32x4*)(ws + WS_RIMG); constexpr int NP = 2 * 36 * WST / 16;
#pragma unroll 1
        for (int base = 0; base < NP; base += 6 * NTHR) {
            u32x4 v[6];
#pragma unroll
            for (int q = 0; q < 6; ++q) { const int i = base + q * NTHR + tid; v[q] = RIMG[i < NP ? i : NP - 1]; }
#pragma unroll
            for (int q = 0; q < 6; ++q) { const int i = base + q * NTHR + tid; if (i < NP) *(LAS u32x4*)(lds + i * 16) = v[q]; }
        }
    }
    if (tid < 32) hist[tid] = 0;
    __syncthreads();
    const int fr = lane & 15, fq = lane >> 4;
    const int t0 = (wg * NWAVES + wave) * 32;
    const float* xa = X1 + (size_t)(t0 + fr) * DM + 8 * fq; const float* xb = xa + (size_t)16 * DM;
    const bf16* moa = MO + (size_t)(t0 + fr) * DM + 8 * fq; const bf16* mob = moa + (size_t)16 * DM;
    bf16* x1a = X1B + (size_t)(t0 + fr) * DM + 8 * fq; bf16* x1b = x1a + (size_t)16 * DM;
    unsigned char* x1fa = ws + WS_X1F + (size_t)(t0 + fr) * DM + 8 * fq; unsigned char* x1fb = x1fa + (size_t)16 * DM;
    f32x4 acc[2][3];
#pragma unroll
    for (int tl = 0; tl < 2; ++tl)
#pragma unroll
        for (int nt = 0; nt < 3; ++nt) acc[tl][nt] = (f32x4){0.f, 0.f, 0.f, 0.f};
    float ss0 = 0.f, ss1 = 0.f;
    int wrow[3];
#pragma unroll
    for (int nt = 0; nt < 3; ++nt) { const int c = 16 * nt + fr; wrow[nt] = (c < 36 ? c : 35) * WST + 16 * fq; }
#pragma unroll 1
    for (int kg = 0; kg < 8; ++kg) {
        f32x4 xa_[4][2], xb_[4][2]; u32x4 ma_[4], mb_[4];
#pragma unroll
        for (int q = 0; q < 4; ++q) { const int ks = 4 * kg + q;
            xa_[q][0] = *(const f32x4*)(xa + 32 * ks); xa_[q][1] = *(const f32x4*)(xa + 32 * ks + 4); xb_[q][0] = *(const f32x4*)(xb + 32 * ks); xb_[q][1] = *(const f32x4*)(xb + 32 * ks + 4);
            ma_[q] = *(const u32x4*)(moa + 32 * ks); mb_[q] = *(const u32x4*)(mob + 32 * ks); }
#pragma unroll
        for (int q = 0; q < 4; ++q) { const int ks = 4 * kg + q;
            f32x4 a0 = xa_[q][0], a1 = xa_[q][1], b0 = xb_[q][0], b1 = xb_[q][1]; const u32x4 ma = ma_[q], mb = mb_[q];
            a0.x += bflo(ma.x); a0.y += bfhi(ma.x); a0.z += bflo(ma.y); a0.w += bfhi(ma.y); a1.x += bflo(ma.z); a1.y += bfhi(ma.z); a1.z += bflo(ma.w); a1.w += bfhi(ma.w);
            b0.x += bflo(mb.x); b0.y += bfhi(mb.x); b0.z += bflo(mb.y); b0.w += bfhi(mb.y); b1.x += bflo(mb.z); b1.y += bfhi(mb.z); b1.z += bflo(mb.w); b1.w += bfhi(mb.w);
            ss0 += (a0.x * a0.x + a0.y * a0.y) + (a0.z * a0.z + a0.w * a0.w) + (a1.x * a1.x + a1.y * a1.y) + (a1.z * a1.z + a1.w * a1.w);
            ss1 += (b0.x * b0.x + b0.y * b0.y) + (b0.z * b0.z + b0.w * b0.w) + (b1.x * b1.x + b1.y * b1.y) + (b1.z * b1.z + b1.w * b1.w);
            bf16x8 ah[2], al[2];
#define P4_SPLIT(v0, v1, H, L) do { u32x4 h_, l_; \
                h_.x = pg8::cvt_pk_bf16(v0.x, v0.y); h_.y = pg8::cvt_pk_bf16(v0.z, v0.w); h_.z = pg8::cvt_pk_bf16(v1.x, v1.y); h_.w = pg8::cvt_pk_bf16(v1.z, v1.w); \
                l_.x = pg8::cvt_pk_bf16(v0.x - bflo(h_.x), v0.y - bfhi(h_.x)); l_.y = pg8::cvt_pk_bf16(v0.z - bflo(h_.y), v0.w - bfhi(h_.y)); l_.z = pg8::cvt_pk_bf16(v1.x - bflo(h_.z), v1.y - bfhi(h_.z)); l_.w = pg8::cvt_pk_bf16(v1.z - bflo(h_.w), v1.w - bfhi(h_.w)); \
                H = __builtin_bit_cast(bf16x8, h_); L = __builtin_bit_cast(bf16x8, l_); } while (0)
            P4_SPLIT(a0, a1, ah[0], al[0]); P4_SPLIT(b0, b1, ah[1], al[1]);
#undef P4_SPLIT
            *(bf16x8*)(x1a + 32 * ks) = ah[0]; *(bf16x8*)(x1b + 32 * ks) = ah[1];
            { u32x2 fa, fb; fa.x = pk4_fp8(a0.x, a0.y, a0.z, a0.w); fa.y = pk4_fp8(a1.x, a1.y, a1.z, a1.w); fb.x = pk4_fp8(b0.x, b0.y, b0.z, b0.w); fb.y = pk4_fp8(b1.x, b1.y, b1.z, b1.w);
              *(u32x2*)(x1fa + 32 * ks) = fa; *(u32x2*)(x1fb + 32 * ks) = fb; }
#pragma unroll
            for (int nt = 0; nt < 3; ++nt) {
                const bf16x8 wh = *(const LAS bf16x8*)(lds + wrow[nt] + ks * 64), wl = *(const LAS bf16x8*)(lds + WLO + wrow[nt] + ks * 64);
#pragma unroll
                for (int tl = 0; tl < 2; ++tl) {
                    acc[tl][nt] = __builtin_amdgcn_mfma_f32_16x16x32_bf16(wh, ah[tl], acc[tl][nt], 0, 0, 0);
                    acc[tl][nt] = __builtin_amdgcn_mfma_f32_16x16x32_bf16(wh, al[tl], acc[tl][nt], 0, 0, 0);
                    acc[tl][nt] = __builtin_amdgcn_mfma_f32_16x16x32_bf16(wl, ah[tl], acc[tl][nt], 0, 0, 0); }
            }
        }
    }
    float bg[4], be[32]; int pe_[2][2] = {{0, 0}, {0, 0}}, pr_[2][2] = {{0, 0}, {0, 0}};
#pragma unroll
    for (int g = 0; g < 4; ++g) bg[g] = b_group[g];
#pragma unroll
    for (int i = 0; i < 32; ++i) be[i] = b_expert[i];
#pragma unroll
    for (int tl = 0; tl < 2; ++tl) {
        float ss = tl ? ss1 : ss0; ss += __shfl_xor(ss, 16); ss += __shfl_xor(ss, 32);
        const float r2 = rsqrtf(ss * (1.f / DM) + EPS);
        float lg[36];
#pragma unroll
        for (int nt = 0; nt < 3; ++nt)
#pragma unroll
            for (int q = 0; q < 4; ++q)
#pragma unroll
                for (int j = 0; j < 4; ++j) { const int c = 16 * nt + 4 * q + j; if (c < 36) lg[c] = __shfl(acc[tl][nt][j], fr + 16 * q) * r2; }
        float gl[4];
#pragma unroll
        for (int g = 0; g < 4; ++g) gl[g] = lg[g] + bg[g];
        int gsel = 0; float gmax = gl[0];
#pragma unroll
        for (int g = 1; g < 4; ++g) if (gl[g] > gmax) { gmax = gl[g]; gsel = g; }
        float gsum = 0.f;
#pragma unroll
        for (int g = 0; g < 4; ++g) gsum += __expf(gl[g] - gmax);
        const float gwt = 1.f / gsum;
        float el[8];
#pragma unroll
        for (int i = 0; i < 8; ++i) el[i] = 0.f;
#pragma unroll
        for (int g = 0; g < 4; ++g) if (gsel == g) {
#pragma unroll
            for (int i = 0; i < 8; ++i) el[i] = lg[4 + 8 * g + i] + be[8 * g + i]; }
        int i1 = 0; float v1 = el[0];
#pragma unroll
        for (int i = 1; i < 8; ++i) if (el[i] > v1) { v1 = el[i]; i1 = i; }
        int i2 = -1; float v2 = -3.0e38f;
#pragma unroll
        for (int i = 0; i < 8; ++i) if (i != i1 && el[i] > v2) { v2 = el[i]; i2 = i; }
        const float p1 = 1.f / (1.f + __expf(v2 - v1)), p2 = 1.f - p1;
        if (fq == 0) {
            const int t = t0 + 16 * tl + fr;
            const int e1 = gsel * 8 + i1, e2 = gsel * 8 + i2;
            const int r1 = atomicAdd((int*)&hist[e1], 1), r2_ = atomicAdd((int*)&hist[e2], 1);
            pe_[tl][0] = e1; pe_[tl][1] = e2; pr_[tl][0] = r1; pr_[tl][1] = r2_;
            ASGW[2 * t] = gwt * p1; ASGW[2 * t + 1] = gwt * p2;
            ASGW[2 * T_ + 2 * t] = r2; ASGW[2 * T_ + 2 * t + 1] = r2;
        }
    }
    __syncthreads();
    LAS int* lbase = hist + 32;
    if (tid < 32) lbase[tid] = atomicAdd((int*)(ws + WS_CTL) + CW_CUR + 64 * tid, hist[tid]);
    __syncthreads();
    if (fq == 0) { int* LIST = (int*)(ws + WS_LIST);
#pragma unroll
        for (int tl = 0; tl < 2; ++tl) { const int t = t0 + 16 * tl + fr;
#pragma unroll
            for (int k = 0; k < 2; ++k) { const int e = pe_[tl][k], ii = lbase[e] + pr_[tl][k]; LIST[(size_t)e * LCAP + ii] = 2 * t + k; ASGE[2 * t + k] = e | (ii << 8); } } }
}

__device__ __forceinline__ void p5_dispatch(const Args& a, LAS unsigned char* lds, int tid, int wg, int G) {
    unsigned char* ws = a.ws;
    const int* ASGE = (const int*)(ws + WS_ASGE); const float* ASGW = (const float*)(ws + WS_ASGW); const int* CNT = (const int*)(ws + WS_CTL) + CW_CNT;
    int* META = (int*)(ws + WS_CTL) + CW_META; int* ROWTOK = (int*)(ws + WS_ROWTOK); float* ROWW = (float*)(ws + WS_ROWW); float* ROWR = (float*)(ws + WS_GATES); int* POSA = (int*)(ws + WS_POSA);
    LAS int* tot = (LAS int*)lds; LAS int* pre = tot + 32; LAS int* pst = pre + 32;
    {
        LAS int* part = pst + 64;
        const int e = tid & 31, j = tid >> 5; int total = 0, prefix = 0;
#pragma unroll
        for (int q = 0; q < 16; ++q) { const int w = 16 * j + q; const int c = (w < G) ? CNT[w * 32 + e] : 0; total += c; prefix += (w < wg) ? c : 0; }
        part[j * 32 + e] = total; part[512 + j * 32 + e] = prefix;
        __syncthreads();
        if (tid < 32) { int t2 = 0, p2 = 0;
#pragma unroll
            for (int q = 0; q < 16; ++q) { t2 += part[q * 32 + tid]; p2 += part[512 + q * 32 + tid]; }
            tot[tid] = t2; pre[tid] = p2; }
    }
    __syncthreads();
    if (tid == 0) { int s = 0; for (int e = 0; e < 32; ++e) { pst[e] = s; s += (tot[e] + 255) & ~255; } pst[32] = s; }
    __syncthreads();
    if (wg == 0 && tid <= 32) META[tid] = pst[tid];
    const int apw = 2 * T_ / G;
    for (int q = tid; q < apw; q += NTHR) { const int idx = wg * apw + q; const int ev = ASGE[idx], e = ev & 255, rank = ev >> 8; const int pos = pst[e] + pre[e] + rank; ROWTOK[pos] = idx; ROWW[pos] = ASGW[idx]; ROWR[pos] = ASGW[2 * T_ + idx]; POSA[idx] = pos; }
    if (wg < 32) { const int e = wg; for (int p = pst[e] + tot[e] + tid; p < pst[e + 1]; p += NTHR) { ROWTOK[p] = -1; ROWW[p] = 0.f; ROWR[p] = 0.f; } }
}

__device__ __forceinline__ int expert_of_row(const LAS int* pst, int row) { int e = 0;
#pragma unroll 1
    for (int i = 1; i < 32; ++i) e += (pst[i] <= row) ? 1 : 0;
    return e; }

__device__ __forceinline__ void unpack8(const u32x4 v, float (&f)[8]) { f[0] = bflo(v.x); f[1] = bfhi(v.x); f[2] = bflo(v.y); f[3] = bfhi(v.y); f[4] = bflo(v.z); f[5] = bfhi(v.z); f[6] = bflo(v.w); f[7] = bfhi(v.w); }
__device__ __forceinline__ void p6_naive(const Args& a, LAS unsigned char* lds, int tid, int wg, int G) {
    unsigned char* ws = a.ws;
    const int* META = (const int*)(ws + WS_CTL) + CW_META; const int* ROWTOK = (const int*)(ws + WS_ROWTOK);
    const bf16* H2 = (const bf16*)(ws + WS_H2); const bf16* WGU = (const bf16*)(ws + WS_WGU); bf16* HID = (bf16*)(ws + WS_HID);
    LAS int* pst = (LAS int*)lds;
    if (tid <= 32) pst[tid] = META[tid];
    __syncthreads();
    const int npad = pst[32], ntile = (npad / 64) * 8, rg = tid >> 5, cg = tid & 31;
    for (int tile = wg; tile < ntile; tile += G) {
        const int rt = tile >> 3, ct = tile & 7, e = expert_of_row(pst, rt * 64);
        const bf16* ar[4];
#pragma unroll
        for (int i = 0; i < 4; ++i) { const int tk = ROWTOK[rt * 64 + rg * 4 + i]; ar[i] = H2 + (size_t)(tk < 0 ? 0 : (tk >> 1)) * DM; }
        const int c0 = ct * 64 + cg * 2;
        const bf16* bg[2]; const bf16* bu[2];
#pragma unroll
        for (int j = 0; j < 2; ++j) { const int c = c0 + j; bg[j] = WGU + ((size_t)e * 1024 + (c >> 7) * 256 + (c & 127)) * 1024; bu[j] = bg[j] + 128 * 1024; }
        float g[4][2], u[4][2];
#pragma unroll
        for (int i = 0; i < 4; ++i)
#pragma unroll
            for (int j = 0; j < 2; ++j) { g[i][j] = 0.f; u[i][j] = 0.f; }
#pragma unroll 1
        for (int k = 0; k < 1024; k += 8) {
            float af[4][8], gf[2][8], uf[2][8];
#pragma unroll
            for (int i = 0; i < 4; ++i) unpack8(*(const u32x4*)(ar[i] + k), af[i]);
#pragma unroll
            for (int j = 0; j < 2; ++j) { unpack8(*(const u32x4*)(bg[j] + k), gf[j]); unpack8(*(const u32x4*)(bu[j] + k), uf[j]); }
#pragma unroll
            for (int i = 0; i < 4; ++i)
#pragma unroll
                for (int j = 0; j < 2; ++j)
#pragma unroll
                    for (int q = 0; q < 8; ++q) { g[i][j] += af[i][q] * gf[j][q]; u[i][j] += af[i][q] * uf[j][q]; }
        }
#pragma unroll
        for (int i = 0; i < 4; ++i) *(unsigned*)(HID + (size_t)(rt * 64 + rg * 4 + i) * DEXP + c0) = pk2(siluf_(g[i][0]) * u[i][0], siluf_(g[i][1]) * u[i][1]);
    }
}

__device__ __forceinline__ void p7_naive(const Args& a, LAS unsigned char* lds, int tid, int wg, int G) {
    unsigned char* ws = a.ws;
    const int* META = (const int*)(ws + WS_CTL) + CW_META; const int* ROWTOK = (const int*)(ws + WS_ROWTOK); const float* ROWW = (const float*)(ws + WS_ROWW);
    const bf16* HID = (const bf16*)(ws + WS_HID); const bf16* WD = (const bf16*)(ws + WS_WD); bf16* YBUF = (bf16*)(ws + WS_YBUF);
    LAS int* pst = (LAS int*)lds;
    if (tid <= 32) pst[tid] = META[tid];
    __syncthreads();
    const int npad = pst[32], ntile = (npad / 64) * 8, rg = tid >> 5, cg = tid & 31;
    for (int tile = wg; tile < ntile; tile += G) {
        const int rt = tile >> 3, ct = tile & 7, e = expert_of_row(pst, rt * 64);
        const bf16* ar[4]; const bf16* br[4];
#pragma unroll
        for (int i = 0; i < 4; ++i) ar[i] = HID + (size_t)(rt * 64 + rg * 4 + i) * DEXP;
        const int c0 = ct * 128 + cg * 4;
#pragma unroll
        for (int j = 0; j < 4; ++j) br[j] = WD + ((size_t)e * 1024 + c0 + j) * DEXP;
        float acc[4][4];
#pragma unroll
        for (int i = 0; i < 4; ++i)
#pragma unroll
            for (int j = 0; j < 4; ++j) acc[i][j] = 0.f;
#pragma unroll 1
        for (int k = 0; k < DEXP; k += 8) {
            float af[4][8], bfv[4][8];
#pragma unroll
            for (int i = 0; i < 4; ++i) { unpack8(*(const u32x4*)(ar[i] + k), af[i]); unpack8(*(const u32x4*)(br[i] + k), bfv[i]); }
#pragma unroll
            for (int i = 0; i < 4; ++i)
#pragma unroll
                for (int j = 0; j < 4; ++j)
#pragma unroll
                    for (int q = 0; q < 8; ++q) acc[i][j] += af[i][q] * bfv[j][q];
        }
#pragma unroll
        for (int i = 0; i < 4; ++i) { const int pos = rt * 64 + rg * 4 + i; const int tk = ROWTOK[pos];
            if (tk >= 0) { const float w = ROWW[pos]; const int t = tk >> 1, kk = tk & 1;
                u32x2 o; o.x = pk2(acc[i][0] * w, acc[i][1] * w); o.y = pk2(acc[i][2] * w, acc[i][3] * w);
                *(u32x2*)(YBUF + ((size_t)kk * T_ + t) * DM + c0) = o; } }
    }
}

__device__ __forceinline__ void p8_combine(const Args& a, int tid, int wg, int G) {
    const unsigned char* Y = a.ws + WS_YBUF; const bf16* X1B = (const bf16*)(a.ws + WS_H2); float* O = a.out;
    const int* POSA = (const int*)(a.ws + WS_POSA); const float* ASGW = (const float*)(a.ws + WS_ASGW);
    const int lane = tid & 63, gw = wg * NWAVES + __builtin_amdgcn_readfirstlane(tid >> 6), NGW = G * NWAVES;
    u32x4 xb[2]; u32x2 y0[2], y1[2]; float w0 = 0.f, w1 = 0.f;
#define P8_LOAD(t_) do { const int t__ = __builtin_amdgcn_readfirstlane(t_); const int p0_ = POSA[2 * t__], p1_ = POSA[2 * t__ + 1]; w0 = ASGW[2 * t__]; w1 = ASGW[2 * t__ + 1]; \
        _Pragma("unroll") for (int q = 0; q < 2; ++q) { xb[q] = *(const u32x4*)(X1B + (size_t)t__ * DM + (lane + 64 * q) * 8); y0[q] = *(const u32x2*)(Y + (size_t)p0_ * DM + (lane + 64 * q) * 8); \
            y1[q] = *(const u32x2*)(Y + (size_t)p1_ * DM + (lane + 64 * q) * 8); } } while (0)
#define P8_F8(w_, i_) __builtin_amdgcn_cvt_f32_fp8((int)(w_), (i_))
    P8_LOAD(gw);
#pragma unroll 1
    for (int t = gw; t < T_; t += NGW) {
        u32x4 cx[2]; u32x2 c0[2], c1[2]; const float cw0 = w0, cw1 = w1;
#pragma unroll
        for (int q = 0; q < 2; ++q) { cx[q] = xb[q]; c0[q] = y0[q]; c1[q] = y1[q]; }
        if (t + NGW < T_) P8_LOAD(t + NGW);
#pragma unroll
        for (int q = 0; q < 2; ++q) {
            f32x4 a0, a1;
            a0.x = bflo(cx[q].x) + cw0 * P8_F8(c0[q].x, 0) + cw1 * P8_F8(c1[q].x, 0); a0.y = bfhi(cx[q].x) + cw0 * P8_F8(c0[q].x, 1) + cw1 * P8_F8(c1[q].x, 1);
            a0.z = bflo(cx[q].y) + cw0 * P8_F8(c0[q].x, 2) + cw1 * P8_F8(c1[q].x, 2); a0.w = bfhi(cx[q].y) + cw0 * P8_F8(c0[q].x, 3) + cw1 * P8_F8(c1[q].x, 3);
            a1.x = bflo(cx[q].z) + cw0 * P8_F8(c0[q].y, 0) + cw1 * P8_F8(c1[q].y, 0); a1.y = bfhi(cx[q].z) + cw0 * P8_F8(c0[q].y, 1) + cw1 * P8_F8(c1[q].y, 1);
            a1.z = bflo(cx[q].w) + cw0 * P8_F8(c0[q].y, 2) + cw1 * P8_F8(c1[q].y, 2); a1.w = bfhi(cx[q].w) + cw0 * P8_F8(c0[q].y, 3) + cw1 * P8_F8(c1[q].y, 3);
            float* op = O + (size_t)t * DM + (lane + 64 * q) * 8;
            *(f32x4*)op = a0; *(f32x4*)(op + 4) = a1;
        }
    }
#undef P8_LOAD
#undef P8_F8
}

#ifndef STAGGER_P1
#define STAGGER_P1 700
#endif
#ifndef STAGGER_P6
#define STAGGER_P6 0
#endif
#ifndef STAGGER_P7
#define STAGGER_P7 0
#endif
__device__ __forceinline__ void phase_stagger(unsigned ticks) {
    const unsigned g = blockIdx.x & 3u;
    if (g != 0u && ticks != 0u) { const unsigned long long t0 = __builtin_amdgcn_s_memrealtime(); while (__builtin_amdgcn_s_memrealtime() - t0 < (unsigned long long)(g * ticks)) __builtin_amdgcn_s_sleep(16); }
}

__device__ __forceinline__ void p6_gemm(const Args& a, LAS unsigned char* lds, int tid, int wg, int G) {
    unsigned char* ws = a.ws;
    LAS int* pst = (LAS int*)(lds + 131072); LAS int* tot = pst + 64;
    if (tid < 32) tot[tid] = ((const int*)(ws + WS_CTL) + CW_CUR)[64 * tid];
    __syncthreads();
    if (tid == 0) { int s_ = 0; for (int e = 0; e < 32; ++e) { pst[e] = s_; s_ += (tot[e] + 255) & ~255; } pst[32] = s_; }
    __syncthreads();
    {
        const int* ASGE = (const int*)(ws + WS_ASGE); int* POSA = (int*)(ws + WS_POSA); const int idx = wg * (2 * T_ / G) + tid;
        if (tid < 2 * T_ / G) { const int ev = ASGE[idx]; POSA[idx] = pst[ev & 255] + (ev >> 8); }
    }
    pg8::MoeGuSched S; S.o.init(pst[32] / 256, 4, G, wg); S.A = (const char*)(ws + WS_X1F); S.Bt = (const char*)(ws + WS_WGU); S.rowtok = (const int*)(ws + WS_ROWTOK); S.pst = pst; S.K = DM / 2;
    LAS int* ltok = (LAS int*)(lds + 131584); LAS float* lrowr = (LAS float*)(lds + 131584 + 9 * 256 * 4);
    {
        const int* LIST = (const int*)(ws + WS_LIST); const float* R2 = (const float*)(ws + WS_ASGW) + 2 * T_;
        int tv[9]; float rv[9]; bool ok[9];
#pragma unroll
        for (int i = 0; i < 9; ++i) { int pm, pn; ok[i] = S.o.map(i, pm, pn); tv[i] = -1; rv[i] = 0.f;
            if (ok[i] && tid < 256) { const int e = pg8::expert_of_row_l(pst, pm * 256), ii = pm * 256 + tid - pst[e]; if (ii < tot[e]) tv[i] = LIST[(size_t)e * LCAP + ii]; } }
#pragma unroll
        for (int i = 0; i < 9; ++i) if (tv[i] >= 0) rv[i] = R2[tv[i]];
#pragma unroll
        for (int i = 0; i < 9; ++i) if (ok[i] && tid < 256) { ltok[i * 256 + tid] = tv[i]; lrowr[i * 256 + tid] = rv[i]; }
        __syncthreads();
    }
    S.ltok = ltok;
    pg8::EpiSwiglu E{(bf16*)(ws + WS_HID), lrowr};
    phase_stagger(STAGGER_P6);
    pg8::gemm_phase<pg8::EpiSwiglu, pg8::MoeGuSched, true, true>(lds, DM / 2, S, E);
}
__device__ __forceinline__ void p7_gemm(const Args& a, LAS unsigned char* lds, int tid, int wg, int G) {
    unsigned char* ws = a.ws;
    LAS int* pst = (LAS int*)(lds + 131072); LAS int* tot = pst + 64;
    if (tid < 32) tot[tid] = ((const int*)(ws + WS_CTL) + CW_CUR)[64 * tid];
    __syncthreads();
    if (tid == 0) { int s_ = 0; for (int e = 0; e < 32; ++e) { pst[e] = s_; s_ += (tot[e] + 255) & ~255; } pst[32] = s_; }
    __syncthreads();
    pg8::MoeDownSched S; S.o.init(pst[32] / 256, 4, G, wg); S.A = (const char*)(ws + WS_HID); S.Bt = (const char*)(ws + WS_WD); S.pst = pst; S.K = DEXP / 2;
    pg8::EpiF8 E{ws + WS_YBUF, DM};
    phase_stagger(STAGGER_P7);
    pg8::gemm_phase<pg8::EpiF8, pg8::MoeDownSched, true, true>(lds, DEXP / 2, S, E);
}

__global__ void __launch_bounds__(NTHR, 2) fwd(Args args) {
    extern __shared__ __attribute__((aligned(16))) unsigned char lds_raw[];
    LAS unsigned char* lds = (LAS unsigned char*)lds_raw;
    const int tid0 = threadIdx.x, wg = blockIdx.x, G = gridDim.x;
#define PH_TID() int tid = threadIdx.x; asm volatile("" : "+v"(tid)); const int lane = tid & 63, wave = __builtin_amdgcn_readfirstlane(tid >> 6); (void)lane; (void)wave
    unsigned char* ws = args.ws;
    unsigned* ctl = (unsigned*)(ws + WS_CTL);
    for (int u = tid0; u < 256; u += NTHR) ((LAS unsigned*)(lds + LDSCTL_OFF))[u] = 0u;
    __syncthreads();
    const int lo = args.ph_lo, hi = args.ph_hi;
    XcdBarrier bar = xcd_barrier_post(ctl + CW_BAR, (volatile LAS unsigned*)(lds + LDSCTL_OFF));
#define IN(k) (lo <= (k) && (k) < hi)
#ifndef PROBE_PHASE
#define PROBE_PHASE -1
#endif
#define REPS(k) ((PROBE_PHASE == (k)) ? 2 : 1)
#define REPSEP(k) do { if (rep + 1 < REPS(k)) xcd_barrier(bar); } while (0)
#define SEAM(k) do { if (IN(k) && IN((k) + 1)) xcd_barrier(bar); } while (0)

    if (IN(0)) { for (int rep = 0; rep < REPS(0); ++rep) { PH_TID(); p0_prologue(args, lds, tid, lane, wave, wg, G);  REPSEP(0); } }
    SEAM(0);
    if (IN(1)) { for (int rep = 0; rep < REPS(1); ++rep) {
        pg8::DenseSched S; S.o.init(T_ / 256, NCOL / 256, G, wg); S.A = (const char*)(ws + WS_H1); S.Bt = (const char*)(ws + WS_W1T); S.K = DM;
        pg8::EpiProj E{(bf16*)(ws + WS_PROJ), NCOL, args.in[8], args.in[9]};
        { PH_TID(); p1_stagger_work(args, lds, lane, wave, wg); }
        asm volatile("s_waitcnt vmcnt(0) lgkmcnt(0)" ::: "memory"); __syncthreads();
        pg8::gemm_phase<pg8::EpiProj, pg8::DenseSched, true>(lds, DM, S, E);
     REPSEP(1); } }
    SEAM(1);
    if (IN(2)) { for (int rep = 0; rep < REPS(2); ++rep) { { PH_TID(); if (wg < NBATCH * 4 || PROBE_PHASE == 23) { ml::mlstm_item(args, lds, wg & 127, tid); } } __syncthreads(); { PH_TID(); p2_fast_attn(args, lds, tid, lane, wave, wg, G, rep); if (PROBE_PHASE == 21) { __syncthreads(); p2_fast_attn(args, lds, tid, lane, wave, wg, G, 1); } }  REPSEP(2); } }
    SEAM(2);
    if (IN(3)) { for (int rep = 0; rep < REPS(3); ++rep) {
        pg8::DenseSched S; S.o.init(T_ / 256, DM / 256, G, wg); S.A = (const char*)(ws + WS_MIX); S.Bt = (const char*)(ws + WS_W2T); S.K = DM;
        pg8::EpiBf16 E{(bf16*)(ws + WS_MO), DM};
        pg8::gemm_phase<pg8::EpiBf16, pg8::DenseSched, true>(lds, DM, S, E);
     REPSEP(3); } }
    SEAM(3);
    if (IN(4)) { for (int rep = 0; rep < REPS(4); ++rep) { PH_TID(); p4_router_mfma(args, lds, tid, lane, wave, wg, G);  REPSEP(4); } }
    SEAM(4);
    if (IN(6)) { for (int rep = 0; rep < REPS(6); ++rep) { PH_TID(); p6_gemm(args, lds, tid, wg, G);  REPSEP(6); } }
    SEAM(6);
    if (IN(7)) { for (int rep = 0; rep < REPS(7); ++rep) { PH_TID(); p7_gemm(args, lds, tid, wg, G);  REPSEP(7); } }
    SEAM(7);
    if (IN(8)) { PH_TID(); p8_combine(args, tid, wg, G); }
#undef IN
#undef SEAM
}

#ifndef MK_N_LAUNCHES
#define MK_N_LAUNCHES 1
#endif
extern "C" void kernel_launch(void* const* d_in, const int* in_sizes, int n_in, void* d_out, int out_size, void* d_ws, size_t ws_size, hipStream_t stream) {
    static int grid = 0;
    if (grid == 0) {
        if (n_in != 24 || in_sizes[0] != T_ * DM || out_size != T_ * DM || ws_size < WS_END) { fprintf(stderr, "kernel_launch: unexpected shapes (n_in %d, in0 %d, out %d, ws %zu); nothing launched\n", n_in, n_in > 0 ? in_sizes[0] : -1, out_size, ws_size); grid = -1; return; }
        int dev = 0, cus = 0, per_cu = 0;
        if (hipGetDevice(&dev) != hipSuccess || hipDeviceGetAttribute(&cus, hipDeviceAttributeMultiprocessorCount, dev) != hipSuccess) { grid = -1; return; }
        if (hipFuncSetAttribute((const void*)fwd, hipFuncAttributeMaxDynamicSharedMemorySize, LDS_BYTES) != hipSuccess) { fprintf(stderr, "kernel_launch: hipFuncSetAttribute failed\n"); grid = -1; return; }
        if (hipOccupancyMaxActiveBlocksPerMultiprocessor(&per_cu, (const void*)fwd, NTHR, LDS_BYTES) != hipSuccess || per_cu < 1) fprintf(stderr, "kernel_launch: occupancy query reports %d\n", per_cu);
        (void)hipGetLastError();
        grid = cus;
        if (grid != 256) { fprintf(stderr, "kernel_launch: built for 256 CUs, found %d; nothing launched\n", cus); grid = -1; return; }
    }
    if (grid < 0) return;
    if (hipMemsetAsync((char*)d_ws + WS_CTL, 0, CTL_ZERO_BYTES, stream) != hipSuccess) return;
    Args a{};
    for (int i = 0; i < 24; ++i) a.in[i] = (const float*)d_in[i];
    a.out = (float*)d_out; a.ws = (unsigned char*)d_ws;
    if (MK_N_LAUNCHES == 1) { a.ph_lo = 0; a.ph_hi = 9; hipLaunchKernelGGL(fwd, dim3(grid), dim3(NTHR), LDS_BYTES, stream, a); }
    else { for (int p = 0; p < 9; ++p) { a.ph_lo = p; a.ph_hi = p + 1; hipLaunchKernelGGL(fwd, dim3(grid), dim3(NTHR), LDS_BYTES, stream, a); } }
    const hipError_t le = hipPeekAtLastError();
    if (le != hipSuccess) fprintf(stderr, "kernel_launch: launch failed: %s\n", hipGetErrorName(le));
}
```

```cpp
#include <hip/hip_runtime.h>
#include <cstdio>
#include <cstdint>

#define GAS __attribute__((address_space(1)))
#define LAS __attribute__((address_space(3)))
typedef unsigned short bf16;
typedef unsigned u32x4 __attribute__((ext_vector_type(4)));
typedef unsigned u32x2 __attribute__((ext_vector_type(2)));
typedef float f32x4 __attribute__((ext_vector_type(4)));
typedef float f32x2 __attribute__((ext_vector_type(2)));
typedef short bf16x8 __attribute__((ext_vector_type(8)));

constexpr int T_ = 65536, DM = 1024, SEQ = 2048, NBATCH = 32, NCOL = 3584, INCOLS = 3592;
constexpr int C_MQ = 0, C_MK = 512, C_MV = 1024, C_MO = 1536, C_AQ = 2048, C_AK = 2560, C_AV = 3072;
constexpr int NEXP = 32, DEXP = 512, PMAX = 131072 + NEXP * 256;
constexpr float EPS = 1e-6f;
constexpr float LAMBDA_INIT = 0.2f;
constexpr int NWAVES = 8, NTHR = 512;

constexpr size_t MiB = 1u << 20;
constexpr size_t WS_CTL = 0, CTL_ZERO_BYTES = 64 * 1024;
constexpr size_t WS_W1T = 1 * MiB, WS_W2T = 8 * MiB, WS_WGU = 10 * MiB, WS_WD = 74 * MiB, WS_GATES = 106 * MiB;
constexpr size_t WS_ASGE = 108 * MiB, WS_ASGW = 109 * MiB, WS_ROWTOK = 110 * MiB, WS_ROWW = 111 * MiB;
constexpr size_t WS_H1 = 112 * MiB, WS_MIX = 240 * MiB, WS_PROJ = 368 * MiB, WS_END = 816 * MiB;
constexpr size_t WS_YBUF = 112 * MiB;
constexpr size_t WS_H2 = 384 * MiB, WS_HID = 512 * MiB;
constexpr size_t WS_MO = 112 * MiB;
constexpr size_t WS_X1F = 584 * MiB;
constexpr size_t WS_RIMG = 111 * MiB + 768 * 1024;
constexpr size_t WS_POSA = 108 * MiB + 512 * 1024;
constexpr int CW_BAR = 4096, CW_QUEUE = 8192, CW_CNT = 16384, CW_META = 32768;
constexpr int CW_CUR = 12288;
constexpr size_t WS_LIST = 700 * MiB; constexpr int LCAP = 2 * 65536;

constexpr int LDS_SCRATCH = 155648;
constexpr int LDSCTL_OFF = LDS_SCRATCH;
constexpr int LDS_BYTES = LDS_SCRATCH + 1024;

__device__ __forceinline__ unsigned f2bf(float f) { unsigned u = __builtin_bit_cast(unsigned, f); return (u + 0x7fffu + ((u >> 16) & 1u)) >> 16; }
__device__ __forceinline__ unsigned pk2(float lo, float hi) { return f2bf(lo) | (f2bf(hi) << 16); }
__device__ __forceinline__ float bf2f(bf16 v) { return __uint_as_float(((unsigned)v) << 16); }
__device__ __forceinline__ float bflo(unsigned u) { return __uint_as_float(u << 16); }
__device__ __forceinline__ float bfhi(unsigned u) { return __uint_as_float(u & 0xffff0000u); }
__device__ __forceinline__ float wave_sum(float v) {
#pragma unroll
    for (int o = 1; o < 64; o <<= 1) v += __shfl_xor(v, o);
    return v;
}
__device__ __forceinline__ float wave_max(float v) {
#pragma unroll
    for (int o = 1; o < 64; o <<= 1) v = fmaxf(v, __shfl_xor(v, o));
    return v;
}
__device__ __forceinline__ float sigmoidf_(float x) { return 1.f / (1.f + __expf(-x)); }
__device__ __forceinline__ float siluf_(float x) { return x / (1.f + __expf(-x)); }
__device__ __forceinline__ unsigned pk4_fp8(float a, float b, float c, float d) { int w = 0; w = __builtin_amdgcn_cvt_pk_fp8_f32(a, b, w, false); w = __builtin_amdgcn_cvt_pk_fp8_f32(c, d, w, true); return (unsigned)w; }
#define LDS_WAIT() asm volatile("s_waitcnt lgkmcnt(0)" ::: "memory")
#define VM_WAIT() asm volatile("s_waitcnt vmcnt(0)" ::: "memory")

namespace pg8 {
#define PG8_LAS __attribute__((address_space(3)))
constexpr int BM = 256, BK = 64, HALF = 128, HTB = HALF * BK * 2, STAGE_BYTES = 8 * HTB, NXCD = 8, WGM = 4;
__host__ __device__ __forceinline__ int lds_byte(int r, int c) { const int st = (r >> 4) * 2 + (c >> 5), rr = r & 15, cc = c & 31, ob = rr * 64 + cc * 2; return st * 1024 + (ob ^ (((ob >> 9) & 1) << 5)); }
__host__ __device__ __forceinline__ void stage_rc(int b, int& R, int& C) { const int st = b / 1024, sb = b % 1024, swz = sb ^ (((sb >> 9) & 1) << 5); R = (st >> 1) * 16 + swz / 64; C = (st & 1) * 32 + (swz % 64) / 2; }
__host__ __device__ __forceinline__ int perm32(int rho) { const int n = rho >> 4, i = rho & 15; return 8 * (i >> 2) + 4 * n + (i & 3); }

struct Unit { int pm, pn, e, li; };
struct TileOrder {
    int nM, nN, nwg, G, c;
    __device__ __forceinline__ void init(int nM_, int nN_, int G_, int c_) { nM = nM_; nN = nN_; nwg = nM * nN; G = G_; c = c_; }
    __device__ __forceinline__ bool map(int i, int& pm, int& pn) const {
        const long L = (long)i * G + c; if (L >= nwg) return false;
        int wgid = (int)L; { const int q = nwg / NXCD, r = nwg % NXCD, xcd = wgid % NXCD, off = wgid / NXCD; wgid = (xcd < r ? xcd * (q + 1) : r * (q + 1) + (xcd - r) * q) + off; }
        const int nig = WGM * nN, gid = wgid / nig, fm = gid * WGM, gsz = (nM - fm) < WGM ? (nM - fm) : WGM;
        pm = fm + ((wgid % nig) % gsz); pn = (wgid % nig) / gsz; return true;
    }
};
struct DenseSched {
    static constexpr bool GATHER = false;
    TileOrder o; const char* A; const char* Bt; int K;
    __device__ __forceinline__ bool next(int i, Unit& u) const { u.e = 0; u.li = i; return o.map(i, u.pm, u.pn); }
    __device__ __forceinline__ const char* a_base(const Unit& u) const { return A + (size_t)u.pm * BM * K * 2; }
    __device__ __forceinline__ const char* b_base(const Unit& u) const { return Bt + (size_t)u.pn * BM * K * 2; }
    __device__ __forceinline__ void a_voff(const Unit&, const int (&R)[2], const int (&C)[2], unsigned (&v)[2][2]) const {
#pragma unroll
        for (int h = 0; h < 2; ++h)
#pragma unroll
            for (int i = 0; i < 2; ++i) v[h][i] = (unsigned)((h * HALF + R[i]) * K + C[i]) * 2u;
    }
};

__device__ __forceinline__ unsigned cvt_pk_bf16(float lo, float hi) { unsigned r; asm volatile("v_cvt_pk_bf16_f32 %0, %1, %2" : "=v"(r) : "v"(lo), "v"(hi)); return r; }

struct EpiBf16 {
    static constexpr bool PERM = true;
    bf16* O; int ldc;
    __device__ __forceinline__ void operator()(const f32x4 (&acc)[2][2][4][2], const Unit& u, int wr, int wc, int fr, int fq) const {
        const int row0 = u.pm * BM + wr * 64 + fr, col0 = u.pn * BM + wc * 32 + 8 * fq;
#pragma unroll
        for (int ai = 0; ai < 2; ++ai)
#pragma unroll
            for (int m = 0; m < 4; ++m) { bf16* rowp = O + (size_t)(row0 + ai * HALF + m * 16) * ldc + col0;
#pragma unroll
                for (int bj = 0; bj < 2; ++bj) { const f32x4 v0 = acc[ai][bj][m][0], v1 = acc[ai][bj][m][1];
                    u32x4 w; w.x = cvt_pk_bf16(v0[0], v0[1]); w.y = cvt_pk_bf16(v0[2], v0[3]); w.z = cvt_pk_bf16(v1[0], v1[1]); w.w = cvt_pk_bf16(v1[2], v1[3]);
                    *(u32x4*)(rowp + bj * HALF) = w; } }
    }
};
struct EpiF8 {
    static constexpr bool PERM = true;
    unsigned char* O; int ldc;
    __device__ __forceinline__ void operator()(const f32x4 (&acc)[2][2][4][2], const Unit& u, int wr, int wc, int fr, int fq) const {
        const int row0 = u.pm * BM + wr * 64 + fr, col0 = u.pn * BM + wc * 32 + 8 * fq;
#pragma unroll
        for (int ai = 0; ai < 2; ++ai)
#pragma unroll
            for (int m = 0; m < 4; ++m) { unsigned char* rowp = O + (size_t)(row0 + ai * HALF + m * 16) * ldc + col0;
#pragma unroll
                for (int bj = 0; bj < 2; ++bj) { const f32x4 v0 = acc[ai][bj][m][0], v1 = acc[ai][bj][m][1];
                    u32x2 w; w.x = pk4_fp8(v0[0], v0[1], v0[2], v0[3]); w.y = pk4_fp8(v1[0], v1[1], v1[2], v1[3]);
                    *(u32x2*)(rowp + bj * HALF) = w; } }
    }
};
struct EpiProj {
    static constexpr bool PERM = true;
    bf16* O; int ldc; const float* qw; const float* kw;
    __device__ __forceinline__ void operator()(const f32x4 (&acc)[2][2][4][2], const Unit& u, int wr, int wc, int fr, int fq) const {
        const int row0 = u.pm * BM + wr * 64 + fr;
        if (u.pn >= 8 && u.pn < 12) {
            const float* wsrc = (u.pn < 10) ? qw : kw; const float post = (u.pn < 10) ? 0.18033688011112042f : 1.0f;
            f32x4 wv[2][2];
#pragma unroll
            for (int bj = 0; bj < 2; ++bj)
#pragma unroll
                for (int n = 0; n < 2; ++n) wv[bj][n] = *(const f32x4*)(wsrc + 32 * bj + 8 * fq + 4 * n) * post;
            const int col0 = u.pn * BM + wc * 64 + 8 * fq;
#pragma unroll
            for (int ai = 0; ai < 2; ++ai)
#pragma unroll
                for (int m = 0; m < 4; ++m) {
                    float ss = 0.f;
#pragma unroll
                    for (int bj = 0; bj < 2; ++bj)
#pragma unroll
                        for (int n = 0; n < 2; ++n) { const f32x4 x = acc[ai][bj][m][n]; ss += (x[0] * x[0] + x[1] * x[1]) + (x[2] * x[2] + x[3] * x[3]); }
                    ss += __shfl_xor(ss, 16); ss += __shfl_xor(ss, 32);
                    const float r = rsqrtf(ss * (1.f / 64.f) + 1e-6f);
                    bf16* rowp = O + (size_t)(row0 + ai * HALF + m * 16) * ldc + col0;
#pragma unroll
                    for (int bj = 0; bj < 2; ++bj) { const f32x4 v0 = acc[ai][bj][m][0] * r * wv[bj][0], v1 = acc[ai][bj][m][1] * r * wv[bj][1];
                        u32x4 w; w.x = cvt_pk_bf16(v0[0], v0[1]); w.y = cvt_pk_bf16(v0[2], v0[3]); w.z = cvt_pk_bf16(v1[0], v1[1]); w.w = cvt_pk_bf16(v1[2], v1[3]);
                        *(u32x4*)(rowp + bj * 32) = w; } }
        } else {
            const int col0 = u.pn * BM + wc * 32 + 8 * fq; const bool sig = (u.pn == 6 || u.pn == 7);
#pragma unroll
            for (int ai = 0; ai < 2; ++ai)
#pragma unroll
                for (int m = 0; m < 4; ++m) { bf16* rowp = O + (size_t)(row0 + ai * HALF + m * 16) * ldc + col0;
#pragma unroll
                    for (int bj = 0; bj < 2; ++bj) { f32x4 v0 = acc[ai][bj][m][0], v1 = acc[ai][bj][m][1];
                        if (sig) {
#pragma unroll
                            for (int j = 0; j < 4; ++j) { v0[j] = __builtin_amdgcn_rcpf(1.f + __builtin_amdgcn_exp2f(v0[j] * -1.4426950408889634f)); v1[j] = __builtin_amdgcn_rcpf(1.f + __builtin_amdgcn_exp2f(v1[j] * -1.4426950408889634f)); } }
                        u32x4 w; w.x = cvt_pk_bf16(v0[0], v0[1]); w.y = cvt_pk_bf16(v0[2], v0[3]); w.z = cvt_pk_bf16(v1[0], v1[1]); w.w = cvt_pk_bf16(v1[2], v1[3]);
                        *(u32x4*)(rowp + bj * HALF) = w; } }
        }
    }
};
struct EpiResF32 {
    static constexpr bool PERM = true;
    const float* X; float* O; int ldc; bf16* OB;
    __device__ __forceinline__ void operator()(const f32x4 (&acc)[2][2][4][2], const Unit& u, int wr, int wc, int fr, int fq) const {
        const int row0 = u.pm * BM + wr * 64 + fr, col0 = u.pn * BM + wc * 32 + 8 * fq;
#pragma unroll
        for (int ai = 0; ai < 2; ++ai) {
            f32x4 xv[4][2][2];
#pragma unroll
            for (int m = 0; m < 4; ++m) { const size_t off = (size_t)(row0 + ai * HALF + m * 16) * ldc + col0;
#pragma unroll
                for (int bj = 0; bj < 2; ++bj) { xv[m][bj][0] = *(const f32x4*)(X + off + bj * HALF); xv[m][bj][1] = *(const f32x4*)(X + off + bj * HALF + 4); } }
#pragma unroll
            for (int m = 0; m < 4; ++m) { const size_t off = (size_t)(row0 + ai * HALF + m * 16) * ldc + col0;
#pragma unroll
                for (int bj = 0; bj < 2; ++bj) {
                    const f32x4 r0 = xv[m][bj][0] + acc[ai][bj][m][0], r1 = xv[m][bj][1] + acc[ai][bj][m][1];
                    *(f32x4*)(O + off + bj * HALF) = r0; *(f32x4*)(O + off + bj * HALF + 4) = r1;
                    u32x4 w; w.x = cvt_pk_bf16(r0[0], r0[1]); w.y = cvt_pk_bf16(r0[2], r0[3]); w.z = cvt_pk_bf16(r1[0], r1[1]); w.w = cvt_pk_bf16(r1[2], r1[3]);
                    *(u32x4*)(OB + off + bj * HALF) = w; } }
            asm volatile("" ::: "memory");
        }
    }
};

__device__ __forceinline__ int expert_of_row_l(const PG8_LAS int* pst, int row) {
    const int lane = (int)__builtin_amdgcn_mbcnt_hi(~0u, __builtin_amdgcn_mbcnt_lo(~0u, 0u));
    const bool hit = (lane >= 1 && lane < 32) ? (pst[lane & 31] <= row) : false;
    return __builtin_popcountll(__ballot(hit)); }
struct MoeGuSched {
    static constexpr bool GATHER = true;
    TileOrder o; const char* A; const char* Bt; const int* rowtok; const PG8_LAS int* pst; int K; const PG8_LAS int* ltok;
    __device__ __forceinline__ bool next(int i, Unit& u) const { u.li = i; if (!o.map(i, u.pm, u.pn)) return false; u.e = expert_of_row_l(pst, u.pm * BM); return true; }
    __device__ __forceinline__ const char* a_base(const Unit&) const { return A; }
    __device__ __forceinline__ const char* b_base(const Unit& u) const { return Bt + ((size_t)u.e * 1024 + (size_t)u.pn * BM) * K * 2; }
    __device__ __forceinline__ void a_voff(const Unit& u, const int (&R)[2], const int (&C)[2], unsigned (&v)[2][2]) const {
#pragma unroll
        for (int h = 0; h < 2; ++h)
#pragma unroll
            for (int i = 0; i < 2; ++i) { const int tk = ltok[u.li * BM + h * HALF + R[i]]; const unsigned tok = tk < 0 ? 0u : (unsigned)(tk >> 1); v[h][i] = (tok * (unsigned)K + (unsigned)C[i]) * 2u; }
    }
};
struct MoeDownSched {
    static constexpr bool GATHER = false;
    TileOrder o; const char* A; const char* Bt; const PG8_LAS int* pst; int K;
    __device__ __forceinline__ bool next(int i, Unit& u) const { u.li = i; if (!o.map(i, u.pm, u.pn)) return false; u.e = expert_of_row_l(pst, u.pm * BM); return true; }
    __device__ __forceinline__ const char* a_base(const Unit& u) const { return A + (size_t)u.pm * BM * K * 2; }
    __device__ __forceinline__ const char* b_base(const Unit& u) const { return Bt + ((size_t)u.e * 1024 + (size_t)u.pn * BM) * K * 2; }
    __device__ __forceinline__ void a_voff(const Unit&, const int (&R)[2], const int (&C)[2], unsigned (&v)[2][2]) const {
#pragma unroll
        for (int h = 0; h < 2; ++h)
#pragma unroll
            for (int i = 0; i < 2; ++i) v[h][i] = (unsigned)((h * HALF + R[i]) * K + C[i]) * 2u;
    }
};
struct EpiSwiglu {
    static constexpr bool PERM = true;
    bf16* O; const PG8_LAS float* rowr;
    __device__ __forceinline__ void operator()(const f32x4 (&acc)[2][2][4][2], const Unit& u, int wr, int wc, int fr, int fq) const {
        const int row0 = u.pm * BM + wr * 64 + fr, col0 = u.pn * HALF + wc * 32 + 8 * fq;
#pragma unroll
        for (int ai = 0; ai < 2; ++ai)
#pragma unroll
            for (int m = 0; m < 4; ++m) { unsigned char* rowp = (unsigned char*)O + (size_t)(row0 + ai * HALF + m * 16) * 512 + col0;
                 const float rs = rowr[u.li * BM + wr * 64 + fr + ai * HALF + m * 16];
                float hv[8];
#pragma unroll
                for (int n = 0; n < 2; ++n)
#pragma unroll
                    for (int j = 0; j < 4; ++j) { const float g = acc[ai][0][m][n][j] * rs, up = acc[ai][1][m][n][j] * rs; hv[n * 4 + j] = g * up * __builtin_amdgcn_rcpf(1.f + __expf(-g)); }
                u32x2 w; w.x = pk4_fp8(hv[0], hv[1], hv[2], hv[3]); w.y = pk4_fp8(hv[4], hv[5], hv[6], hv[7]);
                *(u32x2*)rowp = w; }
    }
};
struct EpiDown {
    static constexpr bool PERM = true;
    bf16* Y; const int* rowtok; const float* roww;
    __device__ __forceinline__ void operator()(const f32x4 (&acc)[2][2][4][2], const Unit& u, int wr, int wc, int fr, int fq) const {
        const int row0 = u.pm * BM + wr * 64 + fr, col0 = u.pn * BM + wc * 32 + 8 * fq;
#pragma unroll
        for (int ai = 0; ai < 2; ++ai)
#pragma unroll
            for (int m = 0; m < 4; ++m) { const int pos = row0 + ai * HALF + m * 16; const int tk = rowtok[pos]; const float w = roww[pos];
                if (tk >= 0) { bf16* rowp = Y + ((size_t)(tk & 1) * 65536 + (size_t)(tk >> 1)) * 1024 + col0;
#pragma unroll
                    for (int bj = 0; bj < 2; ++bj) { const f32x4 v0 = acc[ai][bj][m][0] * w, v1 = acc[ai][bj][m][1] * w;
                        u32x4 o; o.x = cvt_pk_bf16(v0[0], v0[1]); o.y = cvt_pk_bf16(v0[2], v0[3]); o.z = cvt_pk_bf16(v1[0], v1[1]); o.w = cvt_pk_bf16(v1[2], v1[3]);
                        *(u32x4*)(rowp + bj * HALF) = o; } } }
    }
};

typedef int i32x4v __attribute__((ext_vector_type(4)));
typedef int i32x8v __attribute__((ext_vector_type(8)));
template <class Epi, class Sched, bool ALIGN_EPI = true, bool F8 = false>
__device__ __forceinline__ void gemm_phase(PG8_LAS unsigned char* lds, const int K, const Sched& S, const Epi& E) {
    int tid = threadIdx.x; asm volatile("" : "+v"(tid));
    const int wid = __builtin_amdgcn_readfirstlane(tid >> 6), lane = tid & 63, wr = wid >> 2, wc = wid & 3, fr = lane & 15, fq = lane >> 4;
    const int nt = K / BK;
    int Rr[2], Cc[2]; unsigned voffB[2];
#pragma unroll
    for (int i = 0; i < 2; ++i) { int R, C; stage_rc(tid * 16 + i * 8192, R, C); const int Rb = Epi::PERM ? ((R & ~31) + perm32(R & 31)) : R;
        Rr[i] = R; Cc[i] = C; voffB[i] = (unsigned)(Rb * K + C) * 2u; }
    const size_t kstep = (size_t)(BK * 2);
    const size_t hstep = (size_t)HALF * K * 2;
    const unsigned ldsw = (unsigned)wid * 1024u;
    const int aoff = lds_byte(wr * 64 + fr, fq * 8), boff = lds_byte(wc * 32 + fr, fq * 8);
#define PG8_SA(b, h) (((b) * 2 + (h)) * HTB)
#define PG8_SB(b, h) ((4 + (b) * 2 + (h)) * HTB)
#define PG8_STAGE(bufoff, gbase, voff) do { _Pragma("unroll") for (int _i = 0; _i < 2; ++_i) \
        __builtin_amdgcn_global_load_lds((const unsigned*)((const char*)(gbase) + (voff)[_i]), (PG8_LAS unsigned*)(lds + (bufoff) + ldsw + _i * 8192), 16, 0, 0); } while (0)
#define PG8_CAT(x0, x1) __builtin_shufflevector(__builtin_bit_cast(i32x4v, x0), __builtin_bit_cast(i32x4v, x1), 0, 1, 2, 3, 4, 5, 6, 7)
#define PG8_LDA(dst, b, h) do { if constexpr (F8) { _Pragma("unroll") for (int m = 0; m < 4; ++m) dst##8[m] = PG8_CAT(*(const PG8_LAS bf16x8*)(lds + PG8_SA(b, h) + aoff + m * 2048), *(const PG8_LAS bf16x8*)(lds + PG8_SA(b, h) + aoff + m * 2048 + 1024)); } \
        else { _Pragma("unroll") for (int m = 0; m < 4; ++m) _Pragma("unroll") for (int k = 0; k < 2; ++k) dst[m][k] = *(const PG8_LAS bf16x8*)(lds + PG8_SA(b, h) + aoff + m * 2048 + k * 1024); } } while (0)
#define PG8_LDB(dst, b, h) do { if constexpr (F8) { _Pragma("unroll") for (int n = 0; n < 2; ++n) dst##8[n] = PG8_CAT(*(const PG8_LAS bf16x8*)(lds + PG8_SB(b, h) + boff + n * 2048), *(const PG8_LAS bf16x8*)(lds + PG8_SB(b, h) + boff + n * 2048 + 1024)); } \
        else { _Pragma("unroll") for (int n = 0; n < 2; ++n) _Pragma("unroll") for (int k = 0; k < 2; ++k) dst[n][k] = *(const PG8_LAS bf16x8*)(lds + PG8_SB(b, h) + boff + n * 2048 + k * 1024); } } while (0)
#define PG8_MMA(ai, bj, At, Bt) do { __builtin_amdgcn_s_setprio(1); \
        if constexpr (F8) { __builtin_amdgcn_sched_barrier(0); _Pragma("unroll") for (int m = 0; m < 4; ++m) _Pragma("unroll") for (int n = 0; n < 2; ++n) \
            asm volatile("v_mfma_scale_f32_16x16x128_f8f6f4 %0, %1, %2, %0, %3, %3 op_sel_hi:[0,0,0]" : "+v"(acc[ai][bj][m][n]) : "v"(Bt##8[n]), "v"(At##8[m]), "v"(f8scale)); __builtin_amdgcn_sched_barrier(0); } \
        else { _Pragma("unroll") for (int m = 0; m < 4; ++m) _Pragma("unroll") for (int n = 0; n < 2; ++n) _Pragma("unroll") for (int k = 0; k < 2; ++k) \
            acc[ai][bj][m][n] = __builtin_amdgcn_mfma_f32_16x16x32_bf16(Bt[n][k], At[m][k], acc[ai][bj][m][n], 0, 0, 0); } \
        __builtin_amdgcn_s_setprio(0); } while (0)
#define PG8_WAIT_V(n) asm volatile("s_waitcnt vmcnt(" #n ")" ::: "memory")
#define PG8_WAIT_L(n) asm volatile("s_waitcnt lgkmcnt(" #n ")" ::: "memory")
#define PG8_BAR __builtin_amdgcn_s_barrier()
#define PG8_SCHED __builtin_amdgcn_sched_barrier(0)
    Unit cur, nxt; int ui = 0;
    if (!S.next(0, cur)) return;
    f32x4 acc[2][2][4][2];
#pragma unroll
    for (int a = 0; a < 2; ++a)
#pragma unroll
        for (int b = 0; b < 2; ++b)
#pragma unroll
            for (int m = 0; m < 4; ++m)
#pragma unroll
                for (int n = 0; n < 2; ++n) acc[a][b][m][n] = (f32x4){0.f, 0.f, 0.f, 0.f};
    bf16x8 At[4][2], B0[2][2], B1[2][2];
    i32x8v At8[4], B08[2], B18[2]; const int f8scale = 127;
    unsigned cv[2][2], nv[2][2];
    S.a_voff(cur, Rr, Cc, cv);
#pragma unroll
    for (int h = 0; h < 2; ++h)
#pragma unroll
        for (int i = 0; i < 2; ++i) nv[h][i] = cv[h][i];
    const char* cA = S.a_base(cur); const char* cB = S.b_base(cur);
    PG8_STAGE(PG8_SB(0, 0), cB, voffB); PG8_STAGE(PG8_SB(0, 1), cB + hstep, voffB); PG8_STAGE(PG8_SA(0, 0), cA, cv[0]); PG8_STAGE(PG8_SA(0, 1), cA, cv[1]);
    if (wr == 1) PG8_BAR;
    PG8_WAIT_V(2); PG8_BAR;
    PG8_STAGE(PG8_SB(1, 0), cB + kstep, voffB); PG8_STAGE(PG8_SA(1, 0), cA + kstep, cv[0]); PG8_STAGE(PG8_SB(1, 1), cB + hstep + kstep, voffB);
    PG8_WAIT_V(6); PG8_BAR;
    for (;;) {
        const bool has_next = S.next(ui + 1, nxt);
        const char* nA = has_next ? S.a_base(nxt) : cA; const char* nB = has_next ? S.b_base(nxt) : cB;
#pragma unroll 1
        for (int t = 0; t < nt; t += 2) {
            const bool last = (t == nt - 2);
            const char* a1 = cA + (size_t)(t + 1) * kstep;
            const char* a2 = last ? nA : cA + (size_t)(t + 2) * kstep; const char* b2 = last ? nB : cB + (size_t)(t + 2) * kstep;
            const char* a3 = a2 + kstep; const char* b3 = b2 + kstep;
            unsigned v2[2][2];
            if constexpr (Sched::GATHER) {
                if (last && has_next) { S.a_voff(nxt, Rr, Cc, nv); }
#pragma unroll
                for (int h = 0; h < 2; ++h)
#pragma unroll
                    for (int i = 0; i < 2; ++i) v2[h][i] = last ? nv[h][i] : cv[h][i];
            } else {
#pragma unroll
                for (int h = 0; h < 2; ++h)
#pragma unroll
                    for (int i = 0; i < 2; ++i) v2[h][i] = cv[h][i];
            }
            PG8_LDB(B0, 0, 0); PG8_LDB(B1, 0, 1); PG8_SCHED; PG8_LDA(At, 0, 0); PG8_STAGE(PG8_SA(1, 1), a1, cv[1]);
            PG8_WAIT_V(8); PG8_WAIT_L(0); PG8_BAR; PG8_MMA(0, 0, At, B0); PG8_MMA(0, 1, At, B1); PG8_BAR; PG8_SCHED;
            PG8_LDA(At, 0, 1); PG8_STAGE(PG8_SB(0, 0), b2, voffB); PG8_STAGE(PG8_SB(0, 1), b2 + hstep, voffB); PG8_STAGE(PG8_SA(0, 0), a2, v2[0]);
            PG8_WAIT_V(8); PG8_WAIT_L(0); PG8_BAR; PG8_MMA(1, 0, At, B0); PG8_MMA(1, 1, At, B1); PG8_BAR; PG8_SCHED;
            PG8_LDB(B0, 1, 0); PG8_LDB(B1, 1, 1); PG8_SCHED; PG8_LDA(At, 1, 0); PG8_STAGE(PG8_SA(0, 1), a2, v2[1]);
            PG8_WAIT_V(8); PG8_WAIT_L(0); PG8_BAR; PG8_MMA(0, 0, At, B0); PG8_MMA(0, 1, At, B1); PG8_BAR; PG8_SCHED;
            PG8_LDA(At, 1, 1); PG8_STAGE(PG8_SB(1, 0), b3, voffB); PG8_STAGE(PG8_SB(1, 1), b3 + hstep, voffB); PG8_STAGE(PG8_SA(1, 0), a3, v2[0]);
            PG8_WAIT_V(8); PG8_WAIT_L(0); PG8_BAR; PG8_MMA(1, 0, At, B0); PG8_MMA(1, 1, At, B1); PG8_BAR; PG8_SCHED;
        }
        if constexpr (ALIGN_EPI) { if (wr == 0) PG8_BAR; }
        if constexpr (F8) { asm volatile("s_nop 15\n\ts_nop 15" ::: "memory"); }
        E(acc, cur, wr, wc, fr, fq);
        if (!has_next) break;
#pragma unroll
        for (int a = 0; a < 2; ++a)
#pragma unroll
            for (int b = 0; b < 2; ++b)
#pragma unroll
                for (int m = 0; m < 4; ++m)
#pragma unroll
                    for (int n = 0; n < 2; ++n) acc[a][b][m][n] = (f32x4){0.f, 0.f, 0.f, 0.f};
        cur = nxt; cA = nA; cB = nB; ++ui;
#pragma unroll
        for (int h = 0; h < 2; ++h)
#pragma unroll
            for (int i = 0; i < 2; ++i) cv[h][i] = nv[h][i];
        if constexpr (ALIGN_EPI) { if (wr == 1) PG8_BAR; }
    }
    PG8_WAIT_V(0);
    if constexpr (!ALIGN_EPI) { if (wr == 0) PG8_BAR; }
    PG8_BAR;
#undef PG8_SA
#undef PG8_SB
#undef PG8_STAGE
#undef PG8_LDA
#undef PG8_LDB
#undef PG8_MMA
#undef PG8_CAT
#undef PG8_WAIT_V
#undef PG8_WAIT_L
#undef PG8_BAR
#undef PG8_SCHED
}
}

#define XB_TMO      128
#define XB_XCNT(j)  (256  + 64 * (j))
#define XB_XSUB(j)  (1280 + 64 * (j))
#define XB_XGEN(j)  (2304 + 64 * (j))
#define XB_TOP      3328
#define XB_TOPGEN   3392
#define XCD_BAR_WORDS 3456
#define XB_SPIN_CAP (1u << 22)

__device__ __forceinline__ unsigned xb_ld(unsigned* p)              { return __hip_atomic_load(p, __ATOMIC_RELAXED, __HIP_MEMORY_SCOPE_AGENT); }
__device__ __forceinline__ unsigned xb_add(unsigned* p, unsigned v) { return __hip_atomic_fetch_add(p, v, __ATOMIC_RELAXED, __HIP_MEMORY_SCOPE_AGENT); }
__device__ __forceinline__ unsigned xb_xcc_id() { return (unsigned)__builtin_amdgcn_s_getreg((3 << 11) | 20) & 0xFu; }
#define XB_SPIN(cond, bar) do { unsigned _sp = 0; while (cond) { __builtin_amdgcn_s_sleep(1); \
    if ((++_sp & 255u) == 0u) { if (xb_ld(&(bar)[XB_TMO])) break; if (_sp > XB_SPIN_CAP) { atomicAdd(&(bar)[XB_TMO], 1u); break; } } } } while (0)

struct XcdBarrier { unsigned* bar; unsigned x; volatile LAS unsigned* st; };

__device__ __forceinline__ XcdBarrier xcd_barrier_post(unsigned* bar, volatile LAS unsigned* st) {
    XcdBarrier b; b.bar = bar; b.x = xb_xcc_id(); b.st = st;
    if (threadIdx.x == 0) (void)xb_add(&bar[XB_XCNT(b.x)], 1u);
    return b;
}
__device__ __forceinline__ void xcd_barrier_complete(unsigned* bar, unsigned x, unsigned& nloc, unsigned& nx) {
    const unsigned G = gridDim.x * gridDim.y * gridDim.z;
    unsigned sum, cnt, mine, sp = 0u;
    for (;;) {
        sum = 0u; cnt = 0u; mine = 0u;
#pragma unroll
        for (unsigned j = 0; j < 16; ++j) { const unsigned c = xb_ld(&bar[XB_XCNT(j)]); sum += c; cnt += (c > 0u) ? 1u : 0u; mine = (j == x) ? c : mine; }
        if (sum == G) break;
        __builtin_amdgcn_s_sleep(1);
        if ((++sp & 255u) == 0u) { if (xb_ld(&bar[XB_TMO])) break; if (sp > XB_SPIN_CAP) { atomicAdd(&bar[XB_TMO], 1u); break; } }
    }
    nloc = mine > 0u ? mine : 1u; nx = cnt > 0u ? cnt : 1u;
}
__device__ __forceinline__ void xcd_barrier(const XcdBarrier& b) {
    asm volatile("s_waitcnt vmcnt(0)" ::: "memory");
    __syncthreads();
    if (threadIdx.x == 0) {
        unsigned* bar = b.bar;
        __builtin_amdgcn_s_waitcnt(0);
        unsigned nloc = b.st[0], nx = b.st[1];
        if (nloc == 0u) { xcd_barrier_complete(bar, b.x, nloc, nx); b.st[0] = nloc; b.st[1] = nx; }
        const unsigned old = xb_add(&bar[XB_XSUB(b.x)], 1u);
        const unsigned gen = old / nloc;
        if (old + 1u == (gen + 1u) * nloc) {
            __builtin_amdgcn_fence(__ATOMIC_RELEASE, "agent");
            asm volatile("s_waitcnt vmcnt(0)" ::: "memory");
            const unsigned og = xb_add(&bar[XB_TOP], 1u);
            const unsigned tg = og / nx;
            if (og + 1u == (tg + 1u) * nx) xb_add(&bar[XB_TOPGEN], 1u);
            else XB_SPIN(xb_ld(&bar[XB_TOPGEN]) == tg, bar);
            __builtin_amdgcn_fence(__ATOMIC_ACQUIRE, "agent");
            xb_add(&bar[XB_XGEN(b.x)], 1u);
            asm volatile("s_waitcnt vmcnt(0)" ::: "memory");
        } else {
            XB_SPIN(xb_ld(&bar[XB_XGEN(b.x)]) == gen, bar);
            __builtin_amdgcn_fence(__ATOMIC_ACQUIRE, "agent");
            asm volatile("s_waitcnt vmcnt(0)" ::: "memory");
        }
    }
    __syncthreads();
}

struct Args {
    const float* in[24];
    float* out;
    unsigned char* ws;
    int ph_lo, ph_hi;
};

struct TrItem { const float* src; int ldsrc, k0, n0s; bf16* dst; int ldd, drow0; const float* kscale; int f8; };
__device__ __forceinline__ void tr_load(const TrItem& t, f32x4 (&v)[8], int lane) {
#pragma unroll
    for (int i = 0; i < 8; ++i) v[i] = *(const f32x4*)(t.src + (size_t)(t.k0 + (lane >> 3) + 8 * i) * t.ldsrc + t.n0s + 4 * (lane & 7));
}
__device__ __forceinline__ void tr_finish(const TrItem& t, const f32x4 (&v)[8], LAS float* scr, int lane) {
#pragma unroll
    for (int i = 0; i < 8; ++i) { const int kk = (lane >> 3) + 8 * i; f32x4 x = v[i]; if (t.kscale) x = x * t.kscale[t.k0 + kk];
        LAS float* d = scr + kk * 33 + 4 * (lane & 7); d[0] = x.x; d[1] = x.y; d[2] = x.z; d[3] = x.w; }
    LDS_WAIT();
    const int c = lane & 7;
#pragma unroll
    for (int j = 0; j < 4; ++j) { const int n = (lane >> 3) + 8 * j; const LAS float* s = scr + (8 * c) * 33 + n;
        if (t.f8) { u32x2 o; o.x = pk4_fp8(s[0 * 33], s[1 * 33], s[2 * 33], s[3 * 33]); o.y = pk4_fp8(s[4 * 33], s[5 * 33], s[6 * 33], s[7 * 33]);
            *(u32x2*)((unsigned char*)t.dst + (size_t)(t.drow0 + n) * t.ldd + t.k0 + 8 * c) = o; }
        else { u32x4 o; o.x = pk2(s[0 * 33], s[1 * 33]); o.y = pk2(s[2 * 33], s[3 * 33]); o.z = pk2(s[4 * 33], s[5 * 33]); o.w = pk2(s[6 * 33], s[7 * 33]);
            *(u32x4*)(t.dst + (size_t)(t.drow0 + n) * t.ldd + t.k0 + 8 * c) = o; } }
    LDS_WAIT();
}

__device__ __forceinline__ void p0_prologue(const Args& a, LAS unsigned char* lds, int tid, int lane, int wave, int wg, int G) {
    unsigned char* ws = a.ws;
    const float* x = a.in[0]; const float* norm1_w = a.in[1]; const float* w_in = a.in[2]; const float* b_ig = a.in[3]; const float* b_fg = a.in[4];
    const float* w_out = a.in[15]; const float* w_gate = a.in[21]; const float* w_up = a.in[22]; const float* w_down = a.in[23];
    bf16* W1T = (bf16*)(ws + WS_W1T); bf16* W2T = (bf16*)(ws + WS_W2T); bf16* WGU = (bf16*)(ws + WS_WGU); bf16* WD = (bf16*)(ws + WS_WD);
    bf16* H1 = (bf16*)(ws + WS_H1); float* GATES = (float*)(ws + WS_GATES);
    LAS float* scr = (LAS float*)(lds + wave * 8448);
    LAS float* gwl = (LAS float*)(lds + 73728);
    {
        float gv[16];
#pragma unroll
        for (int q = 0; q < 16; ++q) { const int idx = tid + NTHR * q; gv[q] = w_in[(size_t)(idx >> 3) * INCOLS + 2048 + (idx & 7)]; }
#pragma unroll
        for (int q = 0; q < 16; ++q) gwl[tid + NTHR * q] = gv[q];
    }
    {
        const float* norm2_w = a.in[16]; const float* w_group = a.in[17]; const float* w_expert = a.in[19]; unsigned char* RIMG = ws + WS_RIMG;
        const int idx = wg * NTHR + tid;
        if (idx < 36864) { int k, c; float v;
            if (idx < 4096) { k = idx >> 2; c = idx & 3; v = w_group[idx]; } else { const int j = idx - 4096; k = j >> 5; c = 4 + (j & 31); v = w_expert[j]; }
            v *= norm2_w[k];
            const unsigned hi = f2bf(v), lo = f2bf(v - __uint_as_float(hi << 16));
            *(bf16*)(RIMG + c * 2064 + k * 2) = (bf16)hi; *(bf16*)(RIMG + 36 * 2064 + c * 2064 + k * 2) = (bf16)lo; }
    }
    __syncthreads();
    const int gw = wg * NWAVES + wave, NGW = G * NWAVES;
    constexpr int I_1 = 16 * 112, I_2 = 16 * 32, I_GU = NEXP * 16 * 32, NITEMS = I_1 + I_2 + I_GU;
    auto item_desc = [&](int it) -> TrItem {
        int r = it;
        if (r < I_1) { const int kb = r / 112, nb = r % 112, n0 = nb * 32; int sc_ = n0;
            if (n0 >= 2048 && n0 < 3072) { const int p0 = n0 & 255; sc_ = (n0 & ~255) + 64 * ((p0 >> 5) & 3) + 32 * (p0 >> 7); }
            return TrItem{w_in, INCOLS, kb * 64, sc_ < 2048 ? sc_ : sc_ + 8, W1T, 1024, n0, nullptr, 0}; } r -= I_1;
        if (r < I_2) { const int kb = r / 32, nb = r % 32; return TrItem{w_out, 1024, kb * 64, nb * 32, W2T, 1024, nb * 32, nullptr, 0}; } r -= I_2;
        { const int e = r / 512, q = r % 512, kb = q / 32, nb = q % 32, j0 = nb * 32, pn = j0 >> 8, rr = j0 & 255;
            const float* s_ = (rr < 128 ? w_gate : w_up) + (size_t)e * 1024 * 512;
            return TrItem{s_, 512, kb * 64, pn * 128 + (rr & 127), (bf16*)((unsigned char*)WGU + (size_t)e * 1024 * 1024), 1024, j0, a.in[16], 1}; }
    };
    if (gw < NITEMS) {
        TrItem cur = item_desc(gw); f32x4 tv[8]; tr_load(cur, tv, lane);
#pragma unroll 1
        for (int it = gw; it < NITEMS; it += NGW) {
            f32x4 cv_[8];
#pragma unroll
            for (int i = 0; i < 8; ++i) cv_[i] = tv[i];
            const TrItem me = cur;
            if (it + NGW < NITEMS) { cur = item_desc(it + NGW); tr_load(cur, tv, lane); }
            tr_finish(me, cv_, scr, lane);
        }
    }
    f32x4 w1v[4];
#pragma unroll
    for (int j = 0; j < 4; ++j) w1v[j] = ((const f32x4*)norm1_w)[lane + 64 * j];
    f32x4 nx[4], nx2[4];
#pragma unroll
    for (int j = 0; j < 4; ++j) { nx[j] = ((const f32x4*)(x + (size_t)gw * DM))[lane + 64 * j]; nx2[j] = ((const f32x4*)(x + (size_t)(gw + NGW) * DM))[lane + 64 * j]; }
    const int gc = ((lane >> 5) & 1) * 4 + ((lane >> 4) & 1) * 2 + ((lane >> 3) & 1), gh = gc & 3;
    const float gbias = (gc < 4) ? b_ig[gh] : b_fg[gh];
#pragma unroll 1
    for (int m = gw; m < T_; m += NGW) {
        f32x4 v[4]; float ss = 0.f;
#pragma unroll
        for (int j = 0; j < 4; ++j) { v[j] = nx[j]; nx[j] = nx2[j]; ss += (v[j].x * v[j].x + v[j].y * v[j].y) + (v[j].z * v[j].z + v[j].w * v[j].w); }
        if (m + 2 * NGW < T_) {
#pragma unroll
            for (int j = 0; j < 4; ++j) nx2[j] = ((const f32x4*)(x + (size_t)(m + 2 * NGW) * DM))[lane + 64 * j]; }
        const float r = rsqrtf(wave_sum(ss) * (1.f / DM) + EPS);
        float g[8];
#pragma unroll
        for (int c = 0; c < 8; ++c) g[c] = 0.f;
        u32x2* o8 = (u32x2*)(H1 + (size_t)m * DM) + lane;
#pragma unroll
        for (int j = 0; j < 4; ++j) {
            const f32x4 hv = v[j] * r * w1v[j];
            u32x2 o; o.x = pk2(hv.x, hv.y); o.y = pk2(hv.z, hv.w); o8[64 * j] = o;
#pragma unroll
            for (int i = 0; i < 4; ++i) { const int k = 256 * j + 4 * lane + i; const f32x4 ga = *(const LAS f32x4*)(gwl + k * 8), gb = *(const LAS f32x4*)(gwl + k * 8 + 4);
                const float hh = hv[i];
                g[0] += hh * ga.x; g[1] += hh * ga.y; g[2] += hh * ga.z; g[3] += hh * ga.w; g[4] += hh * gb.x; g[5] += hh * gb.y; g[6] += hh * gb.z; g[7] += hh * gb.w; }
        }
        float k4[4], k2[2], k1;
        { const bool up = (lane & 32) != 0;
#pragma unroll
          for (int i = 0; i < 4; ++i) { const float send = up ? g[i] : g[i + 4]; const float recv = __shfl_xor(send, 32); k4[i] = (up ? g[i + 4] : g[i]) + recv; } }
        { const bool up = (lane & 16) != 0;
#pragma unroll
          for (int i = 0; i < 2; ++i) { const float send = up ? k4[i] : k4[i + 2]; const float recv = __shfl_xor(send, 16); k2[i] = (up ? k4[i + 2] : k4[i]) + recv; } }
        { const bool up = (lane & 8) != 0; const float send = up ? k2[0] : k2[1]; const float recv = __shfl_xor(send, 8); k1 = (up ? k2[1] : k2[0]) + recv; }
        k1 += __shfl_xor(k1, 4); k1 += __shfl_xor(k1, 2); k1 += __shfl_xor(k1, 1);
        if ((lane & 7) == 0) {
            float res = k1 + gbias;
            if (gc >= 4) res = fminf(res, 0.f) - log1pf(__expf(-fabsf(res)));
            GATES[(size_t)m * 8 + gc] = res;
        }
    }
}

__device__ __forceinline__ void p1_stagger_work(const Args& a, LAS unsigned char* lds, int lane, int wave, int wg) {
    const int g = wg & 3; if (g == 0) return;
    const float* w_down = a.in[23]; bf16* WD = (bf16*)(a.ws + WS_WD);
    constexpr int NIT = NEXP * 8 * 32;
    const int lo = (g == 1) ? 0 : (g == 2) ? NIT / 6 : NIT / 2, hi = (g == 1) ? NIT / 6 : (g == 2) ? NIT / 2 : NIT;
    LAS float* scr = (LAS float*)(lds + wave * 8448);
    const int gw = (wg >> 2) * NWAVES + wave, NGW = 64 * NWAVES;
    auto desc = [&](int r) -> TrItem { const int e = r / 256, q = r % 256, kb = q / 32, nb = q % 32;
        return TrItem{w_down + (size_t)e * 512 * 1024, 1024, kb * 64, nb * 32, (bf16*)((unsigned char*)WD + (size_t)e * 1024 * 512), 512, nb * 32, nullptr, 1}; };
    if (lo + gw < hi) {
        TrItem cur = desc(lo + gw); f32x4 tv[8]; tr_load(cur, tv, lane);
#pragma unroll 1
        for (int it = lo + gw; it < hi; it += NGW) {
            f32x4 cv_[8];
#pragma unroll
            for (int i = 0; i < 8; ++i) cv_[i] = tv[i];
            const TrItem me = cur;
            if (it + NGW < hi) { cur = desc(it + NGW); tr_load(cur, tv, lane); }
            tr_finish(me, cv_, scr, lane);
        }
    }
}

__device__ __forceinline__ void mlstm_naive(const Args& a, LAS unsigned char* lds, int item, int tid, int lane, int wave) {
    unsigned char* ws = a.ws;
    const bf16* PROJ = (const bf16*)(ws + WS_PROJ); const float* GATES = (const float*)(ws + WS_GATES); bf16* MIX = (bf16*)(ws + WS_MIX);
    const float* conv_w = a.in[5]; const float* conv_b = a.in[6]; const float* m_norm_w = a.in[7];
    LAS float* qs = (LAS float*)lds; LAS float* ks = qs + 8192; LAS float* vs = ks + 8192; LAS float* hb = vs + 8192;
    LAS float* red = hb + 8192; LAS float* dred = red + 1024; LAS float* igs = dred + 16; LAS float* lfs = igs + 64;
    const int b = item >> 2, h = item & 3, e = tid & 127, dq = tid >> 7;
    float Cr[32], nr[32];
#pragma unroll
    for (int j = 0; j < 32; ++j) { Cr[j] = 0.f; nr[j] = 0.f; }
    float m = 0.f;
    const float mw0 = m_norm_w[lane], mw1 = m_norm_w[lane + 64];
    for (int c = 0; c < SEQ / 64; ++c) {
        const int t0 = c * 64;
        for (int idx = tid; idx < 8192; idx += NTHR) {
            const int tt = idx >> 7, d = idx & 127, t = t0 + tt, colq = C_MQ + h * 128 + d, colk = C_MK + h * 128 + d;
            float aq = conv_b[colq], ak = conv_b[colk];
#pragma unroll
            for (int j = 0; j < 4; ++j) { const int ts = t - 3 + j; if (ts >= 0) { const bf16* row = PROJ + (size_t)(b * SEQ + ts) * NCOL; aq += bf2f(row[colq]) * conv_w[j * 1024 + colq]; ak += bf2f(row[colk]) * conv_w[j * 1024 + colk]; } }
            qs[idx] = siluf_(aq); ks[idx] = siluf_(ak) * 0.08838834764831845f;
            vs[idx] = bf2f(PROJ[(size_t)(b * SEQ + t) * NCOL + C_MV + h * 128 + d]);
        }
        if (tid < 64) { igs[tid] = GATES[(size_t)(b * SEQ + t0 + tid) * 8 + h]; lfs[tid] = GATES[(size_t)(b * SEQ + t0 + tid) * 8 + 4 + h]; }
        __syncthreads();
        for (int tt = 0; tt < 64; ++tt) {
            const float lf = lfs[tt], ig = igs[tt];
            const float mnew = fmaxf(lf + m, ig), fd = __expf(lf + m - mnew), iw = __expf(ig - mnew); m = mnew;
            const float ve = vs[tt * 128 + e] * iw;
            float num = 0.f, den = 0.f;
#pragma unroll
            for (int j = 0; j < 32; ++j) { const int d = dq * 32 + j; const float kd = ks[tt * 128 + d], qd = qs[tt * 128 + d];
                Cr[j] = fd * Cr[j] + kd * ve; nr[j] = fd * nr[j] + iw * kd; num += qd * Cr[j]; den += qd * nr[j]; }
            const int p = tt & 1;
            red[(p * 4 + dq) * 128 + e] = num; if (e == 0) dred[p * 4 + dq] = den;
            __syncthreads();
            if (dq == 0) { const float ntot = (red[(p * 4 + 0) * 128 + e] + red[(p * 4 + 1) * 128 + e]) + (red[(p * 4 + 2) * 128 + e] + red[(p * 4 + 3) * 128 + e]);
                const float dtot = (dred[p * 4 + 0] + dred[p * 4 + 1]) + (dred[p * 4 + 2] + dred[p * 4 + 3]);
                hb[tt * 128 + e] = ntot / fmaxf(fabsf(dtot), __expf(-mnew)); }
        }
        __syncthreads();
#pragma unroll 1
        for (int rr = 0; rr < 8; ++rr) {
            const int tt = wave * 8 + rr, t = t0 + tt; const bf16* rowp = PROJ + (size_t)(b * SEQ + t) * NCOL + C_MO + h * 128;
            const float y0 = hb[tt * 128 + lane] * sigmoidf_(bf2f(rowp[lane])), y1 = hb[tt * 128 + lane + 64] * sigmoidf_(bf2f(rowp[lane + 64]));
            const float r = rsqrtf(wave_sum(y0 * y0 + y1 * y1) * (1.f / 128.f) + EPS);
            bf16* orow = MIX + (size_t)(b * SEQ + t) * DM + h * 128;
            orow[lane] = (bf16)f2bf(y0 * r * mw0); orow[lane + 64] = (bf16)f2bf(y1 * r * mw1);
        }
        __syncthreads();
    }
}

__device__ __forceinline__ void attn_naive_row(const Args& a, LAS float* sc, LAS float* qsl, int ridx, int lane, float lam) {
    unsigned char* ws = a.ws;
    const bf16* PROJ = (const bf16*)(ws + WS_PROJ); bf16* MIX = (bf16*)(ws + WS_MIX);
    const float* qnw = a.in[8]; const float* knw = a.in[9]; const float* anw = a.in[14];
    const int h = ridx & 3, bt = ridx >> 2, t = bt & (SEQ - 1), b = bt >> 11;
    {
        const unsigned u = *(const unsigned*)(PROJ + (size_t)bt * NCOL + C_AQ + h * 128 + 2 * lane);
        const float q0 = bflo(u), q1 = bfhi(u); float ss = q0 * q0 + q1 * q1;
#pragma unroll
        for (int o = 1; o < 32; o <<= 1) ss += __shfl_xor(ss, o);
        const float rq = rsqrtf(ss * (1.f / 64.f) + EPS) * 0.125f; const int dd = (2 * lane) & 63;
        qsl[2 * lane] = q0 * rq * qnw[dd] * knw[dd]; qsl[2 * lane + 1] = q1 * rq * qnw[dd + 1] * knw[dd + 1];
    }
    LDS_WAIT();
    const int nk = ((t >> 6) + 1) * 64;
    float m0 = -1e30f, m1 = -1e30f;
    for (int j = lane; j < nk; j += 64) {
        const u32x4* krow = (const u32x4*)(PROJ + (size_t)(b * SEQ + j) * NCOL + C_AK + h * 128);
        float s0 = 0.f, ss0 = 0.f, s1 = 0.f, ss1 = 0.f;
#pragma unroll
        for (int q = 0; q < 8; ++q) { const u32x4 kv = krow[q]; const f32x4 qa = *(const LAS f32x4*)(qsl + q * 8), qb = *(const LAS f32x4*)(qsl + q * 8 + 4);
            const float k0 = bflo(kv.x), k1 = bfhi(kv.x), k2 = bflo(kv.y), k3 = bfhi(kv.y), k4 = bflo(kv.z), k5 = bfhi(kv.z), k6 = bflo(kv.w), k7 = bfhi(kv.w);
            s0 += qa.x * k0 + qa.y * k1 + qa.z * k2 + qa.w * k3 + qb.x * k4 + qb.y * k5 + qb.z * k6 + qb.w * k7;
            ss0 += k0 * k0 + k1 * k1 + k2 * k2 + k3 * k3 + k4 * k4 + k5 * k5 + k6 * k6 + k7 * k7; }
#pragma unroll
        for (int q = 8; q < 16; ++q) { const u32x4 kv = krow[q]; const f32x4 qa = *(const LAS f32x4*)(qsl + q * 8), qb = *(const LAS f32x4*)(qsl + q * 8 + 4);
            const float k0 = bflo(kv.x), k1 = bfhi(kv.x), k2 = bflo(kv.y), k3 = bfhi(kv.y), k4 = bflo(kv.z), k5 = bfhi(kv.z), k6 = bflo(kv.w), k7 = bfhi(kv.w);
            s1 += qa.x * k0 + qa.y * k1 + qa.z * k2 + qa.w * k3 + qb.x * k4 + qb.y * k5 + qb.z * k6 + qb.w * k7;
            ss1 += k0 * k0 + k1 * k1 + k2 * k2 + k3 * k3 + k4 * k4 + k5 * k5 + k6 * k6 + k7 * k7; }
        s0 *= rsqrtf(ss0 * (1.f / 64.f) + EPS); s1 *= rsqrtf(ss1 * (1.f / 64.f) + EPS);
        sc[j] = s0; sc[2048 + j] = s1; m0 = fmaxf(m0, s0); m1 = fmaxf(m1, s1);
    }
    m0 = wave_max(m0); m1 = wave_max(m1);
    float l0 = 0.f, l1 = 0.f;
    for (int j = lane; j < nk; j += 64) { const float e0 = __expf(sc[j] - m0), e1 = __expf(sc[2048 + j] - m1); sc[j] = e0; sc[2048 + j] = e1; l0 += e0; l1 += e1; }
    l0 = wave_sum(l0); l1 = wave_sum(l1);
    const float c0 = 1.f / l0, c1 = lam / l1;
    LDS_WAIT();
    float o0 = 0.f, o1 = 0.f;
    const bf16* vb = PROJ + (size_t)(b * SEQ) * NCOL + C_AV + h * 128 + 2 * lane;
    for (int j = 0; j < nk; ++j) { const float p = sc[j] * c0 - sc[2048 + j] * c1; const unsigned u = *(const unsigned*)(vb + (size_t)j * NCOL); o0 += p * bflo(u); o1 += p * bfhi(u); }
    const float r = rsqrtf(wave_sum(o0 * o0 + o1 * o1) * (1.f / 128.f) + EPS) * (1.f - LAMBDA_INIT);
    *(unsigned*)(MIX + (size_t)bt * DM + 512 + h * 128 + 2 * lane) = pk2(o0 * r * anw[2 * lane], o1 * r * anw[2 * lane + 1]);
    LDS_WAIT();
}

__device__ __forceinline__ void p2_naive(const Args& a, LAS unsigned char* lds, int tid, int lane, int wave, int wg, int G) {
    if (wg < NBATCH * 4) mlstm_naive(a, lds, wg, tid, lane, wave);
    __syncthreads();
    const float* lq1 = a.in[10]; const float* lk1 = a.in[11]; const float* lq2 = a.in[12]; const float* lk2 = a.in[13];
    const float lam = __expf(wave_sum(lq1[lane] * lk1[lane])) - __expf(wave_sum(lq2[lane] * lk2[lane])) + LAMBDA_INIT;
    LAS float* sc = (LAS float*)(lds + wave * 16896); LAS float* qsl = sc + 4096;
    unsigned* queue = (unsigned*)(a.ws + WS_CTL) + CW_QUEUE;
    constexpr int NUNITS = T_ * 4 / 8;
    for (;;) {
        unsigned u = 0; if (lane == 0) u = __hip_atomic_fetch_add(queue, 1u, __ATOMIC_RELAXED, __HIP_MEMORY_SCOPE_AGENT);
        u = (unsigned)__builtin_amdgcn_readfirstlane((int)u);
        if (u >= (unsigned)NUNITS) break;
        const int base = (NUNITS - 1 - (int)u) * 8;
        for (int k = 0; k < 8; ++k) attn_naive_row(a, sc, qsl, base + k, lane, lam);
    }
}


namespace ml {
constexpr int QL = 0, KL = 17408, KWT = 34816, VT = 53248, SD = 71680, AV = 80896, MV = 89088, WV = 97280, IT = 105472, FL = 113664;
constexpr int MC = 121856, BEND = 121984, AMAX = 122112, DEC = 122240, NL = 122368, RS = 122880, QN = 123392, PSQ = 123648;
constexpr int QS = 272, TS = 144;
constexpr float L2E = 1.4426950408889634f;
#define LBAR() do { asm volatile("s_waitcnt lgkmcnt(0)" ::: "memory"); __builtin_amdgcn_s_barrier(); asm volatile("" ::: "memory"); } while (0)
__device__ __forceinline__ f32x4 mfma16(bf16x8 a, bf16x8 b, f32x4 c) { return __builtin_amdgcn_mfma_f32_16x16x32_bf16(a, b, c, 0, 0, 0); }
__device__ __forceinline__ unsigned cvtpk(float lo, float hi) { unsigned r; asm volatile("v_cvt_pk_bf16_f32 %0, %1, %2" : "=v"(r) : "v"(lo), "v"(hi)); return r; }
__device__ __forceinline__ unsigned cvtpk_nv(float lo, float hi) { unsigned r; asm("v_cvt_pk_bf16_f32 %0, %1, %2" : "=v"(r) : "v"(lo), "v"(hi)); return r; }
__device__ __forceinline__ f32x2 silu2(f32x2 o) { f32x2 e = o * (-L2E); e.x = __builtin_amdgcn_exp2f(e.x); e.y = __builtin_amdgcn_exp2f(e.y); e = e + 1.0f; e.x = __builtin_amdgcn_rcpf(e.x); e.y = __builtin_amdgcn_rcpf(e.y); return o * e; }

__device__ __forceinline__ void mlstm_item(const Args& a, LAS unsigned char* lds, const int item, const int tid) {
    unsigned char* ws = a.ws;
    const bf16* PROJ = (const bf16*)(ws + WS_PROJ); const float* GATES = (const float*)(ws + WS_GATES); bf16* MIX = (bf16*)(ws + WS_MIX);
    const float* conv_w = a.in[5]; const float* conv_b = a.in[6]; const float* m_norm_w = a.in[7];
    const int wid = __builtin_amdgcn_readfirstlane(tid >> 6), lane = tid & 63, fr = lane & 15, fq = lane >> 4;
    const int b = item >> 2, h = item & 3, e0 = 16 * wid;
    LAS float* AVl = (LAS float*)(lds + AV); LAS float* MVl = (LAS float*)(lds + MV); LAS float* WVl = (LAS float*)(lds + WV); LAS float* ITl = (LAS float*)(lds + IT); LAS float* FLl = (LAS float*)(lds + FL);
    LAS float* MCl = (LAS float*)(lds + MC); LAS float* BENDl = (LAS float*)(lds + BEND); LAS float* AMAXl = (LAS float*)(lds + AMAX); LAS float* DECl = (LAS float*)(lds + DEC);
    LAS float* NLl = (LAS float*)(lds + NL); LAS float* RSl = (LAS float*)(lds + RS); LAS float* QNl = (LAS float*)(lds + QN); LAS float* PSQl = (LAS float*)(lds + PSQ);
#pragma unroll 1
    for (int cc = 0; cc < 4; ++cc) {
        const int c = 4 * wid + cc, t = 64 * c + lane; const float* g = GATES + (size_t)(b * SEQ + t) * 8;
        float bs = g[4 + h]; const float ig = g[h];
#pragma unroll
        for (int o = 1; o < 64; o <<= 1) { const float v = __shfl_up(bs, o); if (lane >= o) bs += v; }
        const float av = ig - bs; float pm = av;
#pragma unroll
        for (int o = 1; o < 64; o <<= 1) { const float v = __shfl_up(pm, o); if (lane >= o) pm = fmaxf(pm, v); }
        AVl[t] = av; MVl[t] = pm; FLl[t] = bs;
        if (lane == 63) { BENDl[c] = bs; AMAXl[c] = pm; }
    }
    if (tid < 128) NLl[tid] = 0.f;
    __syncthreads();
    if (tid == 0) { float m = 0.f; for (int c = 0; c < 32; ++c) { MCl[c] = m; m = BENDl[c] + fmaxf(m, AMAXl[c]); } }
    __syncthreads();
    {
        float av_[4], pm_[4], bs_[4], m63_[4], mc_[4];
#pragma unroll
        for (int k = 0; k < 4; ++k) { const int t = tid + NTHR * k, c = t >> 6; av_[k] = AVl[t]; pm_[k] = MVl[t]; bs_[k] = FLl[t]; mc_[k] = MCl[c]; m63_[k] = fmaxf(mc_[k], MVl[64 * c + 63]); }
        __syncthreads();
#pragma unroll
        for (int k = 0; k < 4; ++k) { const int t = tid + NTHR * k; const float M = fmaxf(mc_[k], pm_[k]);
            AVl[t] = av_[k] * L2E; MVl[t] = M * L2E; WVl[t] = __expf(av_[k] - m63_[k]); ITl[t] = __expf(mc_[k] - M); FLl[t] = __expf(-(bs_[k] + M)); }
        if (tid < 32) DECl[tid] = __expf(MCl[tid] - fmaxf(MCl[tid], AMAXl[tid]));
    }
    __syncthreads();
    const int isk = wid >> 2, r0 = (wid & 3) * 16;
    const int ccol = (isk ? C_MK : C_MQ) + h * 128 + 2 * lane;
    f32x2 cw2[4], cb2;
#pragma unroll
    for (int j = 0; j < 4; ++j) { cw2[j].x = conv_w[j * 1024 + ccol]; cw2[j].y = conv_w[j * 1024 + ccol + 1]; }
    cb2.x = conv_b[ccol]; cb2.y = conv_b[ccol + 1];
    const bf16* qkbase = PROJ + (size_t)(b * SEQ) * NCOL + ccol;
    const bf16* vbase = PROJ + (size_t)(b * SEQ) * NCOL + C_MV + h * 128 + 2 * lane;
    const bf16* obase = PROJ + (size_t)(b * SEQ) * NCOL + C_MO + h * 128 + e0 + 4 * fq;
    const f32x4 mw = *(const f32x4*)(m_norm_w + e0 + 4 * fq);
    unsigned raw[19], vraw[8];
#define ML_LOADS(c_) do { _Pragma("unroll") for (int i = 0; i < 19; ++i) { const int t = 64 * (c_) + r0 - 3 + i; raw[i] = (t >= 0) ? *(const unsigned*)(qkbase + (size_t)(t < 0 ? 0 : t) * NCOL) : 0u; } \
        _Pragma("unroll") for (int i = 0; i < 8; ++i) vraw[i] = *(const unsigned*)(vbase + (size_t)(64 * (c_) + 8 * wid + i) * NCOL); } while (0)
    ML_LOADS(0);
    f32x4 Cacc[8];
#pragma unroll
    for (int i = 0; i < 8; ++i) Cacc[i] = (f32x4){0.f, 0.f, 0.f, 0.f};
#pragma unroll 1
    for (int c = 0; c < SEQ / 64; ++c) {
        {
            f32x2 xx[19];
#pragma unroll
            for (int i = 0; i < 19; ++i) { xx[i].x = bflo(raw[i]); xx[i].y = bfhi(raw[i]); }
            f32x2 oo[16], ee[16];
#pragma unroll
            for (int i = 0; i < 16; ++i) oo[i] = xx[i] * cw2[0] + cb2;
#pragma unroll
            for (int j = 1; j < 4; ++j)
#pragma unroll
                for (int i = 0; i < 16; ++i) oo[i] = xx[i + j] * cw2[j] + oo[i];
#pragma unroll
            for (int i = 0; i < 16; ++i) ee[i] = oo[i] * (-L2E);
#pragma unroll
            for (int i = 0; i < 16; ++i) { ee[i].x = __builtin_amdgcn_exp2f(ee[i].x); ee[i].y = __builtin_amdgcn_exp2f(ee[i].y); }
#pragma unroll
            for (int i = 0; i < 16; ++i) ee[i] = ee[i] + 1.0f;
#pragma unroll
            for (int i = 0; i < 16; ++i) { ee[i].x = __builtin_amdgcn_rcpf(ee[i].x); ee[i].y = __builtin_amdgcn_rcpf(ee[i].y); }
            if (!isk) {
#pragma unroll
                for (int i = 0; i < 16; ++i) oo[i] = oo[i] * ee[i];
#pragma unroll
                for (int i = 0; i < 16; ++i) *(LAS unsigned*)(lds + QL + (r0 + i) * QS + 4 * lane) = cvtpk_nv(oo[i].x, oo[i].y);
            } else {
                f32x2 kv[16];
#pragma unroll
                for (int i = 0; i < 16; ++i) kv[i] = oo[i] * ee[i] * 0.08838834764831845f;
#pragma unroll
                for (int i = 0; i < 16; ++i) *(LAS unsigned*)(lds + KL + (r0 + i) * QS + 4 * lane) = cvtpk_nv(kv[i].x, kv[i].y);
                u32x4 k0a, k0b, k1a, k1b;
#pragma unroll
                for (int q = 0; q < 4; ++q) { const f32x4 w4 = *(const LAS f32x4*)(WVl + 64 * c + r0 + 4 * q);
                    const f32x2 e0_ = kv[4 * q] * w4.x, e1_ = kv[4 * q + 1] * w4.y, e2_ = kv[4 * q + 2] * w4.z, e3_ = kv[4 * q + 3] * w4.w;
                    const unsigned a0 = cvtpk(e0_.x, e1_.x), a1 = cvtpk(e2_.x, e3_.x), b0 = cvtpk(e0_.y, e1_.y), b1 = cvtpk(e2_.y, e3_.y);
                    if (q == 0) { k0a.x = a0; k0a.y = a1; k1a.x = b0; k1a.y = b1; } else if (q == 1) { k0a.z = a0; k0a.w = a1; k1a.z = b0; k1a.w = b1; }
                    else if (q == 2) { k0b.x = a0; k0b.y = a1; k1b.x = b0; k1b.y = b1; } else { k0b.z = a0; k0b.w = a1; k1b.z = b0; k1b.w = b1; } }
                *(LAS u32x4*)(lds + KWT + (2 * lane) * TS + r0 * 2) = k0a; *(LAS u32x4*)(lds + KWT + (2 * lane) * TS + r0 * 2 + 16) = k0b;
                *(LAS u32x4*)(lds + KWT + (2 * lane + 1) * TS + r0 * 2) = k1a; *(LAS u32x4*)(lds + KWT + (2 * lane + 1) * TS + r0 * 2 + 16) = k1b;
            }
            u32x4 v0, v1;
            v0.x = (vraw[0] & 0xffffu) | (vraw[1] << 16); v0.y = (vraw[2] & 0xffffu) | (vraw[3] << 16); v0.z = (vraw[4] & 0xffffu) | (vraw[5] << 16); v0.w = (vraw[6] & 0xffffu) | (vraw[7] << 16);
            v1.x = (vraw[0] >> 16) | (vraw[1] & 0xffff0000u); v1.y = (vraw[2] >> 16) | (vraw[3] & 0xffff0000u); v1.z = (vraw[4] >> 16) | (vraw[5] & 0xffff0000u); v1.w = (vraw[6] >> 16) | (vraw[7] & 0xffff0000u);
            *(LAS u32x4*)(lds + VT + (2 * lane) * TS + 16 * wid) = v0;
            *(LAS u32x4*)(lds + VT + (2 * lane + 1) * TS + 16 * wid) = v1;
        }
        if (c + 1 < SEQ / 64) ML_LOADS(c + 1);
        u32x2 og[4];
#pragma unroll
        for (int ti = 0; ti < 4; ++ti) og[ti] = *(const u32x2*)(obase + (size_t)(64 * c + 16 * ti + fr) * NCOL);
        LBAR();
        {
            const int ti = wid >> 1, half = wid & 1; float rsum = 0.f;
            const float Mt = MVl[64 * c + 16 * ti + fr];
#pragma unroll
            for (int sx = 0; sx < 2; ++sx) {
                const int si = 2 * half + sx; f32x4 acc = (f32x4){0.f, 0.f, 0.f, 0.f};
                if (si <= ti) {
#pragma unroll
                    for (int kb = 0; kb < 4; ++kb) {
                        const bf16x8 kf = *(const LAS bf16x8*)(lds + KL + (16 * si + fr) * QS + (32 * kb + 8 * fq) * 2);
                        const bf16x8 qf = *(const LAS bf16x8*)(lds + QL + (16 * ti + fr) * QS + (32 * kb + 8 * fq) * 2);
                        acc = mfma16(kf, qf, acc); }
                    const f32x4 av = *(const LAS f32x4*)(AVl + 64 * c + 16 * si + 4 * fq);
#pragma unroll
                    for (int j = 0; j < 4; ++j) { const int s = 16 * si + 4 * fq + j, t = 16 * ti + fr; const float dd = (s <= t) ? __builtin_amdgcn_exp2f(av[j] - Mt) : 0.f; acc[j] *= dd; rsum += acc[j]; }
                }
                u32x2 o; o.x = cvtpk(acc[0], acc[1]); o.y = cvtpk(acc[2], acc[3]);
                *(LAS u32x2*)(lds + SD + (16 * ti + fr) * TS + (16 * si + 4 * fq) * 2) = o;
            }
            rsum += __shfl_xor(rsum, 16); rsum += __shfl_xor(rsum, 32);
            if (fq == 0) RSl[(16 * ti + fr) * 2 + half] = rsum;
        }
        {
            const int t = tid >> 3, part = tid & 7;
            const u32x4 qa = *(const LAS u32x4*)(lds + QL + t * QS + part * 32), qb = *(const LAS u32x4*)(lds + QL + t * QS + part * 32 + 16);
            const f32x4 n0 = *(const LAS f32x4*)(NLl + 16 * part), n1 = *(const LAS f32x4*)(NLl + 16 * part + 4), n2 = *(const LAS f32x4*)(NLl + 16 * part + 8), n3 = *(const LAS f32x4*)(NLl + 16 * part + 12);
            float s = bflo(qa.x) * n0.x + bfhi(qa.x) * n0.y + bflo(qa.y) * n0.z + bfhi(qa.y) * n0.w + bflo(qa.z) * n1.x + bfhi(qa.z) * n1.y + bflo(qa.w) * n1.z + bfhi(qa.w) * n1.w
                    + bflo(qb.x) * n2.x + bfhi(qb.x) * n2.y + bflo(qb.y) * n2.z + bfhi(qb.y) * n2.w + bflo(qb.z) * n3.x + bfhi(qb.z) * n3.y + bflo(qb.w) * n3.z + bfhi(qb.w) * n3.w;
            s += __shfl_xor(s, 1); s += __shfl_xor(s, 2); s += __shfl_xor(s, 4);
            if (part == 0) QNl[t] = s;
        }
        LBAR();
        f32x4 hacc[4]; float inter[4];
        {
            bf16x8 cf[4];
#pragma unroll
            for (int kb = 0; kb < 4; ++kb) { u32x4 w; w.x = cvtpk(Cacc[2 * kb][0], Cacc[2 * kb][1]); w.y = cvtpk(Cacc[2 * kb][2], Cacc[2 * kb][3]); w.z = cvtpk(Cacc[2 * kb + 1][0], Cacc[2 * kb + 1][1]); w.w = cvtpk(Cacc[2 * kb + 1][2], Cacc[2 * kb + 1][3]);
                cf[kb] = __builtin_bit_cast(bf16x8, w); }
#pragma unroll
            for (int ti = 0; ti < 4; ++ti) {
                hacc[ti] = (f32x4){0.f, 0.f, 0.f, 0.f};
#pragma unroll
                for (int kb = 0; kb < 4; ++kb) {
                    const u32x2 lo = *(const LAS u32x2*)(lds + QL + (16 * ti + fr) * QS + (32 * kb + 4 * fq) * 2), hi = *(const LAS u32x2*)(lds + QL + (16 * ti + fr) * QS + (32 * kb + 16 + 4 * fq) * 2);
                    const u32x4 qq = (u32x4){lo.x, lo.y, hi.x, hi.y};
                    hacc[ti] = mfma16(cf[kb], __builtin_bit_cast(bf16x8, qq), hacc[ti]); }
                inter[ti] = ITl[64 * c + 16 * ti + fr];
                hacc[ti] = hacc[ti] * inter[ti];
            }
        }
        {
            bf16x8 vf[2];
#pragma unroll
            for (int ks = 0; ks < 2; ++ks) vf[ks] = *(const LAS bf16x8*)(lds + VT + (e0 + fr) * TS + (32 * ks + 8 * fq) * 2);
#pragma unroll
            for (int ti = 0; ti < 4; ++ti)
#pragma unroll
                for (int ks = 0; ks < 2; ++ks) if (ks == 0 || ti >= 2) {
                    const bf16x8 sf = *(const LAS bf16x8*)(lds + SD + (16 * ti + fr) * TS + (32 * ks + 8 * fq) * 2);
                    hacc[ti] = mfma16(vf[ks], sf, hacc[ti]); }
            const float decay = DECl[c];
            float nsum = 0.f;
#pragma unroll
            for (int i = 0; i < 8; ++i) {
                Cacc[i] = Cacc[i] * decay;
#pragma unroll
                for (int ks = 0; ks < 2; ++ks) {
                    const bf16x8 kwf = *(const LAS bf16x8*)(lds + KWT + (16 * i + fr) * TS + (32 * ks + 8 * fq) * 2);
                    Cacc[i] = mfma16(kwf, vf[ks], Cacc[i]); }
            }
#pragma unroll
            for (int ks = 0; ks < 2; ++ks) {
                const u32x4 kk = *(const LAS u32x4*)(lds + KWT + (16 * wid + fr) * TS + (32 * ks + 8 * fq) * 2);
                nsum += (bflo(kk.x) + bfhi(kk.x)) + (bflo(kk.y) + bfhi(kk.y)) + (bflo(kk.z) + bfhi(kk.z)) + (bflo(kk.w) + bfhi(kk.w)); }
            nsum += __shfl_xor(nsum, 16); nsum += __shfl_xor(nsum, 32);
            if (fq == 0) NLl[16 * wid + fr] = decay * NLl[16 * wid + fr] + nsum;
        }
        f32x4 hm[4];
#pragma unroll
        for (int ti = 0; ti < 4; ++ti) {
            const int t = 16 * ti + fr;
            const float den = RSl[2 * t] + RSl[2 * t + 1] + inter[ti] * QNl[t];
            const float rd = __builtin_amdgcn_rcpf(fmaxf(fabsf(den), FLl[64 * c + t]));
            const f32x4 gg = (f32x4){bflo(og[ti].x), bfhi(og[ti].x), bflo(og[ti].y), bfhi(og[ti].y)};
            hm[ti] = hacc[ti] * gg * rd;
            float psq = (hm[ti][0] * hm[ti][0] + hm[ti][1] * hm[ti][1]) + (hm[ti][2] * hm[ti][2] + hm[ti][3] * hm[ti][3]);
            psq += __shfl_xor(psq, 16); psq += __shfl_xor(psq, 32);
            if (fq == 0) PSQl[t * 8 + wid] = psq;
        }
        LBAR();
#pragma unroll
        for (int ti = 0; ti < 4; ++ti) {
            const int t = 16 * ti + fr;
            const f32x4 p0 = *(const LAS f32x4*)(PSQl + t * 8), p1 = *(const LAS f32x4*)(PSQl + t * 8 + 4);
            const float r = rsqrtf(((p0.x + p0.y) + (p0.z + p0.w) + (p1.x + p1.y) + (p1.z + p1.w)) * (1.f / 128.f) + EPS);
            const f32x4 ov = hm[ti] * mw * r;
            u32x2 o; o.x = cvtpk(ov[0], ov[1]); o.y = cvtpk(ov[2], ov[3]);
            *(u32x2*)(MIX + (size_t)(b * SEQ + 64 * c + t) * DM + h * 128 + e0 + 4 * fq) = o;
        }
    }
#undef ML_LOADS
}
}

namespace att {
using s16x4  = __attribute__((ext_vector_type(4))) short;
using f32x16 = __attribute__((ext_vector_type(16))) float;
constexpr int SHM_V = 16384, SHM_K = 16384;
constexpr float THR2 = 11.5415603f;
#define KSWZ(row, colB) ((row) * 256 + ((colB) ^ (((row) & 7) << 4)))
#define SBAR() __builtin_amdgcn_sched_barrier(0)
__device__ __forceinline__ int crow(int r, int hi) { return (r & 3) + 8 * (r >> 2) + 4 * hi; }
__device__ __forceinline__ unsigned cvtpk(float lo, float hi) { unsigned r; asm volatile("v_cvt_pk_bf16_f32 %0, %1, %2" : "=v"(r) : "v"(lo), "v"(hi)); return r; }
__device__ __forceinline__ void partialSM(f32x16& p0, f32x16& p1, float& m_reg, float& mn, float& alpha) {
  float pmax = p0[0];
#pragma unroll
  for (int r = 1; r < 16; ++r) pmax = fmaxf(pmax, p0[r]);
#pragma unroll
  for (int r = 0; r < 16; ++r) pmax = fmaxf(pmax, p1[r]);
  { auto rr = __builtin_amdgcn_permlane32_swap(__float_as_uint(pmax), __float_as_uint(pmax), false, false);
    pmax = fmaxf(__uint_as_float(rr[0]), __uint_as_float(rr[1])); }
  if (__builtin_expect(__all(pmax - m_reg <= THR2), 1)) { mn = m_reg; alpha = 1.f; }
  else { mn = fmaxf(m_reg, pmax); alpha = __builtin_amdgcn_exp2f(m_reg - mn); m_reg = mn; }
#pragma unroll
  for (int r = 0; r < 16; ++r) p0[r] = p0[r] - mn;
#pragma unroll
  for (int r = 0; r < 16; ++r) p1[r] = p1[r] - mn;
#pragma unroll
  for (int r = 0; r < 16; ++r) p0[r] = __builtin_amdgcn_exp2f(p0[r]);
}
__device__ __forceinline__ void finishSM(f32x16& p0, f32x16& p1, float alpha, float& l_reg, bf16x8& pa0, bf16x8& pa1, bf16x8& pa2, bf16x8& pa3) {
#pragma unroll
  for (int r = 0; r < 16; ++r) p1[r] = __builtin_amdgcn_exp2f(p1[r]);
  float ps = 0;
#pragma unroll
  for (int r = 0; r < 16; ++r) ps += p0[r];
#pragma unroll
  for (int r = 0; r < 16; ++r) ps += p1[r];
  { auto rr = __builtin_amdgcn_permlane32_swap(__float_as_uint(ps), __float_as_uint(ps), false, false);
    ps = __uint_as_float(rr[0]) + __uint_as_float(rr[1]); }
  l_reg = l_reg * alpha + ps;
#define PK4(P, BASE, OUT) do { unsigned a0 = cvtpk(P[BASE + 0], P[BASE + 1]), a1 = cvtpk(P[BASE + 2], P[BASE + 3]);   \
    unsigned b0 = cvtpk(P[BASE + 4], P[BASE + 5]), b1 = cvtpk(P[BASE + 6], P[BASE + 7]);                              \
    auto r0 = __builtin_amdgcn_permlane32_swap(a0, b0, false, false); auto r1 = __builtin_amdgcn_permlane32_swap(a1, b1, false, false); \
    u32x4 w = {r0[0], r1[0], r0[1], r1[1]}; OUT = __builtin_bit_cast(bf16x8, w); } while (0)
  PK4(p0, 0, pa0); PK4(p0, 8, pa1); PK4(p1, 0, pa2); PK4(p1, 8, pa3);
#undef PK4
}
__device__ __forceinline__ void partialFX(f32x16& p0) {
#pragma unroll
  for (int r = 0; r < 16; ++r) p0[r] = __builtin_amdgcn_exp2f(p0[r]);
}
__device__ __forceinline__ void finishFX(f32x16& p0, f32x16& p1, float& l_reg, bf16x8& pa0, bf16x8& pa1, bf16x8& pa2, bf16x8& pa3) {
#pragma unroll
  for (int r = 0; r < 16; ++r) p1[r] = __builtin_amdgcn_exp2f(p1[r]);
  float ps = 0;
#pragma unroll
  for (int r = 0; r < 16; ++r) ps += p0[r];
#pragma unroll
  for (int r = 0; r < 16; ++r) ps += p1[r];
  l_reg += ps;
#define PK4(P, BASE, OUT) do { unsigned a0 = cvtpk(P[BASE + 0], P[BASE + 1]), a1 = cvtpk(P[BASE + 2], P[BASE + 3]);   \
    unsigned b0 = cvtpk(P[BASE + 4], P[BASE + 5]), b1 = cvtpk(P[BASE + 6], P[BASE + 7]);                              \
    auto r0 = __builtin_amdgcn_permlane32_swap(a0, b0, false, false); auto r1 = __builtin_amdgcn_permlane32_swap(a1, b1, false, false); \
    u32x4 w = {r0[0], r1[0], r0[1], r1[1]}; OUT = __builtin_bit_cast(bf16x8, w); } while (0)
  PK4(p0, 0, pa0); PK4(p0, 8, pa1); PK4(p1, 0, pa2); PK4(p1, 8, pa3);
#undef PK4
}
__device__ __forceinline__ void qkt(f32x16& p0, f32x16& p1, const LAS unsigned char* Ks, const bf16x8 (&qr)[4], int c, int r32, int hi) {
  p0 = f32x16{}; p1 = f32x16{};
#pragma unroll
  for (int d0 = 0; d0 < 4; ++d0) { const int cb = (c * 64 + d0 * 16 + hi * 8) * 2;
    const bf16x8 b0 = *(const LAS bf16x8*)(Ks + KSWZ(r32, cb));
    const bf16x8 b1 = *(const LAS bf16x8*)(Ks + KSWZ(32 + r32, cb));
    p0 = __builtin_amdgcn_mfma_f32_32x32x16_bf16(b0, qr[d0], p0, 0, 0, 0);
    p1 = __builtin_amdgcn_mfma_f32_32x32x16_bf16(b1, qr[d0], p1, 0, 0, 0); }
}
__device__ __forceinline__ int v_st(int k, int c) { const int kk = (k & ~0xC) | ((k & 4) << 1) | ((k & 8) >> 1); return ((kk >> 3) * 4 + (c >> 5)) * 512 + ((kk & 7) * 32 + (c & 31)) * 2; }
__device__ __forceinline__ int v_rd_base(int lane) { return ((lane & 3) << 3) | (((lane >> 2) & 3) << 6) | (((lane >> 4) & 1) << 5) | (((lane >> 5) & 1) << 8); }
constexpr int v_rd_off(int d0, int ks, int half) { return d0 * 512 + ks * 4096 + half * 2048; }
template <int OFF> __device__ __forceinline__ s16x4 tr_read(int vb) {
  s16x4 r; asm volatile("ds_read_b64_tr_b16 %0, %1 offset:%2" : "=&v"(r) : "v"(vb), "i"(OFF) : "memory"); return r;
}
template <int D0> __device__ __forceinline__ void pv_one(f32x16& od, int vb, bf16x8 pa0, bf16x8 pa1, bf16x8 pa2, bf16x8 pa3) {
  const s16x4 l0 = tr_read<v_rd_off(D0, 0, 0)>(vb), h0 = tr_read<v_rd_off(D0, 0, 1)>(vb), l1 = tr_read<v_rd_off(D0, 1, 0)>(vb), h1 = tr_read<v_rd_off(D0, 1, 1)>(vb);
  const s16x4 l2 = tr_read<v_rd_off(D0, 2, 0)>(vb), h2 = tr_read<v_rd_off(D0, 2, 1)>(vb), l3 = tr_read<v_rd_off(D0, 3, 0)>(vb), h3 = tr_read<v_rd_off(D0, 3, 1)>(vb);
  asm volatile("s_waitcnt lgkmcnt(0)" ::: "memory"); SBAR();
#define PK(L, H) (bf16x8){L[0], L[1], L[2], L[3], H[0], H[1], H[2], H[3]}
  od = __builtin_amdgcn_mfma_f32_32x32x16_bf16(pa0, PK(l0, h0), od, 0, 0, 0);
  od = __builtin_amdgcn_mfma_f32_32x32x16_bf16(pa1, PK(l1, h1), od, 0, 0, 0);
  od = __builtin_amdgcn_mfma_f32_32x32x16_bf16(pa2, PK(l2, h2), od, 0, 0, 0);
  od = __builtin_amdgcn_mfma_f32_32x32x16_bf16(pa3, PK(l3, h3), od, 0, 0, 0);
#undef PK
}
#define PVRD(D0) const s16x4 l0_##D0 = tr_read<v_rd_off(D0, 0, 0)>(vb), h0_##D0 = tr_read<v_rd_off(D0, 0, 1)>(vb), l1_##D0 = tr_read<v_rd_off(D0, 1, 0)>(vb), h1_##D0 = tr_read<v_rd_off(D0, 1, 1)>(vb), \
    l2_##D0 = tr_read<v_rd_off(D0, 2, 0)>(vb), h2_##D0 = tr_read<v_rd_off(D0, 2, 1)>(vb), l3_##D0 = tr_read<v_rd_off(D0, 3, 0)>(vb), h3_##D0 = tr_read<v_rd_off(D0, 3, 1)>(vb)
#define PVPK(L, H) (bf16x8){L[0], L[1], L[2], L[3], H[0], H[1], H[2], H[3]}
#define PVMM(D0, N) do { asm volatile("s_waitcnt lgkmcnt(" #N ")" ::: "memory"); SBAR(); \
    o[D0] = __builtin_amdgcn_mfma_f32_32x32x16_bf16(pa0, PVPK(l0_##D0, h0_##D0), o[D0], 0, 0, 0); o[D0] = __builtin_amdgcn_mfma_f32_32x32x16_bf16(pa1, PVPK(l1_##D0, h1_##D0), o[D0], 0, 0, 0); \
    o[D0] = __builtin_amdgcn_mfma_f32_32x32x16_bf16(pa2, PVPK(l2_##D0, h2_##D0), o[D0], 0, 0, 0); o[D0] = __builtin_amdgcn_mfma_f32_32x32x16_bf16(pa3, PVPK(l3_##D0, h3_##D0), o[D0], 0, 0, 0); } while (0)
__device__ __forceinline__ void pv_d0(f32x16* o, int vb, bf16x8 pa0, bf16x8 pa1, bf16x8 pa2, bf16x8 pa3) {
  PVRD(0); PVRD(1); PVMM(0, 8); PVRD(2); PVMM(1, 8); PVRD(3); PVMM(2, 8); PVMM(3, 0);
}
#undef PVRD
#undef PVPK
#undef PVMM

template <bool FX>
__device__ __forceinline__ void attn_unit(const bf16* __restrict__ PROJ, bf16* __restrict__ MIX, const float* __restrict__ anw, const float lam, const float nb, const int b, const int h, const int qb,
                                          LAS unsigned char* lds, const int tid) {
  const int wid = __builtin_amdgcn_readfirstlane(tid >> 6), lane = tid & 63, r32 = lane & 31, hi = lane >> 5, g = wid >> 1, c = wid & 1;
  const int q0 = qb * 128, NT = 2 * qb + 2; const bool masked_last = (g < 2);
  int hcol = h * 128; asm volatile("" : "+s"(hcol));
  const char* Kg = (const char*)(PROJ + (size_t)(b * SEQ) * NCOL + C_AK + hcol);
  const char* Vg = (const char*)(PROJ + (size_t)(b * SEQ) * NCOL + C_AV + hcol);
  LAS float* wsf = (LAS float*)(lds + 131072) + wid * 64; LAS float* li_l = wsf; LAS float* al_l = wsf + 32;
  unsigned koff[2], voff[2];
#pragma unroll
  for (int p = 0; p < 2; ++p) { const int s = (wid * 2 + p) * 64 + lane, row = s >> 4, ch = (s & 15) ^ (row & 7); koff[p] = (unsigned)(row * NCOL + ch * 8) * 2u;
    const int o = s * 16, sub = o >> 9, within = o & 511, kk = (sub >> 2) * 8 + (within >> 6), k = (kk & ~0xC) | ((kk & 4) << 1) | ((kk & 8) >> 1), cc = (sub & 3) * 32 + ((within & 63) >> 4) * 8;
    voff[p] = (unsigned)(k * NCOL + cc) * 2u; }
#define DMA(tile, slot) do { const char* kt_ = Kg + (size_t)(tile) * (64 * NCOL * 2); const char* vt_ = Vg + (size_t)(tile) * (64 * NCOL * 2); LAS unsigned char* sl_ = lds + (slot) * 32768 + wid * 2048; \
    _Pragma("unroll") for (int p_ = 0; p_ < 2; ++p_) __builtin_amdgcn_global_load_lds((const unsigned*)(kt_ + koff[p_]), (LAS unsigned*)(sl_ + p_ * 1024), 16, 0, 0); \
    _Pragma("unroll") for (int p_ = 0; p_ < 2; ++p_) __builtin_amdgcn_global_load_lds((const unsigned*)(vt_ + voff[p_]), (LAS unsigned*)(sl_ + 16384 + p_ * 1024), 16, 0, 0); } while (0)
#define WB4() do { asm volatile("s_waitcnt vmcnt(4)" ::: "memory"); __builtin_amdgcn_s_barrier(); asm volatile("" ::: "memory"); } while (0)
#define WB8() do { asm volatile("s_waitcnt vmcnt(8)" ::: "memory"); __builtin_amdgcn_s_barrier(); asm volatile("" ::: "memory"); } while (0)
#define KSLOT(j) (lds + ((j) & 3) * 32768)
#define VSLOT(j) (vb0 + ((j) & 3) * 32768)
  float m_reg = -1e30f, l_reg = 0; f32x16 o[4] = {}; bf16x8 qr[4];
  { const bf16* Qw = PROJ + (size_t)(b * SEQ + q0 + 32 * g + r32) * NCOL + C_AQ + hcol + c * 64 + hi * 8;
#pragma unroll
    for (int d0 = 0; d0 < 4; ++d0) qr[d0] = *(const bf16x8*)(Qw + d0 * 16); }
  const int vb0 = (int)(unsigned)(uintptr_t)lds + 16384 + v_rd_base(lane);
#define RESC(a) do { if (__any((a) < 1.f)) { if (hi == 0) al_l[r32] = (a); asm volatile("s_waitcnt lgkmcnt(0)" ::: "memory"); \
    _Pragma("unroll") for (int d = 0; d < 4; ++d) _Pragma("unroll") for (int r = 0; r < 16; ++r) o[d][r] *= al_l[crow(r, hi)]; } } while (0)
  f32x16 p0, p1; float mn, al; bf16x8 pa0, pa1, pa2, pa3;
  DMA(0, 0); DMA(1, 1);
#pragma unroll 1
  for (int j = 0; j < NT; ++j) {
    WB4();
    DMA((j + 2 < NT ? j + 2 : NT - 1), (j + 2) & 3);
    SBAR(); qkt(p0, p1, KSLOT(j), qr, c, r32, hi);
    if (masked_last && j == NT - 1) {
#pragma unroll
      for (int r = 0; r < 16; ++r) { p0[r] = -1e30f; p1[r] = -1e30f; } }
    if constexpr (FX) { SBAR(); partialFX(p0); finishFX(p0, p1, l_reg, pa0, pa1, pa2, pa3); SBAR(); }
    else { partialSM(p0, p1, m_reg, mn, al); RESC(al); finishSM(p0, p1, al, l_reg, pa0, pa1, pa2, pa3); SBAR(); }
    pv_d0(o, VSLOT(j), pa0, pa1, pa2, pa3);
  }
  if constexpr (FX) l_reg += __shfl_xor(l_reg, 32);
  asm volatile("s_waitcnt vmcnt(0)" ::: "memory");
#undef DMA
#undef WB4
#undef WB8
#undef KSLOT
#undef VSLOT
  if (hi == 0) li_l[r32] = l_reg; asm volatile("s_waitcnt lgkmcnt(0)" ::: "memory");
  int lane2 = lane; asm volatile("" : "+v"(lane2));
  const int r32b = lane2 & 31, hib = lane2 >> 5;
  float rli[16];
#pragma unroll
  for (int r = 0; r < 16; ++r) rli[r] = __builtin_amdgcn_rcpf(li_l[(r & 3) + 8 * (r >> 2) + 4 * hib]);
  __syncthreads();
  LAS float* X = (LAS float*)(lds + g * 16384) + hib * 512 + r32b;
  if (c == 1) {
#pragma unroll
    for (int r = 0; r < 16; ++r)
#pragma unroll
      for (int d0 = 0; d0 < 4; ++d0) X[((r & 3) + 8 * (r >> 2)) * 128 + d0 * 32] = o[d0][r] * (rli[r] * lam);
  }
  __syncthreads();
  if (c == 0) {
    float ss[16];
#pragma unroll
    for (int r = 0; r < 16; ++r) { ss[r] = 0.f;
#pragma unroll
      for (int d0 = 0; d0 < 4; ++d0) { const float v = o[d0][r] * rli[r] - X[((r & 3) + 8 * (r >> 2)) * 128 + d0 * 32]; o[d0][r] = v; ss[r] += v * v; } }
#pragma unroll
    for (int r = 0; r < 16; ++r) {
#pragma unroll
      for (int s = 1; s < 32; s <<= 1) ss[r] += __shfl_xor(ss[r], s);
      ss[r] = rsqrtf(ss[r] * (1.f / 128.f) + EPS) * (1.f - LAMBDA_INIT); }
    float aw[4];
#pragma unroll
    for (int d0 = 0; d0 < 4; ++d0) aw[d0] = anw[d0 * 32 + r32b];
    asm volatile("s_waitcnt lgkmcnt(0)" ::: "memory");
    LAS bf16* Ost = (LAS bf16*)(lds + g * 16384);
    LAS bf16* Ow = Ost + hib * 512 + r32b;
#pragma unroll
    for (int r = 0; r < 16; ++r)
#pragma unroll
      for (int d0 = 0; d0 < 4; ++d0) Ow[((r & 3) + 8 * (r >> 2)) * 128 + d0 * 32] = (bf16)f2bf(o[d0][r] * ss[r] * aw[d0]);
    asm volatile("s_waitcnt lgkmcnt(0)" ::: "memory");
    const int rowb = lane2 >> 4, c16 = lane2 & 15;
    bf16* Ob = MIX + (size_t)(b * SEQ + q0 + 32 * g + rowb) * DM + 512 + h * 128 + c16 * 8;
    const LAS bf16* Os = Ost + rowb * 128 + c16 * 8;
#pragma unroll
    for (int k = 0; k < 8; ++k) *(u32x4*)(Ob + (size_t)k * 4 * DM) = *(const LAS u32x4*)(Os + k * 512);
  }
  __syncthreads();
#undef RESC
}

template <int C, int HALF_> __device__ __forceinline__ void half_scores(f32x16& p, const LAS unsigned char* Ks, const bf16x8 (&qr)[8], const int kaddr) {
  p = f32x16{};
#pragma unroll
  for (int d0 = 0; d0 < 4; ++d0) { const bf16x8 kf = *(const LAS bf16x8*)(Ks + (kaddr ^ (d0 * 32)) + C * 128 + HALF_ * 8192);
    p = __builtin_amdgcn_mfma_f32_32x32x16_bf16(kf, qr[C * 4 + d0], p, 0, 0, 0); }
}
__device__ __forceinline__ void half_softmax(f32x16& p, float& l_reg, bf16x8& pa, bf16x8& pb) {
#pragma unroll
  for (int r = 0; r < 16; ++r) p[r] = __builtin_amdgcn_exp2f(p[r]);
  float ps = 0;
#pragma unroll
  for (int r = 0; r < 16; ++r) ps += p[r];
  l_reg += ps;
#define PK4(P, BASE, OUT) do { unsigned a0 = cvtpk(P[BASE + 0], P[BASE + 1]), a1 = cvtpk(P[BASE + 2], P[BASE + 3]);   \
    unsigned b0 = cvtpk(P[BASE + 4], P[BASE + 5]), b1 = cvtpk(P[BASE + 6], P[BASE + 7]);                              \
    auto r0 = __builtin_amdgcn_permlane32_swap(a0, b0, false, false); auto r1 = __builtin_amdgcn_permlane32_swap(a1, b1, false, false); \
    u32x4 w = {r0[0], r1[0], r0[1], r1[1]}; OUT = __builtin_bit_cast(bf16x8, w); } while (0)
  PK4(p, 0, pa); PK4(p, 8, pb);
#undef PK4
  SBAR();
}
template <int D0, int HALF_> __device__ __forceinline__ void pv_half(f32x16& oa, f32x16& ob, int vb, bf16x8 a0, bf16x8 a1, bf16x8 b0, bf16x8 b1) {
  const s16x4 l0 = tr_read<v_rd_off(D0, 2 * HALF_, 0)>(vb), h0 = tr_read<v_rd_off(D0, 2 * HALF_, 1)>(vb), l1 = tr_read<v_rd_off(D0, 2 * HALF_ + 1, 0)>(vb), h1 = tr_read<v_rd_off(D0, 2 * HALF_ + 1, 1)>(vb);
  asm volatile("s_waitcnt lgkmcnt(0)" ::: "memory"); SBAR();
#define PK(L, H) (bf16x8){L[0], L[1], L[2], L[3], H[0], H[1], H[2], H[3]}
  oa = __builtin_amdgcn_mfma_f32_32x32x16_bf16(a0, PK(l0, h0), oa, 0, 0, 0);
  ob = __builtin_amdgcn_mfma_f32_32x32x16_bf16(b0, PK(l0, h0), ob, 0, 0, 0);
  oa = __builtin_amdgcn_mfma_f32_32x32x16_bf16(a1, PK(l1, h1), oa, 0, 0, 0);
  ob = __builtin_amdgcn_mfma_f32_32x32x16_bf16(b1, PK(l1, h1), ob, 0, 0, 0);
#undef PK
  SBAR();
}
__device__ __forceinline__ void attn2_setup(LAS unsigned char* lds, const int tid) {
  const int wid = __builtin_amdgcn_readfirstlane(tid >> 6), lane = tid & 63;
  unsigned koff[2], voff[2];
#pragma unroll
  for (int p = 0; p < 2; ++p) { const int s = (wid * 2 + p) * 64 + lane, row = s >> 4, ch = (s & 15) ^ (row & 7); koff[p] = (unsigned)(row * NCOL + ch * 8) * 2u;
    const int o = s * 16, sub = o >> 9, within = o & 511, kk = (sub >> 2) * 8 + (within >> 6), k = (kk & ~0xC) | ((kk & 4) << 1) | ((kk & 8) >> 1), cc = (sub & 3) * 32 + ((within & 63) >> 4) * 8;
    voff[p] = (unsigned)(k * NCOL + cc) * 2u; }
  *((LAS u32x4*)(lds + 133120 + wid * 1024) + lane) = (u32x4){koff[0], koff[1], voff[0], voff[1]};
  asm volatile("s_waitcnt lgkmcnt(0)" ::: "memory");
}
__device__ __forceinline__ void attn_unit2(const bf16* __restrict__ PROJ, bf16* __restrict__ MIX, const float* __restrict__ anw, const float lam, const int b, const int h, const int qb,
                                           LAS unsigned char* lds, const int tid) {
  const int wid = __builtin_amdgcn_readfirstlane(tid >> 6), lane = tid & 63, r32 = lane & 31, hi = lane >> 5;
  const int q0 = qb * 256, NT = 4 * qb + 4, jlast = 4 * qb + (wid >> 1);
  int hcol = h * 128; asm volatile("" : "+s"(hcol));
  const char* Kg = (const char*)(PROJ + (size_t)(b * SEQ) * NCOL + C_AK + hcol);
  const char* Vg = (const char*)(PROJ + (size_t)(b * SEQ) * NCOL + C_AV + hcol);
  LAS float* wsf = (LAS float*)(lds + 131072) + wid * 64;
  LAS u32x4* offt = (LAS u32x4*)(lds + 133120 + wid * 1024) + lane;
#define DMA(tile, slot) do { const char* kt_ = Kg + (size_t)(tile) * (64 * NCOL * 2); const char* vt_ = Vg + (size_t)(tile) * (64 * NCOL * 2); LAS unsigned char* sl_ = lds + (slot) * 32768 + wid * 2048; const u32x4 of_ = *offt; \
    __builtin_amdgcn_global_load_lds((const unsigned*)(kt_ + of_.x), (LAS unsigned*)(sl_), 16, 0, 0); __builtin_amdgcn_global_load_lds((const unsigned*)(kt_ + of_.y), (LAS unsigned*)(sl_ + 1024), 16, 0, 0); \
    __builtin_amdgcn_global_load_lds((const unsigned*)(vt_ + of_.z), (LAS unsigned*)(sl_ + 16384), 16, 0, 0); __builtin_amdgcn_global_load_lds((const unsigned*)(vt_ + of_.w), (LAS unsigned*)(sl_ + 16384 + 1024), 16, 0, 0); } while (0)
#define WB4() do { asm volatile("s_waitcnt vmcnt(4)" ::: "memory"); __builtin_amdgcn_s_barrier(); asm volatile("" ::: "memory"); } while (0)
  float l0 = 0.f, l1 = 0.f; f32x16 oa[4] = {}, ob[4] = {}; bf16x8 qr[8];
  { const bf16* Qw = PROJ + (size_t)(b * SEQ + q0 + 32 * wid + r32) * NCOL + C_AQ + hcol + hi * 8;
#pragma unroll
    for (int d = 0; d < 8; ++d) qr[d] = *(const bf16x8*)(Qw + d * 16); }
  const int vb0 = (int)(unsigned)(uintptr_t)lds + 16384 + v_rd_base(lane);
  const int kaddr = r32 * 256 + ((hi * 16) ^ ((r32 & 7) << 4));
  DMA(0, 0); DMA(1, 1);
#pragma unroll 1
  for (int j = 0; j < NT; ++j) {
    WB4();
    DMA((j + 2 < NT ? j + 2 : NT - 1), (j + 2) & 3);
    if (j <= jlast) {
      const LAS unsigned char* Ks = lds + (j & 3) * 32768; const int vb = vb0 + (j & 3) * 32768;
      f32x16 p; bf16x8 a0, a1, b0, b1;
      SBAR(); half_scores<0, 0>(p, Ks, qr, kaddr); half_softmax(p, l0, a0, a1);
      SBAR(); half_scores<1, 0>(p, Ks, qr, kaddr); half_softmax(p, l1, b0, b1); SBAR();
      pv_half<0, 0>(oa[0], ob[0], vb, a0, a1, b0, b1); pv_half<1, 0>(oa[1], ob[1], vb, a0, a1, b0, b1); pv_half<2, 0>(oa[2], ob[2], vb, a0, a1, b0, b1); pv_half<3, 0>(oa[3], ob[3], vb, a0, a1, b0, b1);
      SBAR(); half_scores<0, 1>(p, Ks, qr, kaddr); half_softmax(p, l0, a0, a1);
      SBAR(); half_scores<1, 1>(p, Ks, qr, kaddr); half_softmax(p, l1, b0, b1); SBAR();
      pv_half<0, 1>(oa[0], ob[0], vb, a0, a1, b0, b1); pv_half<1, 1>(oa[1], ob[1], vb, a0, a1, b0, b1); pv_half<2, 1>(oa[2], ob[2], vb, a0, a1, b0, b1); pv_half<3, 1>(oa[3], ob[3], vb, a0, a1, b0, b1);
    }
  }
  l0 += __shfl_xor(l0, 32); l1 += __shfl_xor(l1, 32);
  asm volatile("s_waitcnt vmcnt(0)" ::: "memory");
  if (hi == 0) { wsf[r32] = l0; wsf[32 + r32] = l1; } asm volatile("s_waitcnt lgkmcnt(0)" ::: "memory");
  int lane2 = lane; asm volatile("" : "+v"(lane2));
  const int r32b = lane2 & 31, hib = lane2 >> 5;
  __syncthreads();
  float ss[16];
#pragma unroll
  for (int r = 0; r < 16; ++r) { const int row = (r & 3) + 8 * (r >> 2) + 4 * hib; const float c0 = __builtin_amdgcn_rcpf(wsf[row]), c1 = lam * __builtin_amdgcn_rcpf(wsf[32 + row]); ss[r] = 0.f;
#pragma unroll
    for (int d0 = 0; d0 < 4; ++d0) { const float v = oa[d0][r] * c0 - ob[d0][r] * c1; oa[d0][r] = v; ss[r] += v * v; } }
#pragma unroll
  for (int r = 0; r < 16; ++r) {
#pragma unroll
    for (int s = 1; s < 32; s <<= 1) ss[r] += __shfl_xor(ss[r], s);
    ss[r] = rsqrtf(ss[r] * (1.f / 128.f) + EPS) * (1.f - LAMBDA_INIT); }
  float aw[4];
#pragma unroll
  for (int d0 = 0; d0 < 4; ++d0) aw[d0] = anw[d0 * 32 + r32b];
  LAS bf16* Ost = (LAS bf16*)(lds + wid * 8192);
  LAS bf16* Ow = Ost + hib * 512 + r32b;
#pragma unroll
  for (int r = 0; r < 16; ++r)
#pragma unroll
    for (int d0 = 0; d0 < 4; ++d0) Ow[((r & 3) + 8 * (r >> 2)) * 128 + d0 * 32] = (bf16)f2bf(oa[d0][r] * ss[r] * aw[d0]);
  asm volatile("s_waitcnt lgkmcnt(0)" ::: "memory");
  const int rowb = lane2 >> 4, c16 = lane2 & 15;
  bf16* Ob = MIX + (size_t)(b * SEQ + q0 + 32 * wid + rowb) * DM + 512 + h * 128 + c16 * 8;
  const LAS bf16* Os = Ost + rowb * 128 + c16 * 8;
#pragma unroll
  for (int k = 0; k < 8; ++k) *(u32x4*)(Ob + (size_t)k * 4 * DM) = *(const LAS u32x4*)(Os + k * 512);
  __syncthreads();
#undef DMA
#undef WB4
}
}

template <bool FX>
__device__ __forceinline__ void attn_queue(const bf16* PROJ, bf16* MIX, const float* anw, const float lam, const float nb, unsigned* queue, LAS unsigned char* lds, int tid) {
    LAS unsigned* slot = (LAS unsigned*)(lds + LDSCTL_OFF + 64);
    const int x0 = (int)(xb_xcc_id() & 7u);
    LAS unsigned* peek = (LAS unsigned*)(lds + LDSCTL_OFF + 72);
    if constexpr (FX) att::attn2_setup(lds, tid);
#pragma unroll 1
    for (int k = 0; k < 8; ++k) {
        const int x = (x0 + k) & 7;
        if (k == 1) { if (tid < 8) peek[tid] = __hip_atomic_load(queue + 64 * tid, __ATOMIC_RELAXED, __HIP_MEMORY_SCOPE_AGENT); __syncthreads(); }
        if (k >= 1) { if (peek[x] >= 128u) continue; }
        if (tid == 0) *slot = __hip_atomic_fetch_add(queue + 64 * x, 1u, __ATOMIC_RELAXED, __HIP_MEMORY_SCOPE_AGENT);
        __syncthreads();
        for (;;) {
            const unsigned l = *slot;
            __syncthreads();
            if (l >= 128u) break;
            unsigned nxt = 0u;
            if (tid == 0) nxt = __hip_atomic_fetch_add(queue + 64 * x, 1u, __ATOMIC_RELAXED, __HIP_MEMORY_SCOPE_AGENT);
            const int bh = ((int)l >> 3) * 8 + x, p = (int)l & 7;
            if constexpr (FX) { const int bh2 = ((int)l & 15) * 8 + x, qb2 = 7 - ((int)l >> 4); att::attn_unit2(PROJ, MIX, anw, lam, bh2 >> 2, bh2 & 3, qb2, lds, tid); }
            else {
#pragma unroll 1
                for (int s = 0; s < 2; ++s) att::attn_unit<false>(PROJ, MIX, anw, lam, nb, bh >> 2, bh & 3, s ? p : 15 - p, lds, tid); }
            if (tid == 0) *slot = nxt;
            __syncthreads();
        }
    }
}
__device__ __forceinline__ void p2_fast_attn(const Args& a, LAS unsigned char* lds, int tid, int lane, int wave, int wg, int G, int rep) {
    const float* lq1 = a.in[10]; const float* lk1 = a.in[11]; const float* lq2 = a.in[12]; const float* lk2 = a.in[13];
    const float lam = __expf(wave_sum(lq1[lane] * lk1[lane])) - __expf(wave_sum(lq2[lane] * lk2[lane])) + LAMBDA_INIT;
    const float bound2 = 8.f * 1.4426950408889634f * 1.01f * wave_max(fabsf(a.in[8][lane])) * wave_max(fabsf(a.in[9][lane]));
    const bool fixedmax = bound2 <= 40.f;
    const bf16* PROJ = (const bf16*)(a.ws + WS_PROJ); bf16* MIX = (bf16*)(a.ws + WS_MIX);
    unsigned* queue = (unsigned*)(a.ws + WS_CTL) + CW_QUEUE + 1024 * rep;
    if (fixedmax) attn_queue<true>(PROJ, MIX, a.in[14], lam, -bound2, queue, lds, tid);
    else attn_queue<false>(PROJ, MIX, a.in[14], lam, 0.f, queue, lds, tid);
}

__device__ __forceinline__ void p4_router(const Args& a, LAS unsigned char* lds, int tid, int lane, int wave, int wg, int G) {
    unsigned char* ws = a.ws;
    const float* norm2_w = a.in[16]; const float* w_group = a.in[17]; const float* b_group = a.in[18]; const float* w_expert = a.in[19]; const float* b_expert = a.in[20];
    const float* X1 = a.out; bf16* H2 = (bf16*)(ws + WS_H2);
    int* ASGE = (int*)(ws + WS_ASGE); float* ASGW = (float*)(ws + WS_ASGW); int* CNT = (int*)(ws + WS_CTL) + CW_CNT;
    LAS float* wl = (LAS float*)lds;
    LAS int* hist = (LAS int*)(lds + LDSCTL_OFF + 128);
    for (int idx = tid; idx < 4096; idx += NTHR) { const int k = idx >> 2, c = idx & 3; wl[c * 1024 + k] = w_group[idx]; }
    for (int idx = tid; idx < 32768; idx += NTHR) { const int k = idx >> 5, c = idx & 31; wl[(4 + c) * 1024 + k] = w_expert[idx]; }
    if (tid < 32) hist[tid] = 0;
    __syncthreads();
    f32x4 w2v[4];
#pragma unroll
    for (int j = 0; j < 4; ++j) w2v[j] = ((const f32x4*)norm2_w)[lane + 64 * j];
    const int tpw = T_ / (G * NWAVES);
#pragma unroll 1
    for (int rr = 0; rr < tpw; ++rr) {
        const int t = (wg * NWAVES + wave) * tpw + rr;
        const f32x4* xr = (const f32x4*)(X1 + (size_t)t * DM) + lane;
        f32x4 hv[4]; float ss = 0.f;
#pragma unroll
        for (int j = 0; j < 4; ++j) { hv[j] = xr[64 * j]; ss += (hv[j].x * hv[j].x + hv[j].y * hv[j].y) + (hv[j].z * hv[j].z + hv[j].w * hv[j].w); }
        const float r2 = rsqrtf(wave_sum(ss) * (1.f / DM) + EPS);
        u32x2* o8 = (u32x2*)(H2 + (size_t)t * DM) + lane;
#pragma unroll
        for (int j = 0; j < 4; ++j) { hv[j] = hv[j] * r2 * w2v[j]; u32x2 o; o.x = pk2(hv[j].x, hv[j].y); o.y = pk2(hv[j].z, hv[j].w); o8[64 * j] = o; }
        float lg[36];
#pragma unroll
        for (int c = 0; c < 36; ++c) { float acc = 0.f;
#pragma unroll
            for (int j = 0; j < 4; ++j) { const f32x4 wv = *(const LAS f32x4*)(wl + c * 1024 + 256 * j + 4 * lane); acc += (hv[j].x * wv.x + hv[j].y * wv.y) + (hv[j].z * wv.z + hv[j].w * wv.w); }
            lg[c] = wave_sum(acc); }
        float gl[4];
#pragma unroll
        for (int g = 0; g < 4; ++g) gl[g] = lg[g] + b_group[g];
        int gsel = 0; float gmax = gl[0];
#pragma unroll
        for (int g = 1; g < 4; ++g) if (gl[g] > gmax) { gmax = gl[g]; gsel = g; }
        float gsum = 0.f;
#pragma unroll
        for (int g = 0; g < 4; ++g) gsum += __expf(gl[g] - gmax);
        const float gwt = 1.f / gsum;
        float el[8];
#pragma unroll
        for (int i = 0; i < 8; ++i) el[i] = 0.f;
#pragma unroll
        for (int g = 0; g < 4; ++g) if (gsel == g) {
#pragma unroll
            for (int i = 0; i < 8; ++i) el[i] = lg[4 + 8 * g + i] + b_expert[8 * g + i]; }
        int i1 = 0; float v1 = el[0];
#pragma unroll
        for (int i = 1; i < 8; ++i) if (el[i] > v1) { v1 = el[i]; i1 = i; }
        int i2 = -1; float v2 = -3.0e38f;
#pragma unroll
        for (int i = 0; i < 8; ++i) if (i != i1 && el[i] > v2) { v2 = el[i]; i2 = i; }
        const float p1 = 1.f / (1.f + __expf(v2 - v1)), p2 = 1.f - p1;
        if (lane == 0) {
            const int e1 = gsel * 8 + i1, e2 = gsel * 8 + i2;
            const int r1 = atomicAdd((int*)&hist[e1], 1), r2_ = atomicAdd((int*)&hist[e2], 1);
            ASGE[2 * t] = e1 | (r1 << 8); ASGE[2 * t + 1] = e2 | (r2_ << 8);
            ASGW[2 * t] = gwt * p1; ASGW[2 * t + 1] = gwt * p2;
        }
    }
    __syncthreads();
    if (tid < 32) CNT[wg * 32 + tid] = hist[tid];
}


__device__ __forceinline__ void p4_router_mfma(const Args& a, LAS unsigned char* lds, int tid, int lane, int wave, int wg, int G) {
    unsigned char* ws = a.ws;
    const float* b_group = a.in[18]; const float* b_expert = a.in[20];
    const float* X1 = a.in[0]; const bf16* MO = (const bf16*)(ws + WS_MO); bf16* X1B = (bf16*)(ws + WS_H2);
    int* ASGE = (int*)(ws + WS_ASGE); float* ASGW = (float*)(ws + WS_ASGW); int* CNT = (int*)(ws + WS_CTL) + CW_CNT;
    constexpr int WST = 2064, WLO = 36 * WST;
    LAS int* hist = (LAS int*)(lds + LDSCTL_OFF + 128);
    {
        const u32x4* RIMG = (const u32x4*)(ws + WS_RIMG); constexpr int NP = 2 * 36 * WST / 16;
#pragma unroll 1
        for (int base = 0; base < NP; base += 6 * NTHR) {
            u32x4 v[6];
#pragma unroll
            for (int q = 0; q < 6; ++q) { const int i = base + q * NTHR + tid; v[q] = RIMG[i < NP ? i : NP - 1]; }
#pragma unroll
            for (int q = 0; q < 6; ++q) { const int i = base + q * NTHR + tid; if (i < NP) *(LAS u32x4*)(lds + i * 16) = v[q]; }
        }
    }
    if (tid < 32) hist[tid] = 0;
    __syncthreads();
    const int fr = lane & 15, fq = lane >> 4;
    const int t0 = (wg * NWAVES + wave) * 32;
    const float* xa = X1 + (size_t)(t0 + fr) * DM + 8 * fq; const float* xb = xa + (size_t)16 * DM;
    const bf16* moa = MO + (size_t)(t0 + fr) * DM + 8 * fq; const bf16* mob = moa + (size_t)16 * DM;
    bf16* x1a = X1B + (size_t)(t0 + fr) * DM + 8 * fq; bf16* x1b = x1a + (size_t)16 * DM;
    unsigned char* x1fa = ws + WS_X1F + (size_t)(t0 + fr) * DM + 8 * fq; unsigned char* x1fb = x1fa + (size_t)16 * DM;
    f32x4 acc[2][3];
#pragma unroll
    for (int tl = 0; tl < 2; ++tl)
#pragma unroll
        for (int nt = 0; nt < 3; ++nt) acc[tl][nt] = (f32x4){0.f, 0.f, 0.f, 0.f};
    float ss0 = 0.f, ss1 = 0.f;
    int wrow[3];
#pragma unroll
    for (int nt = 0; nt < 3; ++nt) { const int c = 16 * nt + fr; wrow[nt] = (c < 36 ? c : 35) * WST + 16 * fq; }
#pragma unroll 1
    for (int kg = 0; kg < 8; ++kg) {
        f32x4 xa_[4][2], xb_[4][2]; u32x4 ma_[4], mb_[4];
#pragma unroll
        for (int q = 0; q < 4; ++q) { const int ks = 4 * kg + q;
            xa_[q][0] = *(const f32x4*)(xa + 32 * ks); xa_[q][1] = *(const f32x4*)(xa + 32 * ks + 4); xb_[q][0] = *(const f32x4*)(xb + 32 * ks); xb_[q][1] = *(const f32x4*)(xb + 32 * ks + 4);
            ma_[q] = *(const u32x4*)(moa + 32 * ks); mb_[q] = *(const u32x4*)(mob + 32 * ks); }
#pragma unroll
        for (int q = 0; q < 4; ++q) { const int ks = 4 * kg + q;
            f32x4 a0 = xa_[q][0], a1 = xa_[q][1], b0 = xb_[q][0], b1 = xb_[q][1]; const u32x4 ma = ma_[q], mb = mb_[q];
            a0.x += bflo(ma.x); a0.y += bfhi(ma.x); a0.z += bflo(ma.y); a0.w += bfhi(ma.y); a1.x += bflo(ma.z); a1.y += bfhi(ma.z); a1.z += bflo(ma.w); a1.w += bfhi(ma.w);
            b0.x += bflo(mb.x); b0.y += bfhi(mb.x); b0.z += bflo(mb.y); b0.w += bfhi(mb.y); b1.x += bflo(mb.z); b1.y += bfhi(mb.z); b1.z += bflo(mb.w); b1.w += bfhi(mb.w);
            ss0 += (a0.x * a0.x + a0.y * a0.y) + (a0.z * a0.z + a0.w * a0.w) + (a1.x * a1.x + a1.y * a1.y) + (a1.z * a1.z + a1.w * a1.w);
            ss1 += (b0.x * b0.x + b0.y * b0.y) + (b0.z * b0.z + b0.w * b0.w) + (b1.x * b1.x + b1.y * b1.y) + (b1.z * b1.z + b1.w * b1.w);
            bf16x8 ah[2], al[2];
#define P4_SPLIT(v0, v1, H, L) do { u32x4 h_, l_; \
                h_.x = pg8::cvt_pk_bf16(v0.x, v0.y); h_.y = pg8::cvt_pk_bf16(v0.z, v0.w); h_.z = pg8::cvt_pk_bf16(v1.x, v1.y); h_.w = pg8::cvt_pk_bf16(v1.z, v1.w); \
                l_.x = pg8::cvt_pk_bf16(v0.x - bflo(h_.x), v0.y - bfhi(h_.x)); l_.y = pg8::cvt_pk_bf16(v0.z - bflo(h_.y), v0.w - bfhi(h_.y)); l_.z = pg8::cvt_pk_bf16(v1.x - bflo(h_.z), v1.y - bfhi(h_.z)); l_.w = pg8::cvt_pk_bf16(v1.z - bflo(h_.w), v1.w - bfhi(h_.w)); \
                H = __builtin_bit_cast(bf16x8, h_); L = __builtin_bit_cast(bf16x8, l_); } while (0)
            P4_SPLIT(a0, a1, ah[0], al[0]); P4_SPLIT(b0, b1, ah[1], al[1]);
#undef P4_SPLIT
            *(bf16x8*)(x1a + 32 * ks) = ah[0]; *(bf16x8*)(x1b + 32 * ks) = ah[1];
            { u32x2 fa, fb; fa.x = pk4_fp8(a0.x, a0.y, a0.z, a0.w); fa.y = pk4_fp8(a1.x, a1.y, a1.z, a1.w); fb.x = pk4_fp8(b0.x, b0.y, b0.z, b0.w); fb.y = pk4_fp8(b1.x, b1.y, b1.z, b1.w);
              *(u32x2*)(x1fa + 32 * ks) = fa; *(u32x2*)(x1fb + 32 * ks) = fb; }
#pragma unroll
            for (int nt = 0; nt < 3; ++nt) {
                const bf16x8 wh = *(const LAS bf16x8*)(lds + wrow[nt] + ks * 64), wl = *(const LAS bf16x8*)(lds + WLO + wrow[nt] + ks * 64);
#pragma unroll
                for (int tl = 0; tl < 2; ++tl) {
                    acc[tl][nt] = __builtin_amdgcn_mfma_f32_16x16x32_bf16(wh, ah[tl], acc[tl][nt], 0, 0, 0);
                    acc[tl][nt] = __builtin_amdgcn_mfma_f32_16x16x32_bf16(wh, al[tl], acc[tl][nt], 0, 0, 0);
                    acc[tl][nt] = __builtin_amdgcn_mfma_f32_16x16x32_bf16(wl, ah[tl], acc[tl][nt], 0, 0, 0); }
            }
        }
    }
    float bg[4], be[32]; int pe_[2][2] = {{0, 0}, {0, 0}}, pr_[2][2] = {{0, 0}, {0, 0}};
#pragma unroll
    for (int g = 0; g < 4; ++g) bg[g] = b_group[g];
#pragma unroll
    for (int i = 0; i < 32; ++i) be[i] = b_expert[i];
#pragma unroll
    for (int tl = 0; tl < 2; ++tl) {
        float ss = tl ? ss1 : ss0; ss += __shfl_xor(ss, 16); ss += __shfl_xor(ss, 32);
        const float r2 = rsqrtf(ss * (1.f / DM) + EPS);
        float lg[36];
#pragma unroll
        for (int nt = 0; nt < 3; ++nt)
#pragma unroll
            for (int q = 0; q < 4; ++q)
#pragma unroll
                for (int j = 0; j < 4; ++j) { const int c = 16 * nt + 4 * q + j; if (c < 36) lg[c] = __shfl(acc[tl][nt][j], fr + 16 * q) * r2; }
        float gl[4];
#pragma unroll
        for (int g = 0; g < 4; ++g) gl[g] = lg[g] + bg[g];
        int gsel = 0; float gmax = gl[0];
#pragma unroll
        for (int g = 1; g < 4; ++g) if (gl[g] > gmax) { gmax = gl[g]; gsel = g; }
        float gsum = 0.f;
#pragma unroll
        for (int g = 0; g < 4; ++g) gsum += __expf(gl[g] - gmax);
        const float gwt = 1.f / gsum;
        float el[8];
#pragma unroll
        for (int i = 0; i < 8; ++i) el[i] = 0.f;
#pragma unroll
        for (int g = 0; g < 4; ++g) if (gsel == g) {
#pragma unroll
            for (int i = 0; i < 8; ++i) el[i] = lg[4 + 8 * g + i] + be[8 * g + i]; }
        int i1 = 0; float v1 = el[0];
#pragma unroll
        for (int i = 1; i < 8; ++i) if (el[i] > v1) { v1 = el[i]; i1 = i; }
        int i2 = -1; float v2 = -3.0e38f;
#pragma unroll
        for (int i = 0; i < 8; ++i) if (i != i1 && el[i] > v2) { v2 = el[i]; i2 = i; }
        const float p1 = 1.f / (1.f + __expf(v2 - v1)), p2 = 1.f - p1;
        if (fq == 0) {
            const int t = t0 + 16 * tl + fr;
            const int e1 = gsel * 8 + i1, e2 = gsel * 8 + i2;
            const int r1 = atomicAdd((int*)&hist[e1], 1), r2_ = atomicAdd((int*)&hist[e2], 1);
            pe_[tl][0] = e1; pe_[tl][1] = e2; pr_[tl][0] = r1; pr_[tl][1] = r2_;
            ASGW[2 * t] = gwt * p1; ASGW[2 * t + 1] = gwt * p2;
            ASGW[2 * T_ + 2 * t] = r2; ASGW[2 * T_ + 2 * t + 1] = r2;
        }
    }
    __syncthreads();
    LAS int* lbase = hist + 32;
    if (tid < 32) lbase[tid] = atomicAdd((int*)(ws + WS_CTL) + CW_CUR + 64 * tid, hist[tid]);
    __syncthreads();
    if (fq == 0) { int* LIST = (int*)(ws + WS_LIST);
#pragma unroll
        for (int tl = 0; tl < 2; ++tl) { const int t = t0 + 16 * tl + fr;
#pragma unroll
            for (int k = 0; k < 2; ++k) { const int e = pe_[tl][k], ii = lbase[e] + pr_[tl][k]; LIST[(size_t)e * LCAP + ii] = 2 * t + k; ASGE[2 * t + k] = e | (ii << 8); } } }
}

__device__ __forceinline__ void p5_dispatch(const Args& a, LAS unsigned char* lds, int tid, int wg, int G) {
    unsigned char* ws = a.ws;
    const int* ASGE = (const int*)(ws + WS_ASGE); const float* ASGW = (const float*)(ws + WS_ASGW); const int* CNT = (const int*)(ws + WS_CTL) + CW_CNT;
    int* META = (int*)(ws + WS_CTL) + CW_META; int* ROWTOK = (int*)(ws + WS_ROWTOK); float* ROWW = (float*)(ws + WS_ROWW); float* ROWR = (float*)(ws + WS_GATES); int* POSA = (int*)(ws + WS_POSA);
    LAS int* tot = (LAS int*)lds; LAS int* pre = tot + 32; LAS int* pst = pre + 32;
    {
        LAS int* part = pst + 64;
        const int e = tid & 31, j = tid >> 5; int total = 0, prefix = 0;
#pragma unroll
        for (int q = 0; q < 16; ++q) { const int w = 16 * j + q; const int c = (w < G) ? CNT[w * 32 + e] : 0; total += c; prefix += (w < wg) ? c : 0; }
        part[j * 32 + e] = total; part[512 + j * 32 + e] = prefix;
        __syncthreads();
        if (tid < 32) { int t2 = 0, p2 = 0;
#pragma unroll
            for (int q = 0; q < 16; ++q) { t2 += part[q * 32 + tid]; p2 += part[512 + q * 32 + tid]; }
            tot[tid] = t2; pre[tid] = p2; }
    }
    __syncthreads();
    if (tid == 0) { int s = 0; for (int e = 0; e < 32; ++e) { pst[e] = s; s += (tot[e] + 255) & ~255; } pst[32] = s; }
    __syncthreads();
    if (wg == 0 && tid <= 32) META[tid] = pst[tid];
    const int apw = 2 * T_ / G;
    for (int q = tid; q < apw; q += NTHR) { const int idx = wg * apw + q; const int ev = ASGE[idx], e = ev & 255, rank = ev >> 8; const int pos = pst[e] + pre[e] + rank; ROWTOK[pos] = idx; ROWW[pos] = ASGW[idx]; ROWR[pos] = ASGW[2 * T_ + idx]; POSA[idx] = pos; }
    if (wg < 32) { const int e = wg; for (int p = pst[e] + tot[e] + tid; p < pst[e + 1]; p += NTHR) { ROWTOK[p] = -1; ROWW[p] = 0.f; ROWR[p] = 0.f; } }
}

__device__ __forceinline__ int expert_of_row(const LAS int* pst, int row) { int e = 0;
#pragma unroll 1
    for (int i = 1; i < 32; ++i) e += (pst[i] <= row) ? 1 : 0;
    return e; }

__device__ __forceinline__ void unpack8(const u32x4 v, float (&f)[8]) { f[0] = bflo(v.x); f[1] = bfhi(v.x); f[2] = bflo(v.y); f[3] = bfhi(v.y); f[4] = bflo(v.z); f[5] = bfhi(v.z); f[6] = bflo(v.w); f[7] = bfhi(v.w); }
__device__ __forceinline__ void p6_naive(const Args& a, LAS unsigned char* lds, int tid, int wg, int G) {
    unsigned char* ws = a.ws;
    const int* META = (const int*)(ws + WS_CTL) + CW_META; const int* ROWTOK = (const int*)(ws + WS_ROWTOK);
    const bf16* H2 = (const bf16*)(ws + WS_H2); const bf16* WGU = (const bf16*)(ws + WS_WGU); bf16* HID = (bf16*)(ws + WS_HID);
    LAS int* pst = (LAS int*)lds;
    if (tid <= 32) pst[tid] = META[tid];
    __syncthreads();
    const int npad = pst[32], ntile = (npad / 64) * 8, rg = tid >> 5, cg = tid & 31;
    for (int tile = wg; tile < ntile; tile += G) {
        const int rt = tile >> 3, ct = tile & 7, e = expert_of_row(pst, rt * 64);
        const bf16* ar[4];
#pragma unroll
        for (int i = 0; i < 4; ++i) { const int tk = ROWTOK[rt * 64 + rg * 4 + i]; ar[i] = H2 + (size_t)(tk < 0 ? 0 : (tk >> 1)) * DM; }
        const int c0 = ct * 64 + cg * 2;
        const bf16* bg[2]; const bf16* bu[2];
#pragma unroll
        for (int j = 0; j < 2; ++j) { const int c = c0 + j; bg[j] = WGU + ((size_t)e * 1024 + (c >> 7) * 256 + (c & 127)) * 1024; bu[j] = bg[j] + 128 * 1024; }
        float g[4][2], u[4][2];
#pragma unroll
        for (int i = 0; i < 4; ++i)
#pragma unroll
            for (int j = 0; j < 2; ++j) { g[i][j] = 0.f; u[i][j] = 0.f; }
#pragma unroll 1
        for (int k = 0; k < 1024; k += 8) {
            float af[4][8], gf[2][8], uf[2][8];
#pragma unroll
            for (int i = 0; i < 4; ++i) unpack8(*(const u32x4*)(ar[i] + k), af[i]);
#pragma unroll
            for (int j = 0; j < 2; ++j) { unpack8(*(const u32x4*)(bg[j] + k), gf[j]); unpack8(*(const u32x4*)(bu[j] + k), uf[j]); }
#pragma unroll
            for (int i = 0; i < 4; ++i)
#pragma unroll
                for (int j = 0; j < 2; ++j)
#pragma unroll
                    for (int q = 0; q < 8; ++q) { g[i][j] += af[i][q] * gf[j][q]; u[i][j] += af[i][q] * uf[j][q]; }
        }
#pragma unroll
        for (int i = 0; i < 4; ++i) *(unsigned*)(HID + (size_t)(rt * 64 + rg * 4 + i) * DEXP + c0) = pk2(siluf_(g[i][0]) * u[i][0], siluf_(g[i][1]) * u[i][1]);
    }
}

__device__ __forceinline__ void p7_naive(const Args& a, LAS unsigned char* lds, int tid, int wg, int G) {
    unsigned char* ws = a.ws;
    const int* META = (const int*)(ws + WS_CTL) + CW_META; const int* ROWTOK = (const int*)(ws + WS_ROWTOK); const float* ROWW = (const float*)(ws + WS_ROWW);
    const bf16* HID = (const bf16*)(ws + WS_HID); const bf16* WD = (const bf16*)(ws + WS_WD); bf16* YBUF = (bf16*)(ws + WS_YBUF);
    LAS int* pst = (LAS int*)lds;
    if (tid <= 32) pst[tid] = META[tid];
    __syncthreads();
    const int npad = pst[32], ntile = (npad / 64) * 8, rg = tid >> 5, cg = tid & 31;
    for (int tile = wg; tile < ntile; tile += G) {
        const int rt = tile >> 3, ct = tile & 7, e = expert_of_row(pst, rt * 64);
        const bf16* ar[4]; const bf16* br[4];
#pragma unroll
        for (int i = 0; i < 4; ++i) ar[i] = HID + (size_t)(rt * 64 + rg * 4 + i) * DEXP;
        const int c0 = ct * 128 + cg * 4;
#pragma unroll
        for (int j = 0; j < 4; ++j) br[j] = WD + ((size_t)e * 1024 + c0 + j) * DEXP;
        float acc[4][4];
#pragma unroll
        for (int i = 0; i < 4; ++i)
#pragma unroll
            for (int j = 0; j < 4; ++j) acc[i][j] = 0.f;
#pragma unroll 1
        for (int k = 0; k < DEXP; k += 8) {
            float af[4][8], bfv[4][8];
#pragma unroll
            for (int i = 0; i < 4; ++i) { unpack8(*(const u32x4*)(ar[i] + k), af[i]); unpack8(*(const u32x4*)(br[i] + k), bfv[i]); }
#pragma unroll
            for (int i = 0; i < 4; ++i)
#pragma unroll
                for (int j = 0; j < 4; ++j)
#pragma unroll
                    for (int q = 0; q < 8; ++q) acc[i][j] += af[i][q] * bfv[j][q];
        }
#pragma unroll
        for (int i = 0; i < 4; ++i) { const int pos = rt * 64 + rg * 4 + i; const int tk = ROWTOK[pos];
            if (tk >= 0) { const float w = ROWW[pos]; const int t = tk >> 1, kk = tk & 1;
                u32x2 o; o.x = pk2(acc[i][0] * w, acc[i][1] * w); o.y = pk2(acc[i][2] * w, acc[i][3] * w);
                *(u32x2*)(YBUF + ((size_t)kk * T_ + t) * DM + c0) = o; } }
    }
}

__device__ __forceinline__ void p8_combine(const Args& a, int tid, int wg, int G) {
    const unsigned char* Y = a.ws + WS_YBUF; const bf16* X1B = (const bf16*)(a.ws + WS_H2); float* O = a.out;
    const int* POSA = (const int*)(a.ws + WS_POSA); const float* ASGW = (const float*)(a.ws + WS_ASGW);
    const int lane = tid & 63, gw = wg * NWAVES + __builtin_amdgcn_readfirstlane(tid >> 6), NGW = G * NWAVES;
    u32x4 xb[2]; u32x2 y0[2], y1[2]; float w0 = 0.f, w1 = 0.f;
#define P8_LOAD(t_) do { const int t__ = __builtin_amdgcn_readfirstlane(t_); const int p0_ = POSA[2 * t__], p1_ = POSA[2 * t__ + 1]; w0 = ASGW[2 * t__]; w1 = ASGW[2 * t__ + 1]; \
        _Pragma("unroll") for (int q = 0; q < 2; ++q) { xb[q] = *(const u32x4*)(X1B + (size_t)t__ * DM + (lane + 64 * q) * 8); y0[q] = *(const u32x2*)(Y + (size_t)p0_ * DM + (lane + 64 * q) * 8); \
            y1[q] = *(const u32x2*)(Y + (size_t)p1_ * DM + (lane + 64 * q) * 8); } } while (0)
#define P8_F8(w_, i_) __builtin_amdgcn_cvt_f32_fp8((int)(w_), (i_))
    P8_LOAD(gw);
#pragma unroll 1
    for (int t = gw; t < T_; t += NGW) {
        u32x4 cx[2]; u32x2 c0[2], c1[2]; const float cw0 = w0, cw1 = w1;
#pragma unroll
        for (int q = 0; q < 2; ++q) { cx[q] = xb[q]; c0[q] = y0[q]; c1[q] = y1[q]; }
        if (t + NGW < T_) P8_LOAD(t + NGW);
#pragma unroll
        for (int q = 0; q < 2; ++q) {
            f32x4 a0, a1;
            a0.x = bflo(cx[q].x) + cw0 * P8_F8(c0[q].x, 0) + cw1 * P8_F8(c1[q].x, 0); a0.y = bfhi(cx[q].x) + cw0 * P8_F8(c0[q].x, 1) + cw1 * P8_F8(c1[q].x, 1);
            a0.z = bflo(cx[q].y) + cw0 * P8_F8(c0[q].x, 2) + cw1 * P8_F8(c1[q].x, 2); a0.w = bfhi(cx[q].y) + cw0 * P8_F8(c0[q].x, 3) + cw1 * P8_F8(c1[q].x, 3);
            a1.x = bflo(cx[q].z) + cw0 * P8_F8(c0[q].y, 0) + cw1 * P8_F8(c1[q].y, 0); a1.y = bfhi(cx[q].z) + cw0 * P8_F8(c0[q].y, 1) + cw1 * P8_F8(c1[q].y, 1);
            a1.z = bflo(cx[q].w) + cw0 * P8_F8(c0[q].y, 2) + cw1 * P8_F8(c1[q].y, 2); a1.w = bfhi(cx[q].w) + cw0 * P8_F8(c0[q].y, 3) + cw1 * P8_F8(c1[q].y, 3);
            float* op = O + (size_t)t * DM + (lane + 64 * q) * 8;
            *(f32x4*)op = a0; *(f32x4*)(op + 4) = a1;
        }
    }
#undef P8_LOAD
#undef P8_F8
}

#ifndef STAGGER_P1
#define STAGGER_P1 700
#endif
#ifndef STAGGER_P6
#define STAGGER_P6 0
#endif
#ifndef STAGGER_P7
#define STAGGER_P7 0
#endif
__device__ __forceinline__ void phase_stagger(unsigned ticks) {
    const unsigned g = blockIdx.x & 3u;
    if (g != 0u && ticks != 0u) { const unsigned long long t0 = __builtin_amdgcn_s_memrealtime(); while (__builtin_amdgcn_s_memrealtime() - t0 < (unsigned long long)(g * ticks)) __builtin_amdgcn_s_sleep(16); }
}

__device__ __forceinline__ void p6_gemm(const Args& a, LAS unsigned char* lds, int tid, int wg, int G) {
    unsigned char* ws = a.ws;
    LAS int* pst = (LAS int*)(lds + 131072); LAS int* tot = pst + 64;
    if (tid < 32) tot[tid] = ((const int*)(ws + WS_CTL) + CW_CUR)[64 * tid];
    __syncthreads();
    if (tid == 0) { int s_ = 0; for (int e = 0; e < 32; ++e) { pst[e] = s_; s_ += (tot[e] + 255) & ~255; } pst[32] = s_; }
    __syncthreads();
    {
        const int* ASGE = (const int*)(ws + WS_ASGE); int* POSA = (int*)(ws + WS_POSA); const int idx = wg * (2 * T_ / G) + tid;
        if (tid < 2 * T_ / G) { const int ev = ASGE[idx]; POSA[idx] = pst[ev & 255] + (ev >> 8); }
    }
    pg8::MoeGuSched S; S.o.init(pst[32] / 256, 4, G, wg); S.A = (const char*)(ws + WS_X1F); S.Bt = (const char*)(ws + WS_WGU); S.rowtok = (const int*)(ws + WS_ROWTOK); S.pst = pst; S.K = DM / 2;
    LAS int* ltok = (LAS int*)(lds + 131584); LAS float* lrowr = (LAS float*)(lds + 131584 + 9 * 256 * 4);
    {
        const int* LIST = (const int*)(ws + WS_LIST); const float* R2 = (const float*)(ws + WS_ASGW) + 2 * T_;
        int tv[9]; float rv[9]; bool ok[9];
#pragma unroll
        for (int i = 0; i < 9; ++i) { int pm, pn; ok[i] = S.o.map(i, pm, pn); tv[i] = -1; rv[i] = 0.f;
            if (ok[i] && tid < 256) { const int e = pg8::expert_of_row_l(pst, pm * 256), ii = pm * 256 + tid - pst[e]; if (ii < tot[e]) tv[i] = LIST[(size_t)e * LCAP + ii]; } }
#pragma unroll
        for (int i = 0; i < 9; ++i) if (tv[i] >= 0) rv[i] = R2[tv[i]];
#pragma unroll
        for (int i = 0; i < 9; ++i) if (ok[i] && tid < 256) { ltok[i * 256 + tid] = tv[i]; lrowr[i * 256 + tid] = rv[i]; }
        __syncthreads();
    }
    S.ltok = ltok;
    pg8::EpiSwiglu E{(bf16*)(ws + WS_HID), lrowr};
    phase_stagger(STAGGER_P6);
    pg8::gemm_phase<pg8::EpiSwiglu, pg8::MoeGuSched, true, true>(lds, DM / 2, S, E);
}
__device__ __forceinline__ void p7_gemm(const Args& a, LAS unsigned char* lds, int tid, int wg, int G) {
    unsigned char* ws = a.ws;
    LAS int* pst = (LAS int*)(lds + 131072); LAS int* tot = pst + 64;
    if (tid < 32) tot[tid] = ((const int*)(ws + WS_CTL) + CW_CUR)[64 * tid];
    __syncthreads();
    if (tid == 0) { int s_ = 0; for (int e = 0; e < 32; ++e) { pst[e] = s_; s_ += (tot[e] + 255) & ~255; } pst[32] = s_; }
    __syncthreads();
    pg8::MoeDownSched S; S.o.init(pst[32] / 256, 4, G, wg); S.A = (const char*)(ws + WS_HID); S.Bt = (const char*)(ws + WS_WD); S.pst = pst; S.K = DEXP / 2;
    pg8::EpiF8 E{ws + WS_YBUF, DM};
    phase_stagger(STAGGER_P7);
    pg8::gemm_phase<pg8::EpiF8, pg8::MoeDownSched, true, true>(lds, DEXP / 2, S, E);
}

__global__ void __launch_bounds__(NTHR, 2) fwd(Args args) {
    extern __shared__ __attribute__((aligned(16))) unsigned char lds_raw[];
    LAS unsigned char* lds = (LAS unsigned char*)lds_raw;
    const int tid0 = threadIdx.x, wg = blockIdx.x, G = gridDim.x;
#define PH_TID() int tid = threadIdx.x; asm volatile("" : "+v"(tid)); const int lane = tid & 63, wave = __builtin_amdgcn_readfirstlane(tid >> 6); (void)lane; (void)wave
    unsigned char* ws = args.ws;
    unsigned* ctl = (unsigned*)(ws + WS_CTL);
    for (int u = tid0; u < 256; u += NTHR) ((LAS unsigned*)(lds + LDSCTL_OFF))[u] = 0u;
    __syncthreads();
    const int lo = args.ph_lo, hi = args.ph_hi;
    XcdBarrier bar = xcd_barrier_post(ctl + CW_BAR, (volatile LAS unsigned*)(lds + LDSCTL_OFF));
#define IN(k) (lo <= (k) && (k) < hi)
#ifndef PROBE_PHASE
#define PROBE_PHASE -1
#endif
#define REPS(k) ((PROBE_PHASE == (k)) ? 2 : 1)
#define REPSEP(k) do { if (rep + 1 < REPS(k)) xcd_barrier(bar); } while (0)
#define SEAM(k) do { if (IN(k) && IN((k) + 1)) xcd_barrier(bar); } while (0)

    if (IN(0)) { for (int rep = 0; rep < REPS(0); ++rep) { PH_TID(); p0_prologue(args, lds, tid, lane, wave, wg, G);  REPSEP(0); } }
    SEAM(0);
    if (IN(1)) { for (int rep = 0; rep < REPS(1); ++rep) {
        pg8::DenseSched S; S.o.init(T_ / 256, NCOL / 256, G, wg); S.A = (const char*)(ws + WS_H1); S.Bt = (const char*)(ws + WS_W1T); S.K = DM;
        pg8::EpiProj E{(bf16*)(ws + WS_PROJ), NCOL, args.in[8], args.in[9]};
        { PH_TID(); p1_stagger_work(args, lds, lane, wave, wg); }
        asm volatile("s_waitcnt vmcnt(0) lgkmcnt(0)" ::: "memory"); __syncthreads();
        pg8::gemm_phase<pg8::EpiProj, pg8::DenseSched, true>(lds, DM, S, E);
     REPSEP(1); } }
    SEAM(1);
    if (IN(2)) { for (int rep = 0; rep < REPS(2); ++rep) { { PH_TID(); if (wg < NBATCH * 4 || PROBE_PHASE == 23) { ml::mlstm_item(args, lds, wg & 127, tid); } } __syncthreads(); { PH_TID(); p2_fast_attn(args, lds, tid, lane, wave, wg, G, rep); if (PROBE_PHASE == 21) { __syncthreads(); p2_fast_attn(args, lds, tid, lane, wave, wg, G, 1); } }  REPSEP(2); } }
    SEAM(2);
    if (IN(3)) { for (int rep = 0; rep < REPS(3); ++rep) {
        pg8::DenseSched S; S.o.init(T_ / 256, DM / 256, G, wg); S.A = (const char*)(ws + WS_MIX); S.Bt = (const char*)(ws + WS_W2T); S.K = DM;
        pg8::EpiBf16 E{(bf16*)(ws + WS_MO), DM};
        pg8::gemm_phase<pg8::EpiBf16, pg8::DenseSched, true>(lds, DM, S, E);
     REPSEP(3); } }
    SEAM(3);
    if (IN(4)) { for (int rep = 0; rep < REPS(4); ++rep) { PH_TID(); p4_router_mfma(args, lds, tid, lane, wave, wg, G);  REPSEP(4); } }
    SEAM(4);
    if (IN(6)) { for (int rep = 0; rep < REPS(6); ++rep) { PH_TID(); p6_gemm(args, lds, tid, wg, G);  REPSEP(6); } }
    SEAM(6);
    if (IN(7)) { for (int rep = 0; rep < REPS(7); ++rep) { PH_TID(); p7_gemm(args, lds, tid, wg, G);  REPSEP(7); } }
    SEAM(7);
    if (IN(8)) { PH_TID(); p8_combine(args, tid, wg, G); }
#undef IN
#undef SEAM
}

#ifndef MK_N_LAUNCHES
#define MK_N_LAUNCHES 1
#endif
extern "C" void kernel_launch(void* const* d_in, const int* in_sizes, int n_in, void* d_out, int out_size, void* d_ws, size_t ws_size, hipStream_t stream) {
    static int grid = 0;
    if (grid == 0) {
        if (n_in != 24 || in_sizes[0] != T_ * DM || out_size != T_ * DM || ws_size < WS_END) { fprintf(stderr, "kernel_launch: unexpected shapes (n_in %d, in0 %d, out %d, ws %zu); nothing launched\n", n_in, n_in > 0 ? in_sizes[0] : -1, out_size, ws_size); grid = -1; return; }
        int dev = 0, cus = 0, per_cu = 0;
        if (hipGetDevice(&dev) != hipSuccess || hipDeviceGetAttribute(&cus, hipDeviceAttributeMultiprocessorCount, dev) != hipSuccess) { grid = -1; return; }
        if (hipFuncSetAttribute((const void*)fwd, hipFuncAttributeMaxDynamicSharedMemorySize, LDS_BYTES) != hipSuccess) { fprintf(stderr, "kernel_launch: hipFuncSetAttribute failed\n"); grid = -1; return; }
        if (hipOccupancyMaxActiveBlocksPerMultiprocessor(&per_cu, (const void*)fwd, NTHR, LDS_BYTES) != hipSuccess || per_cu < 1) fprintf(stderr, "kernel_launch: occupancy query reports %d\n", per_cu);
        (void)hipGetLastError();
        grid = cus;
        if (grid != 256) { fprintf(stderr, "kernel_launch: built for 256 CUs, found %d; nothing launched\n", cus); grid = -1; return; }
    }
    if (grid < 0) return;
    if (hipMemsetAsync((char*)d_ws + WS_CTL, 0, CTL_ZERO_BYTES, stream) != hipSuccess) return;
    Args a{};
    for (int i = 0; i < 24; ++i) a.in[i] = (const float*)d_in[i];
    a.out = (float*)d_out; a.ws = (unsigned char*)d_ws;
    if (MK_N_LAUNCHES == 1) { a.ph_lo = 0; a.ph_hi = 9; hipLaunchKernelGGL(fwd, dim3(grid), dim3(NTHR), LDS_BYTES, stream, a); }
    else { for (int p = 0; p < 9; ++p) { a.ph_lo = p; a.ph_hi = p + 1; hipLaunchKernelGGL(fwd, dim3(grid), dim3(NTHR), LDS_BYTES, stream, a); } }
    const hipError_t le = hipPeekAtLastError();
    if (le != hipSuccess) fprintf(stderr, "kernel_launch: launch failed: %s\n", hipGetErrorName(le));
}
```

```cpp
#include <hip/hip_runtime.h>
#include <cstdio>
#include <cstdint>

#define GAS __attribute__((address_space(1)))
#define LAS __attribute__((address_space(3)))
typedef unsigned short bf16;
typedef unsigned u32x4 __attribute__((ext_vector_type(4)));
typedef unsigned u32x2 __attribute__((ext_vector_type(2)));
typedef float f32x4 __attribute__((ext_vector_type(4)));
typedef float f32x2 __attribute__((ext_vector_type(2)));
typedef short bf16x8 __attribute__((ext_vector_type(8)));

constexpr int T_ = 65536, DM = 1024, SEQ = 2048, NBATCH = 32, NCOL = 3584, INCOLS = 3592;
constexpr int C_MQ = 0, C_MK = 512, C_MV = 1024, C_MO = 1536, C_AQ = 2048, C_AK = 2560, C_AV = 3072;
constexpr int NEXP = 32, DEXP = 512, PMAX = 131072 + NEXP * 256;
constexpr float EPS = 1e-6f;
constexpr float LAMBDA_INIT = 0.2f;
constexpr int NWAVES = 8, NTHR = 512;

constexpr size_t MiB = 1u << 20;
constexpr size_t WS_CTL = 0, CTL_ZERO_BYTES = 64 * 1024;
constexpr size_t WS_W1T = 1 * MiB, WS_W2T = 8 * MiB, WS_WGU = 10 * MiB, WS_WD = 74 * MiB, WS_GATES = 106 * MiB;
constexpr size_t WS_ASGE = 108 * MiB, WS_ASGW = 109 * MiB, WS_ROWTOK = 110 * MiB, WS_ROWW = 111 * MiB;
constexpr size_t WS_H1 = 112 * MiB, WS_MIX = 240 * MiB, WS_PROJ = 368 * MiB, WS_END = 816 * MiB;
constexpr size_t WS_YBUF = 112 * MiB;
constexpr size_t WS_H2 = 384 * MiB, WS_HID = 512 * MiB;
constexpr size_t WS_MO = 112 * MiB;
constexpr size_t WS_X1F = 584 * MiB;
constexpr size_t WS_RIMG = 111 * MiB + 768 * 1024;
constexpr size_t WS_POSA = 108 * MiB + 512 * 1024;
constexpr int CW_BAR = 4096, CW_QUEUE = 8192, CW_CNT = 16384, CW_META = 32768;
constexpr int CW_CUR = 12288;
constexpr size_t WS_LIST = 700 * MiB; constexpr int LCAP = 2 * 65536;

constexpr int LDS_SCRATCH = 155648;
constexpr int LDSCTL_OFF = LDS_SCRATCH;
constexpr int LDS_BYTES = LDS_SCRATCH + 1024;

__device__ __forceinline__ unsigned f2bf(float f) { unsigned u = __builtin_bit_cast(unsigned, f); return (u + 0x7fffu + ((u >> 16) & 1u)) >> 16; }
__device__ __forceinline__ unsigned pk2(float lo, float hi) { return f2bf(lo) | (f2bf(hi) << 16); }
__device__ __forceinline__ float bf2f(bf16 v) { return __uint_as_float(((unsigned)v) << 16); }
__device__ __forceinline__ float bflo(unsigned u) { return __uint_as_float(u << 16); }
__device__ __forceinline__ float bfhi(unsigned u) { return __uint_as_float(u & 0xffff0000u); }
__device__ __forceinline__ float wave_sum(float v) {
#pragma unroll
    for (int o = 1; o < 64; o <<= 1) v += __shfl_xor(v, o);
    return v;
}
__device__ __forceinline__ float wave_max(float v) {
#pragma unroll
    for (int o = 1; o < 64; o <<= 1) v = fmaxf(v, __shfl_xor(v, o));
    return v;
}
__device__ __forceinline__ float sigmoidf_(float x) { return 1.f / (1.f + __expf(-x)); }
__device__ __forceinline__ float siluf_(float x) { return x / (1.f + __expf(-x)); }
__device__ __forceinline__ unsigned pk4_fp8(float a, float b, float c, float d) { int w = 0; w = __builtin_amdgcn_cvt_pk_fp8_f32(a, b, w, false); w = __builtin_amdgcn_cvt_pk_fp8_f32(c, d, w, true); return (unsigned)w; }
#define LDS_WAIT() asm volatile("s_waitcnt lgkmcnt(0)" ::: "memory")
#define VM_WAIT() asm volatile("s_waitcnt vmcnt(0)" ::: "memory")

namespace pg8 {
#define PG8_LAS __attribute__((address_space(3)))
constexpr int BM = 256, BK = 64, HALF = 128, HTB = HALF * BK * 2, STAGE_BYTES = 8 * HTB, NXCD = 8, WGM = 4;
__host__ __device__ __forceinline__ int lds_byte(int r, int c) { const int st = (r >> 4) * 2 + (c >> 5), rr = r & 15, cc = c & 31, ob = rr * 64 + cc * 2; return st * 1024 + (ob ^ (((ob >> 9) & 1) << 5)); }
__host__ __device__ __forceinline__ void stage_rc(int b, int& R, int& C) { const int st = b / 1024, sb = b % 1024, swz = sb ^ (((sb >> 9) & 1) << 5); R = (st >> 1) * 16 + swz / 64; C = (st & 1) * 32 + (swz % 64) / 2; }
__host__ __device__ __forceinline__ int perm32(int rho) { const int n = rho >> 4, i = rho & 15; return 8 * (i >> 2) + 4 * n + (i & 3); }

struct Unit { int pm, pn, e, li; };
struct TileOrder {
    int nM, nN, nwg, G, c;
    __device__ __forceinline__ void init(int nM_, int nN_, int G_, int c_) { nM = nM_; nN = nN_; nwg = nM * nN; G = G_; c = c_; }
    __device__ __forceinline__ bool map(int i, int& pm, int& pn) const {
        const long L = (long)i * G + c; if (L >= nwg) return false;
        int wgid = (int)L; { const int q = nwg / NXCD, r = nwg % NXCD, xcd = wgid % NXCD, off = wgid / NXCD; wgid = (xcd < r ? xcd * (q + 1) : r * (q + 1) + (xcd - r) * q) + off; }
        const int nig = WGM * nN, gid = wgid / nig, fm = gid * WGM, gsz = (nM - fm) < WGM ? (nM - fm) : WGM;
        pm = fm + ((wgid % nig) % gsz); pn = (wgid % nig) / gsz; return true;
    }
};
struct DenseSched {
    static constexpr bool GATHER = false;
    TileOrder o; const char* A; const char* Bt; int K;
    __device__ __forceinline__ bool next(int i, Unit& u) const { u.e = 0; u.li = i; return o.map(i, u.pm, u.pn); }
    __device__ __forceinline__ const char* a_base(const Unit& u) const { return A + (size_t)u.pm * BM * K * 2; }
    __device__ __forceinline__ const char* b_base(const Unit& u) const { return Bt + (size_t)u.pn * BM * K * 2; }
    __device__ __forceinline__ void a_voff(const Unit&, const int (&R)[2], const int (&C)[2], unsigned (&v)[2][2]) const {
#pragma unroll
        for (int h = 0; h < 2; ++h)
#pragma unroll
            for (int i = 0; i < 2; ++i) v[h][i] = (unsigned)((h * HALF + R[i]) * K + C[i]) * 2u;
    }
};

__device__ __forceinline__ unsigned cvt_pk_bf16(float lo, float hi) { unsigned r; asm volatile("v_cvt_pk_bf16_f32 %0, %1, %2" : "=v"(r) : "v"(lo), "v"(hi)); return r; }

struct EpiBf16 {
    static constexpr bool PERM = true;
    bf16* O; int ldc;
    __device__ __forceinline__ void operator()(const f32x4 (&acc)[2][2][4][2], const Unit& u, int wr, int wc, int fr, int fq) const {
        const int row0 = u.pm * BM + wr * 64 + fr, col0 = u.pn * BM + wc * 32 + 8 * fq;
#pragma unroll
        for (int ai = 0; ai < 2; ++ai)
#pragma unroll
            for (int m = 0; m < 4; ++m) { bf16* rowp = O + (size_t)(row0 + ai * HALF + m * 16) * ldc + col0;
#pragma unroll
                for (int bj = 0; bj < 2; ++bj) { const f32x4 v0 = acc[ai][bj][m][0], v1 = acc[ai][bj][m][1];
                    u32x4 w; w.x = cvt_pk_bf16(v0[0], v0[1]); w.y = cvt_pk_bf16(v0[2], v0[3]); w.z = cvt_pk_bf16(v1[0], v1[1]); w.w = cvt_pk_bf16(v1[2], v1[3]);
                    *(u32x4*)(rowp + bj * HALF) = w; } }
    }
};
struct EpiF8 {
    static constexpr bool PERM = true;
    unsigned char* O; int ldc;
    __device__ __forceinline__ void operator()(const f32x4 (&acc)[2][2][4][2], const Unit& u, int wr, int wc, int fr, int fq) const {
        const int row0 = u.pm * BM + wr * 64 + fr, col0 = u.pn * BM + wc * 32 + 8 * fq;
#pragma unroll
        for (int ai = 0; ai < 2; ++ai)
#pragma unroll
            for (int m = 0; m < 4; ++m) { unsigned char* rowp = O + (size_t)(row0 + ai * HALF + m * 16) * ldc + col0;
#pragma unroll
                for (int bj = 0; bj < 2; ++bj) { const f32x4 v0 = acc[ai][bj][m][0], v1 = acc[ai][bj][m][1];
                    u32x2 w; w.x = pk4_fp8(v0[0], v0[1], v0[2], v0[3]); w.y = pk4_fp8(v1[0], v1[1], v1[2], v1[3]);
                    *(u32x2*)(rowp + bj * HALF) = w; } }
    }
};
struct EpiProj {
    static constexpr bool PERM = true;
    bf16* O; int ldc; const float* qw; const float* kw;
    __device__ __forceinline__ void operator()(const f32x4 (&acc)[2][2][4][2], const Unit& u, int wr, int wc, int fr, int fq) const {
        const int row0 = u.pm * BM + wr * 64 + fr;
        if (u.pn >= 8 && u.pn < 12) {
            const float* wsrc = (u.pn < 10) ? qw : kw; const float post = (u.pn < 10) ? 0.18033688011112042f : 1.0f;
            f32x4 wv[2][2];
#pragma unroll
            for (int bj = 0; bj < 2; ++bj)
#pragma unroll
                for (int n = 0; n < 2; ++n) wv[bj][n] = *(const f32x4*)(wsrc + 32 * bj + 8 * fq + 4 * n) * post;
            const int col0 = u.pn * BM + wc * 64 + 8 * fq;
#pragma unroll
            for (int ai = 0; ai < 2; ++ai)
#pragma unroll
                for (int m = 0; m < 4; ++m) {
                    float ss = 0.f;
#pragma unroll
                    for (int bj = 0; bj < 2; ++bj)
#pragma unroll
                        for (int n = 0; n < 2; ++n) { const f32x4 x = acc[ai][bj][m][n]; ss += (x[0] * x[0] + x[1] * x[1]) + (x[2] * x[2] + x[3] * x[3]); }
                    ss += __shfl_xor(ss, 16); ss += __shfl_xor(ss, 32);
                    const float r = rsqrtf(ss * (1.f / 64.f) + 1e-6f);
                    bf16* rowp = O + (size_t)(row0 + ai * HALF + m * 16) * ldc + col0;
#pragma unroll
                    for (int bj = 0; bj < 2; ++bj) { const f32x4 v0 = acc[ai][bj][m][0] * r * wv[bj][0], v1 = acc[ai][bj][m][1] * r * wv[bj][1];
                        u32x4 w; w.x = cvt_pk_bf16(v0[0], v0[1]); w.y = cvt_pk_bf16(v0[2], v0[3]); w.z = cvt_pk_bf16(v1[0], v1[1]); w.w = cvt_pk_bf16(v1[2], v1[3]);
                        *(u32x4*)(rowp + bj * 32) = w; } }
        } else {
            const int col0 = u.pn * BM + wc * 32 + 8 * fq; const bool sig = (u.pn == 6 || u.pn == 7);
#pragma unroll
            for (int ai = 0; ai < 2; ++ai)
#pragma unroll
                for (int m = 0; m < 4; ++m) { bf16* rowp = O + (size_t)(row0 + ai * HALF + m * 16) * ldc + col0;
#pragma unroll
                    for (int bj = 0; bj < 2; ++bj) { f32x4 v0 = acc[ai][bj][m][0], v1 = acc[ai][bj][m][1];
                        if (sig) {
#pragma unroll
                            for (int j = 0; j < 4; ++j) { v0[j] = __builtin_amdgcn_rcpf(1.f + __builtin_amdgcn_exp2f(v0[j] * -1.4426950408889634f)); v1[j] = __builtin_amdgcn_rcpf(1.f + __builtin_amdgcn_exp2f(v1[j] * -1.4426950408889634f)); } }
                        u32x4 w; w.x = cvt_pk_bf16(v0[0], v0[1]); w.y = cvt_pk_bf16(v0[2], v0[3]); w.z = cvt_pk_bf16(v1[0], v1[1]); w.w = cvt_pk_bf16(v1[2], v1[3]);
                        *(u32x4*)(rowp + bj * HALF) = w; } }
        }
    }
};
struct EpiX1 {
    static constexpr bool PERM = true;
    const float* X; bf16* OB; unsigned char* OF; int ldc;
    __device__ __forceinline__ void operator()(const f32x4 (&acc)[2][2][4][2], const Unit& u, int wr, int wc, int fr, int fq) const {
        const int row0 = u.pm * BM + wr * 64 + fr, col0 = u.pn * BM + wc * 32 + 8 * fq;
#pragma unroll
        for (int ai = 0; ai < 2; ++ai) {
            f32x4 xv[4][2][2];
#pragma unroll
            for (int m = 0; m < 4; ++m) { const size_t off = (size_t)(row0 + ai * HALF + m * 16) * ldc + col0;
#pragma unroll
                for (int bj = 0; bj < 2; ++bj) { xv[m][bj][0] = *(const f32x4*)(X + off + bj * HALF); xv[m][bj][1] = *(const f32x4*)(X + off + bj * HALF + 4); } }
#pragma unroll
            for (int m = 0; m < 4; ++m) { const size_t off = (size_t)(row0 + ai * HALF + m * 16) * ldc + col0;
#pragma unroll
                for (int bj = 0; bj < 2; ++bj) {
                    const f32x4 r0 = xv[m][bj][0] + acc[ai][bj][m][0], r1 = xv[m][bj][1] + acc[ai][bj][m][1];
                    u32x4 w; w.x = cvt_pk_bf16(r0[0], r0[1]); w.y = cvt_pk_bf16(r0[2], r0[3]); w.z = cvt_pk_bf16(r1[0], r1[1]); w.w = cvt_pk_bf16(r1[2], r1[3]);
                    *(u32x4*)(OB + off + bj * HALF) = w;
                    u32x2 f; f.x = pk4_fp8(r0[0], r0[1], r0[2], r0[3]); f.y = pk4_fp8(r1[0], r1[1], r1[2], r1[3]);
                    *(u32x2*)(OF + off + bj * HALF) = f; } }
            asm volatile("" ::: "memory");
        }
    }
};
struct EpiResF32 {
    static constexpr bool PERM = true;
    const float* X; float* O; int ldc; bf16* OB;
    __device__ __forceinline__ void operator()(const f32x4 (&acc)[2][2][4][2], const Unit& u, int wr, int wc, int fr, int fq) const {
        const int row0 = u.pm * BM + wr * 64 + fr, col0 = u.pn * BM + wc * 32 + 8 * fq;
#pragma unroll
        for (int ai = 0; ai < 2; ++ai) {
            f32x4 xv[4][2][2];
#pragma unroll
            for (int m = 0; m < 4; ++m) { const size_t off = (size_t)(row0 + ai * HALF + m * 16) * ldc + col0;
#pragma unroll
                for (int bj = 0; bj < 2; ++bj) { xv[m][bj][0] = *(const f32x4*)(X + off + bj * HALF); xv[m][bj][1] = *(const f32x4*)(X + off + bj * HALF + 4); } }
#pragma unroll
            for (int m = 0; m < 4; ++m) { const size_t off = (size_t)(row0 + ai * HALF + m * 16) * ldc + col0;
#pragma unroll
                for (int bj = 0; bj < 2; ++bj) {
                    const f32x4 r0 = xv[m][bj][0] + acc[ai][bj][m][0], r1 = xv[m][bj][1] + acc[ai][bj][m][1];
                    *(f32x4*)(O + off + bj * HALF) = r0; *(f32x4*)(O + off + bj * HALF + 4) = r1;
                    u32x4 w; w.x = cvt_pk_bf16(r0[0], r0[1]); w.y = cvt_pk_bf16(r0[2], r0[3]); w.z = cvt_pk_bf16(r1[0], r1[1]); w.w = cvt_pk_bf16(r1[2], r1[3]);
                    *(u32x4*)(OB + off + bj * HALF) = w; } }
            asm volatile("" ::: "memory");
        }
    }
};

__device__ __forceinline__ int expert_of_row_l(const PG8_LAS int* pst, int row) {
    const int lane = (int)__builtin_amdgcn_mbcnt_hi(~0u, __builtin_amdgcn_mbcnt_lo(~0u, 0u));
    const bool hit = (lane >= 1 && lane < 32) ? (pst[lane & 31] <= row) : false;
    return __builtin_popcountll(__ballot(hit)); }
struct MoeGuSched {
    static constexpr bool GATHER = true;
    TileOrder o; const char* A; const char* Bt; const int* rowtok; const PG8_LAS int* pst; int K; const PG8_LAS int* ltok;
    __device__ __forceinline__ bool next(int i, Unit& u) const { u.li = i; if (!o.map(i, u.pm, u.pn)) return false; u.e = expert_of_row_l(pst, u.pm * BM); return true; }
    __device__ __forceinline__ const char* a_base(const Unit&) const { return A; }
    __device__ __forceinline__ const char* b_base(const Unit& u) const { return Bt + ((size_t)u.e * 1024 + (size_t)u.pn * BM) * K * 2; }
    __device__ __forceinline__ void a_voff(const Unit& u, const int (&R)[2], const int (&C)[2], unsigned (&v)[2][2]) const {
#pragma unroll
        for (int h = 0; h < 2; ++h)
#pragma unroll
            for (int i = 0; i < 2; ++i) { const int tk = ltok[u.li * BM + h * HALF + R[i]]; const unsigned tok = tk < 0 ? 0u : (unsigned)(tk >> 1); v[h][i] = (tok * (unsigned)K + (unsigned)C[i]) * 2u; }
    }
};
struct MoeDownSched {
    static constexpr bool GATHER = false;
    TileOrder o; const char* A; const char* Bt; const PG8_LAS int* pst; int K;
    __device__ __forceinline__ bool next(int i, Unit& u) const { u.li = i; if (!o.map(i, u.pm, u.pn)) return false; u.e = expert_of_row_l(pst, u.pm * BM); return true; }
    __device__ __forceinline__ const char* a_base(const Unit& u) const { return A + (size_t)u.pm * BM * K * 2; }
    __device__ __forceinline__ const char* b_base(const Unit& u) const { return Bt + ((size_t)u.e * 1024 + (size_t)u.pn * BM) * K * 2; }
    __device__ __forceinline__ void a_voff(const Unit&, const int (&R)[2], const int (&C)[2], unsigned (&v)[2][2]) const {
#pragma unroll
        for (int h = 0; h < 2; ++h)
#pragma unroll
            for (int i = 0; i < 2; ++i) v[h][i] = (unsigned)((h * HALF + R[i]) * K + C[i]) * 2u;
    }
};
struct EpiSwiglu {
    static constexpr bool PERM = true;
    bf16* O; const PG8_LAS float* rowr;
    __device__ __forceinline__ void operator()(const f32x4 (&acc)[2][2][4][2], const Unit& u, int wr, int wc, int fr, int fq) const {
        const int row0 = u.pm * BM + wr * 64 + fr, col0 = u.pn * HALF + wc * 32 + 8 * fq;
#pragma unroll
        for (int ai = 0; ai < 2; ++ai)
#pragma unroll
            for (int m = 0; m < 4; ++m) { unsigned char* rowp = (unsigned char*)O + (size_t)(row0 + ai * HALF + m * 16) * 512 + col0;
                 const float rs = rowr[u.li * BM + wr * 64 + fr + ai * HALF + m * 16];
                float hv[8];
#pragma unroll
                for (int n = 0; n < 2; ++n)
#pragma unroll
                    for (int j = 0; j < 4; ++j) { const float g = acc[ai][0][m][n][j] * rs, up = acc[ai][1][m][n][j] * rs; hv[n * 4 + j] = g * up * __builtin_amdgcn_rcpf(1.f + __expf(-g)); }
                u32x2 w; w.x = pk4_fp8(hv[0], hv[1], hv[2], hv[3]); w.y = pk4_fp8(hv[4], hv[5], hv[6], hv[7]);
                *(u32x2*)rowp = w; }
    }
};
struct EpiDown {
    static constexpr bool PERM = true;
    bf16* Y; const int* rowtok; const float* roww;
    __device__ __forceinline__ void operator()(const f32x4 (&acc)[2][2][4][2], const Unit& u, int wr, int wc, int fr, int fq) const {
        const int row0 = u.pm * BM + wr * 64 + fr, col0 = u.pn * BM + wc * 32 + 8 * fq;
#pragma unroll
        for (int ai = 0; ai < 2; ++ai)
#pragma unroll
            for (int m = 0; m < 4; ++m) { const int pos = row0 + ai * HALF + m * 16; const int tk = rowtok[pos]; const float w = roww[pos];
                if (tk >= 0) { bf16* rowp = Y + ((size_t)(tk & 1) * 65536 + (size_t)(tk >> 1)) * 1024 + col0;
#pragma unroll
                    for (int bj = 0; bj < 2; ++bj) { const f32x4 v0 = acc[ai][bj][m][0] * w, v1 = acc[ai][bj][m][1] * w;
                        u32x4 o; o.x = cvt_pk_bf16(v0[0], v0[1]); o.y = cvt_pk_bf16(v0[2], v0[3]); o.z = cvt_pk_bf16(v1[0], v1[1]); o.w = cvt_pk_bf16(v1[2], v1[3]);
                        *(u32x4*)(rowp + bj * HALF) = o; } } }
    }
};

typedef int i32x4v __attribute__((ext_vector_type(4)));
typedef int i32x8v __attribute__((ext_vector_type(8)));
template <class Epi, class Sched, bool ALIGN_EPI = true, bool F8 = false>
__device__ __forceinline__ void gemm_phase(PG8_LAS unsigned char* lds, const int K, const Sched& S, const Epi& E) {
    int tid = threadIdx.x; asm volatile("" : "+v"(tid));
    const int wid = __builtin_amdgcn_readfirstlane(tid >> 6), lane = tid & 63, wr = wid >> 2, wc = wid & 3, fr = lane & 15, fq = lane >> 4;
    const int nt = K / BK;
    int Rr[2], Cc[2]; unsigned voffB[2];
#pragma unroll
    for (int i = 0; i < 2; ++i) { int R, C; stage_rc(tid * 16 + i * 8192, R, C); const int Rb = Epi::PERM ? ((R & ~31) + perm32(R & 31)) : R;
        Rr[i] = R; Cc[i] = C; voffB[i] = (unsigned)(Rb * K + C) * 2u; }
    const size_t kstep = (size_t)(BK * 2);
    const size_t hstep = (size_t)HALF * K * 2;
    const unsigned ldsw = (unsigned)wid * 1024u;
    const int aoff = lds_byte(wr * 64 + fr, fq * 8), boff = lds_byte(wc * 32 + fr, fq * 8);
#define PG8_SA(b, h) (((b) * 2 + (h)) * HTB)
#define PG8_SB(b, h) ((4 + (b) * 2 + (h)) * HTB)
#define PG8_STAGE(bufoff, gbase, voff) do { _Pragma("unroll") for (int _i = 0; _i < 2; ++_i) \
        __builtin_amdgcn_global_load_lds((const unsigned*)((const char*)(gbase) + (voff)[_i]), (PG8_LAS unsigned*)(lds + (bufoff) + ldsw + _i * 8192), 16, 0, 0); } while (0)
#define PG8_CAT(x0, x1) __builtin_shufflevector(__builtin_bit_cast(i32x4v, x0), __builtin_bit_cast(i32x4v, x1), 0, 1, 2, 3, 4, 5, 6, 7)
#define PG8_LDA(dst, b, h) do { if constexpr (F8) { _Pragma("unroll") for (int m = 0; m < 4; ++m) dst##8[m] = PG8_CAT(*(const PG8_LAS bf16x8*)(lds + PG8_SA(b, h) + aoff + m * 2048), *(const PG8_LAS bf16x8*)(lds + PG8_SA(b, h) + aoff + m * 2048 + 1024)); } \
        else { _Pragma("unroll") for (int m = 0; m < 4; ++m) _Pragma("unroll") for (int k = 0; k < 2; ++k) dst[m][k] = *(const PG8_LAS bf16x8*)(lds + PG8_SA(b, h) + aoff + m * 2048 + k * 1024); } } while (0)
#define PG8_LDB(dst, b, h) do { if constexpr (F8) { _Pragma("unroll") for (int n = 0; n < 2; ++n) dst##8[n] = PG8_CAT(*(const PG8_LAS bf16x8*)(lds + PG8_SB(b, h) + boff + n * 2048), *(const PG8_LAS bf16x8*)(lds + PG8_SB(b, h) + boff + n * 2048 + 1024)); } \
        else { _Pragma("unroll") for (int n = 0; n < 2; ++n) _Pragma("unroll") for (int k = 0; k < 2; ++k) dst[n][k] = *(const PG8_LAS bf16x8*)(lds + PG8_SB(b, h) + boff + n * 2048 + k * 1024); } } while (0)
#define PG8_MMA(ai, bj, At, Bt) do { __builtin_amdgcn_s_setprio(1); \
        if constexpr (F8) { __builtin_amdgcn_sched_barrier(0); _Pragma("unroll") for (int m = 0; m < 4; ++m) _Pragma("unroll") for (int n = 0; n < 2; ++n) \
            asm volatile("v_mfma_scale_f32_16x16x128_f8f6f4 %0, %1, %2, %0, %3, %3 op_sel_hi:[0,0,0]" : "+v"(acc[ai][bj][m][n]) : "v"(Bt##8[n]), "v"(At##8[m]), "v"(f8scale)); __builtin_amdgcn_sched_barrier(0); } \
        else { _Pragma("unroll") for (int m = 0; m < 4; ++m) _Pragma("unroll") for (int n = 0; n < 2; ++n) _Pragma("unroll") for (int k = 0; k < 2; ++k) \
            acc[ai][bj][m][n] = __builtin_amdgcn_mfma_f32_16x16x32_bf16(Bt[n][k], At[m][k], acc[ai][bj][m][n], 0, 0, 0); } \
        __builtin_amdgcn_s_setprio(0); } while (0)
#define PG8_WAIT_V(n) asm volatile("s_waitcnt vmcnt(" #n ")" ::: "memory")
#define PG8_WAIT_L(n) asm volatile("s_waitcnt lgkmcnt(" #n ")" ::: "memory")
#define PG8_BAR __builtin_amdgcn_s_barrier()
#define PG8_SCHED __builtin_amdgcn_sched_barrier(0)
    Unit cur, nxt; int ui = 0;
    if (!S.next(0, cur)) return;
    f32x4 acc[2][2][4][2];
#pragma unroll
    for (int a = 0; a < 2; ++a)
#pragma unroll
        for (int b = 0; b < 2; ++b)
#pragma unroll
            for (int m = 0; m < 4; ++m)
#pragma unroll
                for (int n = 0; n < 2; ++n) acc[a][b][m][n] = (f32x4){0.f, 0.f, 0.f, 0.f};
    bf16x8 At[4][2], B0[2][2], B1[2][2];
    i32x8v At8[4], B08[2], B18[2]; const int f8scale = 127;
    unsigned cv[2][2], nv[2][2];
    S.a_voff(cur, Rr, Cc, cv);
#pragma unroll
    for (int h = 0; h < 2; ++h)
#pragma unroll
        for (int i = 0; i < 2; ++i) nv[h][i] = cv[h][i];
    const char* cA = S.a_base(cur); const char* cB = S.b_base(cur);
    PG8_STAGE(PG8_SB(0, 0), cB, voffB); PG8_STAGE(PG8_SB(0, 1), cB + hstep, voffB); PG8_STAGE(PG8_SA(0, 0), cA, cv[0]); PG8_STAGE(PG8_SA(0, 1), cA, cv[1]);
    if (wr == 1) PG8_BAR;
    PG8_WAIT_V(2); PG8_BAR;
    PG8_STAGE(PG8_SB(1, 0), cB + kstep, voffB); PG8_STAGE(PG8_SA(1, 0), cA + kstep, cv[0]); PG8_STAGE(PG8_SB(1, 1), cB + hstep + kstep, voffB);
    PG8_WAIT_V(6); PG8_BAR;
    for (;;) {
        const bool has_next = S.next(ui + 1, nxt);
        const char* nA = has_next ? S.a_base(nxt) : cA; const char* nB = has_next ? S.b_base(nxt) : cB;
#pragma unroll 1
        for (int t = 0; t < nt; t += 2) {
            const bool last = (t == nt - 2);
            const char* a1 = cA + (size_t)(t + 1) * kstep;
            const char* a2 = last ? nA : cA + (size_t)(t + 2) * kstep; const char* b2 = last ? nB : cB + (size_t)(t + 2) * kstep;
            const char* a3 = a2 + kstep; const char* b3 = b2 + kstep;
            unsigned v2[2][2];
            if constexpr (Sched::GATHER) {
                if (last && has_next) { S.a_voff(nxt, Rr, Cc, nv); }
#pragma unroll
                for (int h = 0; h < 2; ++h)
#pragma unroll
                    for (int i = 0; i < 2; ++i) v2[h][i] = last ? nv[h][i] : cv[h][i];
            } else {
#pragma unroll
                for (int h = 0; h < 2; ++h)
#pragma unroll
                    for (int i = 0; i < 2; ++i) v2[h][i] = cv[h][i];
            }
            PG8_LDB(B0, 0, 0); PG8_LDB(B1, 0, 1); PG8_SCHED; PG8_LDA(At, 0, 0); PG8_STAGE(PG8_SA(1, 1), a1, cv[1]);
            PG8_WAIT_V(8); PG8_WAIT_L(0); PG8_BAR; PG8_MMA(0, 0, At, B0); PG8_MMA(0, 1, At, B1); PG8_BAR; PG8_SCHED;
            PG8_LDA(At, 0, 1); PG8_STAGE(PG8_SB(0, 0), b2, voffB); PG8_STAGE(PG8_SB(0, 1), b2 + hstep, voffB); PG8_STAGE(PG8_SA(0, 0), a2, v2[0]);
            PG8_WAIT_V(8); PG8_WAIT_L(0); PG8_BAR; PG8_MMA(1, 0, At, B0); PG8_MMA(1, 1, At, B1); PG8_BAR; PG8_SCHED;
            PG8_LDB(B0, 1, 0); PG8_LDB(B1, 1, 1); PG8_SCHED; PG8_LDA(At, 1, 0); PG8_STAGE(PG8_SA(0, 1), a2, v2[1]);
            PG8_WAIT_V(8); PG8_WAIT_L(0); PG8_BAR; PG8_MMA(0, 0, At, B0); PG8_MMA(0, 1, At, B1); PG8_BAR; PG8_SCHED;
            PG8_LDA(At, 1, 1); PG8_STAGE(PG8_SB(1, 0), b3, voffB); PG8_STAGE(PG8_SB(1, 1), b3 + hstep, voffB); PG8_STAGE(PG8_SA(1, 0), a3, v2[0]);
            PG8_WAIT_V(8); PG8_WAIT_L(0); PG8_BAR; PG8_MMA(1, 0, At, B0); PG8_MMA(1, 1, At, B1); PG8_BAR; PG8_SCHED;
        }
        if constexpr (ALIGN_EPI) { if (wr == 0) PG8_BAR; }
        if constexpr (F8) { asm volatile("s_nop 15\n\ts_nop 15" ::: "memory"); }
        E(acc, cur, wr, wc, fr, fq);
        if (!has_next) break;
#pragma unroll
        for (int a = 0; a < 2; ++a)
#pragma unroll
            for (int b = 0; b < 2; ++b)
#pragma unroll
                for (int m = 0; m < 4; ++m)
#pragma unroll
                    for (int n = 0; n < 2; ++n) acc[a][b][m][n] = (f32x4){0.f, 0.f, 0.f, 0.f};
        cur = nxt; cA = nA; cB = nB; ++ui;
#pragma unroll
        for (int h = 0; h < 2; ++h)
#pragma unroll
            for (int i = 0; i < 2; ++i) cv[h][i] = nv[h][i];
        if constexpr (ALIGN_EPI) { if (wr == 1) PG8_BAR; }
    }
    PG8_WAIT_V(0);
    if constexpr (!ALIGN_EPI) { if (wr == 0) PG8_BAR; }
    PG8_BAR;
#undef PG8_SA
#undef PG8_SB
#undef PG8_STAGE
#undef PG8_LDA
#undef PG8_LDB
#undef PG8_MMA
#undef PG8_CAT
#undef PG8_WAIT_V
#undef PG8_WAIT_L
#undef PG8_BAR
#undef PG8_SCHED
}
}

#define XB_TMO      128
#define XB_XCNT(j)  (256  + 64 * (j))
#define XB_XSUB(j)  (1280 + 64 * (j))
#define XB_XGEN(j)  (2304 + 64 * (j))
#define XB_TOP      3328
#define XB_TOPGEN   3392
#define XCD_BAR_WORDS 3456
#define XB_SPIN_CAP (1u << 22)

__device__ __forceinline__ unsigned xb_ld(unsigned* p)              { return __hip_atomic_load(p, __ATOMIC_RELAXED, __HIP_MEMORY_SCOPE_AGENT); }
__device__ __forceinline__ unsigned xb_add(unsigned* p, unsigned v) { return __hip_atomic_fetch_add(p, v, __ATOMIC_RELAXED, __HIP_MEMORY_SCOPE_AGENT); }
__device__ __forceinline__ unsigned xb_xcc_id() { return (unsigned)__builtin_amdgcn_s_getreg((3 << 11) | 20) & 0xFu; }
#define XB_SPIN(cond, bar) do { unsigned _sp = 0; while (cond) { __builtin_amdgcn_s_sleep(1); \
    if ((++_sp & 255u) == 0u) { if (xb_ld(&(bar)[XB_TMO])) break; if (_sp > XB_SPIN_CAP) { atomicAdd(&(bar)[XB_TMO], 1u); break; } } } } while (0)

struct XcdBarrier { unsigned* bar; unsigned x; volatile LAS unsigned* st; };

__device__ __forceinline__ XcdBarrier xcd_barrier_post(unsigned* bar, volatile LAS unsigned* st) {
    XcdBarrier b; b.bar = bar; b.x = xb_xcc_id(); b.st = st;
    if (threadIdx.x == 0) (void)xb_add(&bar[XB_XCNT(b.x)], 1u);
    return b;
}
__device__ __forceinline__ void xcd_barrier_complete(unsigned* bar, unsigned x, unsigned& nloc, unsigned& nx) {
    const unsigned G = gridDim.x * gridDim.y * gridDim.z;
    unsigned sum, cnt, mine, sp = 0u;
    for (;;) {
        sum = 0u; cnt = 0u; mine = 0u;
#pragma unroll
        for (unsigned j = 0; j < 16; ++j) { const unsigned c = xb_ld(&bar[XB_XCNT(j)]); sum += c; cnt += (c > 0u) ? 1u : 0u; mine = (j == x) ? c : mine; }
        if (sum == G) break;
        __builtin_amdgcn_s_sleep(1);
        if ((++sp & 255u) == 0u) { if (xb_ld(&bar[XB_TMO])) break; if (sp > XB_SPIN_CAP) { atomicAdd(&bar[XB_TMO], 1u); break; } }
    }
    nloc = mine > 0u ? mine : 1u; nx = cnt > 0u ? cnt : 1u;
}
__device__ __forceinline__ void xcd_barrier(const XcdBarrier& b) {
    asm volatile("s_waitcnt vmcnt(0)" ::: "memory");
    __syncthreads();
    if (threadIdx.x == 0) {
        unsigned* bar = b.bar;
        __builtin_amdgcn_s_waitcnt(0);
        unsigned nloc = b.st[0], nx = b.st[1];
        if (nloc == 0u) { xcd_barrier_complete(bar, b.x, nloc, nx); b.st[0] = nloc; b.st[1] = nx; }
        const unsigned old = xb_add(&bar[XB_XSUB(b.x)], 1u);
        const unsigned gen = old / nloc;
        if (old + 1u == (gen + 1u) * nloc) {
            __builtin_amdgcn_fence(__ATOMIC_RELEASE, "agent");
            asm volatile("s_waitcnt vmcnt(0)" ::: "memory");
            const unsigned og = xb_add(&bar[XB_TOP], 1u);
            const unsigned tg = og / nx;
            if (og + 1u == (tg + 1u) * nx) xb_add(&bar[XB_TOPGEN], 1u);
            else XB_SPIN(xb_ld(&bar[XB_TOPGEN]) == tg, bar);
            __builtin_amdgcn_fence(__ATOMIC_ACQUIRE, "agent");
            xb_add(&bar[XB_XGEN(b.x)], 1u);
            asm volatile("s_waitcnt vmcnt(0)" ::: "memory");
        } else {
            XB_SPIN(xb_ld(&bar[XB_XGEN(b.x)]) == gen, bar);
            __builtin_amdgcn_fence(__ATOMIC_ACQUIRE, "agent");
            asm volatile("s_waitcnt vmcnt(0)" ::: "memory");
        }
    }
    __syncthreads();
}

struct Args {
    const float* in[24];
    float* out;
    unsigned char* ws;
    int ph_lo, ph_hi;
};

struct TrItem { const float* src; int ldsrc, k0, n0s; bf16* dst; int ldd, drow0; const float* kscale; int f8; };
__device__ __forceinline__ void tr_load(const TrItem& t, f32x4 (&v)[8], int lane) {
#pragma unroll
    for (int i = 0; i < 8; ++i) v[i] = *(const f32x4*)(t.src + (size_t)(t.k0 + (lane >> 3) + 8 * i) * t.ldsrc + t.n0s + 4 * (lane & 7));
}
__device__ __forceinline__ void tr_finish(const TrItem& t, const f32x4 (&v)[8], LAS float* scr, int lane) {
#pragma unroll
    for (int i = 0; i < 8; ++i) { const int kk = (lane >> 3) + 8 * i; f32x4 x = v[i]; if (t.kscale) x = x * t.kscale[t.k0 + kk];
        LAS float* d = scr + kk * 33 + 4 * (lane & 7); d[0] = x.x; d[1] = x.y; d[2] = x.z; d[3] = x.w; }
    LDS_WAIT();
    const int c = lane & 7;
#pragma unroll
    for (int j = 0; j < 4; ++j) { const int n = (lane >> 3) + 8 * j; const LAS float* s = scr + (8 * c) * 33 + n;
        if (t.f8) { u32x2 o; o.x = pk4_fp8(s[0 * 33], s[1 * 33], s[2 * 33], s[3 * 33]); o.y = pk4_fp8(s[4 * 33], s[5 * 33], s[6 * 33], s[7 * 33]);
            *(u32x2*)((unsigned char*)t.dst + (size_t)(t.drow0 + n) * t.ldd + t.k0 + 8 * c) = o; }
        else { u32x4 o; o.x = pk2(s[0 * 33], s[1 * 33]); o.y = pk2(s[2 * 33], s[3 * 33]); o.z = pk2(s[4 * 33], s[5 * 33]); o.w = pk2(s[6 * 33], s[7 * 33]);
            *(u32x4*)(t.dst + (size_t)(t.drow0 + n) * t.ldd + t.k0 + 8 * c) = o; } }
    LDS_WAIT();
}

__device__ __forceinline__ void p0_prologue(const Args& a, LAS unsigned char* lds, int tid, int lane, int wave, int wg, int G) {
    unsigned char* ws = a.ws;
    const float* x = a.in[0]; const float* norm1_w = a.in[1]; const float* w_in = a.in[2]; const float* b_ig = a.in[3]; const float* b_fg = a.in[4];
    const float* w_out = a.in[15]; const float* w_gate = a.in[21]; const float* w_up = a.in[22]; const float* w_down = a.in[23];
    bf16* W1T = (bf16*)(ws + WS_W1T); bf16* W2T = (bf16*)(ws + WS_W2T); bf16* WGU = (bf16*)(ws + WS_WGU); bf16* WD = (bf16*)(ws + WS_WD);
    bf16* H1 = (bf16*)(ws + WS_H1); float* GATES = (float*)(ws + WS_GATES);
    LAS float* scr = (LAS float*)(lds + wave * 8448);
    LAS float* gwl = (LAS float*)(lds + 73728);
    {
        float gv[16];
#pragma unroll
        for (int q = 0; q < 16; ++q) { const int idx = tid + NTHR * q; gv[q] = w_in[(size_t)(idx >> 3) * INCOLS + 2048 + (idx & 7)]; }
#pragma unroll
        for (int q = 0; q < 16; ++q) gwl[tid + NTHR * q] = gv[q];
    }
    {
        const float* norm2_w = a.in[16]; const float* w_group = a.in[17]; const float* w_expert = a.in[19]; unsigned char* RIMG = ws + WS_RIMG;
        const int idx = wg * NTHR + tid;
        if (idx < 36864) { int k, c; float v;
            if (idx < 4096) { k = idx >> 2; c = idx & 3; v = w_group[idx]; } else { const int j = idx - 4096; k = j >> 5; c = 4 + (j & 31); v = w_expert[j]; }
            v *= norm2_w[k];
            const unsigned hi = f2bf(v), lo = f2bf(v - __uint_as_float(hi << 16));
            *(bf16*)(RIMG + c * 2064 + k * 2) = (bf16)hi; *(bf16*)(RIMG + 36 * 2064 + c * 2064 + k * 2) = (bf16)lo; }
    }
    __syncthreads();
    const int gw = wg * NWAVES + wave, NGW = G * NWAVES;
    constexpr int I_1 = 16 * 112, I_2 = 16 * 32, I_GU = NEXP * 16 * 32, NITEMS = I_1 + I_2 + I_GU;
    auto item_desc = [&](int it) -> TrItem {
        int r = it;
        if (r < I_1) { const int kb = r / 112, nb = r % 112, n0 = nb * 32; int sc_ = n0;
            if (n0 >= 2048 && n0 < 3072) { const int p0 = n0 & 255; sc_ = (n0 & ~255) + 64 * ((p0 >> 5) & 3) + 32 * (p0 >> 7); }
            return TrItem{w_in, INCOLS, kb * 64, sc_ < 2048 ? sc_ : sc_ + 8, W1T, 1024, n0, nullptr, 0}; } r -= I_1;
        if (r < I_2) { const int kb = r / 32, nb = r % 32; return TrItem{w_out, 1024, kb * 64, nb * 32, W2T, 1024, nb * 32, nullptr, 0}; } r -= I_2;
        { const int e = r / 512, q = r % 512, kb = q / 32, nb = q % 32, j0 = nb * 32, pn = j0 >> 8, rr = j0 & 255;
            const float* s_ = (rr < 128 ? w_gate : w_up) + (size_t)e * 1024 * 512;
            return TrItem{s_, 512, kb * 64, pn * 128 + (rr & 127), (bf16*)((unsigned char*)WGU + (size_t)e * 1024 * 1024), 1024, j0, a.in[16], 1}; }
    };
    if (gw < NITEMS) {
        TrItem cur = item_desc(gw); f32x4 tv[8]; tr_load(cur, tv, lane);
#pragma unroll 1
        for (int it = gw; it < NITEMS; it += NGW) {
            f32x4 cv_[8];
#pragma unroll
            for (int i = 0; i < 8; ++i) cv_[i] = tv[i];
            const TrItem me = cur;
            if (it + NGW < NITEMS) { cur = item_desc(it + NGW); tr_load(cur, tv, lane); }
            tr_finish(me, cv_, scr, lane);
        }
    }
    f32x4 w1v[4];
#pragma unroll
    for (int j = 0; j < 4; ++j) w1v[j] = ((const f32x4*)norm1_w)[lane + 64 * j];
    f32x4 nx[4], nx2[4];
#pragma unroll
    for (int j = 0; j < 4; ++j) { nx[j] = ((const f32x4*)(x + (size_t)gw * DM))[lane + 64 * j]; nx2[j] = ((const f32x4*)(x + (size_t)(gw + NGW) * DM))[lane + 64 * j]; }
    const int gc = ((lane >> 5) & 1) * 4 + ((lane >> 4) & 1) * 2 + ((lane >> 3) & 1), gh = gc & 3;
    const float gbias = (gc < 4) ? b_ig[gh] : b_fg[gh];
#pragma unroll 1
    for (int m = gw; m < T_; m += NGW) {
        f32x4 v[4]; float ss = 0.f;
#pragma unroll
        for (int j = 0; j < 4; ++j) { v[j] = nx[j]; nx[j] = nx2[j]; ss += (v[j].x * v[j].x + v[j].y * v[j].y) + (v[j].z * v[j].z + v[j].w * v[j].w); }
        if (m + 2 * NGW < T_) {
#pragma unroll
            for (int j = 0; j < 4; ++j) nx2[j] = ((const f32x4*)(x + (size_t)(m + 2 * NGW) * DM))[lane + 64 * j]; }
        const float r = rsqrtf(wave_sum(ss) * (1.f / DM) + EPS);
        float g[8];
#pragma unroll
        for (int c = 0; c < 8; ++c) g[c] = 0.f;
        u32x2* o8 = (u32x2*)(H1 + (size_t)m * DM) + lane;
#pragma unroll
        for (int j = 0; j < 4; ++j) {
            const f32x4 hv = v[j] * r * w1v[j];
            u32x2 o; o.x = pk2(hv.x, hv.y); o.y = pk2(hv.z, hv.w); o8[64 * j] = o;
#pragma unroll
            for (int i = 0; i < 4; ++i) { const int k = 256 * j + 4 * lane + i; const f32x4 ga = *(const LAS f32x4*)(gwl + k * 8), gb = *(const LAS f32x4*)(gwl + k * 8 + 4);
                const float hh = hv[i];
                g[0] += hh * ga.x; g[1] += hh * ga.y; g[2] += hh * ga.z; g[3] += hh * ga.w; g[4] += hh * gb.x; g[5] += hh * gb.y; g[6] += hh * gb.z; g[7] += hh * gb.w; }
        }
        float k4[4], k2[2], k1;
        { const bool up = (lane & 32) != 0;
#pragma unroll
          for (int i = 0; i < 4; ++i) { const float send = up ? g[i] : g[i + 4]; const float recv = __shfl_xor(send, 32); k4[i] = (up ? g[i + 4] : g[i]) + recv; } }
        { const bool up = (lane & 16) != 0;
#pragma unroll
          for (int i = 0; i < 2; ++i) { const float send = up ? k4[i] : k4[i + 2]; const float recv = __shfl_xor(send, 16); k2[i] = (up ? k4[i + 2] : k4[i]) + recv; } }
        { const bool up = (lane & 8) != 0; const float send = up ? k2[0] : k2[1]; const float recv = __shfl_xor(send, 8); k1 = (up ? k2[1] : k2[0]) + recv; }
        k1 += __shfl_xor(k1, 4); k1 += __shfl_xor(k1, 2); k1 += __shfl_xor(k1, 1);
        if ((lane & 7) == 0) {
            float res = k1 + gbias;
            if (gc >= 4) res = fminf(res, 0.f) - log1pf(__expf(-fabsf(res)));
            GATES[(size_t)m * 8 + gc] = res;
        }
    }
}

__device__ __forceinline__ void p1_stagger_work(const Args& a, LAS unsigned char* lds, int lane, int wave, int wg) {
    const int g = wg & 3; if (g == 0) return;
    const float* w_down = a.in[23]; bf16* WD = (bf16*)(a.ws + WS_WD);
    constexpr int NIT = NEXP * 8 * 32;
    const int lo = (g == 1) ? 0 : (g == 2) ? NIT / 6 : NIT / 2, hi = (g == 1) ? NIT / 6 : (g == 2) ? NIT / 2 : NIT;
    LAS float* scr = (LAS float*)(lds + wave * 8448);
    const int gw = (wg >> 2) * NWAVES + wave, NGW = 64 * NWAVES;
    auto desc = [&](int r) -> TrItem { const int e = r / 256, q = r % 256, kb = q / 32, nb = q % 32;
        return TrItem{w_down + (size_t)e * 512 * 1024, 1024, kb * 64, nb * 32, (bf16*)((unsigned char*)WD + (size_t)e * 1024 * 512), 512, nb * 32, nullptr, 1}; };
    if (lo + gw < hi) {
        TrItem cur = desc(lo + gw); f32x4 tv[8]; tr_load(cur, tv, lane);
#pragma unroll 1
        for (int it = lo + gw; it < hi; it += NGW) {
            f32x4 cv_[8];
#pragma unroll
            for (int i = 0; i < 8; ++i) cv_[i] = tv[i];
            const TrItem me = cur;
            if (it + NGW < hi) { cur = desc(it + NGW); tr_load(cur, tv, lane); }
            tr_finish(me, cv_, scr, lane);
        }
    }
}

__device__ __forceinline__ void mlstm_naive(const Args& a, LAS unsigned char* lds, int item, int tid, int lane, int wave) {
    unsigned char* ws = a.ws;
    const bf16* PROJ = (const bf16*)(ws + WS_PROJ); const float* GATES = (const float*)(ws + WS_GATES); bf16* MIX = (bf16*)(ws + WS_MIX);
    const float* conv_w = a.in[5]; const float* conv_b = a.in[6]; const float* m_norm_w = a.in[7];
    LAS float* qs = (LAS float*)lds; LAS float* ks = qs + 8192; LAS float* vs = ks + 8192; LAS float* hb = vs + 8192;
    LAS float* red = hb + 8192; LAS float* dred = red + 1024; LAS float* igs = dred + 16; LAS float* lfs = igs + 64;
    const int b = item >> 2, h = item & 3, e = tid & 127, dq = tid >> 7;
    float Cr[32], nr[32];
#pragma unroll
    for (int j = 0; j < 32; ++j) { Cr[j] = 0.f; nr[j] = 0.f; }
    float m = 0.f;
    const float mw0 = m_norm_w[lane], mw1 = m_norm_w[lane + 64];
    for (int c = 0; c < SEQ / 64; ++c) {
        const int t0 = c * 64;
        for (int idx = tid; idx < 8192; idx += NTHR) {
            const int tt = idx >> 7, d = idx & 127, t = t0 + tt, colq = C_MQ + h * 128 + d, colk = C_MK + h * 128 + d;
            float aq = conv_b[colq], ak = conv_b[colk];
#pragma unroll
            for (int j = 0; j < 4; ++j) { const int ts = t - 3 + j; if (ts >= 0) { const bf16* row = PROJ + (size_t)(b * SEQ + ts) * NCOL; aq += bf2f(row[colq]) * conv_w[j * 1024 + colq]; ak += bf2f(row[colk]) * conv_w[j * 1024 + colk]; } }
            qs[idx] = siluf_(aq); ks[idx] = siluf_(ak) * 0.08838834764831845f;
            vs[idx] = bf2f(PROJ[(size_t)(b * SEQ + t) * NCOL + C_MV + h * 128 + d]);
        }
        if (tid < 64) { igs[tid] = GATES[(size_t)(b * SEQ + t0 + tid) * 8 + h]; lfs[tid] = GATES[(size_t)(b * SEQ + t0 + tid) * 8 + 4 + h]; }
        __syncthreads();
        for (int tt = 0; tt < 64; ++tt) {
            const float lf = lfs[tt], ig = igs[tt];
            const float mnew = fmaxf(lf + m, ig), fd = __expf(lf + m - mnew), iw = __expf(ig - mnew); m = mnew;
            const float ve = vs[tt * 128 + e] * iw;
            float num = 0.f, den = 0.f;
#pragma unroll
            for (int j = 0; j < 32; ++j) { const int d = dq * 32 + j; const float kd = ks[tt * 128 + d], qd = qs[tt * 128 + d];
                Cr[j] = fd * Cr[j] + kd * ve; nr[j] = fd * nr[j] + iw * kd; num += qd * Cr[j]; den += qd * nr[j]; }
            const int p = tt & 1;
            red[(p * 4 + dq) * 128 + e] = num; if (e == 0) dred[p * 4 + dq] = den;
            __syncthreads();
            if (dq == 0) { const float ntot = (red[(p * 4 + 0) * 128 + e] + red[(p * 4 + 1) * 128 + e]) + (red[(p * 4 + 2) * 128 + e] + red[(p * 4 + 3) * 128 + e]);
                const float dtot = (dred[p * 4 + 0] + dred[p * 4 + 1]) + (dred[p * 4 + 2] + dred[p * 4 + 3]);
                hb[tt * 128 + e] = ntot / fmaxf(fabsf(dtot), __expf(-mnew)); }
        }
        __syncthreads();
#pragma unroll 1
        for (int rr = 0; rr < 8; ++rr) {
            const int tt = wave * 8 + rr, t = t0 + tt; const bf16* rowp = PROJ + (size_t)(b * SEQ + t) * NCOL + C_MO + h * 128;
            const float y0 = hb[tt * 128 + lane] * sigmoidf_(bf2f(rowp[lane])), y1 = hb[tt * 128 + lane + 64] * sigmoidf_(bf2f(rowp[lane + 64]));
            const float r = rsqrtf(wave_sum(y0 * y0 + y1 * y1) * (1.f / 128.f) + EPS);
            bf16* orow = MIX + (size_t)(b * SEQ + t) * DM + h * 128;
            orow[lane] = (bf16)f2bf(y0 * r * mw0); orow[lane + 64] = (bf16)f2bf(y1 * r * mw1);
        }
        __syncthreads();
    }
}

__device__ __forceinline__ void attn_naive_row(const Args& a, LAS float* sc, LAS float* qsl, int ridx, int lane, float lam) {
    unsigned char* ws = a.ws;
    const bf16* PROJ = (const bf16*)(ws + WS_PROJ); bf16* MIX = (bf16*)(ws + WS_MIX);
    const float* qnw = a.in[8]; const float* knw = a.in[9]; const float* anw = a.in[14];
    const int h = ridx & 3, bt = ridx >> 2, t = bt & (SEQ - 1), b = bt >> 11;
    {
        const unsigned u = *(const unsigned*)(PROJ + (size_t)bt * NCOL + C_AQ + h * 128 + 2 * lane);
        const float q0 = bflo(u), q1 = bfhi(u); float ss = q0 * q0 + q1 * q1;
#pragma unroll
        for (int o = 1; o < 32; o <<= 1) ss += __shfl_xor(ss, o);
        const float rq = rsqrtf(ss * (1.f / 64.f) + EPS) * 0.125f; const int dd = (2 * lane) & 63;
        qsl[2 * lane] = q0 * rq * qnw[dd] * knw[dd]; qsl[2 * lane + 1] = q1 * rq * qnw[dd + 1] * knw[dd + 1];
    }
    LDS_WAIT();
    const int nk = ((t >> 6) + 1) * 64;
    float m0 = -1e30f, m1 = -1e30f;
    for (int j = lane; j < nk; j += 64) {
        const u32x4* krow = (const u32x4*)(PROJ + (size_t)(b * SEQ + j) * NCOL + C_AK + h * 128);
        float s0 = 0.f, ss0 = 0.f, s1 = 0.f, ss1 = 0.f;
#pragma unroll
        for (int q = 0; q < 8; ++q) { const u32x4 kv = krow[q]; const f32x4 qa = *(const LAS f32x4*)(qsl + q * 8), qb = *(const LAS f32x4*)(qsl + q * 8 + 4);
            const float k0 = bflo(kv.x), k1 = bfhi(kv.x), k2 = bflo(kv.y), k3 = bfhi(kv.y), k4 = bflo(kv.z), k5 = bfhi(kv.z), k6 = bflo(kv.w), k7 = bfhi(kv.w);
            s0 += qa.x * k0 + qa.y * k1 + qa.z * k2 + qa.w * k3 + qb.x * k4 + qb.y * k5 + qb.z * k6 + qb.w * k7;
            ss0 += k0 * k0 + k1 * k1 + k2 * k2 + k3 * k3 + k4 * k4 + k5 * k5 + k6 * k6 + k7 * k7; }
#pragma unroll
        for (int q = 8; q < 16; ++q) { const u32x4 kv = krow[q]; const f32x4 qa = *(const LAS f32x4*)(qsl + q * 8), qb = *(const LAS f32x4*)(qsl + q * 8 + 4);
            const float k0 = bflo(kv.x), k1 = bfhi(kv.x), k2 = bflo(kv.y), k3 = bfhi(kv.y), k4 = bflo(kv.z), k5 = bfhi(kv.z), k6 = bflo(kv.w), k7 = bfhi(kv.w);
            s1 += qa.x * k0 + qa.y * k1 + qa.z * k2 + qa.w * k3 + qb.x * k4 + qb.y * k5 + qb.z * k6 + qb.w * k7;
            ss1 += k0 * k0 + k1 * k1 + k2 * k2 + k3 * k3 + k4 * k4 + k5 * k5 + k6 * k6 + k7 * k7; }
        s0 *= rsqrtf(ss0 * (1.f / 64.f) + EPS); s1 *= rsqrtf(ss1 * (1.f / 64.f) + EPS);
        sc[j] = s0; sc[2048 + j] = s1; m0 = fmaxf(m0, s0); m1 = fmaxf(m1, s1);
    }
    m0 = wave_max(m0); m1 = wave_max(m1);
    float l0 = 0.f, l1 = 0.f;
    for (int j = lane; j < nk; j += 64) { const float e0 = __expf(sc[j] - m0), e1 = __expf(sc[2048 + j] - m1); sc[j] = e0; sc[2048 + j] = e1; l0 += e0; l1 += e1; }
    l0 = wave_sum(l0); l1 = wave_sum(l1);
    const float c0 = 1.f / l0, c1 = lam / l1;
    LDS_WAIT();
    float o0 = 0.f, o1 = 0.f;
    const bf16* vb = PROJ + (size_t)(b * SEQ) * NCOL + C_AV + h * 128 + 2 * lane;
    for (int j = 0; j < nk; ++j) { const float p = sc[j] * c0 - sc[2048 + j] * c1; const unsigned u = *(const unsigned*)(vb + (size_t)j * NCOL); o0 += p * bflo(u); o1 += p * bfhi(u); }
    const float r = rsqrtf(wave_sum(o0 * o0 + o1 * o1) * (1.f / 128.f) + EPS) * (1.f - LAMBDA_INIT);
    *(unsigned*)(MIX + (size_t)bt * DM + 512 + h * 128 + 2 * lane) = pk2(o0 * r * anw[2 * lane], o1 * r * anw[2 * lane + 1]);
    LDS_WAIT();
}

__device__ __forceinline__ void p2_naive(const Args& a, LAS unsigned char* lds, int tid, int lane, int wave, int wg, int G) {
    if (wg < NBATCH * 4) mlstm_naive(a, lds, wg, tid, lane, wave);
    __syncthreads();
    const float* lq1 = a.in[10]; const float* lk1 = a.in[11]; const float* lq2 = a.in[12]; const float* lk2 = a.in[13];
    const float lam = __expf(wave_sum(lq1[lane] * lk1[lane])) - __expf(wave_sum(lq2[lane] * lk2[lane])) + LAMBDA_INIT;
    LAS float* sc = (LAS float*)(lds + wave * 16896); LAS float* qsl = sc + 4096;
    unsigned* queue = (unsigned*)(a.ws + WS_CTL) + CW_QUEUE;
    constexpr int NUNITS = T_ * 4 / 8;
    for (;;) {
        unsigned u = 0; if (lane == 0) u = __hip_atomic_fetch_add(queue, 1u, __ATOMIC_RELAXED, __HIP_MEMORY_SCOPE_AGENT);
        u = (unsigned)__builtin_amdgcn_readfirstlane((int)u);
        if (u >= (unsigned)NUNITS) break;
        const int base = (NUNITS - 1 - (int)u) * 8;
        for (int k = 0; k < 8; ++k) attn_naive_row(a, sc, qsl, base + k, lane, lam);
    }
}


namespace ml {
constexpr int QL = 0, KL = 17408, KWT = 34816, VT = 53248, SD = 71680, AV = 80896, MV = 89088, WV = 97280, IT = 105472, FL = 113664;
constexpr int MC = 121856, BEND = 121984, AMAX = 122112, DEC = 122240, NL = 122368, RS = 122880, QN = 123392, PSQ = 123648;
constexpr int QS = 272, TS = 144;
constexpr float L2E = 1.4426950408889634f;
#define LBAR() do { asm volatile("s_waitcnt lgkmcnt(0)" ::: "memory"); __builtin_amdgcn_s_barrier(); asm volatile("" ::: "memory"); } while (0)
__device__ __forceinline__ f32x4 mfma16(bf16x8 a, bf16x8 b, f32x4 c) { return __builtin_amdgcn_mfma_f32_16x16x32_bf16(a, b, c, 0, 0, 0); }
__device__ __forceinline__ unsigned cvtpk(float lo, float hi) { unsigned r; asm volatile("v_cvt_pk_bf16_f32 %0, %1, %2" : "=v"(r) : "v"(lo), "v"(hi)); return r; }
__device__ __forceinline__ unsigned cvtpk_nv(float lo, float hi) { unsigned r; asm("v_cvt_pk_bf16_f32 %0, %1, %2" : "=v"(r) : "v"(lo), "v"(hi)); return r; }
__device__ __forceinline__ f32x2 silu2(f32x2 o) { f32x2 e = o * (-L2E); e.x = __builtin_amdgcn_exp2f(e.x); e.y = __builtin_amdgcn_exp2f(e.y); e = e + 1.0f; e.x = __builtin_amdgcn_rcpf(e.x); e.y = __builtin_amdgcn_rcpf(e.y); return o * e; }

__device__ __forceinline__ void mlstm_item(const Args& a, LAS unsigned char* lds, const int item, const int tid) {
    unsigned char* ws = a.ws;
    const bf16* PROJ = (const bf16*)(ws + WS_PROJ); const float* GATES = (const float*)(ws + WS_GATES); bf16* MIX = (bf16*)(ws + WS_MIX);
    const float* conv_w = a.in[5]; const float* conv_b = a.in[6]; const float* m_norm_w = a.in[7];
    const int wid = __builtin_amdgcn_readfirstlane(tid >> 6), lane = tid & 63, fr = lane & 15, fq = lane >> 4;
    const int b = item >> 2, h = item & 3, e0 = 16 * wid;
    LAS float* AVl = (LAS float*)(lds + AV); LAS float* MVl = (LAS float*)(lds + MV); LAS float* WVl = (LAS float*)(lds + WV); LAS float* ITl = (LAS float*)(lds + IT); LAS float* FLl = (LAS float*)(lds + FL);
    LAS float* MCl = (LAS float*)(lds + MC); LAS float* BENDl = (LAS float*)(lds + BEND); LAS float* AMAXl = (LAS float*)(lds + AMAX); LAS float* DECl = (LAS float*)(lds + DEC);
    LAS float* NLl = (LAS float*)(lds + NL); LAS float* RSl = (LAS float*)(lds + RS); LAS float* QNl = (LAS float*)(lds + QN); LAS float* PSQl = (LAS float*)(lds + PSQ);
#pragma unroll 1
    for (int cc = 0; cc < 4; ++cc) {
        const int c = 4 * wid + cc, t = 64 * c + lane; const float* g = GATES + (size_t)(b * SEQ + t) * 8;
        float bs = g[4 + h]; const float ig = g[h];
#pragma unroll
        for (int o = 1; o < 64; o <<= 1) { const float v = __shfl_up(bs, o); if (lane >= o) bs += v; }
        const float av = ig - bs; float pm = av;
#pragma unroll
        for (int o = 1; o < 64; o <<= 1) { const float v = __shfl_up(pm, o); if (lane >= o) pm = fmaxf(pm, v); }
        AVl[t] = av; MVl[t] = pm; FLl[t] = bs;
        if (lane == 63) { BENDl[c] = bs; AMAXl[c] = pm; }
    }
    if (tid < 128) NLl[tid] = 0.f;
    __syncthreads();
    if (tid == 0) { float m = 0.f; for (int c = 0; c < 32; ++c) { MCl[c] = m; m = BENDl[c] + fmaxf(m, AMAXl[c]); } }
    __syncthreads();
    {
        float av_[4], pm_[4], bs_[4], m63_[4], mc_[4];
#pragma unroll
        for (int k = 0; k < 4; ++k) { const int t = tid + NTHR * k, c = t >> 6; av_[k] = AVl[t]; pm_[k] = MVl[t]; bs_[k] = FLl[t]; mc_[k] = MCl[c]; m63_[k] = fmaxf(mc_[k], MVl[64 * c + 63]); }
        __syncthreads();
#pragma unroll
        for (int k = 0; k < 4; ++k) { const int t = tid + NTHR * k; const float M = fmaxf(mc_[k], pm_[k]);
            AVl[t] = av_[k] * L2E; MVl[t] = M * L2E; WVl[t] = __expf(av_[k] - m63_[k]); ITl[t] = __expf(mc_[k] - M); FLl[t] = __expf(-(bs_[k] + M)); }
        if (tid < 32) DECl[tid] = __expf(MCl[tid] - fmaxf(MCl[tid], AMAXl[tid]));
    }
    __syncthreads();
    const int isk = wid >> 2, r0 = (wid & 3) * 16;
    const int ccol = (isk ? C_MK : C_MQ) + h * 128 + 2 * lane;
    f32x2 cw2[4], cb2;
#pragma unroll
    for (int j = 0; j < 4; ++j) { cw2[j].x = conv_w[j * 1024 + ccol]; cw2[j].y = conv_w[j * 1024 + ccol + 1]; }
    cb2.x = conv_b[ccol]; cb2.y = conv_b[ccol + 1];
    const bf16* qkbase = PROJ + (size_t)(b * SEQ) * NCOL + ccol;
    const bf16* vbase = PROJ + (size_t)(b * SEQ) * NCOL + C_MV + h * 128 + 2 * lane;
    const bf16* obase = PROJ + (size_t)(b * SEQ) * NCOL + C_MO + h * 128 + e0 + 4 * fq;
    const f32x4 mw = *(const f32x4*)(m_norm_w + e0 + 4 * fq);
    unsigned raw[19], vraw[8];
#define ML_LOADS(c_) do { _Pragma("unroll") for (int i = 0; i < 19; ++i) { const int t = 64 * (c_) + r0 - 3 + i; raw[i] = (t >= 0) ? *(const unsigned*)(qkbase + (size_t)(t < 0 ? 0 : t) * NCOL) : 0u; } \
        _Pragma("unroll") for (int i = 0; i < 8; ++i) vraw[i] = *(const unsigned*)(vbase + (size_t)(64 * (c_) + 8 * wid + i) * NCOL); } while (0)
    ML_LOADS(0);
    f32x4 Cacc[8];
#pragma unroll
    for (int i = 0; i < 8; ++i) Cacc[i] = (f32x4){0.f, 0.f, 0.f, 0.f};
#pragma unroll 1
    for (int c = 0; c < SEQ / 64; ++c) {
        {
            f32x2 xx[19];
#pragma unroll
            for (int i = 0; i < 19; ++i) { xx[i].x = bflo(raw[i]); xx[i].y = bfhi(raw[i]); }
            f32x2 oo[16], ee[16];
#pragma unroll
            for (int i = 0; i < 16; ++i) oo[i] = xx[i] * cw2[0] + cb2;
#pragma unroll
            for (int j = 1; j < 4; ++j)
#pragma unroll
                for (int i = 0; i < 16; ++i) oo[i] = xx[i + j] * cw2[j] + oo[i];
#pragma unroll
            for (int i = 0; i < 16; ++i) ee[i] = oo[i] * (-L2E);
#pragma unroll
            for (int i = 0; i < 16; ++i) { ee[i].x = __builtin_amdgcn_exp2f(ee[i].x); ee[i].y = __builtin_amdgcn_exp2f(ee[i].y); }
#pragma unroll
            for (int i = 0; i < 16; ++i) ee[i] = ee[i] + 1.0f;
#pragma unroll
            for (int i = 0; i < 16; ++i) { ee[i].x = __builtin_amdgcn_rcpf(ee[i].x); ee[i].y = __builtin_amdgcn_rcpf(ee[i].y); }
            if (!isk) {
#pragma unroll
                for (int i = 0; i < 16; ++i) oo[i] = oo[i] * ee[i];
#pragma unroll
                for (int i = 0; i < 16; ++i) *(LAS unsigned*)(lds + QL + (r0 + i) * QS + 4 * lane) = cvtpk_nv(oo[i].x, oo[i].y);
            } else {
                f32x2 kv[16];
#pragma unroll
                for (int i = 0; i < 16; ++i) kv[i] = oo[i] * ee[i] * 0.08838834764831845f;
#pragma unroll
                for (int i = 0; i < 16; ++i) *(LAS unsigned*)(lds + KL + (r0 + i) * QS + 4 * lane) = cvtpk_nv(kv[i].x, kv[i].y);
                u32x4 k0a, k0b, k1a, k1b;
#pragma unroll
                for (int q = 0; q < 4; ++q) { const f32x4 w4 = *(const LAS f32x4*)(WVl + 64 * c + r0 + 4 * q);
                    const f32x2 e0_ = kv[4 * q] * w4.x, e1_ = kv[4 * q + 1] * w4.y, e2_ = kv[4 * q + 2] * w4.z, e3_ = kv[4 * q + 3] * w4.w;
                    const unsigned a0 = cvtpk(e0_.x, e1_.x), a1 = cvtpk(e2_.x, e3_.x), b0 = cvtpk(e0_.y, e1_.y), b1 = cvtpk(e2_.y, e3_.y);
                    if (q == 0) { k0a.x = a0; k0a.y = a1; k1a.x = b0; k1a.y = b1; } else if (q == 1) { k0a.z = a0; k0a.w = a1; k1a.z = b0; k1a.w = b1; }
                    else if (q == 2) { k0b.x = a0; k0b.y = a1; k1b.x = b0; k1b.y = b1; } else { k0b.z = a0; k0b.w = a1; k1b.z = b0; k1b.w = b1; } }
                *(LAS u32x4*)(lds + KWT + (2 * lane) * TS + r0 * 2) = k0a; *(LAS u32x4*)(lds + KWT + (2 * lane) * TS + r0 * 2 + 16) = k0b;
                *(LAS u32x4*)(lds + KWT + (2 * lane + 1) * TS + r0 * 2) = k1a; *(LAS u32x4*)(lds + KWT + (2 * lane + 1) * TS + r0 * 2 + 16) = k1b;
            }
            u32x4 v0, v1;
            v0.x = (vraw[0] & 0xffffu) | (vraw[1] << 16); v0.y = (vraw[2] & 0xffffu) | (vraw[3] << 16); v0.z = (vraw[4] & 0xffffu) | (vraw[5] << 16); v0.w = (vraw[6] & 0xffffu) | (vraw[7] << 16);
            v1.x = (vraw[0] >> 16) | (vraw[1] & 0xffff0000u); v1.y = (vraw[2] >> 16) | (vraw[3] & 0xffff0000u); v1.z = (vraw[4] >> 16) | (vraw[5] & 0xffff0000u); v1.w = (vraw[6] >> 16) | (vraw[7] & 0xffff0000u);
            *(LAS u32x4*)(lds + VT + (2 * lane) * TS + 16 * wid) = v0;
            *(LAS u32x4*)(lds + VT + (2 * lane + 1) * TS + 16 * wid) = v1;
        }
        if (c + 1 < SEQ / 64) ML_LOADS(c + 1);
        u32x2 og[4];
#pragma unroll
        for (int ti = 0; ti < 4; ++ti) og[ti] = *(const u32x2*)(obase + (size_t)(64 * c + 16 * ti + fr) * NCOL);
        LBAR();
        {
            const int ti = wid >> 1, half = wid & 1; float rsum = 0.f;
            const float Mt = MVl[64 * c + 16 * ti + fr];
#pragma unroll
            for (int sx = 0; sx < 2; ++sx) {
                const int si = 2 * half + sx; f32x4 acc = (f32x4){0.f, 0.f, 0.f, 0.f};
                if (si <= ti) {
#pragma unroll
                    for (int kb = 0; kb < 4; ++kb) {
                        const bf16x8 kf = *(const LAS bf16x8*)(lds + KL + (16 * si + fr) * QS + (32 * kb + 8 * fq) * 2);
                        const bf16x8 qf = *(const LAS bf16x8*)(lds + QL + (16 * ti + fr) * QS + (32 * kb + 8 * fq) * 2);
                        acc = mfma16(kf, qf, acc); }
                    const f32x4 av = *(const LAS f32x4*)(AVl + 64 * c + 16 * si + 4 * fq);
#pragma unroll
                    for (int j = 0; j < 4; ++j) { const int s = 16 * si + 4 * fq + j, t = 16 * ti + fr; const float dd = (s <= t) ? __builtin_amdgcn_exp2f(av[j] - Mt) : 0.f; acc[j] *= dd; rsum += acc[j]; }
                }
                u32x2 o; o.x = cvtpk(acc[0], acc[1]); o.y = cvtpk(acc[2], acc[3]);
                *(LAS u32x2*)(lds + SD + (16 * ti + fr) * TS + (16 * si + 4 * fq) * 2) = o;
            }
            rsum += __shfl_xor(rsum, 16); rsum += __shfl_xor(rsum, 32);
            if (fq == 0) RSl[(16 * ti + fr) * 2 + half] = rsum;
        }
        {
            const int t = tid >> 3, part = tid & 7;
            const u32x4 qa = *(const LAS u32x4*)(lds + QL + t * QS + part * 32), qb = *(const LAS u32x4*)(lds + QL + t * QS + part * 32 + 16);
            const f32x4 n0 = *(const LAS f32x4*)(NLl + 16 * part), n1 = *(const LAS f32x4*)(NLl + 16 * part + 4), n2 = *(const LAS f32x4*)(NLl + 16 * part + 8), n3 = *(const LAS f32x4*)(NLl + 16 * part + 12);
            float s = bflo(qa.x) * n0.x + bfhi(qa.x) * n0.y + bflo(qa.y) * n0.z + bfhi(qa.y) * n0.w + bflo(qa.z) * n1.x + bfhi(qa.z) * n1.y + bflo(qa.w) * n1.z + bfhi(qa.w) * n1.w
                    + bflo(qb.x) * n2.x + bfhi(qb.x) * n2.y + bflo(qb.y) * n2.z + bfhi(qb.y) * n2.w + bflo(qb.z) * n3.x + bfhi(qb.z) * n3.y + bflo(qb.w) * n3.z + bfhi(qb.w) * n3.w;
            s += __shfl_xor(s, 1); s += __shfl_xor(s, 2); s += __shfl_xor(s, 4);
            if (part == 0) QNl[t] = s;
        }
        LBAR();
        f32x4 hacc[4]; float inter[4];
        {
            bf16x8 cf[4];
#pragma unroll
            for (int kb = 0; kb < 4; ++kb) { u32x4 w; w.x = cvtpk(Cacc[2 * kb][0], Cacc[2 * kb][1]); w.y = cvtpk(Cacc[2 * kb][2], Cacc[2 * kb][3]); w.z = cvtpk(Cacc[2 * kb + 1][0], Cacc[2 * kb + 1][1]); w.w = cvtpk(Cacc[2 * kb + 1][2], Cacc[2 * kb + 1][3]);
                cf[kb] = __builtin_bit_cast(bf16x8, w); }
#pragma unroll
            for (int ti = 0; ti < 4; ++ti) {
                hacc[ti] = (f32x4){0.f, 0.f, 0.f, 0.f};
#pragma unroll
                for (int kb = 0; kb < 4; ++kb) {
                    const u32x2 lo = *(const LAS u32x2*)(lds + QL + (16 * ti + fr) * QS + (32 * kb + 4 * fq) * 2), hi = *(const LAS u32x2*)(lds + QL + (16 * ti + fr) * QS + (32 * kb + 16 + 4 * fq) * 2);
                    const u32x4 qq = (u32x4){lo.x, lo.y, hi.x, hi.y};
                    hacc[ti] = mfma16(cf[kb], __builtin_bit_cast(bf16x8, qq), hacc[ti]); }
                inter[ti] = ITl[64 * c + 16 * ti + fr];
                hacc[ti] = hacc[ti] * inter[ti];
            }
        }
        {
            bf16x8 vf[2];
#pragma unroll
            for (int ks = 0; ks < 2; ++ks) vf[ks] = *(const LAS bf16x8*)(lds + VT + (e0 + fr) * TS + (32 * ks + 8 * fq) * 2);
#pragma unroll
            for (int ti = 0; ti < 4; ++ti)
#pragma unroll
                for (int ks = 0; ks < 2; ++ks) if (ks == 0 || ti >= 2) {
                    const bf16x8 sf = *(const LAS bf16x8*)(lds + SD + (16 * ti + fr) * TS + (32 * ks + 8 * fq) * 2);
                    hacc[ti] = mfma16(vf[ks], sf, hacc[ti]); }
            const float decay = DECl[c];
            float nsum = 0.f;
#pragma unroll
            for (int i = 0; i < 8; ++i) {
                Cacc[i] = Cacc[i] * decay;
#pragma unroll
                for (int ks = 0; ks < 2; ++ks) {
                    const bf16x8 kwf = *(const LAS bf16x8*)(lds + KWT + (16 * i + fr) * TS + (32 * ks + 8 * fq) * 2);
                    Cacc[i] = mfma16(kwf, vf[ks], Cacc[i]); }
            }
#pragma unroll
            for (int ks = 0; ks < 2; ++ks) {
                const u32x4 kk = *(const LAS u32x4*)(lds + KWT + (16 * wid + fr) * TS + (32 * ks + 8 * fq) * 2);
                nsum += (bflo(kk.x) + bfhi(kk.x)) + (bflo(kk.y) + bfhi(kk.y)) + (bflo(kk.z) + bfhi(kk.z)) + (bflo(kk.w) + bfhi(kk.w)); }
            nsum += __shfl_xor(nsum, 16); nsum += __shfl_xor(nsum, 32);
            if (fq == 0) NLl[16 * wid + fr] = decay * NLl[16 * wid + fr] + nsum;
        }
        f32x4 hm[4];
#pragma unroll
        for (int ti = 0; ti < 4; ++ti) {
            const int t = 16 * ti + fr;
            const float den = RSl[2 * t] + RSl[2 * t + 1] + inter[ti] * QNl[t];
            const float rd = __builtin_amdgcn_rcpf(fmaxf(fabsf(den), FLl[64 * c + t]));
            const f32x4 gg = (f32x4){bflo(og[ti].x), bfhi(og[ti].x), bflo(og[ti].y), bfhi(og[ti].y)};
            hm[ti] = hacc[ti] * gg * rd;
            float psq = (hm[ti][0] * hm[ti][0] + hm[ti][1] * hm[ti][1]) + (hm[ti][2] * hm[ti][2] + hm[ti][3] * hm[ti][3]);
            psq += __shfl_xor(psq, 16); psq += __shfl_xor(psq, 32);
            if (fq == 0) PSQl[t * 8 + wid] = psq;
        }
        LBAR();
#pragma unroll
        for (int ti = 0; ti < 4; ++ti) {
            const int t = 16 * ti + fr;
            const f32x4 p0 = *(const LAS f32x4*)(PSQl + t * 8), p1 = *(const LAS f32x4*)(PSQl + t * 8 + 4);
            const float r = rsqrtf(((p0.x + p0.y) + (p0.z + p0.w) + (p1.x + p1.y) + (p1.z + p1.w)) * (1.f / 128.f) + EPS);
            const f32x4 ov = hm[ti] * mw * r;
            u32x2 o; o.x = cvtpk(ov[0], ov[1]); o.y = cvtpk(ov[2], ov[3]);
            *(u32x2*)(MIX + (size_t)(b * SEQ + 64 * c + t) * DM + h * 128 + e0 + 4 * fq) = o;
        }
    }
#undef ML_LOADS
}
}

namespace att {
using s16x4  = __attribute__((ext_vector_type(4))) short;
using f32x16 = __attribute__((ext_vector_type(16))) float;
constexpr int SHM_V = 16384, SHM_K = 16384;
constexpr float THR2 = 11.5415603f;
#define KSWZ(row, colB) ((row) * 256 + ((colB) ^ (((row) & 7) << 4)))
#define SBAR() __builtin_amdgcn_sched_barrier(0)
__device__ __forceinline__ int crow(int r, int hi) { return (r & 3) + 8 * (r >> 2) + 4 * hi; }
__device__ __forceinline__ unsigned cvtpk(float lo, float hi) { unsigned r; asm volatile("v_cvt_pk_bf16_f32 %0, %1, %2" : "=v"(r) : "v"(lo), "v"(hi)); return r; }
__device__ __forceinline__ void partialSM(f32x16& p0, f32x16& p1, float& m_reg, float& mn, float& alpha) {
  float pmax = p0[0];
#pragma unroll
  for (int r = 1; r < 16; ++r) pmax = fmaxf(pmax, p0[r]);
#pragma unroll
  for (int r = 0; r < 16; ++r) pmax = fmaxf(pmax, p1[r]);
  { auto rr = __builtin_amdgcn_permlane32_swap(__float_as_uint(pmax), __float_as_uint(pmax), false, false);
    pmax = fmaxf(__uint_as_float(rr[0]), __uint_as_float(rr[1])); }
  if (__builtin_expect(__all(pmax - m_reg <= THR2), 1)) { mn = m_reg; alpha = 1.f; }
  else { mn = fmaxf(m_reg, pmax); alpha = __builtin_amdgcn_exp2f(m_reg - mn); m_reg = mn; }
#pragma unroll
  for (int r = 0; r < 16; ++r) p0[r] = p0[r] - mn;
#pragma unroll
  for (int r = 0; r < 16; ++r) p1[r] = p1[r] - mn;
#pragma unroll
  for (int r = 0; r < 16; ++r) p0[r] = __builtin_amdgcn_exp2f(p0[r]);
}
__device__ __forceinline__ void finishSM(f32x16& p0, f32x16& p1, float alpha, float& l_reg, bf16x8& pa0, bf16x8& pa1, bf16x8& pa2, bf16x8& pa3) {
#pragma unroll
  for (int r = 0; r < 16; ++r) p1[r] = __builtin_amdgcn_exp2f(p1[r]);
  float ps = 0;
#pragma unroll
  for (int r = 0; r < 16; ++r) ps += p0[r];
#pragma unroll
  for (int r = 0; r < 16; ++r) ps += p1[r];
  { auto rr = __builtin_amdgcn_permlane32_swap(__float_as_uint(ps), __float_as_uint(ps), false, false);
    ps = __uint_as_float(rr[0]) + __uint_as_float(rr[1]); }
  l_reg = l_reg * alpha + ps;
#define PK4(P, BASE, OUT) do { unsigned a0 = cvtpk(P[BASE + 0], P[BASE + 1]), a1 = cvtpk(P[BASE + 2], P[BASE + 3]);   \
    unsigned b0 = cvtpk(P[BASE + 4], P[BASE + 5]), b1 = cvtpk(P[BASE + 6], P[BASE + 7]);                              \
    auto r0 = __builtin_amdgcn_permlane32_swap(a0, b0, false, false); auto r1 = __builtin_amdgcn_permlane32_swap(a1, b1, false, false); \
    u32x4 w = {r0[0], r1[0], r0[1], r1[1]}; OUT = __builtin_bit_cast(bf16x8, w); } while (0)
  PK4(p0, 0, pa0); PK4(p0, 8, pa1); PK4(p1, 0, pa2); PK4(p1, 8, pa3);
#undef PK4
}
__device__ __forceinline__ void partialFX(f32x16& p0) {
#pragma unroll
  for (int r = 0; r < 16; ++r) p0[r] = __builtin_amdgcn_exp2f(p0[r]);
}
__device__ __forceinline__ void finishFX(f32x16& p0, f32x16& p1, float& l_reg, bf16x8& pa0, bf16x8& pa1, bf16x8& pa2, bf16x8& pa3) {
#pragma unroll
  for (int r = 0; r < 16; ++r) p1[r] = __builtin_amdgcn_exp2f(p1[r]);
  float ps = 0;
#pragma unroll
  for (int r = 0; r < 16; ++r) ps += p0[r];
#pragma unroll
  for (int r = 0; r < 16; ++r) ps += p1[r];
  l_reg += ps;
#define PK4(P, BASE, OUT) do { unsigned a0 = cvtpk(P[BASE + 0], P[BASE + 1]), a1 = cvtpk(P[BASE + 2], P[BASE + 3]);   \
    unsigned b0 = cvtpk(P[BASE + 4], P[BASE + 5]), b1 = cvtpk(P[BASE + 6], P[BASE + 7]);                              \
    auto r0 = __builtin_amdgcn_permlane32_swap(a0, b0, false, false); auto r1 = __builtin_amdgcn_permlane32_swap(a1, b1, false, false); \
    u32x4 w = {r0[0], r1[0], r0[1], r1[1]}; OUT = __builtin_bit_cast(bf16x8, w); } while (0)
  PK4(p0, 0, pa0); PK4(p0, 8, pa1); PK4(p1, 0, pa2); PK4(p1, 8, pa3);
#undef PK4
}
__device__ __forceinline__ void qkt(f32x16& p0, f32x16& p1, const LAS unsigned char* Ks, const bf16x8 (&qr)[4], int c, int r32, int hi) {
  p0 = f32x16{}; p1 = f32x16{};
#pragma unroll
  for (int d0 = 0; d0 < 4; ++d0) { const int cb = (c * 64 + d0 * 16 + hi * 8) * 2;
    const bf16x8 b0 = *(const LAS bf16x8*)(Ks + KSWZ(r32, cb));
    const bf16x8 b1 = *(const LAS bf16x8*)(Ks + KSWZ(32 + r32, cb));
    p0 = __builtin_amdgcn_mfma_f32_32x32x16_bf16(b0, qr[d0], p0, 0, 0, 0);
    p1 = __builtin_amdgcn_mfma_f32_32x32x16_bf16(b1, qr[d0], p1, 0, 0, 0); }
}
__device__ __forceinline__ int v_st(int k, int c) { const int kk = (k & ~0xC) | ((k & 4) << 1) | ((k & 8) >> 1); return ((kk >> 3) * 4 + (c >> 5)) * 512 + ((kk & 7) * 32 + (c & 31)) * 2; }
__device__ __forceinline__ int v_rd_base(int lane) { return ((lane & 3) << 3) | (((lane >> 2) & 3) << 6) | (((lane >> 4) & 1) << 5) | (((lane >> 5) & 1) << 8); }
constexpr int v_rd_off(int d0, int ks, int half) { return d0 * 512 + ks * 4096 + half * 2048; }
template <int OFF> __device__ __forceinline__ s16x4 tr_read(int vb) {
  s16x4 r; asm volatile("ds_read_b64_tr_b16 %0, %1 offset:%2" : "=&v"(r) : "v"(vb), "i"(OFF) : "memory"); return r;
}
template <int D0> __device__ __forceinline__ void pv_one(f32x16& od, int vb, bf16x8 pa0, bf16x8 pa1, bf16x8 pa2, bf16x8 pa3) {
  const s16x4 l0 = tr_read<v_rd_off(D0, 0, 0)>(vb), h0 = tr_read<v_rd_off(D0, 0, 1)>(vb), l1 = tr_read<v_rd_off(D0, 1, 0)>(vb), h1 = tr_read<v_rd_off(D0, 1, 1)>(vb);
  const s16x4 l2 = tr_read<v_rd_off(D0, 2, 0)>(vb), h2 = tr_read<v_rd_off(D0, 2, 1)>(vb), l3 = tr_read<v_rd_off(D0, 3, 0)>(vb), h3 = tr_read<v_rd_off(D0, 3, 1)>(vb);
  asm volatile("s_waitcnt lgkmcnt(0)" ::: "memory"); SBAR();
#define PK(L, H) (bf16x8){L[0], L[1], L[2], L[3], H[0], H[1], H[2], H[3]}
  od = __builtin_amdgcn_mfma_f32_32x32x16_bf16(pa0, PK(l0, h0), od, 0, 0, 0);
  od = __builtin_amdgcn_mfma_f32_32x32x16_bf16(pa1, PK(l1, h1), od, 0, 0, 0);
  od = __builtin_amdgcn_mfma_f32_32x32x16_bf16(pa2, PK(l2, h2), od, 0, 0, 0);
  od = __builtin_amdgcn_mfma_f32_32x32x16_bf16(pa3, PK(l3, h3), od, 0, 0, 0);
#undef PK
}
#define PVRD(D0) const s16x4 l0_##D0 = tr_read<v_rd_off(D0, 0, 0)>(vb), h0_##D0 = tr_read<v_rd_off(D0, 0, 1)>(vb), l1_##D0 = tr_read<v_rd_off(D0, 1, 0)>(vb), h1_##D0 = tr_read<v_rd_off(D0, 1, 1)>(vb), \
    l2_##D0 = tr_read<v_rd_off(D0, 2, 0)>(vb), h2_##D0 = tr_read<v_rd_off(D0, 2, 1)>(vb), l3_##D0 = tr_read<v_rd_off(D0, 3, 0)>(vb), h3_##D0 = tr_read<v_rd_off(D0, 3, 1)>(vb)
#define PVPK(L, H) (bf16x8){L[0], L[1], L[2], L[3], H[0], H[1], H[2], H[3]}
#define PVMM(D0, N) do { asm volatile("s_waitcnt lgkmcnt(" #N ")" ::: "memory"); SBAR(); \
    o[D0] = __builtin_amdgcn_mfma_f32_32x32x16_bf16(pa0, PVPK(l0_##D0, h0_##D0), o[D0], 0, 0, 0); o[D0] = __builtin_amdgcn_mfma_f32_32x32x16_bf16(pa1, PVPK(l1_##D0, h1_##D0), o[D0], 0, 0, 0); \
    o[D0] = __builtin_amdgcn_mfma_f32_32x32x16_bf16(pa2, PVPK(l2_##D0, h2_##D0), o[D0], 0, 0, 0); o[D0] = __builtin_amdgcn_mfma_f32_32x32x16_bf16(pa3, PVPK(l3_##D0, h3_##D0), o[D0], 0, 0, 0); } while (0)
__device__ __forceinline__ void pv_d0(f32x16* o, int vb, bf16x8 pa0, bf16x8 pa1, bf16x8 pa2, bf16x8 pa3) {
  PVRD(0); PVRD(1); PVMM(0, 8); PVRD(2); PVMM(1, 8); PVRD(3); PVMM(2, 8); PVMM(3, 0);
}
#undef PVRD
#undef PVPK
#undef PVMM

template <bool FX>
__device__ __forceinline__ void attn_unit(const bf16* __restrict__ PROJ, bf16* __restrict__ MIX, const float* __restrict__ anw, const float lam, const float nb, const int b, const int h, const int qb,
                                          LAS unsigned char* lds, const int tid) {
  const int wid = __builtin_amdgcn_readfirstlane(tid >> 6), lane = tid & 63, r32 = lane & 31, hi = lane >> 5, g = wid >> 1, c = wid & 1;
  const int q0 = qb * 128, NT = 2 * qb + 2; const bool masked_last = (g < 2);
  int hcol = h * 128; asm volatile("" : "+s"(hcol));
  const char* Kg = (const char*)(PROJ + (size_t)(b * SEQ) * NCOL + C_AK + hcol);
  const char* Vg = (const char*)(PROJ + (size_t)(b * SEQ) * NCOL + C_AV + hcol);
  LAS float* wsf = (LAS float*)(lds + 131072) + wid * 64; LAS float* li_l = wsf; LAS float* al_l = wsf + 32;
  unsigned koff[2], voff[2];
#pragma unroll
  for (int p = 0; p < 2; ++p) { const int s = (wid * 2 + p) * 64 + lane, row = s >> 4, ch = (s & 15) ^ (row & 7); koff[p] = (unsigned)(row * NCOL + ch * 8) * 2u;
    const int o = s * 16, sub = o >> 9, within = o & 511, kk = (sub >> 2) * 8 + (within >> 6), k = (kk & ~0xC) | ((kk & 4) << 1) | ((kk & 8) >> 1), cc = (sub & 3) * 32 + ((within & 63) >> 4) * 8;
    voff[p] = (unsigned)(k * NCOL + cc) * 2u; }
#define DMA(tile, slot) do { const char* kt_ = Kg + (size_t)(tile) * (64 * NCOL * 2); const char* vt_ = Vg + (size_t)(tile) * (64 * NCOL * 2); LAS unsigned char* sl_ = lds + (slot) * 32768 + wid * 2048; \
    _Pragma("unroll") for (int p_ = 0; p_ < 2; ++p_) __builtin_amdgcn_global_load_lds((const unsigned*)(kt_ + koff[p_]), (LAS unsigned*)(sl_ + p_ * 1024), 16, 0, 0); \
    _Pragma("unroll") for (int p_ = 0; p_ < 2; ++p_) __builtin_amdgcn_global_load_lds((const unsigned*)(vt_ + voff[p_]), (LAS unsigned*)(sl_ + 16384 + p_ * 1024), 16, 0, 0); } while (0)
#define WB4() do { asm volatile("s_waitcnt vmcnt(4)" ::: "memory"); __builtin_amdgcn_s_barrier(); asm volatile("" ::: "memory"); } while (0)
#define WB8() do { asm volatile("s_waitcnt vmcnt(8)" ::: "memory"); __builtin_amdgcn_s_barrier(); asm volatile("" ::: "memory"); } while (0)
#define KSLOT(j) (lds + ((j) & 3) * 32768)
#define VSLOT(j) (vb0 + ((j) & 3) * 32768)
  float m_reg = -1e30f, l_reg = 0; f32x16 o[4] = {}; bf16x8 qr[4];
  { const bf16* Qw = PROJ + (size_t)(b * SEQ + q0 + 32 * g + r32) * NCOL + C_AQ + hcol + c * 64 + hi * 8;
#pragma unroll
    for (int d0 = 0; d0 < 4; ++d0) qr[d0] = *(const bf16x8*)(Qw + d0 * 16); }
  const int vb0 = (int)(unsigned)(uintptr_t)lds + 16384 + v_rd_base(lane);
#define RESC(a) do { if (__any((a) < 1.f)) { if (hi == 0) al_l[r32] = (a); asm volatile("s_waitcnt lgkmcnt(0)" ::: "memory"); \
    _Pragma("unroll") for (int d = 0; d < 4; ++d) _Pragma("unroll") for (int r = 0; r < 16; ++r) o[d][r] *= al_l[crow(r, hi)]; } } while (0)
  f32x16 p0, p1; float mn, al; bf16x8 pa0, pa1, pa2, pa3;
  DMA(0, 0); DMA(1, 1);
#pragma unroll 1
  for (int j = 0; j < NT; ++j) {
    WB4();
    DMA((j + 2 < NT ? j + 2 : NT - 1), (j + 2) & 3);
    SBAR(); qkt(p0, p1, KSLOT(j), qr, c, r32, hi);
    if (masked_last && j == NT - 1) {
#pragma unroll
      for (int r = 0; r < 16; ++r) { p0[r] = -1e30f; p1[r] = -1e30f; } }
    if constexpr (FX) { SBAR(); partialFX(p0); finishFX(p0, p1, l_reg, pa0, pa1, pa2, pa3); SBAR(); }
    else { partialSM(p0, p1, m_reg, mn, al); RESC(al); finishSM(p0, p1, al, l_reg, pa0, pa1, pa2, pa3); SBAR(); }
    pv_d0(o, VSLOT(j), pa0, pa1, pa2, pa3);
  }
  if constexpr (FX) l_reg += __shfl_xor(l_reg, 32);
  asm volatile("s_waitcnt vmcnt(0)" ::: "memory");
#undef DMA
#undef WB4
#undef WB8
#undef KSLOT
#undef VSLOT
  if (hi == 0) li_l[r32] = l_reg; asm volatile("s_waitcnt lgkmcnt(0)" ::: "memory");
  int lane2 = lane; asm volatile("" : "+v"(lane2));
  const int r32b = lane2 & 31, hib = lane2 >> 5;
  float rli[16];
#pragma unroll
  for (int r = 0; r < 16; ++r) rli[r] = __builtin_amdgcn_rcpf(li_l[(r & 3) + 8 * (r >> 2) + 4 * hib]);
  __syncthreads();
  LAS float* X = (LAS float*)(lds + g * 16384) + hib * 512 + r32b;
  if (c == 1) {
#pragma unroll
    for (int r = 0; r < 16; ++r)
#pragma unroll
      for (int d0 = 0; d0 < 4; ++d0) X[((r & 3) + 8 * (r >> 2)) * 128 + d0 * 32] = o[d0][r] * (rli[r] * lam);
  }
  __syncthreads();
  if (c == 0) {
    float ss[16];
#pragma unroll
    for (int r = 0; r < 16; ++r) { ss[r] = 0.f;
#pragma unroll
      for (int d0 = 0; d0 < 4; ++d0) { const float v = o[d0][r] * rli[r] - X[((r & 3) + 8 * (r >> 2)) * 128 + d0 * 32]; o[d0][r] = v; ss[r] += v * v; } }
#pragma unroll
    for (int r = 0; r < 16; ++r) {
#pragma unroll
      for (int s = 1; s < 32; s <<= 1) ss[r] += __shfl_xor(ss[r], s);
      ss[r] = rsqrtf(ss[r] * (1.f / 128.f) + EPS) * (1.f - LAMBDA_INIT); }
    float aw[4];
#pragma unroll
    for (int d0 = 0; d0 < 4; ++d0) aw[d0] = anw[d0 * 32 + r32b];
    asm volatile("s_waitcnt lgkmcnt(0)" ::: "memory");
    LAS bf16* Ost = (LAS bf16*)(lds + g * 16384);
    LAS bf16* Ow = Ost + hib * 512 + r32b;
#pragma unroll
    for (int r = 0; r < 16; ++r)
#pragma unroll
      for (int d0 = 0; d0 < 4; ++d0) Ow[((r & 3) + 8 * (r >> 2)) * 128 + d0 * 32] = (bf16)f2bf(o[d0][r] * ss[r] * aw[d0]);
    asm volatile("s_waitcnt lgkmcnt(0)" ::: "memory");
    const int rowb = lane2 >> 4, c16 = lane2 & 15;
    bf16* Ob = MIX + (size_t)(b * SEQ + q0 + 32 * g + rowb) * DM + 512 + h * 128 + c16 * 8;
    const LAS bf16* Os = Ost + rowb * 128 + c16 * 8;
#pragma unroll
    for (int k = 0; k < 8; ++k) *(u32x4*)(Ob + (size_t)k * 4 * DM) = *(const LAS u32x4*)(Os + k * 512);
  }
  __syncthreads();
#undef RESC
}

template <int C, int HALF_> __device__ __forceinline__ void half_scores(f32x16& p, const LAS unsigned char* Ks, const bf16x8 (&qr)[8], const int kaddr) {
  p = f32x16{};
#pragma unroll
  for (int d0 = 0; d0 < 4; ++d0) { const bf16x8 kf = *(const LAS bf16x8*)(Ks + (kaddr ^ (d0 * 32)) + C * 128 + HALF_ * 8192);
    p = __builtin_amdgcn_mfma_f32_32x32x16_bf16(kf, qr[C * 4 + d0], p, 0, 0, 0); }
}
__device__ __forceinline__ void half_softmax(f32x16& p, float& l_reg, bf16x8& pa, bf16x8& pb) {
#pragma unroll
  for (int r = 0; r < 16; ++r) p[r] = __builtin_amdgcn_exp2f(p[r]);
  float ps = 0;
#pragma unroll
  for (int r = 0; r < 16; ++r) ps += p[r];
  l_reg += ps;
#define PK4(P, BASE, OUT) do { unsigned a0 = cvtpk(P[BASE + 0], P[BASE + 1]), a1 = cvtpk(P[BASE + 2], P[BASE + 3]);   \
    unsigned b0 = cvtpk(P[BASE + 4], P[BASE + 5]), b1 = cvtpk(P[BASE + 6], P[BASE + 7]);                              \
    auto r0 = __builtin_amdgcn_permlane32_swap(a0, b0, false, false); auto r1 = __builtin_amdgcn_permlane32_swap(a1, b1, false, false); \
    u32x4 w = {r0[0], r1[0], r0[1], r1[1]}; OUT = __builtin_bit_cast(bf16x8, w); } while (0)
  PK4(p, 0, pa); PK4(p, 8, pb);
#undef PK4
  SBAR();
}
template <int D0, int HALF_> __device__ __forceinline__ void pv_half(f32x16& oa, f32x16& ob, int vb, bf16x8 a0, bf16x8 a1, bf16x8 b0, bf16x8 b1) {
  const s16x4 l0 = tr_read<v_rd_off(D0, 2 * HALF_, 0)>(vb), h0 = tr_read<v_rd_off(D0, 2 * HALF_, 1)>(vb), l1 = tr_read<v_rd_off(D0, 2 * HALF_ + 1, 0)>(vb), h1 = tr_read<v_rd_off(D0, 2 * HALF_ + 1, 1)>(vb);
  asm volatile("s_waitcnt lgkmcnt(0)" ::: "memory"); SBAR();
#define PK(L, H) (bf16x8){L[0], L[1], L[2], L[3], H[0], H[1], H[2], H[3]}
  oa = __builtin_amdgcn_mfma_f32_32x32x16_bf16(a0, PK(l0, h0), oa, 0, 0, 0);
  ob = __builtin_amdgcn_mfma_f32_32x32x16_bf16(b0, PK(l0, h0), ob, 0, 0, 0);
  oa = __builtin_amdgcn_mfma_f32_32x32x16_bf16(a1, PK(l1, h1), oa, 0, 0, 0);
  ob = __builtin_amdgcn_mfma_f32_32x32x16_bf16(b1, PK(l1, h1), ob, 0, 0, 0);
#undef PK
  SBAR();
}
__device__ __forceinline__ void attn2_setup(LAS unsigned char* lds, const int tid) {
  const int wid = __builtin_amdgcn_readfirstlane(tid >> 6), lane = tid & 63;
  unsigned koff[2], voff[2];
#pragma unroll
  for (int p = 0; p < 2; ++p) { const int s = (wid * 2 + p) * 64 + lane, row = s >> 4, ch = (s & 15) ^ (row & 7); koff[p] = (unsigned)(row * NCOL + ch * 8) * 2u;
    const int o = s * 16, sub = o >> 9, within = o & 511, kk = (sub >> 2) * 8 + (within >> 6), k = (kk & ~0xC) | ((kk & 4) << 1) | ((kk & 8) >> 1), cc = (sub & 3) * 32 + ((within & 63) >> 4) * 8;
    voff[p] = (unsigned)(k * NCOL + cc) * 2u; }
  *((LAS u32x4*)(lds + 133120 + wid * 1024) + lane) = (u32x4){koff[0], koff[1], voff[0], voff[1]};
  asm volatile("s_waitcnt lgkmcnt(0)" ::: "memory");
}
__device__ __forceinline__ void attn_unit2(const bf16* __restrict__ PROJ, bf16* __restrict__ MIX, const float* __restrict__ anw, const float lam, const int b, const int h, const int qb,
                                           LAS unsigned char* lds, const int tid) {
  const int wid = __builtin_amdgcn_readfirstlane(tid >> 6), lane = tid & 63, r32 = lane & 31, hi = lane >> 5;
  const int q0 = qb * 256, NT = 4 * qb + 4, jlast = 4 * qb + (wid >> 1);
  int hcol = h * 128; asm volatile("" : "+s"(hcol));
  const char* Kg = (const char*)(PROJ + (size_t)(b * SEQ) * NCOL + C_AK + hcol);
  const char* Vg = (const char*)(PROJ + (size_t)(b * SEQ) * NCOL + C_AV + hcol);
  LAS float* wsf = (LAS float*)(lds + 131072) + wid * 64;
  LAS u32x4* offt = (LAS u32x4*)(lds + 133120 + wid * 1024) + lane;
#define DMA(tile, slot) do { const char* kt_ = Kg + (size_t)(tile) * (64 * NCOL * 2); const char* vt_ = Vg + (size_t)(tile) * (64 * NCOL * 2); LAS unsigned char* sl_ = lds + (slot) * 32768 + wid * 2048; const u32x4 of_ = *offt; \
    __builtin_amdgcn_global_load_lds((const unsigned*)(kt_ + of_.x), (LAS unsigned*)(sl_), 16, 0, 0); __builtin_amdgcn_global_load_lds((const unsigned*)(kt_ + of_.y), (LAS unsigned*)(sl_ + 1024), 16, 0, 0); \
    __builtin_amdgcn_global_load_lds((const unsigned*)(vt_ + of_.z), (LAS unsigned*)(sl_ + 16384), 16, 0, 0); __builtin_amdgcn_global_load_lds((const unsigned*)(vt_ + of_.w), (LAS unsigned*)(sl_ + 16384 + 1024), 16, 0, 0); } while (0)
#define WB4() do { asm volatile("s_waitcnt vmcnt(4)" ::: "memory"); __builtin_amdgcn_s_barrier(); asm volatile("" ::: "memory"); } while (0)
  float l0 = 0.f, l1 = 0.f; f32x16 oa[4] = {}, ob[4] = {}; bf16x8 qr[8];
  { const bf16* Qw = PROJ + (size_t)(b * SEQ + q0 + 32 * wid + r32) * NCOL + C_AQ + hcol + hi * 8;
#pragma unroll
    for (int d = 0; d < 8; ++d) qr[d] = *(const bf16x8*)(Qw + d * 16); }
  const int vb0 = (int)(unsigned)(uintptr_t)lds + 16384 + v_rd_base(lane);
  const int kaddr = r32 * 256 + ((hi * 16) ^ ((r32 & 7) << 4));
  DMA(0, 0); DMA(1, 1);
#pragma unroll 1
  for (int j = 0; j < NT; ++j) {
    WB4();
    DMA((j + 2 < NT ? j + 2 : NT - 1), (j + 2) & 3);
    if (j <= jlast) {
      const LAS unsigned char* Ks = lds + (j & 3) * 32768; const int vb = vb0 + (j & 3) * 32768;
      f32x16 p; bf16x8 a0, a1, b0, b1;
      SBAR(); half_scores<0, 0>(p, Ks, qr, kaddr); half_softmax(p, l0, a0, a1);
      SBAR(); half_scores<1, 0>(p, Ks, qr, kaddr); half_softmax(p, l1, b0, b1); SBAR();
      pv_half<0, 0>(oa[0], ob[0], vb, a0, a1, b0, b1); pv_half<1, 0>(oa[1], ob[1], vb, a0, a1, b0, b1); pv_half<2, 0>(oa[2], ob[2], vb, a0, a1, b0, b1); pv_half<3, 0>(oa[3], ob[3], vb, a0, a1, b0, b1);
      SBAR(); half_scores<0, 1>(p, Ks, qr, kaddr); half_softmax(p, l0, a0, a1);
      SBAR(); half_scores<1, 1>(p, Ks, qr, kaddr); half_softmax(p, l1, b0, b1); SBAR();
      pv_half<0, 1>(oa[0], ob[0], vb, a0, a1, b0, b1); pv_half<1, 1>(oa[1], ob[1], vb, a0, a1, b0, b1); pv_half<2, 1>(oa[2], ob[2], vb, a0, a1, b0, b1); pv_half<3, 1>(oa[3], ob[3], vb, a0, a1, b0, b1);
    }
  }
  l0 += __shfl_xor(l0, 32); l1 += __shfl_xor(l1, 32);
  asm volatile("s_waitcnt vmcnt(0)" ::: "memory");
  if (hi == 0) { wsf[r32] = l0; wsf[32 + r32] = l1; } asm volatile("s_waitcnt lgkmcnt(0)" ::: "memory");
  int lane2 = lane; asm volatile("" : "+v"(lane2));
  const int r32b = lane2 & 31, hib = lane2 >> 5;
  __syncthreads();
  float ss[16];
#pragma unroll
  for (int r = 0; r < 16; ++r) { const int row = (r & 3) + 8 * (r >> 2) + 4 * hib; const float c0 = __builtin_amdgcn_rcpf(wsf[row]), c1 = lam * __builtin_amdgcn_rcpf(wsf[32 + row]); ss[r] = 0.f;
#pragma unroll
    for (int d0 = 0; d0 < 4; ++d0) { const float v = oa[d0][r] * c0 - ob[d0][r] * c1; oa[d0][r] = v; ss[r] += v * v; } }
#pragma unroll
  for (int r = 0; r < 16; ++r) {
#pragma unroll
    for (int s = 1; s < 32; s <<= 1) ss[r] += __shfl_xor(ss[r], s);
    ss[r] = rsqrtf(ss[r] * (1.f / 128.f) + EPS) * (1.f - LAMBDA_INIT); }
  float aw[4];
#pragma unroll
  for (int d0 = 0; d0 < 4; ++d0) aw[d0] = anw[d0 * 32 + r32b];
  LAS bf16* Ost = (LAS bf16*)(lds + wid * 8192);
  LAS bf16* Ow = Ost + hib * 512 + r32b;
#pragma unroll
  for (int r = 0; r < 16; ++r)
#pragma unroll
    for (int d0 = 0; d0 < 4; ++d0) Ow[((r & 3) + 8 * (r >> 2)) * 128 + d0 * 32] = (bf16)f2bf(oa[d0][r] * ss[r] * aw[d0]);
  asm volatile("s_waitcnt lgkmcnt(0)" ::: "memory");
  const int rowb = lane2 >> 4, c16 = lane2 & 15;
  bf16* Ob = MIX + (size_t)(b * SEQ + q0 + 32 * wid + rowb) * DM + 512 + h * 128 + c16 * 8;
  const LAS bf16* Os = Ost + rowb * 128 + c16 * 8;
#pragma unroll
  for (int k = 0; k < 8; ++k) *(u32x4*)(Ob + (size_t)k * 4 * DM) = *(const LAS u32x4*)(Os + k * 512);
  __syncthreads();
#undef DMA
#undef WB4
}
}

template <bool FX>
__device__ __forceinline__ void attn_queue(const bf16* PROJ, bf16* MIX, const float* anw, const float lam, const float nb, unsigned* queue, LAS unsigned char* lds, int tid) {
    LAS unsigned* slot = (LAS unsigned*)(lds + LDSCTL_OFF + 64);
    const int x0 = (int)(xb_xcc_id() & 7u);
    LAS unsigned* peek = (LAS unsigned*)(lds + LDSCTL_OFF + 72);
    if constexpr (FX) att::attn2_setup(lds, tid);
#pragma unroll 1
    for (int k = 0; k < 8; ++k) {
        const int x = (x0 + k) & 7;
        if (k == 1) { if (tid < 8) peek[tid] = __hip_atomic_load(queue + 64 * tid, __ATOMIC_RELAXED, __HIP_MEMORY_SCOPE_AGENT); __syncthreads(); }
        if (k >= 1) { if (peek[x] >= 128u) continue; }
        if (tid == 0) *slot = __hip_atomic_fetch_add(queue + 64 * x, 1u, __ATOMIC_RELAXED, __HIP_MEMORY_SCOPE_AGENT);
        __syncthreads();
        for (;;) {
            const unsigned l = *slot;
            __syncthreads();
            if (l >= 128u) break;
            unsigned nxt = 0u;
            if (tid == 0) nxt = __hip_atomic_fetch_add(queue + 64 * x, 1u, __ATOMIC_RELAXED, __HIP_MEMORY_SCOPE_AGENT);
            const int bh = ((int)l >> 3) * 8 + x, p = (int)l & 7;
            if constexpr (FX) { const int bh2 = ((int)l & 15) * 8 + x, qb2 = 7 - ((int)l >> 4); att::attn_unit2(PROJ, MIX, anw, lam, bh2 >> 2, bh2 & 3, qb2, lds, tid); }
            else {
#pragma unroll 1
                for (int s = 0; s < 2; ++s) att::attn_unit<false>(PROJ, MIX, anw, lam, nb, bh >> 2, bh & 3, s ? p : 15 - p, lds, tid); }
            if (tid == 0) *slot = nxt;
            __syncthreads();
        }
    }
}
__device__ __forceinline__ void p2_fast_attn(const Args& a, LAS unsigned char* lds, int tid, int lane, int wave, int wg, int G, int rep) {
    const float* lq1 = a.in[10]; const float* lk1 = a.in[11]; const float* lq2 = a.in[12]; const float* lk2 = a.in[13];
    const float lam = __expf(wave_sum(lq1[lane] * lk1[lane])) - __expf(wave_sum(lq2[lane] * lk2[lane])) + LAMBDA_INIT;
    const float bound2 = 8.f * 1.4426950408889634f * 1.01f * wave_max(fabsf(a.in[8][lane])) * wave_max(fabsf(a.in[9][lane]));
    const bool fixedmax = bound2 <= 40.f;
    const bf16* PROJ = (const bf16*)(a.ws + WS_PROJ); bf16* MIX = (bf16*)(a.ws + WS_MIX);
    unsigned* queue = (unsigned*)(a.ws + WS_CTL) + CW_QUEUE + 1024 * rep;
    if (fixedmax) attn_queue<true>(PROJ, MIX, a.in[14], lam, -bound2, queue, lds, tid);
    else attn_queue<false>(PROJ, MIX, a.in[14], lam, 0.f, queue, lds, tid);
}

__device__ __forceinline__ void p4_router(const Args& a, LAS unsigned char* lds, int tid, int lane, int wave, int wg, int G) {
    unsigned char* ws = a.ws;
    const float* norm2_w = a.in[16]; const float* w_group = a.in[17]; const float* b_group = a.in[18]; const float* w_expert = a.in[19]; const float* b_expert = a.in[20];
    const float* X1 = a.out; bf16* H2 = (bf16*)(ws + WS_H2);
    int* ASGE = (int*)(ws + WS_ASGE); float* ASGW = (float*)(ws + WS_ASGW); int* CNT = (int*)(ws + WS_CTL) + CW_CNT;
    LAS float* wl = (LAS float*)lds;
    LAS int* hist = (LAS int*)(lds + LDSCTL_OFF + 128);
    for (int idx = tid; idx < 4096; idx += NTHR) { const int k = idx >> 2, c = idx & 3; wl[c * 1024 + k] = w_group[idx]; }
    for (int idx = tid; idx < 32768; idx += NTHR) { const int k = idx >> 5, c = idx & 31; wl[(4 + c) * 1024 + k] = w_expert[idx]; }
    if (tid < 32) hist[tid] = 0;
    __syncthreads();
    f32x4 w2v[4];
#pragma unroll
    for (int j = 0; j < 4; ++j) w2v[j] = ((const f32x4*)norm2_w)[lane + 64 * j];
    const int tpw = T_ / (G * NWAVES);
#pragma unroll 1
    for (int rr = 0; rr < tpw; ++rr) {
        const int t = (wg * NWAVES + wave) * tpw + rr;
        const f32x4* xr = (const f32x4*)(X1 + (size_t)t * DM) + lane;
        f32x4 hv[4]; float ss = 0.f;
#pragma unroll
        for (int j = 0; j < 4; ++j) { hv[j] = xr[64 * j]; ss += (hv[j].x * hv[j].x + hv[j].y * hv[j].y) + (hv[j].z * hv[j].z + hv[j].w * hv[j].w); }
        const float r2 = rsqrtf(wave_sum(ss) * (1.f / DM) + EPS);
        u32x2* o8 = (u32x2*)(H2 + (size_t)t * DM) + lane;
#pragma unroll
        for (int j = 0; j < 4; ++j) { hv[j] = hv[j] * r2 * w2v[j]; u32x2 o; o.x = pk2(hv[j].x, hv[j].y); o.y = pk2(hv[j].z, hv[j].w); o8[64 * j] = o; }
        float lg[36];
#pragma unroll
        for (int c = 0; c < 36; ++c) { float acc = 0.f;
#pragma unroll
            for (int j = 0; j < 4; ++j) { const f32x4 wv = *(const LAS f32x4*)(wl + c * 1024 + 256 * j + 4 * lane); acc += (hv[j].x * wv.x + hv[j].y * wv.y) + (hv[j].z * wv.z + hv[j].w * wv.w); }
            lg[c] = wave_sum(acc); }
        float gl[4];
#pragma unroll
        for (int g = 0; g < 4; ++g) gl[g] = lg[g] + b_group[g];
        int gsel = 0; float gmax = gl[0];
#pragma unroll
        for (int g = 1; g < 4; ++g) if (gl[g] > gmax) { gmax = gl[g]; gsel = g; }
        float gsum = 0.f;
#pragma unroll
        for (int g = 0; g < 4; ++g) gsum += __expf(gl[g] - gmax);
        const float gwt = 1.f / gsum;
        float el[8];
#pragma unroll
        for (int i = 0; i < 8; ++i) el[i] = 0.f;
#pragma unroll
        for (int g = 0; g < 4; ++g) if (gsel == g) {
#pragma unroll
            for (int i = 0; i < 8; ++i) el[i] = lg[4 + 8 * g + i] + b_expert[8 * g + i]; }
        int i1 = 0; float v1 = el[0];
#pragma unroll
        for (int i = 1; i < 8; ++i) if (el[i] > v1) { v1 = el[i]; i1 = i; }
        int i2 = -1; float v2 = -3.0e38f;
#pragma unroll
        for (int i = 0; i < 8; ++i) if (i != i1 && el[i] > v2) { v2 = el[i]; i2 = i; }
        const float p1 = 1.f / (1.f + __expf(v2 - v1)), p2 = 1.f - p1;
        if (lane == 0) {
            const int e1 = gsel * 8 + i1, e2 = gsel * 8 + i2;
            const int r1 = atomicAdd((int*)&hist[e1], 1), r2_ = atomicAdd((int*)&hist[e2], 1);
            ASGE[2 * t] = e1 | (r1 << 8); ASGE[2 * t + 1] = e2 | (r2_ << 8);
            ASGW[2 * t] = gwt * p1; ASGW[2 * t + 1] = gwt * p2;
        }
    }
    __syncthreads();
    if (tid < 32) CNT[wg * 32 + tid] = hist[tid];
}


__device__ __forceinline__ void p4_router_mfma(const Args& a, LAS unsigned char* lds, int tid, int lane, int wave, int wg, int G) {
    unsigned char* ws = a.ws;
    const float* b_group = a.in[18]; const float* b_expert = a.in[20];
    const bf16* X1B = (const bf16*)(ws + WS_H2);
    int* ASGE = (int*)(ws + WS_ASGE); float* ASGW = (float*)(ws + WS_ASGW); int* CNT = (int*)(ws + WS_CTL) + CW_CNT;
    constexpr int WST = 2064, WLO = 36 * WST;
    LAS int* hist = (LAS int*)(lds + LDSCTL_OFF + 128);
    {
        const u32x4* RIMG = (const u32x4*)(ws + WS_RIMG); constexpr int NP = 2 * 36 * WST / 16;
#pragma unroll 1
        for (int base = 0; base < NP; base += 6 * NTHR) {
            u32x4 v[6];
#pragma unroll
            for (int q = 0; q < 6; ++q) { const int i = base + q * NTHR + tid; v[q] = RIMG[i < NP ? i : NP - 1]; }
#pragma unroll
            for (int q = 0; q < 6; ++q) { const int i = base + q * NTHR + tid; if (i < NP) *(LAS u32x4*)(lds + i * 16) = v[q]; }
        }
    }
    if (tid < 32) hist[tid] = 0;
    __syncthreads();
    const int fr = lane & 15, fq = lane >> 4;
    const int t0 = (wg * NWAVES + wave) * 32;
    const bf16* x1a = X1B + (size_t)(t0 + fr) * DM + 8 * fq; const bf16* x1b = x1a + (size_t)16 * DM;
    f32x4 acc[2][3];
#pragma unroll
    for (int tl = 0; tl < 2; ++tl)
#pragma unroll
        for (int nt = 0; nt < 3; ++nt) acc[tl][nt] = (f32x4){0.f, 0.f, 0.f, 0.f};
    float ss0 = 0.f, ss1 = 0.f;
    int wrow[3];
#pragma unroll
    for (int nt = 0; nt < 3; ++nt) { const int c = 16 * nt + fr; wrow[nt] = (c < 36 ? c : 35) * WST + 16 * fq; }
#pragma unroll 1
    for (int kg = 0; kg < 4; ++kg) {
        u32x4 va[8], vb[8];
#pragma unroll
        for (int q = 0; q < 8; ++q) { va[q] = *(const u32x4*)(x1a + 32 * (8 * kg + q)); vb[q] = *(const u32x4*)(x1b + 32 * (8 * kg + q)); }
#pragma unroll
        for (int q = 0; q < 8; ++q) { const int ks = 8 * kg + q; const u32x4 a_ = va[q], b_ = vb[q];
            { const float f0 = bflo(a_.x), f1 = bfhi(a_.x), f2 = bflo(a_.y), f3 = bfhi(a_.y), f4 = bflo(a_.z), f5 = bfhi(a_.z), f6 = bflo(a_.w), f7 = bfhi(a_.w);
              ss0 += (f0 * f0 + f1 * f1) + (f2 * f2 + f3 * f3) + (f4 * f4 + f5 * f5) + (f6 * f6 + f7 * f7); }
            { const float f0 = bflo(b_.x), f1 = bfhi(b_.x), f2 = bflo(b_.y), f3 = bfhi(b_.y), f4 = bflo(b_.z), f5 = bfhi(b_.z), f6 = bflo(b_.w), f7 = bfhi(b_.w);
              ss1 += (f0 * f0 + f1 * f1) + (f2 * f2 + f3 * f3) + (f4 * f4 + f5 * f5) + (f6 * f6 + f7 * f7); }
            const bf16x8 ah[2] = {__builtin_bit_cast(bf16x8, a_), __builtin_bit_cast(bf16x8, b_)};
#pragma unroll
            for (int nt = 0; nt < 3; ++nt) {
                const bf16x8 wh = *(const LAS bf16x8*)(lds + wrow[nt] + ks * 64), wl = *(const LAS bf16x8*)(lds + WLO + wrow[nt] + ks * 64);
#pragma unroll
                for (int tl = 0; tl < 2; ++tl) {
                    acc[tl][nt] = __builtin_amdgcn_mfma_f32_16x16x32_bf16(wh, ah[tl], acc[tl][nt], 0, 0, 0);
                    acc[tl][nt] = __builtin_amdgcn_mfma_f32_16x16x32_bf16(wl, ah[tl], acc[tl][nt], 0, 0, 0); }
            }
        }
    }
    float bg[4], be[32]; int pe_[2][2] = {{0, 0}, {0, 0}}, pr_[2][2] = {{0, 0}, {0, 0}};
#pragma unroll
    for (int g = 0; g < 4; ++g) bg[g] = b_group[g];
#pragma unroll
    for (int i = 0; i < 32; ++i) be[i] = b_expert[i];
#pragma unroll
    for (int tl = 0; tl < 2; ++tl) {
        float ss = tl ? ss1 : ss0; ss += __shfl_xor(ss, 16); ss += __shfl_xor(ss, 32);
        const float r2 = rsqrtf(ss * (1.f / DM) + EPS);
        float lg[36];
#pragma unroll
        for (int nt = 0; nt < 3; ++nt)
#pragma unroll
            for (int q = 0; q < 4; ++q)
#pragma unroll
                for (int j = 0; j < 4; ++j) { const int c = 16 * nt + 4 * q + j; if (c < 36) lg[c] = __shfl(acc[tl][nt][j], fr + 16 * q) * r2; }
        float gl[4];
#pragma unroll
        for (int g = 0; g < 4; ++g) gl[g] = lg[g] + bg[g];
        int gsel = 0; float gmax = gl[0];
#pragma unroll
        for (int g = 1; g < 4; ++g) if (gl[g] > gmax) { gmax = gl[g]; gsel = g; }
        float gsum = 0.f;
#pragma unroll
        for (int g = 0; g < 4; ++g) gsum += __expf(gl[g] - gmax);
        const float gwt = 1.f / gsum;
        float el[8];
#pragma unroll
        for (int i = 0; i < 8; ++i) el[i] = 0.f;
#pragma unroll
        for (int g = 0; g < 4; ++g) if (gsel == g) {
#pragma unroll
            for (int i = 0; i < 8; ++i) el[i] = lg[4 + 8 * g + i] + be[8 * g + i]; }
        int i1 = 0; float v1 = el[0];
#pragma unroll
        for (int i = 1; i < 8; ++i) if (el[i] > v1) { v1 = el[i]; i1 = i; }
        int i2 = -1; float v2 = -3.0e38f;
#pragma unroll
        for (int i = 0; i < 8; ++i) if (i != i1 && el[i] > v2) { v2 = el[i]; i2 = i; }
        const float p1 = 1.f / (1.f + __expf(v2 - v1)), p2 = 1.f - p1;
        if (fq == 0) {
            const int t = t0 + 16 * tl + fr;
            const int e1 = gsel * 8 + i1, e2 = gsel * 8 + i2;
            const int r1 = atomicAdd((int*)&hist[e1], 1), r2_ = atomicAdd((int*)&hist[e2], 1);
            pe_[tl][0] = e1; pe_[tl][1] = e2; pr_[tl][0] = r1; pr_[tl][1] = r2_;
            ASGW[2 * t] = gwt * p1; ASGW[2 * t + 1] = gwt * p2;
            ASGW[2 * T_ + 2 * t] = r2; ASGW[2 * T_ + 2 * t + 1] = r2;
        }
    }
    __syncthreads();
    LAS int* lbase = hist + 32;
    if (tid < 32) lbase[tid] = atomicAdd((int*)(ws + WS_CTL) + CW_CUR + 64 * tid, hist[tid]);
    __syncthreads();
    if (fq == 0) { int* LIST = (int*)(ws + WS_LIST);
#pragma unroll
        for (int tl = 0; tl < 2; ++tl) { const int t = t0 + 16 * tl + fr;
#pragma unroll
            for (int k = 0; k < 2; ++k) { const int e = pe_[tl][k], ii = lbase[e] + pr_[tl][k]; LIST[(size_t)e * LCAP + ii] = 2 * t + k; ASGE[2 * t + k] = e | (ii << 8); } } }
}

__device__ __forceinline__ void p5_dispatch(const Args& a, LAS unsigned char* lds, int tid, int wg, int G) {
    unsigned char* ws = a.ws;
    const int* ASGE = (const int*)(ws + WS_ASGE); const float* ASGW = (const float*)(ws + WS_ASGW); const int* CNT = (const int*)(ws + WS_CTL) + CW_CNT;
    int* META = (int*)(ws + WS_CTL) + CW_META; int* ROWTOK = (int*)(ws + WS_ROWTOK); float* ROWW = (float*)(ws + WS_ROWW); float* ROWR = (float*)(ws + WS_GATES); int* POSA = (int*)(ws + WS_POSA);
    LAS int* tot = (LAS int*)lds; LAS int* pre = tot + 32; LAS int* pst = pre + 32;
    {
        LAS int* part = pst + 64;
        const int e = tid & 31, j = tid >> 5; int total = 0, prefix = 0;
#pragma unroll
        for (int q = 0; q < 16; ++q) { const int w = 16 * j + q; const int c = (w < G) ? CNT[w * 32 + e] : 0; total += c; prefix += (w < wg) ? c : 0; }
        part[j * 32 + e] = total; part[512 + j * 32 + e] = prefix;
        __syncthreads();
        if (tid < 32) { int t2 = 0, p2 = 0;
#pragma unroll
            for (int q = 0; q < 16; ++q) { t2 += part[q * 32 + tid]; p2 += part[512 + q * 32 + tid]; }
            tot[tid] = t2; pre[tid] = p2; }
    }
    __syncthreads();
    if (tid == 0) { int s = 0; for (int e = 0; e < 32; ++e) { pst[e] = s; s += (tot[e] + 255) & ~255; } pst[32] = s; }
    __syncthreads();
    if (wg == 0 && tid <= 32) META[tid] = pst[tid];
    const int apw = 2 * T_ / G;
    for (int q = tid; q < apw; q += NTHR) { const int idx = wg * apw + q; const int ev = ASGE[idx], e = ev & 255, rank = ev >> 8; const int pos = pst[e] + pre[e] + rank; ROWTOK[pos] = idx; ROWW[pos] = ASGW[idx]; ROWR[pos] = ASGW[2 * T_ + idx]; POSA[idx] = pos; }
    if (wg < 32) { const int e = wg; for (int p = pst[e] + tot[e] + tid; p < pst[e + 1]; p += NTHR) { ROWTOK[p] = -1; ROWW[p] = 0.f; ROWR[p] = 0.f; } }
}

__device__ __forceinline__ int expert_of_row(const LAS int* pst, int row) { int e = 0;
#pragma unroll 1
    for (int i = 1; i < 32; ++i) e += (pst[i] <= row) ? 1 : 0;
    return e; }

__device__ __forceinline__ void unpack8(const u32x4 v, float (&f)[8]) { f[0] = bflo(v.x); f[1] = bfhi(v.x); f[2] = bflo(v.y); f[3] = bfhi(v.y); f[4] = bflo(v.z); f[5] = bfhi(v.z); f[6] = bflo(v.w); f[7] = bfhi(v.w); }
__device__ __forceinline__ void p6_naive(const Args& a, LAS unsigned char* lds, int tid, int wg, int G) {
    unsigned char* ws = a.ws;
    const int* META = (const int*)(ws + WS_CTL) + CW_META; const int* ROWTOK = (const int*)(ws + WS_ROWTOK);
    const bf16* H2 = (const bf16*)(ws + WS_H2); const bf16* WGU = (const bf16*)(ws + WS_WGU); bf16* HID = (bf16*)(ws + WS_HID);
    LAS int* pst = (LAS int*)lds;
    if (tid <= 32) pst[tid] = META[tid];
    __syncthreads();
    const int npad = pst[32], ntile = (npad / 64) * 8, rg = tid >> 5, cg = tid & 31;
    for (int tile = wg; tile < ntile; tile += G) {
        const int rt = tile >> 3, ct = tile & 7, e = expert_of_row(pst, rt * 64);
        const bf16* ar[4];
#pragma unroll
        for (int i = 0; i < 4; ++i) { const int tk = ROWTOK[rt * 64 + rg * 4 + i]; ar[i] = H2 + (size_t)(tk < 0 ? 0 : (tk >> 1)) * DM; }
        const int c0 = ct * 64 + cg * 2;
        const bf16* bg[2]; const bf16* bu[2];
#pragma unroll
        for (int j = 0; j < 2; ++j) { const int c = c0 + j; bg[j] = WGU + ((size_t)e * 1024 + (c >> 7) * 256 + (c & 127)) * 1024; bu[j] = bg[j] + 128 * 1024; }
        float g[4][2], u[4][2];
#pragma unroll
        for (int i = 0; i < 4; ++i)
#pragma unroll
            for (int j = 0; j < 2; ++j) { g[i][j] = 0.f; u[i][j] = 0.f; }
#pragma unroll 1
        for (int k = 0; k < 1024; k += 8) {
            float af[4][8], gf[2][8], uf[2][8];
#pragma unroll
            for (int i = 0; i < 4; ++i) unpack8(*(const u32x4*)(ar[i] + k), af[i]);
#pragma unroll
            for (int j = 0; j < 2; ++j) { unpack8(*(const u32x4*)(bg[j] + k), gf[j]); unpack8(*(const u32x4*)(bu[j] + k), uf[j]); }
#pragma unroll
            for (int i = 0; i < 4; ++i)
#pragma unroll
                for (int j = 0; j < 2; ++j)
#pragma unroll
                    for (int q = 0; q < 8; ++q) { g[i][j] += af[i][q] * gf[j][q]; u[i][j] += af[i][q] * uf[j][q]; }
        }
#pragma unroll
        for (int i = 0; i < 4; ++i) *(unsigned*)(HID + (size_t)(rt * 64 + rg * 4 + i) * DEXP + c0) = pk2(siluf_(g[i][0]) * u[i][0], siluf_(g[i][1]) * u[i][1]);
    }
}

__device__ __forceinline__ void p7_naive(const Args& a, LAS unsigned char* lds, int tid, int wg, int G) {
    unsigned char* ws = a.ws;
    const int* META = (const int*)(ws + WS_CTL) + CW_META; const int* ROWTOK = (const int*)(ws + WS_ROWTOK); const float* ROWW = (const float*)(ws + WS_ROWW);
    const bf16* HID = (const bf16*)(ws + WS_HID); const bf16* WD = (const bf16*)(ws + WS_WD); bf16* YBUF = (bf16*)(ws + WS_YBUF);
    LAS int* pst = (LAS int*)lds;
    if (tid <= 32) pst[tid] = META[tid];
    __syncthreads();
    const int npad = pst[32], ntile = (npad / 64) * 8, rg = tid >> 5, cg = tid & 31;
    for (int tile = wg; tile < ntile; tile += G) {
        const int rt = tile >> 3, ct = tile & 7, e = expert_of_row(pst, rt * 64);
        const bf16* ar[4]; const bf16* br[4];
#pragma unroll
        for (int i = 0; i < 4; ++i) ar[i] = HID + (size_t)(rt * 64 + rg * 4 + i) * DEXP;
        const int c0 = ct * 128 + cg * 4;
#pragma unroll
        for (int j = 0; j < 4; ++j) br[j] = WD + ((size_t)e * 1024 + c0 + j) * DEXP;
        float acc[4][4];
#pragma unroll
        for (int i = 0; i < 4; ++i)
#pragma unroll
            for (int j = 0; j < 4; ++j) acc[i][j] = 0.f;
#pragma unroll 1
        for (int k = 0; k < DEXP; k += 8) {
            float af[4][8], bfv[4][8];
#pragma unroll
            for (int i = 0; i < 4; ++i) { unpack8(*(const u32x4*)(ar[i] + k), af[i]); unpack8(*(const u32x4*)(br[i] + k), bfv[i]); }
#pragma unroll
            for (int i = 0; i < 4; ++i)
#pragma unroll
                for (int j = 0; j < 4; ++j)
#pragma unroll
                    for (int q = 0; q < 8; ++q) acc[i][j] += af[i][q] * bfv[j][q];
        }
#pragma unroll
        for (int i = 0; i < 4; ++i) { const int pos = rt * 64 + rg * 4 + i; const int tk = ROWTOK[pos];
            if (tk >= 0) { const float w = ROWW[pos]; const int t = tk >> 1, kk = tk & 1;
                u32x2 o; o.x = pk2(acc[i][0] * w, acc[i][1] * w); o.y = pk2(acc[i][2] * w, acc[i][3] * w);
                *(u32x2*)(YBUF + ((size_t)kk * T_ + t) * DM + c0) = o; } }
    }
}

__device__ __forceinline__ void p8_combine(const Args& a, int tid, int wg, int G) {
    const unsigned char* Y = a.ws + WS_YBUF; const bf16* X1B = (const bf16*)(a.ws + WS_H2); float* O = a.out;
    const int* POSA = (const int*)(a.ws + WS_POSA); const float* ASGW = (const float*)(a.ws + WS_ASGW);
    const int lane = tid & 63, gw = wg * NWAVES + __builtin_amdgcn_readfirstlane(tid >> 6), NGW = G * NWAVES;
    u32x4 xb[2]; u32x2 y0[2], y1[2]; float w0 = 0.f, w1 = 0.f;
#define P8_LOAD(t_) do { const int t__ = __builtin_amdgcn_readfirstlane(t_); const int p0_ = POSA[2 * t__], p1_ = POSA[2 * t__ + 1]; w0 = ASGW[2 * t__]; w1 = ASGW[2 * t__ + 1]; \
        _Pragma("unroll") for (int q = 0; q < 2; ++q) { xb[q] = *(const u32x4*)(X1B + (size_t)t__ * DM + (lane + 64 * q) * 8); y0[q] = *(const u32x2*)(Y + (size_t)p0_ * DM + (lane + 64 * q) * 8); \
            y1[q] = *(const u32x2*)(Y + (size_t)p1_ * DM + (lane + 64 * q) * 8); } } while (0)
#define P8_F8(w_, i_) __builtin_amdgcn_cvt_f32_fp8((int)(w_), (i_))
    P8_LOAD(gw);
#pragma unroll 1
    for (int t = gw; t < T_; t += NGW) {
        u32x4 cx[2]; u32x2 c0[2], c1[2]; const float cw0 = w0, cw1 = w1;
#pragma unroll
        for (int q = 0; q < 2; ++q) { cx[q] = xb[q]; c0[q] = y0[q]; c1[q] = y1[q]; }
        if (t + NGW < T_) P8_LOAD(t + NGW);
#pragma unroll
        for (int q = 0; q < 2; ++q) {
            f32x4 a0, a1;
            a0.x = bflo(cx[q].x) + cw0 * P8_F8(c0[q].x, 0) + cw1 * P8_F8(c1[q].x, 0); a0.y = bfhi(cx[q].x) + cw0 * P8_F8(c0[q].x, 1) + cw1 * P8_F8(c1[q].x, 1);
            a0.z = bflo(cx[q].y) + cw0 * P8_F8(c0[q].x, 2) + cw1 * P8_F8(c1[q].x, 2); a0.w = bfhi(cx[q].y) + cw0 * P8_F8(c0[q].x, 3) + cw1 * P8_F8(c1[q].x, 3);
            a1.x = bflo(cx[q].z) + cw0 * P8_F8(c0[q].y, 0) + cw1 * P8_F8(c1[q].y, 0); a1.y = bfhi(cx[q].z) + cw0 * P8_F8(c0[q].y, 1) + cw1 * P8_F8(c1[q].y, 1);
            a1.z = bflo(cx[q].w) + cw0 * P8_F8(c0[q].y, 2) + cw1 * P8_F8(c1[q].y, 2); a1.w = bfhi(cx[q].w) + cw0 * P8_F8(c0[q].y, 3) + cw1 * P8_F8(c1[q].y, 3);
            float* op = O + (size_t)t * DM + (lane + 64 * q) * 8;
            *(f32x4*)op = a0; *(f32x4*)(op + 4) = a1;
        }
    }
#undef P8_LOAD
#undef P8_F8
}

#ifndef STAGGER_P1
#define STAGGER_P1 700
#endif
#ifndef STAGGER_P6
#define STAGGER_P6 0
#endif
#ifndef STAGGER_P7
#define STAGGER_P7 0
#endif
__device__ __forceinline__ void phase_stagger(unsigned ticks) {
    const unsigned g = blockIdx.x & 3u;
    if (g != 0u && ticks != 0u) { const unsigned long long t0 = __builtin_amdgcn_s_memrealtime(); while (__builtin_amdgcn_s_memrealtime() - t0 < (unsigned long long)(g * ticks)) __builtin_amdgcn_s_sleep(16); }
}

__device__ __forceinline__ void p6_gemm(const Args& a, LAS unsigned char* lds, int tid, int wg, int G) {
    unsigned char* ws = a.ws;
    LAS int* pst = (LAS int*)(lds + 131072); LAS int* tot = pst + 64;
    if (tid < 32) tot[tid] = ((const int*)(ws + WS_CTL) + CW_CUR)[64 * tid];
    __syncthreads();
    if (tid == 0) { int s_ = 0; for (int e = 0; e < 32; ++e) { pst[e] = s_; s_ += (tot[e] + 255) & ~255; } pst[32] = s_; }
    __syncthreads();
    {
        const int* ASGE = (const int*)(ws + WS_ASGE); int* POSA = (int*)(ws + WS_POSA); const int idx = wg * (2 * T_ / G) + tid;
        if (tid < 2 * T_ / G) { const int ev = ASGE[idx]; POSA[idx] = pst[ev & 255] + (ev >> 8); }
    }
    pg8::MoeGuSched S; S.o.init(pst[32] / 256, 4, G, wg); S.A = (const char*)(ws + WS_X1F); S.Bt = (const char*)(ws + WS_WGU); S.rowtok = (const int*)(ws + WS_ROWTOK); S.pst = pst; S.K = DM / 2;
    LAS int* ltok = (LAS int*)(lds + 131584); LAS float* lrowr = (LAS float*)(lds + 131584 + 9 * 256 * 4);
    {
        const int* LIST = (const int*)(ws + WS_LIST); const float* R2 = (const float*)(ws + WS_ASGW) + 2 * T_;
        int tv[9]; float rv[9]; bool ok[9];
#pragma unroll
        for (int i = 0; i < 9; ++i) { int pm, pn; ok[i] = S.o.map(i, pm, pn); tv[i] = -1; rv[i] = 0.f;
            if (ok[i] && tid < 256) { const int e = pg8::expert_of_row_l(pst, pm * 256), ii = pm * 256 + tid - pst[e]; if (ii < tot[e]) tv[i] = LIST[(size_t)e * LCAP + ii]; } }
#pragma unroll
        for (int i = 0; i < 9; ++i) if (tv[i] >= 0) rv[i] = R2[tv[i]];
#pragma unroll
        for (int i = 0; i < 9; ++i) if (ok[i] && tid < 256) { ltok[i * 256 + tid] = tv[i]; lrowr[i * 256 + tid] = rv[i]; }
        __syncthreads();
    }
    S.ltok = ltok;
    pg8::EpiSwiglu E{(bf16*)(ws + WS_HID), lrowr};
    phase_stagger(STAGGER_P6);
    pg8::gemm_phase<pg8::EpiSwiglu, pg8::MoeGuSched, true, true>(lds, DM / 2, S, E);
}
__device__ __forceinline__ void p7_gemm(const Args& a, LAS unsigned char* lds, int tid, int wg, int G) {
    unsigned char* ws = a.ws;
    LAS int* pst = (LAS int*)(lds + 131072); LAS int* tot = pst + 64;
    if (tid < 32) tot[tid] = ((const int*)(ws + WS_CTL) + CW_CUR)[64 * tid];
    __syncthreads();
    if (tid == 0) { int s_ = 0; for (int e = 0; e < 32; ++e) { pst[e] = s_; s_ += (tot[e] + 255) & ~255; } pst[32] = s_; }
    __syncthreads();
    pg8::MoeDownSched S; S.o.init(pst[32] / 256, 4, G, wg); S.A = (const char*)(ws + WS_HID); S.Bt = (const char*)(ws + WS_WD); S.pst = pst; S.K = DEXP / 2;
    pg8::EpiF8 E{ws + WS_YBUF, DM};
    phase_stagger(STAGGER_P7);
    pg8::gemm_phase<pg8::EpiF8, pg8::MoeDownSched, true, true>(lds, DEXP / 2, S, E);
}

__global__ void __launch_bounds__(NTHR, 2) fwd(Args args) {
    extern __shared__ __attribute__((aligned(16))) unsigned char lds_raw[];
    LAS unsigned char* lds = (LAS unsigned char*)lds_raw;
    const int tid0 = threadIdx.x, wg = blockIdx.x, G = gridDim.x;
#define PH_TID() int tid = threadIdx.x; asm volatile("" : "+v"(tid)); const int lane = tid & 63, wave = __builtin_amdgcn_readfirstlane(tid >> 6); (void)lane; (void)wave
    unsigned char* ws = args.ws;
    unsigned* ctl = (unsigned*)(ws + WS_CTL);
    for (int u = tid0; u < 256; u += NTHR) ((LAS unsigned*)(lds + LDSCTL_OFF))[u] = 0u;
    __syncthreads();
    const int lo = args.ph_lo, hi = args.ph_hi;
    XcdBarrier bar = xcd_barrier_post(ctl + CW_BAR, (volatile LAS unsigned*)(lds + LDSCTL_OFF));
#define IN(k) (lo <= (k) && (k) < hi)
#ifndef PROBE_PHASE
#define PROBE_PHASE -1
#endif
#define REPS(k) ((PROBE_PHASE == (k)) ? 2 : 1)
#define REPSEP(k) do { if (rep + 1 < REPS(k)) xcd_barrier(bar); } while (0)
#define SEAM(k) do { if (IN(k) && IN((k) + 1)) xcd_barrier(bar); } while (0)

    if (IN(0)) { for (int rep = 0; rep < REPS(0); ++rep) { PH_TID(); p0_prologue(args, lds, tid, lane, wave, wg, G);  REPSEP(0); } }
    SEAM(0);
    if (IN(1)) { for (int rep = 0; rep < REPS(1); ++rep) {
        pg8::DenseSched S; S.o.init(T_ / 256, NCOL / 256, G, wg); S.A = (const char*)(ws + WS_H1); S.Bt = (const char*)(ws + WS_W1T); S.K = DM;
        pg8::EpiProj E{(bf16*)(ws + WS_PROJ), NCOL, args.in[8], args.in[9]};
        { PH_TID(); p1_stagger_work(args, lds, lane, wave, wg); }
        asm volatile("s_waitcnt vmcnt(0) lgkmcnt(0)" ::: "memory"); __syncthreads();
        pg8::gemm_phase<pg8::EpiProj, pg8::DenseSched, true>(lds, DM, S, E);
     REPSEP(1); } }
    SEAM(1);
    if (IN(2)) { for (int rep = 0; rep < REPS(2); ++rep) { { PH_TID(); if (wg < NBATCH * 4 || PROBE_PHASE == 23) { ml::mlstm_item(args, lds, wg & 127, tid); } } __syncthreads(); { PH_TID(); p2_fast_attn(args, lds, tid, lane, wave, wg, G, rep); if (PROBE_PHASE == 21) { __syncthreads(); p2_fast_attn(args, lds, tid, lane, wave, wg, G, 1); } }  REPSEP(2); } }
    SEAM(2);
    if (IN(3)) { for (int rep = 0; rep < REPS(3); ++rep) {
        pg8::DenseSched S; S.o.init(T_ / 256, DM / 256, G, wg); S.A = (const char*)(ws + WS_MIX); S.Bt = (const char*)(ws + WS_W2T); S.K = DM;
        pg8::EpiX1 E{args.in[0], (bf16*)(ws + WS_H2), ws + WS_X1F, DM};
        pg8::gemm_phase<pg8::EpiX1, pg8::DenseSched, true>(lds, DM, S, E);
     REPSEP(3); } }
    SEAM(3);
    if (IN(4)) { for (int rep = 0; rep < REPS(4); ++rep) { PH_TID(); p4_router_mfma(args, lds, tid, lane, wave, wg, G);  REPSEP(4); } }
    SEAM(4);
    if (IN(6)) { for (int rep = 0; rep < REPS(6); ++rep) { PH_TID(); p6_gemm(args, lds, tid, wg, G);  REPSEP(6); } }
    SEAM(6);
    if (IN(7)) { for (int rep = 0; rep < REPS(7); ++rep) { PH_TID(); p7_gemm(args, lds, tid, wg, G);  REPSEP(7); } }
    SEAM(7);
    if (IN(8)) { PH_TID(); p8_combine(args, tid, wg, G); }
#undef IN
#undef SEAM
}

#ifndef MK_N_LAUNCHES
#define MK_N_LAUNCHES 1
#endif
extern "C" void kernel_launch(void* const* d_in, const int* in_sizes, int n_in, void* d_out, int out_size, void* d_ws, size_t ws_size, hipStream_t stream) {
    static int grid = 0;
    if (grid == 0) {
        if (n_in != 24 || in_sizes[0] != T_ * DM || out_size != T_ * DM || ws_size < WS_END) { fprintf(stderr, "kernel_launch: unexpected shapes (n_in %d, in0 %d, out %d, ws %zu); nothing launched\n", n_in, n_in > 0 ? in_sizes[0] : -1, out_size, ws_size); grid = -1; return; }
        int dev = 0, cus = 0, per_cu = 0;
        if (hipGetDevice(&dev) != hipSuccess || hipDeviceGetAttribute(&cus, hipDeviceAttributeMultiprocessorCount, dev) != hipSuccess) { grid = -1; return; }
        if (hipFuncSetAttribute((const void*)fwd, hipFuncAttributeMaxDynamicSharedMemorySize, LDS_BYTES) != hipSuccess) { fprintf(stderr, "kernel_launch: hipFuncSetAttribute failed\n"); grid = -1; return; }
        if (hipOccupancyMaxActiveBlocksPerMultiprocessor(&per_cu, (const void*)fwd, NTHR, LDS_BYTES) != hipSuccess || per_cu < 1) fprintf(stderr, "kernel_launch: occupancy query reports %d\n", per_cu);
        (void)hipGetLastError();
        grid = cus;
        if (grid != 256) { fprintf(stderr, "kernel_launch: built for 256 CUs, found %d; nothing launched\n", cus); grid = -1; return; }
    }
    if (grid < 0) return;
    if (hipMemsetAsync((char*)d_ws + WS_CTL, 0, CTL_ZERO_BYTES, stream) != hipSuccess) return;
    Args a{};
    for (int i = 0; i < 24; ++i) a.in[i] = (const float*)d_in[i];
    a.out = (float*)d_out; a.ws = (unsigned char*)d_ws;
    if (MK_N_LAUNCHES == 1) { a.ph_lo = 0; a.ph_hi = 9; hipLaunchKernelGGL(fwd, dim3(grid), dim3(NTHR), LDS_BYTES, stream, a); }
    else { for (int p = 0; p < 9; ++p) { a.ph_lo = p; a.ph_hi = p + 1; hipLaunchKernelGGL(fwd, dim3(grid), dim3(NTHR), LDS_BYTES, stream, a); } }
    const hipError_t le = hipPeekAtLastError();
    if (le != hipSuccess) fprintf(stderr, "kernel_launch: launch failed: %s\n", hipGetErrorName(le));
}
```

```cpp
#include <hip/hip_runtime.h>
#include <cstdio>
#include <cstdint>

#define GAS __attribute__((address_space(1)))
#define LAS __attribute__((address_space(3)))
typedef unsigned short bf16;
typedef unsigned u32x4 __attribute__((ext_vector_type(4)));
typedef unsigned u32x2 __attribute__((ext_vector_type(2)));
typedef float f32x4 __attribute__((ext_vector_type(4)));
typedef float f32x2 __attribute__((ext_vector_type(2)));
typedef short bf16x8 __attribute__((ext_vector_type(8)));

constexpr int T_ = 65536, DM = 1024, SEQ = 2048, NBATCH = 32, NCOL = 3584, INCOLS = 3592;
constexpr int C_MQ = 0, C_MK = 512, C_MV = 1024, C_MO = 1536, C_AQ = 2048, C_AK = 2560, C_AV = 3072;
constexpr int NEXP = 32, DEXP = 512, PMAX = 131072 + NEXP * 256;
constexpr float EPS = 1e-6f;
constexpr float LAMBDA_INIT = 0.2f;
constexpr int NWAVES = 8, NTHR = 512;

constexpr size_t MiB = 1u << 20;
constexpr size_t WS_CTL = 0, CTL_ZERO_BYTES = 64 * 1024;
constexpr size_t WS_W1T = 1 * MiB, WS_W2T = 8 * MiB, WS_WGU = 10 * MiB, WS_WD = 74 * MiB, WS_GATES = 106 * MiB;
constexpr size_t WS_ASGE = 108 * MiB, WS_ASGW = 109 * MiB, WS_ROWTOK = 110 * MiB, WS_ROWW = 111 * MiB;
constexpr size_t WS_H1 = 112 * MiB, WS_MIX = 240 * MiB, WS_PROJ = 368 * MiB, WS_END = 816 * MiB;
constexpr size_t WS_YBUF = 112 * MiB;
constexpr size_t WS_H2 = 384 * MiB, WS_HID = 512 * MiB;
constexpr size_t WS_MO = 112 * MiB;
constexpr size_t WS_X1F = 584 * MiB;
constexpr size_t WS_RIMG = 111 * MiB + 768 * 1024;
constexpr size_t WS_POSA = 108 * MiB + 512 * 1024;
constexpr int CW_BAR = 4096, CW_QUEUE = 8192, CW_CNT = 16384, CW_META = 32768;
constexpr size_t WS_R1 = 100 * MiB;
constexpr int CW_CUR = 12288;
constexpr size_t WS_LIST = 700 * MiB; constexpr int LCAP = 2 * 65536;

constexpr int LDS_SCRATCH = 155648;
constexpr int LDSCTL_OFF = LDS_SCRATCH;
constexpr int LDS_BYTES = LDS_SCRATCH + 1024;

__device__ __forceinline__ unsigned f2bf(float f) { unsigned u = __builtin_bit_cast(unsigned, f); return (u + 0x7fffu + ((u >> 16) & 1u)) >> 16; }
__device__ __forceinline__ unsigned pk2(float lo, float hi) { return f2bf(lo) | (f2bf(hi) << 16); }
__device__ __forceinline__ float bf2f(bf16 v) { return __uint_as_float(((unsigned)v) << 16); }
__device__ __forceinline__ float bflo(unsigned u) { return __uint_as_float(u << 16); }
__device__ __forceinline__ float bfhi(unsigned u) { return __uint_as_float(u & 0xffff0000u); }
__device__ __forceinline__ float wave_sum(float v) {
#pragma unroll
    for (int o = 1; o < 64; o <<= 1) v += __shfl_xor(v, o);
    return v;
}
__device__ __forceinline__ float wave_max(float v) {
#pragma unroll
    for (int o = 1; o < 64; o <<= 1) v = fmaxf(v, __shfl_xor(v, o));
    return v;
}
__device__ __forceinline__ float sigmoidf_(float x) { return 1.f / (1.f + __expf(-x)); }
__device__ __forceinline__ float siluf_(float x) { return x / (1.f + __expf(-x)); }
__device__ __forceinline__ unsigned pk4_fp8(float a, float b, float c, float d) { int w = 0; w = __builtin_amdgcn_cvt_pk_fp8_f32(a, b, w, false); w = __builtin_amdgcn_cvt_pk_fp8_f32(c, d, w, true); return (unsigned)w; }
#define LDS_WAIT() asm volatile("s_waitcnt lgkmcnt(0)" ::: "memory")
#define VM_WAIT() asm volatile("s_waitcnt vmcnt(0)" ::: "memory")

namespace pg8 {
#define PG8_LAS __attribute__((address_space(3)))
constexpr int BM = 256, BK = 64, HALF = 128, HTB = HALF * BK * 2, STAGE_BYTES = 8 * HTB, NXCD = 8, WGM = 4;
__host__ __device__ __forceinline__ int lds_byte(int r, int c) { const int st = (r >> 4) * 2 + (c >> 5), rr = r & 15, cc = c & 31, ob = rr * 64 + cc * 2; return st * 1024 + (ob ^ (((ob >> 9) & 1) << 5)); }
__host__ __device__ __forceinline__ void stage_rc(int b, int& R, int& C) { const int st = b / 1024, sb = b % 1024, swz = sb ^ (((sb >> 9) & 1) << 5); R = (st >> 1) * 16 + swz / 64; C = (st & 1) * 32 + (swz % 64) / 2; }
__host__ __device__ __forceinline__ int perm32(int rho) { const int n = rho >> 4, i = rho & 15; return 8 * (i >> 2) + 4 * n + (i & 3); }

struct Unit { int pm, pn, e, li; };
struct TileOrder {
    int nM, nN, nwg, G, c;
    __device__ __forceinline__ void init(int nM_, int nN_, int G_, int c_) { nM = nM_; nN = nN_; nwg = nM * nN; G = G_; c = c_; }
    __device__ __forceinline__ bool map(int i, int& pm, int& pn) const {
        const long L = (long)i * G + c; if (L >= nwg) return false;
        int wgid = (int)L; { const int q = nwg / NXCD, r = nwg % NXCD, xcd = wgid % NXCD, off = wgid / NXCD; wgid = (xcd < r ? xcd * (q + 1) : r * (q + 1) + (xcd - r) * q) + off; }
        const int nig = WGM * nN, gid = wgid / nig, fm = gid * WGM, gsz = (nM - fm) < WGM ? (nM - fm) : WGM;
        pm = fm + ((wgid % nig) % gsz); pn = (wgid % nig) / gsz; return true;
    }
};
struct DenseSched {
    static constexpr bool GATHER = false;
    TileOrder o; const char* A; const char* Bt; int K;
    __device__ __forceinline__ bool next(int i, Unit& u) const { u.e = 0; u.li = i; return o.map(i, u.pm, u.pn); }
    __device__ __forceinline__ const char* a_base(const Unit& u) const { return A + (size_t)u.pm * BM * K * 2; }
    __device__ __forceinline__ const char* b_base(const Unit& u) const { return Bt + (size_t)u.pn * BM * K * 2; }
    __device__ __forceinline__ void a_voff(const Unit&, const int (&R)[2], const int (&C)[2], unsigned (&v)[2][2]) const {
#pragma unroll
        for (int h = 0; h < 2; ++h)
#pragma unroll
            for (int i = 0; i < 2; ++i) v[h][i] = (unsigned)((h * HALF + R[i]) * K + C[i]) * 2u;
    }
};

__device__ __forceinline__ unsigned cvt_pk_bf16(float lo, float hi) { unsigned r; asm volatile("v_cvt_pk_bf16_f32 %0, %1, %2" : "=v"(r) : "v"(lo), "v"(hi)); return r; }

struct EpiBf16 {
    static constexpr bool PERM = true;
    bf16* O; int ldc;
    __device__ __forceinline__ void operator()(const f32x4 (&acc)[2][2][4][2], const Unit& u, int wr, int wc, int fr, int fq) const {
        const int row0 = u.pm * BM + wr * 64 + fr, col0 = u.pn * BM + wc * 32 + 8 * fq;
#pragma unroll
        for (int ai = 0; ai < 2; ++ai)
#pragma unroll
            for (int m = 0; m < 4; ++m) { bf16* rowp = O + (size_t)(row0 + ai * HALF + m * 16) * ldc + col0;
#pragma unroll
                for (int bj = 0; bj < 2; ++bj) { const f32x4 v0 = acc[ai][bj][m][0], v1 = acc[ai][bj][m][1];
                    u32x4 w; w.x = cvt_pk_bf16(v0[0], v0[1]); w.y = cvt_pk_bf16(v0[2], v0[3]); w.z = cvt_pk_bf16(v1[0], v1[1]); w.w = cvt_pk_bf16(v1[2], v1[3]);
                    *(u32x4*)(rowp + bj * HALF) = w; } }
    }
};
struct EpiF8 {
    static constexpr bool PERM = true;
    unsigned char* O; int ldc;
    __device__ __forceinline__ void operator()(const f32x4 (&acc)[2][2][4][2], const Unit& u, int wr, int wc, int fr, int fq) const {
        const int row0 = u.pm * BM + wr * 64 + fr, col0 = u.pn * BM + wc * 32 + 8 * fq;
#pragma unroll
        for (int ai = 0; ai < 2; ++ai)
#pragma unroll
            for (int m = 0; m < 4; ++m) { unsigned char* rowp = O + (size_t)(row0 + ai * HALF + m * 16) * ldc + col0;
#pragma unroll
                for (int bj = 0; bj < 2; ++bj) { const f32x4 v0 = acc[ai][bj][m][0], v1 = acc[ai][bj][m][1];
                    u32x2 w; w.x = pk4_fp8(v0[0], v0[1], v0[2], v0[3]); w.y = pk4_fp8(v1[0], v1[1], v1[2], v1[3]);
                    *(u32x2*)(rowp + bj * HALF) = w; } }
    }
};
struct EpiProj {
    static constexpr bool PERM = true;
    bf16* O; int ldc; const float* qw; const float* kw; const PG8_LAS float* rs;
    __device__ __forceinline__ void operator()(const f32x4 (&acc)[2][2][4][2], const Unit& u, int wr, int wc, int fr, int fq) const {
        const int row0 = u.pm * BM + wr * 64 + fr;
        if (u.pn >= 8 && u.pn < 12) {
            const float* wsrc = (u.pn < 10) ? qw : kw; const float post = (u.pn < 10) ? 0.18033688011112042f : 1.0f;
            f32x4 wv[2][2];
#pragma unroll
            for (int bj = 0; bj < 2; ++bj)
#pragma unroll
                for (int n = 0; n < 2; ++n) wv[bj][n] = *(const f32x4*)(wsrc + 32 * bj + 8 * fq + 4 * n) * post;
            const int col0 = u.pn * BM + wc * 64 + 8 * fq;
#pragma unroll
            for (int ai = 0; ai < 2; ++ai)
#pragma unroll
                for (int m = 0; m < 4; ++m) {
                    float ss = 0.f;
#pragma unroll
                    for (int bj = 0; bj < 2; ++bj)
#pragma unroll
                        for (int n = 0; n < 2; ++n) { const f32x4 x = acc[ai][bj][m][n]; ss += (x[0] * x[0] + x[1] * x[1]) + (x[2] * x[2] + x[3] * x[3]); }
                    ss += __shfl_xor(ss, 16); ss += __shfl_xor(ss, 32);
                    const float r1 = rs[u.li * BM + wr * 64 + fr + ai * HALF + m * 16];
                    const float r = rsqrtf(ss * (r1 * r1) * (1.f / 64.f) + 1e-6f) * r1;
                    bf16* rowp = O + (size_t)(row0 + ai * HALF + m * 16) * ldc + col0;
#pragma unroll
                    for (int bj = 0; bj < 2; ++bj) { const f32x4 v0 = acc[ai][bj][m][0] * r * wv[bj][0], v1 = acc[ai][bj][m][1] * r * wv[bj][1];
                        u32x4 w; w.x = cvt_pk_bf16(v0[0], v0[1]); w.y = cvt_pk_bf16(v0[2], v0[3]); w.z = cvt_pk_bf16(v1[0], v1[1]); w.w = cvt_pk_bf16(v1[2], v1[3]);
                        *(u32x4*)(rowp + bj * 32) = w; } }
        } else {
            const int col0 = u.pn * BM + wc * 32 + 8 * fq; const bool sig = (u.pn == 6 || u.pn == 7);
#pragma unroll
            for (int ai = 0; ai < 2; ++ai)
#pragma unroll
                for (int m = 0; m < 4; ++m) { bf16* rowp = O + (size_t)(row0 + ai * HALF + m * 16) * ldc + col0; const float r1 = rs[u.li * BM + wr * 64 + fr + ai * HALF + m * 16];
#pragma unroll
                    for (int bj = 0; bj < 2; ++bj) { f32x4 v0 = acc[ai][bj][m][0] * r1, v1 = acc[ai][bj][m][1] * r1;
                        if (sig) {
#pragma unroll
                            for (int j = 0; j < 4; ++j) { v0[j] = __builtin_amdgcn_rcpf(1.f + __builtin_amdgcn_exp2f(v0[j] * -1.4426950408889634f)); v1[j] = __builtin_amdgcn_rcpf(1.f + __builtin_amdgcn_exp2f(v1[j] * -1.4426950408889634f)); } }
                        u32x4 w; w.x = cvt_pk_bf16(v0[0], v0[1]); w.y = cvt_pk_bf16(v0[2], v0[3]); w.z = cvt_pk_bf16(v1[0], v1[1]); w.w = cvt_pk_bf16(v1[2], v1[3]);
                        *(u32x4*)(rowp + bj * HALF) = w; } }
        }
    }
};
struct EpiX1 {
    static constexpr bool PERM = true;
    const bf16* X; bf16* OB; unsigned char* OF; int ldc;
    __device__ __forceinline__ void operator()(const f32x4 (&acc)[2][2][4][2], const Unit& u, int wr, int wc, int fr, int fq) const {
        const int row0 = u.pm * BM + wr * 64 + fr, col0 = u.pn * BM + wc * 32 + 8 * fq;
#pragma unroll
        for (int ai = 0; ai < 2; ++ai) {
            u32x4 xv[4][2];
#pragma unroll
            for (int m = 0; m < 4; ++m) { const size_t off = (size_t)(row0 + ai * HALF + m * 16) * ldc + col0;
#pragma unroll
                for (int bj = 0; bj < 2; ++bj) xv[m][bj] = *(const u32x4*)(X + off + bj * HALF); }
#pragma unroll
            for (int m = 0; m < 4; ++m) { const size_t off = (size_t)(row0 + ai * HALF + m * 16) * ldc + col0;
#pragma unroll
                for (int bj = 0; bj < 2; ++bj) { const u32x4 xx = xv[m][bj];
                    const f32x4 r0 = (f32x4){bflo(xx.x), bfhi(xx.x), bflo(xx.y), bfhi(xx.y)} + acc[ai][bj][m][0], r1 = (f32x4){bflo(xx.z), bfhi(xx.z), bflo(xx.w), bfhi(xx.w)} + acc[ai][bj][m][1];
                    u32x4 w; w.x = cvt_pk_bf16(r0[0], r0[1]); w.y = cvt_pk_bf16(r0[2], r0[3]); w.z = cvt_pk_bf16(r1[0], r1[1]); w.w = cvt_pk_bf16(r1[2], r1[3]);
                    *(u32x4*)(OB + off + bj * HALF) = w;
                    u32x2 f; f.x = pk4_fp8(r0[0], r0[1], r0[2], r0[3]); f.y = pk4_fp8(r1[0], r1[1], r1[2], r1[3]);
                    *(u32x2*)(OF + off + bj * HALF) = f; } }
            asm volatile("" ::: "memory");
        }
    }
};
struct EpiResF32 {
    static constexpr bool PERM = true;
    const float* X; float* O; int ldc; bf16* OB;
    __device__ __forceinline__ void operator()(const f32x4 (&acc)[2][2][4][2], const Unit& u, int wr, int wc, int fr, int fq) const {
        const int row0 = u.pm * BM + wr * 64 + fr, col0 = u.pn * BM + wc * 32 + 8 * fq;
#pragma unroll
        for (int ai = 0; ai < 2; ++ai) {
            f32x4 xv[4][2][2];
#pragma unroll
            for (int m = 0; m < 4; ++m) { const size_t off = (size_t)(row0 + ai * HALF + m * 16) * ldc + col0;
#pragma unroll
                for (int bj = 0; bj < 2; ++bj) { xv[m][bj][0] = *(const f32x4*)(X + off + bj * HALF); xv[m][bj][1] = *(const f32x4*)(X + off + bj * HALF + 4); } }
#pragma unroll
            for (int m = 0; m < 4; ++m) { const size_t off = (size_t)(row0 + ai * HALF + m * 16) * ldc + col0;
#pragma unroll
                for (int bj = 0; bj < 2; ++bj) {
                    const f32x4 r0 = xv[m][bj][0] + acc[ai][bj][m][0], r1 = xv[m][bj][1] + acc[ai][bj][m][1];
                    *(f32x4*)(O + off + bj * HALF) = r0; *(f32x4*)(O + off + bj * HALF + 4) = r1;
                    u32x4 w; w.x = cvt_pk_bf16(r0[0], r0[1]); w.y = cvt_pk_bf16(r0[2], r0[3]); w.z = cvt_pk_bf16(r1[0], r1[1]); w.w = cvt_pk_bf16(r1[2], r1[3]);
                    *(u32x4*)(OB + off + bj * HALF) = w; } }
            asm volatile("" ::: "memory");
        }
    }
};

__device__ __forceinline__ int expert_of_row_l(const PG8_LAS int* pst, int row) {
    const int lane = (int)__builtin_amdgcn_mbcnt_hi(~0u, __builtin_amdgcn_mbcnt_lo(~0u, 0u));
    const bool hit = (lane >= 1 && lane < 32) ? (pst[lane & 31] <= row) : false;
    return __builtin_popcountll(__ballot(hit)); }
struct MoeGuSched {
    static constexpr bool GATHER = true;
    TileOrder o; const char* A; const char* Bt; const int* rowtok; const PG8_LAS int* pst; int K; const PG8_LAS int* ltok;
    __device__ __forceinline__ bool next(int i, Unit& u) const { u.li = i; if (!o.map(i, u.pm, u.pn)) return false; u.e = expert_of_row_l(pst, u.pm * BM); return true; }
    __device__ __forceinline__ const char* a_base(const Unit&) const { return A; }
    __device__ __forceinline__ const char* b_base(const Unit& u) const { return Bt + ((size_t)u.e * 1024 + (size_t)u.pn * BM) * K * 2; }
    __device__ __forceinline__ void a_voff(const Unit& u, const int (&R)[2], const int (&C)[2], unsigned (&v)[2][2]) const {
#pragma unroll
        for (int h = 0; h < 2; ++h)
#pragma unroll
            for (int i = 0; i < 2; ++i) { const int tk = ltok[u.li * BM + h * HALF + R[i]]; const unsigned tok = tk < 0 ? 0u : (unsigned)(tk >> 1); v[h][i] = (tok * (unsigned)K + (unsigned)C[i]) * 2u; }
    }
};
struct MoeDownSched {
    static constexpr bool GATHER = false;
    TileOrder o; const char* A; const char* Bt; const PG8_LAS int* pst; int K;
    __device__ __forceinline__ bool next(int i, Unit& u) const { u.li = i; if (!o.map(i, u.pm, u.pn)) return false; u.e = expert_of_row_l(pst, u.pm * BM); return true; }
    __device__ __forceinline__ const char* a_base(const Unit& u) const { return A + (size_t)u.pm * BM * K * 2; }
    __device__ __forceinline__ const char* b_base(const Unit& u) const { return Bt + ((size_t)u.e * 1024 + (size_t)u.pn * BM) * K * 2; }
    __device__ __forceinline__ void a_voff(const Unit&, const int (&R)[2], const int (&C)[2], unsigned (&v)[2][2]) const {
#pragma unroll
        for (int h = 0; h < 2; ++h)
#pragma unroll
            for (int i = 0; i < 2; ++i) v[h][i] = (unsigned)((h * HALF + R[i]) * K + C[i]) * 2u;
    }
};
struct EpiSwiglu {
    static constexpr bool PERM = true;
    bf16* O; const PG8_LAS float* rowr;
    __device__ __forceinline__ void operator()(const f32x4 (&acc)[2][2][4][2], const Unit& u, int wr, int wc, int fr, int fq) const {
        const int row0 = u.pm * BM + wr * 64 + fr, col0 = u.pn * HALF + wc * 32 + 8 * fq;
#pragma unroll
        for (int ai = 0; ai < 2; ++ai)
#pragma unroll
            for (int m = 0; m < 4; ++m) { unsigned char* rowp = (unsigned char*)O + (size_t)(row0 + ai * HALF + m * 16) * 512 + col0;
                 const float rs = rowr[u.li * BM + wr * 64 + fr + ai * HALF + m * 16];
                float hv[8];
#pragma unroll
                for (int n = 0; n < 2; ++n)
#pragma unroll
                    for (int j = 0; j < 4; ++j) { const float g = acc[ai][0][m][n][j] * rs, up = acc[ai][1][m][n][j] * rs; hv[n * 4 + j] = g * up * __builtin_amdgcn_rcpf(1.f + __expf(-g)); }
                u32x2 w; w.x = pk4_fp8(hv[0], hv[1], hv[2], hv[3]); w.y = pk4_fp8(hv[4], hv[5], hv[6], hv[7]);
                *(u32x2*)rowp = w; }
    }
};
struct EpiDown {
    static constexpr bool PERM = true;
    bf16* Y; const int* rowtok; const float* roww;
    __device__ __forceinline__ void operator()(const f32x4 (&acc)[2][2][4][2], const Unit& u, int wr, int wc, int fr, int fq) const {
        const int row0 = u.pm * BM + wr * 64 + fr, col0 = u.pn * BM + wc * 32 + 8 * fq;
#pragma unroll
        for (int ai = 0; ai < 2; ++ai)
#pragma unroll
            for (int m = 0; m < 4; ++m) { const int pos = row0 + ai * HALF + m * 16; const int tk = rowtok[pos]; const float w = roww[pos];
                if (tk >= 0) { bf16* rowp = Y + ((size_t)(tk & 1) * 65536 + (size_t)(tk >> 1)) * 1024 + col0;
#pragma unroll
                    for (int bj = 0; bj < 2; ++bj) { const f32x4 v0 = acc[ai][bj][m][0] * w, v1 = acc[ai][bj][m][1] * w;
                        u32x4 o; o.x = cvt_pk_bf16(v0[0], v0[1]); o.y = cvt_pk_bf16(v0[2], v0[3]); o.z = cvt_pk_bf16(v1[0], v1[1]); o.w = cvt_pk_bf16(v1[2], v1[3]);
                        *(u32x4*)(rowp + bj * HALF) = o; } } }
    }
};

typedef int i32x4v __attribute__((ext_vector_type(4)));
typedef int i32x8v __attribute__((ext_vector_type(8)));
template <class Epi, class Sched, bool ALIGN_EPI = true, bool F8 = false>
__device__ __forceinline__ void gemm_phase(PG8_LAS unsigned char* lds, const int K, const Sched& S, const Epi& E) {
    int tid = threadIdx.x; asm volatile("" : "+v"(tid));
    const int wid = __builtin_amdgcn_readfirstlane(tid >> 6), lane = tid & 63, wr = wid >> 2, wc = wid & 3, fr = lane & 15, fq = lane >> 4;
    const int nt = K / BK;
    int Rr[2], Cc[2]; unsigned voffB[2];
#pragma unroll
    for (int i = 0; i < 2; ++i) { int R, C; stage_rc(tid * 16 + i * 8192, R, C); const int Rb = Epi::PERM ? ((R & ~31) + perm32(R & 31)) : R;
        Rr[i] = R; Cc[i] = C; voffB[i] = (unsigned)(Rb * K + C) * 2u; }
    const size_t kstep = (size_t)(BK * 2);
    const size_t hstep = (size_t)HALF * K * 2;
    const unsigned ldsw = (unsigned)wid * 1024u;
    const int aoff = lds_byte(wr * 64 + fr, fq * 8), boff = lds_byte(wc * 32 + fr, fq * 8);
#define PG8_SA(b, h) (((b) * 2 + (h)) * HTB)
#define PG8_SB(b, h) ((4 + (b) * 2 + (h)) * HTB)
#define PG8_STAGE(bufoff, gbase, voff) do { _Pragma("unroll") for (int _i = 0; _i < 2; ++_i) \
        __builtin_amdgcn_global_load_lds((const unsigned*)((const char*)(gbase) + (voff)[_i]), (PG8_LAS unsigned*)(lds + (bufoff) + ldsw + _i * 8192), 16, 0, 0); } while (0)
#define PG8_CAT(x0, x1) __builtin_shufflevector(__builtin_bit_cast(i32x4v, x0), __builtin_bit_cast(i32x4v, x1), 0, 1, 2, 3, 4, 5, 6, 7)
#define PG8_LDA(dst, b, h) do { if constexpr (F8) { _Pragma("unroll") for (int m = 0; m < 4; ++m) dst##8[m] = PG8_CAT(*(const PG8_LAS bf16x8*)(lds + PG8_SA(b, h) + aoff + m * 2048), *(const PG8_LAS bf16x8*)(lds + PG8_SA(b, h) + aoff + m * 2048 + 1024)); } \
        else { _Pragma("unroll") for (int m = 0; m < 4; ++m) _Pragma("unroll") for (int k = 0; k < 2; ++k) dst[m][k] = *(const PG8_LAS bf16x8*)(lds + PG8_SA(b, h) + aoff + m * 2048 + k * 1024); } } while (0)
#define PG8_LDB(dst, b, h) do { if constexpr (F8) { _Pragma("unroll") for (int n = 0; n < 2; ++n) dst##8[n] = PG8_CAT(*(const PG8_LAS bf16x8*)(lds + PG8_SB(b, h) + boff + n * 2048), *(const PG8_LAS bf16x8*)(lds + PG8_SB(b, h) + boff + n * 2048 + 1024)); } \
        else { _Pragma("unroll") for (int n = 0; n < 2; ++n) _Pragma("unroll") for (int k = 0; k < 2; ++k) dst[n][k] = *(const PG8_LAS bf16x8*)(lds + PG8_SB(b, h) + boff + n * 2048 + k * 1024); } } while (0)
#define PG8_MMA(ai, bj, At, Bt) do { __builtin_amdgcn_s_setprio(1); \
        if constexpr (F8) { __builtin_amdgcn_sched_barrier(0); _Pragma("unroll") for (int m = 0; m < 4; ++m) _Pragma("unroll") for (int n = 0; n < 2; ++n) \
            asm volatile("v_mfma_scale_f32_16x16x128_f8f6f4 %0, %1, %2, %0, %3, %3 op_sel_hi:[0,0,0]" : "+v"(acc[ai][bj][m][n]) : "v"(Bt##8[n]), "v"(At##8[m]), "v"(f8scale)); __builtin_amdgcn_sched_barrier(0); } \
        else { _Pragma("unroll") for (int m = 0; m < 4; ++m) _Pragma("unroll") for (int n = 0; n < 2; ++n) _Pragma("unroll") for (int k = 0; k < 2; ++k) \
            acc[ai][bj][m][n] = __builtin_amdgcn_mfma_f32_16x16x32_bf16(Bt[n][k], At[m][k], acc[ai][bj][m][n], 0, 0, 0); } \
        __builtin_amdgcn_s_setprio(0); } while (0)
#define PG8_WAIT_V(n) asm volatile("s_waitcnt vmcnt(" #n ")" ::: "memory")
#define PG8_WAIT_L(n) asm volatile("s_waitcnt lgkmcnt(" #n ")" ::: "memory")
#define PG8_BAR __builtin_amdgcn_s_barrier()
#define PG8_SCHED __builtin_amdgcn_sched_barrier(0)
    Unit cur, nxt; int ui = 0;
    if (!S.next(0, cur)) return;
    f32x4 acc[2][2][4][2];
#pragma unroll
    for (int a = 0; a < 2; ++a)
#pragma unroll
        for (int b = 0; b < 2; ++b)
#pragma unroll
            for (int m = 0; m < 4; ++m)
#pragma unroll
                for (int n = 0; n < 2; ++n) acc[a][b][m][n] = (f32x4){0.f, 0.f, 0.f, 0.f};
    bf16x8 At[4][2], B0[2][2], B1[2][2];
    i32x8v At8[4], B08[2], B18[2]; const int f8scale = 127;
    unsigned cv[2][2], nv[2][2];
    S.a_voff(cur, Rr, Cc, cv);
#pragma unroll
    for (int h = 0; h < 2; ++h)
#pragma unroll
        for (int i = 0; i < 2; ++i) nv[h][i] = cv[h][i];
    const char* cA = S.a_base(cur); const char* cB = S.b_base(cur);
    PG8_STAGE(PG8_SB(0, 0), cB, voffB); PG8_STAGE(PG8_SB(0, 1), cB + hstep, voffB); PG8_STAGE(PG8_SA(0, 0), cA, cv[0]); PG8_STAGE(PG8_SA(0, 1), cA, cv[1]);
    if (wr == 1) PG8_BAR;
    PG8_WAIT_V(2); PG8_BAR;
    PG8_STAGE(PG8_SB(1, 0), cB + kstep, voffB); PG8_STAGE(PG8_SA(1, 0), cA + kstep, cv[0]); PG8_STAGE(PG8_SB(1, 1), cB + hstep + kstep, voffB);
    PG8_WAIT_V(6); PG8_BAR;
    for (;;) {
        const bool has_next = S.next(ui + 1, nxt);
        const char* nA = has_next ? S.a_base(nxt) : cA; const char* nB = has_next ? S.b_base(nxt) : cB;
#pragma unroll 1
        for (int t = 0; t < nt; t += 2) {
            const bool last = (t == nt - 2);
            const char* a1 = cA + (size_t)(t + 1) * kstep;
            const char* a2 = last ? nA : cA + (size_t)(t + 2) * kstep; const char* b2 = last ? nB : cB + (size_t)(t + 2) * kstep;
            const char* a3 = a2 + kstep; const char* b3 = b2 + kstep;
            unsigned v2[2][2];
            if constexpr (Sched::GATHER) {
                if (last && has_next) { S.a_voff(nxt, Rr, Cc, nv); }
#pragma unroll
                for (int h = 0; h < 2; ++h)
#pragma unroll
                    for (int i = 0; i < 2; ++i) v2[h][i] = last ? nv[h][i] : cv[h][i];
            } else {
#pragma unroll
                for (int h = 0; h < 2; ++h)
#pragma unroll
                    for (int i = 0; i < 2; ++i) v2[h][i] = cv[h][i];
            }
            PG8_LDB(B0, 0, 0); PG8_LDB(B1, 0, 1); PG8_SCHED; PG8_LDA(At, 0, 0); PG8_STAGE(PG8_SA(1, 1), a1, cv[1]);
            PG8_WAIT_V(8); PG8_WAIT_L(0); PG8_BAR; PG8_MMA(0, 0, At, B0); PG8_MMA(0, 1, At, B1); PG8_BAR; PG8_SCHED;
            PG8_LDA(At, 0, 1); PG8_STAGE(PG8_SB(0, 0), b2, voffB); PG8_STAGE(PG8_SB(0, 1), b2 + hstep, voffB); PG8_STAGE(PG8_SA(0, 0), a2, v2[0]);
            PG8_WAIT_V(8); PG8_WAIT_L(0); PG8_BAR; PG8_MMA(1, 0, At, B0); PG8_MMA(1, 1, At, B1); PG8_BAR; PG8_SCHED;
            PG8_LDB(B0, 1, 0); PG8_LDB(B1, 1, 1); PG8_SCHED; PG8_LDA(At, 1, 0); PG8_STAGE(PG8_SA(0, 1), a2, v2[1]);
            PG8_WAIT_V(8); PG8_WAIT_L(0); PG8_BAR; PG8_MMA(0, 0, At, B0); PG8_MMA(0, 1, At, B1); PG8_BAR; PG8_SCHED;
            PG8_LDA(At, 1, 1); PG8_STAGE(PG8_SB(1, 0), b3, voffB); PG8_STAGE(PG8_SB(1, 1), b3 + hstep, voffB); PG8_STAGE(PG8_SA(1, 0), a3, v2[0]);
            PG8_WAIT_V(8); PG8_WAIT_L(0); PG8_BAR; PG8_MMA(1, 0, At, B0); PG8_MMA(1, 1, At, B1); PG8_BAR; PG8_SCHED;
        }
        if constexpr (ALIGN_EPI) { if (wr == 0) PG8_BAR; }
        if constexpr (F8) { asm volatile("s_nop 15\n\ts_nop 15" ::: "memory"); }
        E(acc, cur, wr, wc, fr, fq);
        if (!has_next) break;
#pragma unroll
        for (int a = 0; a < 2; ++a)
#pragma unroll
            for (int b = 0; b < 2; ++b)
#pragma unroll
                for (int m = 0; m < 4; ++m)
#pragma unroll
                    for (int n = 0; n < 2; ++n) acc[a][b][m][n] = (f32x4){0.f, 0.f, 0.f, 0.f};
        cur = nxt; cA = nA; cB = nB; ++ui;
#pragma unroll
        for (int h = 0; h < 2; ++h)
#pragma unroll
            for (int i = 0; i < 2; ++i) cv[h][i] = nv[h][i];
        if constexpr (ALIGN_EPI) { if (wr == 1) PG8_BAR; }
    }
    PG8_WAIT_V(0);
    if constexpr (!ALIGN_EPI) { if (wr == 0) PG8_BAR; }
    PG8_BAR;
#undef PG8_SA
#undef PG8_SB
#undef PG8_STAGE
#undef PG8_LDA
#undef PG8_LDB
#undef PG8_MMA
#undef PG8_CAT
#undef PG8_WAIT_V
#undef PG8_WAIT_L
#undef PG8_BAR
#undef PG8_SCHED
}
}

#define XB_TMO      128
#define XB_XCNT(j)  (256  + 64 * (j))
#define XB_XSUB(j)  (1280 + 64 * (j))
#define XB_XGEN(j)  (2304 + 64 * (j))
#define XB_TOP      3328
#define XB_TOPGEN   3392
#define XCD_BAR_WORDS 3456
#define XB_SPIN_CAP (1u << 22)

__device__ __forceinline__ unsigned xb_ld(unsigned* p)              { return __hip_atomic_load(p, __ATOMIC_RELAXED, __HIP_MEMORY_SCOPE_AGENT); }
__device__ __forceinline__ unsigned xb_add(unsigned* p, unsigned v) { return __hip_atomic_fetch_add(p, v, __ATOMIC_RELAXED, __HIP_MEMORY_SCOPE_AGENT); }
__device__ __forceinline__ unsigned xb_xcc_id() { return (unsigned)__builtin_amdgcn_s_getreg((3 << 11) | 20) & 0xFu; }
#define XB_SPIN(cond, bar) do { unsigned _sp = 0; while (cond) { __builtin_amdgcn_s_sleep(1); \
    if ((++_sp & 255u) == 0u) { if (xb_ld(&(bar)[XB_TMO])) break; if (_sp > XB_SPIN_CAP) { atomicAdd(&(bar)[XB_TMO], 1u); break; } } } } while (0)

struct XcdBarrier { unsigned* bar; unsigned x; volatile LAS unsigned* st; };

__device__ __forceinline__ XcdBarrier xcd_barrier_post(unsigned* bar, volatile LAS unsigned* st) {
    XcdBarrier b; b.bar = bar; b.x = xb_xcc_id(); b.st = st;
    if (threadIdx.x == 0) (void)xb_add(&bar[XB_XCNT(b.x)], 1u);
    return b;
}
__device__ __forceinline__ void xcd_barrier_complete(unsigned* bar, unsigned x, unsigned& nloc, unsigned& nx) {
    const unsigned G = gridDim.x * gridDim.y * gridDim.z;
    unsigned sum, cnt, mine, sp = 0u;
    for (;;) {
        sum = 0u; cnt = 0u; mine = 0u;
#pragma unroll
        for (unsigned j = 0; j < 16; ++j) { const unsigned c = xb_ld(&bar[XB_XCNT(j)]); sum += c; cnt += (c > 0u) ? 1u : 0u; mine = (j == x) ? c : mine; }
        if (sum == G) break;
        __builtin_amdgcn_s_sleep(1);
        if ((++sp & 255u) == 0u) { if (xb_ld(&bar[XB_TMO])) break; if (sp > XB_SPIN_CAP) { atomicAdd(&bar[XB_TMO], 1u); break; } }
    }
    nloc = mine > 0u ? mine : 1u; nx = cnt > 0u ? cnt : 1u;
}
__device__ __forceinline__ void xcd_barrier(const XcdBarrier& b) {
    asm volatile("s_waitcnt vmcnt(0)" ::: "memory");
    __syncthreads();
    if (threadIdx.x == 0) {
        unsigned* bar = b.bar;
        __builtin_amdgcn_s_waitcnt(0);
        unsigned nloc = b.st[0], nx = b.st[1];
        if (nloc == 0u) { xcd_barrier_complete(bar, b.x, nloc, nx); b.st[0] = nloc; b.st[1] = nx; }
        const unsigned old = xb_add(&bar[XB_XSUB(b.x)], 1u);
        const unsigned gen = old / nloc;
        if (old + 1u == (gen + 1u) * nloc) {
            __builtin_amdgcn_fence(__ATOMIC_RELEASE, "agent");
            asm volatile("s_waitcnt vmcnt(0)" ::: "memory");
            const unsigned og = xb_add(&bar[XB_TOP], 1u);
            const unsigned tg = og / nx;
            if (og + 1u == (tg + 1u) * nx) xb_add(&bar[XB_TOPGEN], 1u);
            else XB_SPIN(xb_ld(&bar[XB_TOPGEN]) == tg, bar);
            __builtin_amdgcn_fence(__ATOMIC_ACQUIRE, "agent");
            xb_add(&bar[XB_XGEN(b.x)], 1u);
            asm volatile("s_waitcnt vmcnt(0)" ::: "memory");
        } else {
            XB_SPIN(xb_ld(&bar[XB_XGEN(b.x)]) == gen, bar);
            __builtin_amdgcn_fence(__ATOMIC_ACQUIRE, "agent");
            asm volatile("s_waitcnt vmcnt(0)" ::: "memory");
        }
    }
    __syncthreads();
}

struct Args {
    const float* in[24];
    float* out;
    unsigned char* ws;
    int ph_lo, ph_hi;
};

struct TrItem { const float* src; int ldsrc, k0, n0s; bf16* dst; int ldd, drow0; const float* kscale; int f8; };
__device__ __forceinline__ void tr_load(const TrItem& t, f32x4 (&v)[8], int lane) {
#pragma unroll
    for (int i = 0; i < 8; ++i) v[i] = *(const f32x4*)(t.src + (size_t)(t.k0 + (lane >> 3) + 8 * i) * t.ldsrc + t.n0s + 4 * (lane & 7));
}
__device__ __forceinline__ void tr_finish(const TrItem& t, const f32x4 (&v)[8], LAS float* scr, int lane) {
#pragma unroll
    for (int i = 0; i < 8; ++i) { const int kk = (lane >> 3) + 8 * i; f32x4 x = v[i]; if (t.kscale) x = x * t.kscale[t.k0 + kk];
        LAS float* d = scr + kk * 33 + 4 * (lane & 7); d[0] = x.x; d[1] = x.y; d[2] = x.z; d[3] = x.w; }
    LDS_WAIT();
    const int c = lane & 7;
#pragma unroll
    for (int j = 0; j < 4; ++j) { const int n = (lane >> 3) + 8 * j; const LAS float* s = scr + (8 * c) * 33 + n;
        if (t.f8) { u32x2 o; o.x = pk4_fp8(s[0 * 33], s[1 * 33], s[2 * 33], s[3 * 33]); o.y = pk4_fp8(s[4 * 33], s[5 * 33], s[6 * 33], s[7 * 33]);
            *(u32x2*)((unsigned char*)t.dst + (size_t)(t.drow0 + n) * t.ldd + t.k0 + 8 * c) = o; }
        else { u32x4 o; o.x = pk2(s[0 * 33], s[1 * 33]); o.y = pk2(s[2 * 33], s[3 * 33]); o.z = pk2(s[4 * 33], s[5 * 33]); o.w = pk2(s[6 * 33], s[7 * 33]);
            *(u32x4*)(t.dst + (size_t)(t.drow0 + n) * t.ldd + t.k0 + 8 * c) = o; } }
    LDS_WAIT();
}

__device__ __forceinline__ void p0_prologue(const Args& a, LAS unsigned char* lds, int tid, int lane, int wave, int wg, int G) {
    unsigned char* ws = a.ws;
    const float* x = a.in[0]; const float* norm1_w = a.in[1]; const float* w_in = a.in[2]; const float* b_ig = a.in[3]; const float* b_fg = a.in[4];
    const float* w_out = a.in[15]; const float* w_gate = a.in[21]; const float* w_up = a.in[22]; const float* w_down = a.in[23];
    bf16* W1T = (bf16*)(ws + WS_W1T); bf16* W2T = (bf16*)(ws + WS_W2T); bf16* WGU = (bf16*)(ws + WS_WGU); bf16* WD = (bf16*)(ws + WS_WD);
    bf16* H1 = (bf16*)(ws + WS_H1); float* GATES = (float*)(ws + WS_GATES);
    LAS float* scr = (LAS float*)(lds + wave * 8448);
    LAS float* gwl = (LAS float*)(lds + 73728);
    {
        float gv[16];
#pragma unroll
        for (int q = 0; q < 16; ++q) { const int idx = tid + NTHR * q; gv[q] = w_in[(size_t)(idx >> 3) * INCOLS + 2048 + (idx & 7)]; }
#pragma unroll
        for (int q = 0; q < 16; ++q) gwl[tid + NTHR * q] = gv[q];
    }
    {
        const float* norm2_w = a.in[16]; const float* w_group = a.in[17]; const float* w_expert = a.in[19]; unsigned char* RIMG = ws + WS_RIMG;
        const int idx = wg * NTHR + tid;
        if (idx < 36864) { int k, c; float v;
            if (idx < 4096) { k = idx >> 2; c = idx & 3; v = w_group[idx]; } else { const int j = idx - 4096; k = j >> 5; c = 4 + (j & 31); v = w_expert[j]; }
            v *= norm2_w[k];
            const unsigned hi = f2bf(v), lo = f2bf(v - __uint_as_float(hi << 16));
            *(bf16*)(RIMG + c * 2064 + k * 2) = (bf16)hi; *(bf16*)(RIMG + 36 * 2064 + c * 2064 + k * 2) = (bf16)lo; }
    }
    __syncthreads();
    const int gw = wg * NWAVES + wave, NGW = G * NWAVES;
    constexpr int I_1 = 16 * 112, I_2 = 16 * 32, I_GU = NEXP * 16 * 32, NITEMS = I_1 + I_2 + I_GU;
    auto item_desc = [&](int it) -> TrItem {
        int r = it;
        if (r < I_1) { const int kb = r / 112, nb = r % 112, n0 = nb * 32; int sc_ = n0;
            if (n0 >= 2048 && n0 < 3072) { const int p0 = n0 & 255; sc_ = (n0 & ~255) + 64 * ((p0 >> 5) & 3) + 32 * (p0 >> 7); }
            return TrItem{w_in, INCOLS, kb * 64, sc_ < 2048 ? sc_ : sc_ + 8, W1T, 1024, n0, norm1_w, 0}; } r -= I_1;
        if (r < I_2) { const int kb = r / 32, nb = r % 32; return TrItem{w_out, 1024, kb * 64, nb * 32, W2T, 1024, nb * 32, nullptr, 0}; } r -= I_2;
        { const int e = r / 512, q = r % 512, kb = q / 32, nb = q % 32, j0 = nb * 32, pn = j0 >> 8, rr = j0 & 255;
            const float* s_ = (rr < 128 ? w_gate : w_up) + (size_t)e * 1024 * 512;
            return TrItem{s_, 512, kb * 64, pn * 128 + (rr & 127), (bf16*)((unsigned char*)WGU + (size_t)e * 1024 * 1024), 1024, j0, a.in[16], 1}; }
    };
    if (gw < NITEMS) {
        TrItem cur = item_desc(gw); f32x4 tv[8]; tr_load(cur, tv, lane);
#pragma unroll 1
        for (int it = gw; it < NITEMS; it += NGW) {
            f32x4 cv_[8];
#pragma unroll
            for (int i = 0; i < 8; ++i) cv_[i] = tv[i];
            const TrItem me = cur;
            if (it + NGW < NITEMS) { cur = item_desc(it + NGW); tr_load(cur, tv, lane); }
            tr_finish(me, cv_, scr, lane);
        }
    }
    f32x4 w1v[4];
#pragma unroll
    for (int j = 0; j < 4; ++j) w1v[j] = ((const f32x4*)norm1_w)[lane + 64 * j];
    f32x4 nx[4], nx2[4];
#pragma unroll
    for (int j = 0; j < 4; ++j) { nx[j] = ((const f32x4*)(x + (size_t)gw * DM))[lane + 64 * j]; nx2[j] = ((const f32x4*)(x + (size_t)(gw + NGW) * DM))[lane + 64 * j]; }
    const int gc = ((lane >> 5) & 1) * 4 + ((lane >> 4) & 1) * 2 + ((lane >> 3) & 1), gh = gc & 3;
    const float gbias = (gc < 4) ? b_ig[gh] : b_fg[gh];
#pragma unroll 1
    for (int m = gw; m < T_; m += NGW) {
        f32x4 v[4]; float ss = 0.f;
#pragma unroll
        for (int j = 0; j < 4; ++j) { v[j] = nx[j]; nx[j] = nx2[j]; ss += (v[j].x * v[j].x + v[j].y * v[j].y) + (v[j].z * v[j].z + v[j].w * v[j].w); }
        if (m + 2 * NGW < T_) {
#pragma unroll
            for (int j = 0; j < 4; ++j) nx2[j] = ((const f32x4*)(x + (size_t)(m + 2 * NGW) * DM))[lane + 64 * j]; }
        const float r = rsqrtf(wave_sum(ss) * (1.f / DM) + EPS);
        if (lane == 0) ((float*)(ws + WS_R1))[m] = r;
        float g[8];
#pragma unroll
        for (int c = 0; c < 8; ++c) g[c] = 0.f;
        u32x2* o8 = (u32x2*)(H1 + (size_t)m * DM) + lane;
#pragma unroll
        for (int j = 0; j < 4; ++j) {
            const f32x4 hv = v[j] * r * w1v[j];
            u32x2 o; o.x = pk2(v[j].x, v[j].y); o.y = pk2(v[j].z, v[j].w); o8[64 * j] = o;
#pragma unroll
            for (int i = 0; i < 4; ++i) { const int k = 256 * j + 4 * lane + i; const f32x4 ga = *(const LAS f32x4*)(gwl + k * 8), gb = *(const LAS f32x4*)(gwl + k * 8 + 4);
                const float hh = hv[i];
                g[0] += hh * ga.x; g[1] += hh * ga.y; g[2] += hh * ga.z; g[3] += hh * ga.w; g[4] += hh * gb.x; g[5] += hh * gb.y; g[6] += hh * gb.z; g[7] += hh * gb.w; }
        }
        float k4[4], k2[2], k1;
        { const bool up = (lane & 32) != 0;
#pragma unroll
          for (int i = 0; i < 4; ++i) { const float send = up ? g[i] : g[i + 4]; const float recv = __shfl_xor(send, 32); k4[i] = (up ? g[i + 4] : g[i]) + recv; } }
        { const bool up = (lane & 16) != 0;
#pragma unroll
          for (int i = 0; i < 2; ++i) { const float send = up ? k4[i] : k4[i + 2]; const float recv = __shfl_xor(send, 16); k2[i] = (up ? k4[i + 2] : k4[i]) + recv; } }
        { const bool up = (lane & 8) != 0; const float send = up ? k2[0] : k2[1]; const float recv = __shfl_xor(send, 8); k1 = (up ? k2[1] : k2[0]) + recv; }
        k1 += __shfl_xor(k1, 4); k1 += __shfl_xor(k1, 2); k1 += __shfl_xor(k1, 1);
        if ((lane & 7) == 0) {
            float res = k1 + gbias;
            if (gc >= 4) res = fminf(res, 0.f) - log1pf(__expf(-fabsf(res)));
            GATES[(size_t)m * 8 + gc] = res;
        }
    }
}

__device__ __forceinline__ void p1_stagger_work(const Args& a, LAS unsigned char* lds, int lane, int wave, int wg) {
    const int g = wg & 3; if (g == 0) return;
    const float* w_down = a.in[23]; bf16* WD = (bf16*)(a.ws + WS_WD);
    constexpr int NIT = NEXP * 8 * 32;
    const int lo = (g == 1) ? 0 : (g == 2) ? NIT / 6 : NIT / 2, hi = (g == 1) ? NIT / 6 : (g == 2) ? NIT / 2 : NIT;
    LAS float* scr = (LAS float*)(lds + wave * 8448);
    const int gw = (wg >> 2) * NWAVES + wave, NGW = 64 * NWAVES;
    auto desc = [&](int r) -> TrItem { const int e = r / 256, q = r % 256, kb = q / 32, nb = q % 32;
        return TrItem{w_down + (size_t)e * 512 * 1024, 1024, kb * 64, nb * 32, (bf16*)((unsigned char*)WD + (size_t)e * 1024 * 512), 512, nb * 32, nullptr, 1}; };
    if (lo + gw < hi) {
        TrItem cur = desc(lo + gw); f32x4 tv[8]; tr_load(cur, tv, lane);
#pragma unroll 1
        for (int it = lo + gw; it < hi; it += NGW) {
            f32x4 cv_[8];
#pragma unroll
            for (int i = 0; i < 8; ++i) cv_[i] = tv[i];
            const TrItem me = cur;
            if (it + NGW < hi) { cur = desc(it + NGW); tr_load(cur, tv, lane); }
            tr_finish(me, cv_, scr, lane);
        }
    }
}

__device__ __forceinline__ void mlstm_naive(const Args& a, LAS unsigned char* lds, int item, int tid, int lane, int wave) {
    unsigned char* ws = a.ws;
    const bf16* PROJ = (const bf16*)(ws + WS_PROJ); const float* GATES = (const float*)(ws + WS_GATES); bf16* MIX = (bf16*)(ws + WS_MIX);
    const float* conv_w = a.in[5]; const float* conv_b = a.in[6]; const float* m_norm_w = a.in[7];
    LAS float* qs = (LAS float*)lds; LAS float* ks = qs + 8192; LAS float* vs = ks + 8192; LAS float* hb = vs + 8192;
    LAS float* red = hb + 8192; LAS float* dred = red + 1024; LAS float* igs = dred + 16; LAS float* lfs = igs + 64;
    const int b = item >> 2, h = item & 3, e = tid & 127, dq = tid >> 7;
    float Cr[32], nr[32];
#pragma unroll
    for (int j = 0; j < 32; ++j) { Cr[j] = 0.f; nr[j] = 0.f; }
    float m = 0.f;
    const float mw0 = m_norm_w[lane], mw1 = m_norm_w[lane + 64];
    for (int c = 0; c < SEQ / 64; ++c) {
        const int t0 = c * 64;
        for (int idx = tid; idx < 8192; idx += NTHR) {
            const int tt = idx >> 7, d = idx & 127, t = t0 + tt, colq = C_MQ + h * 128 + d, colk = C_MK + h * 128 + d;
            float aq = conv_b[colq], ak = conv_b[colk];
#pragma unroll
            for (int j = 0; j < 4; ++j) { const int ts = t - 3 + j; if (ts >= 0) { const bf16* row = PROJ + (size_t)(b * SEQ + ts) * NCOL; aq += bf2f(row[colq]) * conv_w[j * 1024 + colq]; ak += bf2f(row[colk]) * conv_w[j * 1024 + colk]; } }
            qs[idx] = siluf_(aq); ks[idx] = siluf_(ak) * 0.08838834764831845f;
            vs[idx] = bf2f(PROJ[(size_t)(b * SEQ + t) * NCOL + C_MV + h * 128 + d]);
        }
        if (tid < 64) { igs[tid] = GATES[(size_t)(b * SEQ + t0 + tid) * 8 + h]; lfs[tid] = GATES[(size_t)(b * SEQ + t0 + tid) * 8 + 4 + h]; }
        __syncthreads();
        for (int tt = 0; tt < 64; ++tt) {
            const float lf = lfs[tt], ig = igs[tt];
            const float mnew = fmaxf(lf + m, ig), fd = __expf(lf + m - mnew), iw = __expf(ig - mnew); m = mnew;
            const float ve = vs[tt * 128 + e] * iw;
            float num = 0.f, den = 0.f;
#pragma unroll
            for (int j = 0; j < 32; ++j) { const int d = dq * 32 + j; const float kd = ks[tt * 128 + d], qd = qs[tt * 128 + d];
                Cr[j] = fd * Cr[j] + kd * ve; nr[j] = fd * nr[j] + iw * kd; num += qd * Cr[j]; den += qd * nr[j]; }
            const int p = tt & 1;
            red[(p * 4 + dq) * 128 + e] = num; if (e == 0) dred[p * 4 + dq] = den;
            __syncthreads();
            if (dq == 0) { const float ntot = (red[(p * 4 + 0) * 128 + e] + red[(p * 4 + 1) * 128 + e]) + (red[(p * 4 + 2) * 128 + e] + red[(p * 4 + 3) * 128 + e]);
                const float dtot = (dred[p * 4 + 0] + dred[p * 4 + 1]) + (dred[p * 4 + 2] + dred[p * 4 + 3]);
                hb[tt * 128 + e] = ntot / fmaxf(fabsf(dtot), __expf(-mnew)); }
        }
        __syncthreads();
#pragma unroll 1
        for (int rr = 0; rr < 8; ++rr) {
            const int tt = wave * 8 + rr, t = t0 + tt; const bf16* rowp = PROJ + (size_t)(b * SEQ + t) * NCOL + C_MO + h * 128;
            const float y0 = hb[tt * 128 + lane] * sigmoidf_(bf2f(rowp[lane])), y1 = hb[tt * 128 + lane + 64] * sigmoidf_(bf2f(rowp[lane + 64]));
            const float r = rsqrtf(wave_sum(y0 * y0 + y1 * y1) * (1.f / 128.f) + EPS);
            bf16* orow = MIX + (size_t)(b * SEQ + t) * DM + h * 128;
            orow[lane] = (bf16)f2bf(y0 * r * mw0); orow[lane + 64] = (bf16)f2bf(y1 * r * mw1);
        }
        __syncthreads();
    }
}

__device__ __forceinline__ void attn_naive_row(const Args& a, LAS float* sc, LAS float* qsl, int ridx, int lane, float lam) {
    unsigned char* ws = a.ws;
    const bf16* PROJ = (const bf16*)(ws + WS_PROJ); bf16* MIX = (bf16*)(ws + WS_MIX);
    const float* qnw = a.in[8]; const float* knw = a.in[9]; const float* anw = a.in[14];
    const int h = ridx & 3, bt = ridx >> 2, t = bt & (SEQ - 1), b = bt >> 11;
    {
        const unsigned u = *(const unsigned*)(PROJ + (size_t)bt * NCOL + C_AQ + h * 128 + 2 * lane);
        const float q0 = bflo(u), q1 = bfhi(u); float ss = q0 * q0 + q1 * q1;
#pragma unroll
        for (int o = 1; o < 32; o <<= 1) ss += __shfl_xor(ss, o);
        const float rq = rsqrtf(ss * (1.f / 64.f) + EPS) * 0.125f; const int dd = (2 * lane) & 63;
        qsl[2 * lane] = q0 * rq * qnw[dd] * knw[dd]; qsl[2 * lane + 1] = q1 * rq * qnw[dd + 1] * knw[dd + 1];
    }
    LDS_WAIT();
    const int nk = ((t >> 6) + 1) * 64;
    float m0 = -1e30f, m1 = -1e30f;
    for (int j = lane; j < nk; j += 64) {
        const u32x4* krow = (const u32x4*)(PROJ + (size_t)(b * SEQ + j) * NCOL + C_AK + h * 128);
        float s0 = 0.f, ss0 = 0.f, s1 = 0.f, ss1 = 0.f;
#pragma unroll
        for (int q = 0; q < 8; ++q) { const u32x4 kv = krow[q]; const f32x4 qa = *(const LAS f32x4*)(qsl + q * 8), qb = *(const LAS f32x4*)(qsl + q * 8 + 4);
            const float k0 = bflo(kv.x), k1 = bfhi(kv.x), k2 = bflo(kv.y), k3 = bfhi(kv.y), k4 = bflo(kv.z), k5 = bfhi(kv.z), k6 = bflo(kv.w), k7 = bfhi(kv.w);
            s0 += qa.x * k0 + qa.y * k1 + qa.z * k2 + qa.w * k3 + qb.x * k4 + qb.y * k5 + qb.z * k6 + qb.w * k7;
            ss0 += k0 * k0 + k1 * k1 + k2 * k2 + k3 * k3 + k4 * k4 + k5 * k5 + k6 * k6 + k7 * k7; }
#pragma unroll
        for (int q = 8; q < 16; ++q) { const u32x4 kv = krow[q]; const f32x4 qa = *(const LAS f32x4*)(qsl + q * 8), qb = *(const LAS f32x4*)(qsl + q * 8 + 4);
            const float k0 = bflo(kv.x), k1 = bfhi(kv.x), k2 = bflo(kv.y), k3 = bfhi(kv.y), k4 = bflo(kv.z), k5 = bfhi(kv.z), k6 = bflo(kv.w), k7 = bfhi(kv.w);
            s1 += qa.x * k0 + qa.y * k1 + qa.z * k2 + qa.w * k3 + qb.x * k4 + qb.y * k5 + qb.z * k6 + qb.w * k7;
            ss1 += k0 * k0 + k1 * k1 + k2 * k2 + k3 * k3 + k4 * k4 + k5 * k5 + k6 * k6 + k7 * k7; }
        s0 *= rsqrtf(ss0 * (1.f / 64.f) + EPS); s1 *= rsqrtf(ss1 * (1.f / 64.f) + EPS);
        sc[j] = s0; sc[2048 + j] = s1; m0 = fmaxf(m0, s0); m1 = fmaxf(m1, s1);
    }
    m0 = wave_max(m0); m1 = wave_max(m1);
    float l0 = 0.f, l1 = 0.f;
    for (int j = lane; j < nk; j += 64) { const float e0 = __expf(sc[j] - m0), e1 = __expf(sc[2048 + j] - m1); sc[j] = e0; sc[2048 + j] = e1; l0 += e0; l1 += e1; }
    l0 = wave_sum(l0); l1 = wave_sum(l1);
    const float c0 = 1.f / l0, c1 = lam / l1;
    LDS_WAIT();
    float o0 = 0.f, o1 = 0.f;
    const bf16* vb = PROJ + (size_t)(b * SEQ) * NCOL + C_AV + h * 128 + 2 * lane;
    for (int j = 0; j < nk; ++j) { const float p = sc[j] * c0 - sc[2048 + j] * c1; const unsigned u = *(const unsigned*)(vb + (size_t)j * NCOL); o0 += p * bflo(u); o1 += p * bfhi(u); }
    const float r = rsqrtf(wave_sum(o0 * o0 + o1 * o1) * (1.f / 128.f) + EPS) * (1.f - LAMBDA_INIT);
    *(unsigned*)(MIX + (size_t)bt * DM + 512 + h * 128 + 2 * lane) = pk2(o0 * r * anw[2 * lane], o1 * r * anw[2 * lane + 1]);
    LDS_WAIT();
}

__device__ __forceinline__ void p2_naive(const Args& a, LAS unsigned char* lds, int tid, int lane, int wave, int wg, int G) {
    if (wg < NBATCH * 4) mlstm_naive(a, lds, wg, tid, lane, wave);
    __syncthreads();
    const float* lq1 = a.in[10]; const float* lk1 = a.in[11]; const float* lq2 = a.in[12]; const float* lk2 = a.in[13];
    const float lam = __expf(wave_sum(lq1[lane] * lk1[lane])) - __expf(wave_sum(lq2[lane] * lk2[lane])) + LAMBDA_INIT;
    LAS float* sc = (LAS float*)(lds + wave * 16896); LAS float* qsl = sc + 4096;
    unsigned* queue = (unsigned*)(a.ws + WS_CTL) + CW_QUEUE;
    constexpr int NUNITS = T_ * 4 / 8;
    for (;;) {
        unsigned u = 0; if (lane == 0) u = __hip_atomic_fetch_add(queue, 1u, __ATOMIC_RELAXED, __HIP_MEMORY_SCOPE_AGENT);
        u = (unsigned)__builtin_amdgcn_readfirstlane((int)u);
        if (u >= (unsigned)NUNITS) break;
        const int base = (NUNITS - 1 - (int)u) * 8;
        for (int k = 0; k < 8; ++k) attn_naive_row(a, sc, qsl, base + k, lane, lam);
    }
}


namespace ml {
constexpr int QL = 0, KL = 17408, KWT = 34816, VT = 53248, SD = 71680, AV = 80896, MV = 89088, WV = 97280, IT = 105472, FL = 113664;
constexpr int MC = 121856, BEND = 121984, AMAX = 122112, DEC = 122240, NL = 122368, RS = 122880, QN = 123392, PSQ = 123648;
constexpr int QS = 272, TS = 144;
constexpr float L2E = 1.4426950408889634f;
#define LBAR() do { asm volatile("s_waitcnt lgkmcnt(0)" ::: "memory"); __builtin_amdgcn_s_barrier(); asm volatile("" ::: "memory"); } while (0)
__device__ __forceinline__ f32x4 mfma16(bf16x8 a, bf16x8 b, f32x4 c) { return __builtin_amdgcn_mfma_f32_16x16x32_bf16(a, b, c, 0, 0, 0); }
__device__ __forceinline__ unsigned cvtpk(float lo, float hi) { unsigned r; asm volatile("v_cvt_pk_bf16_f32 %0, %1, %2" : "=v"(r) : "v"(lo), "v"(hi)); return r; }
__device__ __forceinline__ unsigned cvtpk_nv(float lo, float hi) { unsigned r; asm("v_cvt_pk_bf16_f32 %0, %1, %2" : "=v"(r) : "v"(lo), "v"(hi)); return r; }
__device__ __forceinline__ f32x2 silu2(f32x2 o) { f32x2 e = o * (-L2E); e.x = __builtin_amdgcn_exp2f(e.x); e.y = __builtin_amdgcn_exp2f(e.y); e = e + 1.0f; e.x = __builtin_amdgcn_rcpf(e.x); e.y = __builtin_amdgcn_rcpf(e.y); return o * e; }

__device__ __forceinline__ void mlstm_item(const Args& a, LAS unsigned char* lds, const int item, const int tid) {
    unsigned char* ws = a.ws;
    const bf16* PROJ = (const bf16*)(ws + WS_PROJ); const float* GATES = (const float*)(ws + WS_GATES); bf16* MIX = (bf16*)(ws + WS_MIX);
    const float* conv_w = a.in[5]; const float* conv_b = a.in[6]; const float* m_norm_w = a.in[7];
    const int wid = __builtin_amdgcn_readfirstlane(tid >> 6), lane = tid & 63, fr = lane & 15, fq = lane >> 4;
    const int b = item >> 2, h = item & 3, e0 = 16 * wid;
    LAS float* AVl = (LAS float*)(lds + AV); LAS float* MVl = (LAS float*)(lds + MV); LAS float* WVl = (LAS float*)(lds + WV); LAS float* ITl = (LAS float*)(lds + IT); LAS float* FLl = (LAS float*)(lds + FL);
    LAS float* MCl = (LAS float*)(lds + MC); LAS float* BENDl = (LAS float*)(lds + BEND); LAS float* AMAXl = (LAS float*)(lds + AMAX); LAS float* DECl = (LAS float*)(lds + DEC);
    LAS float* NLl = (LAS float*)(lds + NL); LAS float* RSl = (LAS float*)(lds + RS); LAS float* QNl = (LAS float*)(lds + QN); LAS float* PSQl = (LAS float*)(lds + PSQ);
#pragma unroll 1
    for (int cc = 0; cc < 4; ++cc) {
        const int c = 4 * wid + cc, t = 64 * c + lane; const float* g = GATES + (size_t)(b * SEQ + t) * 8;
        float bs = g[4 + h]; const float ig = g[h];
#pragma unroll
        for (int o = 1; o < 64; o <<= 1) { const float v = __shfl_up(bs, o); if (lane >= o) bs += v; }
        const float av = ig - bs; float pm = av;
#pragma unroll
        for (int o = 1; o < 64; o <<= 1) { const float v = __shfl_up(pm, o); if (lane >= o) pm = fmaxf(pm, v); }
        AVl[t] = av; MVl[t] = pm; FLl[t] = bs;
        if (lane == 63) { BENDl[c] = bs; AMAXl[c] = pm; }
    }
    if (tid < 128) NLl[tid] = 0.f;
    __syncthreads();
    if (tid == 0) { float m = 0.f; for (int c = 0; c < 32; ++c) { MCl[c] = m; m = BENDl[c] + fmaxf(m, AMAXl[c]); } }
    __syncthreads();
    {
        float av_[4], pm_[4], bs_[4], m63_[4], mc_[4];
#pragma unroll
        for (int k = 0; k < 4; ++k) { const int t = tid + NTHR * k, c = t >> 6; av_[k] = AVl[t]; pm_[k] = MVl[t]; bs_[k] = FLl[t]; mc_[k] = MCl[c]; m63_[k] = fmaxf(mc_[k], MVl[64 * c + 63]); }
        __syncthreads();
#pragma unroll
        for (int k = 0; k < 4; ++k) { const int t = tid + NTHR * k; const float M = fmaxf(mc_[k], pm_[k]);
            AVl[t] = av_[k] * L2E; MVl[t] = M * L2E; WVl[t] = __expf(av_[k] - m63_[k]); ITl[t] = __expf(mc_[k] - M); FLl[t] = __expf(-(bs_[k] + M)); }
        if (tid < 32) DECl[tid] = __expf(MCl[tid] - fmaxf(MCl[tid], AMAXl[tid]));
    }
    __syncthreads();
    const int isk = wid >> 2, r0 = (wid & 3) * 16;
    const int ccol = (isk ? C_MK : C_MQ) + h * 128 + 2 * lane;
    f32x2 cw2[4], cb2;
#pragma unroll
    for (int j = 0; j < 4; ++j) { cw2[j].x = conv_w[j * 1024 + ccol]; cw2[j].y = conv_w[j * 1024 + ccol + 1]; }
    cb2.x = conv_b[ccol]; cb2.y = conv_b[ccol + 1];
    const bf16* qkbase = PROJ + (size_t)(b * SEQ) * NCOL + ccol;
    const bf16* vbase = PROJ + (size_t)(b * SEQ) * NCOL + C_MV + h * 128 + 2 * lane;
    const bf16* obase = PROJ + (size_t)(b * SEQ) * NCOL + C_MO + h * 128 + e0 + 4 * fq;
    const f32x4 mw = *(const f32x4*)(m_norm_w + e0 + 4 * fq);
    unsigned raw[19], vraw[8];
#define ML_LOADS(c_) do { _Pragma("unroll") for (int i = 0; i < 19; ++i) { const int t = 64 * (c_) + r0 - 3 + i; raw[i] = (t >= 0) ? *(const unsigned*)(qkbase + (size_t)(t < 0 ? 0 : t) * NCOL) : 0u; } \
        _Pragma("unroll") for (int i = 0; i < 8; ++i) vraw[i] = *(const unsigned*)(vbase + (size_t)(64 * (c_) + 8 * wid + i) * NCOL); } while (0)
    ML_LOADS(0);
    f32x4 Cacc[8];
#pragma unroll
    for (int i = 0; i < 8; ++i) Cacc[i] = (f32x4){0.f, 0.f, 0.f, 0.f};
#pragma unroll 1
    for (int c = 0; c < SEQ / 64; ++c) {
        {
            f32x2 xx[19];
#pragma unroll
            for (int i = 0; i < 19; ++i) { xx[i].x = bflo(raw[i]); xx[i].y = bfhi(raw[i]); }
            f32x2 oo[16], ee[16];
#pragma unroll
            for (int i = 0; i < 16; ++i) oo[i] = xx[i] * cw2[0] + cb2;
#pragma unroll
            for (int j = 1; j < 4; ++j)
#pragma unroll
                for (int i = 0; i < 16; ++i) oo[i] = xx[i + j] * cw2[j] + oo[i];
#pragma unroll
            for (int i = 0; i < 16; ++i) ee[i] = oo[i] * (-L2E);
#pragma unroll
            for (int i = 0; i < 16; ++i) { ee[i].x = __builtin_amdgcn_exp2f(ee[i].x); ee[i].y = __builtin_amdgcn_exp2f(ee[i].y); }
#pragma unroll
            for (int i = 0; i < 16; ++i) ee[i] = ee[i] + 1.0f;
#pragma unroll
            for (int i = 0; i < 16; ++i) { ee[i].x = __builtin_amdgcn_rcpf(ee[i].x); ee[i].y = __builtin_amdgcn_rcpf(ee[i].y); }
            if (!isk) {
#pragma unroll
                for (int i = 0; i < 16; ++i) oo[i] = oo[i] * ee[i];
#pragma unroll
                for (int i = 0; i < 16; ++i) *(LAS unsigned*)(lds + QL + (r0 + i) * QS + 4 * lane) = cvtpk_nv(oo[i].x, oo[i].y);
            } else {
                f32x2 kv[16];
#pragma unroll
                for (int i = 0; i < 16; ++i) kv[i] = oo[i] * ee[i] * 0.08838834764831845f;
#pragma unroll
                for (int i = 0; i < 16; ++i) *(LAS unsigned*)(lds + KL + (r0 + i) * QS + 4 * lane) = cvtpk_nv(kv[i].x, kv[i].y);
                u32x4 k0a, k0b, k1a, k1b;
#pragma unroll
                for (int q = 0; q < 4; ++q) { const f32x4 w4 = *(const LAS f32x4*)(WVl + 64 * c + r0 + 4 * q);
                    const f32x2 e0_ = kv[4 * q] * w4.x, e1_ = kv[4 * q + 1] * w4.y, e2_ = kv[4 * q + 2] * w4.z, e3_ = kv[4 * q + 3] * w4.w;
                    const unsigned a0 = cvtpk(e0_.x, e1_.x), a1 = cvtpk(e2_.x, e3_.x), b0 = cvtpk(e0_.y, e1_.y), b1 = cvtpk(e2_.y, e3_.y);
                    if (q == 0) { k0a.x = a0; k0a.y = a1; k1a.x = b0; k1a.y = b1; } else if (q == 1) { k0a.z = a0; k0a.w = a1; k1a.z = b0; k1a.w = b1; }
                    else if (q == 2) { k0b.x = a0; k0b.y = a1; k1b.x = b0; k1b.y = b1; } else { k0b.z = a0; k0b.w = a1; k1b.z = b0; k1b.w = b1; } }
                *(LAS u32x4*)(lds + KWT + (2 * lane) * TS + r0 * 2) = k0a; *(LAS u32x4*)(lds + KWT + (2 * lane) * TS + r0 * 2 + 16) = k0b;
                *(LAS u32x4*)(lds + KWT + (2 * lane + 1) * TS + r0 * 2) = k1a; *(LAS u32x4*)(lds + KWT + (2 * lane + 1) * TS + r0 * 2 + 16) = k1b;
            }
            u32x4 v0, v1;
            v0.x = (vraw[0] & 0xffffu) | (vraw[1] << 16); v0.y = (vraw[2] & 0xffffu) | (vraw[3] << 16); v0.z = (vraw[4] & 0xffffu) | (vraw[5] << 16); v0.w = (vraw[6] & 0xffffu) | (vraw[7] << 16);
            v1.x = (vraw[0] >> 16) | (vraw[1] & 0xffff0000u); v1.y = (vraw[2] >> 16) | (vraw[3] & 0xffff0000u); v1.z = (vraw[4] >> 16) | (vraw[5] & 0xffff0000u); v1.w = (vraw[6] >> 16) | (vraw[7] & 0xffff0000u);
            *(LAS u32x4*)(lds + VT + (2 * lane) * TS + 16 * wid) = v0;
            *(LAS u32x4*)(lds + VT + (2 * lane + 1) * TS + 16 * wid) = v1;
        }
        if (c + 1 < SEQ / 64) ML_LOADS(c + 1);
        u32x2 og[4];
#pragma unroll
        for (int ti = 0; ti < 4; ++ti) og[ti] = *(const u32x2*)(obase + (size_t)(64 * c + 16 * ti + fr) * NCOL);
        LBAR();
        {
            const int ti = wid >> 1, half = wid & 1; float rsum = 0.f;
            const float Mt = MVl[64 * c + 16 * ti + fr];
#pragma unroll
            for (int sx = 0; sx < 2; ++sx) {
                const int si = 2 * half + sx; f32x4 acc = (f32x4){0.f, 0.f, 0.f, 0.f};
                if (si <= ti) {
#pragma unroll
                    for (int kb = 0; kb < 4; ++kb) {
                        const bf16x8 kf = *(const LAS bf16x8*)(lds + KL + (16 * si + fr) * QS + (32 * kb + 8 * fq) * 2);
                        const bf16x8 qf = *(const LAS bf16x8*)(lds + QL + (16 * ti + fr) * QS + (32 * kb + 8 * fq) * 2);
                        acc = mfma16(kf, qf, acc); }
                    const f32x4 av = *(const LAS f32x4*)(AVl + 64 * c + 16 * si + 4 * fq);
#pragma unroll
                    for (int j = 0; j < 4; ++j) { const int s = 16 * si + 4 * fq + j, t = 16 * ti + fr; const float dd = (s <= t) ? __builtin_amdgcn_exp2f(av[j] - Mt) : 0.f; acc[j] *= dd; rsum += acc[j]; }
                }
                u32x2 o; o.x = cvtpk(acc[0], acc[1]); o.y = cvtpk(acc[2], acc[3]);
                *(LAS u32x2*)(lds + SD + (16 * ti + fr) * TS + (16 * si + 4 * fq) * 2) = o;
            }
            rsum += __shfl_xor(rsum, 16); rsum += __shfl_xor(rsum, 32);
            if (fq == 0) RSl[(16 * ti + fr) * 2 + half] = rsum;
        }
        {
            const int t = tid >> 3, part = tid & 7;
            const u32x4 qa = *(const LAS u32x4*)(lds + QL + t * QS + part * 32), qb = *(const LAS u32x4*)(lds + QL + t * QS + part * 32 + 16);
            const f32x4 n0 = *(const LAS f32x4*)(NLl + 16 * part), n1 = *(const LAS f32x4*)(NLl + 16 * part + 4), n2 = *(const LAS f32x4*)(NLl + 16 * part + 8), n3 = *(const LAS f32x4*)(NLl + 16 * part + 12);
            float s = bflo(qa.x) * n0.x + bfhi(qa.x) * n0.y + bflo(qa.y) * n0.z + bfhi(qa.y) * n0.w + bflo(qa.z) * n1.x + bfhi(qa.z) * n1.y + bflo(qa.w) * n1.z + bfhi(qa.w) * n1.w
                    + bflo(qb.x) * n2.x + bfhi(qb.x) * n2.y + bflo(qb.y) * n2.z + bfhi(qb.y) * n2.w + bflo(qb.z) * n3.x + bfhi(qb.z) * n3.y + bflo(qb.w) * n3.z + bfhi(qb.w) * n3.w;
            s += __shfl_xor(s, 1); s += __shfl_xor(s, 2); s += __shfl_xor(s, 4);
            if (part == 0) QNl[t] = s;
        }
        LBAR();
        f32x4 hacc[4]; float inter[4];
        {
            bf16x8 cf[4];
#pragma unroll
            for (int kb = 0; kb < 4; ++kb) { u32x4 w; w.x = cvtpk(Cacc[2 * kb][0], Cacc[2 * kb][1]); w.y = cvtpk(Cacc[2 * kb][2], Cacc[2 * kb][3]); w.z = cvtpk(Cacc[2 * kb + 1][0], Cacc[2 * kb + 1][1]); w.w = cvtpk(Cacc[2 * kb + 1][2], Cacc[2 * kb + 1][3]);
                cf[kb] = __builtin_bit_cast(bf16x8, w); }
#pragma unroll
            for (int ti = 0; ti < 4; ++ti) {
                hacc[ti] = (f32x4){0.f, 0.f, 0.f, 0.f};
#pragma unroll
                for (int kb = 0; kb < 4; ++kb) {
                    const u32x2 lo = *(const LAS u32x2*)(lds + QL + (16 * ti + fr) * QS + (32 * kb + 4 * fq) * 2), hi = *(const LAS u32x2*)(lds + QL + (16 * ti + fr) * QS + (32 * kb + 16 + 4 * fq) * 2);
                    const u32x4 qq = (u32x4){lo.x, lo.y, hi.x, hi.y};
                    hacc[ti] = mfma16(cf[kb], __builtin_bit_cast(bf16x8, qq), hacc[ti]); }
                inter[ti] = ITl[64 * c + 16 * ti + fr];
                hacc[ti] = hacc[ti] * inter[ti];
            }
        }
        {
            bf16x8 vf[2];
#pragma unroll
            for (int ks = 0; ks < 2; ++ks) vf[ks] = *(const LAS bf16x8*)(lds + VT + (e0 + fr) * TS + (32 * ks + 8 * fq) * 2);
#pragma unroll
            for (int ti = 0; ti < 4; ++ti)
#pragma unroll
                for (int ks = 0; ks < 2; ++ks) if (ks == 0 || ti >= 2) {
                    const bf16x8 sf = *(const LAS bf16x8*)(lds + SD + (16 * ti + fr) * TS + (32 * ks + 8 * fq) * 2);
                    hacc[ti] = mfma16(vf[ks], sf, hacc[ti]); }
            const float decay = DECl[c];
            float nsum = 0.f;
#pragma unroll
            for (int i = 0; i < 8; ++i) {
                Cacc[i] = Cacc[i] * decay;
#pragma unroll
                for (int ks = 0; ks < 2; ++ks) {
                    const bf16x8 kwf = *(const LAS bf16x8*)(lds + KWT + (16 * i + fr) * TS + (32 * ks + 8 * fq) * 2);
                    Cacc[i] = mfma16(kwf, vf[ks], Cacc[i]); }
            }
#pragma unroll
            for (int ks = 0; ks < 2; ++ks) {
                const u32x4 kk = *(const LAS u32x4*)(lds + KWT + (16 * wid + fr) * TS + (32 * ks + 8 * fq) * 2);
                nsum += (bflo(kk.x) + bfhi(kk.x)) + (bflo(kk.y) + bfhi(kk.y)) + (bflo(kk.z) + bfhi(kk.z)) + (bflo(kk.w) + bfhi(kk.w)); }
            nsum += __shfl_xor(nsum, 16); nsum += __shfl_xor(nsum, 32);
            if (fq == 0) NLl[16 * wid + fr] = decay * NLl[16 * wid + fr] + nsum;
        }
        f32x4 hm[4];
#pragma unroll
        for (int ti = 0; ti < 4; ++ti) {
            const int t = 16 * ti + fr;
            const float den = RSl[2 * t] + RSl[2 * t + 1] + inter[ti] * QNl[t];
            const float rd = __builtin_amdgcn_rcpf(fmaxf(fabsf(den), FLl[64 * c + t]));
            const f32x4 gg = (f32x4){bflo(og[ti].x), bfhi(og[ti].x), bflo(og[ti].y), bfhi(og[ti].y)};
            hm[ti] = hacc[ti] * gg * rd;
            float psq = (hm[ti][0] * hm[ti][0] + hm[ti][1] * hm[ti][1]) + (hm[ti][2] * hm[ti][2] + hm[ti][3] * hm[ti][3]);
            psq += __shfl_xor(psq, 16); psq += __shfl_xor(psq, 32);
            if (fq == 0) PSQl[t * 8 + wid] = psq;
        }
        LBAR();
#pragma unroll
        for (int ti = 0; ti < 4; ++ti) {
            const int t = 16 * ti + fr;
            const f32x4 p0 = *(const LAS f32x4*)(PSQl + t * 8), p1 = *(const LAS f32x4*)(PSQl + t * 8 + 4);
            const float r = rsqrtf(((p0.x + p0.y) + (p0.z + p0.w) + (p1.x + p1.y) + (p1.z + p1.w)) * (1.f / 128.f) + EPS);
            const f32x4 ov = hm[ti] * mw * r;
            u32x2 o; o.x = cvtpk(ov[0], ov[1]); o.y = cvtpk(ov[2], ov[3]);
            *(u32x2*)(MIX + (size_t)(b * SEQ + 64 * c + t) * DM + h * 128 + e0 + 4 * fq) = o;
        }
    }
#undef ML_LOADS
}
}

namespace att {
using s16x4  = __attribute__((ext_vector_type(4))) short;
using f32x16 = __attribute__((ext_vector_type(16))) float;
constexpr int SHM_V = 16384, SHM_K = 16384;
constexpr float THR2 = 11.5415603f;
#define KSWZ(row, colB) ((row) * 256 + ((colB) ^ (((row) & 7) << 4)))
#define SBAR() __builtin_amdgcn_sched_barrier(0)
__device__ __forceinline__ int crow(int r, int hi) { return (r & 3) + 8 * (r >> 2) + 4 * hi; }
__device__ __forceinline__ unsigned cvtpk(float lo, float hi) { unsigned r; asm volatile("v_cvt_pk_bf16_f32 %0, %1, %2" : "=v"(r) : "v"(lo), "v"(hi)); return r; }
__device__ __forceinline__ void partialSM(f32x16& p0, f32x16& p1, float& m_reg, float& mn, float& alpha) {
  float pmax = p0[0];
#pragma unroll
  for (int r = 1; r < 16; ++r) pmax = fmaxf(pmax, p0[r]);
#pragma unroll
  for (int r = 0; r < 16; ++r) pmax = fmaxf(pmax, p1[r]);
  { auto rr = __builtin_amdgcn_permlane32_swap(__float_as_uint(pmax), __float_as_uint(pmax), false, false);
    pmax = fmaxf(__uint_as_float(rr[0]), __uint_as_float(rr[1])); }
  if (__builtin_expect(__all(pmax - m_reg <= THR2), 1)) { mn = m_reg; alpha = 1.f; }
  else { mn = fmaxf(m_reg, pmax); alpha = __builtin_amdgcn_exp2f(m_reg - mn); m_reg = mn; }
#pragma unroll
  for (int r = 0; r < 16; ++r) p0[r] = p0[r] - mn;
#pragma unroll
  for (int r = 0; r < 16; ++r) p1[r] = p1[r] - mn;
#pragma unroll
  for (int r = 0; r < 16; ++r) p0[r] = __builtin_amdgcn_exp2f(p0[r]);
}
__device__ __forceinline__ void finishSM(f32x16& p0, f32x16& p1, float alpha, float& l_reg, bf16x8& pa0, bf16x8& pa1, bf16x8& pa2, bf16x8& pa3) {
#pragma unroll
  for (int r = 0; r < 16; ++r) p1[r] = __builtin_amdgcn_exp2f(p1[r]);
  float ps = 0;
#pragma unroll
  for (int r = 0; r < 16; ++r) ps += p0[r];
#pragma unroll
  for (int r = 0; r < 16; ++r) ps += p1[r];
  { auto rr = __builtin_amdgcn_permlane32_swap(__float_as_uint(ps), __float_as_uint(ps), false, false);
    ps = __uint_as_float(rr[0]) + __uint_as_float(rr[1]); }
  l_reg = l_reg * alpha + ps;
#define PK4(P, BASE, OUT) do { unsigned a0 = cvtpk(P[BASE + 0], P[BASE + 1]), a1 = cvtpk(P[BASE + 2], P[BASE + 3]);   \
    unsigned b0 = cvtpk(P[BASE + 4], P[BASE + 5]), b1 = cvtpk(P[BASE + 6], P[BASE + 7]);                              \
    auto r0 = __builtin_amdgcn_permlane32_swap(a0, b0, false, false); auto r1 = __builtin_amdgcn_permlane32_swap(a1, b1, false, false); \
    u32x4 w = {r0[0], r1[0], r0[1], r1[1]}; OUT = __builtin_bit_cast(bf16x8, w); } while (0)
  PK4(p0, 0, pa0); PK4(p0, 8, pa1); PK4(p1, 0, pa2); PK4(p1, 8, pa3);
#undef PK4
}
__device__ __forceinline__ void partialFX(f32x16& p0) {
#pragma unroll
  for (int r = 0; r < 16; ++r) p0[r] = __builtin_amdgcn_exp2f(p0[r]);
}
__device__ __forceinline__ void finishFX(f32x16& p0, f32x16& p1, float& l_reg, bf16x8& pa0, bf16x8& pa1, bf16x8& pa2, bf16x8& pa3) {
#pragma unroll
  for (int r = 0; r < 16; ++r) p1[r] = __builtin_amdgcn_exp2f(p1[r]);
  float ps = 0;
#pragma unroll
  for (int r = 0; r < 16; ++r) ps += p0[r];
#pragma unroll
  for (int r = 0; r < 16; ++r) ps += p1[r];
  l_reg += ps;
#define PK4(P, BASE, OUT) do { unsigned a0 = cvtpk(P[BASE + 0], P[BASE + 1]), a1 = cvtpk(P[BASE + 2], P[BASE + 3]);   \
    unsigned b0 = cvtpk(P[BASE + 4], P[BASE + 5]), b1 = cvtpk(P[BASE + 6], P[BASE + 7]);                              \
    auto r0 = __builtin_amdgcn_permlane32_swap(a0, b0, false, false); auto r1 = __builtin_amdgcn_permlane32_swap(a1, b1, false, false); \
    u32x4 w = {r0[0], r1[0], r0[1], r1[1]}; OUT = __builtin_bit_cast(bf16x8, w); } while (0)
  PK4(p0, 0, pa0); PK4(p0, 8, pa1); PK4(p1, 0, pa2); PK4(p1, 8, pa3);
#undef PK4
}
__device__ __forceinline__ void qkt(f32x16& p0, f32x16& p1, const LAS unsigned char* Ks, const bf16x8 (&qr)[4], int c, int r32, int hi) {
  p0 = f32x16{}; p1 = f32x16{};
#pragma unroll
  for (int d0 = 0; d0 < 4; ++d0) { const int cb = (c * 64 + d0 * 16 + hi * 8) * 2;
    const bf16x8 b0 = *(const LAS bf16x8*)(Ks + KSWZ(r32, cb));
    const bf16x8 b1 = *(const LAS bf16x8*)(Ks + KSWZ(32 + r32, cb));
    p0 = __builtin_amdgcn_mfma_f32_32x32x16_bf16(b0, qr[d0], p0, 0, 0, 0);
    p1 = __builtin_amdgcn_mfma_f32_32x32x16_bf16(b1, qr[d0], p1, 0, 0, 0); }
}
__device__ __forceinline__ int v_st(int k, int c) { const int kk = (k & ~0xC) | ((k & 4) << 1) | ((k & 8) >> 1); return ((kk >> 3) * 4 + (c >> 5)) * 512 + ((kk & 7) * 32 + (c & 31)) * 2; }
__device__ __forceinline__ int v_rd_base(int lane) { return ((lane & 3) << 3) | (((lane >> 2) & 3) << 6) | (((lane >> 4) & 1) << 5) | (((lane >> 5) & 1) << 8); }
constexpr int v_rd_off(int d0, int ks, int half) { return d0 * 512 + ks * 4096 + half * 2048; }
template <int OFF> __device__ __forceinline__ s16x4 tr_read(int vb) {
  s16x4 r; asm volatile("ds_read_b64_tr_b16 %0, %1 offset:%2" : "=&v"(r) : "v"(vb), "i"(OFF) : "memory"); return r;
}
template <int D0> __device__ __forceinline__ void pv_one(f32x16& od, int vb, bf16x8 pa0, bf16x8 pa1, bf16x8 pa2, bf16x8 pa3) {
  const s16x4 l0 = tr_read<v_rd_off(D0, 0, 0)>(vb), h0 = tr_read<v_rd_off(D0, 0, 1)>(vb), l1 = tr_read<v_rd_off(D0, 1, 0)>(vb), h1 = tr_read<v_rd_off(D0, 1, 1)>(vb);
  const s16x4 l2 = tr_read<v_rd_off(D0, 2, 0)>(vb), h2 = tr_read<v_rd_off(D0, 2, 1)>(vb), l3 = tr_read<v_rd_off(D0, 3, 0)>(vb), h3 = tr_read<v_rd_off(D0, 3, 1)>(vb);
  asm volatile("s_waitcnt lgkmcnt(0)" ::: "memory"); SBAR();
#define PK(L, H) (bf16x8){L[0], L[1], L[2], L[3], H[0], H[1], H[2], H[3]}
  od = __builtin_amdgcn_mfma_f32_32x32x16_bf16(pa0, PK(l0, h0), od, 0, 0, 0);
  od = __builtin_amdgcn_mfma_f32_32x32x16_bf16(pa1, PK(l1, h1), od, 0, 0, 0);
  od = __builtin_amdgcn_mfma_f32_32x32x16_bf16(pa2, PK(l2, h2), od, 0, 0, 0);
  od = __builtin_amdgcn_mfma_f32_32x32x16_bf16(pa3, PK(l3, h3), od, 0, 0, 0);
#undef PK
}
#define PVRD(D0) const s16x4 l0_##D0 = tr_read<v_rd_off(D0, 0, 0)>(vb), h0_##D0 = tr_read<v_rd_off(D0, 0, 1)>(vb), l1_##D0 = tr_read<v_rd_off(D0, 1, 0)>(vb), h1_##D0 = tr_read<v_rd_off(D0, 1, 1)>(vb), \
    l2_##D0 = tr_read<v_rd_off(D0, 2, 0)>(vb), h2_##D0 = tr_read<v_rd_off(D0, 2, 1)>(vb), l3_##D0 = tr_read<v_rd_off(D0, 3, 0)>(vb), h3_##D0 = tr_read<v_rd_off(D0, 3, 1)>(vb)
#define PVPK(L, H) (bf16x8){L[0], L[1], L[2], L[3], H[0], H[1], H[2], H[3]}
#define PVMM(D0, N) do { asm volatile("s_waitcnt lgkmcnt(" #N ")" ::: "memory"); SBAR(); \
    o[D0] = __builtin_amdgcn_mfma_f32_32x32x16_bf16(pa0, PVPK(l0_##D0, h0_##D0), o[D0], 0, 0, 0); o[D0] = __builtin_amdgcn_mfma_f32_32x32x16_bf16(pa1, PVPK(l1_##D0, h1_##D0), o[D0], 0, 0, 0); \
    o[D0] = __builtin_amdgcn_mfma_f32_32x32x16_bf16(pa2, PVPK(l2_##D0, h2_##D0), o[D0], 0, 0, 0); o[D0] = __builtin_amdgcn_mfma_f32_32x32x16_bf16(pa3, PVPK(l3_##D0, h3_##D0), o[D0], 0, 0, 0); } while (0)
__device__ __forceinline__ void pv_d0(f32x16* o, int vb, bf16x8 pa0, bf16x8 pa1, bf16x8 pa2, bf16x8 pa3) {
  PVRD(0); PVRD(1); PVMM(0, 8); PVRD(2); PVMM(1, 8); PVRD(3); PVMM(2, 8); PVMM(3, 0);
}
#undef PVRD
#undef PVPK
#undef PVMM

template <bool FX>
__device__ __forceinline__ void attn_unit(const bf16* __restrict__ PROJ, bf16* __restrict__ MIX, const float* __restrict__ anw, const float lam, const float nb, const int b, const int h, const int qb,
                                          LAS unsigned char* lds, const int tid) {
  const int wid = __builtin_amdgcn_readfirstlane(tid >> 6), lane = tid & 63, r32 = lane & 31, hi = lane >> 5, g = wid >> 1, c = wid & 1;
  const int q0 = qb * 128, NT = 2 * qb + 2; const bool masked_last = (g < 2);
  int hcol = h * 128; asm volatile("" : "+s"(hcol));
  const char* Kg = (const char*)(PROJ + (size_t)(b * SEQ) * NCOL + C_AK + hcol);
  const char* Vg = (const char*)(PROJ + (size_t)(b * SEQ) * NCOL + C_AV + hcol);
  LAS float* wsf = (LAS float*)(lds + 131072) + wid * 64; LAS float* li_l = wsf; LAS float* al_l = wsf + 32;
  unsigned koff[2], voff[2];
#pragma unroll
  for (int p = 0; p < 2; ++p) { const int s = (wid * 2 + p) * 64 + lane, row = s >> 4, ch = (s & 15) ^ (row & 7); koff[p] = (unsigned)(row * NCOL + ch * 8) * 2u;
    const int o = s * 16, sub = o >> 9, within = o & 511, kk = (sub >> 2) * 8 + (within >> 6), k = (kk & ~0xC) | ((kk & 4) << 1) | ((kk & 8) >> 1), cc = (sub & 3) * 32 + ((within & 63) >> 4) * 8;
    voff[p] = (unsigned)(k * NCOL + cc) * 2u; }
#define DMA(tile, slot) do { const char* kt_ = Kg + (size_t)(tile) * (64 * NCOL * 2); const char* vt_ = Vg + (size_t)(tile) * (64 * NCOL * 2); LAS unsigned char* sl_ = lds + (slot) * 32768 + wid * 2048; \
    _Pragma("unroll") for (int p_ = 0; p_ < 2; ++p_) __builtin_amdgcn_global_load_lds((const unsigned*)(kt_ + koff[p_]), (LAS unsigned*)(sl_ + p_ * 1024), 16, 0, 0); \
    _Pragma("unroll") for (int p_ = 0; p_ < 2; ++p_) __builtin_amdgcn_global_load_lds((const unsigned*)(vt_ + voff[p_]), (LAS unsigned*)(sl_ + 16384 + p_ * 1024), 16, 0, 0); } while (0)
#define WB4() do { asm volatile("s_waitcnt vmcnt(4)" ::: "memory"); __builtin_amdgcn_s_barrier(); asm volatile("" ::: "memory"); } while (0)
#define WB8() do { asm volatile("s_waitcnt vmcnt(8)" ::: "memory"); __builtin_amdgcn_s_barrier(); asm volatile("" ::: "memory"); } while (0)
#define KSLOT(j) (lds + ((j) & 3) * 32768)
#define VSLOT(j) (vb0 + ((j) & 3) * 32768)
  float m_reg = -1e30f, l_reg = 0; f32x16 o[4] = {}; bf16x8 qr[4];
  { const bf16* Qw = PROJ + (size_t)(b * SEQ + q0 + 32 * g + r32) * NCOL + C_AQ + hcol + c * 64 + hi * 8;
#pragma unroll
    for (int d0 = 0; d0 < 4; ++d0) qr[d0] = *(const bf16x8*)(Qw + d0 * 16); }
  const int vb0 = (int)(unsigned)(uintptr_t)lds + 16384 + v_rd_base(lane);
#define RESC(a) do { if (__any((a) < 1.f)) { if (hi == 0) al_l[r32] = (a); asm volatile("s_waitcnt lgkmcnt(0)" ::: "memory"); \
    _Pragma("unroll") for (int d = 0; d < 4; ++d) _Pragma("unroll") for (int r = 0; r < 16; ++r) o[d][r] *= al_l[crow(r, hi)]; } } while (0)
  f32x16 p0, p1; float mn, al; bf16x8 pa0, pa1, pa2, pa3;
  DMA(0, 0); DMA(1, 1);
#pragma unroll 1
  for (int j = 0; j < NT; ++j) {
    WB4();
    DMA((j + 2 < NT ? j + 2 : NT - 1), (j + 2) & 3);
    SBAR(); qkt(p0, p1, KSLOT(j), qr, c, r32, hi);
    if (masked_last && j == NT - 1) {
#pragma unroll
      for (int r = 0; r < 16; ++r) { p0[r] = -1e30f; p1[r] = -1e30f; } }
    if constexpr (FX) { SBAR(); partialFX(p0); finishFX(p0, p1, l_reg, pa0, pa1, pa2, pa3); SBAR(); }
    else { partialSM(p0, p1, m_reg, mn, al); RESC(al); finishSM(p0, p1, al, l_reg, pa0, pa1, pa2, pa3); SBAR(); }
    pv_d0(o, VSLOT(j), pa0, pa1, pa2, pa3);
  }
  if constexpr (FX) l_reg += __shfl_xor(l_reg, 32);
  asm volatile("s_waitcnt vmcnt(0)" ::: "memory");
#undef DMA
#undef WB4
#undef WB8
#undef KSLOT
#undef VSLOT
  if (hi == 0) li_l[r32] = l_reg; asm volatile("s_waitcnt lgkmcnt(0)" ::: "memory");
  int lane2 = lane; asm volatile("" : "+v"(lane2));
  const int r32b = lane2 & 31, hib = lane2 >> 5;
  float rli[16];
#pragma unroll
  for (int r = 0; r < 16; ++r) rli[r] = __builtin_amdgcn_rcpf(li_l[(r & 3) + 8 * (r >> 2) + 4 * hib]);
  __syncthreads();
  LAS float* X = (LAS float*)(lds + g * 16384) + hib * 512 + r32b;
  if (c == 1) {
#pragma unroll
    for (int r = 0; r < 16; ++r)
#pragma unroll
      for (int d0 = 0; d0 < 4; ++d0) X[((r & 3) + 8 * (r >> 2)) * 128 + d0 * 32] = o[d0][r] * (rli[r] * lam);
  }
  __syncthreads();
  if (c == 0) {
    float ss[16];
#pragma unroll
    for (int r = 0; r < 16; ++r) { ss[r] = 0.f;
#pragma unroll
      for (int d0 = 0; d0 < 4; ++d0) { const float v = o[d0][r] * rli[r] - X[((r & 3) + 8 * (r >> 2)) * 128 + d0 * 32]; o[d0][r] = v; ss[r] += v * v; } }
#pragma unroll
    for (int r = 0; r < 16; ++r) {
#pragma unroll
      for (int s = 1; s < 32; s <<= 1) ss[r] += __shfl_xor(ss[r], s);
      ss[r] = rsqrtf(ss[r] * (1.f / 128.f) + EPS) * (1.f - LAMBDA_INIT); }
    float aw[4];
#pragma unroll
    for (int d0 = 0; d0 < 4; ++d0) aw[d0] = anw[d0 * 32 + r32b];
    asm volatile("s_waitcnt lgkmcnt(0)" ::: "memory");
    LAS bf16* Ost = (LAS bf16*)(lds + g * 16384);
    LAS bf16* Ow = Ost + hib * 512 + r32b;
#pragma unroll
    for (int r = 0; r < 16; ++r)
#pragma unroll
      for (int d0 = 0; d0 < 4; ++d0) Ow[((r & 3) + 8 * (r >> 2)) * 128 + d0 * 32] = (bf16)f2bf(o[d0][r] * ss[r] * aw[d0]);
    asm volatile("s_waitcnt lgkmcnt(0)" ::: "memory");
    const int rowb = lane2 >> 4, c16 = lane2 & 15;
    bf16* Ob = MIX + (size_t)(b * SEQ + q0 + 32 * g + rowb) * DM + 512 + h * 128 + c16 * 8;
    const LAS bf16* Os = Ost + rowb * 128 + c16 * 8;
#pragma unroll
    for (int k = 0; k < 8; ++k) *(u32x4*)(Ob + (size_t)k * 4 * DM) = *(const LAS u32x4*)(Os + k * 512);
  }
  __syncthreads();
#undef RESC
}

template <int C, int HALF_> __device__ __forceinline__ void half_scores(f32x16& p, const LAS unsigned char* Ks, const bf16x8 (&qr)[8], const int kaddr) {
  p = f32x16{};
#pragma unroll
  for (int d0 = 0; d0 < 4; ++d0) { const bf16x8 kf = *(const LAS bf16x8*)(Ks + (kaddr ^ (d0 * 32)) + C * 128 + HALF_ * 8192);
    p = __builtin_amdgcn_mfma_f32_32x32x16_bf16(kf, qr[C * 4 + d0], p, 0, 0, 0); }
}
__device__ __forceinline__ void half_softmax(f32x16& p, float& l_reg, bf16x8& pa, bf16x8& pb) {
#pragma unroll
  for (int r = 0; r < 16; ++r) p[r] = __builtin_amdgcn_exp2f(p[r]);
  float ps = 0;
#pragma unroll
  for (int r = 0; r < 16; ++r) ps += p[r];
  l_reg += ps;
#define PK4(P, BASE, OUT) do { unsigned a0 = cvtpk(P[BASE + 0], P[BASE + 1]), a1 = cvtpk(P[BASE + 2], P[BASE + 3]);   \
    unsigned b0 = cvtpk(P[BASE + 4], P[BASE + 5]), b1 = cvtpk(P[BASE + 6], P[BASE + 7]);                              \
    auto r0 = __builtin_amdgcn_permlane32_swap(a0, b0, false, false); auto r1 = __builtin_amdgcn_permlane32_swap(a1, b1, false, false); \
    u32x4 w = {r0[0], r1[0], r0[1], r1[1]}; OUT = __builtin_bit_cast(bf16x8, w); } while (0)
  PK4(p, 0, pa); PK4(p, 8, pb);
#undef PK4
  SBAR();
}
template <int D0, int HALF_> __device__ __forceinline__ void pv_half(f32x16& oa, f32x16& ob, int vb, bf16x8 a0, bf16x8 a1, bf16x8 b0, bf16x8 b1) {
  const s16x4 l0 = tr_read<v_rd_off(D0, 2 * HALF_, 0)>(vb), h0 = tr_read<v_rd_off(D0, 2 * HALF_, 1)>(vb), l1 = tr_read<v_rd_off(D0, 2 * HALF_ + 1, 0)>(vb), h1 = tr_read<v_rd_off(D0, 2 * HALF_ + 1, 1)>(vb);
  asm volatile("s_waitcnt lgkmcnt(0)" ::: "memory"); SBAR();
#define PK(L, H) (bf16x8){L[0], L[1], L[2], L[3], H[0], H[1], H[2], H[3]}
  oa = __builtin_amdgcn_mfma_f32_32x32x16_bf16(a0, PK(l0, h0), oa, 0, 0, 0);
  ob = __builtin_amdgcn_mfma_f32_32x32x16_bf16(b0, PK(l0, h0), ob, 0, 0, 0);
  oa = __builtin_amdgcn_mfma_f32_32x32x16_bf16(a1, PK(l1, h1), oa, 0, 0, 0);
  ob = __builtin_amdgcn_mfma_f32_32x32x16_bf16(b1, PK(l1, h1), ob, 0, 0, 0);
#undef PK
  SBAR();
}
__device__ __forceinline__ void attn2_setup(LAS unsigned char* lds, const int tid) {
  const int wid = __builtin_amdgcn_readfirstlane(tid >> 6), lane = tid & 63;
  unsigned koff[2], voff[2];
#pragma unroll
  for (int p = 0; p < 2; ++p) { const int s = (wid * 2 + p) * 64 + lane, row = s >> 4, ch = (s & 15) ^ (row & 7); koff[p] = (unsigned)(row * NCOL + ch * 8) * 2u;
    const int o = s * 16, sub = o >> 9, within = o & 511, kk = (sub >> 2) * 8 + (within >> 6), k = (kk & ~0xC) | ((kk & 4) << 1) | ((kk & 8) >> 1), cc = (sub & 3) * 32 + ((within & 63) >> 4) * 8;
    voff[p] = (unsigned)(k * NCOL + cc) * 2u; }
  *((LAS u32x4*)(lds + 133120 + wid * 1024) + lane) = (u32x4){koff[0], koff[1], voff[0], voff[1]};
  asm volatile("s_waitcnt lgkmcnt(0)" ::: "memory");
}
__device__ __forceinline__ void attn_unit2(const bf16* __restrict__ PROJ, bf16* __restrict__ MIX, const float* __restrict__ anw, const float lam, const int b, const int h, const int qb,
                                           LAS unsigned char* lds, const int tid) {
  const int wid = __builtin_amdgcn_readfirstlane(tid >> 6), lane = tid & 63, r32 = lane & 31, hi = lane >> 5;
  const int q0 = qb * 256, NT = 4 * qb + 4, jlast = 4 * qb + (wid >> 1);
  int hcol = h * 128; asm volatile("" : "+s"(hcol));
  const char* Kg = (const char*)(PROJ + (size_t)(b * SEQ) * NCOL + C_AK + hcol);
  const char* Vg = (const char*)(PROJ + (size_t)(b * SEQ) * NCOL + C_AV + hcol);
  LAS float* wsf = (LAS float*)(lds + 131072) + wid * 64;
  LAS u32x4* offt = (LAS u32x4*)(lds + 133120 + wid * 1024) + lane;
#define DMA(tile, slot) do { const char* kt_ = Kg + (size_t)(tile) * (64 * NCOL * 2); const char* vt_ = Vg + (size_t)(tile) * (64 * NCOL * 2); LAS unsigned char* sl_ = lds + (slot) * 32768 + wid * 2048; const u32x4 of_ = *offt; \
    __builtin_amdgcn_global_load_lds((const unsigned*)(kt_ + of_.x), (LAS unsigned*)(sl_), 16, 0, 0); __builtin_amdgcn_global_load_lds((const unsigned*)(kt_ + of_.y), (LAS unsigned*)(sl_ + 1024), 16, 0, 0); \
    __builtin_amdgcn_global_load_lds((const unsigned*)(vt_ + of_.z), (LAS unsigned*)(sl_ + 16384), 16, 0, 0); __builtin_amdgcn_global_load_lds((const unsigned*)(vt_ + of_.w), (LAS unsigned*)(sl_ + 16384 + 1024), 16, 0, 0); } while (0)
#define WB4() do { asm volatile("s_waitcnt vmcnt(4)" ::: "memory"); __builtin_amdgcn_s_barrier(); asm volatile("" ::: "memory"); } while (0)
  float l0 = 0.f, l1 = 0.f; f32x16 oa[4] = {}, ob[4] = {}; bf16x8 qr[8];
  { const bf16* Qw = PROJ + (size_t)(b * SEQ + q0 + 32 * wid + r32) * NCOL + C_AQ + hcol + hi * 8;
#pragma unroll
    for (int d = 0; d < 8; ++d) qr[d] = *(const bf16x8*)(Qw + d * 16); }
  const int vb0 = (int)(unsigned)(uintptr_t)lds + 16384 + v_rd_base(lane);
  const int kaddr = r32 * 256 + ((hi * 16) ^ ((r32 & 7) << 4));
  DMA(0, 0); DMA(1, 1);
#pragma unroll 1
  for (int j = 0; j < NT; ++j) {
    WB4();
    DMA((j + 2 < NT ? j + 2 : NT - 1), (j + 2) & 3);
    if (j <= jlast) {
      const LAS unsigned char* Ks = lds + (j & 3) * 32768; const int vb = vb0 + (j & 3) * 32768;
      f32x16 p; bf16x8 a0, a1, b0, b1;
      SBAR(); half_scores<0, 0>(p, Ks, qr, kaddr); half_softmax(p, l0, a0, a1);
      SBAR(); half_scores<1, 0>(p, Ks, qr, kaddr); half_softmax(p, l1, b0, b1); SBAR();
      pv_half<0, 0>(oa[0], ob[0], vb, a0, a1, b0, b1); pv_half<1, 0>(oa[1], ob[1], vb, a0, a1, b0, b1); pv_half<2, 0>(oa[2], ob[2], vb, a0, a1, b0, b1); pv_half<3, 0>(oa[3], ob[3], vb, a0, a1, b0, b1);
      SBAR(); half_scores<0, 1>(p, Ks, qr, kaddr); half_softmax(p, l0, a0, a1);
      SBAR(); half_scores<1, 1>(p, Ks, qr, kaddr); half_softmax(p, l1, b0, b1); SBAR();
      pv_half<0, 1>(oa[0], ob[0], vb, a0, a1, b0, b1); pv_half<1, 1>(oa[1], ob[1], vb, a0, a1, b0, b1); pv_half<2, 1>(oa[2], ob[2], vb, a0, a1, b0, b1); pv_half<3, 1>(oa[3], ob[3], vb, a0, a1, b0, b1);
    }
  }
  l0 += __shfl_xor(l0, 32); l1 += __shfl_xor(l1, 32);
  asm volatile("s_waitcnt vmcnt(0)" ::: "memory");
  if (hi == 0) { wsf[r32] = l0; wsf[32 + r32] = l1; } asm volatile("s_waitcnt lgkmcnt(0)" ::: "memory");
  int lane2 = lane; asm volatile("" : "+v"(lane2));
  const int r32b = lane2 & 31, hib = lane2 >> 5;
  __syncthreads();
  float ss[16];
#pragma unroll
  for (int r = 0; r < 16; ++r) { const int row = (r & 3) + 8 * (r >> 2) + 4 * hib; const float c0 = __builtin_amdgcn_rcpf(wsf[row]), c1 = lam * __builtin_amdgcn_rcpf(wsf[32 + row]); ss[r] = 0.f;
#pragma unroll
    for (int d0 = 0; d0 < 4; ++d0) { const float v = oa[d0][r] * c0 - ob[d0][r] * c1; oa[d0][r] = v; ss[r] += v * v; } }
#pragma unroll
  for (int r = 0; r < 16; ++r) {
#pragma unroll
    for (int s = 1; s < 32; s <<= 1) ss[r] += __shfl_xor(ss[r], s);
    ss[r] = rsqrtf(ss[r] * (1.f / 128.f) + EPS) * (1.f - LAMBDA_INIT); }
  float aw[4];
#pragma unroll
  for (int d0 = 0; d0 < 4; ++d0) aw[d0] = anw[d0 * 32 + r32b];
  LAS bf16* Ost = (LAS bf16*)(lds + wid * 8192);
  LAS bf16* Ow = Ost + hib * 512 + r32b;
#pragma unroll
  for (int r = 0; r < 16; ++r)
#pragma unroll
    for (int d0 = 0; d0 < 4; ++d0) Ow[((r & 3) + 8 * (r >> 2)) * 128 + d0 * 32] = (bf16)f2bf(oa[d0][r] * ss[r] * aw[d0]);
  asm volatile("s_waitcnt lgkmcnt(0)" ::: "memory");
  const int rowb = lane2 >> 4, c16 = lane2 & 15;
  bf16* Ob = MIX + (size_t)(b * SEQ + q0 + 32 * wid + rowb) * DM + 512 + h * 128 + c16 * 8;
  const LAS bf16* Os = Ost + rowb * 128 + c16 * 8;
#pragma unroll
  for (int k = 0; k < 8; ++k) *(u32x4*)(Ob + (size_t)k * 4 * DM) = *(const LAS u32x4*)(Os + k * 512);
  __syncthreads();
#undef DMA
#undef WB4
}
}

template <bool FX>
__device__ __forceinline__ void attn_queue(const bf16* PROJ, bf16* MIX, const float* anw, const float lam, const float nb, unsigned* queue, LAS unsigned char* lds, int tid) {
    LAS unsigned* slot = (LAS unsigned*)(lds + LDSCTL_OFF + 64);
    const int x0 = (int)(xb_xcc_id() & 7u);
    LAS unsigned* peek = (LAS unsigned*)(lds + LDSCTL_OFF + 72);
    if constexpr (FX) att::attn2_setup(lds, tid);
#pragma unroll 1
    for (int k = 0; k < 8; ++k) {
        const int x = (x0 + k) & 7;
        if (k == 1) { if (tid < 8) peek[tid] = __hip_atomic_load(queue + 64 * tid, __ATOMIC_RELAXED, __HIP_MEMORY_SCOPE_AGENT); __syncthreads(); }
        if (k >= 1) { if (peek[x] >= 128u) continue; }
        if (tid == 0) *slot = __hip_atomic_fetch_add(queue + 64 * x, 1u, __ATOMIC_RELAXED, __HIP_MEMORY_SCOPE_AGENT);
        __syncthreads();
        for (;;) {
            const unsigned l = *slot;
            __syncthreads();
            if (l >= 128u) break;
            unsigned nxt = 0u;
            if (tid == 0) nxt = __hip_atomic_fetch_add(queue + 64 * x, 1u, __ATOMIC_RELAXED, __HIP_MEMORY_SCOPE_AGENT);
            const int bh = ((int)l >> 3) * 8 + x, p = (int)l & 7;
            if constexpr (FX) { const int bh2 = ((int)l & 15) * 8 + x, qb2 = 7 - ((int)l >> 4); att::attn_unit2(PROJ, MIX, anw, lam, bh2 >> 2, bh2 & 3, qb2, lds, tid); }
            else {
#pragma unroll 1
                for (int s = 0; s < 2; ++s) att::attn_unit<false>(PROJ, MIX, anw, lam, nb, bh >> 2, bh & 3, s ? p : 15 - p, lds, tid); }
            if (tid == 0) *slot = nxt;
            __syncthreads();
        }
    }
}
__device__ __forceinline__ void p2_fast_attn(const Args& a, LAS unsigned char* lds, int tid, int lane, int wave, int wg, int G, int rep) {
    const float* lq1 = a.in[10]; const float* lk1 = a.in[11]; const float* lq2 = a.in[12]; const float* lk2 = a.in[13];
    const float lam = __expf(wave_sum(lq1[lane] * lk1[lane])) - __expf(wave_sum(lq2[lane] * lk2[lane])) + LAMBDA_INIT;
    const float bound2 = 8.f * 1.4426950408889634f * 1.01f * wave_max(fabsf(a.in[8][lane])) * wave_max(fabsf(a.in[9][lane]));
    const bool fixedmax = bound2 <= 40.f;
    const bf16* PROJ = (const bf16*)(a.ws + WS_PROJ); bf16* MIX = (bf16*)(a.ws + WS_MIX);
    unsigned* queue = (unsigned*)(a.ws + WS_CTL) + CW_QUEUE + 1024 * rep;
    if (fixedmax) attn_queue<true>(PROJ, MIX, a.in[14], lam, -bound2, queue, lds, tid);
    else attn_queue<false>(PROJ, MIX, a.in[14], lam, 0.f, queue, lds, tid);
}

__device__ __forceinline__ void p4_router(const Args& a, LAS unsigned char* lds, int tid, int lane, int wave, int wg, int G) {
    unsigned char* ws = a.ws;
    const float* norm2_w = a.in[16]; const float* w_group = a.in[17]; const float* b_group = a.in[18]; const float* w_expert = a.in[19]; const float* b_expert = a.in[20];
    const float* X1 = a.out; bf16* H2 = (bf16*)(ws + WS_H2);
    int* ASGE = (int*)(ws + WS_ASGE); float* ASGW = (float*)(ws + WS_ASGW); int* CNT = (int*)(ws + WS_CTL) + CW_CNT;
    LAS float* wl = (LAS float*)lds;
    LAS int* hist = (LAS int*)(lds + LDSCTL_OFF + 128);
    for (int idx = tid; idx < 4096; idx += NTHR) { const int k = idx >> 2, c = idx & 3; wl[c * 1024 + k] = w_group[idx]; }
    for (int idx = tid; idx < 32768; idx += NTHR) { const int k = idx >> 5, c = idx & 31; wl[(4 + c) * 1024 + k] = w_expert[idx]; }
    if (tid < 32) hist[tid] = 0;
    __syncthreads();
    f32x4 w2v[4];
#pragma unroll
    for (int j = 0; j < 4; ++j) w2v[j] = ((const f32x4*)norm2_w)[lane + 64 * j];
    const int tpw = T_ / (G * NWAVES);
#pragma unroll 1
    for (int rr = 0; rr < tpw; ++rr) {
        const int t = (wg * NWAVES + wave) * tpw + rr;
        const f32x4* xr = (const f32x4*)(X1 + (size_t)t * DM) + lane;
        f32x4 hv[4]; float ss = 0.f;
#pragma unroll
        for (int j = 0; j < 4; ++j) { hv[j] = xr[64 * j]; ss += (hv[j].x * hv[j].x + hv[j].y * hv[j].y) + (hv[j].z * hv[j].z + hv[j].w * hv[j].w); }
        const float r2 = rsqrtf(wave_sum(ss) * (1.f / DM) + EPS);
        u32x2* o8 = (u32x2*)(H2 + (size_t)t * DM) + lane;
#pragma unroll
        for (int j = 0; j < 4; ++j) { hv[j] = hv[j] * r2 * w2v[j]; u32x2 o; o.x = pk2(hv[j].x, hv[j].y); o.y = pk2(hv[j].z, hv[j].w); o8[64 * j] = o; }
        float lg[36];
#pragma unroll
        for (int c = 0; c < 36; ++c) { float acc = 0.f;
#pragma unroll
            for (int j = 0; j < 4; ++j) { const f32x4 wv = *(const LAS f32x4*)(wl + c * 1024 + 256 * j + 4 * lane); acc += (hv[j].x * wv.x + hv[j].y * wv.y) + (hv[j].z * wv.z + hv[j].w * wv.w); }
            lg[c] = wave_sum(acc); }
        float gl[4];
#pragma unroll
        for (int g = 0; g < 4; ++g) gl[g] = lg[g] + b_group[g];
        int gsel = 0; float gmax = gl[0];
#pragma unroll
        for (int g = 1; g < 4; ++g) if (gl[g] > gmax) { gmax = gl[g]; gsel = g; }
        float gsum = 0.f;
#pragma unroll
        for (int g = 0; g < 4; ++g) gsum += __expf(gl[g] - gmax);
        const float gwt = 1.f / gsum;
        float el[8];
#pragma unroll
        for (int i = 0; i < 8; ++i) el[i] = 0.f;
#pragma unroll
        for (int g = 0; g < 4; ++g) if (gsel == g) {
#pragma unroll
            for (int i = 0; i < 8; ++i) el[i] = lg[4 + 8 * g + i] + b_expert[8 * g + i]; }
        int i1 = 0; float v1 = el[0];
#pragma unroll
        for (int i = 1; i < 8; ++i) if (el[i] > v1) { v1 = el[i]; i1 = i; }
        int i2 = -1; float v2 = -3.0e38f;
#pragma unroll
        for (int i = 0; i < 8; ++i) if (i != i1 && el[i] > v2) { v2 = el[i]; i2 = i; }
        const float p1 = 1.f / (1.f + __expf(v2 - v1)), p2 = 1.f - p1;
        if (lane == 0) {
            const int e1 = gsel * 8 + i1, e2 = gsel * 8 + i2;
            const int r1 = atomicAdd((int*)&hist[e1], 1), r2_ = atomicAdd((int*)&hist[e2], 1);
            ASGE[2 * t] = e1 | (r1 << 8); ASGE[2 * t + 1] = e2 | (r2_ << 8);
            ASGW[2 * t] = gwt * p1; ASGW[2 * t + 1] = gwt * p2;
        }
    }
    __syncthreads();
    if (tid < 32) CNT[wg * 32 + tid] = hist[tid];
}


__device__ __forceinline__ void p4_router_mfma(const Args& a, LAS unsigned char* lds, int tid, int lane, int wave, int wg, int G) {
    unsigned char* ws = a.ws;
    const float* b_group = a.in[18]; const float* b_expert = a.in[20];
    const bf16* X1B = (const bf16*)(ws + WS_H2);
    int* ASGE = (int*)(ws + WS_ASGE); float* ASGW = (float*)(ws + WS_ASGW); int* CNT = (int*)(ws + WS_CTL) + CW_CNT;
    constexpr int WST = 2064, WLO = 36 * WST;
    LAS int* hist = (LAS int*)(lds + LDSCTL_OFF + 128);
    {
        const u32x4* RIMG = (const u32x4*)(ws + WS_RIMG); constexpr int NP = 2 * 36 * WST / 16;
#pragma unroll 1
        for (int base = 0; base < NP; base += 6 * NTHR) {
            u32x4 v[6];
#pragma unroll
            for (int q = 0; q < 6; ++q) { const int i = base + q * NTHR + tid; v[q] = RIMG[i < NP ? i : NP - 1]; }
#pragma unroll
            for (int q = 0; q < 6; ++q) { const int i = base + q * NTHR + tid; if (i < NP) *(LAS u32x4*)(lds + i * 16) = v[q]; }
        }
    }
    if (tid < 32) hist[tid] = 0;
    __syncthreads();
    const int fr = lane & 15, fq = lane >> 4;
    const int t0 = (wg * NWAVES + wave) * 32;
    const bf16* x1a = X1B + (size_t)(t0 + fr) * DM + 8 * fq; const bf16* x1b = x1a + (size_t)16 * DM;
    f32x4 acc[2][3];
#pragma unroll
    for (int tl = 0; tl < 2; ++tl)
#pragma unroll
        for (int nt = 0; nt < 3; ++nt) acc[tl][nt] = (f32x4){0.f, 0.f, 0.f, 0.f};
    float ss0 = 0.f, ss1 = 0.f;
    int wrow[3];
#pragma unroll
    for (int nt = 0; nt < 3; ++nt) { const int c = 16 * nt + fr; wrow[nt] = (c < 36 ? c : 35) * WST + 16 * fq; }
#pragma unroll 1
    for (int kg = 0; kg < 4; ++kg) {
        u32x4 va[8], vb[8];
#pragma unroll
        for (int q = 0; q < 8; ++q) { va[q] = *(const u32x4*)(x1a + 32 * (8 * kg + q)); vb[q] = *(const u32x4*)(x1b + 32 * (8 * kg + q)); }
#pragma unroll
        for (int q = 0; q < 8; ++q) { const int ks = 8 * kg + q; const u32x4 a_ = va[q], b_ = vb[q];
            { const float f0 = bflo(a_.x), f1 = bfhi(a_.x), f2 = bflo(a_.y), f3 = bfhi(a_.y), f4 = bflo(a_.z), f5 = bfhi(a_.z), f6 = bflo(a_.w), f7 = bfhi(a_.w);
              ss0 += (f0 * f0 + f1 * f1) + (f2 * f2 + f3 * f3) + (f4 * f4 + f5 * f5) + (f6 * f6 + f7 * f7); }
            { const float f0 = bflo(b_.x), f1 = bfhi(b_.x), f2 = bflo(b_.y), f3 = bfhi(b_.y), f4 = bflo(b_.z), f5 = bfhi(b_.z), f6 = bflo(b_.w), f7 = bfhi(b_.w);
              ss1 += (f0 * f0 + f1 * f1) + (f2 * f2 + f3 * f3) + (f4 * f4 + f5 * f5) + (f6 * f6 + f7 * f7); }
            const bf16x8 ah[2] = {__builtin_bit_cast(bf16x8, a_), __builtin_bit_cast(bf16x8, b_)};
#pragma unroll
            for (int nt = 0; nt < 3; ++nt) {
                const bf16x8 wh = *(const LAS bf16x8*)(lds + wrow[nt] + ks * 64), wl = *(const LAS bf16x8*)(lds + WLO + wrow[nt] + ks * 64);
#pragma unroll
                for (int tl = 0; tl < 2; ++tl) {
                    acc[tl][nt] = __builtin_amdgcn_mfma_f32_16x16x32_bf16(wh, ah[tl], acc[tl][nt], 0, 0, 0);
                    acc[tl][nt] = __builtin_amdgcn_mfma_f32_16x16x32_bf16(wl, ah[tl], acc[tl][nt], 0, 0, 0); }
            }
        }
    }
    float bg[4], be[32]; int pe_[2][2] = {{0, 0}, {0, 0}}, pr_[2][2] = {{0, 0}, {0, 0}};
#pragma unroll
    for (int g = 0; g < 4; ++g) bg[g] = b_group[g];
#pragma unroll
    for (int i = 0; i < 32; ++i) be[i] = b_expert[i];
#pragma unroll
    for (int tl = 0; tl < 2; ++tl) {
        float ss = tl ? ss1 : ss0; ss += __shfl_xor(ss, 16); ss += __shfl_xor(ss, 32);
        const float r2 = rsqrtf(ss * (1.f / DM) + EPS);
        float lg[36];
#pragma unroll
        for (int nt = 0; nt < 3; ++nt)
#pragma unroll
            for (int q = 0; q < 4; ++q)
#pragma unroll
                for (int j = 0; j < 4; ++j) { const int c = 16 * nt + 4 * q + j; if (c < 36) lg[c] = __shfl(acc[tl][nt][j], fr + 16 * q) * r2; }
        float gl[4];
#pragma unroll
        for (int g = 0; g < 4; ++g) gl[g] = lg[g] + bg[g];
        int gsel = 0; float gmax = gl[0];
#pragma unroll
        for (int g = 1; g < 4; ++g) if (gl[g] > gmax) { gmax = gl[g]; gsel = g; }
        float gsum = 0.f;
#pragma unroll
        for (int g = 0; g < 4; ++g) gsum += __expf(gl[g] - gmax);
        const float gwt = 1.f / gsum;
        float el[8];
#pragma unroll
        for (int i = 0; i < 8; ++i) el[i] = 0.f;
#pragma unroll
        for (int g = 0; g < 4; ++g) if (gsel == g) {
#pragma unroll
            for (int i = 0; i < 8; ++i) el[i] = lg[4 + 8 * g + i] + be[8 * g + i]; }
        int i1 = 0; float v1 = el[0];
#pragma unroll
        for (int i = 1; i < 8; ++i) if (el[i] > v1) { v1 = el[i]; i1 = i; }
        int i2 = -1; float v2 = -3.0e38f;
#pragma unroll
        for (int i = 0; i < 8; ++i) if (i != i1 && el[i] > v2) { v2 = el[i]; i2 = i; }
        const float p1 = 1.f / (1.f + __expf(v2 - v1)), p2 = 1.f - p1;
        if (fq == 0) {
            const int t = t0 + 16 * tl + fr;
            const int e1 = gsel * 8 + i1, e2 = gsel * 8 + i2;
            const int r1 = atomicAdd((int*)&hist[e1], 1), r2_ = atomicAdd((int*)&hist[e2], 1);
            pe_[tl][0] = e1; pe_[tl][1] = e2; pr_[tl][0] = r1; pr_[tl][1] = r2_;
            ASGW[2 * t] = gwt * p1; ASGW[2 * t + 1] = gwt * p2;
            ASGW[2 * T_ + 2 * t] = r2; ASGW[2 * T_ + 2 * t + 1] = r2;
        }
    }
    __syncthreads();
    LAS int* lbase = hist + 32;
    if (tid < 32) lbase[tid] = atomicAdd((int*)(ws + WS_CTL) + CW_CUR + 64 * tid, hist[tid]);
    __syncthreads();
    if (fq == 0) { int* LIST = (int*)(ws + WS_LIST);
#pragma unroll
        for (int tl = 0; tl < 2; ++tl) { const int t = t0 + 16 * tl + fr;
#pragma unroll
            for (int k = 0; k < 2; ++k) { const int e = pe_[tl][k], ii = lbase[e] + pr_[tl][k]; LIST[(size_t)e * LCAP + ii] = 2 * t + k; ASGE[2 * t + k] = e | (ii << 8); } } }
}

__device__ __forceinline__ void p5_dispatch(const Args& a, LAS unsigned char* lds, int tid, int wg, int G) {
    unsigned char* ws = a.ws;
    const int* ASGE = (const int*)(ws + WS_ASGE); const float* ASGW = (const float*)(ws + WS_ASGW); const int* CNT = (const int*)(ws + WS_CTL) + CW_CNT;
    int* META = (int*)(ws + WS_CTL) + CW_META; int* ROWTOK = (int*)(ws + WS_ROWTOK); float* ROWW = (float*)(ws + WS_ROWW); float* ROWR = (float*)(ws + WS_GATES); int* POSA = (int*)(ws + WS_POSA);
    LAS int* tot = (LAS int*)lds; LAS int* pre = tot + 32; LAS int* pst = pre + 32;
    {
        LAS int* part = pst + 64;
        const int e = tid & 31, j = tid >> 5; int total = 0, prefix = 0;
#pragma unroll
        for (int q = 0; q < 16; ++q) { const int w = 16 * j + q; const int c = (w < G) ? CNT[w * 32 + e] : 0; total += c; prefix += (w < wg) ? c : 0; }
        part[j * 32 + e] = total; part[512 + j * 32 + e] = prefix;
        __syncthreads();
        if (tid < 32) { int t2 = 0, p2 = 0;
#pragma unroll
            for (int q = 0; q < 16; ++q) { t2 += part[q * 32 + tid]; p2 += part[512 + q * 32 + tid]; }
            tot[tid] = t2; pre[tid] = p2; }
    }
    __syncthreads();
    if (tid == 0) { int s = 0; for (int e = 0; e < 32; ++e) { pst[e] = s; s += (tot[e] + 255) & ~255; } pst[32] = s; }
    __syncthreads();
    if (wg == 0 && tid <= 32) META[tid] = pst[tid];
    const int apw = 2 * T_ / G;
    for (int q = tid; q < apw; q += NTHR) { const int idx = wg * apw + q; const int ev = ASGE[idx], e = ev & 255, rank = ev >> 8; const int pos = pst[e] + pre[e] + rank; ROWTOK[pos] = idx; ROWW[pos] = ASGW[idx]; ROWR[pos] = ASGW[2 * T_ + idx]; POSA[idx] = pos; }
    if (wg < 32) { const int e = wg; for (int p = pst[e] + tot[e] + tid; p < pst[e + 1]; p += NTHR) { ROWTOK[p] = -1; ROWW[p] = 0.f; ROWR[p] = 0.f; } }
}

__device__ __forceinline__ int expert_of_row(const LAS int* pst, int row) { int e = 0;
#pragma unroll 1
    for (int i = 1; i < 32; ++i) e += (pst[i] <= row) ? 1 : 0;
    return e; }

__device__ __forceinline__ void unpack8(const u32x4 v, float (&f)[8]) { f[0] = bflo(v.x); f[1] = bfhi(v.x); f[2] = bflo(v.y); f[3] = bfhi(v.y); f[4] = bflo(v.z); f[5] = bfhi(v.z); f[6] = bflo(v.w); f[7] = bfhi(v.w); }
__device__ __forceinline__ void p6_naive(const Args& a, LAS unsigned char* lds, int tid, int wg, int G) {
    unsigned char* ws = a.ws;
    const int* META = (const int*)(ws + WS_CTL) + CW_META; const int* ROWTOK = (const int*)(ws + WS_ROWTOK);
    const bf16* H2 = (const bf16*)(ws + WS_H2); const bf16* WGU = (const bf16*)(ws + WS_WGU); bf16* HID = (bf16*)(ws + WS_HID);
    LAS int* pst = (LAS int*)lds;
    if (tid <= 32) pst[tid] = META[tid];
    __syncthreads();
    const int npad = pst[32], ntile = (npad / 64) * 8, rg = tid >> 5, cg = tid & 31;
    for (int tile = wg; tile < ntile; tile += G) {
        const int rt = tile >> 3, ct = tile & 7, e = expert_of_row(pst, rt * 64);
        const bf16* ar[4];
#pragma unroll
        for (int i = 0; i < 4; ++i) { const int tk = ROWTOK[rt * 64 + rg * 4 + i]; ar[i] = H2 + (size_t)(tk < 0 ? 0 : (tk >> 1)) * DM; }
        const int c0 = ct * 64 + cg * 2;
        const bf16* bg[2]; const bf16* bu[2];
#pragma unroll
        for (int j = 0; j < 2; ++j) { const int c = c0 + j; bg[j] = WGU + ((size_t)e * 1024 + (c >> 7) * 256 + (c & 127)) * 1024; bu[j] = bg[j] + 128 * 1024; }
        float g[4][2], u[4][2];
#pragma unroll
        for (int i = 0; i < 4; ++i)
#pragma unroll
            for (int j = 0; j < 2; ++j) { g[i][j] = 0.f; u[i][j] = 0.f; }
#pragma unroll 1
        for (int k = 0; k < 1024; k += 8) {
            float af[4][8], gf[2][8], uf[2][8];
#pragma unroll
            for (int i = 0; i < 4; ++i) unpack8(*(const u32x4*)(ar[i] + k), af[i]);
#pragma unroll
            for (int j = 0; j < 2; ++j) { unpack8(*(const u32x4*)(bg[j] + k), gf[j]); unpack8(*(const u32x4*)(bu[j] + k), uf[j]); }
#pragma unroll
            for (int i = 0; i < 4; ++i)
#pragma unroll
                for (int j = 0; j < 2; ++j)
#pragma unroll
                    for (int q = 0; q < 8; ++q) { g[i][j] += af[i][q] * gf[j][q]; u[i][j] += af[i][q] * uf[j][q]; }
        }
#pragma unroll
        for (int i = 0; i < 4; ++i) *(unsigned*)(HID + (size_t)(rt * 64 + rg * 4 + i) * DEXP + c0) = pk2(siluf_(g[i][0]) * u[i][0], siluf_(g[i][1]) * u[i][1]);
    }
}

__device__ __forceinline__ void p7_naive(const Args& a, LAS unsigned char* lds, int tid, int wg, int G) {
    unsigned char* ws = a.ws;
    const int* META = (const int*)(ws + WS_CTL) + CW_META; const int* ROWTOK = (const int*)(ws + WS_ROWTOK); const float* ROWW = (const float*)(ws + WS_ROWW);
    const bf16* HID = (const bf16*)(ws + WS_HID); const bf16* WD = (const bf16*)(ws + WS_WD); bf16* YBUF = (bf16*)(ws + WS_YBUF);
    LAS int* pst = (LAS int*)lds;
    if (tid <= 32) pst[tid] = META[tid];
    __syncthreads();
    const int npad = pst[32], ntile = (npad / 64) * 8, rg = tid >> 5, cg = tid & 31;
    for (int tile = wg; tile < ntile; tile += G) {
        const int rt = tile >> 3, ct = tile & 7, e = expert_of_row(pst, rt * 64);
        const bf16* ar[4]; const bf16* br[4];
#pragma unroll
        for (int i = 0; i < 4; ++i) ar[i] = HID + (size_t)(rt * 64 + rg * 4 + i) * DEXP;
        const int c0 = ct * 128 + cg * 4;
#pragma unroll
        for (int j = 0; j < 4; ++j) br[j] = WD + ((size_t)e * 1024 + c0 + j) * DEXP;
        float acc[4][4];
#pragma unroll
        for (int i = 0; i < 4; ++i)
#pragma unroll
            for (int j = 0; j < 4; ++j) acc[i][j] = 0.f;
#pragma unroll 1
        for (int k = 0; k < DEXP; k += 8) {
            float af[4][8], bfv[4][8];
#pragma unroll
            for (int i = 0; i < 4; ++i) { unpack8(*(const u32x4*)(ar[i] + k), af[i]); unpack8(*(const u32x4*)(br[i] + k), bfv[i]); }
#pragma unroll
            for (int i = 0; i < 4; ++i)
#pragma unroll
                for (int j = 0; j < 4; ++j)
#pragma unroll
                    for (int q = 0; q < 8; ++q) acc[i][j] += af[i][q] * bfv[j][q];
        }
#pragma unroll
        for (int i = 0; i < 4; ++i) { const int pos = rt * 64 + rg * 4 + i; const int tk = ROWTOK[pos];
            if (tk >= 0) { const float w = ROWW[pos]; const int t = tk >> 1, kk = tk & 1;
                u32x2 o; o.x = pk2(acc[i][0] * w, acc[i][1] * w); o.y = pk2(acc[i][2] * w, acc[i][3] * w);
                *(u32x2*)(YBUF + ((size_t)kk * T_ + t) * DM + c0) = o; } }
    }
}

__device__ __forceinline__ void p8_combine(const Args& a, int tid, int wg, int G) {
    const unsigned char* Y = a.ws + WS_YBUF; const bf16* X1B = (const bf16*)(a.ws + WS_H2); float* O = a.out;
    const int* POSA = (const int*)(a.ws + WS_POSA); const float* ASGW = (const float*)(a.ws + WS_ASGW);
    const int lane = tid & 63, gw = wg * NWAVES + __builtin_amdgcn_readfirstlane(tid >> 6), NGW = G * NWAVES;
    u32x4 xb[2]; u32x2 y0[2], y1[2]; float w0 = 0.f, w1 = 0.f;
#define P8_LOAD(t_) do { const int t__ = __builtin_amdgcn_readfirstlane(t_); const int p0_ = POSA[2 * t__], p1_ = POSA[2 * t__ + 1]; w0 = ASGW[2 * t__]; w1 = ASGW[2 * t__ + 1]; \
        _Pragma("unroll") for (int q = 0; q < 2; ++q) { xb[q] = *(const u32x4*)(X1B + (size_t)t__ * DM + (lane + 64 * q) * 8); y0[q] = *(const u32x2*)(Y + (size_t)p0_ * DM + (lane + 64 * q) * 8); \
            y1[q] = *(const u32x2*)(Y + (size_t)p1_ * DM + (lane + 64 * q) * 8); } } while (0)
#define P8_F8(w_, i_) __builtin_amdgcn_cvt_f32_fp8((int)(w_), (i_))
    P8_LOAD(gw);
#pragma unroll 1
    for (int t = gw; t < T_; t += NGW) {
        u32x4 cx[2]; u32x2 c0[2], c1[2]; const float cw0 = w0, cw1 = w1;
#pragma unroll
        for (int q = 0; q < 2; ++q) { cx[q] = xb[q]; c0[q] = y0[q]; c1[q] = y1[q]; }
        if (t + NGW < T_) P8_LOAD(t + NGW);
#pragma unroll
        for (int q = 0; q < 2; ++q) {
            f32x4 a0, a1;
            a0.x = bflo(cx[q].x) + cw0 * P8_F8(c0[q].x, 0) + cw1 * P8_F8(c1[q].x, 0); a0.y = bfhi(cx[q].x) + cw0 * P8_F8(c0[q].x, 1) + cw1 * P8_F8(c1[q].x, 1);
            a0.z = bflo(cx[q].y) + cw0 * P8_F8(c0[q].x, 2) + cw1 * P8_F8(c1[q].x, 2); a0.w = bfhi(cx[q].y) + cw0 * P8_F8(c0[q].x, 3) + cw1 * P8_F8(c1[q].x, 3);
            a1.x = bflo(cx[q].z) + cw0 * P8_F8(c0[q].y, 0) + cw1 * P8_F8(c1[q].y, 0); a1.y = bfhi(cx[q].z) + cw0 * P8_F8(c0[q].y, 1) + cw1 * P8_F8(c1[q].y, 1);
            a1.z = bflo(cx[q].w) + cw0 * P8_F8(c0[q].y, 2) + cw1 * P8_F8(c1[q].y, 2); a1.w = bfhi(cx[q].w) + cw0 * P8_F8(c0[q].y, 3) + cw1 * P8_F8(c1[q].y, 3);
            float* op = O + (size_t)t * DM + (lane + 64 * q) * 8;
            *(f32x4*)op = a0; *(f32x4*)(op + 4) = a1;
        }
    }
#undef P8_LOAD
#undef P8_F8
}

#ifndef STAGGER_P1
#define STAGGER_P1 700
#endif
#ifndef STAGGER_P6
#define STAGGER_P6 0
#endif
#ifndef STAGGER_P7
#define STAGGER_P7 0
#endif
__device__ __forceinline__ void phase_stagger(unsigned ticks) {
    const unsigned g = blockIdx.x & 3u;
    if (g != 0u && ticks != 0u) { const unsigned long long t0 = __builtin_amdgcn_s_memrealtime(); while (__builtin_amdgcn_s_memrealtime() - t0 < (unsigned long long)(g * ticks)) __builtin_amdgcn_s_sleep(16); }
}

__device__ __forceinline__ void p6_gemm(const Args& a, LAS unsigned char* lds, int tid, int wg, int G) {
    unsigned char* ws = a.ws;
    LAS int* pst = (LAS int*)(lds + 131072); LAS int* tot = pst + 64;
    if (tid < 32) tot[tid] = ((const int*)(ws + WS_CTL) + CW_CUR)[64 * tid];
    __syncthreads();
    if (tid == 0) { int s_ = 0; for (int e = 0; e < 32; ++e) { pst[e] = s_; s_ += (tot[e] + 255) & ~255; } pst[32] = s_; }
    __syncthreads();
    {
        const int* ASGE = (const int*)(ws + WS_ASGE); int* POSA = (int*)(ws + WS_POSA); const int idx = wg * (2 * T_ / G) + tid;
        if (tid < 2 * T_ / G) { const int ev = ASGE[idx]; POSA[idx] = pst[ev & 255] + (ev >> 8); }
    }
    pg8::MoeGuSched S; S.o.init(pst[32] / 256, 4, G, wg); S.A = (const char*)(ws + WS_X1F); S.Bt = (const char*)(ws + WS_WGU); S.rowtok = (const int*)(ws + WS_ROWTOK); S.pst = pst; S.K = DM / 2;
    LAS int* ltok = (LAS int*)(lds + 131584); LAS float* lrowr = (LAS float*)(lds + 131584 + 9 * 256 * 4);
    {
        const int* LIST = (const int*)(ws + WS_LIST); const float* R2 = (const float*)(ws + WS_ASGW) + 2 * T_;
        int tv[9]; float rv[9]; bool ok[9];
#pragma unroll
        for (int i = 0; i < 9; ++i) { int pm, pn; ok[i] = S.o.map(i, pm, pn); tv[i] = -1; rv[i] = 0.f;
            if (ok[i] && tid < 256) { const int e = pg8::expert_of_row_l(pst, pm * 256), ii = pm * 256 + tid - pst[e]; if (ii < tot[e]) tv[i] = LIST[(size_t)e * LCAP + ii]; } }
#pragma unroll
        for (int i = 0; i < 9; ++i) if (tv[i] >= 0) rv[i] = R2[tv[i]];
#pragma unroll
        for (int i = 0; i < 9; ++i) if (ok[i] && tid < 256) { ltok[i * 256 + tid] = tv[i]; lrowr[i * 256 + tid] = rv[i]; }
        __syncthreads();
    }
    S.ltok = ltok;
    pg8::EpiSwiglu E{(bf16*)(ws + WS_HID), lrowr};
    phase_stagger(STAGGER_P6);
    pg8::gemm_phase<pg8::EpiSwiglu, pg8::MoeGuSched, true, true>(lds, DM / 2, S, E);
}
__device__ __forceinline__ void p7_gemm(const Args& a, LAS unsigned char* lds, int tid, int wg, int G) {
    unsigned char* ws = a.ws;
    LAS int* pst = (LAS int*)(lds + 131072); LAS int* tot = pst + 64;
    if (tid < 32) tot[tid] = ((const int*)(ws + WS_CTL) + CW_CUR)[64 * tid];
    __syncthreads();
    if (tid == 0) { int s_ = 0; for (int e = 0; e < 32; ++e) { pst[e] = s_; s_ += (tot[e] + 255) & ~255; } pst[32] = s_; }
    __syncthreads();
    pg8::MoeDownSched S; S.o.init(pst[32] / 256, 4, G, wg); S.A = (const char*)(ws + WS_HID); S.Bt = (const char*)(ws + WS_WD); S.pst = pst; S.K = DEXP / 2;
    pg8::EpiF8 E{ws + WS_YBUF, DM};
    phase_stagger(STAGGER_P7);
    pg8::gemm_phase<pg8::EpiF8, pg8::MoeDownSched, true, true>(lds, DEXP / 2, S, E);
}

__global__ void __launch_bounds__(NTHR, 2) fwd(Args args) {
    extern __shared__ __attribute__((aligned(16))) unsigned char lds_raw[];
    LAS unsigned char* lds = (LAS unsigned char*)lds_raw;
    const int tid0 = threadIdx.x, wg = blockIdx.x, G = gridDim.x;
#define PH_TID() int tid = threadIdx.x; asm volatile("" : "+v"(tid)); const int lane = tid & 63, wave = __builtin_amdgcn_readfirstlane(tid >> 6); (void)lane; (void)wave
    unsigned char* ws = args.ws;
    unsigned* ctl = (unsigned*)(ws + WS_CTL);
    for (int u = tid0; u < 256; u += NTHR) ((LAS unsigned*)(lds + LDSCTL_OFF))[u] = 0u;
    __syncthreads();
    const int lo = args.ph_lo, hi = args.ph_hi;
    XcdBarrier bar = xcd_barrier_post(ctl + CW_BAR, (volatile LAS unsigned*)(lds + LDSCTL_OFF));
#define IN(k) (lo <= (k) && (k) < hi)
#ifndef PROBE_PHASE
#define PROBE_PHASE -1
#endif
#define REPS(k) ((PROBE_PHASE == (k)) ? 2 : 1)
#define REPSEP(k) do { if (rep + 1 < REPS(k)) xcd_barrier(bar); } while (0)
#define SEAM(k) do { if (IN(k) && IN((k) + 1)) xcd_barrier(bar); } while (0)

    if (IN(0)) { for (int rep = 0; rep < REPS(0); ++rep) { PH_TID(); p0_prologue(args, lds, tid, lane, wave, wg, G);  REPSEP(0); } }
    SEAM(0);
    if (IN(1)) { for (int rep = 0; rep < REPS(1); ++rep) {
        pg8::DenseSched S; S.o.init(T_ / 256, NCOL / 256, G, wg); S.A = (const char*)(ws + WS_H1); S.Bt = (const char*)(ws + WS_W1T); S.K = DM;
        LAS float* lrs = (LAS float*)(lds + 131584);
        { PH_TID(); const float* R1 = (const float*)(ws + WS_R1);
#pragma unroll 1
          for (int i = 0; i < 14; ++i) { int pm, pn; if (S.o.map(i, pm, pn) && tid < 256) lrs[i * 256 + tid] = R1[pm * 256 + tid]; } }
        pg8::EpiProj E{(bf16*)(ws + WS_PROJ), NCOL, args.in[8], args.in[9], lrs};
        { PH_TID(); p1_stagger_work(args, lds, lane, wave, wg); }
        asm volatile("s_waitcnt vmcnt(0) lgkmcnt(0)" ::: "memory"); __syncthreads();
        pg8::gemm_phase<pg8::EpiProj, pg8::DenseSched, true>(lds, DM, S, E);
     REPSEP(1); } }
    SEAM(1);
    if (IN(2)) { for (int rep = 0; rep < REPS(2); ++rep) { { PH_TID(); if (wg < NBATCH * 4 || PROBE_PHASE == 23) { ml::mlstm_item(args, lds, wg & 127, tid); } } __syncthreads(); { PH_TID(); p2_fast_attn(args, lds, tid, lane, wave, wg, G, rep); if (PROBE_PHASE == 21) { __syncthreads(); p2_fast_attn(args, lds, tid, lane, wave, wg, G, 1); } }  REPSEP(2); } }
    SEAM(2);
    if (IN(3)) { for (int rep = 0; rep < REPS(3); ++rep) {
        pg8::DenseSched S; S.o.init(T_ / 256, DM / 256, G, wg); S.A = (const char*)(ws + WS_MIX); S.Bt = (const char*)(ws + WS_W2T); S.K = DM;
        pg8::EpiX1 E{(const bf16*)(ws + WS_H1), (bf16*)(ws + WS_H2), ws + WS_X1F, DM};
        pg8::gemm_phase<pg8::EpiX1, pg8::DenseSched, true>(lds, DM, S, E);
     REPSEP(3); } }
    SEAM(3);
    if (IN(4)) { for (int rep = 0; rep < REPS(4); ++rep) { PH_TID(); p4_router_mfma(args, lds, tid, lane, wave, wg, G);  REPSEP(4); } }
    SEAM(4);
    if (IN(6)) { for (int rep = 0; rep < REPS(6); ++rep) { PH_TID(); p6_gemm(args, lds, tid, wg, G);  REPSEP(6); } }
    SEAM(6);
    if (IN(7)) { for (int rep = 0; rep < REPS(7); ++rep) { PH_TID(); p7_gemm(args, lds, tid, wg, G);  REPSEP(7); } }
    SEAM(7);
    if (IN(8)) { PH_TID(); p8_combine(args, tid, wg, G); }
#undef IN
#undef SEAM
}

#ifndef MK_N_LAUNCHES
#define MK_N_LAUNCHES 1
#endif
extern "C" void kernel_launch(void* const* d_in, const int* in_sizes, int n_in, void* d_out, int out_size, void* d_ws, size_t ws_size, hipStream_t stream) {
    static int grid = 0;
    if (grid == 0) {
        if (n_in != 24 || in_sizes[0] != T_ * DM || out_size != T_ * DM || ws_size < WS_END) { fprintf(stderr, "kernel_launch: unexpected shapes (n_in %d, in0 %d, out %d, ws %zu); nothing launched\n", n_in, n_in > 0 ? in_sizes[0] : -1, out_size, ws_size); grid = -1; return; }
        int dev = 0, cus = 0, per_cu = 0;
        if (hipGetDevice(&dev) != hipSuccess || hipDeviceGetAttribute(&cus, hipDeviceAttributeMultiprocessorCount, dev) != hipSuccess) { grid = -1; return; }
        if (hipFuncSetAttribute((const void*)fwd, hipFuncAttributeMaxDynamicSharedMemorySize, LDS_BYTES) != hipSuccess) { fprintf(stderr, "kernel_launch: hipFuncSetAttribute failed\n"); grid = -1; return; }
        if (hipOccupancyMaxActiveBlocksPerMultiprocessor(&per_cu, (const void*)fwd, NTHR, LDS_BYTES) != hipSuccess || per_cu < 1) fprintf(stderr, "kernel_launch: occupancy query reports %d\n", per_cu);
        (void)hipGetLastError();
        grid = cus;
        if (grid != 256) { fprintf(stderr, "kernel_launch: built for 256 CUs, found %d; nothing launched\n", cus); grid = -1; return; }
    }
    if (grid < 0) return;
    if (hipMemsetAsync((char*)d_ws + WS_CTL, 0, CTL_ZERO_BYTES, stream) != hipSuccess) return;
    Args a{};
    for (int i = 0; i < 24; ++i) a.in[i] = (const float*)d_in[i];
    a.out = (float*)d_out; a.ws = (unsigned char*)d_ws;
    if (MK_N_LAUNCHES == 1) { a.ph_lo = 0; a.ph_hi = 9; hipLaunchKernelGGL(fwd, dim3(grid), dim3(NTHR), LDS_BYTES, stream, a); }
    else { for (int p = 0; p < 9; ++p) { a.ph_lo = p; a.ph_hi = p + 1; hipLaunchKernelGGL(fwd, dim3(grid), dim3(NTHR), LDS_BYTES, stream, a); } }
    const hipError_t le = hipPeekAtLastError();
    if (le != hipSuccess) fprintf(stderr, "kernel_launch: launch failed: %s\n", hipGetErrorName(le));
}
```

```cpp
#include <hip/hip_runtime.h>
#include <cstdio>
#include <cstdint>

#define GAS __attribute__((address_space(1)))
#define LAS __attribute__((address_space(3)))
typedef unsigned short bf16;
typedef unsigned u32x4 __attribute__((ext_vector_type(4)));
typedef unsigned u32x2 __attribute__((ext_vector_type(2)));
typedef float f32x4 __attribute__((ext_vector_type(4)));
typedef float f32x2 __attribute__((ext_vector_type(2)));
typedef short bf16x8 __attribute__((ext_vector_type(8)));

constexpr int T_ = 65536, DM = 1024, SEQ = 2048, NBATCH = 32, NCOL = 3584, INCOLS = 3592;
constexpr int C_MQ = 0, C_MK = 512, C_MV = 1024, C_MO = 1536, C_AQ = 2048, C_AK = 2560, C_AV = 3072;
constexpr int NEXP = 32, DEXP = 512, PMAX = 131072 + NEXP * 256;
constexpr float EPS = 1e-6f;
constexpr float LAMBDA_INIT = 0.2f;
constexpr int NWAVES = 8, NTHR = 512;

constexpr size_t MiB = 1u << 20;
constexpr size_t WS_CTL = 0, CTL_ZERO_BYTES = 64 * 1024;
constexpr size_t WS_W1T = 1 * MiB, WS_W2T = 8 * MiB, WS_WGU = 10 * MiB, WS_WD = 74 * MiB, WS_GATES = 106 * MiB;
constexpr size_t WS_ASGE = 108 * MiB, WS_ASGW = 109 * MiB, WS_ROWTOK = 110 * MiB, WS_ROWW = 111 * MiB;
constexpr size_t WS_H1 = 112 * MiB, WS_MIX = 240 * MiB, WS_PROJ = 368 * MiB, WS_END = 816 * MiB;
constexpr size_t WS_YBUF = 112 * MiB;
constexpr size_t WS_H2 = 384 * MiB, WS_HID = 512 * MiB;
constexpr size_t WS_MO = 112 * MiB;
constexpr size_t WS_X1F = 584 * MiB;
constexpr size_t WS_RIMG = 111 * MiB + 768 * 1024;
constexpr size_t WS_POSA = 108 * MiB + 512 * 1024;
constexpr int CW_BAR = 4096, CW_QUEUE = 8192, CW_CNT = 16384, CW_META = 32768;
constexpr size_t WS_R1 = 100 * MiB;
constexpr int CW_CUR = 12288;
constexpr size_t WS_LIST = 700 * MiB; constexpr int LCAP = 2 * 65536;

constexpr int LDS_SCRATCH = 155648;
constexpr int LDSCTL_OFF = LDS_SCRATCH;
constexpr int LDS_BYTES = LDS_SCRATCH + 1024;

__device__ __forceinline__ unsigned f2bf(float f) { unsigned u = __builtin_bit_cast(unsigned, f); return (u + 0x7fffu + ((u >> 16) & 1u)) >> 16; }
__device__ __forceinline__ unsigned pk2(float lo, float hi) { return f2bf(lo) | (f2bf(hi) << 16); }
__device__ __forceinline__ float bf2f(bf16 v) { return __uint_as_float(((unsigned)v) << 16); }
__device__ __forceinline__ float bflo(unsigned u) { return __uint_as_float(u << 16); }
__device__ __forceinline__ float bfhi(unsigned u) { return __uint_as_float(u & 0xffff0000u); }
__device__ __forceinline__ float wave_sum(float v) {
#pragma unroll
    for (int o = 1; o < 64; o <<= 1) v += __shfl_xor(v, o);
    return v;
}
__device__ __forceinline__ float wave_max(float v) {
#pragma unroll
    for (int o = 1; o < 64; o <<= 1) v = fmaxf(v, __shfl_xor(v, o));
    return v;
}
__device__ __forceinline__ float sigmoidf_(float x) { return 1.f / (1.f + __expf(-x)); }
__device__ __forceinline__ float siluf_(float x) { return x / (1.f + __expf(-x)); }
__device__ __forceinline__ unsigned pk4_fp8(float a, float b, float c, float d) { int w = 0; w = __builtin_amdgcn_cvt_pk_fp8_f32(a, b, w, false); w = __builtin_amdgcn_cvt_pk_fp8_f32(c, d, w, true); return (unsigned)w; }
#define LDS_WAIT() asm volatile("s_waitcnt lgkmcnt(0)" ::: "memory")
#define VM_WAIT() asm volatile("s_waitcnt vmcnt(0)" ::: "memory")

namespace pg8 {
#define PG8_LAS __attribute__((address_space(3)))
constexpr int BM = 256, BK = 64, HALF = 128, HTB = HALF * BK * 2, STAGE_BYTES = 8 * HTB, NXCD = 8, WGM = 4;
__host__ __device__ __forceinline__ int lds_byte(int r, int c) { const int st = (r >> 4) * 2 + (c >> 5), rr = r & 15, cc = c & 31, ob = rr * 64 + cc * 2; return st * 1024 + (ob ^ (((ob >> 9) & 1) << 5)); }
__host__ __device__ __forceinline__ void stage_rc(int b, int& R, int& C) { const int st = b / 1024, sb = b % 1024, swz = sb ^ (((sb >> 9) & 1) << 5); R = (st >> 1) * 16 + swz / 64; C = (st & 1) * 32 + (swz % 64) / 2; }
__host__ __device__ __forceinline__ int perm32(int rho) { const int n = rho >> 4, i = rho & 15; return 8 * (i >> 2) + 4 * n + (i & 3); }

struct Unit { int pm, pn, e, li; };
struct TileOrder {
    int nM, nN, nwg, G, c;
    __device__ __forceinline__ void init(int nM_, int nN_, int G_, int c_) { nM = nM_; nN = nN_; nwg = nM * nN; G = G_; c = c_; }
    __device__ __forceinline__ bool map(int i, int& pm, int& pn) const {
        const long L = (long)i * G + c; if (L >= nwg) return false;
        int wgid = (int)L; { const int q = nwg / NXCD, r = nwg % NXCD, xcd = wgid % NXCD, off = wgid / NXCD; wgid = (xcd < r ? xcd * (q + 1) : r * (q + 1) + (xcd - r) * q) + off; }
        const int nig = WGM * nN, gid = wgid / nig, fm = gid * WGM, gsz = (nM - fm) < WGM ? (nM - fm) : WGM;
        pm = fm + ((wgid % nig) % gsz); pn = (wgid % nig) / gsz; return true;
    }
};
struct DenseSched {
    static constexpr bool GATHER = false;
    TileOrder o; const char* A; const char* Bt; int K;
    __device__ __forceinline__ bool next(int i, Unit& u) const { u.e = 0; u.li = i; return o.map(i, u.pm, u.pn); }
    __device__ __forceinline__ const char* a_base(const Unit& u) const { return A + (size_t)u.pm * BM * K * 2; }
    __device__ __forceinline__ const char* b_base(const Unit& u) const { return Bt + (size_t)u.pn * BM * K * 2; }
    __device__ __forceinline__ void a_voff(const Unit&, const int (&R)[2], const int (&C)[2], unsigned (&v)[2][2]) const {
#pragma unroll
        for (int h = 0; h < 2; ++h)
#pragma unroll
            for (int i = 0; i < 2; ++i) v[h][i] = (unsigned)((h * HALF + R[i]) * K + C[i]) * 2u;
    }
};

__device__ __forceinline__ unsigned cvt_pk_bf16(float lo, float hi) { unsigned r; asm volatile("v_cvt_pk_bf16_f32 %0, %1, %2" : "=v"(r) : "v"(lo), "v"(hi)); return r; }

struct EpiBf16 {
    static constexpr bool PERM = true;
    bf16* O; int ldc;
    __device__ __forceinline__ void operator()(const f32x4 (&acc)[2][2][4][2], const Unit& u, int wr, int wc, int fr, int fq) const {
        const int row0 = u.pm * BM + wr * 64 + fr, col0 = u.pn * BM + wc * 32 + 8 * fq;
#pragma unroll
        for (int ai = 0; ai < 2; ++ai)
#pragma unroll
            for (int m = 0; m < 4; ++m) { bf16* rowp = O + (size_t)(row0 + ai * HALF + m * 16) * ldc + col0;
#pragma unroll
                for (int bj = 0; bj < 2; ++bj) { const f32x4 v0 = acc[ai][bj][m][0], v1 = acc[ai][bj][m][1];
                    u32x4 w; w.x = cvt_pk_bf16(v0[0], v0[1]); w.y = cvt_pk_bf16(v0[2], v0[3]); w.z = cvt_pk_bf16(v1[0], v1[1]); w.w = cvt_pk_bf16(v1[2], v1[3]);
                    *(u32x4*)(rowp + bj * HALF) = w; } }
    }
};
struct EpiF8 {
    static constexpr bool PERM = true;
    unsigned char* O; int ldc;
    __device__ __forceinline__ void operator()(const f32x4 (&acc)[2][2][4][2], const Unit& u, int wr, int wc, int fr, int fq) const {
        const int row0 = u.pm * BM + wr * 64 + fr, col0 = u.pn * BM + wc * 32 + 8 * fq;
#pragma unroll
        for (int ai = 0; ai < 2; ++ai)
#pragma unroll
            for (int m = 0; m < 4; ++m) { unsigned char* rowp = O + (size_t)(row0 + ai * HALF + m * 16) * ldc + col0;
#pragma unroll
                for (int bj = 0; bj < 2; ++bj) { const f32x4 v0 = acc[ai][bj][m][0], v1 = acc[ai][bj][m][1];
                    u32x2 w; w.x = pk4_fp8(v0[0], v0[1], v0[2], v0[3]); w.y = pk4_fp8(v1[0], v1[1], v1[2], v1[3]);
                    *(u32x2*)(rowp + bj * HALF) = w; } }
    }
};
struct EpiProj {
    static constexpr bool PERM = true;
    bf16* O; int ldc; const float* qw; const float* kw; const PG8_LAS float* rs;
    __device__ __forceinline__ void operator()(const f32x4 (&acc)[2][2][4][2], const Unit& u, int wr, int wc, int fr, int fq) const {
        const int row0 = u.pm * BM + wr * 64 + fr;
        if (u.pn >= 8 && u.pn < 12) {
            const float* wsrc = (u.pn < 10) ? qw : kw; const float post = (u.pn < 10) ? 0.18033688011112042f : 1.0f;
            f32x4 wv[2][2];
#pragma unroll
            for (int bj = 0; bj < 2; ++bj)
#pragma unroll
                for (int n = 0; n < 2; ++n) wv[bj][n] = *(const f32x4*)(wsrc + 32 * bj + 8 * fq + 4 * n) * post;
            const int col0 = u.pn * BM + wc * 64 + 8 * fq;
#pragma unroll
            for (int ai = 0; ai < 2; ++ai)
#pragma unroll
                for (int m = 0; m < 4; ++m) {
                    float ss = 0.f;
#pragma unroll
                    for (int bj = 0; bj < 2; ++bj)
#pragma unroll
                        for (int n = 0; n < 2; ++n) { const f32x4 x = acc[ai][bj][m][n]; ss += (x[0] * x[0] + x[1] * x[1]) + (x[2] * x[2] + x[3] * x[3]); }
                    ss += __shfl_xor(ss, 16); ss += __shfl_xor(ss, 32);
                    const float r1 = rs[u.li * BM + wr * 64 + fr + ai * HALF + m * 16];
                    const float r = rsqrtf(ss * (r1 * r1) * (1.f / 64.f) + 1e-6f) * r1;
                    bf16* rowp = O + (size_t)(row0 + ai * HALF + m * 16) * ldc + col0;
#pragma unroll
                    for (int bj = 0; bj < 2; ++bj) { const f32x4 v0 = acc[ai][bj][m][0] * r * wv[bj][0], v1 = acc[ai][bj][m][1] * r * wv[bj][1];
                        u32x4 w; w.x = cvt_pk_bf16(v0[0], v0[1]); w.y = cvt_pk_bf16(v0[2], v0[3]); w.z = cvt_pk_bf16(v1[0], v1[1]); w.w = cvt_pk_bf16(v1[2], v1[3]);
                        *(u32x4*)(rowp + bj * 32) = w; } }
        } else {
            const int col0 = u.pn * BM + wc * 32 + 8 * fq; const bool sig = (u.pn == 6 || u.pn == 7);
#pragma unroll
            for (int ai = 0; ai < 2; ++ai)
#pragma unroll
                for (int m = 0; m < 4; ++m) { bf16* rowp = O + (size_t)(row0 + ai * HALF + m * 16) * ldc + col0; const float r1 = rs[u.li * BM + wr * 64 + fr + ai * HALF + m * 16];
#pragma unroll
                    for (int bj = 0; bj < 2; ++bj) { f32x4 v0 = acc[ai][bj][m][0] * r1, v1 = acc[ai][bj][m][1] * r1;
                        if (sig) {
#pragma unroll
                            for (int j = 0; j < 4; ++j) { v0[j] = __builtin_amdgcn_rcpf(1.f + __builtin_amdgcn_exp2f(v0[j] * -1.4426950408889634f)); v1[j] = __builtin_amdgcn_rcpf(1.f + __builtin_amdgcn_exp2f(v1[j] * -1.4426950408889634f)); } }
                        u32x4 w; w.x = cvt_pk_bf16(v0[0], v0[1]); w.y = cvt_pk_bf16(v0[2], v0[3]); w.z = cvt_pk_bf16(v1[0], v1[1]); w.w = cvt_pk_bf16(v1[2], v1[3]);
                        *(u32x4*)(rowp + bj * HALF) = w; } }
        }
    }
};
struct EpiX1 {
    static constexpr bool PERM = true;
    const bf16* X; bf16* OB; unsigned char* OF; int ldc;
    __device__ __forceinline__ void operator()(const f32x4 (&acc)[2][2][4][2], const Unit& u, int wr, int wc, int fr, int fq) const {
        const int row0 = u.pm * BM + wr * 64 + fr, col0 = u.pn * BM + wc * 32 + 8 * fq;
        u32x4 xv[2][4][2];
#pragma unroll
        for (int ai = 0; ai < 2; ++ai)
#pragma unroll
            for (int m = 0; m < 4; ++m) { const size_t off = (size_t)(row0 + ai * HALF + m * 16) * ldc + col0;
#pragma unroll
                for (int bj = 0; bj < 2; ++bj) xv[ai][m][bj] = *(const u32x4*)(X + off + bj * HALF); }
#pragma unroll
        for (int ai = 0; ai < 2; ++ai)
#pragma unroll
            for (int m = 0; m < 4; ++m) { const size_t off = (size_t)(row0 + ai * HALF + m * 16) * ldc + col0;
#pragma unroll
                for (int bj = 0; bj < 2; ++bj) { const u32x4 xx = xv[ai][m][bj];
                    const f32x4 r0 = (f32x4){bflo(xx.x), bfhi(xx.x), bflo(xx.y), bfhi(xx.y)} + acc[ai][bj][m][0], r1 = (f32x4){bflo(xx.z), bfhi(xx.z), bflo(xx.w), bfhi(xx.w)} + acc[ai][bj][m][1];
                    u32x4 w; w.x = cvt_pk_bf16(r0[0], r0[1]); w.y = cvt_pk_bf16(r0[2], r0[3]); w.z = cvt_pk_bf16(r1[0], r1[1]); w.w = cvt_pk_bf16(r1[2], r1[3]);
                    *(u32x4*)(OB + off + bj * HALF) = w;
                    u32x2 f; f.x = pk4_fp8(r0[0], r0[1], r0[2], r0[3]); f.y = pk4_fp8(r1[0], r1[1], r1[2], r1[3]);
                    *(u32x2*)(OF + off + bj * HALF) = f; } }
    }
};
struct EpiResF32 {
    static constexpr bool PERM = true;
    const float* X; float* O; int ldc; bf16* OB;
    __device__ __forceinline__ void operator()(const f32x4 (&acc)[2][2][4][2], const Unit& u, int wr, int wc, int fr, int fq) const {
        const int row0 = u.pm * BM + wr * 64 + fr, col0 = u.pn * BM + wc * 32 + 8 * fq;
#pragma unroll
        for (int ai = 0; ai < 2; ++ai) {
            f32x4 xv[4][2][2];
#pragma unroll
            for (int m = 0; m < 4; ++m) { const size_t off = (size_t)(row0 + ai * HALF + m * 16) * ldc + col0;
#pragma unroll
                for (int bj = 0; bj < 2; ++bj) { xv[m][bj][0] = *(const f32x4*)(X + off + bj * HALF); xv[m][bj][1] = *(const f32x4*)(X + off + bj * HALF + 4); } }
#pragma unroll
            for (int m = 0; m < 4; ++m) { const size_t off = (size_t)(row0 + ai * HALF + m * 16) * ldc + col0;
#pragma unroll
                for (int bj = 0; bj < 2; ++bj) {
                    const f32x4 r0 = xv[m][bj][0] + acc[ai][bj][m][0], r1 = xv[m][bj][1] + acc[ai][bj][m][1];
                    *(f32x4*)(O + off + bj * HALF) = r0; *(f32x4*)(O + off + bj * HALF + 4) = r1;
                    u32x4 w; w.x = cvt_pk_bf16(r0[0], r0[1]); w.y = cvt_pk_bf16(r0[2], r0[3]); w.z = cvt_pk_bf16(r1[0], r1[1]); w.w = cvt_pk_bf16(r1[2], r1[3]);
                    *(u32x4*)(OB + off + bj * HALF) = w; } }
            asm volatile("" ::: "memory");
        }
    }
};

__device__ __forceinline__ int expert_of_row_l(const PG8_LAS int* pst, int row) {
    const int lane = (int)__builtin_amdgcn_mbcnt_hi(~0u, __builtin_amdgcn_mbcnt_lo(~0u, 0u));
    const bool hit = (lane >= 1 && lane < 32) ? (pst[lane & 31] <= row) : false;
    return __builtin_popcountll(__ballot(hit)); }
struct MoeGuSched {
    static constexpr bool GATHER = true;
    TileOrder o; const char* A; const char* Bt; const int* rowtok; const PG8_LAS int* pst; int K; const PG8_LAS int* ltok;
    __device__ __forceinline__ bool next(int i, Unit& u) const { u.li = i; if (!o.map(i, u.pm, u.pn)) return false; u.e = expert_of_row_l(pst, u.pm * BM); return true; }
    __device__ __forceinline__ const char* a_base(const Unit&) const { return A; }
    __device__ __forceinline__ const char* b_base(const Unit& u) const { return Bt + ((size_t)u.e * 1024 + (size_t)u.pn * BM) * K * 2; }
    __device__ __forceinline__ void a_voff(const Unit& u, const int (&R)[2], const int (&C)[2], unsigned (&v)[2][2]) const {
#pragma unroll
        for (int h = 0; h < 2; ++h)
#pragma unroll
            for (int i = 0; i < 2; ++i) { const int tk = ltok[u.li * BM + h * HALF + R[i]]; const unsigned tok = tk < 0 ? 0u : (unsigned)(tk >> 1); v[h][i] = (tok * (unsigned)K + (unsigned)C[i]) * 2u; }
    }
};
struct MoeDownSched {
    static constexpr bool GATHER = false;
    TileOrder o; const char* A; const char* Bt; const PG8_LAS int* pst; int K;
    __device__ __forceinline__ bool next(int i, Unit& u) const { u.li = i; if (!o.map(i, u.pm, u.pn)) return false; u.e = expert_of_row_l(pst, u.pm * BM); return true; }
    __device__ __forceinline__ const char* a_base(const Unit& u) const { return A + (size_t)u.pm * BM * K * 2; }
    __device__ __forceinline__ const char* b_base(const Unit& u) const { return Bt + ((size_t)u.e * 1024 + (size_t)u.pn * BM) * K * 2; }
    __device__ __forceinline__ void a_voff(const Unit&, const int (&R)[2], const int (&C)[2], unsigned (&v)[2][2]) const {
#pragma unroll
        for (int h = 0; h < 2; ++h)
#pragma unroll
            for (int i = 0; i < 2; ++i) v[h][i] = (unsigned)((h * HALF + R[i]) * K + C[i]) * 2u;
    }
};
struct EpiSwiglu {
    static constexpr bool PERM = true;
    bf16* O; const PG8_LAS float* rowr;
    __device__ __forceinline__ void operator()(const f32x4 (&acc)[2][2][4][2], const Unit& u, int wr, int wc, int fr, int fq) const {
        const int row0 = u.pm * BM + wr * 64 + fr, col0 = u.pn * HALF + wc * 32 + 8 * fq;
#pragma unroll
        for (int ai = 0; ai < 2; ++ai)
#pragma unroll
            for (int m = 0; m < 4; ++m) { unsigned char* rowp = (unsigned char*)O + (size_t)(row0 + ai * HALF + m * 16) * 512 + col0;
                 const float rs = rowr[u.li * BM + wr * 64 + fr + ai * HALF + m * 16];
                float hv[8];
#pragma unroll
                for (int n = 0; n < 2; ++n)
#pragma unroll
                    for (int j = 0; j < 4; ++j) { const float g = acc[ai][0][m][n][j] * rs, up = acc[ai][1][m][n][j] * rs; hv[n * 4 + j] = g * up * __builtin_amdgcn_rcpf(1.f + __expf(-g)); }
                u32x2 w; w.x = pk4_fp8(hv[0], hv[1], hv[2], hv[3]); w.y = pk4_fp8(hv[4], hv[5], hv[6], hv[7]);
                *(u32x2*)rowp = w; }
    }
};
struct EpiDown {
    static constexpr bool PERM = true;
    bf16* Y; const int* rowtok; const float* roww;
    __device__ __forceinline__ void operator()(const f32x4 (&acc)[2][2][4][2], const Unit& u, int wr, int wc, int fr, int fq) const {
        const int row0 = u.pm * BM + wr * 64 + fr, col0 = u.pn * BM + wc * 32 + 8 * fq;
#pragma unroll
        for (int ai = 0; ai < 2; ++ai)
#pragma unroll
            for (int m = 0; m < 4; ++m) { const int pos = row0 + ai * HALF + m * 16; const int tk = rowtok[pos]; const float w = roww[pos];
                if (tk >= 0) { bf16* rowp = Y + ((size_t)(tk & 1) * 65536 + (size_t)(tk >> 1)) * 1024 + col0;
#pragma unroll
                    for (int bj = 0; bj < 2; ++bj) { const f32x4 v0 = acc[ai][bj][m][0] * w, v1 = acc[ai][bj][m][1] * w;
                        u32x4 o; o.x = cvt_pk_bf16(v0[0], v0[1]); o.y = cvt_pk_bf16(v0[2], v0[3]); o.z = cvt_pk_bf16(v1[0], v1[1]); o.w = cvt_pk_bf16(v1[2], v1[3]);
                        *(u32x4*)(rowp + bj * HALF) = o; } } }
    }
};

typedef int i32x4v __attribute__((ext_vector_type(4)));
typedef int i32x8v __attribute__((ext_vector_type(8)));
template <class Epi, class Sched, bool ALIGN_EPI = true, bool F8 = false>
__device__ __forceinline__ void gemm_phase(PG8_LAS unsigned char* lds, const int K, const Sched& S, const Epi& E) {
    int tid = threadIdx.x; asm volatile("" : "+v"(tid));
    const int wid = __builtin_amdgcn_readfirstlane(tid >> 6), lane = tid & 63, wr = wid >> 2, wc = wid & 3, fr = lane & 15, fq = lane >> 4;
    const int nt = K / BK;
    int Rr[2], Cc[2]; unsigned voffB[2];
#pragma unroll
    for (int i = 0; i < 2; ++i) { int R, C; stage_rc(tid * 16 + i * 8192, R, C); const int Rb = Epi::PERM ? ((R & ~31) + perm32(R & 31)) : R;
        Rr[i] = R; Cc[i] = C; voffB[i] = (unsigned)(Rb * K + C) * 2u; }
    const size_t kstep = (size_t)(BK * 2);
    const size_t hstep = (size_t)HALF * K * 2;
    const unsigned ldsw = (unsigned)wid * 1024u;
    const int aoff = lds_byte(wr * 64 + fr, fq * 8), boff = lds_byte(wc * 32 + fr, fq * 8);
#define PG8_SA(b, h) (((b) * 2 + (h)) * HTB)
#define PG8_SB(b, h) ((4 + (b) * 2 + (h)) * HTB)
#define PG8_STAGE(bufoff, gbase, voff) do { _Pragma("unroll") for (int _i = 0; _i < 2; ++_i) \
        __builtin_amdgcn_global_load_lds((const unsigned*)((const char*)(gbase) + (voff)[_i]), (PG8_LAS unsigned*)(lds + (bufoff) + ldsw + _i * 8192), 16, 0, 0); } while (0)
#define PG8_CAT(x0, x1) __builtin_shufflevector(__builtin_bit_cast(i32x4v, x0), __builtin_bit_cast(i32x4v, x1), 0, 1, 2, 3, 4, 5, 6, 7)
#define PG8_LDA(dst, b, h) do { if constexpr (F8) { _Pragma("unroll") for (int m = 0; m < 4; ++m) dst##8[m] = PG8_CAT(*(const PG8_LAS bf16x8*)(lds + PG8_SA(b, h) + aoff + m * 2048), *(const PG8_LAS bf16x8*)(lds + PG8_SA(b, h) + aoff + m * 2048 + 1024)); } \
        else { _Pragma("unroll") for (int m = 0; m < 4; ++m) _Pragma("unroll") for (int k = 0; k < 2; ++k) dst[m][k] = *(const PG8_LAS bf16x8*)(lds + PG8_SA(b, h) + aoff + m * 2048 + k * 1024); } } while (0)
#define PG8_LDB(dst, b, h) do { if constexpr (F8) { _Pragma("unroll") for (int n = 0; n < 2; ++n) dst##8[n] = PG8_CAT(*(const PG8_LAS bf16x8*)(lds + PG8_SB(b, h) + boff + n * 2048), *(const PG8_LAS bf16x8*)(lds + PG8_SB(b, h) + boff + n * 2048 + 1024)); } \
        else { _Pragma("unroll") for (int n = 0; n < 2; ++n) _Pragma("unroll") for (int k = 0; k < 2; ++k) dst[n][k] = *(const PG8_LAS bf16x8*)(lds + PG8_SB(b, h) + boff + n * 2048 + k * 1024); } } while (0)
#define PG8_MMA(ai, bj, At, Bt) do { __builtin_amdgcn_s_setprio(1); \
        if constexpr (F8) { __builtin_amdgcn_sched_barrier(0); _Pragma("unroll") for (int m = 0; m < 4; ++m) _Pragma("unroll") for (int n = 0; n < 2; ++n) \
            asm volatile("v_mfma_scale_f32_16x16x128_f8f6f4 %0, %1, %2, %0, %3, %3 op_sel_hi:[0,0,0]" : "+v"(acc[ai][bj][m][n]) : "v"(Bt##8[n]), "v"(At##8[m]), "v"(f8scale)); __builtin_amdgcn_sched_barrier(0); } \
        else { _Pragma("unroll") for (int m = 0; m < 4; ++m) _Pragma("unroll") for (int n = 0; n < 2; ++n) _Pragma("unroll") for (int k = 0; k < 2; ++k) \
            acc[ai][bj][m][n] = __builtin_amdgcn_mfma_f32_16x16x32_bf16(Bt[n][k], At[m][k], acc[ai][bj][m][n], 0, 0, 0); } \
        __builtin_amdgcn_s_setprio(0); } while (0)
#define PG8_WAIT_V(n) asm volatile("s_waitcnt vmcnt(" #n ")" ::: "memory")
#define PG8_WAIT_L(n) asm volatile("s_waitcnt lgkmcnt(" #n ")" ::: "memory")
#define PG8_BAR __builtin_amdgcn_s_barrier()
#define PG8_SCHED __builtin_amdgcn_sched_barrier(0)
    Unit cur, nxt; int ui = 0;
    if (!S.next(0, cur)) return;
    f32x4 acc[2][2][4][2];
#pragma unroll
    for (int a = 0; a < 2; ++a)
#pragma unroll
        for (int b = 0; b < 2; ++b)
#pragma unroll
            for (int m = 0; m < 4; ++m)
#pragma unroll
                for (int n = 0; n < 2; ++n) acc[a][b][m][n] = (f32x4){0.f, 0.f, 0.f, 0.f};
    bf16x8 At[4][2], B0[2][2], B1[2][2];
    i32x8v At8[4], B08[2], B18[2]; const int f8scale = 127;
    unsigned cv[2][2], nv[2][2];
    S.a_voff(cur, Rr, Cc, cv);
#pragma unroll
    for (int h = 0; h < 2; ++h)
#pragma unroll
        for (int i = 0; i < 2; ++i) nv[h][i] = cv[h][i];
    const char* cA = S.a_base(cur); const char* cB = S.b_base(cur);
    PG8_STAGE(PG8_SB(0, 0), cB, voffB); PG8_STAGE(PG8_SB(0, 1), cB + hstep, voffB); PG8_STAGE(PG8_SA(0, 0), cA, cv[0]); PG8_STAGE(PG8_SA(0, 1), cA, cv[1]);
    if (wr == 1) PG8_BAR;
    PG8_WAIT_V(2); PG8_BAR;
    PG8_STAGE(PG8_SB(1, 0), cB + kstep, voffB); PG8_STAGE(PG8_SA(1, 0), cA + kstep, cv[0]); PG8_STAGE(PG8_SB(1, 1), cB + hstep + kstep, voffB);
    PG8_WAIT_V(6); PG8_BAR;
    for (;;) {
        const bool has_next = S.next(ui + 1, nxt);
        const char* nA = has_next ? S.a_base(nxt) : cA; const char* nB = has_next ? S.b_base(nxt) : cB;
#pragma unroll 1
        for (int t = 0; t < nt; t += 2) {
            const bool last = (t == nt - 2);
            const char* a1 = cA + (size_t)(t + 1) * kstep;
            const char* a2 = last ? nA : cA + (size_t)(t + 2) * kstep; const char* b2 = last ? nB : cB + (size_t)(t + 2) * kstep;
            const char* a3 = a2 + kstep; const char* b3 = b2 + kstep;
            unsigned v2[2][2];
            if constexpr (Sched::GATHER) {
                if (last && has_next) { S.a_voff(nxt, Rr, Cc, nv); }
#pragma unroll
                for (int h = 0; h < 2; ++h)
#pragma unroll
                    for (int i = 0; i < 2; ++i) v2[h][i] = last ? nv[h][i] : cv[h][i];
            } else {
#pragma unroll
                for (int h = 0; h < 2; ++h)
#pragma unroll
                    for (int i = 0; i < 2; ++i) v2[h][i] = cv[h][i];
            }
            PG8_LDB(B0, 0, 0); PG8_LDB(B1, 0, 1); PG8_SCHED; PG8_LDA(At, 0, 0); PG8_STAGE(PG8_SA(1, 1), a1, cv[1]);
            PG8_WAIT_V(8); PG8_WAIT_L(0); PG8_BAR; PG8_MMA(0, 0, At, B0); PG8_MMA(0, 1, At, B1); PG8_BAR; PG8_SCHED;
            PG8_LDA(At, 0, 1); PG8_STAGE(PG8_SB(0, 0), b2, voffB); PG8_STAGE(PG8_SB(0, 1), b2 + hstep, voffB); PG8_STAGE(PG8_SA(0, 0), a2, v2[0]);
            PG8_WAIT_V(8); PG8_WAIT_L(0); PG8_BAR; PG8_MMA(1, 0, At, B0); PG8_MMA(1, 1, At, B1); PG8_BAR; PG8_SCHED;
            PG8_LDB(B0, 1, 0); PG8_LDB(B1, 1, 1); PG8_SCHED; PG8_LDA(At, 1, 0); PG8_STAGE(PG8_SA(0, 1), a2, v2[1]);
            PG8_WAIT_V(8); PG8_WAIT_L(0); PG8_BAR; PG8_MMA(0, 0, At, B0); PG8_MMA(0, 1, At, B1); PG8_BAR; PG8_SCHED;
            PG8_LDA(At, 1, 1); PG8_STAGE(PG8_SB(1, 0), b3, voffB); PG8_STAGE(PG8_SB(1, 1), b3 + hstep, voffB); PG8_STAGE(PG8_SA(1, 0), a3, v2[0]);
            PG8_WAIT_V(8); PG8_WAIT_L(0); PG8_BAR; PG8_MMA(1, 0, At, B0); PG8_MMA(1, 1, At, B1); PG8_BAR; PG8_SCHED;
        }
        if constexpr (ALIGN_EPI) { if (wr == 0) PG8_BAR; }
        if constexpr (F8) { asm volatile("s_nop 15\n\ts_nop 15" ::: "memory"); }
        E(acc, cur, wr, wc, fr, fq);
        if (!has_next) break;
#pragma unroll
        for (int a = 0; a < 2; ++a)
#pragma unroll
            for (int b = 0; b < 2; ++b)
#pragma unroll
                for (int m = 0; m < 4; ++m)
#pragma unroll
                    for (int n = 0; n < 2; ++n) acc[a][b][m][n] = (f32x4){0.f, 0.f, 0.f, 0.f};
        cur = nxt; cA = nA; cB = nB; ++ui;
#pragma unroll
        for (int h = 0; h < 2; ++h)
#pragma unroll
            for (int i = 0; i < 2; ++i) cv[h][i] = nv[h][i];
        if constexpr (ALIGN_EPI) { if (wr == 1) PG8_BAR; }
    }
    PG8_WAIT_V(0);
    if constexpr (!ALIGN_EPI) { if (wr == 0) PG8_BAR; }
    PG8_BAR;
#undef PG8_SA
#undef PG8_SB
#undef PG8_STAGE
#undef PG8_LDA
#undef PG8_LDB
#undef PG8_MMA
#undef PG8_CAT
#undef PG8_WAIT_V
#undef PG8_WAIT_L
#undef PG8_BAR
#undef PG8_SCHED
}
}

#define XB_TMO      128
#define XB_XCNT(j)  (256  + 64 * (j))
#define XB_XSUB(j)  (1280 + 64 * (j))
#define XB_XGEN(j)  (2304 + 64 * (j))
#define XB_TOP      3328
#define XB_TOPGEN   3392
#define XCD_BAR_WORDS 3456
#define XB_SPIN_CAP (1u << 22)

__device__ __forceinline__ unsigned xb_ld(unsigned* p)              { return __hip_atomic_load(p, __ATOMIC_RELAXED, __HIP_MEMORY_SCOPE_AGENT); }
__device__ __forceinline__ unsigned xb_add(unsigned* p, unsigned v) { return __hip_atomic_fetch_add(p, v, __ATOMIC_RELAXED, __HIP_MEMORY_SCOPE_AGENT); }
__device__ __forceinline__ unsigned xb_xcc_id() { return (unsigned)__builtin_amdgcn_s_getreg((3 << 11) | 20) & 0xFu; }
#define XB_SPIN(cond, bar) do { unsigned _sp = 0; while (cond) { __builtin_amdgcn_s_sleep(1); \
    if ((++_sp & 255u) == 0u) { if (xb_ld(&(bar)[XB_TMO])) break; if (_sp > XB_SPIN_CAP) { atomicAdd(&(bar)[XB_TMO], 1u); break; } } } } while (0)

struct XcdBarrier { unsigned* bar; unsigned x; volatile LAS unsigned* st; };

__device__ __forceinline__ XcdBarrier xcd_barrier_post(unsigned* bar, volatile LAS unsigned* st) {
    XcdBarrier b; b.bar = bar; b.x = xb_xcc_id(); b.st = st;
    if (threadIdx.x == 0) (void)xb_add(&bar[XB_XCNT(b.x)], 1u);
    return b;
}
__device__ __forceinline__ void xcd_barrier_complete(unsigned* bar, unsigned x, unsigned& nloc, unsigned& nx) {
    const unsigned G = gridDim.x * gridDim.y * gridDim.z;
    unsigned sum, cnt, mine, sp = 0u;
    for (;;) {
        sum = 0u; cnt = 0u; mine = 0u;
#pragma unroll
        for (unsigned j = 0; j < 16; ++j) { const unsigned c = xb_ld(&bar[XB_XCNT(j)]); sum += c; cnt += (c > 0u) ? 1u : 0u; mine = (j == x) ? c : mine; }
        if (sum == G) break;
        __builtin_amdgcn_s_sleep(1);
        if ((++sp & 255u) == 0u) { if (xb_ld(&bar[XB_TMO])) break; if (sp > XB_SPIN_CAP) { atomicAdd(&bar[XB_TMO], 1u); break; } }
    }
    nloc = mine > 0u ? mine : 1u; nx = cnt > 0u ? cnt : 1u;
}
__device__ __forceinline__ void xcd_barrier(const XcdBarrier& b) {
    asm volatile("s_waitcnt vmcnt(0)" ::: "memory");
    __syncthreads();
    if (threadIdx.x == 0) {
        unsigned* bar = b.bar;
        __builtin_amdgcn_s_waitcnt(0);
        unsigned nloc = b.st[0], nx = b.st[1];
        if (nloc == 0u) { xcd_barrier_complete(bar, b.x, nloc, nx); b.st[0] = nloc; b.st[1] = nx; }
        const unsigned old = xb_add(&bar[XB_XSUB(b.x)], 1u);
        const unsigned gen = old / nloc;
        if (old + 1u == (gen + 1u) * nloc) {
            __builtin_amdgcn_fence(__ATOMIC_RELEASE, "agent");
            asm volatile("s_waitcnt vmcnt(0)" ::: "memory");
            const unsigned og = xb_add(&bar[XB_TOP], 1u);
            const unsigned tg = og / nx;
            if (og + 1u == (tg + 1u) * nx) xb_add(&bar[XB_TOPGEN], 1u);
            else XB_SPIN(xb_ld(&bar[XB_TOPGEN]) == tg, bar);
            __builtin_amdgcn_fence(__ATOMIC_ACQUIRE, "agent");
            xb_add(&bar[XB_XGEN(b.x)], 1u);
            asm volatile("s_waitcnt vmcnt(0)" ::: "memory");
        } else {
            XB_SPIN(xb_ld(&bar[XB_XGEN(b.x)]) == gen, bar);
            __builtin_amdgcn_fence(__ATOMIC_ACQUIRE, "agent");
            asm volatile("s_waitcnt vmcnt(0)" ::: "memory");
        }
    }
    __syncthreads();
}

struct Args {
    const float* in[24];
    float* out;
    unsigned char* ws;
    int ph_lo, ph_hi;
};

struct TrItem { const float* src; int ldsrc, k0, n0s; bf16* dst; int ldd, drow0; const float* kscale; int f8; };
__device__ __forceinline__ void tr_load(const TrItem& t, f32x4 (&v)[8], int lane) {
#pragma unroll
    for (int i = 0; i < 8; ++i) v[i] = *(const f32x4*)(t.src + (size_t)(t.k0 + (lane >> 3) + 8 * i) * t.ldsrc + t.n0s + 4 * (lane & 7));
}
__device__ __forceinline__ void tr_finish(const TrItem& t, const f32x4 (&v)[8], LAS float* scr, int lane) {
#pragma unroll
    for (int i = 0; i < 8; ++i) { const int kk = (lane >> 3) + 8 * i; f32x4 x = v[i]; if (t.kscale) x = x * t.kscale[t.k0 + kk];
        LAS float* d = scr + kk * 33 + 4 * (lane & 7); d[0] = x.x; d[1] = x.y; d[2] = x.z; d[3] = x.w; }
    LDS_WAIT();
    const int c = lane & 7;
#pragma unroll
    for (int j = 0; j < 4; ++j) { const int n = (lane >> 3) + 8 * j; const LAS float* s = scr + (8 * c) * 33 + n;
        if (t.f8) { u32x2 o; o.x = pk4_fp8(s[0 * 33], s[1 * 33], s[2 * 33], s[3 * 33]); o.y = pk4_fp8(s[4 * 33], s[5 * 33], s[6 * 33], s[7 * 33]);
            *(u32x2*)((unsigned char*)t.dst + (size_t)(t.drow0 + n) * t.ldd + t.k0 + 8 * c) = o; }
        else { u32x4 o; o.x = pk2(s[0 * 33], s[1 * 33]); o.y = pk2(s[2 * 33], s[3 * 33]); o.z = pk2(s[4 * 33], s[5 * 33]); o.w = pk2(s[6 * 33], s[7 * 33]);
            *(u32x4*)(t.dst + (size_t)(t.drow0 + n) * t.ldd + t.k0 + 8 * c) = o; } }
    LDS_WAIT();
}

__device__ __forceinline__ void p0_prologue(const Args& a, LAS unsigned char* lds, int tid, int lane, int wave, int wg, int G) {
    unsigned char* ws = a.ws;
    const float* x = a.in[0]; const float* norm1_w = a.in[1]; const float* w_in = a.in[2]; const float* b_ig = a.in[3]; const float* b_fg = a.in[4];
    const float* w_out = a.in[15]; const float* w_gate = a.in[21]; const float* w_up = a.in[22]; const float* w_down = a.in[23];
    bf16* W1T = (bf16*)(ws + WS_W1T); bf16* W2T = (bf16*)(ws + WS_W2T); bf16* WGU = (bf16*)(ws + WS_WGU); bf16* WD = (bf16*)(ws + WS_WD);
    bf16* H1 = (bf16*)(ws + WS_H1); float* GATES = (float*)(ws + WS_GATES);
    LAS float* scr = (LAS float*)(lds + wave * 8448);
    LAS float* gwl = (LAS float*)(lds + 73728);
    {
        float gv[16];
#pragma unroll
        for (int q = 0; q < 16; ++q) { const int idx = tid + NTHR * q; gv[q] = w_in[(size_t)(idx >> 3) * INCOLS + 2048 + (idx & 7)]; }
#pragma unroll
        for (int q = 0; q < 16; ++q) gwl[tid + NTHR * q] = gv[q];
    }
    {
        const float* norm2_w = a.in[16]; const float* w_group = a.in[17]; const float* w_expert = a.in[19]; unsigned char* RIMG = ws + WS_RIMG;
        const int idx = wg * NTHR + tid;
        if (idx < 36864) { int k, c; float v;
            if (idx < 4096) { k = idx >> 2; c = idx & 3; v = w_group[idx]; } else { const int j = idx - 4096; k = j >> 5; c = 4 + (j & 31); v = w_expert[j]; }
            v *= norm2_w[k];
            const unsigned hi = f2bf(v), lo = f2bf(v - __uint_as_float(hi << 16));
            *(bf16*)(RIMG + c * 2064 + k * 2) = (bf16)hi; *(bf16*)(RIMG + 36 * 2064 + c * 2064 + k * 2) = (bf16)lo; }
    }
    __syncthreads();
    const int gw = wg * NWAVES + wave, NGW = G * NWAVES;
    constexpr int I_1 = 16 * 112, I_2 = 16 * 32, I_GU = NEXP * 16 * 32, NITEMS = I_1 + I_2 + I_GU;
    auto item_desc = [&](int it) -> TrItem {
        int r = it;
        if (r < I_1) { const int kb = r / 112, nb = r % 112, n0 = nb * 32; int sc_ = n0;
            if (n0 >= 2048 && n0 < 3072) { const int p0 = n0 & 255; sc_ = (n0 & ~255) + 64 * ((p0 >> 5) & 3) + 32 * (p0 >> 7); }
            return TrItem{w_in, INCOLS, kb * 64, sc_ < 2048 ? sc_ : sc_ + 8, W1T, 1024, n0, norm1_w, 0}; } r -= I_1;
        if (r < I_2) { const int kb = r / 32, nb = r % 32; return TrItem{w_out, 1024, kb * 64, nb * 32, W2T, 1024, nb * 32, nullptr, 0}; } r -= I_2;
        { const int e = r / 512, q = r % 512, kb = q / 32, nb = q % 32, j0 = nb * 32, pn = j0 >> 8, rr = j0 & 255;
            const float* s_ = (rr < 128 ? w_gate : w_up) + (size_t)e * 1024 * 512;
            return TrItem{s_, 512, kb * 64, pn * 128 + (rr & 127), (bf16*)((unsigned char*)WGU + (size_t)e * 1024 * 1024), 1024, j0, a.in[16], 1}; }
    };
    if (gw < NITEMS) {
        TrItem cur = item_desc(gw); f32x4 tv[8]; tr_load(cur, tv, lane);
#pragma unroll 1
        for (int it = gw; it < NITEMS; it += NGW) {
            f32x4 cv_[8];
#pragma unroll
            for (int i = 0; i < 8; ++i) cv_[i] = tv[i];
            const TrItem me = cur;
            if (it + NGW < NITEMS) { cur = item_desc(it + NGW); tr_load(cur, tv, lane); }
            tr_finish(me, cv_, scr, lane);
        }
    }
    f32x4 w1v[4];
#pragma unroll
    for (int j = 0; j < 4; ++j) w1v[j] = ((const f32x4*)norm1_w)[lane + 64 * j];
    f32x4 nx[4], nx2[4];
#pragma unroll
    for (int j = 0; j < 4; ++j) { nx[j] = ((const f32x4*)(x + (size_t)gw * DM))[lane + 64 * j]; nx2[j] = ((const f32x4*)(x + (size_t)(gw + NGW) * DM))[lane + 64 * j]; }
    const int gc = ((lane >> 5) & 1) * 4 + ((lane >> 4) & 1) * 2 + ((lane >> 3) & 1), gh = gc & 3;
    const float gbias = (gc < 4) ? b_ig[gh] : b_fg[gh];
#pragma unroll 1
    for (int m = gw; m < T_; m += NGW) {
        f32x4 v[4]; float ss = 0.f;
#pragma unroll
        for (int j = 0; j < 4; ++j) { v[j] = nx[j]; nx[j] = nx2[j]; ss += (v[j].x * v[j].x + v[j].y * v[j].y) + (v[j].z * v[j].z + v[j].w * v[j].w); }
        if (m + 2 * NGW < T_) {
#pragma unroll
            for (int j = 0; j < 4; ++j) nx2[j] = ((const f32x4*)(x + (size_t)(m + 2 * NGW) * DM))[lane + 64 * j]; }
        const float r = rsqrtf(wave_sum(ss) * (1.f / DM) + EPS);
        if (lane == 0) ((float*)(ws + WS_R1))[m] = r;
        float g[8];
#pragma unroll
        for (int c = 0; c < 8; ++c) g[c] = 0.f;
        u32x2* o8 = (u32x2*)(H1 + (size_t)m * DM) + lane;
#pragma unroll
        for (int j = 0; j < 4; ++j) {
            const f32x4 hv = v[j] * r * w1v[j];
            u32x2 o; o.x = pk2(v[j].x, v[j].y); o.y = pk2(v[j].z, v[j].w); o8[64 * j] = o;
#pragma unroll
            for (int i = 0; i < 4; ++i) { const int k = 256 * j + 4 * lane + i; const f32x4 ga = *(const LAS f32x4*)(gwl + k * 8), gb = *(const LAS f32x4*)(gwl + k * 8 + 4);
                const float hh = hv[i];
                g[0] += hh * ga.x; g[1] += hh * ga.y; g[2] += hh * ga.z; g[3] += hh * ga.w; g[4] += hh * gb.x; g[5] += hh * gb.y; g[6] += hh * gb.z; g[7] += hh * gb.w; }
        }
        float k4[4], k2[2], k1;
        { const bool up = (lane & 32) != 0;
#pragma unroll
          for (int i = 0; i < 4; ++i) { const float send = up ? g[i] : g[i + 4]; const float recv = __shfl_xor(send, 32); k4[i] = (up ? g[i + 4] : g[i]) + recv; } }
        { const bool up = (lane & 16) != 0;
#pragma unroll
          for (int i = 0; i < 2; ++i) { const float send = up ? k4[i] : k4[i + 2]; const float recv = __shfl_xor(send, 16); k2[i] = (up ? k4[i + 2] : k4[i]) + recv; } }
        { const bool up = (lane & 8) != 0; const float send = up ? k2[0] : k2[1]; const float recv = __shfl_xor(send, 8); k1 = (up ? k2[1] : k2[0]) + recv; }
        k1 += __shfl_xor(k1, 4); k1 += __shfl_xor(k1, 2); k1 += __shfl_xor(k1, 1);
        if ((lane & 7) == 0) {
            float res = k1 + gbias;
            if (gc >= 4) res = fminf(res, 0.f) - log1pf(__expf(-fabsf(res)));
            GATES[(size_t)m * 8 + gc] = res;
        }
    }
}

__device__ __forceinline__ void p1_stagger_work(const Args& a, LAS unsigned char* lds, int lane, int wave, int wg) {
    const int g = wg & 3; if (g == 0) return;
    const float* w_down = a.in[23]; bf16* WD = (bf16*)(a.ws + WS_WD);
    constexpr int NIT = NEXP * 8 * 32;
    const int lo = (g == 1) ? 0 : (g == 2) ? NIT / 6 : NIT / 2, hi = (g == 1) ? NIT / 6 : (g == 2) ? NIT / 2 : NIT;
    LAS float* scr = (LAS float*)(lds + wave * 8448);
    const int gw = (wg >> 2) * NWAVES + wave, NGW = 64 * NWAVES;
    auto desc = [&](int r) -> TrItem { const int e = r / 256, q = r % 256, kb = q / 32, nb = q % 32;
        return TrItem{w_down + (size_t)e * 512 * 1024, 1024, kb * 64, nb * 32, (bf16*)((unsigned char*)WD + (size_t)e * 1024 * 512), 512, nb * 32, nullptr, 1}; };
    if (lo + gw < hi) {
        TrItem cur = desc(lo + gw); f32x4 tv[8]; tr_load(cur, tv, lane);
#pragma unroll 1
        for (int it = lo + gw; it < hi; it += NGW) {
            f32x4 cv_[8];
#pragma unroll
            for (int i = 0; i < 8; ++i) cv_[i] = tv[i];
            const TrItem me = cur;
            if (it + NGW < hi) { cur = desc(it + NGW); tr_load(cur, tv, lane); }
            tr_finish(me, cv_, scr, lane);
        }
    }
}

__device__ __forceinline__ void mlstm_naive(const Args& a, LAS unsigned char* lds, int item, int tid, int lane, int wave) {
    unsigned char* ws = a.ws;
    const bf16* PROJ = (const bf16*)(ws + WS_PROJ); const float* GATES = (const float*)(ws + WS_GATES); bf16* MIX = (bf16*)(ws + WS_MIX);
    const float* conv_w = a.in[5]; const float* conv_b = a.in[6]; const float* m_norm_w = a.in[7];
    LAS float* qs = (LAS float*)lds; LAS float* ks = qs + 8192; LAS float* vs = ks + 8192; LAS float* hb = vs + 8192;
    LAS float* red = hb + 8192; LAS float* dred = red + 1024; LAS float* igs = dred + 16; LAS float* lfs = igs + 64;
    const int b = item >> 2, h = item & 3, e = tid & 127, dq = tid >> 7;
    float Cr[32], nr[32];
#pragma unroll
    for (int j = 0; j < 32; ++j) { Cr[j] = 0.f; nr[j] = 0.f; }
    float m = 0.f;
    const float mw0 = m_norm_w[lane], mw1 = m_norm_w[lane + 64];
    for (int c = 0; c < SEQ / 64; ++c) {
        const int t0 = c * 64;
        for (int idx = tid; idx < 8192; idx += NTHR) {
            const int tt = idx >> 7, d = idx & 127, t = t0 + tt, colq = C_MQ + h * 128 + d, colk = C_MK + h * 128 + d;
            float aq = conv_b[colq], ak = conv_b[colk];
#pragma unroll
            for (int j = 0; j < 4; ++j) { const int ts = t - 3 + j; if (ts >= 0) { const bf16* row = PROJ + (size_t)(b * SEQ + ts) * NCOL; aq += bf2f(row[colq]) * conv_w[j * 1024 + colq]; ak += bf2f(row[colk]) * conv_w[j * 1024 + colk]; } }
            qs[idx] = siluf_(aq); ks[idx] = siluf_(ak) * 0.08838834764831845f;
            vs[idx] = bf2f(PROJ[(size_t)(b * SEQ + t) * NCOL + C_MV + h * 128 + d]);
        }
        if (tid < 64) { igs[tid] = GATES[(size_t)(b * SEQ + t0 + tid) * 8 + h]; lfs[tid] = GATES[(size_t)(b * SEQ + t0 + tid) * 8 + 4 + h]; }
        __syncthreads();
        for (int tt = 0; tt < 64; ++tt) {
            const float lf = lfs[tt], ig = igs[tt];
            const float mnew = fmaxf(lf + m, ig), fd = __expf(lf + m - mnew), iw = __expf(ig - mnew); m = mnew;
            const float ve = vs[tt * 128 + e] * iw;
            float num = 0.f, den = 0.f;
#pragma unroll
            for (int j = 0; j < 32; ++j) { const int d = dq * 32 + j; const float kd = ks[tt * 128 + d], qd = qs[tt * 128 + d];
                Cr[j] = fd * Cr[j] + kd * ve; nr[j] = fd * nr[j] + iw * kd; num += qd * Cr[j]; den += qd * nr[j]; }
            const int p = tt & 1;
            red[(p * 4 + dq) * 128 + e] = num; if (e == 0) dred[p * 4 + dq] = den;
            __syncthreads();
            if (dq == 0) { const float ntot = (red[(p * 4 + 0) * 128 + e] + red[(p * 4 + 1) * 128 + e]) + (red[(p * 4 + 2) * 128 + e] + red[(p * 4 + 3) * 128 + e]);
                const float dtot = (dred[p * 4 + 0] + dred[p * 4 + 1]) + (dred[p * 4 + 2] + dred[p * 4 + 3]);
                hb[tt * 128 + e] = ntot / fmaxf(fabsf(dtot), __expf(-mnew)); }
        }
        __syncthreads();
#pragma unroll 1
        for (int rr = 0; rr < 8; ++rr) {
            const int tt = wave * 8 + rr, t = t0 + tt; const bf16* rowp = PROJ + (size_t)(b * SEQ + t) * NCOL + C_MO + h * 128;
            const float y0 = hb[tt * 128 + lane] * sigmoidf_(bf2f(rowp[lane])), y1 = hb[tt * 128 + lane + 64] * sigmoidf_(bf2f(rowp[lane + 64]));
            const float r = rsqrtf(wave_sum(y0 * y0 + y1 * y1) * (1.f / 128.f) + EPS);
            bf16* orow = MIX + (size_t)(b * SEQ + t) * DM + h * 128;
            orow[lane] = (bf16)f2bf(y0 * r * mw0); orow[lane + 64] = (bf16)f2bf(y1 * r * mw1);
        }
        __syncthreads();
    }
}

__device__ __forceinline__ void attn_naive_row(const Args& a, LAS float* sc, LAS float* qsl, int ridx, int lane, float lam) {
    unsigned char* ws = a.ws;
    const bf16* PROJ = (const bf16*)(ws + WS_PROJ); bf16* MIX = (bf16*)(ws + WS_MIX);
    const float* qnw = a.in[8]; const float* knw = a.in[9]; const float* anw = a.in[14];
    const int h = ridx & 3, bt = ridx >> 2, t = bt & (SEQ - 1), b = bt >> 11;
    {
        const unsigned u = *(const unsigned*)(PROJ + (size_t)bt * NCOL + C_AQ + h * 128 + 2 * lane);
        const float q0 = bflo(u), q1 = bfhi(u); float ss = q0 * q0 + q1 * q1;
#pragma unroll
        for (int o = 1; o < 32; o <<= 1) ss += __shfl_xor(ss, o);
        const float rq = rsqrtf(ss * (1.f / 64.f) + EPS) * 0.125f; const int dd = (2 * lane) & 63;
        qsl[2 * lane] = q0 * rq * qnw[dd] * knw[dd]; qsl[2 * lane + 1] = q1 * rq * qnw[dd + 1] * knw[dd + 1];
    }
    LDS_WAIT();
    const int nk = ((t >> 6) + 1) * 64;
    float m0 = -1e30f, m1 = -1e30f;
    for (int j = lane; j < nk; j += 64) {
        const u32x4* krow = (const u32x4*)(PROJ + (size_t)(b * SEQ + j) * NCOL + C_AK + h * 128);
        float s0 = 0.f, ss0 = 0.f, s1 = 0.f, ss1 = 0.f;
#pragma unroll
        for (int q = 0; q < 8; ++q) { const u32x4 kv = krow[q]; const f32x4 qa = *(const LAS f32x4*)(qsl + q * 8), qb = *(const LAS f32x4*)(qsl + q * 8 + 4);
            const float k0 = bflo(kv.x), k1 = bfhi(kv.x), k2 = bflo(kv.y), k3 = bfhi(kv.y), k4 = bflo(kv.z), k5 = bfhi(kv.z), k6 = bflo(kv.w), k7 = bfhi(kv.w);
            s0 += qa.x * k0 + qa.y * k1 + qa.z * k2 + qa.w * k3 + qb.x * k4 + qb.y * k5 + qb.z * k6 + qb.w * k7;
            ss0 += k0 * k0 + k1 * k1 + k2 * k2 + k3 * k3 + k4 * k4 + k5 * k5 + k6 * k6 + k7 * k7; }
#pragma unroll
        for (int q = 8; q < 16; ++q) { const u32x4 kv = krow[q]; const f32x4 qa = *(const LAS f32x4*)(qsl + q * 8), qb = *(const LAS f32x4*)(qsl + q * 8 + 4);
            const float k0 = bflo(kv.x), k1 = bfhi(kv.x), k2 = bflo(kv.y), k3 = bfhi(kv.y), k4 = bflo(kv.z), k5 = bfhi(kv.z), k6 = bflo(kv.w), k7 = bfhi(kv.w);
            s1 += qa.x * k0 + qa.y * k1 + qa.z * k2 + qa.w * k3 + qb.x * k4 + qb.y * k5 + qb.z * k6 + qb.w * k7;
            ss1 += k0 * k0 + k1 * k1 + k2 * k2 + k3 * k3 + k4 * k4 + k5 * k5 + k6 * k6 + k7 * k7; }
        s0 *= rsqrtf(ss0 * (1.f / 64.f) + EPS); s1 *= rsqrtf(ss1 * (1.f / 64.f) + EPS);
        sc[j] = s0; sc[2048 + j] = s1; m0 = fmaxf(m0, s0); m1 = fmaxf(m1, s1);
    }
    m0 = wave_max(m0); m1 = wave_max(m1);
    float l0 = 0.f, l1 = 0.f;
    for (int j = lane; j < nk; j += 64) { const float e0 = __expf(sc[j] - m0), e1 = __expf(sc[2048 + j] - m1); sc[j] = e0; sc[2048 + j] = e1; l0 += e0; l1 += e1; }
    l0 = wave_sum(l0); l1 = wave_sum(l1);
    const float c0 = 1.f / l0, c1 = lam / l1;
    LDS_WAIT();
    float o0 = 0.f, o1 = 0.f;
    const bf16* vb = PROJ + (size_t)(b * SEQ) * NCOL + C_AV + h * 128 + 2 * lane;
    for (int j = 0; j < nk; ++j) { const float p = sc[j] * c0 - sc[2048 + j] * c1; const unsigned u = *(const unsigned*)(vb + (size_t)j * NCOL); o0 += p * bflo(u); o1 += p * bfhi(u); }
    const float r = rsqrtf(wave_sum(o0 * o0 + o1 * o1) * (1.f / 128.f) + EPS) * (1.f - LAMBDA_INIT);
    *(unsigned*)(MIX + (size_t)bt * DM + 512 + h * 128 + 2 * lane) = pk2(o0 * r * anw[2 * lane], o1 * r * anw[2 * lane + 1]);
    LDS_WAIT();
}

__device__ __forceinline__ void p2_naive(const Args& a, LAS unsigned char* lds, int tid, int lane, int wave, int wg, int G) {
    if (wg < NBATCH * 4) mlstm_naive(a, lds, wg, tid, lane, wave);
    __syncthreads();
    const float* lq1 = a.in[10]; const float* lk1 = a.in[11]; const float* lq2 = a.in[12]; const float* lk2 = a.in[13];
    const float lam = __expf(wave_sum(lq1[lane] * lk1[lane])) - __expf(wave_sum(lq2[lane] * lk2[lane])) + LAMBDA_INIT;
    LAS float* sc = (LAS float*)(lds + wave * 16896); LAS float* qsl = sc + 4096;
    unsigned* queue = (unsigned*)(a.ws + WS_CTL) + CW_QUEUE;
    constexpr int NUNITS = T_ * 4 / 8;
    for (;;) {
        unsigned u = 0; if (lane == 0) u = __hip_atomic_fetch_add(queue, 1u, __ATOMIC_RELAXED, __HIP_MEMORY_SCOPE_AGENT);
        u = (unsigned)__builtin_amdgcn_readfirstlane((int)u);
        if (u >= (unsigned)NUNITS) break;
        const int base = (NUNITS - 1 - (int)u) * 8;
        for (int k = 0; k < 8; ++k) attn_naive_row(a, sc, qsl, base + k, lane, lam);
    }
}


namespace ml {
constexpr int QL = 0, KL = 17408, KWT = 34816, VT = 53248, SD = 71680, AV = 80896, MV = 89088, WV = 97280, IT = 105472, FL = 113664;
constexpr int MC = 121856, BEND = 121984, AMAX = 122112, DEC = 122240, NL = 122368, RS = 122880, QN = 123392, PSQ = 123648;
constexpr int QS = 272, TS = 144;
constexpr float L2E = 1.4426950408889634f;
#define LBAR() do { asm volatile("s_waitcnt lgkmcnt(0)" ::: "memory"); __builtin_amdgcn_s_barrier(); asm volatile("" ::: "memory"); } while (0)
__device__ __forceinline__ f32x4 mfma16(bf16x8 a, bf16x8 b, f32x4 c) { return __builtin_amdgcn_mfma_f32_16x16x32_bf16(a, b, c, 0, 0, 0); }
__device__ __forceinline__ unsigned cvtpk(float lo, float hi) { unsigned r; asm volatile("v_cvt_pk_bf16_f32 %0, %1, %2" : "=v"(r) : "v"(lo), "v"(hi)); return r; }
__device__ __forceinline__ unsigned cvtpk_nv(float lo, float hi) { unsigned r; asm("v_cvt_pk_bf16_f32 %0, %1, %2" : "=v"(r) : "v"(lo), "v"(hi)); return r; }
__device__ __forceinline__ f32x2 silu2(f32x2 o) { f32x2 e = o * (-L2E); e.x = __builtin_amdgcn_exp2f(e.x); e.y = __builtin_amdgcn_exp2f(e.y); e = e + 1.0f; e.x = __builtin_amdgcn_rcpf(e.x); e.y = __builtin_amdgcn_rcpf(e.y); return o * e; }

__device__ __forceinline__ void mlstm_item(const Args& a, LAS unsigned char* lds, const int item, const int tid) {
    unsigned char* ws = a.ws;
    const bf16* PROJ = (const bf16*)(ws + WS_PROJ); const float* GATES = (const float*)(ws + WS_GATES); bf16* MIX = (bf16*)(ws + WS_MIX);
    const float* conv_w = a.in[5]; const float* conv_b = a.in[6]; const float* m_norm_w = a.in[7];
    const int wid = __builtin_amdgcn_readfirstlane(tid >> 6), lane = tid & 63, fr = lane & 15, fq = lane >> 4;
    const int b = item >> 2, h = item & 3, e0 = 16 * wid;
    LAS float* AVl = (LAS float*)(lds + AV); LAS float* MVl = (LAS float*)(lds + MV); LAS float* WVl = (LAS float*)(lds + WV); LAS float* ITl = (LAS float*)(lds + IT); LAS float* FLl = (LAS float*)(lds + FL);
    LAS float* MCl = (LAS float*)(lds + MC); LAS float* BENDl = (LAS float*)(lds + BEND); LAS float* AMAXl = (LAS float*)(lds + AMAX); LAS float* DECl = (LAS float*)(lds + DEC);
    LAS float* NLl = (LAS float*)(lds + NL); LAS float* RSl = (LAS float*)(lds + RS); LAS float* QNl = (LAS float*)(lds + QN); LAS float* PSQl = (LAS float*)(lds + PSQ);
#pragma unroll 1
    for (int cc = 0; cc < 4; ++cc) {
        const int c = 4 * wid + cc, t = 64 * c + lane; const float* g = GATES + (size_t)(b * SEQ + t) * 8;
        float bs = g[4 + h]; const float ig = g[h];
#pragma unroll
        for (int o = 1; o < 64; o <<= 1) { const float v = __shfl_up(bs, o); if (lane >= o) bs += v; }
        const float av = ig - bs; float pm = av;
#pragma unroll
        for (int o = 1; o < 64; o <<= 1) { const float v = __shfl_up(pm, o); if (lane >= o) pm = fmaxf(pm, v); }
        AVl[t] = av; MVl[t] = pm; FLl[t] = bs;
        if (lane == 63) { BENDl[c] = bs; AMAXl[c] = pm; }
    }
    if (tid < 128) NLl[tid] = 0.f;
    __syncthreads();
    if (tid == 0) { float m = 0.f; for (int c = 0; c < 32; ++c) { MCl[c] = m; m = BENDl[c] + fmaxf(m, AMAXl[c]); } }
    __syncthreads();
    {
        float av_[4], pm_[4], bs_[4], m63_[4], mc_[4];
#pragma unroll
        for (int k = 0; k < 4; ++k) { const int t = tid + NTHR * k, c = t >> 6; av_[k] = AVl[t]; pm_[k] = MVl[t]; bs_[k] = FLl[t]; mc_[k] = MCl[c]; m63_[k] = fmaxf(mc_[k], MVl[64 * c + 63]); }
        __syncthreads();
#pragma unroll
        for (int k = 0; k < 4; ++k) { const int t = tid + NTHR * k; const float M = fmaxf(mc_[k], pm_[k]);
            AVl[t] = av_[k] * L2E; MVl[t] = M * L2E; WVl[t] = __expf(av_[k] - m63_[k]); ITl[t] = __expf(mc_[k] - M); FLl[t] = __expf(-(bs_[k] + M)); }
        if (tid < 32) DECl[tid] = __expf(MCl[tid] - fmaxf(MCl[tid], AMAXl[tid]));
    }
    __syncthreads();
    const int isk = wid >> 2, r0 = (wid & 3) * 16;
    const int ccol = (isk ? C_MK : C_MQ) + h * 128 + 2 * lane;
    f32x2 cw2[4], cb2;
#pragma unroll
    for (int j = 0; j < 4; ++j) { cw2[j].x = conv_w[j * 1024 + ccol]; cw2[j].y = conv_w[j * 1024 + ccol + 1]; }
    cb2.x = conv_b[ccol]; cb2.y = conv_b[ccol + 1];
    const bf16* qkbase = PROJ + (size_t)(b * SEQ) * NCOL + ccol;
    const bf16* vbase = PROJ + (size_t)(b * SEQ) * NCOL + C_MV + h * 128 + 2 * lane;
    const bf16* obase = PROJ + (size_t)(b * SEQ) * NCOL + C_MO + h * 128 + e0 + 4 * fq;
    const f32x4 mw = *(const f32x4*)(m_norm_w + e0 + 4 * fq);
    unsigned raw[19], vraw[8];
#define ML_LOADS(c_) do { _Pragma("unroll") for (int i = 0; i < 19; ++i) { const int t = 64 * (c_) + r0 - 3 + i; raw[i] = (t >= 0) ? *(const unsigned*)(qkbase + (size_t)(t < 0 ? 0 : t) * NCOL) : 0u; } \
        _Pragma("unroll") for (int i = 0; i < 8; ++i) vraw[i] = *(const unsigned*)(vbase + (size_t)(64 * (c_) + 8 * wid + i) * NCOL); } while (0)
    ML_LOADS(0);
    f32x4 Cacc[8];
#pragma unroll
    for (int i = 0; i < 8; ++i) Cacc[i] = (f32x4){0.f, 0.f, 0.f, 0.f};
#pragma unroll 1
    for (int c = 0; c < SEQ / 64; ++c) {
        {
            f32x2 xx[19];
#pragma unroll
            for (int i = 0; i < 19; ++i) { xx[i].x = bflo(raw[i]); xx[i].y = bfhi(raw[i]); }
            f32x2 oo[16], ee[16];
#pragma unroll
            for (int i = 0; i < 16; ++i) oo[i] = xx[i] * cw2[0] + cb2;
#pragma unroll
            for (int j = 1; j < 4; ++j)
#pragma unroll
                for (int i = 0; i < 16; ++i) oo[i] = xx[i + j] * cw2[j] + oo[i];
#pragma unroll
            for (int i = 0; i < 16; ++i) ee[i] = oo[i] * (-L2E);
#pragma unroll
            for (int i = 0; i < 16; ++i) { ee[i].x = __builtin_amdgcn_exp2f(ee[i].x); ee[i].y = __builtin_amdgcn_exp2f(ee[i].y); }
#pragma unroll
            for (int i = 0; i < 16; ++i) ee[i] = ee[i] + 1.0f;
#pragma unroll
            for (int i = 0; i < 16; ++i) { ee[i].x = __builtin_amdgcn_rcpf(ee[i].x); ee[i].y = __builtin_amdgcn_rcpf(ee[i].y); }
            if (!isk) {
#pragma unroll
                for (int i = 0; i < 16; ++i) oo[i] = oo[i] * ee[i];
#pragma unroll
                for (int i = 0; i < 16; ++i) *(LAS unsigned*)(lds + QL + (r0 + i) * QS + 4 * lane) = cvtpk_nv(oo[i].x, oo[i].y);
            } else {
                f32x2 kv[16];
#pragma unroll
                for (int i = 0; i < 16; ++i) kv[i] = oo[i] * ee[i] * 0.08838834764831845f;
#pragma unroll
                for (int i = 0; i < 16; ++i) *(LAS unsigned*)(lds + KL + (r0 + i) * QS + 4 * lane) = cvtpk_nv(kv[i].x, kv[i].y);
                u32x4 k0a, k0b, k1a, k1b;
#pragma unroll
                for (int q = 0; q < 4; ++q) { const f32x4 w4 = *(const LAS f32x4*)(WVl + 64 * c + r0 + 4 * q);
                    const f32x2 e0_ = kv[4 * q] * w4.x, e1_ = kv[4 * q + 1] * w4.y, e2_ = kv[4 * q + 2] * w4.z, e3_ = kv[4 * q + 3] * w4.w;
                    const unsigned a0 = cvtpk(e0_.x, e1_.x), a1 = cvtpk(e2_.x, e3_.x), b0 = cvtpk(e0_.y, e1_.y), b1 = cvtpk(e2_.y, e3_.y);
                    if (q == 0) { k0a.x = a0; k0a.y = a1; k1a.x = b0; k1a.y = b1; } else if (q == 1) { k0a.z = a0; k0a.w = a1; k1a.z = b0; k1a.w = b1; }
                    else if (q == 2) { k0b.x = a0; k0b.y = a1; k1b.x = b0; k1b.y = b1; } else { k0b.z = a0; k0b.w = a1; k1b.z = b0; k1b.w = b1; } }
                *(LAS u32x4*)(lds + KWT + (2 * lane) * TS + r0 * 2) = k0a; *(LAS u32x4*)(lds + KWT + (2 * lane) * TS + r0 * 2 + 16) = k0b;
                *(LAS u32x4*)(lds + KWT + (2 * lane + 1) * TS + r0 * 2) = k1a; *(LAS u32x4*)(lds + KWT + (2 * lane + 1) * TS + r0 * 2 + 16) = k1b;
            }
            u32x4 v0, v1;
            v0.x = (vraw[0] & 0xffffu) | (vraw[1] << 16); v0.y = (vraw[2] & 0xffffu) | (vraw[3] << 16); v0.z = (vraw[4] & 0xffffu) | (vraw[5] << 16); v0.w = (vraw[6] & 0xffffu) | (vraw[7] << 16);
            v1.x = (vraw[0] >> 16) | (vraw[1] & 0xffff0000u); v1.y = (vraw[2] >> 16) | (vraw[3] & 0xffff0000u); v1.z = (vraw[4] >> 16) | (vraw[5] & 0xffff0000u); v1.w = (vraw[6] >> 16) | (vraw[7] & 0xffff0000u);
            *(LAS u32x4*)(lds + VT + (2 * lane) * TS + 16 * wid) = v0;
            *(LAS u32x4*)(lds + VT + (2 * lane + 1) * TS + 16 * wid) = v1;
        }
        if (c + 1 < SEQ / 64) ML_LOADS(c + 1);
        u32x2 og[4];
#pragma unroll
        for (int ti = 0; ti < 4; ++ti) og[ti] = *(const u32x2*)(obase + (size_t)(64 * c + 16 * ti + fr) * NCOL);
        LBAR();
        {
            const int ti = wid >> 1, half = wid & 1; float rsum = 0.f;
            const float Mt = MVl[64 * c + 16 * ti + fr];
#pragma unroll
            for (int sx = 0; sx < 2; ++sx) {
                const int si = 2 * half + sx; f32x4 acc = (f32x4){0.f, 0.f, 0.f, 0.f};
                if (si <= ti) {
#pragma unroll
                    for (int kb = 0; kb < 4; ++kb) {
                        const bf16x8 kf = *(const LAS bf16x8*)(lds + KL + (16 * si + fr) * QS + (32 * kb + 8 * fq) * 2);
                        const bf16x8 qf = *(const LAS bf16x8*)(lds + QL + (16 * ti + fr) * QS + (32 * kb + 8 * fq) * 2);
                        acc = mfma16(kf, qf, acc); }
                    const f32x4 av = *(const LAS f32x4*)(AVl + 64 * c + 16 * si + 4 * fq);
#pragma unroll
                    for (int j = 0; j < 4; ++j) { const int s = 16 * si + 4 * fq + j, t = 16 * ti + fr; const float dd = (s <= t) ? __builtin_amdgcn_exp2f(av[j] - Mt) : 0.f; acc[j] *= dd; rsum += acc[j]; }
                }
                u32x2 o; o.x = cvtpk(acc[0], acc[1]); o.y = cvtpk(acc[2], acc[3]);
                *(LAS u32x2*)(lds + SD + (16 * ti + fr) * TS + (16 * si + 4 * fq) * 2) = o;
            }
            rsum += __shfl_xor(rsum, 16); rsum += __shfl_xor(rsum, 32);
            if (fq == 0) RSl[(16 * ti + fr) * 2 + half] = rsum;
        }
        {
            const int t = tid >> 3, part = tid & 7;
            const u32x4 qa = *(const LAS u32x4*)(lds + QL + t * QS + part * 32), qb = *(const LAS u32x4*)(lds + QL + t * QS + part * 32 + 16);
            const f32x4 n0 = *(const LAS f32x4*)(NLl + 16 * part), n1 = *(const LAS f32x4*)(NLl + 16 * part + 4), n2 = *(const LAS f32x4*)(NLl + 16 * part + 8), n3 = *(const LAS f32x4*)(NLl + 16 * part + 12);
            float s = bflo(qa.x) * n0.x + bfhi(qa.x) * n0.y + bflo(qa.y) * n0.z + bfhi(qa.y) * n0.w + bflo(qa.z) * n1.x + bfhi(qa.z) * n1.y + bflo(qa.w) * n1.z + bfhi(qa.w) * n1.w
                    + bflo(qb.x) * n2.x + bfhi(qb.x) * n2.y + bflo(qb.y) * n2.z + bfhi(qb.y) * n2.w + bflo(qb.z) * n3.x + bfhi(qb.z) * n3.y + bflo(qb.w) * n3.z + bfhi(qb.w) * n3.w;
            s += __shfl_xor(s, 1); s += __shfl_xor(s, 2); s += __shfl_xor(s, 4);
            if (part == 0) QNl[t] = s;
        }
        LBAR();
        f32x4 hacc[4]; float inter[4];
        {
            bf16x8 cf[4];
#pragma unroll
            for (int kb = 0; kb < 4; ++kb) { u32x4 w; w.x = cvtpk(Cacc[2 * kb][0], Cacc[2 * kb][1]); w.y = cvtpk(Cacc[2 * kb][2], Cacc[2 * kb][3]); w.z = cvtpk(Cacc[2 * kb + 1][0], Cacc[2 * kb + 1][1]); w.w = cvtpk(Cacc[2 * kb + 1][2], Cacc[2 * kb + 1][3]);
                cf[kb] = __builtin_bit_cast(bf16x8, w); }
#pragma unroll
            for (int ti = 0; ti < 4; ++ti) {
                hacc[ti] = (f32x4){0.f, 0.f, 0.f, 0.f};
#pragma unroll
                for (int kb = 0; kb < 4; ++kb) {
                    const u32x2 lo = *(const LAS u32x2*)(lds + QL + (16 * ti + fr) * QS + (32 * kb + 4 * fq) * 2), hi = *(const LAS u32x2*)(lds + QL + (16 * ti + fr) * QS + (32 * kb + 16 + 4 * fq) * 2);
                    const u32x4 qq = (u32x4){lo.x, lo.y, hi.x, hi.y};
                    hacc[ti] = mfma16(cf[kb], __builtin_bit_cast(bf16x8, qq), hacc[ti]); }
                inter[ti] = ITl[64 * c + 16 * ti + fr];
                hacc[ti] = hacc[ti] * inter[ti];
            }
        }
        {
            bf16x8 vf[2];
#pragma unroll
            for (int ks = 0; ks < 2; ++ks) vf[ks] = *(const LAS bf16x8*)(lds + VT + (e0 + fr) * TS + (32 * ks + 8 * fq) * 2);
#pragma unroll
            for (int ti = 0; ti < 4; ++ti)
#pragma unroll
                for (int ks = 0; ks < 2; ++ks) if (ks == 0 || ti >= 2) {
                    const bf16x8 sf = *(const LAS bf16x8*)(lds + SD + (16 * ti + fr) * TS + (32 * ks + 8 * fq) * 2);
                    hacc[ti] = mfma16(vf[ks], sf, hacc[ti]); }
            const float decay = DECl[c];
            float nsum = 0.f;
#pragma unroll
            for (int i = 0; i < 8; ++i) {
                Cacc[i] = Cacc[i] * decay;
#pragma unroll
                for (int ks = 0; ks < 2; ++ks) {
                    const bf16x8 kwf = *(const LAS bf16x8*)(lds + KWT + (16 * i + fr) * TS + (32 * ks + 8 * fq) * 2);
                    Cacc[i] = mfma16(kwf, vf[ks], Cacc[i]); }
            }
#pragma unroll
            for (int ks = 0; ks < 2; ++ks) {
                const u32x4 kk = *(const LAS u32x4*)(lds + KWT + (16 * wid + fr) * TS + (32 * ks + 8 * fq) * 2);
                nsum += (bflo(kk.x) + bfhi(kk.x)) + (bflo(kk.y) + bfhi(kk.y)) + (bflo(kk.z) + bfhi(kk.z)) + (bflo(kk.w) + bfhi(kk.w)); }
            nsum += __shfl_xor(nsum, 16); nsum += __shfl_xor(nsum, 32);
            if (fq == 0) NLl[16 * wid + fr] = decay * NLl[16 * wid + fr] + nsum;
        }
        f32x4 hm[4];
#pragma unroll
        for (int ti = 0; ti < 4; ++ti) {
            const int t = 16 * ti + fr;
            const float den = RSl[2 * t] + RSl[2 * t + 1] + inter[ti] * QNl[t];
            const float rd = __builtin_amdgcn_rcpf(fmaxf(fabsf(den), FLl[64 * c + t]));
            const f32x4 gg = (f32x4){bflo(og[ti].x), bfhi(og[ti].x), bflo(og[ti].y), bfhi(og[ti].y)};
            hm[ti] = hacc[ti] * gg * rd;
            float psq = (hm[ti][0] * hm[ti][0] + hm[ti][1] * hm[ti][1]) + (hm[ti][2] * hm[ti][2] + hm[ti][3] * hm[ti][3]);
            psq += __shfl_xor(psq, 16); psq += __shfl_xor(psq, 32);
            if (fq == 0) PSQl[t * 8 + wid] = psq;
        }
        LBAR();
#pragma unroll
        for (int ti = 0; ti < 4; ++ti) {
            const int t = 16 * ti + fr;
            const f32x4 p0 = *(const LAS f32x4*)(PSQl + t * 8), p1 = *(const LAS f32x4*)(PSQl + t * 8 + 4);
            const float r = rsqrtf(((p0.x + p0.y) + (p0.z + p0.w) + (p1.x + p1.y) + (p1.z + p1.w)) * (1.f / 128.f) + EPS);
            const f32x4 ov = hm[ti] * mw * r;
            u32x2 o; o.x = cvtpk(ov[0], ov[1]); o.y = cvtpk(ov[2], ov[3]);
            *(u32x2*)(MIX + (size_t)(b * SEQ + 64 * c + t) * DM + h * 128 + e0 + 4 * fq) = o;
        }
    }
#undef ML_LOADS
}
}

namespace att {
using s16x4  = __attribute__((ext_vector_type(4))) short;
using f32x16 = __attribute__((ext_vector_type(16))) float;
constexpr int SHM_V = 16384, SHM_K = 16384;
constexpr float THR2 = 11.5415603f;
#define KSWZ(row, colB) ((row) * 256 + ((colB) ^ (((row) & 7) << 4)))
#define SBAR() __builtin_amdgcn_sched_barrier(0)
__device__ __forceinline__ int crow(int r, int hi) { return (r & 3) + 8 * (r >> 2) + 4 * hi; }
__device__ __forceinline__ unsigned cvtpk(float lo, float hi) { unsigned r; asm volatile("v_cvt_pk_bf16_f32 %0, %1, %2" : "=v"(r) : "v"(lo), "v"(hi)); return r; }
__device__ __forceinline__ void partialSM(f32x16& p0, f32x16& p1, float& m_reg, float& mn, float& alpha) {
  float pmax = p0[0];
#pragma unroll
  for (int r = 1; r < 16; ++r) pmax = fmaxf(pmax, p0[r]);
#pragma unroll
  for (int r = 0; r < 16; ++r) pmax = fmaxf(pmax, p1[r]);
  { auto rr = __builtin_amdgcn_permlane32_swap(__float_as_uint(pmax), __float_as_uint(pmax), false, false);
    pmax = fmaxf(__uint_as_float(rr[0]), __uint_as_float(rr[1])); }
  if (__builtin_expect(__all(pmax - m_reg <= THR2), 1)) { mn = m_reg; alpha = 1.f; }
  else { mn = fmaxf(m_reg, pmax); alpha = __builtin_amdgcn_exp2f(m_reg - mn); m_reg = mn; }
#pragma unroll
  for (int r = 0; r < 16; ++r) p0[r] = p0[r] - mn;
#pragma unroll
  for (int r = 0; r < 16; ++r) p1[r] = p1[r] - mn;
#pragma unroll
  for (int r = 0; r < 16; ++r) p0[r] = __builtin_amdgcn_exp2f(p0[r]);
}
__device__ __forceinline__ void finishSM(f32x16& p0, f32x16& p1, float alpha, float& l_reg, bf16x8& pa0, bf16x8& pa1, bf16x8& pa2, bf16x8& pa3) {
#pragma unroll
  for (int r = 0; r < 16; ++r) p1[r] = __builtin_amdgcn_exp2f(p1[r]);
  float ps = 0;
#pragma unroll
  for (int r = 0; r < 16; ++r) ps += p0[r];
#pragma unroll
  for (int r = 0; r < 16; ++r) ps += p1[r];
  { auto rr = __builtin_amdgcn_permlane32_swap(__float_as_uint(ps), __float_as_uint(ps), false, false);
    ps = __uint_as_float(rr[0]) + __uint_as_float(rr[1]); }
  l_reg = l_reg * alpha + ps;
#define PK4(P, BASE, OUT) do { unsigned a0 = cvtpk(P[BASE + 0], P[BASE + 1]), a1 = cvtpk(P[BASE + 2], P[BASE + 3]);   \
    unsigned b0 = cvtpk(P[BASE + 4], P[BASE + 5]), b1 = cvtpk(P[BASE + 6], P[BASE + 7]);                              \
    auto r0 = __builtin_amdgcn_permlane32_swap(a0, b0, false, false); auto r1 = __builtin_amdgcn_permlane32_swap(a1, b1, false, false); \
    u32x4 w = {r0[0], r1[0], r0[1], r1[1]}; OUT = __builtin_bit_cast(bf16x8, w); } while (0)
  PK4(p0, 0, pa0); PK4(p0, 8, pa1); PK4(p1, 0, pa2); PK4(p1, 8, pa3);
#undef PK4
}
__device__ __forceinline__ void partialFX(f32x16& p0) {
#pragma unroll
  for (int r = 0; r < 16; ++r) p0[r] = __builtin_amdgcn_exp2f(p0[r]);
}
__device__ __forceinline__ void finishFX(f32x16& p0, f32x16& p1, float& l_reg, bf16x8& pa0, bf16x8& pa1, bf16x8& pa2, bf16x8& pa3) {
#pragma unroll
  for (int r = 0; r < 16; ++r) p1[r] = __builtin_amdgcn_exp2f(p1[r]);
  float ps = 0;
#pragma unroll
  for (int r = 0; r < 16; ++r) ps += p0[r];
#pragma unroll
  for (int r = 0; r < 16; ++r) ps += p1[r];
  l_reg += ps;
#define PK4(P, BASE, OUT) do { unsigned a0 = cvtpk(P[BASE + 0], P[BASE + 1]), a1 = cvtpk(P[BASE + 2], P[BASE + 3]);   \
    unsigned b0 = cvtpk(P[BASE + 4], P[BASE + 5]), b1 = cvtpk(P[BASE + 6], P[BASE + 7]);                              \
    auto r0 = __builtin_amdgcn_permlane32_swap(a0, b0, false, false); auto r1 = __builtin_amdgcn_permlane32_swap(a1, b1, false, false); \
    u32x4 w = {r0[0], r1[0], r0[1], r1[1]}; OUT = __builtin_bit_cast(bf16x8, w); } while (0)
  PK4(p0, 0, pa0); PK4(p0, 8, pa1); PK4(p1, 0, pa2); PK4(p1, 8, pa3);
#undef PK4
}
__device__ __forceinline__ void qkt(f32x16& p0, f32x16& p1, const LAS unsigned char* Ks, const bf16x8 (&qr)[4], int c, int r32, int hi) {
  p0 = f32x16{}; p1 = f32x16{};
#pragma unroll
  for (int d0 = 0; d0 < 4; ++d0) { const int cb = (c * 64 + d0 * 16 + hi * 8) * 2;
    const bf16x8 b0 = *(const LAS bf16x8*)(Ks + KSWZ(r32, cb));
    const bf16x8 b1 = *(const LAS bf16x8*)(Ks + KSWZ(32 + r32, cb));
    p0 = __builtin_amdgcn_mfma_f32_32x32x16_bf16(b0, qr[d0], p0, 0, 0, 0);
    p1 = __builtin_amdgcn_mfma_f32_32x32x16_bf16(b1, qr[d0], p1, 0, 0, 0); }
}
__device__ __forceinline__ int v_st(int k, int c) { const int kk = (k & ~0xC) | ((k & 4) << 1) | ((k & 8) >> 1); return ((kk >> 3) * 4 + (c >> 5)) * 512 + ((kk & 7) * 32 + (c & 31)) * 2; }
__device__ __forceinline__ int v_rd_base(int lane) { return ((lane & 3) << 3) | (((lane >> 2) & 3) << 6) | (((lane >> 4) & 1) << 5) | (((lane >> 5) & 1) << 8); }
constexpr int v_rd_off(int d0, int ks, int half) { return d0 * 512 + ks * 4096 + half * 2048; }
template <int OFF> __device__ __forceinline__ s16x4 tr_read(int vb) {
  s16x4 r; asm volatile("ds_read_b64_tr_b16 %0, %1 offset:%2" : "=&v"(r) : "v"(vb), "i"(OFF) : "memory"); return r;
}
template <int D0> __device__ __forceinline__ void pv_one(f32x16& od, int vb, bf16x8 pa0, bf16x8 pa1, bf16x8 pa2, bf16x8 pa3) {
  const s16x4 l0 = tr_read<v_rd_off(D0, 0, 0)>(vb), h0 = tr_read<v_rd_off(D0, 0, 1)>(vb), l1 = tr_read<v_rd_off(D0, 1, 0)>(vb), h1 = tr_read<v_rd_off(D0, 1, 1)>(vb);
  const s16x4 l2 = tr_read<v_rd_off(D0, 2, 0)>(vb), h2 = tr_read<v_rd_off(D0, 2, 1)>(vb), l3 = tr_read<v_rd_off(D0, 3, 0)>(vb), h3 = tr_read<v_rd_off(D0, 3, 1)>(vb);
  asm volatile("s_waitcnt lgkmcnt(0)" ::: "memory"); SBAR();
#define PK(L, H) (bf16x8){L[0], L[1], L[2], L[3], H[0], H[1], H[2], H[3]}
  od = __builtin_amdgcn_mfma_f32_32x32x16_bf16(pa0, PK(l0, h0), od, 0, 0, 0);
  od = __builtin_amdgcn_mfma_f32_32x32x16_bf16(pa1, PK(l1, h1), od, 0, 0, 0);
  od = __builtin_amdgcn_mfma_f32_32x32x16_bf16(pa2, PK(l2, h2), od, 0, 0, 0);
  od = __builtin_amdgcn_mfma_f32_32x32x16_bf16(pa3, PK(l3, h3), od, 0, 0, 0);
#undef PK
}
#define PVRD(D0) const s16x4 l0_##D0 = tr_read<v_rd_off(D0, 0, 0)>(vb), h0_##D0 = tr_read<v_rd_off(D0, 0, 1)>(vb), l1_##D0 = tr_read<v_rd_off(D0, 1, 0)>(vb), h1_##D0 = tr_read<v_rd_off(D0, 1, 1)>(vb), \
    l2_##D0 = tr_read<v_rd_off(D0, 2, 0)>(vb), h2_##D0 = tr_read<v_rd_off(D0, 2, 1)>(vb), l3_##D0 = tr_read<v_rd_off(D0, 3, 0)>(vb), h3_##D0 = tr_read<v_rd_off(D0, 3, 1)>(vb)
#define PVPK(L, H) (bf16x8){L[0], L[1], L[2], L[3], H[0], H[1], H[2], H[3]}
#define PVMM(D0, N) do { asm volatile("s_waitcnt lgkmcnt(" #N ")" ::: "memory"); SBAR(); \
    o[D0] = __builtin_amdgcn_mfma_f32_32x32x16_bf16(pa0, PVPK(l0_##D0, h0_##D0), o[D0], 0, 0, 0); o[D0] = __builtin_amdgcn_mfma_f32_32x32x16_bf16(pa1, PVPK(l1_##D0, h1_##D0), o[D0], 0, 0, 0); \
    o[D0] = __builtin_amdgcn_mfma_f32_32x32x16_bf16(pa2, PVPK(l2_##D0, h2_##D0), o[D0], 0, 0, 0); o[D0] = __builtin_amdgcn_mfma_f32_32x32x16_bf16(pa3, PVPK(l3_##D0, h3_##D0), o[D0], 0, 0, 0); } while (0)
__device__ __forceinline__ void pv_d0(f32x16* o, int vb, bf16x8 pa0, bf16x8 pa1, bf16x8 pa2, bf16x8 pa3) {
  PVRD(0); PVRD(1); PVMM(0, 8); PVRD(2); PVMM(1, 8); PVRD(3); PVMM(2, 8); PVMM(3, 0);
}
#undef PVRD
#undef PVPK
#undef PVMM

template <bool FX>
__device__ __forceinline__ void attn_unit(const bf16* __restrict__ PROJ, bf16* __restrict__ MIX, const float* __restrict__ anw, const float lam, const float nb, const int b, const int h, const int qb,
                                          LAS unsigned char* lds, const int tid) {
  const int wid = __builtin_amdgcn_readfirstlane(tid >> 6), lane = tid & 63, r32 = lane & 31, hi = lane >> 5, g = wid >> 1, c = wid & 1;
  const int q0 = qb * 128, NT = 2 * qb + 2; const bool masked_last = (g < 2);
  int hcol = h * 128; asm volatile("" : "+s"(hcol));
  const char* Kg = (const char*)(PROJ + (size_t)(b * SEQ) * NCOL + C_AK + hcol);
  const char* Vg = (const char*)(PROJ + (size_t)(b * SEQ) * NCOL + C_AV + hcol);
  LAS float* wsf = (LAS float*)(lds + 131072) + wid * 64; LAS float* li_l = wsf; LAS float* al_l = wsf + 32;
  unsigned koff[2], voff[2];
#pragma unroll
  for (int p = 0; p < 2; ++p) { const int s = (wid * 2 + p) * 64 + lane, row = s >> 4, ch = (s & 15) ^ (row & 7); koff[p] = (unsigned)(row * NCOL + ch * 8) * 2u;
    const int o = s * 16, sub = o >> 9, within = o & 511, kk = (sub >> 2) * 8 + (within >> 6), k = (kk & ~0xC) | ((kk & 4) << 1) | ((kk & 8) >> 1), cc = (sub & 3) * 32 + ((within & 63) >> 4) * 8;
    voff[p] = (unsigned)(k * NCOL + cc) * 2u; }
#define DMA(tile, slot) do { const char* kt_ = Kg + (size_t)(tile) * (64 * NCOL * 2); const char* vt_ = Vg + (size_t)(tile) * (64 * NCOL * 2); LAS unsigned char* sl_ = lds + (slot) * 32768 + wid * 2048; \
    _Pragma("unroll") for (int p_ = 0; p_ < 2; ++p_) __builtin_amdgcn_global_load_lds((const unsigned*)(kt_ + koff[p_]), (LAS unsigned*)(sl_ + p_ * 1024), 16, 0, 0); \
    _Pragma("unroll") for (int p_ = 0; p_ < 2; ++p_) __builtin_amdgcn_global_load_lds((const unsigned*)(vt_ + voff[p_]), (LAS unsigned*)(sl_ + 16384 + p_ * 1024), 16, 0, 0); } while (0)
#define WB4() do { asm volatile("s_waitcnt vmcnt(4)" ::: "memory"); __builtin_amdgcn_s_barrier(); asm volatile("" ::: "memory"); } while (0)
#define WB8() do { asm volatile("s_waitcnt vmcnt(8)" ::: "memory"); __builtin_amdgcn_s_barrier(); asm volatile("" ::: "memory"); } while (0)
#define KSLOT(j) (lds + ((j) & 3) * 32768)
#define VSLOT(j) (vb0 + ((j) & 3) * 32768)
  float m_reg = -1e30f, l_reg = 0; f32x16 o[4] = {}; bf16x8 qr[4];
  { const bf16* Qw = PROJ + (size_t)(b * SEQ + q0 + 32 * g + r32) * NCOL + C_AQ + hcol + c * 64 + hi * 8;
#pragma unroll
    for (int d0 = 0; d0 < 4; ++d0) qr[d0] = *(const bf16x8*)(Qw + d0 * 16); }
  const int vb0 = (int)(unsigned)(uintptr_t)lds + 16384 + v_rd_base(lane);
#define RESC(a) do { if (__any((a) < 1.f)) { if (hi == 0) al_l[r32] = (a); asm volatile("s_waitcnt lgkmcnt(0)" ::: "memory"); \
    _Pragma("unroll") for (int d = 0; d < 4; ++d) _Pragma("unroll") for (int r = 0; r < 16; ++r) o[d][r] *= al_l[crow(r, hi)]; } } while (0)
  f32x16 p0, p1; float mn, al; bf16x8 pa0, pa1, pa2, pa3;
  DMA(0, 0); DMA(1, 1);
#pragma unroll 1
  for (int j = 0; j < NT; ++j) {
    WB4();
    DMA((j + 2 < NT ? j + 2 : NT - 1), (j + 2) & 3);
    SBAR(); qkt(p0, p1, KSLOT(j), qr, c, r32, hi);
    if (masked_last && j == NT - 1) {
#pragma unroll
      for (int r = 0; r < 16; ++r) { p0[r] = -1e30f; p1[r] = -1e30f; } }
    if constexpr (FX) { SBAR(); partialFX(p0); finishFX(p0, p1, l_reg, pa0, pa1, pa2, pa3); SBAR(); }
    else { partialSM(p0, p1, m_reg, mn, al); RESC(al); finishSM(p0, p1, al, l_reg, pa0, pa1, pa2, pa3); SBAR(); }
    pv_d0(o, VSLOT(j), pa0, pa1, pa2, pa3);
  }
  if constexpr (FX) l_reg += __shfl_xor(l_reg, 32);
  asm volatile("s_waitcnt vmcnt(0)" ::: "memory");
#undef DMA
#undef WB4
#undef WB8
#undef KSLOT
#undef VSLOT
  if (hi == 0) li_l[r32] = l_reg; asm volatile("s_waitcnt lgkmcnt(0)" ::: "memory");
  int lane2 = lane; asm volatile("" : "+v"(lane2));
  const int r32b = lane2 & 31, hib = lane2 >> 5;
  float rli[16];
#pragma unroll
  for (int r = 0; r < 16; ++r) rli[r] = __builtin_amdgcn_rcpf(li_l[(r & 3) + 8 * (r >> 2) + 4 * hib]);
  __syncthreads();
  LAS float* X = (LAS float*)(lds + g * 16384) + hib * 512 + r32b;
  if (c == 1) {
#pragma unroll
    for (int r = 0; r < 16; ++r)
#pragma unroll
      for (int d0 = 0; d0 < 4; ++d0) X[((r & 3) + 8 * (r >> 2)) * 128 + d0 * 32] = o[d0][r] * (rli[r] * lam);
  }
  __syncthreads();
  if (c == 0) {
    float ss[16];
#pragma unroll
    for (int r = 0; r < 16; ++r) { ss[r] = 0.f;
#pragma unroll
      for (int d0 = 0; d0 < 4; ++d0) { const float v = o[d0][r] * rli[r] - X[((r & 3) + 8 * (r >> 2)) * 128 + d0 * 32]; o[d0][r] = v; ss[r] += v * v; } }
#pragma unroll
    for (int r = 0; r < 16; ++r) {
#pragma unroll
      for (int s = 1; s < 32; s <<= 1) ss[r] += __shfl_xor(ss[r], s);
      ss[r] = rsqrtf(ss[r] * (1.f / 128.f) + EPS) * (1.f - LAMBDA_INIT); }
    float aw[4];
#pragma unroll
    for (int d0 = 0; d0 < 4; ++d0) aw[d0] = anw[d0 * 32 + r32b];
    asm volatile("s_waitcnt lgkmcnt(0)" ::: "memory");
    LAS bf16* Ost = (LAS bf16*)(lds + g * 16384);
    LAS bf16* Ow = Ost + hib * 512 + r32b;
#pragma unroll
    for (int r = 0; r < 16; ++r)
#pragma unroll
      for (int d0 = 0; d0 < 4; ++d0) Ow[((r & 3) + 8 * (r >> 2)) * 128 + d0 * 32] = (bf16)f2bf(o[d0][r] * ss[r] * aw[d0]);
    asm volatile("s_waitcnt lgkmcnt(0)" ::: "memory");
    const int rowb = lane2 >> 4, c16 = lane2 & 15;
    bf16* Ob = MIX + (size_t)(b * SEQ + q0 + 32 * g + rowb) * DM + 512 + h * 128 + c16 * 8;
    const LAS bf16* Os = Ost + rowb * 128 + c16 * 8;
#pragma unroll
    for (int k = 0; k < 8; ++k) *(u32x4*)(Ob + (size_t)k * 4 * DM) = *(const LAS u32x4*)(Os + k * 512);
  }
  __syncthreads();
#undef RESC
}

template <int C, int HALF_> __device__ __forceinline__ void half_scores(f32x16& p, const LAS unsigned char* Ks, const bf16x8 (&qr)[8], const int kaddr) {
  p = f32x16{};
#pragma unroll
  for (int d0 = 0; d0 < 4; ++d0) { const bf16x8 kf = *(const LAS bf16x8*)(Ks + (kaddr ^ (d0 * 32)) + C * 128 + HALF_ * 8192);
    p = __builtin_amdgcn_mfma_f32_32x32x16_bf16(kf, qr[C * 4 + d0], p, 0, 0, 0); }
}
__device__ __forceinline__ void half_softmax(f32x16& p, float& l_reg, bf16x8& pa, bf16x8& pb) {
#pragma unroll
  for (int r = 0; r < 16; ++r) p[r] = __builtin_amdgcn_exp2f(p[r]);
  float ps = 0;
#pragma unroll
  for (int r = 0; r < 16; ++r) ps += p[r];
  l_reg += ps;
#define PK4(P, BASE, OUT) do { unsigned a0 = cvtpk(P[BASE + 0], P[BASE + 1]), a1 = cvtpk(P[BASE + 2], P[BASE + 3]);   \
    unsigned b0 = cvtpk(P[BASE + 4], P[BASE + 5]), b1 = cvtpk(P[BASE + 6], P[BASE + 7]);                              \
    auto r0 = __builtin_amdgcn_permlane32_swap(a0, b0, false, false); auto r1 = __builtin_amdgcn_permlane32_swap(a1, b1, false, false); \
    u32x4 w = {r0[0], r1[0], r0[1], r1[1]}; OUT = __builtin_bit_cast(bf16x8, w); } while (0)
  PK4(p, 0, pa); PK4(p, 8, pb);
#undef PK4
  SBAR();
}
template <int D0, int HALF_> __device__ __forceinline__ void pv_half(f32x16& oa, f32x16& ob, int vb, bf16x8 a0, bf16x8 a1, bf16x8 b0, bf16x8 b1) {
  const s16x4 l0 = tr_read<v_rd_off(D0, 2 * HALF_, 0)>(vb), h0 = tr_read<v_rd_off(D0, 2 * HALF_, 1)>(vb), l1 = tr_read<v_rd_off(D0, 2 * HALF_ + 1, 0)>(vb), h1 = tr_read<v_rd_off(D0, 2 * HALF_ + 1, 1)>(vb);
  asm volatile("s_waitcnt lgkmcnt(0)" ::: "memory"); SBAR();
#define PK(L, H) (bf16x8){L[0], L[1], L[2], L[3], H[0], H[1], H[2], H[3]}
  oa = __builtin_amdgcn_mfma_f32_32x32x16_bf16(a0, PK(l0, h0), oa, 0, 0, 0);
  ob = __builtin_amdgcn_mfma_f32_32x32x16_bf16(b0, PK(l0, h0), ob, 0, 0, 0);
  oa = __builtin_amdgcn_mfma_f32_32x32x16_bf16(a1, PK(l1, h1), oa, 0, 0, 0);
  ob = __builtin_amdgcn_mfma_f32_32x32x16_bf16(b1, PK(l1, h1), ob, 0, 0, 0);
#undef PK
  SBAR();
}
__device__ __forceinline__ void attn2_setup(LAS unsigned char* lds, const int tid) {
  const int wid = __builtin_amdgcn_readfirstlane(tid >> 6), lane = tid & 63;
  unsigned koff[2], voff[2];
#pragma unroll
  for (int p = 0; p < 2; ++p) { const int s = (wid * 2 + p) * 64 + lane, row = s >> 4, ch = (s & 15) ^ (row & 7); koff[p] = (unsigned)(row * NCOL + ch * 8) * 2u;
    const int o = s * 16, sub = o >> 9, within = o & 511, kk = (sub >> 2) * 8 + (within >> 6), k = (kk & ~0xC) | ((kk & 4) << 1) | ((kk & 8) >> 1), cc = (sub & 3) * 32 + ((within & 63) >> 4) * 8;
    voff[p] = (unsigned)(k * NCOL + cc) * 2u; }
  *((LAS u32x4*)(lds + 133120 + wid * 1024) + lane) = (u32x4){koff[0], koff[1], voff[0], voff[1]};
  asm volatile("s_waitcnt lgkmcnt(0)" ::: "memory");
}
__device__ __forceinline__ void attn_unit2(const bf16* __restrict__ PROJ, bf16* __restrict__ MIX, const float* __restrict__ anw, const float lam, const int b, const int h, const int qb,
                                           LAS unsigned char* lds, const int tid) {
  const int wid = __builtin_amdgcn_readfirstlane(tid >> 6), lane = tid & 63, r32 = lane & 31, hi = lane >> 5;
  const int q0 = qb * 256, NT = 4 * qb + 4, jlast = 4 * qb + (wid >> 1);
  int hcol = h * 128; asm volatile("" : "+s"(hcol));
  const char* Kg = (const char*)(PROJ + (size_t)(b * SEQ) * NCOL + C_AK + hcol);
  const char* Vg = (const char*)(PROJ + (size_t)(b * SEQ) * NCOL + C_AV + hcol);
  LAS float* wsf = (LAS float*)(lds + 131072) + wid * 64;
  LAS u32x4* offt = (LAS u32x4*)(lds + 133120 + wid * 1024) + lane;
#define DMA(tile, slot) do { const char* kt_ = Kg + (size_t)(tile) * (64 * NCOL * 2); const char* vt_ = Vg + (size_t)(tile) * (64 * NCOL * 2); LAS unsigned char* sl_ = lds + (slot) * 32768 + wid * 2048; const u32x4 of_ = *offt; \
    __builtin_amdgcn_global_load_lds((const unsigned*)(kt_ + of_.x), (LAS unsigned*)(sl_), 16, 0, 0); __builtin_amdgcn_global_load_lds((const unsigned*)(kt_ + of_.y), (LAS unsigned*)(sl_ + 1024), 16, 0, 0); \
    __builtin_amdgcn_global_load_lds((const unsigned*)(vt_ + of_.z), (LAS unsigned*)(sl_ + 16384), 16, 0, 0); __builtin_amdgcn_global_load_lds((const unsigned*)(vt_ + of_.w), (LAS unsigned*)(sl_ + 16384 + 1024), 16, 0, 0); } while (0)
#define WB4() do { asm volatile("s_waitcnt vmcnt(4)" ::: "memory"); __builtin_amdgcn_s_barrier(); asm volatile("" ::: "memory"); } while (0)
  float l0 = 0.f, l1 = 0.f; f32x16 oa[4] = {}, ob[4] = {}; bf16x8 qr[8];
  { const bf16* Qw = PROJ + (size_t)(b * SEQ + q0 + 32 * wid + r32) * NCOL + C_AQ + hcol + hi * 8;
#pragma unroll
    for (int d = 0; d < 8; ++d) qr[d] = *(const bf16x8*)(Qw + d * 16); }
  const int vb0 = (int)(unsigned)(uintptr_t)lds + 16384 + v_rd_base(lane);
  const int kaddr = r32 * 256 + ((hi * 16) ^ ((r32 & 7) << 4));
  DMA(0, 0); DMA(1, 1);
#pragma unroll 1
  for (int j = 0; j < NT; ++j) {
    WB4();
    DMA((j + 2 < NT ? j + 2 : NT - 1), (j + 2) & 3);
    if (j <= jlast) {
      const LAS unsigned char* Ks = lds + (j & 3) * 32768; const int vb = vb0 + (j & 3) * 32768;
      f32x16 p; bf16x8 a0, a1, b0, b1;
      SBAR(); half_scores<0, 0>(p, Ks, qr, kaddr); half_softmax(p, l0, a0, a1);
      SBAR(); half_scores<1, 0>(p, Ks, qr, kaddr); half_softmax(p, l1, b0, b1); SBAR();
      pv_half<0, 0>(oa[0], ob[0], vb, a0, a1, b0, b1); pv_half<1, 0>(oa[1], ob[1], vb, a0, a1, b0, b1); pv_half<2, 0>(oa[2], ob[2], vb, a0, a1, b0, b1); pv_half<3, 0>(oa[3], ob[3], vb, a0, a1, b0, b1);
      SBAR(); half_scores<0, 1>(p, Ks, qr, kaddr); half_softmax(p, l0, a0, a1);
      SBAR(); half_scores<1, 1>(p, Ks, qr, kaddr); half_softmax(p, l1, b0, b1); SBAR();
      pv_half<0, 1>(oa[0], ob[0], vb, a0, a1, b0, b1); pv_half<1, 1>(oa[1], ob[1], vb, a0, a1, b0, b1); pv_half<2, 1>(oa[2], ob[2], vb, a0, a1, b0, b1); pv_half<3, 1>(oa[3], ob[3], vb, a0, a1, b0, b1);
    }
  }
  l0 += __shfl_xor(l0, 32); l1 += __shfl_xor(l1, 32);
  asm volatile("s_waitcnt vmcnt(0)" ::: "memory");
  if (hi == 0) { wsf[r32] = l0; wsf[32 + r32] = l1; } asm volatile("s_waitcnt lgkmcnt(0)" ::: "memory");
  int lane2 = lane; asm volatile("" : "+v"(lane2));
  const int r32b = lane2 & 31, hib = lane2 >> 5;
  __syncthreads();
  float ss[16];
#pragma unroll
  for (int r = 0; r < 16; ++r) { const int row = (r & 3) + 8 * (r >> 2) + 4 * hib; const float c0 = __builtin_amdgcn_rcpf(wsf[row]), c1 = lam * __builtin_amdgcn_rcpf(wsf[32 + row]); ss[r] = 0.f;
#pragma unroll
    for (int d0 = 0; d0 < 4; ++d0) { const float v = oa[d0][r] * c0 - ob[d0][r] * c1; oa[d0][r] = v; ss[r] += v * v; } }
#pragma unroll
  for (int r = 0; r < 16; ++r) {
#pragma unroll
    for (int s = 1; s < 32; s <<= 1) ss[r] += __shfl_xor(ss[r], s);
    ss[r] = rsqrtf(ss[r] * (1.f / 128.f) + EPS) * (1.f - LAMBDA_INIT); }
  float aw[4];
#pragma unroll
  for (int d0 = 0; d0 < 4; ++d0) aw[d0] = anw[d0 * 32 + r32b];
  LAS bf16* Ost = (LAS bf16*)(lds + wid * 8192);
  LAS bf16* Ow = Ost + hib * 512 + r32b;
#pragma unroll
  for (int r = 0; r < 16; ++r)
#pragma unroll
    for (int d0 = 0; d0 < 4; ++d0) Ow[((r & 3) + 8 * (r >> 2)) * 128 + d0 * 32] = (bf16)f2bf(oa[d0][r] * ss[r] * aw[d0]);
  asm volatile("s_waitcnt lgkmcnt(0)" ::: "memory");
  const int rowb = lane2 >> 4, c16 = lane2 & 15;
  bf16* Ob = MIX + (size_t)(b * SEQ + q0 + 32 * wid + rowb) * DM + 512 + h * 128 + c16 * 8;
  const LAS bf16* Os = Ost + rowb * 128 + c16 * 8;
#pragma unroll
  for (int k = 0; k < 8; ++k) *(u32x4*)(Ob + (size_t)k * 4 * DM) = *(const LAS u32x4*)(Os + k * 512);
  __syncthreads();
#undef DMA
#undef WB4
}
}

template <bool FX>
__device__ __forceinline__ void attn_queue(const bf16* PROJ, bf16* MIX, const float* anw, const float lam, const float nb, unsigned* queue, LAS unsigned char* lds, int tid) {
    LAS unsigned* slot = (LAS unsigned*)(lds + LDSCTL_OFF + 64);
    const int x0 = (int)(xb_xcc_id() & 7u);
    LAS unsigned* peek = (LAS unsigned*)(lds + LDSCTL_OFF + 72);
    if constexpr (FX) att::attn2_setup(lds, tid);
#pragma unroll 1
    for (int k = 0; k < 8; ++k) {
        const int x = (x0 + k) & 7;
        if (k == 1) { if (tid < 8) peek[tid] = __hip_atomic_load(queue + 64 * tid, __ATOMIC_RELAXED, __HIP_MEMORY_SCOPE_AGENT); __syncthreads(); }
        if (k >= 1) { if (peek[x] >= 128u) continue; }
        if (tid == 0) *slot = __hip_atomic_fetch_add(queue + 64 * x, 1u, __ATOMIC_RELAXED, __HIP_MEMORY_SCOPE_AGENT);
        __syncthreads();
        for (;;) {
            const unsigned l = *slot;
            __syncthreads();
            if (l >= 128u) break;
            unsigned nxt = 0u;
            if (tid == 0) nxt = __hip_atomic_fetch_add(queue + 64 * x, 1u, __ATOMIC_RELAXED, __HIP_MEMORY_SCOPE_AGENT);
            const int bh = ((int)l >> 3) * 8 + x, p = (int)l & 7;
            if constexpr (FX) { const int bh2 = ((int)l & 15) * 8 + x, qb2 = 7 - ((int)l >> 4); att::attn_unit2(PROJ, MIX, anw, lam, bh2 >> 2, bh2 & 3, qb2, lds, tid); }
            else {
#pragma unroll 1
                for (int s = 0; s < 2; ++s) att::attn_unit<false>(PROJ, MIX, anw, lam, nb, bh >> 2, bh & 3, s ? p : 15 - p, lds, tid); }
            if (tid == 0) *slot = nxt;
            __syncthreads();
        }
    }
}
__device__ __forceinline__ void p2_fast_attn(const Args& a, LAS unsigned char* lds, int tid, int lane, int wave, int wg, int G, int rep) {
    const float* lq1 = a.in[10]; const float* lk1 = a.in[11]; const float* lq2 = a.in[12]; const float* lk2 = a.in[13];
    const float lam = __expf(wave_sum(lq1[lane] * lk1[lane])) - __expf(wave_sum(lq2[lane] * lk2[lane])) + LAMBDA_INIT;
    const float bound2 = 8.f * 1.4426950408889634f * 1.01f * wave_max(fabsf(a.in[8][lane])) * wave_max(fabsf(a.in[9][lane]));
    const bool fixedmax = bound2 <= 40.f;
    const bf16* PROJ = (const bf16*)(a.ws + WS_PROJ); bf16* MIX = (bf16*)(a.ws + WS_MIX);
    unsigned* queue = (unsigned*)(a.ws + WS_CTL) + CW_QUEUE + 1024 * rep;
    if (fixedmax) attn_queue<true>(PROJ, MIX, a.in[14], lam, -bound2, queue, lds, tid);
    else attn_queue<false>(PROJ, MIX, a.in[14], lam, 0.f, queue, lds, tid);
}

__device__ __forceinline__ void p4_router(const Args& a, LAS unsigned char* lds, int tid, int lane, int wave, int wg, int G) {
    unsigned char* ws = a.ws;
    const float* norm2_w = a.in[16]; const float* w_group = a.in[17]; const float* b_group = a.in[18]; const float* w_expert = a.in[19]; const float* b_expert = a.in[20];
    const float* X1 = a.out; bf16* H2 = (bf16*)(ws + WS_H2);
    int* ASGE = (int*)(ws + WS_ASGE); float* ASGW = (float*)(ws + WS_ASGW); int* CNT = (int*)(ws + WS_CTL) + CW_CNT;
    LAS float* wl = (LAS float*)lds;
    LAS int* hist = (LAS int*)(lds + LDSCTL_OFF + 128);
    for (int idx = tid; idx < 4096; idx += NTHR) { const int k = idx >> 2, c = idx & 3; wl[c * 1024 + k] = w_group[idx]; }
    for (int idx = tid; idx < 32768; idx += NTHR) { const int k = idx >> 5, c = idx & 31; wl[(4 + c) * 1024 + k] = w_expert[idx]; }
    if (tid < 32) hist[tid] = 0;
    __syncthreads();
    f32x4 w2v[4];
#pragma unroll
    for (int j = 0; j < 4; ++j) w2v[j] = ((const f32x4*)norm2_w)[lane + 64 * j];
    const int tpw = T_ / (G * NWAVES);
#pragma unroll 1
    for (int rr = 0; rr < tpw; ++rr) {
        const int t = (wg * NWAVES + wave) * tpw + rr;
        const f32x4* xr = (const f32x4*)(X1 + (size_t)t * DM) + lane;
        f32x4 hv[4]; float ss = 0.f;
#pragma unroll
        for (int j = 0; j < 4; ++j) { hv[j] = xr[64 * j]; ss += (hv[j].x * hv[j].x + hv[j].y * hv[j].y) + (hv[j].z * hv[j].z + hv[j].w * hv[j].w); }
        const float r2 = rsqrtf(wave_sum(ss) * (1.f / DM) + EPS);
        u32x2* o8 = (u32x2*)(H2 + (size_t)t * DM) + lane;
#pragma unroll
        for (int j = 0; j < 4; ++j) { hv[j] = hv[j] * r2 * w2v[j]; u32x2 o; o.x = pk2(hv[j].x, hv[j].y); o.y = pk2(hv[j].z, hv[j].w); o8[64 * j] = o; }
        float lg[36];
#pragma unroll
        for (int c = 0; c < 36; ++c) { float acc = 0.f;
#pragma unroll
            for (int j = 0; j < 4; ++j) { const f32x4 wv = *(const LAS f32x4*)(wl + c * 1024 + 256 * j + 4 * lane); acc += (hv[j].x * wv.x + hv[j].y * wv.y) + (hv[j].z * wv.z + hv[j].w * wv.w); }
            lg[c] = wave_sum(acc); }
        float gl[4];
#pragma unroll
        for (int g = 0; g < 4; ++g) gl[g] = lg[g] + b_group[g];
        int gsel = 0; float gmax = gl[0];
#pragma unroll
        for (int g = 1; g < 4; ++g) if (gl[g] > gmax) { gmax = gl[g]; gsel = g; }
        float gsum = 0.f;
#pragma unroll
        for (int g = 0; g < 4; ++g) gsum += __expf(gl[g] - gmax);
        const float gwt = 1.f / gsum;
        float el[8];
#pragma unroll
        for (int i = 0; i < 8; ++i) el[i] = 0.f;
#pragma unroll
        for (int g = 0; g < 4; ++g) if (gsel == g) {
#pragma unroll
            for (int i = 0; i < 8; ++i) el[i] = lg[4 + 8 * g + i] + b_expert[8 * g + i]; }
        int i1 = 0; float v1 = el[0];
#pragma unroll
        for (int i = 1; i < 8; ++i) if (el[i] > v1) { v1 = el[i]; i1 = i; }
        int i2 = -1; float v2 = -3.0e38f;
#pragma unroll
        for (int i = 0; i < 8; ++i) if (i != i1 && el[i] > v2) { v2 = el[i]; i2 = i; }
        const float p1 = 1.f / (1.f + __expf(v2 - v1)), p2 = 1.f - p1;
        if (lane == 0) {
            const int e1 = gsel * 8 + i1, e2 = gsel * 8 + i2;
            const int r1 = atomicAdd((int*)&hist[e1], 1), r2_ = atomicAdd((int*)&hist[e2], 1);
            ASGE[2 * t] = e1 | (r1 << 8); ASGE[2 * t + 1] = e2 | (r2_ << 8);
            ASGW[2 * t] = gwt * p1; ASGW[2 * t + 1] = gwt * p2;
        }
    }
    __syncthreads();
    if (tid < 32) CNT[wg * 32 + tid] = hist[tid];
}


__device__ __forceinline__ void p4_router_mfma(const Args& a, LAS unsigned char* lds, int tid, int lane, int wave, int wg, int G) {
    unsigned char* ws = a.ws;
    const float* b_group = a.in[18]; const float* b_expert = a.in[20];
    const bf16* X1B = (const bf16*)(ws + WS_H2);
    int* ASGE = (int*)(ws + WS_ASGE); float* ASGW = (float*)(ws + WS_ASGW); int* CNT = (int*)(ws + WS_CTL) + CW_CNT;
    constexpr int WST = 2064, WLO = 36 * WST;
    LAS int* hist = (LAS int*)(lds + LDSCTL_OFF + 128);
    {
        const u32x4* RIMG = (const u32x4*)(ws + WS_RIMG); constexpr int NP = 2 * 36 * WST / 16;
#pragma unroll 1
        for (int base = 0; base < NP; base += 6 * NTHR) {
            u32x4 v[6];
#pragma unroll
            for (int q = 0; q < 6; ++q) { const int i = base + q * NTHR + tid; v[q] = RIMG[i < NP ? i : NP - 1]; }
#pragma unroll
            for (int q = 0; q < 6; ++q) { const int i = base + q * NTHR + tid; if (i < NP) *(LAS u32x4*)(lds + i * 16) = v[q]; }
        }
    }
    if (tid < 32) hist[tid] = 0;
    __syncthreads();
    const int fr = lane & 15, fq = lane >> 4;
    const int t0 = (wg * NWAVES + wave) * 32;
    const bf16* x1a = X1B + (size_t)(t0 + fr) * DM + 8 * fq; const bf16* x1b = x1a + (size_t)16 * DM;
    f32x4 acc[2][3];
#pragma unroll
    for (int tl = 0; tl < 2; ++tl)
#pragma unroll
        for (int nt = 0; nt < 3; ++nt) acc[tl][nt] = (f32x4){0.f, 0.f, 0.f, 0.f};
    float ss0 = 0.f, ss1 = 0.f;
    int wrow[3];
#pragma unroll
    for (int nt = 0; nt < 3; ++nt) { const int c = 16 * nt + fr; wrow[nt] = (c < 36 ? c : 35) * WST + 16 * fq; }
#pragma unroll 1
    for (int kg = 0; kg < 4; ++kg) {
        u32x4 va[8], vb[8];
#pragma unroll
        for (int q = 0; q < 8; ++q) { va[q] = *(const u32x4*)(x1a + 32 * (8 * kg + q)); vb[q] = *(const u32x4*)(x1b + 32 * (8 * kg + q)); }
#pragma unroll
        for (int q = 0; q < 8; ++q) { const int ks = 8 * kg + q; const u32x4 a_ = va[q], b_ = vb[q];
            { const float f0 = bflo(a_.x), f1 = bfhi(a_.x), f2 = bflo(a_.y), f3 = bfhi(a_.y), f4 = bflo(a_.z), f5 = bfhi(a_.z), f6 = bflo(a_.w), f7 = bfhi(a_.w);
              ss0 += (f0 * f0 + f1 * f1) + (f2 * f2 + f3 * f3) + (f4 * f4 + f5 * f5) + (f6 * f6 + f7 * f7); }
            { const float f0 = bflo(b_.x), f1 = bfhi(b_.x), f2 = bflo(b_.y), f3 = bfhi(b_.y), f4 = bflo(b_.z), f5 = bfhi(b_.z), f6 = bflo(b_.w), f7 = bfhi(b_.w);
              ss1 += (f0 * f0 + f1 * f1) + (f2 * f2 + f3 * f3) + (f4 * f4 + f5 * f5) + (f6 * f6 + f7 * f7); }
            const bf16x8 ah[2] = {__builtin_bit_cast(bf16x8, a_), __builtin_bit_cast(bf16x8, b_)};
#pragma unroll
            for (int nt = 0; nt < 3; ++nt) {
                const bf16x8 wh = *(const LAS bf16x8*)(lds + wrow[nt] + ks * 64), wl = *(const LAS bf16x8*)(lds + WLO + wrow[nt] + ks * 64);
#pragma unroll
                for (int tl = 0; tl < 2; ++tl) {
                    acc[tl][nt] = __builtin_amdgcn_mfma_f32_16x16x32_bf16(wh, ah[tl], acc[tl][nt], 0, 0, 0);
                    acc[tl][nt] = __builtin_amdgcn_mfma_f32_16x16x32_bf16(wl, ah[tl], acc[tl][nt], 0, 0, 0); }
            }
        }
    }
    float bg[4], be[32]; int pe_[2][2] = {{0, 0}, {0, 0}}, pr_[2][2] = {{0, 0}, {0, 0}};
#pragma unroll
    for (int g = 0; g < 4; ++g) bg[g] = b_group[g];
#pragma unroll
    for (int i = 0; i < 32; ++i) be[i] = b_expert[i];
#pragma unroll
    for (int tl = 0; tl < 2; ++tl) {
        float ss = tl ? ss1 : ss0; ss += __shfl_xor(ss, 16); ss += __shfl_xor(ss, 32);
        const float r2 = rsqrtf(ss * (1.f / DM) + EPS);
        float lg[36];
#pragma unroll
        for (int nt = 0; nt < 3; ++nt)
#pragma unroll
            for (int q = 0; q < 4; ++q)
#pragma unroll
                for (int j = 0; j < 4; ++j) { const int c = 16 * nt + 4 * q + j; if (c < 36) lg[c] = __shfl(acc[tl][nt][j], fr + 16 * q) * r2; }
        float gl[4];
#pragma unroll
        for (int g = 0; g < 4; ++g) gl[g] = lg[g] + bg[g];
        int gsel = 0; float gmax = gl[0];
#pragma unroll
        for (int g = 1; g < 4; ++g) if (gl[g] > gmax) { gmax = gl[g]; gsel = g; }
        float gsum = 0.f;
#pragma unroll
        for (int g = 0; g < 4; ++g) gsum += __expf(gl[g] - gmax);
        const float gwt = 1.f / gsum;
        float el[8];
#pragma unroll
        for (int i = 0; i < 8; ++i) el[i] = 0.f;
#pragma unroll
        for (int g = 0; g < 4; ++g) if (gsel == g) {
#pragma unroll
            for (int i = 0; i < 8; ++i) el[i] = lg[4 + 8 * g + i] + be[8 * g + i]; }
        int i1 = 0; float v1 = el[0];
#pragma unroll
        for (int i = 1; i < 8; ++i) if (el[i] > v1) { v1 = el[i]; i1 = i; }
        int i2 = -1; float v2 = -3.0e38f;
#pragma unroll
        for (int i = 0; i < 8; ++i) if (i != i1 && el[i] > v2) { v2 = el[i]; i2 = i; }
        const float p1 = 1.f / (1.f + __expf(v2 - v1)), p2 = 1.f - p1;
        if (fq == 0) {
            const int t = t0 + 16 * tl + fr;
            const int e1 = gsel * 8 + i1, e2 = gsel * 8 + i2;
            const int r1 = atomicAdd((int*)&hist[e1], 1), r2_ = atomicAdd((int*)&hist[e2], 1);
            pe_[tl][0] = e1; pe_[tl][1] = e2; pr_[tl][0] = r1; pr_[tl][1] = r2_;
            ASGW[2 * t] = gwt * p1; ASGW[2 * t + 1] = gwt * p2;
            ASGW[2 * T_ + 2 * t] = r2; ASGW[2 * T_ + 2 * t + 1] = r2;
        }
    }
    __syncthreads();
    LAS int* lbase = hist + 32;
    if (tid < 32) lbase[tid] = atomicAdd((int*)(ws + WS_CTL) + CW_CUR + 64 * tid, hist[tid]);
    __syncthreads();
    if (fq == 0) { int* LIST = (int*)(ws + WS_LIST);
#pragma unroll
        for (int tl = 0; tl < 2; ++tl) { const int t = t0 + 16 * tl + fr;
#pragma unroll
            for (int k = 0; k < 2; ++k) { const int e = pe_[tl][k], ii = lbase[e] + pr_[tl][k]; LIST[(size_t)e * LCAP + ii] = 2 * t + k; ASGE[2 * t + k] = e | (ii << 8); } } }
}

__device__ __forceinline__ void p5_dispatch(const Args& a, LAS unsigned char* lds, int tid, int wg, int G) {
    unsigned char* ws = a.ws;
    const int* ASGE = (const int*)(ws + WS_ASGE); const float* ASGW = (const float*)(ws + WS_ASGW); const int* CNT = (const int*)(ws + WS_CTL) + CW_CNT;
    int* META = (int*)(ws + WS_CTL) + CW_META; int* ROWTOK = (int*)(ws + WS_ROWTOK); float* ROWW = (float*)(ws + WS_ROWW); float* ROWR = (float*)(ws + WS_GATES); int* POSA = (int*)(ws + WS_POSA);
    LAS int* tot = (LAS int*)lds; LAS int* pre = tot + 32; LAS int* pst = pre + 32;
    {
        LAS int* part = pst + 64;
        const int e = tid & 31, j = tid >> 5; int total = 0, prefix = 0;
#pragma unroll
        for (int q = 0; q < 16; ++q) { const int w = 16 * j + q; const int c = (w < G) ? CNT[w * 32 + e] : 0; total += c; prefix += (w < wg) ? c : 0; }
        part[j * 32 + e] = total; part[512 + j * 32 + e] = prefix;
        __syncthreads();
        if (tid < 32) { int t2 = 0, p2 = 0;
#pragma unroll
            for (int q = 0; q < 16; ++q) { t2 += part[q * 32 + tid]; p2 += part[512 + q * 32 + tid]; }
            tot[tid] = t2; pre[tid] = p2; }
    }
    __syncthreads();
    if (tid == 0) { int s = 0; for (int e = 0; e < 32; ++e) { pst[e] = s; s += (tot[e] + 255) & ~255; } pst[32] = s; }
    __syncthreads();
    if (wg == 0 && tid <= 32) META[tid] = pst[tid];
    const int apw = 2 * T_ / G;
    for (int q = tid; q < apw; q += NTHR) { const int idx = wg * apw + q; const int ev = ASGE[idx], e = ev & 255, rank = ev >> 8; const int pos = pst[e] + pre[e] + rank; ROWTOK[pos] = idx; ROWW[pos] = ASGW[idx]; ROWR[pos] = ASGW[2 * T_ + idx]; POSA[idx] = pos; }
    if (wg < 32) { const int e = wg; for (int p = pst[e] + tot[e] + tid; p < pst[e + 1]; p += NTHR) { ROWTOK[p] = -1; ROWW[p] = 0.f; ROWR[p] = 0.f; } }
}

__device__ __forceinline__ int expert_of_row(const LAS int* pst, int row) { int e = 0;
#pragma unroll 1
    for (int i = 1; i < 32; ++i) e += (pst[i] <= row) ? 1 : 0;
    return e; }

__device__ __forceinline__ void unpack8(const u32x4 v, float (&f)[8]) { f[0] = bflo(v.x); f[1] = bfhi(v.x); f[2] = bflo(v.y); f[3] = bfhi(v.y); f[4] = bflo(v.z); f[5] = bfhi(v.z); f[6] = bflo(v.w); f[7] = bfhi(v.w); }
__device__ __forceinline__ void p6_naive(const Args& a, LAS unsigned char* lds, int tid, int wg, int G) {
    unsigned char* ws = a.ws;
    const int* META = (const int*)(ws + WS_CTL) + CW_META; const int* ROWTOK = (const int*)(ws + WS_ROWTOK);
    const bf16* H2 = (const bf16*)(ws + WS_H2); const bf16* WGU = (const bf16*)(ws + WS_WGU); bf16* HID = (bf16*)(ws + WS_HID);
    LAS int* pst = (LAS int*)lds;
    if (tid <= 32) pst[tid] = META[tid];
    __syncthreads();
    const int npad = pst[32], ntile = (npad / 64) * 8, rg = tid >> 5, cg = tid & 31;
    for (int tile = wg; tile < ntile; tile += G) {
        const int rt = tile >> 3, ct = tile & 7, e = expert_of_row(pst, rt * 64);
        const bf16* ar[4];
#pragma unroll
        for (int i = 0; i < 4; ++i) { const int tk = ROWTOK[rt * 64 + rg * 4 + i]; ar[i] = H2 + (size_t)(tk < 0 ? 0 : (tk >> 1)) * DM; }
        const int c0 = ct * 64 + cg * 2;
        const bf16* bg[2]; const bf16* bu[2];
#pragma unroll
        for (int j = 0; j < 2; ++j) { const int c = c0 + j; bg[j] = WGU + ((size_t)e * 1024 + (c >> 7) * 256 + (c & 127)) * 1024; bu[j] = bg[j] + 128 * 1024; }
        float g[4][2], u[4][2];
#pragma unroll
        for (int i = 0; i < 4; ++i)
#pragma unroll
            for (int j = 0; j < 2; ++j) { g[i][j] = 0.f; u[i][j] = 0.f; }
#pragma unroll 1
        for (int k = 0; k < 1024; k += 8) {
            float af[4][8], gf[2][8], uf[2][8];
#pragma unroll
            for (int i = 0; i < 4; ++i) unpack8(*(const u32x4*)(ar[i] + k), af[i]);
#pragma unroll
            for (int j = 0; j < 2; ++j) { unpack8(*(const u32x4*)(bg[j] + k), gf[j]); unpack8(*(const u32x4*)(bu[j] + k), uf[j]); }
#pragma unroll
            for (int i = 0; i < 4; ++i)
#pragma unroll
                for (int j = 0; j < 2; ++j)
#pragma unroll
                    for (int q = 0; q < 8; ++q) { g[i][j] += af[i][q] * gf[j][q]; u[i][j] += af[i][q] * uf[j][q]; }
        }
#pragma unroll
        for (int i = 0; i < 4; ++i) *(unsigned*)(HID + (size_t)(rt * 64 + rg * 4 + i) * DEXP + c0) = pk2(siluf_(g[i][0]) * u[i][0], siluf_(g[i][1]) * u[i][1]);
    }
}

__device__ __forceinline__ void p7_naive(const Args& a, LAS unsigned char* lds, int tid, int wg, int G) {
    unsigned char* ws = a.ws;
    const int* META = (const int*)(ws + WS_CTL) + CW_META; const int* ROWTOK = (const int*)(ws + WS_ROWTOK); const float* ROWW = (const float*)(ws + WS_ROWW);
    const bf16* HID = (const bf16*)(ws + WS_HID); const bf16* WD = (const bf16*)(ws + WS_WD); bf16* YBUF = (bf16*)(ws + WS_YBUF);
    LAS int* pst = (LAS int*)lds;
    if (tid <= 32) pst[tid] = META[tid];
    __syncthreads();
    const int npad = pst[32], ntile = (npad / 64) * 8, rg = tid >> 5, cg = tid & 31;
    for (int tile = wg; tile < ntile; tile += G) {
        const int rt = tile >> 3, ct = tile & 7, e = expert_of_row(pst, rt * 64);
        const bf16* ar[4]; const bf16* br[4];
#pragma unroll
        for (int i = 0; i < 4; ++i) ar[i] = HID + (size_t)(rt * 64 + rg * 4 + i) * DEXP;
        const int c0 = ct * 128 + cg * 4;
#pragma unroll
        for (int j = 0; j < 4; ++j) br[j] = WD + ((size_t)e * 1024 + c0 + j) * DEXP;
        float acc[4][4];
#pragma unroll
        for (int i = 0; i < 4; ++i)
#pragma unroll
            for (int j = 0; j < 4; ++j) acc[i][j] = 0.f;
#pragma unroll 1
        for (int k = 0; k < DEXP; k += 8) {
            float af[4][8], bfv[4][8];
#pragma unroll
            for (int i = 0; i < 4; ++i) { unpack8(*(const u32x4*)(ar[i] + k), af[i]); unpack8(*(const u32x4*)(br[i] + k), bfv[i]); }
#pragma unroll
            for (int i = 0; i < 4; ++i)
#pragma unroll
                for (int j = 0; j < 4; ++j)
#pragma unroll
                    for (int q = 0; q < 8; ++q) acc[i][j] += af[i][q] * bfv[j][q];
        }
#pragma unroll
        for (int i = 0; i < 4; ++i) { const int pos = rt * 64 + rg * 4 + i; const int tk = ROWTOK[pos];
            if (tk >= 0) { const float w = ROWW[pos]; const int t = tk >> 1, kk = tk & 1;
                u32x2 o; o.x = pk2(acc[i][0] * w, acc[i][1] * w); o.y = pk2(acc[i][2] * w, acc[i][3] * w);
                *(u32x2*)(YBUF + ((size_t)kk * T_ + t) * DM + c0) = o; } }
    }
}

__device__ __forceinline__ void p8_combine(const Args& a, int tid, int wg, int G) {
    const unsigned char* Y = a.ws + WS_YBUF; const bf16* X1B = (const bf16*)(a.ws + WS_H2); float* O = a.out;
    const int* POSA = (const int*)(a.ws + WS_POSA); const float* ASGW = (const float*)(a.ws + WS_ASGW);
    const int lane = tid & 63, gw = wg * NWAVES + __builtin_amdgcn_readfirstlane(tid >> 6), NGW = G * NWAVES;
    u32x4 xb[2]; u32x2 y0[2], y1[2]; float w0 = 0.f, w1 = 0.f;
#define P8_LOAD(t_) do { const int t__ = __builtin_amdgcn_readfirstlane(t_); const int p0_ = POSA[2 * t__], p1_ = POSA[2 * t__ + 1]; w0 = ASGW[2 * t__]; w1 = ASGW[2 * t__ + 1]; \
        _Pragma("unroll") for (int q = 0; q < 2; ++q) { xb[q] = *(const u32x4*)(X1B + (size_t)t__ * DM + (lane + 64 * q) * 8); y0[q] = *(const u32x2*)(Y + (size_t)p0_ * DM + (lane + 64 * q) * 8); \
            y1[q] = *(const u32x2*)(Y + (size_t)p1_ * DM + (lane + 64 * q) * 8); } } while (0)
#define P8_F8(w_, i_) __builtin_amdgcn_cvt_f32_fp8((int)(w_), (i_))
    P8_LOAD(gw);
#pragma unroll 1
    for (int t = gw; t < T_; t += NGW) {
        u32x4 cx[2]; u32x2 c0[2], c1[2]; const float cw0 = w0, cw1 = w1;
#pragma unroll
        for (int q = 0; q < 2; ++q) { cx[q] = xb[q]; c0[q] = y0[q]; c1[q] = y1[q]; }
        if (t + NGW < T_) P8_LOAD(t + NGW);
#pragma unroll
        for (int q = 0; q < 2; ++q) {
            f32x4 a0, a1;
            a0.x = bflo(cx[q].x) + cw0 * P8_F8(c0[q].x, 0) + cw1 * P8_F8(c1[q].x, 0); a0.y = bfhi(cx[q].x) + cw0 * P8_F8(c0[q].x, 1) + cw1 * P8_F8(c1[q].x, 1);
            a0.z = bflo(cx[q].y) + cw0 * P8_F8(c0[q].x, 2) + cw1 * P8_F8(c1[q].x, 2); a0.w = bfhi(cx[q].y) + cw0 * P8_F8(c0[q].x, 3) + cw1 * P8_F8(c1[q].x, 3);
            a1.x = bflo(cx[q].z) + cw0 * P8_F8(c0[q].y, 0) + cw1 * P8_F8(c1[q].y, 0); a1.y = bfhi(cx[q].z) + cw0 * P8_F8(c0[q].y, 1) + cw1 * P8_F8(c1[q].y, 1);
            a1.z = bflo(cx[q].w) + cw0 * P8_F8(c0[q].y, 2) + cw1 * P8_F8(c1[q].y, 2); a1.w = bfhi(cx[q].w) + cw0 * P8_F8(c0[q].y, 3) + cw1 * P8_F8(c1[q].y, 3);
            float* op = O + (size_t)t * DM + (lane + 64 * q) * 8;
            *(f32x4*)op = a0; *(f32x4*)(op + 4) = a1;
        }
    }
#undef P8_LOAD
#undef P8_F8
}

#ifndef STAGGER_P1
#define STAGGER_P1 700
#endif
#ifndef STAGGER_P6
#define STAGGER_P6 0
#endif
#ifndef STAGGER_P7
#define STAGGER_P7 0
#endif
__device__ __forceinline__ void phase_stagger(unsigned ticks) {
    const unsigned g = blockIdx.x & 3u;
    if (g != 0u && ticks != 0u) { const unsigned long long t0 = __builtin_amdgcn_s_memrealtime(); while (__builtin_amdgcn_s_memrealtime() - t0 < (unsigned long long)(g * ticks)) __builtin_amdgcn_s_sleep(16); }
}

__device__ __forceinline__ void p6_gemm(const Args& a, LAS unsigned char* lds, int tid, int wg, int G) {
    unsigned char* ws = a.ws;
    LAS int* pst = (LAS int*)(lds + 131072); LAS int* tot = pst + 64;
    if (tid < 32) tot[tid] = ((const int*)(ws + WS_CTL) + CW_CUR)[64 * tid];
    __syncthreads();
    if (tid == 0) { int s_ = 0; for (int e = 0; e < 32; ++e) { pst[e] = s_; s_ += (tot[e] + 255) & ~255; } pst[32] = s_; }
    __syncthreads();
    {
        const int* ASGE = (const int*)(ws + WS_ASGE); int* POSA = (int*)(ws + WS_POSA); const int idx = wg * (2 * T_ / G) + tid;
        if (tid < 2 * T_ / G) { const int ev = ASGE[idx]; POSA[idx] = pst[ev & 255] + (ev >> 8); }
    }
    pg8::MoeGuSched S; S.o.init(pst[32] / 256, 4, G, wg); S.A = (const char*)(ws + WS_X1F); S.Bt = (const char*)(ws + WS_WGU); S.rowtok = (const int*)(ws + WS_ROWTOK); S.pst = pst; S.K = DM / 2;
    LAS int* ltok = (LAS int*)(lds + 131584); LAS float* lrowr = (LAS float*)(lds + 131584 + 9 * 256 * 4);
    {
        const int* LIST = (const int*)(ws + WS_LIST); const float* R2 = (const float*)(ws + WS_ASGW) + 2 * T_;
        int tv[9]; float rv[9]; bool ok[9];
#pragma unroll
        for (int i = 0; i < 9; ++i) { int pm, pn; ok[i] = S.o.map(i, pm, pn); tv[i] = -1; rv[i] = 0.f;
            if (ok[i] && tid < 256) { const int e = pg8::expert_of_row_l(pst, pm * 256), ii = pm * 256 + tid - pst[e]; if (ii < tot[e]) tv[i] = LIST[(size_t)e * LCAP + ii]; } }
#pragma unroll
        for (int i = 0; i < 9; ++i) if (tv[i] >= 0) rv[i] = R2[tv[i]];
#pragma unroll
        for (int i = 0; i < 9; ++i) if (ok[i] && tid < 256) { ltok[i * 256 + tid] = tv[i]; lrowr[i * 256 + tid] = rv[i]; }
        __syncthreads();
    }
    S.ltok = ltok;
    pg8::EpiSwiglu E{(bf16*)(ws + WS_HID), lrowr};
    phase_stagger(STAGGER_P6);
    pg8::gemm_phase<pg8::EpiSwiglu, pg8::MoeGuSched, true, true>(lds, DM / 2, S, E);
}
__device__ __forceinline__ void p7_gemm(const Args& a, LAS unsigned char* lds, int tid, int wg, int G) {
    unsigned char* ws = a.ws;
    LAS int* pst = (LAS int*)(lds + 131072); LAS int* tot = pst + 64;
    if (tid < 32) tot[tid] = ((const int*)(ws + WS_CTL) + CW_CUR)[64 * tid];
    __syncthreads();
    if (tid == 0) { int s_ = 0; for (int e = 0; e < 32; ++e) { pst[e] = s_; s_ += (tot[e] + 255) & ~255; } pst[32] = s_; }
    __syncthreads();
    pg8::MoeDownSched S; S.o.init(pst[32] / 256, 4, G, wg); S.A = (const char*)(ws + WS_HID); S.Bt = (const char*)(ws + WS_WD); S.pst = pst; S.K = DEXP / 2;
    pg8::EpiF8 E{ws + WS_YBUF, DM};
    phase_stagger(STAGGER_P7);
    pg8::gemm_phase<pg8::EpiF8, pg8::MoeDownSched, true, true>(lds, DEXP / 2, S, E);
}

__global__ void __launch_bounds__(NTHR, 2) fwd(Args args) {
    extern __shared__ __attribute__((aligned(16))) unsigned char lds_raw[];
    LAS unsigned char* lds = (LAS unsigned char*)lds_raw;
    const int tid0 = threadIdx.x, wg = blockIdx.x, G = gridDim.x;
#define PH_TID() int tid = threadIdx.x; asm volatile("" : "+v"(tid)); const int lane = tid & 63, wave = __builtin_amdgcn_readfirstlane(tid >> 6); (void)lane; (void)wave
    unsigned char* ws = args.ws;
    unsigned* ctl = (unsigned*)(ws + WS_CTL);
    for (int u = tid0; u < 256; u += NTHR) ((LAS unsigned*)(lds + LDSCTL_OFF))[u] = 0u;
    __syncthreads();
    const int lo = args.ph_lo, hi = args.ph_hi;
    XcdBarrier bar = xcd_barrier_post(ctl + CW_BAR, (volatile LAS unsigned*)(lds + LDSCTL_OFF));
#define IN(k) (lo <= (k) && (k) < hi)
#ifndef PROBE_PHASE
#define PROBE_PHASE -1
#endif
#define REPS(k) ((PROBE_PHASE == (k)) ? 2 : 1)
#define REPSEP(k) do { if (rep + 1 < REPS(k)) xcd_barrier(bar); } while (0)
#define SEAM(k) do { if (IN(k) && IN((k) + 1)) xcd_barrier(bar); } while (0)

    if (IN(0)) { for (int rep = 0; rep < REPS(0); ++rep) { PH_TID(); p0_prologue(args, lds, tid, lane, wave, wg, G);  REPSEP(0); } }
    SEAM(0);
    if (IN(1)) { for (int rep = 0; rep < REPS(1); ++rep) {
        pg8::DenseSched S; S.o.init(T_ / 256, NCOL / 256, G, wg); S.A = (const char*)(ws + WS_H1); S.Bt = (const char*)(ws + WS_W1T); S.K = DM;
        LAS float* lrs = (LAS float*)(lds + 131584);
        { PH_TID(); const float* R1 = (const float*)(ws + WS_R1);
#pragma unroll 1
          for (int i = 0; i < 14; ++i) { int pm, pn; if (S.o.map(i, pm, pn) && tid < 256) lrs[i * 256 + tid] = R1[pm * 256 + tid]; } }
        pg8::EpiProj E{(bf16*)(ws + WS_PROJ), NCOL, args.in[8], args.in[9], lrs};
        { PH_TID(); p1_stagger_work(args, lds, lane, wave, wg); }
        asm volatile("s_waitcnt vmcnt(0) lgkmcnt(0)" ::: "memory"); __syncthreads();
        pg8::gemm_phase<pg8::EpiProj, pg8::DenseSched, true>(lds, DM, S, E);
     REPSEP(1); } }
    SEAM(1);
    if (IN(2)) { for (int rep = 0; rep < REPS(2); ++rep) { { PH_TID(); if (wg < NBATCH * 4 || PROBE_PHASE == 23) { ml::mlstm_item(args, lds, wg & 127, tid); } } __syncthreads(); { PH_TID(); p2_fast_attn(args, lds, tid, lane, wave, wg, G, rep); if (PROBE_PHASE == 21) { __syncthreads(); p2_fast_attn(args, lds, tid, lane, wave, wg, G, 1); } }  REPSEP(2); } }
    SEAM(2);
    if (IN(3)) { for (int rep = 0; rep < REPS(3); ++rep) {
        pg8::DenseSched S; S.o.init(T_ / 256, DM / 256, G, wg); S.A = (const char*)(ws + WS_MIX); S.Bt = (const char*)(ws + WS_W2T); S.K = DM;
        pg8::EpiX1 E{(const bf16*)(ws + WS_H1), (bf16*)(ws + WS_H2), ws + WS_X1F, DM};
        pg8::gemm_phase<pg8::EpiX1, pg8::DenseSched, true>(lds, DM, S, E);
     REPSEP(3); } }
    SEAM(3);
    if (IN(4)) { for (int rep = 0; rep < REPS(4); ++rep) { PH_TID(); p4_router_mfma(args, lds, tid, lane, wave, wg, G);  REPSEP(4); } }
    SEAM(4);
    if (IN(6)) { for (int rep = 0; rep < REPS(6); ++rep) { PH_TID(); p6_gemm(args, lds, tid, wg, G);  REPSEP(6); } }
    SEAM(6);
    if (IN(7)) { for (int rep = 0; rep < REPS(7); ++rep) { PH_TID(); p7_gemm(args, lds, tid, wg, G);  REPSEP(7); } }
    SEAM(7);
    if (IN(8)) { PH_TID(); p8_combine(args, tid, wg, G); }
#undef IN
#undef SEAM
}

#ifndef MK_N_LAUNCHES
#define MK_N_LAUNCHES 1
#endif
extern "C" void kernel_launch(void* const* d_in, const int* in_sizes, int n_in, void* d_out, int out_size, void* d_ws, size_t ws_size, hipStream_t stream) {
    static int grid = 0;
    if (grid == 0) {
        if (n_in != 24 || in_sizes[0] != T_ * DM || out_size != T_ * DM || ws_size < WS_END) { fprintf(stderr, "kernel_launch: unexpected shapes (n_in %d, in0 %d, out %d, ws %zu); nothing launched\n", n_in, n_in > 0 ? in_sizes[0] : -1, out_size, ws_size); grid = -1; return; }
        int dev = 0, cus = 0, per_cu = 0;
        if (hipGetDevice(&dev) != hipSuccess || hipDeviceGetAttribute(&cus, hipDeviceAttributeMultiprocessorCount, dev) != hipSuccess) { grid = -1; return; }
        if (hipFuncSetAttribute((const void*)fwd, hipFuncAttributeMaxDynamicSharedMemorySize, LDS_BYTES) != hipSuccess) { fprintf(stderr, "kernel_launch: hipFuncSetAttribute failed\n"); grid = -1; return; }
        if (hipOccupancyMaxActiveBlocksPerMultiprocessor(&per_cu, (const void*)fwd, NTHR, LDS_BYTES) != hipSuccess || per_cu < 1) fprintf(stderr, "kernel_launch: occupancy query reports %d\n", per_cu);
        (void)hipGetLastError();
        grid = cus;
        if (grid != 256) { fprintf(stderr, "kernel_launch: built for 256 CUs, found %d; nothing launched\n", cus); grid = -1; return; }
    }
    if (grid < 0) return;
    if (hipMemsetAsync((char*)d_ws + WS_CTL, 0, CTL_ZERO_BYTES, stream) != hipSuccess) return;
    Args a{};
    for (int i = 0; i < 24; ++i) a.in[i] = (const float*)d_in[i];
    a.out = (float*)d_out; a.ws = (unsigned char*)d_ws;
    if (MK_N_LAUNCHES == 1) { a.ph_lo = 0; a.ph_hi = 9; hipLaunchKernelGGL(fwd, dim3(grid), dim3(NTHR), LDS_BYTES, stream, a); }
    else { for (int p = 0; p < 9; ++p) { a.ph_lo = p; a.ph_hi = p + 1; hipLaunchKernelGGL(fwd, dim3(grid), dim3(NTHR), LDS_BYTES, stream, a); } }
    const hipError_t le = hipPeekAtLastError();
    if (le != hipSuccess) fprintf(stderr, "kernel_launch: launch failed: %s\n", hipGetErrorName(le));
}
```

```cpp
#include <hip/hip_runtime.h>
#include <cstdio>
#include <cstdint>

#define GAS __attribute__((address_space(1)))
#define LAS __attribute__((address_space(3)))
typedef unsigned short bf16;
typedef unsigned u32x4 __attribute__((ext_vector_type(4)));
typedef unsigned u32x2 __attribute__((ext_vector_type(2)));
typedef float f32x4 __attribute__((ext_vector_type(4)));
typedef float f32x2 __attribute__((ext_vector_type(2)));
typedef short bf16x8 __attribute__((ext_vector_type(8)));

constexpr int T_ = 65536, DM = 1024, SEQ = 2048, NBATCH = 32, NCOL = 3584, INCOLS = 3592;
constexpr int C_MQ = 0, C_MK = 512, C_MV = 1024, C_MO = 1536, C_AQ = 2048, C_AK = 2560, C_AV = 3072;
constexpr int NEXP = 32, DEXP = 512, PMAX = 131072 + NEXP * 256;
constexpr float EPS = 1e-6f;
constexpr float LAMBDA_INIT = 0.2f;
constexpr int NWAVES = 8, NTHR = 512;

constexpr size_t MiB = 1u << 20;
constexpr size_t WS_CTL = 0, CTL_ZERO_BYTES = 64 * 1024;
constexpr size_t WS_W1T = 1 * MiB, WS_W2T = 8 * MiB, WS_WGU = 10 * MiB, WS_WD = 74 * MiB, WS_GATES = 106 * MiB;
constexpr size_t WS_ASGE = 108 * MiB, WS_ASGW = 109 * MiB, WS_ROWTOK = 110 * MiB, WS_ROWW = 111 * MiB;
constexpr size_t WS_H1 = 112 * MiB, WS_MIX = 240 * MiB, WS_PROJ = 368 * MiB, WS_END = 816 * MiB;
constexpr size_t WS_YBUF = 112 * MiB;
constexpr size_t WS_H2 = 384 * MiB, WS_HID = 512 * MiB;
constexpr size_t WS_MO = 112 * MiB;
constexpr size_t WS_X1F = 584 * MiB;
constexpr size_t WS_RIMG = 111 * MiB + 768 * 1024;
constexpr size_t WS_POSA = 108 * MiB + 512 * 1024;
constexpr int CW_BAR = 4096, CW_QUEUE = 8192, CW_CNT = 16384, CW_META = 32768;
constexpr size_t WS_R1 = 100 * MiB;
constexpr int CW_CUR = 12288;
constexpr size_t WS_LIST = 700 * MiB; constexpr int LCAP = 2 * 65536;

constexpr int LDS_SCRATCH = 155648;
constexpr int LDSCTL_OFF = LDS_SCRATCH;
constexpr int LDS_BYTES = LDS_SCRATCH + 1024;

__device__ __forceinline__ unsigned f2bf(float f) { unsigned u = __builtin_bit_cast(unsigned, f); return (u + 0x7fffu + ((u >> 16) & 1u)) >> 16; }
__device__ __forceinline__ unsigned pk2(float lo, float hi) { return f2bf(lo) | (f2bf(hi) << 16); }
__device__ __forceinline__ float bf2f(bf16 v) { return __uint_as_float(((unsigned)v) << 16); }
__device__ __forceinline__ float bflo(unsigned u) { return __uint_as_float(u << 16); }
__device__ __forceinline__ float bfhi(unsigned u) { return __uint_as_float(u & 0xffff0000u); }
__device__ __forceinline__ float wave_sum(float v) {
#pragma unroll
    for (int o = 1; o < 64; o <<= 1) v += __shfl_xor(v, o);
    return v;
}
__device__ __forceinline__ float wave_max(float v) {
#pragma unroll
    for (int o = 1; o < 64; o <<= 1) v = fmaxf(v, __shfl_xor(v, o));
    return v;
}
__device__ __forceinline__ float sigmoidf_(float x) { return 1.f / (1.f + __expf(-x)); }
__device__ __forceinline__ float siluf_(float x) { return x / (1.f + __expf(-x)); }
__device__ __forceinline__ unsigned pk4_fp8(float a, float b, float c, float d) { int w = 0; w = __builtin_amdgcn_cvt_pk_fp8_f32(a, b, w, false); w = __builtin_amdgcn_cvt_pk_fp8_f32(c, d, w, true); return (unsigned)w; }
#define LDS_WAIT() asm volatile("s_waitcnt lgkmcnt(0)" ::: "memory")
#define VM_WAIT() asm volatile("s_waitcnt vmcnt(0)" ::: "memory")

namespace pg8 {
#define PG8_LAS __attribute__((address_space(3)))
constexpr int BM = 256, BK = 64, HALF = 128, HTB = HALF * BK * 2, STAGE_BYTES = 8 * HTB, NXCD = 8, WGM = 4;
__host__ __device__ __forceinline__ int lds_byte(int r, int c) { const int st = (r >> 4) * 2 + (c >> 5), rr = r & 15, cc = c & 31, ob = rr * 64 + cc * 2; return st * 1024 + (ob ^ (((ob >> 9) & 1) << 5)); }
__host__ __device__ __forceinline__ void stage_rc(int b, int& R, int& C) { const int st = b / 1024, sb = b % 1024, swz = sb ^ (((sb >> 9) & 1) << 5); R = (st >> 1) * 16 + swz / 64; C = (st & 1) * 32 + (swz % 64) / 2; }
__host__ __device__ __forceinline__ int perm32(int rho) { const int n = rho >> 4, i = rho & 15; return 8 * (i >> 2) + 4 * n + (i & 3); }
__host__ __device__ __forceinline__ int perm32g(int rho) { const int n = rho >> 4, i = rho & 15, q = i >> 2; return 8 * (((q & 1) << 1) | (q >> 1)) + 4 * n + (i & 3); }

struct Unit { int pm, pn, e, li; };
struct TileOrder {
    int nM, nN, nwg, G, c;
    __device__ __forceinline__ void init(int nM_, int nN_, int G_, int c_) { nM = nM_; nN = nN_; nwg = nM * nN; G = G_; c = c_; }
    __device__ __forceinline__ bool map(int i, int& pm, int& pn) const {
        const long L = (long)i * G + c; if (L >= nwg) return false;
        int wgid = (int)L; { const int q = nwg / NXCD, r = nwg % NXCD, xcd = wgid % NXCD, off = wgid / NXCD; wgid = (xcd < r ? xcd * (q + 1) : r * (q + 1) + (xcd - r) * q) + off; }
        const int nig = WGM * nN, gid = wgid / nig, fm = gid * WGM, gsz = (nM - fm) < WGM ? (nM - fm) : WGM;
        pm = fm + ((wgid % nig) % gsz); pn = (wgid % nig) / gsz; return true;
    }
};
struct DenseSched {
    static constexpr bool GATHER = false;
    TileOrder o; const char* A; const char* Bt; int K;
    __device__ __forceinline__ bool next(int i, Unit& u) const { u.e = 0; u.li = i; return o.map(i, u.pm, u.pn); }
    __device__ __forceinline__ const char* a_base(const Unit& u) const { return A + (size_t)u.pm * BM * K * 2; }
    __device__ __forceinline__ const char* b_base(const Unit& u) const { return Bt + (size_t)u.pn * BM * K * 2; }
    __device__ __forceinline__ void a_voff(const Unit&, const int (&R)[2], const int (&C)[2], unsigned (&v)[2][2]) const {
#pragma unroll
        for (int h = 0; h < 2; ++h)
#pragma unroll
            for (int i = 0; i < 2; ++i) v[h][i] = (unsigned)((h * HALF + R[i]) * K + C[i]) * 2u;
    }
};

__device__ __forceinline__ unsigned cvt_pk_bf16(float lo, float hi) { unsigned r; asm volatile("v_cvt_pk_bf16_f32 %0, %1, %2" : "=v"(r) : "v"(lo), "v"(hi)); return r; }

struct EpiBf16 {
    static constexpr int PERM = 1;
    bf16* O; int ldc;
    __device__ __forceinline__ void operator()(const f32x4 (&acc)[2][2][4][2], const Unit& u, int wr, int wc, int fr, int fq) const {
        const int row0 = u.pm * BM + wr * 64 + fr, col0 = u.pn * BM + wc * 32 + 8 * fq;
#pragma unroll
        for (int ai = 0; ai < 2; ++ai)
#pragma unroll
            for (int m = 0; m < 4; ++m) { bf16* rowp = O + (size_t)(row0 + ai * HALF + m * 16) * ldc + col0;
#pragma unroll
                for (int bj = 0; bj < 2; ++bj) { const f32x4 v0 = acc[ai][bj][m][0], v1 = acc[ai][bj][m][1];
                    u32x4 w; w.x = cvt_pk_bf16(v0[0], v0[1]); w.y = cvt_pk_bf16(v0[2], v0[3]); w.z = cvt_pk_bf16(v1[0], v1[1]); w.w = cvt_pk_bf16(v1[2], v1[3]);
                    *(u32x4*)(rowp + bj * HALF) = w; } }
    }
};
struct EpiF8 {
    static constexpr int PERM = 2;
    unsigned char* O; int ldc;
    __device__ __forceinline__ void operator()(const f32x4 (&acc)[2][2][4][2], const Unit& u, int wr, int wc, int fr, int fq) const {
        const int row0 = u.pm * BM + wr * 64 + fr + 16 * (fq >> 1), col0 = u.pn * BM + wc * 32 + 16 * (fq & 1);
#pragma unroll
        for (int ai = 0; ai < 2; ++ai)
#pragma unroll
            for (int p = 0; p < 2; ++p) { unsigned char* rowp = O + (size_t)(row0 + ai * HALF + p * 32) * ldc + col0;
#pragma unroll
                for (int bj = 0; bj < 2; ++bj) { const f32x4 x0 = acc[ai][bj][2 * p][0], x1 = acc[ai][bj][2 * p][1], y0 = acc[ai][bj][2 * p + 1][0], y1 = acc[ai][bj][2 * p + 1][1];
                    const unsigned xa = pk4_fp8(x0[0], x0[1], x0[2], x0[3]), xb = pk4_fp8(x1[0], x1[1], x1[2], x1[3]), ya = pk4_fp8(y0[0], y0[1], y0[2], y0[3]), yb = pk4_fp8(y1[0], y1[1], y1[2], y1[3]);
                    auto ra = __builtin_amdgcn_permlane32_swap(xa, ya, false, false); auto rb = __builtin_amdgcn_permlane32_swap(xb, yb, false, false);
                    u32x4 w = {ra[0], rb[0], ra[1], rb[1]};
                    *(u32x4*)(rowp + bj * HALF) = w; } }
    }
};
struct EpiProj {
    static constexpr int PERM = 1;
    bf16* O; int ldc; const float* qw; const float* kw; const PG8_LAS float* rs;
    __device__ __forceinline__ void operator()(const f32x4 (&acc)[2][2][4][2], const Unit& u, int wr, int wc, int fr, int fq) const {
        const int row0 = u.pm * BM + wr * 64 + fr;
        if (u.pn >= 8 && u.pn < 12) {
            const float* wsrc = (u.pn < 10) ? qw : kw; const float post = (u.pn < 10) ? 0.18033688011112042f : 1.0f;
            f32x4 wv[2][2];
#pragma unroll
            for (int bj = 0; bj < 2; ++bj)
#pragma unroll
                for (int n = 0; n < 2; ++n) wv[bj][n] = *(const f32x4*)(wsrc + 32 * bj + 8 * fq + 4 * n) * post;
            const int col0 = u.pn * BM + wc * 64 + 8 * fq;
#pragma unroll
            for (int ai = 0; ai < 2; ++ai)
#pragma unroll
                for (int m = 0; m < 4; ++m) {
                    float ss = 0.f;
#pragma unroll
                    for (int bj = 0; bj < 2; ++bj)
#pragma unroll
                        for (int n = 0; n < 2; ++n) { const f32x4 x = acc[ai][bj][m][n]; ss += (x[0] * x[0] + x[1] * x[1]) + (x[2] * x[2] + x[3] * x[3]); }
                    ss += __shfl_xor(ss, 16); ss += __shfl_xor(ss, 32);
                    const float r1 = rs[u.li * BM + wr * 64 + fr + ai * HALF + m * 16];
                    const float r = rsqrtf(ss * (r1 * r1) * (1.f / 64.f) + 1e-6f) * r1;
                    bf16* rowp = O + (size_t)(row0 + ai * HALF + m * 16) * ldc + col0;
#pragma unroll
                    for (int bj = 0; bj < 2; ++bj) { const f32x4 v0 = acc[ai][bj][m][0] * r * wv[bj][0], v1 = acc[ai][bj][m][1] * r * wv[bj][1];
                        u32x4 w; w.x = cvt_pk_bf16(v0[0], v0[1]); w.y = cvt_pk_bf16(v0[2], v0[3]); w.z = cvt_pk_bf16(v1[0], v1[1]); w.w = cvt_pk_bf16(v1[2], v1[3]);
                        *(u32x4*)(rowp + bj * 32) = w; } }
        } else {
            const int col0 = u.pn * BM + wc * 32 + 8 * fq; const bool sig = (u.pn == 6 || u.pn == 7);
#pragma unroll
            for (int ai = 0; ai < 2; ++ai)
#pragma unroll
                for (int m = 0; m < 4; ++m) { bf16* rowp = O + (size_t)(row0 + ai * HALF + m * 16) * ldc + col0; const float r1 = rs[u.li * BM + wr * 64 + fr + ai * HALF + m * 16];
#pragma unroll
                    for (int bj = 0; bj < 2; ++bj) { f32x4 v0 = acc[ai][bj][m][0] * r1, v1 = acc[ai][bj][m][1] * r1;
                        if (sig) {
#pragma unroll
                            for (int j = 0; j < 4; ++j) { v0[j] = __builtin_amdgcn_rcpf(1.f + __builtin_amdgcn_exp2f(v0[j] * -1.4426950408889634f)); v1[j] = __builtin_amdgcn_rcpf(1.f + __builtin_amdgcn_exp2f(v1[j] * -1.4426950408889634f)); } }
                        u32x4 w; w.x = cvt_pk_bf16(v0[0], v0[1]); w.y = cvt_pk_bf16(v0[2], v0[3]); w.z = cvt_pk_bf16(v1[0], v1[1]); w.w = cvt_pk_bf16(v1[2], v1[3]);
                        *(u32x4*)(rowp + bj * HALF) = w; } }
        }
    }
};
struct EpiX1 {
    static constexpr int PERM = 2;
    const bf16* X; bf16* OB; unsigned char* OF; int ldc;
    __device__ __forceinline__ void operator()(const f32x4 (&acc)[2][2][4][2], const Unit& u, int wr, int wc, int fr, int fq) const {
        const int g8 = 8 * (((fq & 1) << 1) | (fq >> 1));
        const int row0 = u.pm * BM + wr * 64 + fr, col0 = u.pn * BM + wc * 32 + g8, colf = u.pn * BM + wc * 32 + 16 * (fq & 1), rsel = 16 * (fq >> 1);
        u32x4 xv[2][4][2];
#pragma unroll
        for (int ai = 0; ai < 2; ++ai)
#pragma unroll
            for (int m = 0; m < 4; ++m) { const size_t off = (size_t)(row0 + ai * HALF + m * 16) * ldc + col0;
#pragma unroll
                for (int bj = 0; bj < 2; ++bj) xv[ai][m][bj] = *(const u32x4*)(X + off + bj * HALF); }
#pragma unroll
        for (int ai = 0; ai < 2; ++ai)
#pragma unroll
            for (int p = 0; p < 2; ++p)
#pragma unroll
                for (int bj = 0; bj < 2; ++bj) { unsigned fa[2], fb[2];
#pragma unroll
                    for (int mm = 0; mm < 2; ++mm) { const int m = 2 * p + mm; const size_t off = (size_t)(row0 + ai * HALF + m * 16) * ldc + col0; const u32x4 xx = xv[ai][m][bj];
                        const f32x4 r0 = (f32x4){bflo(xx.x), bfhi(xx.x), bflo(xx.y), bfhi(xx.y)} + acc[ai][bj][m][0], r1 = (f32x4){bflo(xx.z), bfhi(xx.z), bflo(xx.w), bfhi(xx.w)} + acc[ai][bj][m][1];
                        u32x4 w; w.x = cvt_pk_bf16(r0[0], r0[1]); w.y = cvt_pk_bf16(r0[2], r0[3]); w.z = cvt_pk_bf16(r1[0], r1[1]); w.w = cvt_pk_bf16(r1[2], r1[3]);
                        *(u32x4*)(OB + off + bj * HALF) = w;
                        fa[mm] = pk4_fp8(r0[0], r0[1], r0[2], r0[3]); fb[mm] = pk4_fp8(r1[0], r1[1], r1[2], r1[3]); }
                    auto ra = __builtin_amdgcn_permlane32_swap(fa[0], fa[1], false, false); auto rb = __builtin_amdgcn_permlane32_swap(fb[0], fb[1], false, false);
                    u32x4 f = {ra[0], rb[0], ra[1], rb[1]};
                    *(u32x4*)(OF + (size_t)(row0 + rsel + ai * HALF + p * 32) * ldc + colf + bj * HALF) = f; }
    }
};
struct EpiResF32 {
    static constexpr int PERM = 1;
    const float* X; float* O; int ldc; bf16* OB;
    __device__ __forceinline__ void operator()(const f32x4 (&acc)[2][2][4][2], const Unit& u, int wr, int wc, int fr, int fq) const {
        const int row0 = u.pm * BM + wr * 64 + fr, col0 = u.pn * BM + wc * 32 + 8 * fq;
#pragma unroll
        for (int ai = 0; ai < 2; ++ai) {
            f32x4 xv[4][2][2];
#pragma unroll
            for (int m = 0; m < 4; ++m) { const size_t off = (size_t)(row0 + ai * HALF + m * 16) * ldc + col0;
#pragma unroll
                for (int bj = 0; bj < 2; ++bj) { xv[m][bj][0] = *(const f32x4*)(X + off + bj * HALF); xv[m][bj][1] = *(const f32x4*)(X + off + bj * HALF + 4); } }
#pragma unroll
            for (int m = 0; m < 4; ++m) { const size_t off = (size_t)(row0 + ai * HALF + m * 16) * ldc + col0;
#pragma unroll
                for (int bj = 0; bj < 2; ++bj) {
                    const f32x4 r0 = xv[m][bj][0] + acc[ai][bj][m][0], r1 = xv[m][bj][1] + acc[ai][bj][m][1];
                    *(f32x4*)(O + off + bj * HALF) = r0; *(f32x4*)(O + off + bj * HALF + 4) = r1;
                    u32x4 w; w.x = cvt_pk_bf16(r0[0], r0[1]); w.y = cvt_pk_bf16(r0[2], r0[3]); w.z = cvt_pk_bf16(r1[0], r1[1]); w.w = cvt_pk_bf16(r1[2], r1[3]);
                    *(u32x4*)(OB + off + bj * HALF) = w; } }
            asm volatile("" ::: "memory");
        }
    }
};

__device__ __forceinline__ int expert_of_row_l(const PG8_LAS int* pst, int row) {
    const int lane = (int)__builtin_amdgcn_mbcnt_hi(~0u, __builtin_amdgcn_mbcnt_lo(~0u, 0u));
    const bool hit = (lane >= 1 && lane < 32) ? (pst[lane & 31] <= row) : false;
    return __builtin_popcountll(__ballot(hit)); }
struct MoeGuSched {
    static constexpr bool GATHER = true;
    TileOrder o; const char* A; const char* Bt; const int* rowtok; const PG8_LAS int* pst; int K; const PG8_LAS int* ltok;
    __device__ __forceinline__ bool next(int i, Unit& u) const { u.li = i; if (!o.map(i, u.pm, u.pn)) return false; u.e = expert_of_row_l(pst, u.pm * BM); return true; }
    __device__ __forceinline__ const char* a_base(const Unit&) const { return A; }
    __device__ __forceinline__ const char* b_base(const Unit& u) const { return Bt + ((size_t)u.e * 1024 + (size_t)u.pn * BM) * K * 2; }
    __device__ __forceinline__ void a_voff(const Unit& u, const int (&R)[2], const int (&C)[2], unsigned (&v)[2][2]) const {
#pragma unroll
        for (int h = 0; h < 2; ++h)
#pragma unroll
            for (int i = 0; i < 2; ++i) { const int tk = ltok[u.li * BM + h * HALF + R[i]]; const unsigned tok = tk < 0 ? 0u : (unsigned)(tk >> 1); v[h][i] = (tok * (unsigned)K + (unsigned)C[i]) * 2u; }
    }
};
struct MoeDownSched {
    static constexpr bool GATHER = false;
    TileOrder o; const char* A; const char* Bt; const PG8_LAS int* pst; int K;
    __device__ __forceinline__ bool next(int i, Unit& u) const { u.li = i; if (!o.map(i, u.pm, u.pn)) return false; u.e = expert_of_row_l(pst, u.pm * BM); return true; }
    __device__ __forceinline__ const char* a_base(const Unit& u) const { return A + (size_t)u.pm * BM * K * 2; }
    __device__ __forceinline__ const char* b_base(const Unit& u) const { return Bt + ((size_t)u.e * 1024 + (size_t)u.pn * BM) * K * 2; }
    __device__ __forceinline__ void a_voff(const Unit&, const int (&R)[2], const int (&C)[2], unsigned (&v)[2][2]) const {
#pragma unroll
        for (int h = 0; h < 2; ++h)
#pragma unroll
            for (int i = 0; i < 2; ++i) v[h][i] = (unsigned)((h * HALF + R[i]) * K + C[i]) * 2u;
    }
};
struct EpiSwiglu {
    static constexpr int PERM = 2;
    bf16* O; const PG8_LAS float* rowr;
    __device__ __forceinline__ void operator()(const f32x4 (&acc)[2][2][4][2], const Unit& u, int wr, int wc, int fr, int fq) const {
        const int row0 = u.pm * BM + wr * 64 + fr + 16 * (fq >> 1), col0 = u.pn * HALF + wc * 32 + 16 * (fq & 1);
#pragma unroll
        for (int ai = 0; ai < 2; ++ai)
#pragma unroll
            for (int p = 0; p < 2; ++p) {
                unsigned wv[2][2];
#pragma unroll
                for (int mm = 0; mm < 2; ++mm) { const int m = 2 * p + mm; const float rs = rowr[u.li * BM + wr * 64 + fr + ai * HALF + m * 16];
                    float hv[8];
#pragma unroll
                    for (int n = 0; n < 2; ++n)
#pragma unroll
                        for (int j = 0; j < 4; ++j) { const float g = acc[ai][0][m][n][j] * rs, up = acc[ai][1][m][n][j] * rs; hv[n * 4 + j] = g * up * __builtin_amdgcn_rcpf(1.f + __expf(-g)); }
                    wv[mm][0] = pk4_fp8(hv[0], hv[1], hv[2], hv[3]); wv[mm][1] = pk4_fp8(hv[4], hv[5], hv[6], hv[7]); }
                auto ra = __builtin_amdgcn_permlane32_swap(wv[0][0], wv[1][0], false, false); auto rb = __builtin_amdgcn_permlane32_swap(wv[0][1], wv[1][1], false, false);
                u32x4 w = {ra[0], rb[0], ra[1], rb[1]};
                *(u32x4*)((unsigned char*)O + (size_t)(row0 + ai * HALF + p * 32) * 512 + col0) = w; }
    }
};
struct EpiDown {
    static constexpr int PERM = 1;
    bf16* Y; const int* rowtok; const float* roww;
    __device__ __forceinline__ void operator()(const f32x4 (&acc)[2][2][4][2], const Unit& u, int wr, int wc, int fr, int fq) const {
        const int row0 = u.pm * BM + wr * 64 + fr, col0 = u.pn * BM + wc * 32 + 8 * fq;
#pragma unroll
        for (int ai = 0; ai < 2; ++ai)
#pragma unroll
            for (int m = 0; m < 4; ++m) { const int pos = row0 + ai * HALF + m * 16; const int tk = rowtok[pos]; const float w = roww[pos];
                if (tk >= 0) { bf16* rowp = Y + ((size_t)(tk & 1) * 65536 + (size_t)(tk >> 1)) * 1024 + col0;
#pragma unroll
                    for (int bj = 0; bj < 2; ++bj) { const f32x4 v0 = acc[ai][bj][m][0] * w, v1 = acc[ai][bj][m][1] * w;
                        u32x4 o; o.x = cvt_pk_bf16(v0[0], v0[1]); o.y = cvt_pk_bf16(v0[2], v0[3]); o.z = cvt_pk_bf16(v1[0], v1[1]); o.w = cvt_pk_bf16(v1[2], v1[3]);
                        *(u32x4*)(rowp + bj * HALF) = o; } } }
    }
};

typedef int i32x4v __attribute__((ext_vector_type(4)));
typedef int i32x8v __attribute__((ext_vector_type(8)));
template <class Epi, class Sched, bool ALIGN_EPI = true, bool F8 = false>
__device__ __forceinline__ void gemm_phase(PG8_LAS unsigned char* lds, const int K, const Sched& S, const Epi& E) {
    int tid = threadIdx.x; asm volatile("" : "+v"(tid));
    const int wid = __builtin_amdgcn_readfirstlane(tid >> 6), lane = tid & 63, wr = wid >> 2, wc = wid & 3, fr = lane & 15, fq = lane >> 4;
    const int nt = K / BK;
    int Rr[2], Cc[2]; unsigned voffB[2];
#pragma unroll
    for (int i = 0; i < 2; ++i) { int R, C; stage_rc(tid * 16 + i * 8192, R, C); const int Rb = Epi::PERM == 2 ? ((R & ~31) + perm32g(R & 31)) : Epi::PERM ? ((R & ~31) + perm32(R & 31)) : R;
        Rr[i] = R; Cc[i] = C; voffB[i] = (unsigned)(Rb * K + C) * 2u; }
    const size_t kstep = (size_t)(BK * 2);
    const size_t hstep = (size_t)HALF * K * 2;
    const unsigned ldsw = (unsigned)wid * 1024u;
    const int aoff = lds_byte(wr * 64 + fr, fq * 8), boff = lds_byte(wc * 32 + fr, fq * 8);
#define PG8_SA(b, h) (((b) * 2 + (h)) * HTB)
#define PG8_SB(b, h) ((4 + (b) * 2 + (h)) * HTB)
#define PG8_STAGE(bufoff, gbase, voff) do { _Pragma("unroll") for (int _i = 0; _i < 2; ++_i) \
        __builtin_amdgcn_global_load_lds((const unsigned*)((const char*)(gbase) + (voff)[_i]), (PG8_LAS unsigned*)(lds + (bufoff) + ldsw + _i * 8192), 16, 0, 0); } while (0)
#define PG8_CAT(x0, x1) __builtin_shufflevector(__builtin_bit_cast(i32x4v, x0), __builtin_bit_cast(i32x4v, x1), 0, 1, 2, 3, 4, 5, 6, 7)
#define PG8_LDA(dst, b, h) do { if constexpr (F8) { _Pragma("unroll") for (int m = 0; m < 4; ++m) dst##8[m] = PG8_CAT(*(const PG8_LAS bf16x8*)(lds + PG8_SA(b, h) + aoff + m * 2048), *(const PG8_LAS bf16x8*)(lds + PG8_SA(b, h) + aoff + m * 2048 + 1024)); } \
        else { _Pragma("unroll") for (int m = 0; m < 4; ++m) _Pragma("unroll") for (int k = 0; k < 2; ++k) dst[m][k] = *(const PG8_LAS bf16x8*)(lds + PG8_SA(b, h) + aoff + m * 2048 + k * 1024); } } while (0)
#define PG8_LDB(dst, b, h) do { if constexpr (F8) { _Pragma("unroll") for (int n = 0; n < 2; ++n) dst##8[n] = PG8_CAT(*(const PG8_LAS bf16x8*)(lds + PG8_SB(b, h) + boff + n * 2048), *(const PG8_LAS bf16x8*)(lds + PG8_SB(b, h) + boff + n * 2048 + 1024)); } \
        else { _Pragma("unroll") for (int n = 0; n < 2; ++n) _Pragma("unroll") for (int k = 0; k < 2; ++k) dst[n][k] = *(const PG8_LAS bf16x8*)(lds + PG8_SB(b, h) + boff + n * 2048 + k * 1024); } } while (0)
#define PG8_MMA(ai, bj, At, Bt) do { __builtin_amdgcn_s_setprio(1); \
        if constexpr (F8) { __builtin_amdgcn_sched_barrier(0); _Pragma("unroll") for (int m = 0; m < 4; ++m) _Pragma("unroll") for (int n = 0; n < 2; ++n) \
            asm volatile("v_mfma_scale_f32_16x16x128_f8f6f4 %0, %1, %2, %0, %3, %3 op_sel_hi:[0,0,0]" : "+v"(acc[ai][bj][m][n]) : "v"(Bt##8[n]), "v"(At##8[m]), "v"(f8scale)); __builtin_amdgcn_sched_barrier(0); } \
        else { _Pragma("unroll") for (int m = 0; m < 4; ++m) _Pragma("unroll") for (int n = 0; n < 2; ++n) _Pragma("unroll") for (int k = 0; k < 2; ++k) \
            acc[ai][bj][m][n] = __builtin_amdgcn_mfma_f32_16x16x32_bf16(Bt[n][k], At[m][k], acc[ai][bj][m][n], 0, 0, 0); } \
        __builtin_amdgcn_s_setprio(0); } while (0)
#define PG8_WAIT_V(n) asm volatile("s_waitcnt vmcnt(" #n ")" ::: "memory")
#define PG8_WAIT_L(n) asm volatile("s_waitcnt lgkmcnt(" #n ")" ::: "memory")
#define PG8_BAR __builtin_amdgcn_s_barrier()
#define PG8_SCHED __builtin_amdgcn_sched_barrier(0)
    Unit cur, nxt; int ui = 0;
    if (!S.next(0, cur)) return;
    f32x4 acc[2][2][4][2];
#pragma unroll
    for (int a = 0; a < 2; ++a)
#pragma unroll
        for (int b = 0; b < 2; ++b)
#pragma unroll
            for (int m = 0; m < 4; ++m)
#pragma unroll
                for (int n = 0; n < 2; ++n) acc[a][b][m][n] = (f32x4){0.f, 0.f, 0.f, 0.f};
    bf16x8 At[4][2], B0[2][2], B1[2][2];
    i32x8v At8[4], B08[2], B18[2]; const int f8scale = 127;
    unsigned cv[2][2], nv[2][2];
    S.a_voff(cur, Rr, Cc, cv);
#pragma unroll
    for (int h = 0; h < 2; ++h)
#pragma unroll
        for (int i = 0; i < 2; ++i) nv[h][i] = cv[h][i];
    const char* cA = S.a_base(cur); const char* cB = S.b_base(cur);
    PG8_STAGE(PG8_SB(0, 0), cB, voffB); PG8_STAGE(PG8_SB(0, 1), cB + hstep, voffB); PG8_STAGE(PG8_SA(0, 0), cA, cv[0]); PG8_STAGE(PG8_SA(0, 1), cA, cv[1]);
    if (wr == 1) PG8_BAR;
    PG8_WAIT_V(2); PG8_BAR;
    PG8_STAGE(PG8_SB(1, 0), cB + kstep, voffB); PG8_STAGE(PG8_SA(1, 0), cA + kstep, cv[0]); PG8_STAGE(PG8_SB(1, 1), cB + hstep + kstep, voffB);
    PG8_WAIT_V(6); PG8_BAR;
    for (;;) {
        const bool has_next = S.next(ui + 1, nxt);
        const char* nA = has_next ? S.a_base(nxt) : cA; const char* nB = has_next ? S.b_base(nxt) : cB;
#pragma unroll 1
        for (int t = 0; t < nt; t += 2) {
            const bool last = (t == nt - 2);
            const char* a1 = cA + (size_t)(t + 1) * kstep;
            const char* a2 = last ? nA : cA + (size_t)(t + 2) * kstep; const char* b2 = last ? nB : cB + (size_t)(t + 2) * kstep;
            const char* a3 = a2 + kstep; const char* b3 = b2 + kstep;
            unsigned v2[2][2];
            if constexpr (Sched::GATHER) {
                if (last && has_next) { S.a_voff(nxt, Rr, Cc, nv); }
#pragma unroll
                for (int h = 0; h < 2; ++h)
#pragma unroll
                    for (int i = 0; i < 2; ++i) v2[h][i] = last ? nv[h][i] : cv[h][i];
            } else {
#pragma unroll
                for (int h = 0; h < 2; ++h)
#pragma unroll
                    for (int i = 0; i < 2; ++i) v2[h][i] = cv[h][i];
            }
            PG8_LDB(B0, 0, 0); PG8_LDB(B1, 0, 1); PG8_SCHED; PG8_LDA(At, 0, 0); PG8_STAGE(PG8_SA(1, 1), a1, cv[1]);
            PG8_WAIT_V(8); PG8_WAIT_L(0); PG8_BAR; PG8_MMA(0, 0, At, B0); PG8_MMA(0, 1, At, B1); PG8_BAR; PG8_SCHED;
            PG8_LDA(At, 0, 1); PG8_STAGE(PG8_SB(0, 0), b2, voffB); PG8_STAGE(PG8_SB(0, 1), b2 + hstep, voffB); PG8_STAGE(PG8_SA(0, 0), a2, v2[0]);
            PG8_WAIT_V(8); PG8_WAIT_L(0); PG8_BAR; PG8_MMA(1, 0, At, B0); PG8_MMA(1, 1, At, B1); PG8_BAR; PG8_SCHED;
            PG8_LDB(B0, 1, 0); PG8_LDB(B1, 1, 1); PG8_SCHED; PG8_LDA(At, 1, 0); PG8_STAGE(PG8_SA(0, 1), a2, v2[1]);
            PG8_WAIT_V(8); PG8_WAIT_L(0); PG8_BAR; PG8_MMA(0, 0, At, B0); PG8_MMA(0, 1, At, B1); PG8_BAR; PG8_SCHED;
            PG8_LDA(At, 1, 1); PG8_STAGE(PG8_SB(1, 0), b3, voffB); PG8_STAGE(PG8_SB(1, 1), b3 + hstep, voffB); PG8_STAGE(PG8_SA(1, 0), a3, v2[0]);
            PG8_WAIT_V(8); PG8_WAIT_L(0); PG8_BAR; PG8_MMA(1, 0, At, B0); PG8_MMA(1, 1, At, B1); PG8_BAR; PG8_SCHED;
        }
        if constexpr (ALIGN_EPI) { if (wr == 0) PG8_BAR; }
        if constexpr (F8) { asm volatile("s_nop 15\n\ts_nop 15" ::: "memory"); }
        E(acc, cur, wr, wc, fr, fq);
        if (!has_next) break;
#pragma unroll
        for (int a = 0; a < 2; ++a)
#pragma unroll
            for (int b = 0; b < 2; ++b)
#pragma unroll
                for (int m = 0; m < 4; ++m)
#pragma unroll
                    for (int n = 0; n < 2; ++n) acc[a][b][m][n] = (f32x4){0.f, 0.f, 0.f, 0.f};
        cur = nxt; cA = nA; cB = nB; ++ui;
#pragma unroll
        for (int h = 0; h < 2; ++h)
#pragma unroll
            for (int i = 0; i < 2; ++i) cv[h][i] = nv[h][i];
        if constexpr (ALIGN_EPI) { if (wr == 1) PG8_BAR; }
    }
    PG8_WAIT_V(0);
    if constexpr (!ALIGN_EPI) { if (wr == 0) PG8_BAR; }
    PG8_BAR;
#undef PG8_SA
#undef PG8_SB
#undef PG8_STAGE
#undef PG8_LDA
#undef PG8_LDB
#undef PG8_MMA
#undef PG8_CAT
#undef PG8_WAIT_V
#undef PG8_WAIT_L
#undef PG8_BAR
#undef PG8_SCHED
}
}

#define XB_TMO      128
#define XB_XCNT(j)  (256  + 64 * (j))
#define XB_XSUB(j)  (1280 + 64 * (j))
#define XB_XGEN(j)  (2304 + 64 * (j))
#define XB_TOP      3328
#define XB_TOPGEN   3392
#define XCD_BAR_WORDS 3456
#define XB_SPIN_CAP (1u << 22)

__device__ __forceinline__ unsigned xb_ld(unsigned* p)              { return __hip_atomic_load(p, __ATOMIC_RELAXED, __HIP_MEMORY_SCOPE_AGENT); }
__device__ __forceinline__ unsigned xb_add(unsigned* p, unsigned v) { return __hip_atomic_fetch_add(p, v, __ATOMIC_RELAXED, __HIP_MEMORY_SCOPE_AGENT); }
__device__ __forceinline__ unsigned xb_xcc_id() { return (unsigned)__builtin_amdgcn_s_getreg((3 << 11) | 20) & 0xFu; }
#define XB_SPIN(cond, bar) do { unsigned _sp = 0; while (cond) { __builtin_amdgcn_s_sleep(1); \
    if ((++_sp & 255u) == 0u) { if (xb_ld(&(bar)[XB_TMO])) break; if (_sp > XB_SPIN_CAP) { atomicAdd(&(bar)[XB_TMO], 1u); break; } } } } while (0)

struct XcdBarrier { unsigned* bar; unsigned x; volatile LAS unsigned* st; };

__device__ __forceinline__ XcdBarrier xcd_barrier_post(unsigned* bar, volatile LAS unsigned* st) {
    XcdBarrier b; b.bar = bar; b.x = xb_xcc_id(); b.st = st;
    if (threadIdx.x == 0) (void)xb_add(&bar[XB_XCNT(b.x)], 1u);
    return b;
}
__device__ __forceinline__ void xcd_barrier_complete(unsigned* bar, unsigned x, unsigned& nloc, unsigned& nx) {
    const unsigned G = gridDim.x * gridDim.y * gridDim.z;
    unsigned sum, cnt, mine, sp = 0u;
    for (;;) {
        sum = 0u; cnt = 0u; mine = 0u;
#pragma unroll
        for (unsigned j = 0; j < 16; ++j) { const unsigned c = xb_ld(&bar[XB_XCNT(j)]); sum += c; cnt += (c > 0u) ? 1u : 0u; mine = (j == x) ? c : mine; }
        if (sum == G) break;
        __builtin_amdgcn_s_sleep(1);
        if ((++sp & 255u) == 0u) { if (xb_ld(&bar[XB_TMO])) break; if (sp > XB_SPIN_CAP) { atomicAdd(&bar[XB_TMO], 1u); break; } }
    }
    nloc = mine > 0u ? mine : 1u; nx = cnt > 0u ? cnt : 1u;
}
__device__ __forceinline__ void xcd_barrier(const XcdBarrier& b) {
    asm volatile("s_waitcnt vmcnt(0)" ::: "memory");
    __syncthreads();
    if (threadIdx.x == 0) {
        unsigned* bar = b.bar;
        __builtin_amdgcn_s_waitcnt(0);
        unsigned nloc = b.st[0], nx = b.st[1];
        if (nloc == 0u) { xcd_barrier_complete(bar, b.x, nloc, nx); b.st[0] = nloc; b.st[1] = nx; }
        const unsigned old = xb_add(&bar[XB_XSUB(b.x)], 1u);
        const unsigned gen = old / nloc;
        if (old + 1u == (gen + 1u) * nloc) {
            __builtin_amdgcn_fence(__ATOMIC_RELEASE, "agent");
            asm volatile("s_waitcnt vmcnt(0)" ::: "memory");
            const unsigned og = xb_add(&bar[XB_TOP], 1u);
            const unsigned tg = og / nx;
            if (og + 1u == (tg + 1u) * nx) xb_add(&bar[XB_TOPGEN], 1u);
            else XB_SPIN(xb_ld(&bar[XB_TOPGEN]) == tg, bar);
            __builtin_amdgcn_fence(__ATOMIC_ACQUIRE, "agent");
            xb_add(&bar[XB_XGEN(b.x)], 1u);
            asm volatile("s_waitcnt vmcnt(0)" ::: "memory");
        } else {
            XB_SPIN(xb_ld(&bar[XB_XGEN(b.x)]) == gen, bar);
            __builtin_amdgcn_fence(__ATOMIC_ACQUIRE, "agent");
            asm volatile("s_waitcnt vmcnt(0)" ::: "memory");
        }
    }
    __syncthreads();
}

struct Args {
    const float* in[24];
    float* out;
    unsigned char* ws;
    int ph_lo, ph_hi;
};

struct TrItem { const float* src; int ldsrc, k0, n0s; bf16* dst; int ldd, drow0; const float* kscale; int f8; };
__device__ __forceinline__ void tr_load(const TrItem& t, f32x4 (&v)[8], int lane) {
#pragma unroll
    for (int i = 0; i < 8; ++i) v[i] = *(const f32x4*)(t.src + (size_t)(t.k0 + (lane >> 3) + 8 * i) * t.ldsrc + t.n0s + 4 * (lane & 7));
}
__device__ __forceinline__ void tr_finish(const TrItem& t, const f32x4 (&v)[8], LAS float* scr, int lane) {
#pragma unroll
    for (int i = 0; i < 8; ++i) { const int kk = (lane >> 3) + 8 * i; f32x4 x = v[i]; if (t.kscale) x = x * t.kscale[t.k0 + kk];
        LAS float* d = scr + kk * 33 + 4 * (lane & 7); d[0] = x.x; d[1] = x.y; d[2] = x.z; d[3] = x.w; }
    LDS_WAIT();
    const int c = lane & 7;
#pragma unroll
    for (int j = 0; j < 4; ++j) { const int n = (lane >> 3) + 8 * j; const LAS float* s = scr + (8 * c) * 33 + n;
        if (t.f8) { u32x2 o; o.x = pk4_fp8(s[0 * 33], s[1 * 33], s[2 * 33], s[3 * 33]); o.y = pk4_fp8(s[4 * 33], s[5 * 33], s[6 * 33], s[7 * 33]);
            *(u32x2*)((unsigned char*)t.dst + (size_t)(t.drow0 + n) * t.ldd + t.k0 + 8 * c) = o; }
        else { u32x4 o; o.x = pk2(s[0 * 33], s[1 * 33]); o.y = pk2(s[2 * 33], s[3 * 33]); o.z = pk2(s[4 * 33], s[5 * 33]); o.w = pk2(s[6 * 33], s[7 * 33]);
            *(u32x4*)(t.dst + (size_t)(t.drow0 + n) * t.ldd + t.k0 + 8 * c) = o; } }
    LDS_WAIT();
}

__device__ __forceinline__ void p0_prologue(const Args& a, LAS unsigned char* lds, int tid, int lane, int wave, int wg, int G) {
    unsigned char* ws = a.ws;
    const float* x = a.in[0]; const float* norm1_w = a.in[1]; const float* w_in = a.in[2]; const float* b_ig = a.in[3]; const float* b_fg = a.in[4];
    const float* w_out = a.in[15]; const float* w_gate = a.in[21]; const float* w_up = a.in[22]; const float* w_down = a.in[23];
    bf16* W1T = (bf16*)(ws + WS_W1T); bf16* W2T = (bf16*)(ws + WS_W2T); bf16* WGU = (bf16*)(ws + WS_WGU); bf16* WD = (bf16*)(ws + WS_WD);
    bf16* H1 = (bf16*)(ws + WS_H1); float* GATES = (float*)(ws + WS_GATES);
    LAS float* scr = (LAS float*)(lds + wave * 8448);
    LAS float* gwl = (LAS float*)(lds + 73728);
    {
        float gv[16];
#pragma unroll
        for (int q = 0; q < 16; ++q) { const int idx = tid + NTHR * q; gv[q] = w_in[(size_t)(idx >> 3) * INCOLS + 2048 + (idx & 7)]; }
#pragma unroll
        for (int q = 0; q < 16; ++q) gwl[tid + NTHR * q] = gv[q];
    }
    {
        const float* norm2_w = a.in[16]; const float* w_group = a.in[17]; const float* w_expert = a.in[19]; unsigned char* RIMG = ws + WS_RIMG;
        const int idx = wg * NTHR + tid;
        if (idx < 36864) { int k, c; float v;
            if (idx < 4096) { k = idx >> 2; c = idx & 3; v = w_group[idx]; } else { const int j = idx - 4096; k = j >> 5; c = 4 + (j & 31); v = w_expert[j]; }
            v *= norm2_w[k];
            const unsigned hi = f2bf(v), lo = f2bf(v - __uint_as_float(hi << 16));
            *(bf16*)(RIMG + c * 2064 + k * 2) = (bf16)hi; *(bf16*)(RIMG + 36 * 2064 + c * 2064 + k * 2) = (bf16)lo; }
    }
    __syncthreads();
    const int gw = wg * NWAVES + wave, NGW = G * NWAVES;
    constexpr int I_1 = 16 * 112, I_2 = 16 * 32, I_GU = NEXP * 16 * 32, NITEMS = I_1 + I_2 + I_GU;
    auto item_desc = [&](int it) -> TrItem {
        int r = it;
        if (r < I_1) { const int kb = r / 112, nb = r % 112, n0 = nb * 32; int sc_ = n0;
            if (n0 >= 2048 && n0 < 3072) { const int p0 = n0 & 255; sc_ = (n0 & ~255) + 64 * ((p0 >> 5) & 3) + 32 * (p0 >> 7); }
            return TrItem{w_in, INCOLS, kb * 64, sc_ < 2048 ? sc_ : sc_ + 8, W1T, 1024, n0, norm1_w, 0}; } r -= I_1;
        if (r < I_2) { const int kb = r / 32, nb = r % 32; return TrItem{w_out, 1024, kb * 64, nb * 32, W2T, 1024, nb * 32, nullptr, 0}; } r -= I_2;
        { const int e = r / 512, q = r % 512, kb = q / 32, nb = q % 32, j0 = nb * 32, pn = j0 >> 8, rr = j0 & 255;
            const float* s_ = (rr < 128 ? w_gate : w_up) + (size_t)e * 1024 * 512;
            return TrItem{s_, 512, kb * 64, pn * 128 + (rr & 127), (bf16*)((unsigned char*)WGU + (size_t)e * 1024 * 1024), 1024, j0, a.in[16], 1}; }
    };
    if (gw < NITEMS) {
        TrItem cur = item_desc(gw); f32x4 tv[8]; tr_load(cur, tv, lane);
#pragma unroll 1
        for (int it = gw; it < NITEMS; it += NGW) {
            f32x4 cv_[8];
#pragma unroll
            for (int i = 0; i < 8; ++i) cv_[i] = tv[i];
            const TrItem me = cur;
            if (it + NGW < NITEMS) { cur = item_desc(it + NGW); tr_load(cur, tv, lane); }
            tr_finish(me, cv_, scr, lane);
        }
    }
    f32x4 w1v[4];
#pragma unroll
    for (int j = 0; j < 4; ++j) w1v[j] = ((const f32x4*)norm1_w)[lane + 64 * j];
    f32x4 nx[4], nx2[4];
#pragma unroll
    for (int j = 0; j < 4; ++j) { nx[j] = ((const f32x4*)(x + (size_t)gw * DM))[lane + 64 * j]; nx2[j] = ((const f32x4*)(x + (size_t)(gw + NGW) * DM))[lane + 64 * j]; }
    const int gc = ((lane >> 5) & 1) * 4 + ((lane >> 4) & 1) * 2 + ((lane >> 3) & 1), gh = gc & 3;
    const float gbias = (gc < 4) ? b_ig[gh] : b_fg[gh];
#pragma unroll 1
    for (int m = gw; m < T_; m += NGW) {
        f32x4 v[4]; float ss = 0.f;
#pragma unroll
        for (int j = 0; j < 4; ++j) { v[j] = nx[j]; nx[j] = nx2[j]; ss += (v[j].x * v[j].x + v[j].y * v[j].y) + (v[j].z * v[j].z + v[j].w * v[j].w); }
        if (m + 2 * NGW < T_) {
#pragma unroll
            for (int j = 0; j < 4; ++j) nx2[j] = ((const f32x4*)(x + (size_t)(m + 2 * NGW) * DM))[lane + 64 * j]; }
        const float r = rsqrtf(wave_sum(ss) * (1.f / DM) + EPS);
        if (lane == 0) ((float*)(ws + WS_R1))[m] = r;
        float g[8];
#pragma unroll
        for (int c = 0; c < 8; ++c) g[c] = 0.f;
        u32x2* o8 = (u32x2*)(H1 + (size_t)m * DM) + lane;
#pragma unroll
        for (int j = 0; j < 4; ++j) {
            const f32x4 hv = v[j] * r * w1v[j];
            u32x2 o; o.x = pk2(v[j].x, v[j].y); o.y = pk2(v[j].z, v[j].w); o8[64 * j] = o;
#pragma unroll
            for (int i = 0; i < 4; ++i) { const int k = 256 * j + 4 * lane + i; const f32x4 ga = *(const LAS f32x4*)(gwl + k * 8), gb = *(const LAS f32x4*)(gwl + k * 8 + 4);
                const float hh = hv[i];
                g[0] += hh * ga.x; g[1] += hh * ga.y; g[2] += hh * ga.z; g[3] += hh * ga.w; g[4] += hh * gb.x; g[5] += hh * gb.y; g[6] += hh * gb.z; g[7] += hh * gb.w; }
        }
        float k4[4], k2[2], k1;
        { const bool up = (lane & 32) != 0;
#pragma unroll
          for (int i = 0; i < 4; ++i) { const float send = up ? g[i] : g[i + 4]; const float recv = __shfl_xor(send, 32); k4[i] = (up ? g[i + 4] : g[i]) + recv; } }
        { const bool up = (lane & 16) != 0;
#pragma unroll
          for (int i = 0; i < 2; ++i) { const float send = up ? k4[i] : k4[i + 2]; const float recv = __shfl_xor(send, 16); k2[i] = (up ? k4[i + 2] : k4[i]) + recv; } }
        { const bool up = (lane & 8) != 0; const float send = up ? k2[0] : k2[1]; const float recv = __shfl_xor(send, 8); k1 = (up ? k2[1] : k2[0]) + recv; }
        k1 += __shfl_xor(k1, 4); k1 += __shfl_xor(k1, 2); k1 += __shfl_xor(k1, 1);
        if ((lane & 7) == 0) {
            float res = k1 + gbias;
            if (gc >= 4) res = fminf(res, 0.f) - log1pf(__expf(-fabsf(res)));
            GATES[(size_t)m * 8 + gc] = res;
        }
    }
}

__device__ __forceinline__ void p1_stagger_work(const Args& a, LAS unsigned char* lds, int lane, int wave, int wg) {
    const int g = wg & 3; if (g == 0) return;
    const float* w_down = a.in[23]; bf16* WD = (bf16*)(a.ws + WS_WD);
    constexpr int NIT = NEXP * 8 * 32;
    const int lo = (g == 1) ? 0 : (g == 2) ? NIT / 6 : NIT / 2, hi = (g == 1) ? NIT / 6 : (g == 2) ? NIT / 2 : NIT;
    LAS float* scr = (LAS float*)(lds + wave * 8448);
    const int gw = (wg >> 2) * NWAVES + wave, NGW = 64 * NWAVES;
    auto desc = [&](int r) -> TrItem { const int e = r / 256, q = r % 256, kb = q / 32, nb = q % 32;
        return TrItem{w_down + (size_t)e * 512 * 1024, 1024, kb * 64, nb * 32, (bf16*)((unsigned char*)WD + (size_t)e * 1024 * 512), 512, nb * 32, nullptr, 1}; };
    if (lo + gw < hi) {
        TrItem cur = desc(lo + gw); f32x4 tv[8]; tr_load(cur, tv, lane);
#pragma unroll 1
        for (int it = lo + gw; it < hi; it += NGW) {
            f32x4 cv_[8];
#pragma unroll
            for (int i = 0; i < 8; ++i) cv_[i] = tv[i];
            const TrItem me = cur;
            if (it + NGW < hi) { cur = desc(it + NGW); tr_load(cur, tv, lane); }
            tr_finish(me, cv_, scr, lane);
        }
    }
}

__device__ __forceinline__ void mlstm_naive(const Args& a, LAS unsigned char* lds, int item, int tid, int lane, int wave) {
    unsigned char* ws = a.ws;
    const bf16* PROJ = (const bf16*)(ws + WS_PROJ); const float* GATES = (const float*)(ws + WS_GATES); bf16* MIX = (bf16*)(ws + WS_MIX);
    const float* conv_w = a.in[5]; const float* conv_b = a.in[6]; const float* m_norm_w = a.in[7];
    LAS float* qs = (LAS float*)lds; LAS float* ks = qs + 8192; LAS float* vs = ks + 8192; LAS float* hb = vs + 8192;
    LAS float* red = hb + 8192; LAS float* dred = red + 1024; LAS float* igs = dred + 16; LAS float* lfs = igs + 64;
    const int b = item >> 2, h = item & 3, e = tid & 127, dq = tid >> 7;
    float Cr[32], nr[32];
#pragma unroll
    for (int j = 0; j < 32; ++j) { Cr[j] = 0.f; nr[j] = 0.f; }
    float m = 0.f;
    const float mw0 = m_norm_w[lane], mw1 = m_norm_w[lane + 64];
    for (int c = 0; c < SEQ / 64; ++c) {
        const int t0 = c * 64;
        for (int idx = tid; idx < 8192; idx += NTHR) {
            const int tt = idx >> 7, d = idx & 127, t = t0 + tt, colq = C_MQ + h * 128 + d, colk = C_MK + h * 128 + d;
            float aq = conv_b[colq], ak = conv_b[colk];
#pragma unroll
            for (int j = 0; j < 4; ++j) { const int ts = t - 3 + j; if (ts >= 0) { const bf16* row = PROJ + (size_t)(b * SEQ + ts) * NCOL; aq += bf2f(row[colq]) * conv_w[j * 1024 + colq]; ak += bf2f(row[colk]) * conv_w[j * 1024 + colk]; } }
            qs[idx] = siluf_(aq); ks[idx] = siluf_(ak) * 0.08838834764831845f;
            vs[idx] = bf2f(PROJ[(size_t)(b * SEQ + t) * NCOL + C_MV + h * 128 + d]);
        }
        if (tid < 64) { igs[tid] = GATES[(size_t)(b * SEQ + t0 + tid) * 8 + h]; lfs[tid] = GATES[(size_t)(b * SEQ + t0 + tid) * 8 + 4 + h]; }
        __syncthreads();
        for (int tt = 0; tt < 64; ++tt) {
            const float lf = lfs[tt], ig = igs[tt];
            const float mnew = fmaxf(lf + m, ig), fd = __expf(lf + m - mnew), iw = __expf(ig - mnew); m = mnew;
            const float ve = vs[tt * 128 + e] * iw;
            float num = 0.f, den = 0.f;
#pragma unroll
            for (int j = 0; j < 32; ++j) { const int d = dq * 32 + j; const float kd = ks[tt * 128 + d], qd = qs[tt * 128 + d];
                Cr[j] = fd * Cr[j] + kd * ve; nr[j] = fd * nr[j] + iw * kd; num += qd * Cr[j]; den += qd * nr[j]; }
            const int p = tt & 1;
            red[(p * 4 + dq) * 128 + e] = num; if (e == 0) dred[p * 4 + dq] = den;
            __syncthreads();
            if (dq == 0) { const float ntot = (red[(p * 4 + 0) * 128 + e] + red[(p * 4 + 1) * 128 + e]) + (red[(p * 4 + 2) * 128 + e] + red[(p * 4 + 3) * 128 + e]);
                const float dtot = (dred[p * 4 + 0] + dred[p * 4 + 1]) + (dred[p * 4 + 2] + dred[p * 4 + 3]);
                hb[tt * 128 + e] = ntot / fmaxf(fabsf(dtot), __expf(-mnew)); }
        }
        __syncthreads();
#pragma unroll 1
        for (int rr = 0; rr < 8; ++rr) {
            const int tt = wave * 8 + rr, t = t0 + tt; const bf16* rowp = PROJ + (size_t)(b * SEQ + t) * NCOL + C_MO + h * 128;
            const float y0 = hb[tt * 128 + lane] * sigmoidf_(bf2f(rowp[lane])), y1 = hb[tt * 128 + lane + 64] * sigmoidf_(bf2f(rowp[lane + 64]));
            const float r = rsqrtf(wave_sum(y0 * y0 + y1 * y1) * (1.f / 128.f) + EPS);
            bf16* orow = MIX + (size_t)(b * SEQ + t) * DM + h * 128;
            orow[lane] = (bf16)f2bf(y0 * r * mw0); orow[lane + 64] = (bf16)f2bf(y1 * r * mw1);
        }
        __syncthreads();
    }
}

__device__ __forceinline__ void attn_naive_row(const Args& a, LAS float* sc, LAS float* qsl, int ridx, int lane, float lam) {
    unsigned char* ws = a.ws;
    const bf16* PROJ = (const bf16*)(ws + WS_PROJ); bf16* MIX = (bf16*)(ws + WS_MIX);
    const float* qnw = a.in[8]; const float* knw = a.in[9]; const float* anw = a.in[14];
    const int h = ridx & 3, bt = ridx >> 2, t = bt & (SEQ - 1), b = bt >> 11;
    {
        const unsigned u = *(const unsigned*)(PROJ + (size_t)bt * NCOL + C_AQ + h * 128 + 2 * lane);
        const float q0 = bflo(u), q1 = bfhi(u); float ss = q0 * q0 + q1 * q1;
#pragma unroll
        for (int o = 1; o < 32; o <<= 1) ss += __shfl_xor(ss, o);
        const float rq = rsqrtf(ss * (1.f / 64.f) + EPS) * 0.125f; const int dd = (2 * lane) & 63;
        qsl[2 * lane] = q0 * rq * qnw[dd] * knw[dd]; qsl[2 * lane + 1] = q1 * rq * qnw[dd + 1] * knw[dd + 1];
    }
    LDS_WAIT();
    const int nk = ((t >> 6) + 1) * 64;
    float m0 = -1e30f, m1 = -1e30f;
    for (int j = lane; j < nk; j += 64) {
        const u32x4* krow = (const u32x4*)(PROJ + (size_t)(b * SEQ + j) * NCOL + C_AK + h * 128);
        float s0 = 0.f, ss0 = 0.f, s1 = 0.f, ss1 = 0.f;
#pragma unroll
        for (int q = 0; q < 8; ++q) { const u32x4 kv = krow[q]; const f32x4 qa = *(const LAS f32x4*)(qsl + q * 8), qb = *(const LAS f32x4*)(qsl + q * 8 + 4);
            const float k0 = bflo(kv.x), k1 = bfhi(kv.x), k2 = bflo(kv.y), k3 = bfhi(kv.y), k4 = bflo(kv.z), k5 = bfhi(kv.z), k6 = bflo(kv.w), k7 = bfhi(kv.w);
            s0 += qa.x * k0 + qa.y * k1 + qa.z * k2 + qa.w * k3 + qb.x * k4 + qb.y * k5 + qb.z * k6 + qb.w * k7;
            ss0 += k0 * k0 + k1 * k1 + k2 * k2 + k3 * k3 + k4 * k4 + k5 * k5 + k6 * k6 + k7 * k7; }
#pragma unroll
        for (int q = 8; q < 16; ++q) { const u32x4 kv = krow[q]; const f32x4 qa = *(const LAS f32x4*)(qsl + q * 8), qb = *(const LAS f32x4*)(qsl + q * 8 + 4);
            const float k0 = bflo(kv.x), k1 = bfhi(kv.x), k2 = bflo(kv.y), k3 = bfhi(kv.y), k4 = bflo(kv.z), k5 = bfhi(kv.z), k6 = bflo(kv.w), k7 = bfhi(kv.w);
            s1 += qa.x * k0 + qa.y * k1 + qa.z * k2 + qa.w * k3 + qb.x * k4 + qb.y * k5 + qb.z * k6 + qb.w * k7;
            ss1 += k0 * k0 + k1 * k1 + k2 * k2 + k3 * k3 + k4 * k4 + k5 * k5 + k6 * k6 + k7 * k7; }
        s0 *= rsqrtf(ss0 * (1.f / 64.f) + EPS); s1 *= rsqrtf(ss1 * (1.f / 64.f) + EPS);
        sc[j] = s0; sc[2048 + j] = s1; m0 = fmaxf(m0, s0); m1 = fmaxf(m1, s1);
    }
    m0 = wave_max(m0); m1 = wave_max(m1);
    float l0 = 0.f, l1 = 0.f;
    for (int j = lane; j < nk; j += 64) { const float e0 = __expf(sc[j] - m0), e1 = __expf(sc[2048 + j] - m1); sc[j] = e0; sc[2048 + j] = e1; l0 += e0; l1 += e1; }
    l0 = wave_sum(l0); l1 = wave_sum(l1);
    const float c0 = 1.f / l0, c1 = lam / l1;
    LDS_WAIT();
    float o0 = 0.f, o1 = 0.f;
    const bf16* vb = PROJ + (size_t)(b * SEQ) * NCOL + C_AV + h * 128 + 2 * lane;
    for (int j = 0; j < nk; ++j) { const float p = sc[j] * c0 - sc[2048 + j] * c1; const unsigned u = *(const unsigned*)(vb + (size_t)j * NCOL); o0 += p * bflo(u); o1 += p * bfhi(u); }
    const float r = rsqrtf(wave_sum(o0 * o0 + o1 * o1) * (1.f / 128.f) + EPS) * (1.f - LAMBDA_INIT);
    *(unsigned*)(MIX + (size_t)bt * DM + 512 + h * 128 + 2 * lane) = pk2(o0 * r * anw[2 * lane], o1 * r * anw[2 * lane + 1]);
    LDS_WAIT();
}

__device__ __forceinline__ void p2_naive(const Args& a, LAS unsigned char* lds, int tid, int lane, int wave, int wg, int G) {
    if (wg < NBATCH * 4) mlstm_naive(a, lds, wg, tid, lane, wave);
    __syncthreads();
    const float* lq1 = a.in[10]; const float* lk1 = a.in[11]; const float* lq2 = a.in[12]; const float* lk2 = a.in[13];
    const float lam = __expf(wave_sum(lq1[lane] * lk1[lane])) - __expf(wave_sum(lq2[lane] * lk2[lane])) + LAMBDA_INIT;
    LAS float* sc = (LAS float*)(lds + wave * 16896); LAS float* qsl = sc + 4096;
    unsigned* queue = (unsigned*)(a.ws + WS_CTL) + CW_QUEUE;
    constexpr int NUNITS = T_ * 4 / 8;
    for (;;) {
        unsigned u = 0; if (lane == 0) u = __hip_atomic_fetch_add(queue, 1u, __ATOMIC_RELAXED, __HIP_MEMORY_SCOPE_AGENT);
        u = (unsigned)__builtin_amdgcn_readfirstlane((int)u);
        if (u >= (unsigned)NUNITS) break;
        const int base = (NUNITS - 1 - (int)u) * 8;
        for (int k = 0; k < 8; ++k) attn_naive_row(a, sc, qsl, base + k, lane, lam);
    }
}


namespace ml {
constexpr int QL = 0, KL = 17408, KWT = 34816, VT = 53248, SD = 71680, AV = 80896, MV = 89088, WV = 97280, IT = 105472, FL = 113664;
constexpr int MC = 121856, BEND = 121984, AMAX = 122112, DEC = 122240, NL = 122368, RS = 122880, QN = 123392, PSQ = 123648;
constexpr int QS = 272, TS = 144;
constexpr float L2E = 1.4426950408889634f;
#define LBAR() do { asm volatile("s_waitcnt lgkmcnt(0)" ::: "memory"); __builtin_amdgcn_s_barrier(); asm volatile("" ::: "memory"); } while (0)
__device__ __forceinline__ f32x4 mfma16(bf16x8 a, bf16x8 b, f32x4 c) { return __builtin_amdgcn_mfma_f32_16x16x32_bf16(a, b, c, 0, 0, 0); }
__device__ __forceinline__ unsigned cvtpk(float lo, float hi) { unsigned r; asm volatile("v_cvt_pk_bf16_f32 %0, %1, %2" : "=v"(r) : "v"(lo), "v"(hi)); return r; }
__device__ __forceinline__ unsigned cvtpk_nv(float lo, float hi) { unsigned r; asm("v_cvt_pk_bf16_f32 %0, %1, %2" : "=v"(r) : "v"(lo), "v"(hi)); return r; }
__device__ __forceinline__ f32x2 silu2(f32x2 o) { f32x2 e = o * (-L2E); e.x = __builtin_amdgcn_exp2f(e.x); e.y = __builtin_amdgcn_exp2f(e.y); e = e + 1.0f; e.x = __builtin_amdgcn_rcpf(e.x); e.y = __builtin_amdgcn_rcpf(e.y); return o * e; }

__device__ __forceinline__ void mlstm_item(const Args& a, LAS unsigned char* lds, const int item, const int tid) {
    unsigned char* ws = a.ws;
    const bf16* PROJ = (const bf16*)(ws + WS_PROJ); const float* GATES = (const float*)(ws + WS_GATES); bf16* MIX = (bf16*)(ws + WS_MIX);
    const float* conv_w = a.in[5]; const float* conv_b = a.in[6]; const float* m_norm_w = a.in[7];
    const int wid = __builtin_amdgcn_readfirstlane(tid >> 6), lane = tid & 63, fr = lane & 15, fq = lane >> 4;
    const int b = item >> 2, h = item & 3, e0 = 16 * wid;
    LAS float* AVl = (LAS float*)(lds + AV); LAS float* MVl = (LAS float*)(lds + MV); LAS float* WVl = (LAS float*)(lds + WV); LAS float* ITl = (LAS float*)(lds + IT); LAS float* FLl = (LAS float*)(lds + FL);
    LAS float* MCl = (LAS float*)(lds + MC); LAS float* BENDl = (LAS float*)(lds + BEND); LAS float* AMAXl = (LAS float*)(lds + AMAX); LAS float* DECl = (LAS float*)(lds + DEC);
    LAS float* NLl = (LAS float*)(lds + NL); LAS float* RSl = (LAS float*)(lds + RS); LAS float* QNl = (LAS float*)(lds + QN); LAS float* PSQl = (LAS float*)(lds + PSQ);
#pragma unroll 1
    for (int cc = 0; cc < 4; ++cc) {
        const int c = 4 * wid + cc, t = 64 * c + lane; const float* g = GATES + (size_t)(b * SEQ + t) * 8;
        float bs = g[4 + h]; const float ig = g[h];
#pragma unroll
        for (int o = 1; o < 64; o <<= 1) { const float v = __shfl_up(bs, o); if (lane >= o) bs += v; }
        const float av = ig - bs; float pm = av;
#pragma unroll
        for (int o = 1; o < 64; o <<= 1) { const float v = __shfl_up(pm, o); if (lane >= o) pm = fmaxf(pm, v); }
        AVl[t] = av; MVl[t] = pm; FLl[t] = bs;
        if (lane == 63) { BENDl[c] = bs; AMAXl[c] = pm; }
    }
    if (tid < 128) NLl[tid] = 0.f;
    __syncthreads();
    if (tid == 0) { float m = 0.f; for (int c = 0; c < 32; ++c) { MCl[c] = m; m = BENDl[c] + fmaxf(m, AMAXl[c]); } }
    __syncthreads();
    {
        float av_[4], pm_[4], bs_[4], m63_[4], mc_[4];
#pragma unroll
        for (int k = 0; k < 4; ++k) { const int t = tid + NTHR * k, c = t >> 6; av_[k] = AVl[t]; pm_[k] = MVl[t]; bs_[k] = FLl[t]; mc_[k] = MCl[c]; m63_[k] = fmaxf(mc_[k], MVl[64 * c + 63]); }
        __syncthreads();
#pragma unroll
        for (int k = 0; k < 4; ++k) { const int t = tid + NTHR * k; const float M = fmaxf(mc_[k], pm_[k]);
            AVl[t] = av_[k] * L2E; MVl[t] = M * L2E; WVl[t] = __expf(av_[k] - m63_[k]); ITl[t] = __expf(mc_[k] - M); FLl[t] = __expf(-(bs_[k] + M)); }
        if (tid < 32) DECl[tid] = __expf(MCl[tid] - fmaxf(MCl[tid], AMAXl[tid]));
    }
    __syncthreads();
    const int isk = wid >> 2, r0 = (wid & 3) * 16;
    const int ccol = (isk ? C_MK : C_MQ) + h * 128 + 2 * lane;
    f32x2 cw2[4], cb2;
#pragma unroll
    for (int j = 0; j < 4; ++j) { cw2[j].x = conv_w[j * 1024 + ccol]; cw2[j].y = conv_w[j * 1024 + ccol + 1]; }
    cb2.x = conv_b[ccol]; cb2.y = conv_b[ccol + 1];
    const bf16* qkbase = PROJ + (size_t)(b * SEQ) * NCOL + ccol;
    const bf16* vbase = PROJ + (size_t)(b * SEQ) * NCOL + C_MV + h * 128 + 2 * lane;
    const bf16* obase = PROJ + (size_t)(b * SEQ) * NCOL + C_MO + h * 128 + e0 + 4 * fq;
    const f32x4 mw = *(const f32x4*)(m_norm_w + e0 + 4 * fq);
    unsigned raw[19], vraw[8];
#define ML_LOADS(c_) do { _Pragma("unroll") for (int i = 0; i < 19; ++i) { const int t = 64 * (c_) + r0 - 3 + i; raw[i] = (t >= 0) ? *(const unsigned*)(qkbase + (size_t)(t < 0 ? 0 : t) * NCOL) : 0u; } \
        _Pragma("unroll") for (int i = 0; i < 8; ++i) vraw[i] = *(const unsigned*)(vbase + (size_t)(64 * (c_) + 8 * wid + i) * NCOL); } while (0)
    ML_LOADS(0);
    f32x4 Cacc[8];
#pragma unroll
    for (int i = 0; i < 8; ++i) Cacc[i] = (f32x4){0.f, 0.f, 0.f, 0.f};
#pragma unroll 1
    for (int c = 0; c < SEQ / 64; ++c) {
        {
            f32x2 xx[19];
#pragma unroll
            for (int i = 0; i < 19; ++i) { xx[i].x = bflo(raw[i]); xx[i].y = bfhi(raw[i]); }
            f32x2 oo[16], ee[16];
#pragma unroll
            for (int i = 0; i < 16; ++i) oo[i] = xx[i] * cw2[0] + cb2;
#pragma unroll
            for (int j = 1; j < 4; ++j)
#pragma unroll
                for (int i = 0; i < 16; ++i) oo[i] = xx[i + j] * cw2[j] + oo[i];
#pragma unroll
            for (int i = 0; i < 16; ++i) ee[i] = oo[i] * (-L2E);
#pragma unroll
            for (int i = 0; i < 16; ++i) { ee[i].x = __builtin_amdgcn_exp2f(ee[i].x); ee[i].y = __builtin_amdgcn_exp2f(ee[i].y); }
#pragma unroll
            for (int i = 0; i < 16; ++i) ee[i] = ee[i] + 1.0f;
#pragma unroll
            for (int i = 0; i < 16; ++i) { ee[i].x = __builtin_amdgcn_rcpf(ee[i].x); ee[i].y = __builtin_amdgcn_rcpf(ee[i].y); }
            if (!isk) {
#pragma unroll
                for (int i = 0; i < 16; ++i) oo[i] = oo[i] * ee[i];
#pragma unroll
                for (int i = 0; i < 16; ++i) *(LAS unsigned*)(lds + QL + (r0 + i) * QS + 4 * lane) = cvtpk_nv(oo[i].x, oo[i].y);
            } else {
                f32x2 kv[16];
#pragma unroll
                for (int i = 0; i < 16; ++i) kv[i] = oo[i] * ee[i] * 0.08838834764831845f;
#pragma unroll
                for (int i = 0; i < 16; ++i) *(LAS unsigned*)(lds + KL + (r0 + i) * QS + 4 * lane) = cvtpk_nv(kv[i].x, kv[i].y);
                u32x4 k0a, k0b, k1a, k1b;
#pragma unroll
                for (int q = 0; q < 4; ++q) { const f32x4 w4 = *(const LAS f32x4*)(WVl + 64 * c + r0 + 4 * q);
                    const f32x2 e0_ = kv[4 * q] * w4.x, e1_ = kv[4 * q + 1] * w4.y, e2_ = kv[4 * q + 2] * w4.z, e3_ = kv[4 * q + 3] * w4.w;
                    const unsigned a0 = cvtpk(e0_.x, e1_.x), a1 = cvtpk(e2_.x, e3_.x), b0 = cvtpk(e0_.y, e1_.y), b1 = cvtpk(e2_.y, e3_.y);
                    if (q == 0) { k0a.x = a0; k0a.y = a1; k1a.x = b0; k1a.y = b1; } else if (q == 1) { k0a.z = a0; k0a.w = a1; k1a.z = b0; k1a.w = b1; }
                    else if (q == 2) { k0b.x = a0; k0b.y = a1; k1b.x = b0; k1b.y = b1; } else { k0b.z = a0; k0b.w = a1; k1b.z = b0; k1b.w = b1; } }
                *(LAS u32x4*)(lds + KWT + (2 * lane) * TS + r0 * 2) = k0a; *(LAS u32x4*)(lds + KWT + (2 * lane) * TS + r0 * 2 + 16) = k0b;
                *(LAS u32x4*)(lds + KWT + (2 * lane + 1) * TS + r0 * 2) = k1a; *(LAS u32x4*)(lds + KWT + (2 * lane + 1) * TS + r0 * 2 + 16) = k1b;
            }
            u32x4 v0, v1;
            v0.x = (vraw[0] & 0xffffu) | (vraw[1] << 16); v0.y = (vraw[2] & 0xffffu) | (vraw[3] << 16); v0.z = (vraw[4] & 0xffffu) | (vraw[5] << 16); v0.w = (vraw[6] & 0xffffu) | (vraw[7] << 16);
            v1.x = (vraw[0] >> 16) | (vraw[1] & 0xffff0000u); v1.y = (vraw[2] >> 16) | (vraw[3] & 0xffff0000u); v1.z = (vraw[4] >> 16) | (vraw[5] & 0xffff0000u); v1.w = (vraw[6] >> 16) | (vraw[7] & 0xffff0000u);
            *(LAS u32x4*)(lds + VT + (2 * lane) * TS + 16 * wid) = v0;
            *(LAS u32x4*)(lds + VT + (2 * lane + 1) * TS + 16 * wid) = v1;
        }
        if (c + 1 < SEQ / 64) ML_LOADS(c + 1);
        u32x2 og[4];
#pragma unroll
        for (int ti = 0; ti < 4; ++ti) og[ti] = *(const u32x2*)(obase + (size_t)(64 * c + 16 * ti + fr) * NCOL);
        LBAR();
        {
            const int ti = wid >> 1, half = wid & 1; float rsum = 0.f;
            const float Mt = MVl[64 * c + 16 * ti + fr];
#pragma unroll
            for (int sx = 0; sx < 2; ++sx) {
                const int si = 2 * half + sx; f32x4 acc = (f32x4){0.f, 0.f, 0.f, 0.f};
                if (si <= ti) {
#pragma unroll
                    for (int kb = 0; kb < 4; ++kb) {
                        const bf16x8 kf = *(const LAS bf16x8*)(lds + KL + (16 * si + fr) * QS + (32 * kb + 8 * fq) * 2);
                        const bf16x8 qf = *(const LAS bf16x8*)(lds + QL + (16 * ti + fr) * QS + (32 * kb + 8 * fq) * 2);
                        acc = mfma16(kf, qf, acc); }
                    const f32x4 av = *(const LAS f32x4*)(AVl + 64 * c + 16 * si + 4 * fq);
#pragma unroll
                    for (int j = 0; j < 4; ++j) { const int s = 16 * si + 4 * fq + j, t = 16 * ti + fr; const float dd = (s <= t) ? __builtin_amdgcn_exp2f(av[j] - Mt) : 0.f; acc[j] *= dd; rsum += acc[j]; }
                }
                u32x2 o; o.x = cvtpk(acc[0], acc[1]); o.y = cvtpk(acc[2], acc[3]);
                *(LAS u32x2*)(lds + SD + (16 * ti + fr) * TS + (16 * si + 4 * fq) * 2) = o;
            }
            rsum += __shfl_xor(rsum, 16); rsum += __shfl_xor(rsum, 32);
            if (fq == 0) RSl[(16 * ti + fr) * 2 + half] = rsum;
        }
        {
            const int t = tid >> 3, part = tid & 7;
            const u32x4 qa = *(const LAS u32x4*)(lds + QL + t * QS + part * 32), qb = *(const LAS u32x4*)(lds + QL + t * QS + part * 32 + 16);
            const f32x4 n0 = *(const LAS f32x4*)(NLl + 16 * part), n1 = *(const LAS f32x4*)(NLl + 16 * part + 4), n2 = *(const LAS f32x4*)(NLl + 16 * part + 8), n3 = *(const LAS f32x4*)(NLl + 16 * part + 12);
            float s = bflo(qa.x) * n0.x + bfhi(qa.x) * n0.y + bflo(qa.y) * n0.z + bfhi(qa.y) * n0.w + bflo(qa.z) * n1.x + bfhi(qa.z) * n1.y + bflo(qa.w) * n1.z + bfhi(qa.w) * n1.w
                    + bflo(qb.x) * n2.x + bfhi(qb.x) * n2.y + bflo(qb.y) * n2.z + bfhi(qb.y) * n2.w + bflo(qb.z) * n3.x + bfhi(qb.z) * n3.y + bflo(qb.w) * n3.z + bfhi(qb.w) * n3.w;
            s += __shfl_xor(s, 1); s += __shfl_xor(s, 2); s += __shfl_xor(s, 4);
            if (part == 0) QNl[t] = s;
        }
        LBAR();
        f32x4 hacc[4]; float inter[4];
        {
            bf16x8 cf[4];
#pragma unroll
            for (int kb = 0; kb < 4; ++kb) { u32x4 w; w.x = cvtpk(Cacc[2 * kb][0], Cacc[2 * kb][1]); w.y = cvtpk(Cacc[2 * kb][2], Cacc[2 * kb][3]); w.z = cvtpk(Cacc[2 * kb + 1][0], Cacc[2 * kb + 1][1]); w.w = cvtpk(Cacc[2 * kb + 1][2], Cacc[2 * kb + 1][3]);
                cf[kb] = __builtin_bit_cast(bf16x8, w); }
#pragma unroll
            for (int ti = 0; ti < 4; ++ti) {
                hacc[ti] = (f32x4){0.f, 0.f, 0.f, 0.f};
#pragma unroll
                for (int kb = 0; kb < 4; ++kb) {
                    const u32x2 lo = *(const LAS u32x2*)(lds + QL + (16 * ti + fr) * QS + (32 * kb + 4 * fq) * 2), hi = *(const LAS u32x2*)(lds + QL + (16 * ti + fr) * QS + (32 * kb + 16 + 4 * fq) * 2);
                    const u32x4 qq = (u32x4){lo.x, lo.y, hi.x, hi.y};
                    hacc[ti] = mfma16(cf[kb], __builtin_bit_cast(bf16x8, qq), hacc[ti]); }
                inter[ti] = ITl[64 * c + 16 * ti + fr];
                hacc[ti] = hacc[ti] * inter[ti];
            }
        }
        {
            bf16x8 vf[2];
#pragma unroll
            for (int ks = 0; ks < 2; ++ks) vf[ks] = *(const LAS bf16x8*)(lds + VT + (e0 + fr) * TS + (32 * ks + 8 * fq) * 2);
#pragma unroll
            for (int ti = 0; ti < 4; ++ti)
#pragma unroll
                for (int ks = 0; ks < 2; ++ks) if (ks == 0 || ti >= 2) {
                    const bf16x8 sf = *(const LAS bf16x8*)(lds + SD + (16 * ti + fr) * TS + (32 * ks + 8 * fq) * 2);
                    hacc[ti] = mfma16(vf[ks], sf, hacc[ti]); }
            const float decay = DECl[c];
            float nsum = 0.f;
#pragma unroll
            for (int i = 0; i < 8; ++i) {
                Cacc[i] = Cacc[i] * decay;
#pragma unroll
                for (int ks = 0; ks < 2; ++ks) {
                    const bf16x8 kwf = *(const LAS bf16x8*)(lds + KWT + (16 * i + fr) * TS + (32 * ks + 8 * fq) * 2);
                    Cacc[i] = mfma16(kwf, vf[ks], Cacc[i]); }
            }
#pragma unroll
            for (int ks = 0; ks < 2; ++ks) {
                const u32x4 kk = *(const LAS u32x4*)(lds + KWT + (16 * wid + fr) * TS + (32 * ks + 8 * fq) * 2);
                nsum += (bflo(kk.x) + bfhi(kk.x)) + (bflo(kk.y) + bfhi(kk.y)) + (bflo(kk.z) + bfhi(kk.z)) + (bflo(kk.w) + bfhi(kk.w)); }
            nsum += __shfl_xor(nsum, 16); nsum += __shfl_xor(nsum, 32);
            if (fq == 0) NLl[16 * wid + fr] = decay * NLl[16 * wid + fr] + nsum;
        }
        f32x4 hm[4];
#pragma unroll
        for (int ti = 0; ti < 4; ++ti) {
            const int t = 16 * ti + fr;
            const float den = RSl[2 * t] + RSl[2 * t + 1] + inter[ti] * QNl[t];
            const float rd = __builtin_amdgcn_rcpf(fmaxf(fabsf(den), FLl[64 * c + t]));
            const f32x4 gg = (f32x4){bflo(og[ti].x), bfhi(og[ti].x), bflo(og[ti].y), bfhi(og[ti].y)};
            hm[ti] = hacc[ti] * gg * rd;
            float psq = (hm[ti][0] * hm[ti][0] + hm[ti][1] * hm[ti][1]) + (hm[ti][2] * hm[ti][2] + hm[ti][3] * hm[ti][3]);
            psq += __shfl_xor(psq, 16); psq += __shfl_xor(psq, 32);
            if (fq == 0) PSQl[t * 8 + wid] = psq;
        }
        LBAR();
#pragma unroll
        for (int ti = 0; ti < 4; ++ti) {
            const int t = 16 * ti + fr;
            const f32x4 p0 = *(const LAS f32x4*)(PSQl + t * 8), p1 = *(const LAS f32x4*)(PSQl + t * 8 + 4);
            const float r = rsqrtf(((p0.x + p0.y) + (p0.z + p0.w) + (p1.x + p1.y) + (p1.z + p1.w)) * (1.f / 128.f) + EPS);
            const f32x4 ov = hm[ti] * mw * r;
            u32x2 o; o.x = cvtpk(ov[0], ov[1]); o.y = cvtpk(ov[2], ov[3]);
            *(u32x2*)(MIX + (size_t)(b * SEQ + 64 * c + t) * DM + h * 128 + e0 + 4 * fq) = o;
        }
    }
#undef ML_LOADS
}
}

namespace att {
using s16x4  = __attribute__((ext_vector_type(4))) short;
using f32x16 = __attribute__((ext_vector_type(16))) float;
constexpr int SHM_V = 16384, SHM_K = 16384;
constexpr float THR2 = 11.5415603f;
#define KSWZ(row, colB) ((row) * 256 + ((colB) ^ (((row) & 7) << 4)))
#define SBAR() __builtin_amdgcn_sched_barrier(0)
__device__ __forceinline__ int crow(int r, int hi) { return (r & 3) + 8 * (r >> 2) + 4 * hi; }
__device__ __forceinline__ unsigned cvtpk(float lo, float hi) { unsigned r; asm volatile("v_cvt_pk_bf16_f32 %0, %1, %2" : "=v"(r) : "v"(lo), "v"(hi)); return r; }
__device__ __forceinline__ void partialSM(f32x16& p0, f32x16& p1, float& m_reg, float& mn, float& alpha) {
  float pmax = p0[0];
#pragma unroll
  for (int r = 1; r < 16; ++r) pmax = fmaxf(pmax, p0[r]);
#pragma unroll
  for (int r = 0; r < 16; ++r) pmax = fmaxf(pmax, p1[r]);
  { auto rr = __builtin_amdgcn_permlane32_swap(__float_as_uint(pmax), __float_as_uint(pmax), false, false);
    pmax = fmaxf(__uint_as_float(rr[0]), __uint_as_float(rr[1])); }
  if (__builtin_expect(__all(pmax - m_reg <= THR2), 1)) { mn = m_reg; alpha = 1.f; }
  else { mn = fmaxf(m_reg, pmax); alpha = __builtin_amdgcn_exp2f(m_reg - mn); m_reg = mn; }
#pragma unroll
  for (int r = 0; r < 16; ++r) p0[r] = p0[r] - mn;
#pragma unroll
  for (int r = 0; r < 16; ++r) p1[r] = p1[r] - mn;
#pragma unroll
  for (int r = 0; r < 16; ++r) p0[r] = __builtin_amdgcn_exp2f(p0[r]);
}
__device__ __forceinline__ void finishSM(f32x16& p0, f32x16& p1, float alpha, float& l_reg, bf16x8& pa0, bf16x8& pa1, bf16x8& pa2, bf16x8& pa3) {
#pragma unroll
  for (int r = 0; r < 16; ++r) p1[r] = __builtin_amdgcn_exp2f(p1[r]);
  float ps = 0;
#pragma unroll
  for (int r = 0; r < 16; ++r) ps += p0[r];
#pragma unroll
  for (int r = 0; r < 16; ++r) ps += p1[r];
  { auto rr = __builtin_amdgcn_permlane32_swap(__float_as_uint(ps), __float_as_uint(ps), false, false);
    ps = __uint_as_float(rr[0]) + __uint_as_float(rr[1]); }
  l_reg = l_reg * alpha + ps;
#define PK4(P, BASE, OUT) do { unsigned a0 = cvtpk(P[BASE + 0], P[BASE + 1]), a1 = cvtpk(P[BASE + 2], P[BASE + 3]);   \
    unsigned b0 = cvtpk(P[BASE + 4], P[BASE + 5]), b1 = cvtpk(P[BASE + 6], P[BASE + 7]);                              \
    auto r0 = __builtin_amdgcn_permlane32_swap(a0, b0, false, false); auto r1 = __builtin_amdgcn_permlane32_swap(a1, b1, false, false); \
    u32x4 w = {r0[0], r1[0], r0[1], r1[1]}; OUT = __builtin_bit_cast(bf16x8, w); } while (0)
  PK4(p0, 0, pa0); PK4(p0, 8, pa1); PK4(p1, 0, pa2); PK4(p1, 8, pa3);
#undef PK4
}
__device__ __forceinline__ void partialFX(f32x16& p0) {
#pragma unroll
  for (int r = 0; r < 16; ++r) p0[r] = __builtin_amdgcn_exp2f(p0[r]);
}
__device__ __forceinline__ void finishFX(f32x16& p0, f32x16& p1, float& l_reg, bf16x8& pa0, bf16x8& pa1, bf16x8& pa2, bf16x8& pa3) {
#pragma unroll
  for (int r = 0; r < 16; ++r) p1[r] = __builtin_amdgcn_exp2f(p1[r]);
  float ps = 0;
#pragma unroll
  for (int r = 0; r < 16; ++r) ps += p0[r];
#pragma unroll
  for (int r = 0; r < 16; ++r) ps += p1[r];
  l_reg += ps;
#define PK4(P, BASE, OUT) do { unsigned a0 = cvtpk(P[BASE + 0], P[BASE + 1]), a1 = cvtpk(P[BASE + 2], P[BASE + 3]);   \
    unsigned b0 = cvtpk(P[BASE + 4], P[BASE + 5]), b1 = cvtpk(P[BASE + 6], P[BASE + 7]);                              \
    auto r0 = __builtin_amdgcn_permlane32_swap(a0, b0, false, false); auto r1 = __builtin_amdgcn_permlane32_swap(a1, b1, false, false); \
    u32x4 w = {r0[0], r1[0], r0[1], r1[1]}; OUT = __builtin_bit_cast(bf16x8, w); } while (0)
  PK4(p0, 0, pa0); PK4(p0, 8, pa1); PK4(p1, 0, pa2); PK4(p1, 8, pa3);
#undef PK4
}
__device__ __forceinline__ void qkt(f32x16& p0, f32x16& p1, const LAS unsigned char* Ks, const bf16x8 (&qr)[4], int c, int r32, int hi) {
  p0 = f32x16{}; p1 = f32x16{};
#pragma unroll
  for (int d0 = 0; d0 < 4; ++d0) { const int cb = (c * 64 + d0 * 16 + hi * 8) * 2;
    const bf16x8 b0 = *(const LAS bf16x8*)(Ks + KSWZ(r32, cb));
    const bf16x8 b1 = *(const LAS bf16x8*)(Ks + KSWZ(32 + r32, cb));
    p0 = __builtin_amdgcn_mfma_f32_32x32x16_bf16(b0, qr[d0], p0, 0, 0, 0);
    p1 = __builtin_amdgcn_mfma_f32_32x32x16_bf16(b1, qr[d0], p1, 0, 0, 0); }
}
__device__ __forceinline__ int v_st(int k, int c) { const int kk = (k & ~0xC) | ((k & 4) << 1) | ((k & 8) >> 1); return ((kk >> 3) * 4 + (c >> 5)) * 512 + ((kk & 7) * 32 + (c & 31)) * 2; }
__device__ __forceinline__ int v_rd_base(int lane) { return ((lane & 3) << 3) | (((lane >> 2) & 3) << 6) | (((lane >> 4) & 1) << 5) | (((lane >> 5) & 1) << 8); }
constexpr int v_rd_off(int d0, int ks, int half) { return d0 * 512 + ks * 4096 + half * 2048; }
template <int OFF> __device__ __forceinline__ s16x4 tr_read(int vb) {
  s16x4 r; asm volatile("ds_read_b64_tr_b16 %0, %1 offset:%2" : "=&v"(r) : "v"(vb), "i"(OFF) : "memory"); return r;
}
template <int D0> __device__ __forceinline__ void pv_one(f32x16& od, int vb, bf16x8 pa0, bf16x8 pa1, bf16x8 pa2, bf16x8 pa3) {
  const s16x4 l0 = tr_read<v_rd_off(D0, 0, 0)>(vb), h0 = tr_read<v_rd_off(D0, 0, 1)>(vb), l1 = tr_read<v_rd_off(D0, 1, 0)>(vb), h1 = tr_read<v_rd_off(D0, 1, 1)>(vb);
  const s16x4 l2 = tr_read<v_rd_off(D0, 2, 0)>(vb), h2 = tr_read<v_rd_off(D0, 2, 1)>(vb), l3 = tr_read<v_rd_off(D0, 3, 0)>(vb), h3 = tr_read<v_rd_off(D0, 3, 1)>(vb);
  asm volatile("s_waitcnt lgkmcnt(0)" ::: "memory"); SBAR();
#define PK(L, H) (bf16x8){L[0], L[1], L[2], L[3], H[0], H[1], H[2], H[3]}
  od = __builtin_amdgcn_mfma_f32_32x32x16_bf16(pa0, PK(l0, h0), od, 0, 0, 0);
  od = __builtin_amdgcn_mfma_f32_32x32x16_bf16(pa1, PK(l1, h1), od, 0, 0, 0);
  od = __builtin_amdgcn_mfma_f32_32x32x16_bf16(pa2, PK(l2, h2), od, 0, 0, 0);
  od = __builtin_amdgcn_mfma_f32_32x32x16_bf16(pa3, PK(l3, h3), od, 0, 0, 0);
#undef PK
}
#define PVRD(D0) const s16x4 l0_##D0 = tr_read<v_rd_off(D0, 0, 0)>(vb), h0_##D0 = tr_read<v_rd_off(D0, 0, 1)>(vb), l1_##D0 = tr_read<v_rd_off(D0, 1, 0)>(vb), h1_##D0 = tr_read<v_rd_off(D0, 1, 1)>(vb), \
    l2_##D0 = tr_read<v_rd_off(D0, 2, 0)>(vb), h2_##D0 = tr_read<v_rd_off(D0, 2, 1)>(vb), l3_##D0 = tr_read<v_rd_off(D0, 3, 0)>(vb), h3_##D0 = tr_read<v_rd_off(D0, 3, 1)>(vb)
#define PVPK(L, H) (bf16x8){L[0], L[1], L[2], L[3], H[0], H[1], H[2], H[3]}
#define PVMM(D0, N) do { asm volatile("s_waitcnt lgkmcnt(" #N ")" ::: "memory"); SBAR(); \
    o[D0] = __builtin_amdgcn_mfma_f32_32x32x16_bf16(pa0, PVPK(l0_##D0, h0_##D0), o[D0], 0, 0, 0); o[D0] = __builtin_amdgcn_mfma_f32_32x32x16_bf16(pa1, PVPK(l1_##D0, h1_##D0), o[D0], 0, 0, 0); \
    o[D0] = __builtin_amdgcn_mfma_f32_32x32x16_bf16(pa2, PVPK(l2_##D0, h2_##D0), o[D0], 0, 0, 0); o[D0] = __builtin_amdgcn_mfma_f32_32x32x16_bf16(pa3, PVPK(l3_##D0, h3_##D0), o[D0], 0, 0, 0); } while (0)
__device__ __forceinline__ void pv_d0(f32x16* o, int vb, bf16x8 pa0, bf16x8 pa1, bf16x8 pa2, bf16x8 pa3) {
  PVRD(0); PVRD(1); PVMM(0, 8); PVRD(2); PVMM(1, 8); PVRD(3); PVMM(2, 8); PVMM(3, 0);
}
#undef PVRD
#undef PVPK
#undef PVMM

template <bool FX>
__device__ __forceinline__ void attn_unit(const bf16* __restrict__ PROJ, bf16* __restrict__ MIX, const float* __restrict__ anw, const float lam, const float nb, const int b, const int h, const int qb,
                                          LAS unsigned char* lds, const int tid) {
  const int wid = __builtin_amdgcn_readfirstlane(tid >> 6), lane = tid & 63, r32 = lane & 31, hi = lane >> 5, g = wid >> 1, c = wid & 1;
  const int q0 = qb * 128, NT = 2 * qb + 2; const bool masked_last = (g < 2);
  int hcol = h * 128; asm volatile("" : "+s"(hcol));
  const char* Kg = (const char*)(PROJ + (size_t)(b * SEQ) * NCOL + C_AK + hcol);
  const char* Vg = (const char*)(PROJ + (size_t)(b * SEQ) * NCOL + C_AV + hcol);
  LAS float* wsf = (LAS float*)(lds + 131072) + wid * 64; LAS float* li_l = wsf; LAS float* al_l = wsf + 32;
  unsigned koff[2], voff[2];
#pragma unroll
  for (int p = 0; p < 2; ++p) { const int s = (wid * 2 + p) * 64 + lane, row = s >> 4, ch = (s & 15) ^ (row & 7); koff[p] = (unsigned)(row * NCOL + ch * 8) * 2u;
    const int o = s * 16, sub = o >> 9, within = o & 511, kk = (sub >> 2) * 8 + (within >> 6), k = (kk & ~0xC) | ((kk & 4) << 1) | ((kk & 8) >> 1), cc = (sub & 3) * 32 + ((within & 63) >> 4) * 8;
    voff[p] = (unsigned)(k * NCOL + cc) * 2u; }
#define DMA(tile, slot) do { const char* kt_ = Kg + (size_t)(tile) * (64 * NCOL * 2); const char* vt_ = Vg + (size_t)(tile) * (64 * NCOL * 2); LAS unsigned char* sl_ = lds + (slot) * 32768 + wid * 2048; \
    _Pragma("unroll") for (int p_ = 0; p_ < 2; ++p_) __builtin_amdgcn_global_load_lds((const unsigned*)(kt_ + koff[p_]), (LAS unsigned*)(sl_ + p_ * 1024), 16, 0, 0); \
    _Pragma("unroll") for (int p_ = 0; p_ < 2; ++p_) __builtin_amdgcn_global_load_lds((const unsigned*)(vt_ + voff[p_]), (LAS unsigned*)(sl_ + 16384 + p_ * 1024), 16, 0, 0); } while (0)
#define WB4() do { asm volatile("s_waitcnt vmcnt(4)" ::: "memory"); __builtin_amdgcn_s_barrier(); asm volatile("" ::: "memory"); } while (0)
#define WB8() do { asm volatile("s_waitcnt vmcnt(8)" ::: "memory"); __builtin_amdgcn_s_barrier(); asm volatile("" ::: "memory"); } while (0)
#define KSLOT(j) (lds + ((j) & 3) * 32768)
#define VSLOT(j) (vb0 + ((j) & 3) * 32768)
  float m_reg = -1e30f, l_reg = 0; f32x16 o[4] = {}; bf16x8 qr[4];
  { const bf16* Qw = PROJ + (size_t)(b * SEQ + q0 + 32 * g + r32) * NCOL + C_AQ + hcol + c * 64 + hi * 8;
#pragma unroll
    for (int d0 = 0; d0 < 4; ++d0) qr[d0] = *(const bf16x8*)(Qw + d0 * 16); }
  const int vb0 = (int)(unsigned)(uintptr_t)lds + 16384 + v_rd_base(lane);
#define RESC(a) do { if (__any((a) < 1.f)) { if (hi == 0) al_l[r32] = (a); asm volatile("s_waitcnt lgkmcnt(0)" ::: "memory"); \
    _Pragma("unroll") for (int d = 0; d < 4; ++d) _Pragma("unroll") for (int r = 0; r < 16; ++r) o[d][r] *= al_l[crow(r, hi)]; } } while (0)
  f32x16 p0, p1; float mn, al; bf16x8 pa0, pa1, pa2, pa3;
  DMA(0, 0); DMA(1, 1);
#pragma unroll 1
  for (int j = 0; j < NT; ++j) {
    WB4();
    DMA((j + 2 < NT ? j + 2 : NT - 1), (j + 2) & 3);
    SBAR(); qkt(p0, p1, KSLOT(j), qr, c, r32, hi);
    if (masked_last && j == NT - 1) {
#pragma unroll
      for (int r = 0; r < 16; ++r) { p0[r] = -1e30f; p1[r] = -1e30f; } }
    if constexpr (FX) { SBAR(); partialFX(p0); finishFX(p0, p1, l_reg, pa0, pa1, pa2, pa3); SBAR(); }
    else { partialSM(p0, p1, m_reg, mn, al); RESC(al); finishSM(p0, p1, al, l_reg, pa0, pa1, pa2, pa3); SBAR(); }
    pv_d0(o, VSLOT(j), pa0, pa1, pa2, pa3);
  }
  if constexpr (FX) l_reg += __shfl_xor(l_reg, 32);
  asm volatile("s_waitcnt vmcnt(0)" ::: "memory");
#undef DMA
#undef WB4
#undef WB8
#undef KSLOT
#undef VSLOT
  if (hi == 0) li_l[r32] = l_reg; asm volatile("s_waitcnt lgkmcnt(0)" ::: "memory");
  int lane2 = lane; asm volatile("" : "+v"(lane2));
  const int r32b = lane2 & 31, hib = lane2 >> 5;
  float rli[16];
#pragma unroll
  for (int r = 0; r < 16; ++r) rli[r] = __builtin_amdgcn_rcpf(li_l[(r & 3) + 8 * (r >> 2) + 4 * hib]);
  __syncthreads();
  LAS float* X = (LAS float*)(lds + g * 16384) + hib * 512 + r32b;
  if (c == 1) {
#pragma unroll
    for (int r = 0; r < 16; ++r)
#pragma unroll
      for (int d0 = 0; d0 < 4; ++d0) X[((r & 3) + 8 * (r >> 2)) * 128 + d0 * 32] = o[d0][r] * (rli[r] * lam);
  }
  __syncthreads();
  if (c == 0) {
    float ss[16];
#pragma unroll
    for (int r = 0; r < 16; ++r) { ss[r] = 0.f;
#pragma unroll
      for (int d0 = 0; d0 < 4; ++d0) { const float v = o[d0][r] * rli[r] - X[((r & 3) + 8 * (r >> 2)) * 128 + d0 * 32]; o[d0][r] = v; ss[r] += v * v; } }
#pragma unroll
    for (int r = 0; r < 16; ++r) {
#pragma unroll
      for (int s = 1; s < 32; s <<= 1) ss[r] += __shfl_xor(ss[r], s);
      ss[r] = rsqrtf(ss[r] * (1.f / 128.f) + EPS) * (1.f - LAMBDA_INIT); }
    float aw[4];
#pragma unroll
    for (int d0 = 0; d0 < 4; ++d0) aw[d0] = anw[d0 * 32 + r32b];
    asm volatile("s_waitcnt lgkmcnt(0)" ::: "memory");
    LAS bf16* Ost = (LAS bf16*)(lds + g * 16384);
    LAS bf16* Ow = Ost + hib * 512 + r32b;
#pragma unroll
    for (int r = 0; r < 16; ++r)
#pragma unroll
      for (int d0 = 0; d0 < 4; ++d0) Ow[((r & 3) + 8 * (r >> 2)) * 128 + d0 * 32] = (bf16)f2bf(o[d0][r] * ss[r] * aw[d0]);
    asm volatile("s_waitcnt lgkmcnt(0)" ::: "memory");
    const int rowb = lane2 >> 4, c16 = lane2 & 15;
    bf16* Ob = MIX + (size_t)(b * SEQ + q0 + 32 * g + rowb) * DM + 512 + h * 128 + c16 * 8;
    const LAS bf16* Os = Ost + rowb * 128 + c16 * 8;
#pragma unroll
    for (int k = 0; k < 8; ++k) *(u32x4*)(Ob + (size_t)k * 4 * DM) = *(const LAS u32x4*)(Os + k * 512);
  }
  __syncthreads();
#undef RESC
}

template <int C, int HALF_> __device__ __forceinline__ void half_scores(f32x16& p, const LAS unsigned char* Ks, const bf16x8 (&qr)[8], const int kaddr) {
  p = f32x16{};
#pragma unroll
  for (int d0 = 0; d0 < 4; ++d0) { const bf16x8 kf = *(const LAS bf16x8*)(Ks + (kaddr ^ (d0 * 32)) + C * 128 + HALF_ * 8192);
    p = __builtin_amdgcn_mfma_f32_32x32x16_bf16(kf, qr[C * 4 + d0], p, 0, 0, 0); }
}
__device__ __forceinline__ void half_softmax(f32x16& p, float& l_reg, bf16x8& pa, bf16x8& pb) {
#pragma unroll
  for (int r = 0; r < 16; ++r) p[r] = __builtin_amdgcn_exp2f(p[r]);
  float ps = 0;
#pragma unroll
  for (int r = 0; r < 16; ++r) ps += p[r];
  l_reg += ps;
#define PK4(P, BASE, OUT) do { unsigned a0 = cvtpk(P[BASE + 0], P[BASE + 1]), a1 = cvtpk(P[BASE + 2], P[BASE + 3]);   \
    unsigned b0 = cvtpk(P[BASE + 4], P[BASE + 5]), b1 = cvtpk(P[BASE + 6], P[BASE + 7]);                              \
    auto r0 = __builtin_amdgcn_permlane32_swap(a0, b0, false, false); auto r1 = __builtin_amdgcn_permlane32_swap(a1, b1, false, false); \
    u32x4 w = {r0[0], r1[0], r0[1], r1[1]}; OUT = __builtin_bit_cast(bf16x8, w); } while (0)
  PK4(p, 0, pa); PK4(p, 8, pb);
#undef PK4
  SBAR();
}
template <int D0, int HALF_> __device__ __forceinline__ void pv_half(f32x16& oa, f32x16& ob, int vb, bf16x8 a0, bf16x8 a1, bf16x8 b0, bf16x8 b1) {
  const s16x4 l0 = tr_read<v_rd_off(D0, 2 * HALF_, 0)>(vb), h0 = tr_read<v_rd_off(D0, 2 * HALF_, 1)>(vb), l1 = tr_read<v_rd_off(D0, 2 * HALF_ + 1, 0)>(vb), h1 = tr_read<v_rd_off(D0, 2 * HALF_ + 1, 1)>(vb);
  asm volatile("s_waitcnt lgkmcnt(0)" ::: "memory"); SBAR();
#define PK(L, H) (bf16x8){L[0], L[1], L[2], L[3], H[0], H[1], H[2], H[3]}
  oa = __builtin_amdgcn_mfma_f32_32x32x16_bf16(a0, PK(l0, h0), oa, 0, 0, 0);
  ob = __builtin_amdgcn_mfma_f32_32x32x16_bf16(b0, PK(l0, h0), ob, 0, 0, 0);
  oa = __builtin_amdgcn_mfma_f32_32x32x16_bf16(a1, PK(l1, h1), oa, 0, 0, 0);
  ob = __builtin_amdgcn_mfma_f32_32x32x16_bf16(b1, PK(l1, h1), ob, 0, 0, 0);
#undef PK
  SBAR();
}
__device__ __forceinline__ void attn2_setup(LAS unsigned char* lds, const int tid) {
  const int wid = __builtin_amdgcn_readfirstlane(tid >> 6), lane = tid & 63;
  unsigned koff[2], voff[2];
#pragma unroll
  for (int p = 0; p < 2; ++p) { const int s = (wid * 2 + p) * 64 + lane, row = s >> 4, ch = (s & 15) ^ (row & 7); koff[p] = (unsigned)(row * NCOL + ch * 8) * 2u;
    const int o = s * 16, sub = o >> 9, within = o & 511, kk = (sub >> 2) * 8 + (within >> 6), k = (kk & ~0xC) | ((kk & 4) << 1) | ((kk & 8) >> 1), cc = (sub & 3) * 32 + ((within & 63) >> 4) * 8;
    voff[p] = (unsigned)(k * NCOL + cc) * 2u; }
  *((LAS u32x4*)(lds + 133120 + wid * 1024) + lane) = (u32x4){koff[0], koff[1], voff[0], voff[1]};
  asm volatile("s_waitcnt lgkmcnt(0)" ::: "memory");
}
__device__ __forceinline__ void attn_unit2(const bf16* __restrict__ PROJ, bf16* __restrict__ MIX, const float* __restrict__ anw, const float lam, const int b, const int h, const int qb,
                                           LAS unsigned char* lds, const int tid) {
  const int wid = __builtin_amdgcn_readfirstlane(tid >> 6), lane = tid & 63, r32 = lane & 31, hi = lane >> 5;
  const int q0 = qb * 256, NT = 4 * qb + 4, jlast = 4 * qb + (wid >> 1);
  int hcol = h * 128; asm volatile("" : "+s"(hcol));
  const char* Kg = (const char*)(PROJ + (size_t)(b * SEQ) * NCOL + C_AK + hcol);
  const char* Vg = (const char*)(PROJ + (size_t)(b * SEQ) * NCOL + C_AV + hcol);
  LAS float* wsf = (LAS float*)(lds + 131072) + wid * 64;
  LAS u32x4* offt = (LAS u32x4*)(lds + 133120 + wid * 1024) + lane;
#define DMA(tile, slot) do { const char* kt_ = Kg + (size_t)(tile) * (64 * NCOL * 2); const char* vt_ = Vg + (size_t)(tile) * (64 * NCOL * 2); LAS unsigned char* sl_ = lds + (slot) * 32768 + wid * 2048; const u32x4 of_ = *offt; \
    __builtin_amdgcn_global_load_lds((const unsigned*)(kt_ + of_.x), (LAS unsigned*)(sl_), 16, 0, 0); __builtin_amdgcn_global_load_lds((const unsigned*)(kt_ + of_.y), (LAS unsigned*)(sl_ + 1024), 16, 0, 0); \
    __builtin_amdgcn_global_load_lds((const unsigned*)(vt_ + of_.z), (LAS unsigned*)(sl_ + 16384), 16, 0, 0); __builtin_amdgcn_global_load_lds((const unsigned*)(vt_ + of_.w), (LAS unsigned*)(sl_ + 16384 + 1024), 16, 0, 0); } while (0)
#define WB4() do { asm volatile("s_waitcnt vmcnt(4)" ::: "memory"); __builtin_amdgcn_s_barrier(); asm volatile("" ::: "memory"); } while (0)
  float l0 = 0.f, l1 = 0.f; f32x16 oa[4] = {}, ob[4] = {}; bf16x8 qr[8];
  { const bf16* Qw = PROJ + (size_t)(b * SEQ + q0 + 32 * wid + r32) * NCOL + C_AQ + hcol + hi * 8;
#pragma unroll
    for (int d = 0; d < 8; ++d) qr[d] = *(const bf16x8*)(Qw + d * 16); }
  const int vb0 = (int)(unsigned)(uintptr_t)lds + 16384 + v_rd_base(lane);
  const int kaddr = r32 * 256 + ((hi * 16) ^ ((r32 & 7) << 4));
  DMA(0, 0); DMA(1, 1);
#pragma unroll 1
  for (int j = 0; j < NT; ++j) {
    WB4();
    DMA((j + 2 < NT ? j + 2 : NT - 1), (j + 2) & 3);
    if (j <= jlast) {
      const LAS unsigned char* Ks = lds + (j & 3) * 32768; const int vb = vb0 + (j & 3) * 32768;
      f32x16 p; bf16x8 a0, a1, b0, b1;
      SBAR(); half_scores<0, 0>(p, Ks, qr, kaddr); half_softmax(p, l0, a0, a1);
      SBAR(); half_scores<1, 0>(p, Ks, qr, kaddr); half_softmax(p, l1, b0, b1); SBAR();
      pv_half<0, 0>(oa[0], ob[0], vb, a0, a1, b0, b1); pv_half<1, 0>(oa[1], ob[1], vb, a0, a1, b0, b1); pv_half<2, 0>(oa[2], ob[2], vb, a0, a1, b0, b1); pv_half<3, 0>(oa[3], ob[3], vb, a0, a1, b0, b1);
      SBAR(); half_scores<0, 1>(p, Ks, qr, kaddr); half_softmax(p, l0, a0, a1);
      SBAR(); half_scores<1, 1>(p, Ks, qr, kaddr); half_softmax(p, l1, b0, b1); SBAR();
      pv_half<0, 1>(oa[0], ob[0], vb, a0, a1, b0, b1); pv_half<1, 1>(oa[1], ob[1], vb, a0, a1, b0, b1); pv_half<2, 1>(oa[2], ob[2], vb, a0, a1, b0, b1); pv_half<3, 1>(oa[3], ob[3], vb, a0, a1, b0, b1);
    }
  }
  l0 += __shfl_xor(l0, 32); l1 += __shfl_xor(l1, 32);
  asm volatile("s_waitcnt vmcnt(0)" ::: "memory");
  if (hi == 0) { wsf[r32] = l0; wsf[32 + r32] = l1; } asm volatile("s_waitcnt lgkmcnt(0)" ::: "memory");
  int lane2 = lane; asm volatile("" : "+v"(lane2));
  const int r32b = lane2 & 31, hib = lane2 >> 5;
  __syncthreads();
  float ss[16];
#pragma unroll
  for (int r = 0; r < 16; ++r) { const int row = (r & 3) + 8 * (r >> 2) + 4 * hib; const float c0 = __builtin_amdgcn_rcpf(wsf[row]), c1 = lam * __builtin_amdgcn_rcpf(wsf[32 + row]); ss[r] = 0.f;
#pragma unroll
    for (int d0 = 0; d0 < 4; ++d0) { const float v = oa[d0][r] * c0 - ob[d0][r] * c1; oa[d0][r] = v; ss[r] += v * v; } }
#pragma unroll
  for (int r = 0; r < 16; ++r) {
#pragma unroll
    for (int s = 1; s < 32; s <<= 1) ss[r] += __shfl_xor(ss[r], s);
    ss[r] = rsqrtf(ss[r] * (1.f / 128.f) + EPS) * (1.f - LAMBDA_INIT); }
  float aw[4];
#pragma unroll
  for (int d0 = 0; d0 < 4; ++d0) aw[d0] = anw[d0 * 32 + r32b];
  LAS bf16* Ost = (LAS bf16*)(lds + wid * 8192);
  LAS bf16* Ow = Ost + hib * 512 + r32b;
#pragma unroll
  for (int r = 0; r < 16; ++r)
#pragma unroll
    for (int d0 = 0; d0 < 4; ++d0) Ow[((r & 3) + 8 * (r >> 2)) * 128 + d0 * 32] = (bf16)f2bf(oa[d0][r] * ss[r] * aw[d0]);
  asm volatile("s_waitcnt lgkmcnt(0)" ::: "memory");
  const int rowb = lane2 >> 4, c16 = lane2 & 15;
  bf16* Ob = MIX + (size_t)(b * SEQ + q0 + 32 * wid + rowb) * DM + 512 + h * 128 + c16 * 8;
  const LAS bf16* Os = Ost + rowb * 128 + c16 * 8;
#pragma unroll
  for (int k = 0; k < 8; ++k) *(u32x4*)(Ob + (size_t)k * 4 * DM) = *(const LAS u32x4*)(Os + k * 512);
  __syncthreads();
#undef DMA
#undef WB4
}
}

template <bool FX>
__device__ __forceinline__ void attn_queue(const bf16* PROJ, bf16* MIX, const float* anw, const float lam, const float nb, unsigned* queue, LAS unsigned char* lds, int tid) {
    LAS unsigned* slot = (LAS unsigned*)(lds + LDSCTL_OFF + 64);
    const int x0 = (int)(xb_xcc_id() & 7u);
    LAS unsigned* peek = (LAS unsigned*)(lds + LDSCTL_OFF + 72);
    if constexpr (FX) att::attn2_setup(lds, tid);
#pragma unroll 1
    for (int k = 0; k < 8; ++k) {
        const int x = (x0 + k) & 7;
        if (k == 1) { if (tid < 8) peek[tid] = __hip_atomic_load(queue + 64 * tid, __ATOMIC_RELAXED, __HIP_MEMORY_SCOPE_AGENT); __syncthreads(); }
        if (k >= 1) { if (peek[x] >= 128u) continue; }
        if (tid == 0) *slot = __hip_atomic_fetch_add(queue + 64 * x, 1u, __ATOMIC_RELAXED, __HIP_MEMORY_SCOPE_AGENT);
        __syncthreads();
        for (;;) {
            const unsigned l = *slot;
            __syncthreads();
            if (l >= 128u) break;
            unsigned nxt = 0u;
            if (tid == 0) nxt = __hip_atomic_fetch_add(queue + 64 * x, 1u, __ATOMIC_RELAXED, __HIP_MEMORY_SCOPE_AGENT);
            const int bh = ((int)l >> 3) * 8 + x, p = (int)l & 7;
            if constexpr (FX) { const int bh2 = ((int)l & 15) * 8 + x, qb2 = 7 - ((int)l >> 4); att::attn_unit2(PROJ, MIX, anw, lam, bh2 >> 2, bh2 & 3, qb2, lds, tid); }
            else {
#pragma unroll 1
                for (int s = 0; s < 2; ++s) att::attn_unit<false>(PROJ, MIX, anw, lam, nb, bh >> 2, bh & 3, s ? p : 15 - p, lds, tid); }
            if (tid == 0) *slot = nxt;
            __syncthreads();
        }
    }
}
__device__ __forceinline__ void p2_fast_attn(const Args& a, LAS unsigned char* lds, int tid, int lane, int wave, int wg, int G, int rep) {
    const float* lq1 = a.in[10]; const float* lk1 = a.in[11]; const float* lq2 = a.in[12]; const float* lk2 = a.in[13];
    const float lam = __expf(wave_sum(lq1[lane] * lk1[lane])) - __expf(wave_sum(lq2[lane] * lk2[lane])) + LAMBDA_INIT;
    const float bound2 = 8.f * 1.4426950408889634f * 1.01f * wave_max(fabsf(a.in[8][lane])) * wave_max(fabsf(a.in[9][lane]));
    const bool fixedmax = bound2 <= 40.f;
    const bf16* PROJ = (const bf16*)(a.ws + WS_PROJ); bf16* MIX = (bf16*)(a.ws + WS_MIX);
    unsigned* queue = (unsigned*)(a.ws + WS_CTL) + CW_QUEUE + 1024 * rep;
    if (fixedmax) attn_queue<true>(PROJ, MIX, a.in[14], lam, -bound2, queue, lds, tid);
    else attn_queue<false>(PROJ, MIX, a.in[14], lam, 0.f, queue, lds, tid);
}

__device__ __forceinline__ void p4_router(const Args& a, LAS unsigned char* lds, int tid, int lane, int wave, int wg, int G) {
    unsigned char* ws = a.ws;
    const float* norm2_w = a.in[16]; const float* w_group = a.in[17]; const float* b_group = a.in[18]; const float* w_expert = a.in[19]; const float* b_expert = a.in[20];
    const float* X1 = a.out; bf16* H2 = (bf16*)(ws + WS_H2);
    int* ASGE = (int*)(ws + WS_ASGE); float* ASGW = (float*)(ws + WS_ASGW); int* CNT = (int*)(ws + WS_CTL) + CW_CNT;
    LAS float* wl = (LAS float*)lds;
    LAS int* hist = (LAS int*)(lds + LDSCTL_OFF + 128);
    for (int idx = tid; idx < 4096; idx += NTHR) { const int k = idx >> 2, c = idx & 3; wl[c * 1024 + k] = w_group[idx]; }
    for (int idx = tid; idx < 32768; idx += NTHR) { const int k = idx >> 5, c = idx & 31; wl[(4 + c) * 1024 + k] = w_expert[idx]; }
    if (tid < 32) hist[tid] = 0;
    __syncthreads();
    f32x4 w2v[4];
#pragma unroll
    for (int j = 0; j < 4; ++j) w2v[j] = ((const f32x4*)norm2_w)[lane + 64 * j];
    const int tpw = T_ / (G * NWAVES);
#pragma unroll 1
    for (int rr = 0; rr < tpw; ++rr) {
        const int t = (wg * NWAVES + wave) * tpw + rr;
        const f32x4* xr = (const f32x4*)(X1 + (size_t)t * DM) + lane;
        f32x4 hv[4]; float ss = 0.f;
#pragma unroll
        for (int j = 0; j < 4; ++j) { hv[j] = xr[64 * j]; ss += (hv[j].x * hv[j].x + hv[j].y * hv[j].y) + (hv[j].z * hv[j].z + hv[j].w * hv[j].w); }
        const float r2 = rsqrtf(wave_sum(ss) * (1.f / DM) + EPS);
        u32x2* o8 = (u32x2*)(H2 + (size_t)t * DM) + lane;
#pragma unroll
        for (int j = 0; j < 4; ++j) { hv[j] = hv[j] * r2 * w2v[j]; u32x2 o; o.x = pk2(hv[j].x, hv[j].y); o.y = pk2(hv[j].z, hv[j].w); o8[64 * j] = o; }
        float lg[36];
#pragma unroll
        for (int c = 0; c < 36; ++c) { float acc = 0.f;
#pragma unroll
            for (int j = 0; j < 4; ++j) { const f32x4 wv = *(const LAS f32x4*)(wl + c * 1024 + 256 * j + 4 * lane); acc += (hv[j].x * wv.x + hv[j].y * wv.y) + (hv[j].z * wv.z + hv[j].w * wv.w); }
            lg[c] = wave_sum(acc); }
        float gl[4];
#pragma unroll
        for (int g = 0; g < 4; ++g) gl[g] = lg[g] + b_group[g];
        int gsel = 0; float gmax = gl[0];
#pragma unroll
        for (int g = 1; g < 4; ++g) if (gl[g] > gmax) { gmax = gl[g]; gsel = g; }
        float gsum = 0.f;
#pragma unroll
        for (int g = 0; g < 4; ++g) gsum += __expf(gl[g] - gmax);
        const float gwt = 1.f / gsum;
        float el[8];
#pragma unroll
        for (int i = 0; i < 8; ++i) el[i] = 0.f;
#pragma unroll
        for (int g = 0; g < 4; ++g) if (gsel == g) {
#pragma unroll
            for (int i = 0; i < 8; ++i) el[i] = lg[4 + 8 * g + i] + b_expert[8 * g + i]; }
        int i1 = 0; float v1 = el[0];
#pragma unroll
        for (int i = 1; i < 8; ++i) if (el[i] > v1) { v1 = el[i]; i1 = i; }
        int i2 = -1; float v2 = -3.0e38f;
#pragma unroll
        for (int i = 0; i < 8; ++i) if (i != i1 && el[i] > v2) { v2 = el[i]; i2 = i; }
        const float p1 = 1.f / (1.f + __expf(v2 - v1)), p2 = 1.f - p1;
        if (lane == 0) {
            const int e1 = gsel * 8 + i1, e2 = gsel * 8 + i2;
            const int r1 = atomicAdd((int*)&hist[e1], 1), r2_ = atomicAdd((int*)&hist[e2], 1);
            ASGE[2 * t] = e1 | (r1 << 8); ASGE[2 * t + 1] = e2 | (r2_ << 8);
            ASGW[2 * t] = gwt * p1; ASGW[2 * t + 1] = gwt * p2;
        }
    }
    __syncthreads();
    if (tid < 32) CNT[wg * 32 + tid] = hist[tid];
}


__device__ __forceinline__ void p4_router_mfma(const Args& a, LAS unsigned char* lds, int tid, int lane, int wave, int wg, int G) {
    unsigned char* ws = a.ws;
    const float* b_group = a.in[18]; const float* b_expert = a.in[20];
    const bf16* X1B = (const bf16*)(ws + WS_H2);
    int* ASGE = (int*)(ws + WS_ASGE); float* ASGW = (float*)(ws + WS_ASGW); int* CNT = (int*)(ws + WS_CTL) + CW_CNT;
    constexpr int WST = 2064, WLO = 36 * WST;
    LAS int* hist = (LAS int*)(lds + LDSCTL_OFF + 128);
    {
        const u32x4* RIMG = (const u32x4*)(ws + WS_RIMG); constexpr int NP = 2 * 36 * WST / 16;
#pragma unroll 1
        for (int base = 0; base < NP; base += 6 * NTHR) {
            u32x4 v[6];
#pragma unroll
            for (int q = 0; q < 6; ++q) { const int i = base + q * NTHR + tid; v[q] = RIMG[i < NP ? i : NP - 1]; }
#pragma unroll
            for (int q = 0; q < 6; ++q) { const int i = base + q * NTHR + tid; if (i < NP) *(LAS u32x4*)(lds + i * 16) = v[q]; }
        }
    }
    if (tid < 32) hist[tid] = 0;
    __syncthreads();
    const int fr = lane & 15, fq = lane >> 4;
    const int t0 = (wg * NWAVES + wave) * 32;
    const bf16* x1a = X1B + (size_t)(t0 + fr) * DM + 8 * fq; const bf16* x1b = x1a + (size_t)16 * DM;
    f32x4 acc[2][3];
#pragma unroll
    for (int tl = 0; tl < 2; ++tl)
#pragma unroll
        for (int nt = 0; nt < 3; ++nt) acc[tl][nt] = (f32x4){0.f, 0.f, 0.f, 0.f};
    float ss0 = 0.f, ss1 = 0.f;
    int wrow[3];
#pragma unroll
    for (int nt = 0; nt < 3; ++nt) { const int c = 16 * nt + fr; wrow[nt] = (c < 36 ? c : 35) * WST + 16 * fq; }
#pragma unroll 1
    for (int kg = 0; kg < 4; ++kg) {
        u32x4 va[8], vb[8];
#pragma unroll
        for (int q = 0; q < 8; ++q) { va[q] = *(const u32x4*)(x1a + 32 * (8 * kg + q)); vb[q] = *(const u32x4*)(x1b + 32 * (8 * kg + q)); }
#pragma unroll
        for (int q = 0; q < 8; ++q) { const int ks = 8 * kg + q; const u32x4 a_ = va[q], b_ = vb[q];
            { const float f0 = bflo(a_.x), f1 = bfhi(a_.x), f2 = bflo(a_.y), f3 = bfhi(a_.y), f4 = bflo(a_.z), f5 = bfhi(a_.z), f6 = bflo(a_.w), f7 = bfhi(a_.w);
              ss0 += (f0 * f0 + f1 * f1) + (f2 * f2 + f3 * f3) + (f4 * f4 + f5 * f5) + (f6 * f6 + f7 * f7); }
            { const float f0 = bflo(b_.x), f1 = bfhi(b_.x), f2 = bflo(b_.y), f3 = bfhi(b_.y), f4 = bflo(b_.z), f5 = bfhi(b_.z), f6 = bflo(b_.w), f7 = bfhi(b_.w);
              ss1 += (f0 * f0 + f1 * f1) + (f2 * f2 + f3 * f3) + (f4 * f4 + f5 * f5) + (f6 * f6 + f7 * f7); }
            const bf16x8 ah[2] = {__builtin_bit_cast(bf16x8, a_), __builtin_bit_cast(bf16x8, b_)};
#pragma unroll
            for (int nt = 0; nt < 3; ++nt) {
                const bf16x8 wh = *(const LAS bf16x8*)(lds + wrow[nt] + ks * 64), wl = *(const LAS bf16x8*)(lds + WLO + wrow[nt] + ks * 64);
#pragma unroll
                for (int tl = 0; tl < 2; ++tl) {
                    acc[tl][nt] = __builtin_amdgcn_mfma_f32_16x16x32_bf16(wh, ah[tl], acc[tl][nt], 0, 0, 0);
                    acc[tl][nt] = __builtin_amdgcn_mfma_f32_16x16x32_bf16(wl, ah[tl], acc[tl][nt], 0, 0, 0); }
            }
        }
    }
    float bg[4], be[32]; int pe_[2][2] = {{0, 0}, {0, 0}}, pr_[2][2] = {{0, 0}, {0, 0}};
#pragma unroll
    for (int g = 0; g < 4; ++g) bg[g] = b_group[g];
#pragma unroll
    for (int i = 0; i < 32; ++i) be[i] = b_expert[i];
#pragma unroll
    for (int tl = 0; tl < 2; ++tl) {
        float ss = tl ? ss1 : ss0; ss += __shfl_xor(ss, 16); ss += __shfl_xor(ss, 32);
        const float r2 = rsqrtf(ss * (1.f / DM) + EPS);
        float lg[36];
#pragma unroll
        for (int nt = 0; nt < 3; ++nt)
#pragma unroll
            for (int q = 0; q < 4; ++q)
#pragma unroll
                for (int j = 0; j < 4; ++j) { const int c = 16 * nt + 4 * q + j; if (c < 36) lg[c] = __shfl(acc[tl][nt][j], fr + 16 * q) * r2; }
        float gl[4];
#pragma unroll
        for (int g = 0; g < 4; ++g) gl[g] = lg[g] + bg[g];
        int gsel = 0; float gmax = gl[0];
#pragma unroll
        for (int g = 1; g < 4; ++g) if (gl[g] > gmax) { gmax = gl[g]; gsel = g; }
        float gsum = 0.f;
#pragma unroll
        for (int g = 0; g < 4; ++g) gsum += __expf(gl[g] - gmax);
        const float gwt = 1.f / gsum;
        float el[8];
#pragma unroll
        for (int i = 0; i < 8; ++i) el[i] = 0.f;
#pragma unroll
        for (int g = 0; g < 4; ++g) if (gsel == g) {
#pragma unroll
            for (int i = 0; i < 8; ++i) el[i] = lg[4 + 8 * g + i] + be[8 * g + i]; }
        int i1 = 0; float v1 = el[0];
#pragma unroll
        for (int i = 1; i < 8; ++i) if (el[i] > v1) { v1 = el[i]; i1 = i; }
        int i2 = -1; float v2 = -3.0e38f;
#pragma unroll
        for (int i = 0; i < 8; ++i) if (i != i1 && el[i] > v2) { v2 = el[i]; i2 = i; }
        const float p1 = 1.f / (1.f + __expf(v2 - v1)), p2 = 1.f - p1;
        if (fq == 0) {
            const int t = t0 + 16 * tl + fr;
            const int e1 = gsel * 8 + i1, e2 = gsel * 8 + i2;
            const int r1 = atomicAdd((int*)&hist[e1], 1), r2_ = atomicAdd((int*)&hist[e2], 1);
            pe_[tl][0] = e1; pe_[tl][1] = e2; pr_[tl][0] = r1; pr_[tl][1] = r2_;
            ASGW[2 * t] = gwt * p1; ASGW[2 * t + 1] = gwt * p2;
            ASGW[2 * T_ + 2 * t] = r2; ASGW[2 * T_ + 2 * t + 1] = r2;
        }
    }
    __syncthreads();
    LAS int* lbase = hist + 32;
    if (tid < 32) lbase[tid] = atomicAdd((int*)(ws + WS_CTL) + CW_CUR + 64 * tid, hist[tid]);
    __syncthreads();
    if (fq == 0) { int* LIST = (int*)(ws + WS_LIST);
#pragma unroll
        for (int tl = 0; tl < 2; ++tl) { const int t = t0 + 16 * tl + fr;
#pragma unroll
            for (int k = 0; k < 2; ++k) { const int e = pe_[tl][k], ii = lbase[e] + pr_[tl][k]; LIST[(size_t)e * LCAP + ii] = 2 * t + k; ASGE[2 * t + k] = e | (ii << 8); } } }
}

__device__ __forceinline__ void p5_dispatch(const Args& a, LAS unsigned char* lds, int tid, int wg, int G) {
    unsigned char* ws = a.ws;
    const int* ASGE = (const int*)(ws + WS_ASGE); const float* ASGW = (const float*)(ws + WS_ASGW); const int* CNT = (const int*)(ws + WS_CTL) + CW_CNT;
    int* META = (int*)(ws + WS_CTL) + CW_META; int* ROWTOK = (int*)(ws + WS_ROWTOK); float* ROWW = (float*)(ws + WS_ROWW); float* ROWR = (float*)(ws + WS_GATES); int* POSA = (int*)(ws + WS_POSA);
    LAS int* tot = (LAS int*)lds; LAS int* pre = tot + 32; LAS int* pst = pre + 32;
    {
        LAS int* part = pst + 64;
        const int e = tid & 31, j = tid >> 5; int total = 0, prefix = 0;
#pragma unroll
        for (int q = 0; q < 16; ++q) { const int w = 16 * j + q; const int c = (w < G) ? CNT[w * 32 + e] : 0; total += c; prefix += (w < wg) ? c : 0; }
        part[j * 32 + e] = total; part[512 + j * 32 + e] = prefix;
        __syncthreads();
        if (tid < 32) { int t2 = 0, p2 = 0;
#pragma unroll
            for (int q = 0; q < 16; ++q) { t2 += part[q * 32 + tid]; p2 += part[512 + q * 32 + tid]; }
            tot[tid] = t2; pre[tid] = p2; }
    }
    __syncthreads();
    if (tid == 0) { int s = 0; for (int e = 0; e < 32; ++e) { pst[e] = s; s += (tot[e] + 255) & ~255; } pst[32] = s; }
    __syncthreads();
    if (wg == 0 && tid <= 32) META[tid] = pst[tid];
    const int apw = 2 * T_ / G;
    for (int q = tid; q < apw; q += NTHR) { const int idx = wg * apw + q; const int ev = ASGE[idx], e = ev & 255, rank = ev >> 8; const int pos = pst[e] + pre[e] + rank; ROWTOK[pos] = idx; ROWW[pos] = ASGW[idx]; ROWR[pos] = ASGW[2 * T_ + idx]; POSA[idx] = pos; }
    if (wg < 32) { const int e = wg; for (int p = pst[e] + tot[e] + tid; p < pst[e + 1]; p += NTHR) { ROWTOK[p] = -1; ROWW[p] = 0.f; ROWR[p] = 0.f; } }
}

__device__ __forceinline__ int expert_of_row(const LAS int* pst, int row) { int e = 0;
#pragma unroll 1
    for (int i = 1; i < 32; ++i) e += (pst[i] <= row) ? 1 : 0;
    return e; }

__device__ __forceinline__ void unpack8(const u32x4 v, float (&f)[8]) { f[0] = bflo(v.x); f[1] = bfhi(v.x); f[2] = bflo(v.y); f[3] = bfhi(v.y); f[4] = bflo(v.z); f[5] = bfhi(v.z); f[6] = bflo(v.w); f[7] = bfhi(v.w); }
__device__ __forceinline__ void p6_naive(const Args& a, LAS unsigned char* lds, int tid, int wg, int G) {
    unsigned char* ws = a.ws;
    const int* META = (const int*)(ws + WS_CTL) + CW_META; const int* ROWTOK = (const int*)(ws + WS_ROWTOK);
    const bf16* H2 = (const bf16*)(ws + WS_H2); const bf16* WGU = (const bf16*)(ws + WS_WGU); bf16* HID = (bf16*)(ws + WS_HID);
    LAS int* pst = (LAS int*)lds;
    if (tid <= 32) pst[tid] = META[tid];
    __syncthreads();
    const int npad = pst[32], ntile = (npad / 64) * 8, rg = tid >> 5, cg = tid & 31;
    for (int tile = wg; tile < ntile; tile += G) {
        const int rt = tile >> 3, ct = tile & 7, e = expert_of_row(pst, rt * 64);
        const bf16* ar[4];
#pragma unroll
        for (int i = 0; i < 4; ++i) { const int tk = ROWTOK[rt * 64 + rg * 4 + i]; ar[i] = H2 + (size_t)(tk < 0 ? 0 : (tk >> 1)) * DM; }
        const int c0 = ct * 64 + cg * 2;
        const bf16* bg[2]; const bf16* bu[2];
#pragma unroll
        for (int j = 0; j < 2; ++j) { const int c = c0 + j; bg[j] = WGU + ((size_t)e * 1024 + (c >> 7) * 256 + (c & 127)) * 1024; bu[j] = bg[j] + 128 * 1024; }
        float g[4][2], u[4][2];
#pragma unroll
        for (int i = 0; i < 4; ++i)
#pragma unroll
            for (int j = 0; j < 2; ++j) { g[i][j] = 0.f; u[i][j] = 0.f; }
#pragma unroll 1
        for (int k = 0; k < 1024; k += 8) {
            float af[4][8], gf[2][8], uf[2][8];
#pragma unroll
            for (int i = 0; i < 4; ++i) unpack8(*(const u32x4*)(ar[i] + k), af[i]);
#pragma unroll
            for (int j = 0; j < 2; ++j) { unpack8(*(const u32x4*)(bg[j] + k), gf[j]); unpack8(*(const u32x4*)(bu[j] + k), uf[j]); }
#pragma unroll
            for (int i = 0; i < 4; ++i)
#pragma unroll
                for (int j = 0; j < 2; ++j)
#pragma unroll
                    for (int q = 0; q < 8; ++q) { g[i][j] += af[i][q] * gf[j][q]; u[i][j] += af[i][q] * uf[j][q]; }
        }
#pragma unroll
        for (int i = 0; i < 4; ++i) *(unsigned*)(HID + (size_t)(rt * 64 + rg * 4 + i) * DEXP + c0) = pk2(siluf_(g[i][0]) * u[i][0], siluf_(g[i][1]) * u[i][1]);
    }
}

__device__ __forceinline__ void p7_naive(const Args& a, LAS unsigned char* lds, int tid, int wg, int G) {
    unsigned char* ws = a.ws;
    const int* META = (const int*)(ws + WS_CTL) + CW_META; const int* ROWTOK = (const int*)(ws + WS_ROWTOK); const float* ROWW = (const float*)(ws + WS_ROWW);
    const bf16* HID = (const bf16*)(ws + WS_HID); const bf16* WD = (const bf16*)(ws + WS_WD); bf16* YBUF = (bf16*)(ws + WS_YBUF);
    LAS int* pst = (LAS int*)lds;
    if (tid <= 32) pst[tid] = META[tid];
    __syncthreads();
    const int npad = pst[32], ntile = (npad / 64) * 8, rg = tid >> 5, cg = tid & 31;
    for (int tile = wg; tile < ntile; tile += G) {
        const int rt = tile >> 3, ct = tile & 7, e = expert_of_row(pst, rt * 64);
        const bf16* ar[4]; const bf16* br[4];
#pragma unroll
        for (int i = 0; i < 4; ++i) ar[i] = HID + (size_t)(rt * 64 + rg * 4 + i) * DEXP;
        const int c0 = ct * 128 + cg * 4;
#pragma unroll
        for (int j = 0; j < 4; ++j) br[j] = WD + ((size_t)e * 1024 + c0 + j) * DEXP;
        float acc[4][4];
#pragma unroll
        for (int i = 0; i < 4; ++i)
#pragma unroll
            for (int j = 0; j < 4; ++j) acc[i][j] = 0.f;
#pragma unroll 1
        for (int k = 0; k < DEXP; k += 8) {
            float af[4][8], bfv[4][8];
#pragma unroll
            for (int i = 0; i < 4; ++i) { unpack8(*(const u32x4*)(ar[i] + k), af[i]); unpack8(*(const u32x4*)(br[i] + k), bfv[i]); }
#pragma unroll
            for (int i = 0; i < 4; ++i)
#pragma unroll
                for (int j = 0; j < 4; ++j)
#pragma unroll
                    for (int q = 0; q < 8; ++q) acc[i][j] += af[i][q] * bfv[j][q];
        }
#pragma unroll
        for (int i = 0; i < 4; ++i) { const int pos = rt * 64 + rg * 4 + i; const int tk = ROWTOK[pos];
            if (tk >= 0) { const float w = ROWW[pos]; const int t = tk >> 1, kk = tk & 1;
                u32x2 o; o.x = pk2(acc[i][0] * w, acc[i][1] * w); o.y = pk2(acc[i][2] * w, acc[i][3] * w);
                *(u32x2*)(YBUF + ((size_t)kk * T_ + t) * DM + c0) = o; } }
    }
}

__device__ __forceinline__ void p8_combine(const Args& a, int tid, int wg, int G) {
    const unsigned char* Y = a.ws + WS_YBUF; const bf16* X1B = (const bf16*)(a.ws + WS_H2); float* O = a.out;
    const int* POSA = (const int*)(a.ws + WS_POSA); const float* ASGW = (const float*)(a.ws + WS_ASGW);
    const int lane = tid & 63, gw = wg * NWAVES + __builtin_amdgcn_readfirstlane(tid >> 6), NGW = G * NWAVES;
    u32x4 xb[2]; u32x2 y0[2], y1[2]; float w0 = 0.f, w1 = 0.f;
#define P8_LOAD(t_) do { const int t__ = __builtin_amdgcn_readfirstlane(t_); const int p0_ = POSA[2 * t__], p1_ = POSA[2 * t__ + 1]; w0 = ASGW[2 * t__]; w1 = ASGW[2 * t__ + 1]; \
        _Pragma("unroll") for (int q = 0; q < 2; ++q) { xb[q] = *(const u32x4*)(X1B + (size_t)t__ * DM + (lane + 64 * q) * 8); y0[q] = *(const u32x2*)(Y + (size_t)p0_ * DM + (lane + 64 * q) * 8); \
            y1[q] = *(const u32x2*)(Y + (size_t)p1_ * DM + (lane + 64 * q) * 8); } } while (0)
#define P8_F8(w_, i_) __builtin_amdgcn_cvt_f32_fp8((int)(w_), (i_))
    P8_LOAD(gw);
#pragma unroll 1
    for (int t = gw; t < T_; t += NGW) {
        u32x4 cx[2]; u32x2 c0[2], c1[2]; const float cw0 = w0, cw1 = w1;
#pragma unroll
        for (int q = 0; q < 2; ++q) { cx[q] = xb[q]; c0[q] = y0[q]; c1[q] = y1[q]; }
        if (t + NGW < T_) P8_LOAD(t + NGW);
#pragma unroll
        for (int q = 0; q < 2; ++q) {
            f32x4 a0, a1;
            a0.x = bflo(cx[q].x) + cw0 * P8_F8(c0[q].x, 0) + cw1 * P8_F8(c1[q].x, 0); a0.y = bfhi(cx[q].x) + cw0 * P8_F8(c0[q].x, 1) + cw1 * P8_F8(c1[q].x, 1);
            a0.z = bflo(cx[q].y) + cw0 * P8_F8(c0[q].x, 2) + cw1 * P8_F8(c1[q].x, 2); a0.w = bfhi(cx[q].y) + cw0 * P8_F8(c0[q].x, 3) + cw1 * P8_F8(c1[q].x, 3);
            a1.x = bflo(cx[q].z) + cw0 * P8_F8(c0[q].y, 0) + cw1 * P8_F8(c1[q].y, 0); a1.y = bfhi(cx[q].z) + cw0 * P8_F8(c0[q].y, 1) + cw1 * P8_F8(c1[q].y, 1);
            a1.z = bflo(cx[q].w) + cw0 * P8_F8(c0[q].y, 2) + cw1 * P8_F8(c1[q].y, 2); a1.w = bfhi(cx[q].w) + cw0 * P8_F8(c0[q].y, 3) + cw1 * P8_F8(c1[q].y, 3);
            float* op = O + (size_t)t * DM + (lane + 64 * q) * 8;
            *(f32x4*)op = a0; *(f32x4*)(op + 4) = a1;
        }
    }
#undef P8_LOAD
#undef P8_F8
}

#ifndef STAGGER_P1
#define STAGGER_P1 700
#endif
#ifndef STAGGER_P6
#define STAGGER_P6 0
#endif
#ifndef STAGGER_P7
#define STAGGER_P7 0
#endif
__device__ __forceinline__ void phase_stagger(unsigned ticks) {
    const unsigned g = blockIdx.x & 3u;
    if (g != 0u && ticks != 0u) { const unsigned long long t0 = __builtin_amdgcn_s_memrealtime(); while (__builtin_amdgcn_s_memrealtime() - t0 < (unsigned long long)(g * ticks)) __builtin_amdgcn_s_sleep(16); }
}

__device__ __forceinline__ void p6_gemm(const Args& a, LAS unsigned char* lds, int tid, int wg, int G) {
    unsigned char* ws = a.ws;
    LAS int* pst = (LAS int*)(lds + 131072); LAS int* tot = pst + 64;
    if (tid < 32) tot[tid] = ((const int*)(ws + WS_CTL) + CW_CUR)[64 * tid];
    __syncthreads();
    if (tid == 0) { int s_ = 0; for (int e = 0; e < 32; ++e) { pst[e] = s_; s_ += (tot[e] + 255) & ~255; } pst[32] = s_; }
    __syncthreads();
    {
        const int* ASGE = (const int*)(ws + WS_ASGE); int* POSA = (int*)(ws + WS_POSA); const int idx = wg * (2 * T_ / G) + tid;
        if (tid < 2 * T_ / G) { const int ev = ASGE[idx]; POSA[idx] = pst[ev & 255] + (ev >> 8); }
    }
    pg8::MoeGuSched S; S.o.init(pst[32] / 256, 4, G, wg); S.A = (const char*)(ws + WS_X1F); S.Bt = (const char*)(ws + WS_WGU); S.rowtok = (const int*)(ws + WS_ROWTOK); S.pst = pst; S.K = DM / 2;
    LAS int* ltok = (LAS int*)(lds + 131584); LAS float* lrowr = (LAS float*)(lds + 131584 + 9 * 256 * 4);
    {
        const int* LIST = (const int*)(ws + WS_LIST); const float* R2 = (const float*)(ws + WS_ASGW) + 2 * T_;
        int tv[9]; float rv[9]; bool ok[9];
#pragma unroll
        for (int i = 0; i < 9; ++i) { int pm, pn; ok[i] = S.o.map(i, pm, pn); tv[i] = -1; rv[i] = 0.f;
            if (ok[i] && tid < 256) { const int e = pg8::expert_of_row_l(pst, pm * 256), ii = pm * 256 + tid - pst[e]; if (ii < tot[e]) tv[i] = LIST[(size_t)e * LCAP + ii]; } }
#pragma unroll
        for (int i = 0; i < 9; ++i) if (tv[i] >= 0) rv[i] = R2[tv[i]];
#pragma unroll
        for (int i = 0; i < 9; ++i) if (ok[i] && tid < 256) { ltok[i * 256 + tid] = tv[i]; lrowr[i * 256 + tid] = rv[i]; }
        __syncthreads();
    }
    S.ltok = ltok;
    pg8::EpiSwiglu E{(bf16*)(ws + WS_HID), lrowr};
    phase_stagger(STAGGER_P6);
    pg8::gemm_phase<pg8::EpiSwiglu, pg8::MoeGuSched, true, true>(lds, DM / 2, S, E);
}
__device__ __forceinline__ void p7_gemm(const Args& a, LAS unsigned char* lds, int tid, int wg, int G) {
    unsigned char* ws = a.ws;
    LAS int* pst = (LAS int*)(lds + 131072); LAS int* tot = pst + 64;
    if (tid < 32) tot[tid] = ((const int*)(ws + WS_CTL) + CW_CUR)[64 * tid];
    __syncthreads();
    if (tid == 0) { int s_ = 0; for (int e = 0; e < 32; ++e) { pst[e] = s_; s_ += (tot[e] + 255) & ~255; } pst[32] = s_; }
    __syncthreads();
    pg8::MoeDownSched S; S.o.init(pst[32] / 256, 4, G, wg); S.A = (const char*)(ws + WS_HID); S.Bt = (const char*)(ws + WS_WD); S.pst = pst; S.K = DEXP / 2;
    pg8::EpiF8 E{ws + WS_YBUF, DM};
    phase_stagger(STAGGER_P7);
    pg8::gemm_phase<pg8::EpiF8, pg8::MoeDownSched, true, true>(lds, DEXP / 2, S, E);
}

__global__ void __launch_bounds__(NTHR, 2) fwd(Args args) {
    extern __shared__ __attribute__((aligned(16))) unsigned char lds_raw[];
    LAS unsigned char* lds = (LAS unsigned char*)lds_raw;
    const int tid0 = threadIdx.x, wg = blockIdx.x, G = gridDim.x;
#define PH_TID() int tid = threadIdx.x; asm volatile("" : "+v"(tid)); const int lane = tid & 63, wave = __builtin_amdgcn_readfirstlane(tid >> 6); (void)lane; (void)wave
    unsigned char* ws = args.ws;
    unsigned* ctl = (unsigned*)(ws + WS_CTL);
    for (int u = tid0; u < 256; u += NTHR) ((LAS unsigned*)(lds + LDSCTL_OFF))[u] = 0u;
    __syncthreads();
    const int lo = args.ph_lo, hi = args.ph_hi;
    XcdBarrier bar = xcd_barrier_post(ctl + CW_BAR, (volatile LAS unsigned*)(lds + LDSCTL_OFF));
#define IN(k) (lo <= (k) && (k) < hi)
#ifndef PROBE_PHASE
#define PROBE_PHASE -1
#endif
#define REPS(k) ((PROBE_PHASE == (k)) ? 2 : 1)
#define REPSEP(k) do { if (rep + 1 < REPS(k)) xcd_barrier(bar); } while (0)
#define SEAM(k) do { if (IN(k) && IN((k) + 1)) xcd_barrier(bar); } while (0)

    if (IN(0)) { for (int rep = 0; rep < REPS(0); ++rep) { PH_TID(); p0_prologue(args, lds, tid, lane, wave, wg, G);  REPSEP(0); } }
    SEAM(0);
    if (IN(1)) { for (int rep = 0; rep < REPS(1); ++rep) {
        pg8::DenseSched S; S.o.init(T_ / 256, NCOL / 256, G, wg); S.A = (const char*)(ws + WS_H1); S.Bt = (const char*)(ws + WS_W1T); S.K = DM;
        LAS float* lrs = (LAS float*)(lds + 131584);
        { PH_TID(); const float* R1 = (const float*)(ws + WS_R1);
#pragma unroll 1
          for (int i = 0; i < 14; ++i) { int pm, pn; if (S.o.map(i, pm, pn) && tid < 256) lrs[i * 256 + tid] = R1[pm * 256 + tid]; } }
        pg8::EpiProj E{(bf16*)(ws + WS_PROJ), NCOL, args.in[8], args.in[9], lrs};
        { PH_TID(); p1_stagger_work(args, lds, lane, wave, wg); }
        asm volatile("s_waitcnt vmcnt(0) lgkmcnt(0)" ::: "memory"); __syncthreads();
        pg8::gemm_phase<pg8::EpiProj, pg8::DenseSched, true>(lds, DM, S, E);
     REPSEP(1); } }
    SEAM(1);
    if (IN(2)) { for (int rep = 0; rep < REPS(2); ++rep) { { PH_TID(); if (wg < NBATCH * 4 || PROBE_PHASE == 23) { ml::mlstm_item(args, lds, wg & 127, tid); } } __syncthreads(); { PH_TID(); p2_fast_attn(args, lds, tid, lane, wave, wg, G, rep); if (PROBE_PHASE == 21) { __syncthreads(); p2_fast_attn(args, lds, tid, lane, wave, wg, G, 1); } }  REPSEP(2); } }
    SEAM(2);
    if (IN(3)) { for (int rep = 0; rep < REPS(3); ++rep) {
        pg8::DenseSched S; S.o.init(T_ / 256, DM / 256, G, wg); S.A = (const char*)(ws + WS_MIX); S.Bt = (const char*)(ws + WS_W2T); S.K = DM;
        pg8::EpiX1 E{(const bf16*)(ws + WS_H1), (bf16*)(ws + WS_H2), ws + WS_X1F, DM};
        pg8::gemm_phase<pg8::EpiX1, pg8::DenseSched, true>(lds, DM, S, E);
     REPSEP(3); } }
    SEAM(3);
    if (IN(4)) { for (int rep = 0; rep < REPS(4); ++rep) { PH_TID(); p4_router_mfma(args, lds, tid, lane, wave, wg, G);  REPSEP(4); } }
    SEAM(4);
    if (IN(6)) { for (int rep = 0; rep < REPS(6); ++rep) { PH_TID(); p6_gemm(args, lds, tid, wg, G);  REPSEP(6); } }
    SEAM(6);
    if (IN(7)) { for (int rep = 0; rep < REPS(7); ++rep) { PH_TID(); p7_gemm(args, lds, tid, wg, G);  REPSEP(7); } }
    SEAM(7);
    if (IN(8)) { PH_TID(); p8_combine(args, tid, wg, G); }
#undef IN
#undef SEAM
}

#ifndef MK_N_LAUNCHES
#define MK_N_LAUNCHES 1
#endif
extern "C" void kernel_launch(void* const* d_in, const int* in_sizes, int n_in, void* d_out, int out_size, void* d_ws, size_t ws_size, hipStream_t stream) {
    static int grid = 0;
    if (grid == 0) {
        if (n_in != 24 || in_sizes[0] != T_ * DM || out_size != T_ * DM || ws_size < WS_END) { fprintf(stderr, "kernel_launch: unexpected shapes (n_in %d, in0 %d, out %d, ws %zu); nothing launched\n", n_in, n_in > 0 ? in_sizes[0] : -1, out_size, ws_size); grid = -1; return; }
        int dev = 0, cus = 0, per_cu = 0;
        if (hipGetDevice(&dev) != hipSuccess || hipDeviceGetAttribute(&cus, hipDeviceAttributeMultiprocessorCount, dev) != hipSuccess) { grid = -1; return; }
        if (hipFuncSetAttribute((const void*)fwd, hipFuncAttributeMaxDynamicSharedMemorySize, LDS_BYTES) != hipSuccess) { fprintf(stderr, "kernel_launch: hipFuncSetAttribute failed\n"); grid = -1; return; }
        if (hipOccupancyMaxActiveBlocksPerMultiprocessor(&per_cu, (const void*)fwd, NTHR, LDS_BYTES) != hipSuccess || per_cu < 1) fprintf(stderr, "kernel_launch: occupancy query reports %d\n", per_cu);
        (void)hipGetLastError();
        grid = cus;
        if (grid != 256) { fprintf(stderr, "kernel_launch: built for 256 CUs, found %d; nothing launched\n", cus); grid = -1; return; }
    }
    if (grid < 0) return;
    if (hipMemsetAsync((char*)d_ws + WS_CTL, 0, CTL_ZERO_BYTES, stream) != hipSuccess) return;
    Args a{};
    for (int i = 0; i < 24; ++i) a.in[i] = (const float*)d_in[i];
    a.out = (float*)d_out; a.ws = (unsigned char*)d_ws;
    if (MK_N_LAUNCHES == 1) { a.ph_lo = 0; a.ph_hi = 9; hipLaunchKernelGGL(fwd, dim3(grid), dim3(NTHR), LDS_BYTES, stream, a); }
    else { for (int p = 0; p < 9; ++p) { a.ph_lo = p; a.ph_hi = p + 1; hipLaunchKernelGGL(fwd, dim3(grid), dim3(NTHR), LDS_BYTES, stream, a); } }
    const hipError_t le = hipPeekAtLastError();
    if (le != hipSuccess) fprintf(stderr, "kernel_launch: launch failed: %s\n", hipGetErrorName(le));
}
```

```cpp
#include <hip/hip_runtime.h>
#include <cstdio>
#include <cstdint>

#define GAS __attribute__((address_space(1)))
#define LAS __attribute__((address_space(3)))
typedef unsigned short bf16;
typedef unsigned u32x4 __attribute__((ext_vector_type(4)));
typedef unsigned u32x2 __attribute__((ext_vector_type(2)));
typedef float f32x4 __attribute__((ext_vector_type(4)));
typedef float f32x2 __attribute__((ext_vector_type(2)));
typedef short bf16x8 __attribute__((ext_vector_type(8)));

constexpr int T_ = 65536, DM = 1024, SEQ = 2048, NBATCH = 32, NCOL = 3584, INCOLS = 3592;
constexpr int C_MQ = 0, C_MK = 512, C_MV = 1024, C_MO = 1536, C_AQ = 2048, C_AK = 2560, C_AV = 3072;
constexpr int NEXP = 32, DEXP = 512, PMAX = 131072 + NEXP * 256;
constexpr float EPS = 1e-6f;
constexpr float LAMBDA_INIT = 0.2f;
constexpr int NWAVES = 8, NTHR = 512;

constexpr size_t MiB = 1u << 20;
constexpr size_t WS_CTL = 0, CTL_ZERO_BYTES = 64 * 1024;
constexpr size_t WS_W1T = 1 * MiB, WS_W2T = 8 * MiB, WS_WGU = 10 * MiB, WS_WD = 74 * MiB, WS_GATES = 106 * MiB;
constexpr size_t WS_ASGE = 108 * MiB, WS_ASGW = 109 * MiB, WS_ROWTOK = 110 * MiB, WS_ROWW = 111 * MiB;
constexpr size_t WS_H1 = 112 * MiB, WS_MIX = 240 * MiB, WS_PROJ = 368 * MiB, WS_END = 816 * MiB;
constexpr size_t WS_YBUF = 112 * MiB;
constexpr size_t WS_H2 = 384 * MiB, WS_HID = 512 * MiB;
constexpr size_t WS_MO = 112 * MiB;
constexpr size_t WS_X1F = 584 * MiB;
constexpr size_t WS_RIMG = 111 * MiB + 768 * 1024;
constexpr size_t WS_POSA = 108 * MiB + 512 * 1024;
constexpr int CW_BAR = 4096, CW_QUEUE = 8192, CW_CNT = 16384, CW_META = 32768;
constexpr size_t WS_R1 = 100 * MiB;
constexpr int CW_CUR = 12288;
constexpr size_t WS_LIST = 700 * MiB; constexpr int LCAP = 2 * 65536;

constexpr int LDS_SCRATCH = 155648;
constexpr int LDSCTL_OFF = LDS_SCRATCH;
constexpr int LDS_BYTES = LDS_SCRATCH + 1024;

__device__ __forceinline__ unsigned f2bf(float f) { unsigned u = __builtin_bit_cast(unsigned, f); return (u + 0x7fffu + ((u >> 16) & 1u)) >> 16; }
__device__ __forceinline__ unsigned pk2(float lo, float hi) { return f2bf(lo) | (f2bf(hi) << 16); }
__device__ __forceinline__ float bf2f(bf16 v) { return __uint_as_float(((unsigned)v) << 16); }
__device__ __forceinline__ float bflo(unsigned u) { return __uint_as_float(u << 16); }
__device__ __forceinline__ float bfhi(unsigned u) { return __uint_as_float(u & 0xffff0000u); }
__device__ __forceinline__ float wave_sum(float v) {
#pragma unroll
    for (int o = 1; o < 64; o <<= 1) v += __shfl_xor(v, o);
    return v;
}
__device__ __forceinline__ float wave_max(float v) {
#pragma unroll
    for (int o = 1; o < 64; o <<= 1) v = fmaxf(v, __shfl_xor(v, o));
    return v;
}
__device__ __forceinline__ float sigmoidf_(float x) { return 1.f / (1.f + __expf(-x)); }
__device__ __forceinline__ float siluf_(float x) { return x / (1.f + __expf(-x)); }
__device__ __forceinline__ unsigned pk4_fp8(float a, float b, float c, float d) { int w = 0; w = __builtin_amdgcn_cvt_pk_fp8_f32(a, b, w, false); w = __builtin_amdgcn_cvt_pk_fp8_f32(c, d, w, true); return (unsigned)w; }
#define LDS_WAIT() asm volatile("s_waitcnt lgkmcnt(0)" ::: "memory")
#define VM_WAIT() asm volatile("s_waitcnt vmcnt(0)" ::: "memory")

namespace pg8 {
#define PG8_LAS __attribute__((address_space(3)))
constexpr int BM = 256, BK = 64, HALF = 128, HTB = HALF * BK * 2, STAGE_BYTES = 8 * HTB, NXCD = 8, WGM = 8;
__host__ __device__ __forceinline__ int lds_byte(int r, int c) { const int st = (r >> 4) * 2 + (c >> 5), rr = r & 15, cc = c & 31, ob = rr * 64 + cc * 2; return st * 1024 + (ob ^ (((ob >> 9) & 1) << 5)); }
__host__ __device__ __forceinline__ void stage_rc(int b, int& R, int& C) { const int st = b / 1024, sb = b % 1024, swz = sb ^ (((sb >> 9) & 1) << 5); R = (st >> 1) * 16 + swz / 64; C = (st & 1) * 32 + (swz % 64) / 2; }
__host__ __device__ __forceinline__ int perm32(int rho) { const int n = rho >> 4, i = rho & 15; return 8 * (i >> 2) + 4 * n + (i & 3); }
__host__ __device__ __forceinline__ int perm32g(int rho) { const int n = rho >> 4, i = rho & 15, q = i >> 2; return 8 * (((q & 1) << 1) | (q >> 1)) + 4 * n + (i & 3); }

struct Unit { int pm, pn, e, li; };
struct TileOrder {
    int nM, nN, nwg, G, c;
    __device__ __forceinline__ void init(int nM_, int nN_, int G_, int c_) { nM = nM_; nN = nN_; nwg = nM * nN; G = G_; c = c_; }
    __device__ __forceinline__ bool map(int i, int& pm, int& pn) const {
        const int L = i * G + c, xcd = L % NXCD, off = L / NXCD;
        const int ngr = (nM + WGM - 1) / WGM, g0 = (ngr * xcd) / NXCD, g1 = (ngr * (xcd + 1)) / NXCD, nig = WGM * nN;
        const int gid = g0 + off / nig; if (gid >= g1) return false;
        const int fm = gid * WGM, gsz = (nM - fm) < WGM ? (nM - fm) : WGM, j = off % nig; if (j >= gsz * nN) return false;
        pm = fm + (j % gsz); pn = j / gsz; return true;
    }
};
struct DenseSched {
    static constexpr bool GATHER = false;
    TileOrder o; const char* A; const char* Bt; int K;
    __device__ __forceinline__ bool next(int i, Unit& u) const { u.e = 0; u.li = i; return o.map(i, u.pm, u.pn); }
    __device__ __forceinline__ const char* a_base(const Unit& u) const { return A + (size_t)u.pm * BM * K * 2; }
    __device__ __forceinline__ const char* b_base(const Unit& u) const { return Bt + (size_t)u.pn * BM * K * 2; }
    __device__ __forceinline__ void a_voff(const Unit&, const int (&R)[2], const int (&C)[2], unsigned (&v)[2][2]) const {
#pragma unroll
        for (int h = 0; h < 2; ++h)
#pragma unroll
            for (int i = 0; i < 2; ++i) v[h][i] = (unsigned)((h * HALF + R[i]) * K + C[i]) * 2u;
    }
};

__device__ __forceinline__ unsigned cvt_pk_bf16(float lo, float hi) { unsigned r; asm volatile("v_cvt_pk_bf16_f32 %0, %1, %2" : "=v"(r) : "v"(lo), "v"(hi)); return r; }

struct EpiBf16 {
    static constexpr int PERM = 1;
    bf16* O; int ldc;
    __device__ __forceinline__ void operator()(const f32x4 (&acc)[2][2][4][2], const Unit& u, int wr, int wc, int fr, int fq) const {
        const int row0 = u.pm * BM + wr * 64 + fr, col0 = u.pn * BM + wc * 32 + 8 * fq;
#pragma unroll
        for (int ai = 0; ai < 2; ++ai)
#pragma unroll
            for (int m = 0; m < 4; ++m) { bf16* rowp = O + (size_t)(row0 + ai * HALF + m * 16) * ldc + col0;
#pragma unroll
                for (int bj = 0; bj < 2; ++bj) { const f32x4 v0 = acc[ai][bj][m][0], v1 = acc[ai][bj][m][1];
                    u32x4 w; w.x = cvt_pk_bf16(v0[0], v0[1]); w.y = cvt_pk_bf16(v0[2], v0[3]); w.z = cvt_pk_bf16(v1[0], v1[1]); w.w = cvt_pk_bf16(v1[2], v1[3]);
                    *(u32x4*)(rowp + bj * HALF) = w; } }
    }
};
struct EpiF8 {
    static constexpr int PERM = 2;
    unsigned char* O; int ldc;
    __device__ __forceinline__ void operator()(const f32x4 (&acc)[2][2][4][2], const Unit& u, int wr, int wc, int fr, int fq) const {
        const int row0 = u.pm * BM + wr * 64 + fr + 16 * (fq >> 1), col0 = u.pn * BM + wc * 32 + 16 * (fq & 1);
#pragma unroll
        for (int ai = 0; ai < 2; ++ai)
#pragma unroll
            for (int p = 0; p < 2; ++p) { unsigned char* rowp = O + (size_t)(row0 + ai * HALF + p * 32) * ldc + col0;
#pragma unroll
                for (int bj = 0; bj < 2; ++bj) { const f32x4 x0 = acc[ai][bj][2 * p][0], x1 = acc[ai][bj][2 * p][1], y0 = acc[ai][bj][2 * p + 1][0], y1 = acc[ai][bj][2 * p + 1][1];
                    const unsigned xa = pk4_fp8(x0[0], x0[1], x0[2], x0[3]), xb = pk4_fp8(x1[0], x1[1], x1[2], x1[3]), ya = pk4_fp8(y0[0], y0[1], y0[2], y0[3]), yb = pk4_fp8(y1[0], y1[1], y1[2], y1[3]);
                    auto ra = __builtin_amdgcn_permlane32_swap(xa, ya, false, false); auto rb = __builtin_amdgcn_permlane32_swap(xb, yb, false, false);
                    u32x4 w = {ra[0], rb[0], ra[1], rb[1]};
                    *(u32x4*)(rowp + bj * HALF) = w; } }
    }
};
struct EpiProj {
    static constexpr int PERM = 1;
    bf16* O; int ldc; const float* qw; const float* kw; const PG8_LAS float* rs;
    __device__ __forceinline__ void operator()(const f32x4 (&acc)[2][2][4][2], const Unit& u, int wr, int wc, int fr, int fq) const {
        const int row0 = u.pm * BM + wr * 64 + fr;
        if (u.pn >= 8 && u.pn < 12) {
            const float* wsrc = (u.pn < 10) ? qw : kw; const float post = (u.pn < 10) ? 0.18033688011112042f : 1.0f;
            f32x4 wv[2][2];
#pragma unroll
            for (int bj = 0; bj < 2; ++bj)
#pragma unroll
                for (int n = 0; n < 2; ++n) wv[bj][n] = *(const f32x4*)(wsrc + 32 * bj + 8 * fq + 4 * n) * post;
            const int col0 = u.pn * BM + wc * 64 + 8 * fq;
#pragma unroll
            for (int ai = 0; ai < 2; ++ai)
#pragma unroll
                for (int m = 0; m < 4; ++m) {
                    float ss = 0.f;
#pragma unroll
                    for (int bj = 0; bj < 2; ++bj)
#pragma unroll
                        for (int n = 0; n < 2; ++n) { const f32x4 x = acc[ai][bj][m][n]; ss += (x[0] * x[0] + x[1] * x[1]) + (x[2] * x[2] + x[3] * x[3]); }
                    ss += __shfl_xor(ss, 16); ss += __shfl_xor(ss, 32);
                    const float r1 = rs[u.li * BM + wr * 64 + fr + ai * HALF + m * 16];
                    const float r = rsqrtf(ss * (r1 * r1) * (1.f / 64.f) + 1e-6f) * r1;
                    bf16* rowp = O + (size_t)(row0 + ai * HALF + m * 16) * ldc + col0;
#pragma unroll
                    for (int bj = 0; bj < 2; ++bj) { const f32x4 v0 = acc[ai][bj][m][0] * r * wv[bj][0], v1 = acc[ai][bj][m][1] * r * wv[bj][1];
                        u32x4 w; w.x = cvt_pk_bf16(v0[0], v0[1]); w.y = cvt_pk_bf16(v0[2], v0[3]); w.z = cvt_pk_bf16(v1[0], v1[1]); w.w = cvt_pk_bf16(v1[2], v1[3]);
                        __builtin_nontemporal_store(w, (u32x4*)(rowp + bj * 32)); } }
        } else {
            const int col0 = u.pn * BM + wc * 64 + 8 * fq; const bool sig = (u.pn == 6 || u.pn == 7);
#pragma unroll
            for (int ai = 0; ai < 2; ++ai)
#pragma unroll
                for (int m = 0; m < 4; ++m) { bf16* rowp = O + (size_t)(row0 + ai * HALF + m * 16) * ldc + col0; const float r1 = rs[u.li * BM + wr * 64 + fr + ai * HALF + m * 16];
#pragma unroll
                    for (int bj = 0; bj < 2; ++bj) { f32x4 v0 = acc[ai][bj][m][0] * r1, v1 = acc[ai][bj][m][1] * r1;
                        if (sig) {
#pragma unroll
                            for (int j = 0; j < 4; ++j) { v0[j] = __builtin_amdgcn_rcpf(1.f + __builtin_amdgcn_exp2f(v0[j] * -1.4426950408889634f)); v1[j] = __builtin_amdgcn_rcpf(1.f + __builtin_amdgcn_exp2f(v1[j] * -1.4426950408889634f)); } }
                        u32x4 w; w.x = cvt_pk_bf16(v0[0], v0[1]); w.y = cvt_pk_bf16(v0[2], v0[3]); w.z = cvt_pk_bf16(v1[0], v1[1]); w.w = cvt_pk_bf16(v1[2], v1[3]);
                        __builtin_nontemporal_store(w, (u32x4*)(rowp + bj * 32)); } }
        }
    }
};
struct EpiX1 {
    static constexpr int PERM = 2;
    const bf16* X; bf16* OB; unsigned char* OF; int ldc;
    __device__ __forceinline__ void operator()(const f32x4 (&acc)[2][2][4][2], const Unit& u, int wr, int wc, int fr, int fq) const {
        const int g8 = 8 * (((fq & 1) << 1) | (fq >> 1));
        const int row0 = u.pm * BM + wr * 64 + fr, col0 = u.pn * BM + wc * 32 + g8, colf = u.pn * BM + wc * 32 + 16 * (fq & 1), rsel = 16 * (fq >> 1);
        u32x4 xv[2][4][2];
#pragma unroll
        for (int ai = 0; ai < 2; ++ai)
#pragma unroll
            for (int m = 0; m < 4; ++m) { const size_t off = (size_t)(row0 + ai * HALF + m * 16) * ldc + col0;
#pragma unroll
                for (int bj = 0; bj < 2; ++bj) xv[ai][m][bj] = __builtin_nontemporal_load((const u32x4*)(X + off + bj * HALF)); }
#pragma unroll
        for (int ai = 0; ai < 2; ++ai)
#pragma unroll
            for (int p = 0; p < 2; ++p)
#pragma unroll
                for (int bj = 0; bj < 2; ++bj) { unsigned fa[2], fb[2];
#pragma unroll
                    for (int mm = 0; mm < 2; ++mm) { const int m = 2 * p + mm; const size_t off = (size_t)(row0 + ai * HALF + m * 16) * ldc + col0; const u32x4 xx = xv[ai][m][bj];
                        const f32x4 r0 = (f32x4){bflo(xx.x), bfhi(xx.x), bflo(xx.y), bfhi(xx.y)} + acc[ai][bj][m][0], r1 = (f32x4){bflo(xx.z), bfhi(xx.z), bflo(xx.w), bfhi(xx.w)} + acc[ai][bj][m][1];
                        u32x4 w; w.x = cvt_pk_bf16(r0[0], r0[1]); w.y = cvt_pk_bf16(r0[2], r0[3]); w.z = cvt_pk_bf16(r1[0], r1[1]); w.w = cvt_pk_bf16(r1[2], r1[3]);
                        *(u32x4*)(OB + off + bj * HALF) = w;
                        fa[mm] = pk4_fp8(r0[0], r0[1], r0[2], r0[3]); fb[mm] = pk4_fp8(r1[0], r1[1], r1[2], r1[3]); }
                    auto ra = __builtin_amdgcn_permlane32_swap(fa[0], fa[1], false, false); auto rb = __builtin_amdgcn_permlane32_swap(fb[0], fb[1], false, false);
                    u32x4 f = {ra[0], rb[0], ra[1], rb[1]};
                    *(u32x4*)(OF + (size_t)(row0 + rsel + ai * HALF + p * 32) * ldc + colf + bj * HALF) = f; }
    }
};
struct EpiResF32 {
    static constexpr int PERM = 1;
    const float* X; float* O; int ldc; bf16* OB;
    __device__ __forceinline__ void operator()(const f32x4 (&acc)[2][2][4][2], const Unit& u, int wr, int wc, int fr, int fq) const {
        const int row0 = u.pm * BM + wr * 64 + fr, col0 = u.pn * BM + wc * 32 + 8 * fq;
#pragma unroll
        for (int ai = 0; ai < 2; ++ai) {
            f32x4 xv[4][2][2];
#pragma unroll
            for (int m = 0; m < 4; ++m) { const size_t off = (size_t)(row0 + ai * HALF + m * 16) * ldc + col0;
#pragma unroll
                for (int bj = 0; bj < 2; ++bj) { xv[m][bj][0] = *(const f32x4*)(X + off + bj * HALF); xv[m][bj][1] = *(const f32x4*)(X + off + bj * HALF + 4); } }
#pragma unroll
            for (int m = 0; m < 4; ++m) { const size_t off = (size_t)(row0 + ai * HALF + m * 16) * ldc + col0;
#pragma unroll
                for (int bj = 0; bj < 2; ++bj) {
                    const f32x4 r0 = xv[m][bj][0] + acc[ai][bj][m][0], r1 = xv[m][bj][1] + acc[ai][bj][m][1];
                    *(f32x4*)(O + off + bj * HALF) = r0; *(f32x4*)(O + off + bj * HALF + 4) = r1;
                    u32x4 w; w.x = cvt_pk_bf16(r0[0], r0[1]); w.y = cvt_pk_bf16(r0[2], r0[3]); w.z = cvt_pk_bf16(r1[0], r1[1]); w.w = cvt_pk_bf16(r1[2], r1[3]);
                    *(u32x4*)(OB + off + bj * HALF) = w; } }
            asm volatile("" ::: "memory");
        }
    }
};

__device__ __forceinline__ int expert_of_row_l(const PG8_LAS int* pst, int row) {
    const int lane = (int)__builtin_amdgcn_mbcnt_hi(~0u, __builtin_amdgcn_mbcnt_lo(~0u, 0u));
    const bool hit = (lane >= 1 && lane < 32) ? (pst[lane & 31] <= row) : false;
    return __builtin_popcountll(__ballot(hit)); }
struct MoeGuSched {
    static constexpr bool GATHER = true;
    TileOrder o; const char* A; const char* Bt; const int* rowtok; const PG8_LAS int* pst; int K; const PG8_LAS int* ltok;
    __device__ __forceinline__ bool next(int i, Unit& u) const { u.li = i; if (!o.map(i, u.pm, u.pn)) return false; u.e = expert_of_row_l(pst, u.pm * BM); return true; }
    __device__ __forceinline__ const char* a_base(const Unit&) const { return A; }
    __device__ __forceinline__ const char* b_base(const Unit& u) const { return Bt + ((size_t)u.e * 1024 + (size_t)u.pn * BM) * K * 2; }
    __device__ __forceinline__ void a_voff(const Unit& u, const int (&R)[2], const int (&C)[2], unsigned (&v)[2][2]) const {
#pragma unroll
        for (int h = 0; h < 2; ++h)
#pragma unroll
            for (int i = 0; i < 2; ++i) { const int tk = ltok[u.li * BM + h * HALF + R[i]]; const unsigned tok = tk < 0 ? 0u : (unsigned)(tk >> 1); v[h][i] = (tok * (unsigned)K + (unsigned)C[i]) * 2u; }
    }
};
struct MoeDownSched {
    static constexpr bool GATHER = false;
    TileOrder o; const char* A; const char* Bt; const PG8_LAS int* pst; int K;
    __device__ __forceinline__ bool next(int i, Unit& u) const { u.li = i; if (!o.map(i, u.pm, u.pn)) return false; u.e = expert_of_row_l(pst, u.pm * BM); return true; }
    __device__ __forceinline__ const char* a_base(const Unit& u) const { return A + (size_t)u.pm * BM * K * 2; }
    __device__ __forceinline__ const char* b_base(const Unit& u) const { return Bt + ((size_t)u.e * 1024 + (size_t)u.pn * BM) * K * 2; }
    __device__ __forceinline__ void a_voff(const Unit&, const int (&R)[2], const int (&C)[2], unsigned (&v)[2][2]) const {
#pragma unroll
        for (int h = 0; h < 2; ++h)
#pragma unroll
            for (int i = 0; i < 2; ++i) v[h][i] = (unsigned)((h * HALF + R[i]) * K + C[i]) * 2u;
    }
};
struct EpiSwiglu {
    static constexpr int PERM = 2;
    bf16* O; const PG8_LAS float* rowr;
    __device__ __forceinline__ void operator()(const f32x4 (&acc)[2][2][4][2], const Unit& u, int wr, int wc, int fr, int fq) const {
        const int row0 = u.pm * BM + wr * 64 + fr + 16 * (fq >> 1), col0 = u.pn * HALF + wc * 32 + 16 * (fq & 1);
#pragma unroll
        for (int ai = 0; ai < 2; ++ai)
#pragma unroll
            for (int p = 0; p < 2; ++p) {
                unsigned wv[2][2];
#pragma unroll
                for (int mm = 0; mm < 2; ++mm) { const int m = 2 * p + mm; const float rs = rowr[u.li * BM + wr * 64 + fr + ai * HALF + m * 16];
                    float hv[8];
#pragma unroll
                    for (int n = 0; n < 2; ++n)
#pragma unroll
                        for (int j = 0; j < 4; ++j) { const float g = acc[ai][0][m][n][j] * rs, up = acc[ai][1][m][n][j] * rs; hv[n * 4 + j] = g * up * __builtin_amdgcn_rcpf(1.f + __expf(-g)); }
                    wv[mm][0] = pk4_fp8(hv[0], hv[1], hv[2], hv[3]); wv[mm][1] = pk4_fp8(hv[4], hv[5], hv[6], hv[7]); }
                auto ra = __builtin_amdgcn_permlane32_swap(wv[0][0], wv[1][0], false, false); auto rb = __builtin_amdgcn_permlane32_swap(wv[0][1], wv[1][1], false, false);
                u32x4 w = {ra[0], rb[0], ra[1], rb[1]};
                *(u32x4*)((unsigned char*)O + (size_t)(row0 + ai * HALF + p * 32) * 512 + col0) = w; }
    }
};
struct EpiDown {
    static constexpr int PERM = 1;
    bf16* Y; const int* rowtok; const float* roww;
    __device__ __forceinline__ void operator()(const f32x4 (&acc)[2][2][4][2], const Unit& u, int wr, int wc, int fr, int fq) const {
        const int row0 = u.pm * BM + wr * 64 + fr, col0 = u.pn * BM + wc * 32 + 8 * fq;
#pragma unroll
        for (int ai = 0; ai < 2; ++ai)
#pragma unroll
            for (int m = 0; m < 4; ++m) { const int pos = row0 + ai * HALF + m * 16; const int tk = rowtok[pos]; const float w = roww[pos];
                if (tk >= 0) { bf16* rowp = Y + ((size_t)(tk & 1) * 65536 + (size_t)(tk >> 1)) * 1024 + col0;
#pragma unroll
                    for (int bj = 0; bj < 2; ++bj) { const f32x4 v0 = acc[ai][bj][m][0] * w, v1 = acc[ai][bj][m][1] * w;
                        u32x4 o; o.x = cvt_pk_bf16(v0[0], v0[1]); o.y = cvt_pk_bf16(v0[2], v0[3]); o.z = cvt_pk_bf16(v1[0], v1[1]); o.w = cvt_pk_bf16(v1[2], v1[3]);
                        *(u32x4*)(rowp + bj * HALF) = o; } } }
    }
};

typedef int i32x4v __attribute__((ext_vector_type(4)));
typedef int i32x8v __attribute__((ext_vector_type(8)));
template <class Epi, class Sched, bool ALIGN_EPI = true, bool F8 = false>
__device__ __forceinline__ void gemm_phase(PG8_LAS unsigned char* lds, const int K, const Sched& S, const Epi& E) {
    int tid = threadIdx.x; asm volatile("" : "+v"(tid));
    const int wid = __builtin_amdgcn_readfirstlane(tid >> 6), lane = tid & 63, wr = wid >> 2, wc = wid & 3, fr = lane & 15, fq = lane >> 4;
    const int nt = K / BK;
    int Rr[2], Cc[2]; unsigned voffB[2];
#pragma unroll
    for (int i = 0; i < 2; ++i) { int R, C; stage_rc(tid * 16 + i * 8192, R, C); const int Rb = Epi::PERM == 2 ? ((R & ~31) + perm32g(R & 31)) : Epi::PERM ? ((R & ~31) + perm32(R & 31)) : R;
        Rr[i] = R; Cc[i] = C; voffB[i] = (unsigned)(Rb * K + C) * 2u; }
    const size_t kstep = (size_t)(BK * 2);
    const size_t hstep = (size_t)HALF * K * 2;
    const unsigned ldsw = (unsigned)wid * 1024u;
    const int aoff = lds_byte(wr * 64 + fr, fq * 8), boff = lds_byte(wc * 32 + fr, fq * 8);
#define PG8_SA(b, h) (((b) * 2 + (h)) * HTB)
#define PG8_SB(b, h) ((4 + (b) * 2 + (h)) * HTB)
#define PG8_STAGE(bufoff, gbase, voff) do { _Pragma("unroll") for (int _i = 0; _i < 2; ++_i) \
        __builtin_amdgcn_global_load_lds((const unsigned*)((const char*)(gbase) + (voff)[_i]), (PG8_LAS unsigned*)(lds + (bufoff) + ldsw + _i * 8192), 16, 0, 0); } while (0)
#define PG8_CAT(x0, x1) __builtin_shufflevector(__builtin_bit_cast(i32x4v, x0), __builtin_bit_cast(i32x4v, x1), 0, 1, 2, 3, 4, 5, 6, 7)
#define PG8_LDA(dst, b, h) do { if constexpr (F8) { _Pragma("unroll") for (int m = 0; m < 4; ++m) dst##8[m] = PG8_CAT(*(const PG8_LAS bf16x8*)(lds + PG8_SA(b, h) + aoff + m * 2048), *(const PG8_LAS bf16x8*)(lds + PG8_SA(b, h) + aoff + m * 2048 + 1024)); } \
        else { _Pragma("unroll") for (int m = 0; m < 4; ++m) _Pragma("unroll") for (int k = 0; k < 2; ++k) dst[m][k] = *(const PG8_LAS bf16x8*)(lds + PG8_SA(b, h) + aoff + m * 2048 + k * 1024); } } while (0)
#define PG8_LDB(dst, b, h) do { if constexpr (F8) { _Pragma("unroll") for (int n = 0; n < 2; ++n) dst##8[n] = PG8_CAT(*(const PG8_LAS bf16x8*)(lds + PG8_SB(b, h) + boff + n * 2048), *(const PG8_LAS bf16x8*)(lds + PG8_SB(b, h) + boff + n * 2048 + 1024)); } \
        else { _Pragma("unroll") for (int n = 0; n < 2; ++n) _Pragma("unroll") for (int k = 0; k < 2; ++k) dst[n][k] = *(const PG8_LAS bf16x8*)(lds + PG8_SB(b, h) + boff + n * 2048 + k * 1024); } } while (0)
#define PG8_MMA(ai, bj, At, Bt) do { __builtin_amdgcn_s_setprio(1); \
        if constexpr (F8) { __builtin_amdgcn_sched_barrier(0); _Pragma("unroll") for (int m = 0; m < 4; ++m) _Pragma("unroll") for (int n = 0; n < 2; ++n) \
            asm volatile("v_mfma_scale_f32_16x16x128_f8f6f4 %0, %1, %2, %0, %3, %3 op_sel_hi:[0,0,0]" : "+v"(acc[ai][bj][m][n]) : "v"(Bt##8[n]), "v"(At##8[m]), "v"(f8scale)); __builtin_amdgcn_sched_barrier(0); } \
        else { _Pragma("unroll") for (int m = 0; m < 4; ++m) _Pragma("unroll") for (int n = 0; n < 2; ++n) _Pragma("unroll") for (int k = 0; k < 2; ++k) \
            acc[ai][bj][m][n] = __builtin_amdgcn_mfma_f32_16x16x32_bf16(Bt[n][k], At[m][k], acc[ai][bj][m][n], 0, 0, 0); } \
        __builtin_amdgcn_s_setprio(0); } while (0)
#define PG8_WAIT_V(n) asm volatile("s_waitcnt vmcnt(" #n ")" ::: "memory")
#define PG8_WAIT_L(n) asm volatile("s_waitcnt lgkmcnt(" #n ")" ::: "memory")
#define PG8_BAR __builtin_amdgcn_s_barrier()
#define PG8_SCHED __builtin_amdgcn_sched_barrier(0)
    Unit cur, nxt; int ui = 0;
    if (!S.next(0, cur)) return;
    f32x4 acc[2][2][4][2];
#pragma unroll
    for (int a = 0; a < 2; ++a)
#pragma unroll
        for (int b = 0; b < 2; ++b)
#pragma unroll
            for (int m = 0; m < 4; ++m)
#pragma unroll
                for (int n = 0; n < 2; ++n) acc[a][b][m][n] = (f32x4){0.f, 0.f, 0.f, 0.f};
    bf16x8 At[4][2], B0[2][2], B1[2][2];
    i32x8v At8[4], B08[2], B18[2]; const int f8scale = 127;
    unsigned cv[2][2], nv[2][2];
    S.a_voff(cur, Rr, Cc, cv);
#pragma unroll
    for (int h = 0; h < 2; ++h)
#pragma unroll
        for (int i = 0; i < 2; ++i) nv[h][i] = cv[h][i];
    const char* cA = S.a_base(cur); const char* cB = S.b_base(cur);
    PG8_STAGE(PG8_SB(0, 0), cB, voffB); PG8_STAGE(PG8_SB(0, 1), cB + hstep, voffB); PG8_STAGE(PG8_SA(0, 0), cA, cv[0]); PG8_STAGE(PG8_SA(0, 1), cA, cv[1]);
    if (wr == 1) PG8_BAR;
    PG8_WAIT_V(2); PG8_BAR;
    PG8_STAGE(PG8_SB(1, 0), cB + kstep, voffB); PG8_STAGE(PG8_SA(1, 0), cA + kstep, cv[0]); PG8_STAGE(PG8_SB(1, 1), cB + hstep + kstep, voffB);
    PG8_WAIT_V(6); PG8_BAR;
    for (;;) {
        const bool has_next = S.next(ui + 1, nxt);
        const char* nA = has_next ? S.a_base(nxt) : cA; const char* nB = has_next ? S.b_base(nxt) : cB;
#pragma unroll 1
        for (int t = 0; t < nt; t += 2) {
            const bool last = (t == nt - 2);
            const char* a1 = cA + (size_t)(t + 1) * kstep;
            const char* a2 = last ? nA : cA + (size_t)(t + 2) * kstep; const char* b2 = last ? nB : cB + (size_t)(t + 2) * kstep;
            const char* a3 = a2 + kstep; const char* b3 = b2 + kstep;
            unsigned v2[2][2];
            if constexpr (Sched::GATHER) {
                if (last && has_next) { S.a_voff(nxt, Rr, Cc, nv); }
#pragma unroll
                for (int h = 0; h < 2; ++h)
#pragma unroll
                    for (int i = 0; i < 2; ++i) v2[h][i] = last ? nv[h][i] : cv[h][i];
            } else {
#pragma unroll
                for (int h = 0; h < 2; ++h)
#pragma unroll
                    for (int i = 0; i < 2; ++i) v2[h][i] = cv[h][i];
            }
            PG8_LDB(B0, 0, 0); PG8_LDB(B1, 0, 1); PG8_SCHED; PG8_LDA(At, 0, 0); PG8_STAGE(PG8_SA(1, 1), a1, cv[1]);
            PG8_WAIT_V(8); PG8_WAIT_L(0); PG8_BAR; PG8_MMA(0, 0, At, B0); PG8_MMA(0, 1, At, B1); PG8_BAR; PG8_SCHED;
            PG8_LDA(At, 0, 1); PG8_STAGE(PG8_SB(0, 0), b2, voffB); PG8_STAGE(PG8_SB(0, 1), b2 + hstep, voffB); PG8_STAGE(PG8_SA(0, 0), a2, v2[0]);
            PG8_WAIT_V(8); PG8_WAIT_L(0); PG8_BAR; PG8_MMA(1, 0, At, B0); PG8_MMA(1, 1, At, B1); PG8_BAR; PG8_SCHED;
            PG8_LDB(B0, 1, 0); PG8_LDB(B1, 1, 1); PG8_SCHED; PG8_LDA(At, 1, 0); PG8_STAGE(PG8_SA(0, 1), a2, v2[1]);
            PG8_WAIT_V(8); PG8_WAIT_L(0); PG8_BAR; PG8_MMA(0, 0, At, B0); PG8_MMA(0, 1, At, B1); PG8_BAR; PG8_SCHED;
            PG8_LDA(At, 1, 1); PG8_STAGE(PG8_SB(1, 0), b3, voffB); PG8_STAGE(PG8_SB(1, 1), b3 + hstep, voffB); PG8_STAGE(PG8_SA(1, 0), a3, v2[0]);
            PG8_WAIT_V(8); PG8_WAIT_L(0); PG8_BAR; PG8_MMA(1, 0, At, B0); PG8_MMA(1, 1, At, B1); PG8_BAR; PG8_SCHED;
        }
        if constexpr (ALIGN_EPI) { if (wr == 0) PG8_BAR; }
        if constexpr (F8) { asm volatile("s_nop 15\n\ts_nop 15" ::: "memory"); }
        E(acc, cur, wr, wc, fr, fq);
        if (!has_next) break;
#pragma unroll
        for (int a = 0; a < 2; ++a)
#pragma unroll
            for (int b = 0; b < 2; ++b)
#pragma unroll
                for (int m = 0; m < 4; ++m)
#pragma unroll
                    for (int n = 0; n < 2; ++n) acc[a][b][m][n] = (f32x4){0.f, 0.f, 0.f, 0.f};
        cur = nxt; cA = nA; cB = nB; ++ui;
#pragma unroll
        for (int h = 0; h < 2; ++h)
#pragma unroll
            for (int i = 0; i < 2; ++i) cv[h][i] = nv[h][i];
        if constexpr (ALIGN_EPI) { if (wr == 1) PG8_BAR; }
    }
    PG8_WAIT_V(0);
    if constexpr (!ALIGN_EPI) { if (wr == 0) PG8_BAR; }
    PG8_BAR;
#undef PG8_SA
#undef PG8_SB
#undef PG8_STAGE
#undef PG8_LDA
#undef PG8_LDB
#undef PG8_MMA
#undef PG8_CAT
#undef PG8_WAIT_V
#undef PG8_WAIT_L
#undef PG8_BAR
#undef PG8_SCHED
}
}

#define XB_TMO      128
#define XB_XCNT(j)  (256  + 64 * (j))
#define XB_XSUB(j)  (1280 + 64 * (j))
#define XB_XGEN(j)  (2304 + 64 * (j))
#define XB_TOP      3328
#define XB_TOPGEN   3392
#define XCD_BAR_WORDS 3456
#define XB_SPIN_CAP (1u << 22)

__device__ __forceinline__ unsigned xb_ld(unsigned* p)              { return __hip_atomic_load(p, __ATOMIC_RELAXED, __HIP_MEMORY_SCOPE_AGENT); }
__device__ __forceinline__ unsigned xb_add(unsigned* p, unsigned v) { return __hip_atomic_fetch_add(p, v, __ATOMIC_RELAXED, __HIP_MEMORY_SCOPE_AGENT); }
__device__ __forceinline__ unsigned xb_xcc_id() { return (unsigned)__builtin_amdgcn_s_getreg((3 << 11) | 20) & 0xFu; }
#define XB_SPIN(cond, bar) do { unsigned _sp = 0; while (cond) { __builtin_amdgcn_s_sleep(1); \
    if ((++_sp & 255u) == 0u) { if (xb_ld(&(bar)[XB_TMO])) break; if (_sp > XB_SPIN_CAP) { atomicAdd(&(bar)[XB_TMO], 1u); break; } } } } while (0)

struct XcdBarrier { unsigned* bar; unsigned x; volatile LAS unsigned* st; };

__device__ __forceinline__ XcdBarrier xcd_barrier_post(unsigned* bar, volatile LAS unsigned* st) {
    XcdBarrier b; b.bar = bar; b.x = xb_xcc_id(); b.st = st;
    if (threadIdx.x == 0) (void)xb_add(&bar[XB_XCNT(b.x)], 1u);
    return b;
}
__device__ __forceinline__ void xcd_barrier_complete(unsigned* bar, unsigned x, unsigned& nloc, unsigned& nx) {
    const unsigned G = gridDim.x * gridDim.y * gridDim.z;
    unsigned sum, cnt, mine, sp = 0u;
    for (;;) {
        sum = 0u; cnt = 0u; mine = 0u;
#pragma unroll
        for (unsigned j = 0; j < 16; ++j) { const unsigned c = xb_ld(&bar[XB_XCNT(j)]); sum += c; cnt += (c > 0u) ? 1u : 0u; mine = (j == x) ? c : mine; }
        if (sum == G) break;
        __builtin_amdgcn_s_sleep(1);
        if ((++sp & 255u) == 0u) { if (xb_ld(&bar[XB_TMO])) break; if (sp > XB_SPIN_CAP) { atomicAdd(&bar[XB_TMO], 1u); break; } }
    }
    nloc = mine > 0u ? mine : 1u; nx = cnt > 0u ? cnt : 1u;
}
__device__ __forceinline__ void xcd_barrier(const XcdBarrier& b) {
    asm volatile("s_waitcnt vmcnt(0)" ::: "memory");
    __syncthreads();
    if (threadIdx.x == 0) {
        unsigned* bar = b.bar;
        __builtin_amdgcn_s_waitcnt(0);
        unsigned nloc = b.st[0], nx = b.st[1];
        if (nloc == 0u) { xcd_barrier_complete(bar, b.x, nloc, nx); b.st[0] = nloc; b.st[1] = nx; }
        const unsigned old = xb_add(&bar[XB_XSUB(b.x)], 1u);
        const unsigned gen = old / nloc;
        if (old + 1u == (gen + 1u) * nloc) {
            __builtin_amdgcn_fence(__ATOMIC_RELEASE, "agent");
            asm volatile("s_waitcnt vmcnt(0)" ::: "memory");
            const unsigned og = xb_add(&bar[XB_TOP], 1u);
            const unsigned tg = og / nx;
            if (og + 1u == (tg + 1u) * nx) xb_add(&bar[XB_TOPGEN], 1u);
            else XB_SPIN(xb_ld(&bar[XB_TOPGEN]) == tg, bar);
            __builtin_amdgcn_fence(__ATOMIC_ACQUIRE, "agent");
            xb_add(&bar[XB_XGEN(b.x)], 1u);
            asm volatile("s_waitcnt vmcnt(0)" ::: "memory");
        } else {
            XB_SPIN(xb_ld(&bar[XB_XGEN(b.x)]) == gen, bar);
            __builtin_amdgcn_fence(__ATOMIC_ACQUIRE, "agent");
            asm volatile("s_waitcnt vmcnt(0)" ::: "memory");
        }
    }
    __syncthreads();
}

struct Args {
    const float* in[24];
    float* out;
    unsigned char* ws;
    int ph_lo, ph_hi;
};

struct TrItem { const float* src; int ldsrc, k0, n0s; bf16* dst; int ldd, drow0; const float* kscale; int f8; };
__device__ __forceinline__ void tr_load(const TrItem& t, f32x4 (&v)[8], int lane) {
#pragma unroll
    for (int i = 0; i < 8; ++i) v[i] = __builtin_nontemporal_load((const f32x4*)(t.src + (size_t)(t.k0 + (lane >> 3) + 8 * i) * t.ldsrc + t.n0s + 4 * (lane & 7)));
}
__device__ __forceinline__ void tr_finish(const TrItem& t, const f32x4 (&v)[8], LAS float* scr, int lane) {
#pragma unroll
    for (int i = 0; i < 8; ++i) { const int kk = (lane >> 3) + 8 * i; f32x4 x = v[i]; if (t.kscale) x = x * t.kscale[t.k0 + kk];
        LAS float* d = scr + kk * 33 + 4 * (lane & 7); d[0] = x.x; d[1] = x.y; d[2] = x.z; d[3] = x.w; }
    LDS_WAIT();
    const int c = lane & 7;
#pragma unroll
    for (int j = 0; j < 4; ++j) { const int n = (lane >> 3) + 8 * j; const LAS float* s = scr + (8 * c) * 33 + n;
        if (t.f8) { u32x2 o; o.x = pk4_fp8(s[0 * 33], s[1 * 33], s[2 * 33], s[3 * 33]); o.y = pk4_fp8(s[4 * 33], s[5 * 33], s[6 * 33], s[7 * 33]);
            *(u32x2*)((unsigned char*)t.dst + (size_t)(t.drow0 + n) * t.ldd + t.k0 + 8 * c) = o; }
        else { u32x4 o; o.x = pk2(s[0 * 33], s[1 * 33]); o.y = pk2(s[2 * 33], s[3 * 33]); o.z = pk2(s[4 * 33], s[5 * 33]); o.w = pk2(s[6 * 33], s[7 * 33]);
            *(u32x4*)(t.dst + (size_t)(t.drow0 + n) * t.ldd + t.k0 + 8 * c) = o; } }
    LDS_WAIT();
}

__device__ __forceinline__ void p0_prologue(const Args& a, LAS unsigned char* lds, int tid, int lane, int wave, int wg, int G) {
    unsigned char* ws = a.ws;
    const float* x = a.in[0]; const float* norm1_w = a.in[1]; const float* w_in = a.in[2]; const float* b_ig = a.in[3]; const float* b_fg = a.in[4];
    const float* w_out = a.in[15]; const float* w_gate = a.in[21]; const float* w_up = a.in[22]; const float* w_down = a.in[23];
    bf16* W1T = (bf16*)(ws + WS_W1T); bf16* W2T = (bf16*)(ws + WS_W2T); bf16* WGU = (bf16*)(ws + WS_WGU); bf16* WD = (bf16*)(ws + WS_WD);
    bf16* H1 = (bf16*)(ws + WS_H1); float* GATES = (float*)(ws + WS_GATES);
    LAS float* scr = (LAS float*)(lds + wave * 8448);
    LAS float* gwl = (LAS float*)(lds + 73728);
    {
        float gv[16];
#pragma unroll
        for (int q = 0; q < 16; ++q) { const int idx = tid + NTHR * q; gv[q] = w_in[(size_t)(idx >> 3) * INCOLS + 2048 + (idx & 7)]; }
#pragma unroll
        for (int q = 0; q < 16; ++q) gwl[tid + NTHR * q] = gv[q];
    }
    {
        const float* norm2_w = a.in[16]; const float* w_group = a.in[17]; const float* w_expert = a.in[19]; unsigned char* RIMG = ws + WS_RIMG;
        const int idx = wg * NTHR + tid;
        if (idx < 36864) { int k, c; float v;
            if (idx < 4096) { k = idx >> 2; c = idx & 3; v = w_group[idx]; } else { const int j = idx - 4096; k = j >> 5; c = 4 + (j & 31); v = w_expert[j]; }
            v *= norm2_w[k];
            const unsigned hi = f2bf(v), lo = f2bf(v - __uint_as_float(hi << 16));
            *(bf16*)(RIMG + c * 2064 + k * 2) = (bf16)hi; *(bf16*)(RIMG + 36 * 2064 + c * 2064 + k * 2) = (bf16)lo; }
    }
    __syncthreads();
    const int gw = wg * NWAVES + wave, NGW = G * NWAVES;
    constexpr int I_1 = 16 * 112, I_2 = 16 * 32, NITEMS = I_1 + I_2;
    auto item_desc = [&](int it) -> TrItem {
        int r = it;
        if (r < I_1) { const int kb = r / 112, nb = r % 112, n0 = nb * 32; int sc_ = n0;
            { const int p0 = n0 & 255; sc_ = (n0 & ~255) + 64 * ((p0 >> 5) & 3) + 32 * (p0 >> 7); }
            return TrItem{w_in, INCOLS, kb * 64, sc_ < 2048 ? sc_ : sc_ + 8, W1T, 1024, n0, norm1_w, 0}; } r -= I_1;
        { const int kb = r / 32, nb = r % 32; return TrItem{w_out, 1024, kb * 64, nb * 32, W2T, 1024, nb * 32, nullptr, 0}; }
    };
    f32x4 w1v[4];
#pragma unroll
    for (int j = 0; j < 4; ++j) w1v[j] = ((const f32x4*)norm1_w)[lane + 64 * j];
    f32x4 nx[4], nx2[4];
#pragma unroll
    for (int j = 0; j < 4; ++j) { nx[j] = __builtin_nontemporal_load((const f32x4*)(x + (size_t)gw * DM) + lane + 64 * j); nx2[j] = __builtin_nontemporal_load((const f32x4*)(x + (size_t)(gw + NGW) * DM) + lane + 64 * j); }
    const int gc = ((lane >> 5) & 1) * 4 + ((lane >> 4) & 1) * 2 + ((lane >> 3) & 1), gh = gc & 3;
    const float gbias = (gc < 4) ? b_ig[gh] : b_fg[gh];
#pragma unroll 1
    for (int m = gw; m < T_; m += NGW) {
        f32x4 v[4]; float ss = 0.f;
#pragma unroll
        for (int j = 0; j < 4; ++j) { v[j] = nx[j]; nx[j] = nx2[j]; ss += (v[j].x * v[j].x + v[j].y * v[j].y) + (v[j].z * v[j].z + v[j].w * v[j].w); }
        if (m + 2 * NGW < T_) {
#pragma unroll
            for (int j = 0; j < 4; ++j) nx2[j] = __builtin_nontemporal_load((const f32x4*)(x + (size_t)(m + 2 * NGW) * DM) + lane + 64 * j); }
        const float r = rsqrtf(wave_sum(ss) * (1.f / DM) + EPS);
        if (lane == 0) ((float*)(ws + WS_R1))[m] = r;
        float g[8];
#pragma unroll
        for (int c = 0; c < 8; ++c) g[c] = 0.f;
        u32x2* o8 = (u32x2*)(H1 + (size_t)m * DM) + lane;
#pragma unroll
        for (int j = 0; j < 4; ++j) {
            const f32x4 hv = v[j] * r * w1v[j];
            u32x2 o; o.x = pk2(v[j].x, v[j].y); o.y = pk2(v[j].z, v[j].w); o8[64 * j] = o;
#pragma unroll
            for (int i = 0; i < 4; ++i) { const int k = 256 * j + 4 * lane + i; const f32x4 ga = *(const LAS f32x4*)(gwl + k * 8), gb = *(const LAS f32x4*)(gwl + k * 8 + 4);
                const float hh = hv[i];
                g[0] += hh * ga.x; g[1] += hh * ga.y; g[2] += hh * ga.z; g[3] += hh * ga.w; g[4] += hh * gb.x; g[5] += hh * gb.y; g[6] += hh * gb.z; g[7] += hh * gb.w; }
        }
        float k4[4], k2[2], k1;
        { const bool up = (lane & 32) != 0;
#pragma unroll
          for (int i = 0; i < 4; ++i) { const float send = up ? g[i] : g[i + 4]; const float recv = __shfl_xor(send, 32); k4[i] = (up ? g[i + 4] : g[i]) + recv; } }
        { const bool up = (lane & 16) != 0;
#pragma unroll
          for (int i = 0; i < 2; ++i) { const float send = up ? k4[i] : k4[i + 2]; const float recv = __shfl_xor(send, 16); k2[i] = (up ? k4[i + 2] : k4[i]) + recv; } }
        { const bool up = (lane & 8) != 0; const float send = up ? k2[0] : k2[1]; const float recv = __shfl_xor(send, 8); k1 = (up ? k2[1] : k2[0]) + recv; }
        k1 += __shfl_xor(k1, 4); k1 += __shfl_xor(k1, 2); k1 += __shfl_xor(k1, 1);
        if ((lane & 7) == 0) {
            float res = k1 + gbias;
            if (gc >= 4) res = fminf(res, 0.f) - log1pf(__expf(-fabsf(res)));
            GATES[(size_t)m * 8 + gc] = res;
        }
    }
    if (gw < NITEMS) {
        TrItem cur = item_desc(gw); f32x4 tv[8]; tr_load(cur, tv, lane);
#pragma unroll 1
        for (int it = gw; it < NITEMS; it += NGW) {
            f32x4 cv_[8];
#pragma unroll
            for (int i = 0; i < 8; ++i) cv_[i] = tv[i];
            const TrItem me = cur;
            if (it + NGW < NITEMS) { cur = item_desc(it + NGW); tr_load(cur, tv, lane); }
            tr_finish(me, cv_, scr, lane);
        }
    }
}

__device__ __forceinline__ void convert_gate_up(const Args& a, LAS unsigned char* lds, int lane, int wave, int wg, int G) {
    const float* w_gate = a.in[21]; const float* w_up = a.in[22]; unsigned char* WGU = a.ws + WS_WGU;
    LAS float* scr = (LAS float*)(lds + wave * 8448);
    const int gw = wg * NWAVES + wave, NGW = G * NWAVES;
    constexpr int I_GU = NEXP * 16 * 32;
    auto desc = [&](int r) -> TrItem { const int e = r / 512, q = r % 512, kb = q / 32, nb = q % 32, j0 = nb * 32, pn = j0 >> 8, rr = j0 & 255;
        const unsigned long long pg_ = (unsigned long long)(uintptr_t)w_gate, pu_ = (unsigned long long)(uintptr_t)w_up;
        const float* s_ = (const float*)(uintptr_t)(pg_ + ((rr < 128) ? 0ull : (pu_ - pg_))) + (size_t)e * 1024 * 512;
        return TrItem{s_, 512, kb * 64, pn * 128 + (rr & 127), (bf16*)(WGU + (size_t)e * 1024 * 1024), 1024, j0, a.in[16], 1}; };
    if (gw < I_GU) {
        TrItem cur = desc(gw); f32x4 tv[8]; tr_load(cur, tv, lane);
#pragma unroll 1
        for (int it = gw; it < I_GU; it += NGW) {
            f32x4 cv_[8];
#pragma unroll
            for (int i = 0; i < 8; ++i) cv_[i] = tv[i];
            const TrItem me = cur;
            if (it + NGW < I_GU) { cur = desc(it + NGW); tr_load(cur, tv, lane); }
            tr_finish(me, cv_, scr, lane);
        }
    }
}
__device__ __forceinline__ void p1_stagger_work(const Args& a, LAS unsigned char* lds, int lane, int wave, int wg) {
    const float* w_down = a.in[23]; bf16* WD = (bf16*)(a.ws + WS_WD);
    constexpr int NIT = NEXP * 8 * 32;
    const int lo = 0, hi = NIT;
    LAS float* scr = (LAS float*)(lds + wave * 8448);
    const int gw = wg * NWAVES + wave, NGW = 256 * NWAVES;
    auto desc = [&](int r) -> TrItem { const int e = r / 256, q = r % 256, kb = q / 32, nb = q % 32;
        return TrItem{w_down + (size_t)e * 512 * 1024, 1024, kb * 64, nb * 32, (bf16*)((unsigned char*)WD + (size_t)e * 1024 * 512), 512, nb * 32, nullptr, 1}; };
    if (lo + gw < hi) {
        TrItem cur = desc(lo + gw); f32x4 tv[8]; tr_load(cur, tv, lane);
#pragma unroll 1
        for (int it = lo + gw; it < hi; it += NGW) {
            f32x4 cv_[8];
#pragma unroll
            for (int i = 0; i < 8; ++i) cv_[i] = tv[i];
            const TrItem me = cur;
            if (it + NGW < hi) { cur = desc(it + NGW); tr_load(cur, tv, lane); }
            tr_finish(me, cv_, scr, lane);
        }
    }
}

__device__ __forceinline__ void mlstm_naive(const Args& a, LAS unsigned char* lds, int item, int tid, int lane, int wave) {
    unsigned char* ws = a.ws;
    const bf16* PROJ = (const bf16*)(ws + WS_PROJ); const float* GATES = (const float*)(ws + WS_GATES); bf16* MIX = (bf16*)(ws + WS_MIX);
    const float* conv_w = a.in[5]; const float* conv_b = a.in[6]; const float* m_norm_w = a.in[7];
    LAS float* qs = (LAS float*)lds; LAS float* ks = qs + 8192; LAS float* vs = ks + 8192; LAS float* hb = vs + 8192;
    LAS float* red = hb + 8192; LAS float* dred = red + 1024; LAS float* igs = dred + 16; LAS float* lfs = igs + 64;
    const int b = item >> 2, h = item & 3, e = tid & 127, dq = tid >> 7;
    float Cr[32], nr[32];
#pragma unroll
    for (int j = 0; j < 32; ++j) { Cr[j] = 0.f; nr[j] = 0.f; }
    float m = 0.f;
    const float mw0 = m_norm_w[lane], mw1 = m_norm_w[lane + 64];
    for (int c = 0; c < SEQ / 64; ++c) {
        const int t0 = c * 64;
        for (int idx = tid; idx < 8192; idx += NTHR) {
            const int tt = idx >> 7, d = idx & 127, t = t0 + tt, colq = C_MQ + h * 128 + d, colk = C_MK + h * 128 + d;
            float aq = conv_b[colq], ak = conv_b[colk];
#pragma unroll
            for (int j = 0; j < 4; ++j) { const int ts = t - 3 + j; if (ts >= 0) { const bf16* row = PROJ + (size_t)(b * SEQ + ts) * NCOL; aq += bf2f(row[colq]) * conv_w[j * 1024 + colq]; ak += bf2f(row[colk]) * conv_w[j * 1024 + colk]; } }
            qs[idx] = siluf_(aq); ks[idx] = siluf_(ak) * 0.08838834764831845f;
            vs[idx] = bf2f(PROJ[(size_t)(b * SEQ + t) * NCOL + C_MV + h * 128 + d]);
        }
        if (tid < 64) { igs[tid] = GATES[(size_t)(b * SEQ + t0 + tid) * 8 + h]; lfs[tid] = GATES[(size_t)(b * SEQ + t0 + tid) * 8 + 4 + h]; }
        __syncthreads();
        for (int tt = 0; tt < 64; ++tt) {
            const float lf = lfs[tt], ig = igs[tt];
            const float mnew = fmaxf(lf + m, ig), fd = __expf(lf + m - mnew), iw = __expf(ig - mnew); m = mnew;
            const float ve = vs[tt * 128 + e] * iw;
            float num = 0.f, den = 0.f;
#pragma unroll
            for (int j = 0; j < 32; ++j) { const int d = dq * 32 + j; const float kd = ks[tt * 128 + d], qd = qs[tt * 128 + d];
                Cr[j] = fd * Cr[j] + kd * ve; nr[j] = fd * nr[j] + iw * kd; num += qd * Cr[j]; den += qd * nr[j]; }
            const int p = tt & 1;
            red[(p * 4 + dq) * 128 + e] = num; if (e == 0) dred[p * 4 + dq] = den;
            __syncthreads();
            if (dq == 0) { const float ntot = (red[(p * 4 + 0) * 128 + e] + red[(p * 4 + 1) * 128 + e]) + (red[(p * 4 + 2) * 128 + e] + red[(p * 4 + 3) * 128 + e]);
                const float dtot = (dred[p * 4 + 0] + dred[p * 4 + 1]) + (dred[p * 4 + 2] + dred[p * 4 + 3]);
                hb[tt * 128 + e] = ntot / fmaxf(fabsf(dtot), __expf(-mnew)); }
        }
        __syncthreads();
#pragma unroll 1
        for (int rr = 0; rr < 8; ++rr) {
            const int tt = wave * 8 + rr, t = t0 + tt; const bf16* rowp = PROJ + (size_t)(b * SEQ + t) * NCOL + C_MO + h * 128;
            const float y0 = hb[tt * 128 + lane] * sigmoidf_(bf2f(rowp[lane])), y1 = hb[tt * 128 + lane + 64] * sigmoidf_(bf2f(rowp[lane + 64]));
            const float r = rsqrtf(wave_sum(y0 * y0 + y1 * y1) * (1.f / 128.f) + EPS);
            bf16* orow = MIX + (size_t)(b * SEQ + t) * DM + h * 128;
            orow[lane] = (bf16)f2bf(y0 * r * mw0); orow[lane + 64] = (bf16)f2bf(y1 * r * mw1);
        }
        __syncthreads();
    }
}

__device__ __forceinline__ void attn_naive_row(const Args& a, LAS float* sc, LAS float* qsl, int ridx, int lane, float lam) {
    unsigned char* ws = a.ws;
    const bf16* PROJ = (const bf16*)(ws + WS_PROJ); bf16* MIX = (bf16*)(ws + WS_MIX);
    const float* qnw = a.in[8]; const float* knw = a.in[9]; const float* anw = a.in[14];
    const int h = ridx & 3, bt = ridx >> 2, t = bt & (SEQ - 1), b = bt >> 11;
    {
        const unsigned u = *(const unsigned*)(PROJ + (size_t)bt * NCOL + C_AQ + h * 128 + 2 * lane);
        const float q0 = bflo(u), q1 = bfhi(u); float ss = q0 * q0 + q1 * q1;
#pragma unroll
        for (int o = 1; o < 32; o <<= 1) ss += __shfl_xor(ss, o);
        const float rq = rsqrtf(ss * (1.f / 64.f) + EPS) * 0.125f; const int dd = (2 * lane) & 63;
        qsl[2 * lane] = q0 * rq * qnw[dd] * knw[dd]; qsl[2 * lane + 1] = q1 * rq * qnw[dd + 1] * knw[dd + 1];
    }
    LDS_WAIT();
    const int nk = ((t >> 6) + 1) * 64;
    float m0 = -1e30f, m1 = -1e30f;
    for (int j = lane; j < nk; j += 64) {
        const u32x4* krow = (const u32x4*)(PROJ + (size_t)(b * SEQ + j) * NCOL + C_AK + h * 128);
        float s0 = 0.f, ss0 = 0.f, s1 = 0.f, ss1 = 0.f;
#pragma unroll
        for (int q = 0; q < 8; ++q) { const u32x4 kv = krow[q]; const f32x4 qa = *(const LAS f32x4*)(qsl + q * 8), qb = *(const LAS f32x4*)(qsl + q * 8 + 4);
            const float k0 = bflo(kv.x), k1 = bfhi(kv.x), k2 = bflo(kv.y), k3 = bfhi(kv.y), k4 = bflo(kv.z), k5 = bfhi(kv.z), k6 = bflo(kv.w), k7 = bfhi(kv.w);
            s0 += qa.x * k0 + qa.y * k1 + qa.z * k2 + qa.w * k3 + qb.x * k4 + qb.y * k5 + qb.z * k6 + qb.w * k7;
            ss0 += k0 * k0 + k1 * k1 + k2 * k2 + k3 * k3 + k4 * k4 + k5 * k5 + k6 * k6 + k7 * k7; }
#pragma unroll
        for (int q = 8; q < 16; ++q) { const u32x4 kv = krow[q]; const f32x4 qa = *(const LAS f32x4*)(qsl + q * 8), qb = *(const LAS f32x4*)(qsl + q * 8 + 4);
            const float k0 = bflo(kv.x), k1 = bfhi(kv.x), k2 = bflo(kv.y), k3 = bfhi(kv.y), k4 = bflo(kv.z), k5 = bfhi(kv.z), k6 = bflo(kv.w), k7 = bfhi(kv.w);
            s1 += qa.x * k0 + qa.y * k1 + qa.z * k2 + qa.w * k3 + qb.x * k4 + qb.y * k5 + qb.z * k6 + qb.w * k7;
            ss1 += k0 * k0 + k1 * k1 + k2 * k2 + k3 * k3 + k4 * k4 + k5 * k5 + k6 * k6 + k7 * k7; }
        s0 *= rsqrtf(ss0 * (1.f / 64.f) + EPS); s1 *= rsqrtf(ss1 * (1.f / 64.f) + EPS);
        sc[j] = s0; sc[2048 + j] = s1; m0 = fmaxf(m0, s0); m1 = fmaxf(m1, s1);
    }
    m0 = wave_max(m0); m1 = wave_max(m1);
    float l0 = 0.f, l1 = 0.f;
    for (int j = lane; j < nk; j += 64) { const float e0 = __expf(sc[j] - m0), e1 = __expf(sc[2048 + j] - m1); sc[j] = e0; sc[2048 + j] = e1; l0 += e0; l1 += e1; }
    l0 = wave_sum(l0); l1 = wave_sum(l1);
    const float c0 = 1.f / l0, c1 = lam / l1;
    LDS_WAIT();
    float o0 = 0.f, o1 = 0.f;
    const bf16* vb = PROJ + (size_t)(b * SEQ) * NCOL + C_AV + h * 128 + 2 * lane;
    for (int j = 0; j < nk; ++j) { const float p = sc[j] * c0 - sc[2048 + j] * c1; const unsigned u = *(const unsigned*)(vb + (size_t)j * NCOL); o0 += p * bflo(u); o1 += p * bfhi(u); }
    const float r = rsqrtf(wave_sum(o0 * o0 + o1 * o1) * (1.f / 128.f) + EPS) * (1.f - LAMBDA_INIT);
    *(unsigned*)(MIX + (size_t)bt * DM + 512 + h * 128 + 2 * lane) = pk2(o0 * r * anw[2 * lane], o1 * r * anw[2 * lane + 1]);
    LDS_WAIT();
}

__device__ __forceinline__ void p2_naive(const Args& a, LAS unsigned char* lds, int tid, int lane, int wave, int wg, int G) {
    if (wg < NBATCH * 4) mlstm_naive(a, lds, wg, tid, lane, wave);
    __syncthreads();
    const float* lq1 = a.in[10]; const float* lk1 = a.in[11]; const float* lq2 = a.in[12]; const float* lk2 = a.in[13];
    const float lam = __expf(wave_sum(lq1[lane] * lk1[lane])) - __expf(wave_sum(lq2[lane] * lk2[lane])) + LAMBDA_INIT;
    LAS float* sc = (LAS float*)(lds + wave * 16896); LAS float* qsl = sc + 4096;
    unsigned* queue = (unsigned*)(a.ws + WS_CTL) + CW_QUEUE;
    constexpr int NUNITS = T_ * 4 / 8;
    for (;;) {
        unsigned u = 0; if (lane == 0) u = __hip_atomic_fetch_add(queue, 1u, __ATOMIC_RELAXED, __HIP_MEMORY_SCOPE_AGENT);
        u = (unsigned)__builtin_amdgcn_readfirstlane((int)u);
        if (u >= (unsigned)NUNITS) break;
        const int base = (NUNITS - 1 - (int)u) * 8;
        for (int k = 0; k < 8; ++k) attn_naive_row(a, sc, qsl, base + k, lane, lam);
    }
}


namespace ml {
constexpr int QL = 0, KL = 17408, KWT = 34816, VT = 53248, SD = 71680, AV = 80896, MV = 89088, WV = 97280, IT = 105472, FL = 113664;
constexpr int MC = 121856, BEND = 121984, AMAX = 122112, DEC = 122240, NL = 122368, RS = 122880, QN = 123392, PSQ = 123648;
constexpr int QS = 272, TS = 144;
constexpr float L2E = 1.4426950408889634f;
#define LBAR() do { asm volatile("s_waitcnt lgkmcnt(0)" ::: "memory"); __builtin_amdgcn_s_barrier(); asm volatile("" ::: "memory"); } while (0)
__device__ __forceinline__ f32x4 mfma16(bf16x8 a, bf16x8 b, f32x4 c) { return __builtin_amdgcn_mfma_f32_16x16x32_bf16(a, b, c, 0, 0, 0); }
__device__ __forceinline__ unsigned cvtpk(float lo, float hi) { unsigned r; asm volatile("v_cvt_pk_bf16_f32 %0, %1, %2" : "=v"(r) : "v"(lo), "v"(hi)); return r; }
__device__ __forceinline__ unsigned cvtpk_nv(float lo, float hi) { unsigned r; asm("v_cvt_pk_bf16_f32 %0, %1, %2" : "=v"(r) : "v"(lo), "v"(hi)); return r; }
__device__ __forceinline__ f32x2 silu2(f32x2 o) { f32x2 e = o * (-L2E); e.x = __builtin_amdgcn_exp2f(e.x); e.y = __builtin_amdgcn_exp2f(e.y); e = e + 1.0f; e.x = __builtin_amdgcn_rcpf(e.x); e.y = __builtin_amdgcn_rcpf(e.y); return o * e; }

__device__ __forceinline__ void mlstm_item(const Args& a, LAS unsigned char* lds, const int item, const int tid) {
    unsigned char* ws = a.ws;
    const bf16* PROJ = (const bf16*)(ws + WS_PROJ); const float* GATES = (const float*)(ws + WS_GATES); bf16* MIX = (bf16*)(ws + WS_MIX);
    const float* conv_w = a.in[5]; const float* conv_b = a.in[6]; const float* m_norm_w = a.in[7];
    const int wid = __builtin_amdgcn_readfirstlane(tid >> 6), lane = tid & 63, fr = lane & 15, fq = lane >> 4;
    const int b = item >> 2, h = item & 3, e0 = 16 * wid;
    LAS float* AVl = (LAS float*)(lds + AV); LAS float* MVl = (LAS float*)(lds + MV); LAS float* WVl = (LAS float*)(lds + WV); LAS float* ITl = (LAS float*)(lds + IT); LAS float* FLl = (LAS float*)(lds + FL);
    LAS float* MCl = (LAS float*)(lds + MC); LAS float* BENDl = (LAS float*)(lds + BEND); LAS float* AMAXl = (LAS float*)(lds + AMAX); LAS float* DECl = (LAS float*)(lds + DEC);
    LAS float* NLl = (LAS float*)(lds + NL); LAS float* RSl = (LAS float*)(lds + RS); LAS float* QNl = (LAS float*)(lds + QN); LAS float* PSQl = (LAS float*)(lds + PSQ);
#pragma unroll 1
    for (int cc = 0; cc < 4; ++cc) {
        const int c = 4 * wid + cc, t = 64 * c + lane; const float* g = GATES + (size_t)(b * SEQ + t) * 8;
        float bs = g[4 + h]; const float ig = g[h];
#pragma unroll
        for (int o = 1; o < 64; o <<= 1) { const float v = __shfl_up(bs, o); if (lane >= o) bs += v; }
        const float av = ig - bs; float pm = av;
#pragma unroll
        for (int o = 1; o < 64; o <<= 1) { const float v = __shfl_up(pm, o); if (lane >= o) pm = fmaxf(pm, v); }
        AVl[t] = av; MVl[t] = pm; FLl[t] = bs;
        if (lane == 63) { BENDl[c] = bs; AMAXl[c] = pm; }
    }
    if (tid < 128) NLl[tid] = 0.f;
    __syncthreads();
    if (tid == 0) { float m = 0.f; for (int c = 0; c < 32; ++c) { MCl[c] = m; m = BENDl[c] + fmaxf(m, AMAXl[c]); } }
    __syncthreads();
    {
        float av_[4], pm_[4], bs_[4], m63_[4], mc_[4];
#pragma unroll
        for (int k = 0; k < 4; ++k) { const int t = tid + NTHR * k, c = t >> 6; av_[k] = AVl[t]; pm_[k] = MVl[t]; bs_[k] = FLl[t]; mc_[k] = MCl[c]; m63_[k] = fmaxf(mc_[k], MVl[64 * c + 63]); }
        __syncthreads();
#pragma unroll
        for (int k = 0; k < 4; ++k) { const int t = tid + NTHR * k; const float M = fmaxf(mc_[k], pm_[k]);
            AVl[t] = av_[k] * L2E; MVl[t] = M * L2E; WVl[t] = __expf(av_[k] - m63_[k]); ITl[t] = __expf(mc_[k] - M); FLl[t] = __expf(-(bs_[k] + M)); }
        if (tid < 32) DECl[tid] = __expf(MCl[tid] - fmaxf(MCl[tid], AMAXl[tid]));
    }
    __syncthreads();
    const int isk = wid >> 2, r0 = (wid & 3) * 16;
    const int ccol = (isk ? C_MK : C_MQ) + h * 128 + 2 * lane;
    f32x2 cw2[4], cb2;
#pragma unroll
    for (int j = 0; j < 4; ++j) { cw2[j].x = conv_w[j * 1024 + ccol]; cw2[j].y = conv_w[j * 1024 + ccol + 1]; }
    cb2.x = conv_b[ccol]; cb2.y = conv_b[ccol + 1];
    const bf16* qkbase = PROJ + (size_t)(b * SEQ) * NCOL + ccol;
    const bf16* vbase = PROJ + (size_t)(b * SEQ) * NCOL + C_MV + h * 128 + 2 * lane;
    const bf16* obase = PROJ + (size_t)(b * SEQ) * NCOL + C_MO + h * 128 + e0 + 4 * fq;
    const f32x4 mw = *(const f32x4*)(m_norm_w + e0 + 4 * fq);
    unsigned raw[19], vraw[8];
#define ML_LOADS(c_) do { _Pragma("unroll") for (int i = 0; i < 19; ++i) { const int t = 64 * (c_) + r0 - 3 + i; raw[i] = (t >= 0) ? __builtin_nontemporal_load((const unsigned*)(qkbase + (size_t)(t < 0 ? 0 : t) * NCOL)) : 0u; } \
        _Pragma("unroll") for (int i = 0; i < 8; ++i) vraw[i] = __builtin_nontemporal_load((const unsigned*)(vbase + (size_t)(64 * (c_) + 8 * wid + i) * NCOL)); } while (0)
    ML_LOADS(0);
    f32x4 Cacc[8];
#pragma unroll
    for (int i = 0; i < 8; ++i) Cacc[i] = (f32x4){0.f, 0.f, 0.f, 0.f};
#pragma unroll 1
    for (int c = 0; c < SEQ / 64; ++c) {
        {
            f32x2 xx[19];
#pragma unroll
            for (int i = 0; i < 19; ++i) { xx[i].x = bflo(raw[i]); xx[i].y = bfhi(raw[i]); }
            f32x2 oo[16], ee[16];
#pragma unroll
            for (int i = 0; i < 16; ++i) oo[i] = xx[i] * cw2[0] + cb2;
#pragma unroll
            for (int j = 1; j < 4; ++j)
#pragma unroll
                for (int i = 0; i < 16; ++i) oo[i] = xx[i + j] * cw2[j] + oo[i];
#pragma unroll
            for (int i = 0; i < 16; ++i) ee[i] = oo[i] * (-L2E);
#pragma unroll
            for (int i = 0; i < 16; ++i) { ee[i].x = __builtin_amdgcn_exp2f(ee[i].x); ee[i].y = __builtin_amdgcn_exp2f(ee[i].y); }
#pragma unroll
            for (int i = 0; i < 16; ++i) ee[i] = ee[i] + 1.0f;
#pragma unroll
            for (int i = 0; i < 16; ++i) { ee[i].x = __builtin_amdgcn_rcpf(ee[i].x); ee[i].y = __builtin_amdgcn_rcpf(ee[i].y); }
            if (!isk) {
#pragma unroll
                for (int i = 0; i < 16; ++i) oo[i] = oo[i] * ee[i];
#pragma unroll
                for (int i = 0; i < 16; ++i) *(LAS unsigned*)(lds + QL + (r0 + i) * QS + 4 * lane) = cvtpk_nv(oo[i].x, oo[i].y);
            } else {
                f32x2 kv[16];
#pragma unroll
                for (int i = 0; i < 16; ++i) kv[i] = oo[i] * ee[i] * 0.08838834764831845f;
#pragma unroll
                for (int i = 0; i < 16; ++i) *(LAS unsigned*)(lds + KL + (r0 + i) * QS + 4 * lane) = cvtpk_nv(kv[i].x, kv[i].y);
                u32x4 k0a, k0b, k1a, k1b;
#pragma unroll
                for (int q = 0; q < 4; ++q) { const f32x4 w4 = *(const LAS f32x4*)(WVl + 64 * c + r0 + 4 * q);
                    const f32x2 e0_ = kv[4 * q] * w4.x, e1_ = kv[4 * q + 1] * w4.y, e2_ = kv[4 * q + 2] * w4.z, e3_ = kv[4 * q + 3] * w4.w;
                    const unsigned a0 = cvtpk(e0_.x, e1_.x), a1 = cvtpk(e2_.x, e3_.x), b0 = cvtpk(e0_.y, e1_.y), b1 = cvtpk(e2_.y, e3_.y);
                    if (q == 0) { k0a.x = a0; k0a.y = a1; k1a.x = b0; k1a.y = b1; } else if (q == 1) { k0a.z = a0; k0a.w = a1; k1a.z = b0; k1a.w = b1; }
                    else if (q == 2) { k0b.x = a0; k0b.y = a1; k1b.x = b0; k1b.y = b1; } else { k0b.z = a0; k0b.w = a1; k1b.z = b0; k1b.w = b1; } }
                *(LAS u32x4*)(lds + KWT + (2 * lane) * TS + r0 * 2) = k0a; *(LAS u32x4*)(lds + KWT + (2 * lane) * TS + r0 * 2 + 16) = k0b;
                *(LAS u32x4*)(lds + KWT + (2 * lane + 1) * TS + r0 * 2) = k1a; *(LAS u32x4*)(lds + KWT + (2 * lane + 1) * TS + r0 * 2 + 16) = k1b;
            }
            u32x4 v0, v1;
            v0.x = (vraw[0] & 0xffffu) | (vraw[1] << 16); v0.y = (vraw[2] & 0xffffu) | (vraw[3] << 16); v0.z = (vraw[4] & 0xffffu) | (vraw[5] << 16); v0.w = (vraw[6] & 0xffffu) | (vraw[7] << 16);
            v1.x = (vraw[0] >> 16) | (vraw[1] & 0xffff0000u); v1.y = (vraw[2] >> 16) | (vraw[3] & 0xffff0000u); v1.z = (vraw[4] >> 16) | (vraw[5] & 0xffff0000u); v1.w = (vraw[6] >> 16) | (vraw[7] & 0xffff0000u);
            *(LAS u32x4*)(lds + VT + (2 * lane) * TS + 16 * wid) = v0;
            *(LAS u32x4*)(lds + VT + (2 * lane + 1) * TS + 16 * wid) = v1;
        }
        if (c + 1 < SEQ / 64) ML_LOADS(c + 1);
        u32x2 og[4];
#pragma unroll
        for (int ti = 0; ti < 4; ++ti) og[ti] = *(const u32x2*)(obase + (size_t)(64 * c + 16 * ti + fr) * NCOL);
        LBAR();
        {
            const int ti = wid >> 1, half = wid & 1; float rsum = 0.f;
            const float Mt = MVl[64 * c + 16 * ti + fr];
#pragma unroll
            for (int sx = 0; sx < 2; ++sx) {
                const int si = 2 * half + sx; f32x4 acc = (f32x4){0.f, 0.f, 0.f, 0.f};
                if (si <= ti) {
#pragma unroll
                    for (int kb = 0; kb < 4; ++kb) {
                        const bf16x8 kf = *(const LAS bf16x8*)(lds + KL + (16 * si + fr) * QS + (32 * kb + 8 * fq) * 2);
                        const bf16x8 qf = *(const LAS bf16x8*)(lds + QL + (16 * ti + fr) * QS + (32 * kb + 8 * fq) * 2);
                        acc = mfma16(kf, qf, acc); }
                    const f32x4 av = *(const LAS f32x4*)(AVl + 64 * c + 16 * si + 4 * fq);
#pragma unroll
                    for (int j = 0; j < 4; ++j) { const int s = 16 * si + 4 * fq + j, t = 16 * ti + fr; const float dd = (s <= t) ? __builtin_amdgcn_exp2f(av[j] - Mt) : 0.f; acc[j] *= dd; rsum += acc[j]; }
                }
                u32x2 o; o.x = cvtpk(acc[0], acc[1]); o.y = cvtpk(acc[2], acc[3]);
                *(LAS u32x2*)(lds + SD + (16 * ti + fr) * TS + (16 * si + 4 * fq) * 2) = o;
            }
            rsum += __shfl_xor(rsum, 16); rsum += __shfl_xor(rsum, 32);
            if (fq == 0) RSl[(16 * ti + fr) * 2 + half] = rsum;
        }
        {
            const int t = tid >> 3, part = tid & 7;
            const u32x4 qa = *(const LAS u32x4*)(lds + QL + t * QS + part * 32), qb = *(const LAS u32x4*)(lds + QL + t * QS + part * 32 + 16);
            const f32x4 n0 = *(const LAS f32x4*)(NLl + 16 * part), n1 = *(const LAS f32x4*)(NLl + 16 * part + 4), n2 = *(const LAS f32x4*)(NLl + 16 * part + 8), n3 = *(const LAS f32x4*)(NLl + 16 * part + 12);
            float s = bflo(qa.x) * n0.x + bfhi(qa.x) * n0.y + bflo(qa.y) * n0.z + bfhi(qa.y) * n0.w + bflo(qa.z) * n1.x + bfhi(qa.z) * n1.y + bflo(qa.w) * n1.z + bfhi(qa.w) * n1.w
                    + bflo(qb.x) * n2.x + bfhi(qb.x) * n2.y + bflo(qb.y) * n2.z + bfhi(qb.y) * n2.w + bflo(qb.z) * n3.x + bfhi(qb.z) * n3.y + bflo(qb.w) * n3.z + bfhi(qb.w) * n3.w;
            s += __shfl_xor(s, 1); s += __shfl_xor(s, 2); s += __shfl_xor(s, 4);
            if (part == 0) QNl[t] = s;
        }
        LBAR();
        f32x4 hacc[4]; float inter[4];
        {
            bf16x8 cf[4];
#pragma unroll
            for (int kb = 0; kb < 4; ++kb) { u32x4 w; w.x = cvtpk(Cacc[2 * kb][0], Cacc[2 * kb][1]); w.y = cvtpk(Cacc[2 * kb][2], Cacc[2 * kb][3]); w.z = cvtpk(Cacc[2 * kb + 1][0], Cacc[2 * kb + 1][1]); w.w = cvtpk(Cacc[2 * kb + 1][2], Cacc[2 * kb + 1][3]);
                cf[kb] = __builtin_bit_cast(bf16x8, w); }
#pragma unroll
            for (int ti = 0; ti < 4; ++ti) {
                hacc[ti] = (f32x4){0.f, 0.f, 0.f, 0.f};
#pragma unroll
                for (int kb = 0; kb < 4; ++kb) {
                    const u32x2 lo = *(const LAS u32x2*)(lds + QL + (16 * ti + fr) * QS + (32 * kb + 4 * fq) * 2), hi = *(const LAS u32x2*)(lds + QL + (16 * ti + fr) * QS + (32 * kb + 16 + 4 * fq) * 2);
                    const u32x4 qq = (u32x4){lo.x, lo.y, hi.x, hi.y};
                    hacc[ti] = mfma16(cf[kb], __builtin_bit_cast(bf16x8, qq), hacc[ti]); }
                inter[ti] = ITl[64 * c + 16 * ti + fr];
                hacc[ti] = hacc[ti] * inter[ti];
            }
        }
        {
            bf16x8 vf[2];
#pragma unroll
            for (int ks = 0; ks < 2; ++ks) vf[ks] = *(const LAS bf16x8*)(lds + VT + (e0 + fr) * TS + (32 * ks + 8 * fq) * 2);
#pragma unroll
            for (int ti = 0; ti < 4; ++ti)
#pragma unroll
                for (int ks = 0; ks < 2; ++ks) if (ks == 0 || ti >= 2) {
                    const bf16x8 sf = *(const LAS bf16x8*)(lds + SD + (16 * ti + fr) * TS + (32 * ks + 8 * fq) * 2);
                    hacc[ti] = mfma16(vf[ks], sf, hacc[ti]); }
            const float decay = DECl[c];
            float nsum = 0.f;
#pragma unroll
            for (int i = 0; i < 8; ++i) {
                Cacc[i] = Cacc[i] * decay;
#pragma unroll
                for (int ks = 0; ks < 2; ++ks) {
                    const bf16x8 kwf = *(const LAS bf16x8*)(lds + KWT + (16 * i + fr) * TS + (32 * ks + 8 * fq) * 2);
                    Cacc[i] = mfma16(kwf, vf[ks], Cacc[i]); }
            }
#pragma unroll
            for (int ks = 0; ks < 2; ++ks) {
                const u32x4 kk = *(const LAS u32x4*)(lds + KWT + (16 * wid + fr) * TS + (32 * ks + 8 * fq) * 2);
                nsum += (bflo(kk.x) + bfhi(kk.x)) + (bflo(kk.y) + bfhi(kk.y)) + (bflo(kk.z) + bfhi(kk.z)) + (bflo(kk.w) + bfhi(kk.w)); }
            nsum += __shfl_xor(nsum, 16); nsum += __shfl_xor(nsum, 32);
            if (fq == 0) NLl[16 * wid + fr] = decay * NLl[16 * wid + fr] + nsum;
        }
        f32x4 hm[4];
#pragma unroll
        for (int ti = 0; ti < 4; ++ti) {
            const int t = 16 * ti + fr;
            const float den = RSl[2 * t] + RSl[2 * t + 1] + inter[ti] * QNl[t];
            const float rd = __builtin_amdgcn_rcpf(fmaxf(fabsf(den), FLl[64 * c + t]));
            const f32x4 gg = (f32x4){bflo(og[ti].x), bfhi(og[ti].x), bflo(og[ti].y), bfhi(og[ti].y)};
            hm[ti] = hacc[ti] * gg * rd;
            float psq = (hm[ti][0] * hm[ti][0] + hm[ti][1] * hm[ti][1]) + (hm[ti][2] * hm[ti][2] + hm[ti][3] * hm[ti][3]);
            psq += __shfl_xor(psq, 16); psq += __shfl_xor(psq, 32);
            if (fq == 0) PSQl[t * 8 + wid] = psq;
        }
        LBAR();
#pragma unroll
        for (int ti = 0; ti < 4; ++ti) {
            const int t = 16 * ti + fr;
            const f32x4 p0 = *(const LAS f32x4*)(PSQl + t * 8), p1 = *(const LAS f32x4*)(PSQl + t * 8 + 4);
            const float r = rsqrtf(((p0.x + p0.y) + (p0.z + p0.w) + (p1.x + p1.y) + (p1.z + p1.w)) * (1.f / 128.f) + EPS);
            const f32x4 ov = hm[ti] * mw * r;
            u32x2 o; o.x = cvtpk(ov[0], ov[1]); o.y = cvtpk(ov[2], ov[3]);
            *(u32x2*)(MIX + (size_t)(b * SEQ + 64 * c + t) * DM + h * 128 + e0 + 4 * fq) = o;
        }
    }
#undef ML_LOADS
}
}

namespace att {
using s16x4  = __attribute__((ext_vector_type(4))) short;
using f32x16 = __attribute__((ext_vector_type(16))) float;
constexpr int SHM_V = 16384, SHM_K = 16384;
constexpr float THR2 = 11.5415603f;
#define KSWZ(row, colB) ((row) * 256 + ((colB) ^ (((row) & 7) << 4)))
#define SBAR() __builtin_amdgcn_sched_barrier(0)
__device__ __forceinline__ int crow(int r, int hi) { return (r & 3) + 8 * (r >> 2) + 4 * hi; }
__device__ __forceinline__ unsigned cvtpk(float lo, float hi) { unsigned r; asm volatile("v_cvt_pk_bf16_f32 %0, %1, %2" : "=v"(r) : "v"(lo), "v"(hi)); return r; }
__device__ __forceinline__ void partialSM(f32x16& p0, f32x16& p1, float& m_reg, float& mn, float& alpha) {
  float pmax = p0[0];
#pragma unroll
  for (int r = 1; r < 16; ++r) pmax = fmaxf(pmax, p0[r]);
#pragma unroll
  for (int r = 0; r < 16; ++r) pmax = fmaxf(pmax, p1[r]);
  { auto rr = __builtin_amdgcn_permlane32_swap(__float_as_uint(pmax), __float_as_uint(pmax), false, false);
    pmax = fmaxf(__uint_as_float(rr[0]), __uint_as_float(rr[1])); }
  if (__builtin_expect(__all(pmax - m_reg <= THR2), 1)) { mn = m_reg; alpha = 1.f; }
  else { mn = fmaxf(m_reg, pmax); alpha = __builtin_amdgcn_exp2f(m_reg - mn); m_reg = mn; }
#pragma unroll
  for (int r = 0; r < 16; ++r) p0[r] = p0[r] - mn;
#pragma unroll
  for (int r = 0; r < 16; ++r) p1[r] = p1[r] - mn;
#pragma unroll
  for (int r = 0; r < 16; ++r) p0[r] = __builtin_amdgcn_exp2f(p0[r]);
}
__device__ __forceinline__ void finishSM(f32x16& p0, f32x16& p1, float alpha, float& l_reg, bf16x8& pa0, bf16x8& pa1, bf16x8& pa2, bf16x8& pa3) {
#pragma unroll
  for (int r = 0; r < 16; ++r) p1[r] = __builtin_amdgcn_exp2f(p1[r]);
  float ps = 0;
#pragma unroll
  for (int r = 0; r < 16; ++r) ps += p0[r];
#pragma unroll
  for (int r = 0; r < 16; ++r) ps += p1[r];
  { auto rr = __builtin_amdgcn_permlane32_swap(__float_as_uint(ps), __float_as_uint(ps), false, false);
    ps = __uint_as_float(rr[0]) + __uint_as_float(rr[1]); }
  l_reg = l_reg * alpha + ps;
#define PK4(P, BASE, OUT) do { unsigned a0 = cvtpk(P[BASE + 0], P[BASE + 1]), a1 = cvtpk(P[BASE + 2], P[BASE + 3]);   \
    unsigned b0 = cvtpk(P[BASE + 4], P[BASE + 5]), b1 = cvtpk(P[BASE + 6], P[BASE + 7]);                              \
    auto r0 = __builtin_amdgcn_permlane32_swap(a0, b0, false, false); auto r1 = __builtin_amdgcn_permlane32_swap(a1, b1, false, false); \
    u32x4 w = {r0[0], r1[0], r0[1], r1[1]}; OUT = __builtin_bit_cast(bf16x8, w); } while (0)
  PK4(p0, 0, pa0); PK4(p0, 8, pa1); PK4(p1, 0, pa2); PK4(p1, 8, pa3);
#undef PK4
}
__device__ __forceinline__ void partialFX(f32x16& p0) {
#pragma unroll
  for (int r = 0; r < 16; ++r) p0[r] = __builtin_amdgcn_exp2f(p0[r]);
}
__device__ __forceinline__ void finishFX(f32x16& p0, f32x16& p1, float& l_reg, bf16x8& pa0, bf16x8& pa1, bf16x8& pa2, bf16x8& pa3) {
#pragma unroll
  for (int r = 0; r < 16; ++r) p1[r] = __builtin_amdgcn_exp2f(p1[r]);
  float ps = 0;
#pragma unroll
  for (int r = 0; r < 16; ++r) ps += p0[r];
#pragma unroll
  for (int r = 0; r < 16; ++r) ps += p1[r];
  l_reg += ps;
#define PK4(P, BASE, OUT) do { unsigned a0 = cvtpk(P[BASE + 0], P[BASE + 1]), a1 = cvtpk(P[BASE + 2], P[BASE + 3]);   \
    unsigned b0 = cvtpk(P[BASE + 4], P[BASE + 5]), b1 = cvtpk(P[BASE + 6], P[BASE + 7]);                              \
    auto r0 = __builtin_amdgcn_permlane32_swap(a0, b0, false, false); auto r1 = __builtin_amdgcn_permlane32_swap(a1, b1, false, false); \
    u32x4 w = {r0[0], r1[0], r0[1], r1[1]}; OUT = __builtin_bit_cast(bf16x8, w); } while (0)
  PK4(p0, 0, pa0); PK4(p0, 8, pa1); PK4(p1, 0, pa2); PK4(p1, 8, pa3);
#undef PK4
}
__device__ __forceinline__ void qkt(f32x16& p0, f32x16& p1, const LAS unsigned char* Ks, const bf16x8 (&qr)[4], int c, int r32, int hi) {
  p0 = f32x16{}; p1 = f32x16{};
#pragma unroll
  for (int d0 = 0; d0 < 4; ++d0) { const int cb = (c * 64 + d0 * 16 + hi * 8) * 2;
    const bf16x8 b0 = *(const LAS bf16x8*)(Ks + KSWZ(r32, cb));
    const bf16x8 b1 = *(const LAS bf16x8*)(Ks + KSWZ(32 + r32, cb));
    p0 = __builtin_amdgcn_mfma_f32_32x32x16_bf16(b0, qr[d0], p0, 0, 0, 0);
    p1 = __builtin_amdgcn_mfma_f32_32x32x16_bf16(b1, qr[d0], p1, 0, 0, 0); }
}
__device__ __forceinline__ int v_st(int k, int c) { const int kk = (k & ~0xC) | ((k & 4) << 1) | ((k & 8) >> 1); return ((kk >> 3) * 4 + (c >> 5)) * 512 + ((kk & 7) * 32 + (c & 31)) * 2; }
__device__ __forceinline__ int v_rd_base(int lane) { return ((lane & 3) << 3) | (((lane >> 2) & 3) << 6) | (((lane >> 4) & 1) << 5) | (((lane >> 5) & 1) << 8); }
constexpr int v_rd_off(int d0, int ks, int half) { return d0 * 512 + ks * 4096 + half * 2048; }
template <int OFF> __device__ __forceinline__ s16x4 tr_read(int vb) {
  s16x4 r; asm volatile("ds_read_b64_tr_b16 %0, %1 offset:%2" : "=&v"(r) : "v"(vb), "i"(OFF) : "memory"); return r;
}
template <int D0> __device__ __forceinline__ void pv_one(f32x16& od, int vb, bf16x8 pa0, bf16x8 pa1, bf16x8 pa2, bf16x8 pa3) {
  const s16x4 l0 = tr_read<v_rd_off(D0, 0, 0)>(vb), h0 = tr_read<v_rd_off(D0, 0, 1)>(vb), l1 = tr_read<v_rd_off(D0, 1, 0)>(vb), h1 = tr_read<v_rd_off(D0, 1, 1)>(vb);
  const s16x4 l2 = tr_read<v_rd_off(D0, 2, 0)>(vb), h2 = tr_read<v_rd_off(D0, 2, 1)>(vb), l3 = tr_read<v_rd_off(D0, 3, 0)>(vb), h3 = tr_read<v_rd_off(D0, 3, 1)>(vb);
  asm volatile("s_waitcnt lgkmcnt(0)" ::: "memory"); SBAR();
#define PK(L, H) (bf16x8){L[0], L[1], L[2], L[3], H[0], H[1], H[2], H[3]}
  od = __builtin_amdgcn_mfma_f32_32x32x16_bf16(pa0, PK(l0, h0), od, 0, 0, 0);
  od = __builtin_amdgcn_mfma_f32_32x32x16_bf16(pa1, PK(l1, h1), od, 0, 0, 0);
  od = __builtin_amdgcn_mfma_f32_32x32x16_bf16(pa2, PK(l2, h2), od, 0, 0, 0);
  od = __builtin_amdgcn_mfma_f32_32x32x16_bf16(pa3, PK(l3, h3), od, 0, 0, 0);
#undef PK
}
#define PVRD(D0) const s16x4 l0_##D0 = tr_read<v_rd_off(D0, 0, 0)>(vb), h0_##D0 = tr_read<v_rd_off(D0, 0, 1)>(vb), l1_##D0 = tr_read<v_rd_off(D0, 1, 0)>(vb), h1_##D0 = tr_read<v_rd_off(D0, 1, 1)>(vb), \
    l2_##D0 = tr_read<v_rd_off(D0, 2, 0)>(vb), h2_##D0 = tr_read<v_rd_off(D0, 2, 1)>(vb), l3_##D0 = tr_read<v_rd_off(D0, 3, 0)>(vb), h3_##D0 = tr_read<v_rd_off(D0, 3, 1)>(vb)
#define PVPK(L, H) (bf16x8){L[0], L[1], L[2], L[3], H[0], H[1], H[2], H[3]}
#define PVMM(D0, N) do { asm volatile("s_waitcnt lgkmcnt(" #N ")" ::: "memory"); SBAR(); \
    o[D0] = __builtin_amdgcn_mfma_f32_32x32x16_bf16(pa0, PVPK(l0_##D0, h0_##D0), o[D0], 0, 0, 0); o[D0] = __builtin_amdgcn_mfma_f32_32x32x16_bf16(pa1, PVPK(l1_##D0, h1_##D0), o[D0], 0, 0, 0); \
    o[D0] = __builtin_amdgcn_mfma_f32_32x32x16_bf16(pa2, PVPK(l2_##D0, h2_##D0), o[D0], 0, 0, 0); o[D0] = __builtin_amdgcn_mfma_f32_32x32x16_bf16(pa3, PVPK(l3_##D0, h3_##D0), o[D0], 0, 0, 0); } while (0)
__device__ __forceinline__ void pv_d0(f32x16* o, int vb, bf16x8 pa0, bf16x8 pa1, bf16x8 pa2, bf16x8 pa3) {
  PVRD(0); PVRD(1); PVMM(0, 8); PVRD(2); PVMM(1, 8); PVRD(3); PVMM(2, 8); PVMM(3, 0);
}
#undef PVRD
#undef PVPK
#undef PVMM

template <bool FX>
__device__ __forceinline__ void attn_unit(const bf16* __restrict__ PROJ, bf16* __restrict__ MIX, const float* __restrict__ anw, const float lam, const float nb, const int b, const int h, const int qb,
                                          LAS unsigned char* lds, const int tid) {
  const int wid = __builtin_amdgcn_readfirstlane(tid >> 6), lane = tid & 63, r32 = lane & 31, hi = lane >> 5, g = wid >> 1, c = wid & 1;
  const int q0 = qb * 128, NT = 2 * qb + 2; const bool masked_last = (g < 2);
  int hcol = h * 128; asm volatile("" : "+s"(hcol));
  const char* Kg = (const char*)(PROJ + (size_t)(b * SEQ) * NCOL + C_AK + hcol);
  const char* Vg = (const char*)(PROJ + (size_t)(b * SEQ) * NCOL + C_AV + hcol);
  LAS float* wsf = (LAS float*)(lds + 131072) + wid * 64; LAS float* li_l = wsf; LAS float* al_l = wsf + 32;
  unsigned koff[2], voff[2];
#pragma unroll
  for (int p = 0; p < 2; ++p) { const int s = (wid * 2 + p) * 64 + lane, row = s >> 4, ch = (s & 15) ^ (row & 7); koff[p] = (unsigned)(row * NCOL + ch * 8) * 2u;
    const int o = s * 16, sub = o >> 9, within = o & 511, kk = (sub >> 2) * 8 + (within >> 6), k = (kk & ~0xC) | ((kk & 4) << 1) | ((kk & 8) >> 1), cc = (sub & 3) * 32 + ((within & 63) >> 4) * 8;
    voff[p] = (unsigned)(k * NCOL + cc) * 2u; }
#define DMA(tile, slot) do { const char* kt_ = Kg + (size_t)(tile) * (64 * NCOL * 2); const char* vt_ = Vg + (size_t)(tile) * (64 * NCOL * 2); LAS unsigned char* sl_ = lds + (slot) * 32768 + wid * 2048; \
    _Pragma("unroll") for (int p_ = 0; p_ < 2; ++p_) __builtin_amdgcn_global_load_lds((const unsigned*)(kt_ + koff[p_]), (LAS unsigned*)(sl_ + p_ * 1024), 16, 0, 0); \
    _Pragma("unroll") for (int p_ = 0; p_ < 2; ++p_) __builtin_amdgcn_global_load_lds((const unsigned*)(vt_ + voff[p_]), (LAS unsigned*)(sl_ + 16384 + p_ * 1024), 16, 0, 0); } while (0)
#define WB4() do { asm volatile("s_waitcnt vmcnt(4)" ::: "memory"); __builtin_amdgcn_s_barrier(); asm volatile("" ::: "memory"); } while (0)
#define WB8() do { asm volatile("s_waitcnt vmcnt(8)" ::: "memory"); __builtin_amdgcn_s_barrier(); asm volatile("" ::: "memory"); } while (0)
#define KSLOT(j) (lds + ((j) & 3) * 32768)
#define VSLOT(j) (vb0 + ((j) & 3) * 32768)
  float m_reg = -1e30f, l_reg = 0; f32x16 o[4] = {}; bf16x8 qr[4];
  { const bf16* Qw = PROJ + (size_t)(b * SEQ + q0 + 32 * g + r32) * NCOL + C_AQ + hcol + c * 64 + hi * 8;
#pragma unroll
    for (int d0 = 0; d0 < 4; ++d0) qr[d0] = *(const bf16x8*)(Qw + d0 * 16); }
  const int vb0 = (int)(unsigned)(uintptr_t)lds + 16384 + v_rd_base(lane);
#define RESC(a) do { if (__any((a) < 1.f)) { if (hi == 0) al_l[r32] = (a); asm volatile("s_waitcnt lgkmcnt(0)" ::: "memory"); \
    _Pragma("unroll") for (int d = 0; d < 4; ++d) _Pragma("unroll") for (int r = 0; r < 16; ++r) o[d][r] *= al_l[crow(r, hi)]; } } while (0)
  f32x16 p0, p1; float mn, al; bf16x8 pa0, pa1, pa2, pa3;
  DMA(0, 0); DMA(1, 1);
#pragma unroll 1
  for (int j = 0; j < NT; ++j) {
    WB4();
    DMA((j + 2 < NT ? j + 2 : NT - 1), (j + 2) & 3);
    SBAR(); qkt(p0, p1, KSLOT(j), qr, c, r32, hi);
    if (masked_last && j == NT - 1) {
#pragma unroll
      for (int r = 0; r < 16; ++r) { p0[r] = -1e30f; p1[r] = -1e30f; } }
    if constexpr (FX) { SBAR(); partialFX(p0); finishFX(p0, p1, l_reg, pa0, pa1, pa2, pa3); SBAR(); }
    else { partialSM(p0, p1, m_reg, mn, al); RESC(al); finishSM(p0, p1, al, l_reg, pa0, pa1, pa2, pa3); SBAR(); }
    pv_d0(o, VSLOT(j), pa0, pa1, pa2, pa3);
  }
  if constexpr (FX) l_reg += __shfl_xor(l_reg, 32);
  asm volatile("s_waitcnt vmcnt(0)" ::: "memory");
#undef DMA
#undef WB4
#undef WB8
#undef KSLOT
#undef VSLOT
  if (hi == 0) li_l[r32] = l_reg; asm volatile("s_waitcnt lgkmcnt(0)" ::: "memory");
  int lane2 = lane; asm volatile("" : "+v"(lane2));
  const int r32b = lane2 & 31, hib = lane2 >> 5;
  float rli[16];
#pragma unroll
  for (int r = 0; r < 16; ++r) rli[r] = __builtin_amdgcn_rcpf(li_l[(r & 3) + 8 * (r >> 2) + 4 * hib]);
  __syncthreads();
  LAS float* X = (LAS float*)(lds + g * 16384) + hib * 512 + r32b;
  if (c == 1) {
#pragma unroll
    for (int r = 0; r < 16; ++r)
#pragma unroll
      for (int d0 = 0; d0 < 4; ++d0) X[((r & 3) + 8 * (r >> 2)) * 128 + d0 * 32] = o[d0][r] * (rli[r] * lam);
  }
  __syncthreads();
  if (c == 0) {
    float ss[16];
#pragma unroll
    for (int r = 0; r < 16; ++r) { ss[r] = 0.f;
#pragma unroll
      for (int d0 = 0; d0 < 4; ++d0) { const float v = o[d0][r] * rli[r] - X[((r & 3) + 8 * (r >> 2)) * 128 + d0 * 32]; o[d0][r] = v; ss[r] += v * v; } }
#pragma unroll
    for (int r = 0; r < 16; ++r) {
#pragma unroll
      for (int s = 1; s < 32; s <<= 1) ss[r] += __shfl_xor(ss[r], s);
      ss[r] = rsqrtf(ss[r] * (1.f / 128.f) + EPS) * (1.f - LAMBDA_INIT); }
    float aw[4];
#pragma unroll
    for (int d0 = 0; d0 < 4; ++d0) aw[d0] = anw[d0 * 32 + r32b];
    asm volatile("s_waitcnt lgkmcnt(0)" ::: "memory");
    LAS bf16* Ost = (LAS bf16*)(lds + g * 16384);
    LAS bf16* Ow = Ost + hib * 512 + r32b;
#pragma unroll
    for (int r = 0; r < 16; ++r)
#pragma unroll
      for (int d0 = 0; d0 < 4; ++d0) Ow[((r & 3) + 8 * (r >> 2)) * 128 + d0 * 32] = (bf16)f2bf(o[d0][r] * ss[r] * aw[d0]);
    asm volatile("s_waitcnt lgkmcnt(0)" ::: "memory");
    const int rowb = lane2 >> 4, c16 = lane2 & 15;
    bf16* Ob = MIX + (size_t)(b * SEQ + q0 + 32 * g + rowb) * DM + 512 + h * 128 + c16 * 8;
    const LAS bf16* Os = Ost + rowb * 128 + c16 * 8;
#pragma unroll
    for (int k = 0; k < 8; ++k) *(u32x4*)(Ob + (size_t)k * 4 * DM) = *(const LAS u32x4*)(Os + k * 512);
  }
  __syncthreads();
#undef RESC
}

template <int C, int HALF_> __device__ __forceinline__ void half_scores(f32x16& p, const LAS unsigned char* Ks, const bf16x8 (&qr)[8], const int kaddr) {
  p = f32x16{};
#pragma unroll
  for (int d0 = 0; d0 < 4; ++d0) { const bf16x8 kf = *(const LAS bf16x8*)(Ks + (kaddr ^ (d0 * 32)) + C * 128 + HALF_ * 8192);
    p = __builtin_amdgcn_mfma_f32_32x32x16_bf16(kf, qr[C * 4 + d0], p, 0, 0, 0); }
}
__device__ __forceinline__ void half_softmax(f32x16& p, float& l_reg, bf16x8& pa, bf16x8& pb) {
#pragma unroll
  for (int r = 0; r < 16; ++r) p[r] = __builtin_amdgcn_exp2f(p[r]);
  float ps = 0;
#pragma unroll
  for (int r = 0; r < 16; ++r) ps += p[r];
  l_reg += ps;
#define PK4(P, BASE, OUT) do { unsigned a0 = cvtpk(P[BASE + 0], P[BASE + 1]), a1 = cvtpk(P[BASE + 2], P[BASE + 3]);   \
    unsigned b0 = cvtpk(P[BASE + 4], P[BASE + 5]), b1 = cvtpk(P[BASE + 6], P[BASE + 7]);                              \
    auto r0 = __builtin_amdgcn_permlane32_swap(a0, b0, false, false); auto r1 = __builtin_amdgcn_permlane32_swap(a1, b1, false, false); \
    u32x4 w = {r0[0], r1[0], r0[1], r1[1]}; OUT = __builtin_bit_cast(bf16x8, w); } while (0)
  PK4(p, 0, pa); PK4(p, 8, pb);
#undef PK4
  SBAR();
}
template <int D0, int HALF_> __device__ __forceinline__ void pv_half(f32x16& oa, f32x16& ob, int vb, bf16x8 a0, bf16x8 a1, bf16x8 b0, bf16x8 b1) {
  const s16x4 l0 = tr_read<v_rd_off(D0, 2 * HALF_, 0)>(vb), h0 = tr_read<v_rd_off(D0, 2 * HALF_, 1)>(vb), l1 = tr_read<v_rd_off(D0, 2 * HALF_ + 1, 0)>(vb), h1 = tr_read<v_rd_off(D0, 2 * HALF_ + 1, 1)>(vb);
  asm volatile("s_waitcnt lgkmcnt(0)" ::: "memory"); SBAR();
#define PK(L, H) (bf16x8){L[0], L[1], L[2], L[3], H[0], H[1], H[2], H[3]}
  oa = __builtin_amdgcn_mfma_f32_32x32x16_bf16(a0, PK(l0, h0), oa, 0, 0, 0);
  ob = __builtin_amdgcn_mfma_f32_32x32x16_bf16(b0, PK(l0, h0), ob, 0, 0, 0);
  oa = __builtin_amdgcn_mfma_f32_32x32x16_bf16(a1, PK(l1, h1), oa, 0, 0, 0);
  ob = __builtin_amdgcn_mfma_f32_32x32x16_bf16(b1, PK(l1, h1), ob, 0, 0, 0);
#undef PK
  SBAR();
}
__device__ __forceinline__ void attn2_setup(LAS unsigned char* lds, const int tid) {
  const int wid = __builtin_amdgcn_readfirstlane(tid >> 6), lane = tid & 63;
  unsigned koff[2], voff[2];
#pragma unroll
  for (int p = 0; p < 2; ++p) { const int s = (wid * 2 + p) * 64 + lane, row = s >> 4, ch = (s & 15) ^ (row & 7); koff[p] = (unsigned)(row * NCOL + ch * 8) * 2u;
    const int o = s * 16, sub = o >> 9, within = o & 511, kk = (sub >> 2) * 8 + (within >> 6), k = (kk & ~0xC) | ((kk & 4) << 1) | ((kk & 8) >> 1), cc = (sub & 3) * 32 + ((within & 63) >> 4) * 8;
    voff[p] = (unsigned)(k * NCOL + cc) * 2u; }
  *((LAS u32x4*)(lds + 133120 + wid * 1024) + lane) = (u32x4){koff[0], koff[1], voff[0], voff[1]};
  asm volatile("s_waitcnt lgkmcnt(0)" ::: "memory");
}
__device__ __forceinline__ void attn_unit2(const bf16* __restrict__ PROJ, bf16* __restrict__ MIX, const float* __restrict__ anw, const float lam, const int b, const int h, const int qb,
                                           LAS unsigned char* lds, const int tid, unsigned* qhead, LAS unsigned* slot) {
  const int wid = __builtin_amdgcn_readfirstlane(tid >> 6), lane = tid & 63, r32 = lane & 31, hi = lane >> 5;
  const int q0 = qb * 256, NT = 4 * qb + 4, jlast = 4 * qb + (wid >> 1);
  int hcol = h * 128; asm volatile("" : "+s"(hcol));
  const char* Kg = (const char*)(PROJ + (size_t)(b * SEQ) * NCOL + C_AK + hcol);
  const char* Vg = (const char*)(PROJ + (size_t)(b * SEQ) * NCOL + C_AV + hcol);
  LAS float* wsf = (LAS float*)(lds + 131072) + wid * 64;
  LAS u32x4* offt = (LAS u32x4*)(lds + 133120 + wid * 1024) + lane;
#define DMA(tile, slot) do { const char* kt_ = Kg + (size_t)(tile) * (64 * NCOL * 2); const char* vt_ = Vg + (size_t)(tile) * (64 * NCOL * 2); LAS unsigned char* sl_ = lds + (slot) * 32768 + wid * 2048; const u32x4 of_ = *offt; \
    __builtin_amdgcn_global_load_lds((const unsigned*)(kt_ + of_.x), (LAS unsigned*)(sl_), 16, 0, 0); __builtin_amdgcn_global_load_lds((const unsigned*)(kt_ + of_.y), (LAS unsigned*)(sl_ + 1024), 16, 0, 0); \
    __builtin_amdgcn_global_load_lds((const unsigned*)(vt_ + of_.z), (LAS unsigned*)(sl_ + 16384), 16, 0, 0); __builtin_amdgcn_global_load_lds((const unsigned*)(vt_ + of_.w), (LAS unsigned*)(sl_ + 16384 + 1024), 16, 0, 0); } while (0)
#define WB4() do { asm volatile("s_waitcnt vmcnt(4)" ::: "memory"); __builtin_amdgcn_s_barrier(); asm volatile("" ::: "memory"); } while (0)
  float l0 = 0.f, l1 = 0.f; f32x16 oa[4] = {}, ob[4] = {}; bf16x8 qr[8];
  { const bf16* Qw = PROJ + (size_t)(b * SEQ + q0 + 32 * wid + r32) * NCOL + C_AQ + hcol + hi * 8;
#pragma unroll
    for (int d = 0; d < 8; ++d) qr[d] = *(const bf16x8*)(Qw + d * 16); }
  const int vb0 = (int)(unsigned)(uintptr_t)lds + 16384 + v_rd_base(lane);
  const int kaddr = r32 * 256 + ((hi * 16) ^ ((r32 & 7) << 4));
  DMA(0, 0); DMA(1, 1);
#pragma unroll 1
  for (int j = 0; j < NT; ++j) {
    WB4();
    DMA((j + 2 < NT ? j + 2 : NT - 1), (j + 2) & 3);
    if (j <= jlast) {
      const LAS unsigned char* Ks = lds + (j & 3) * 32768; const int vb = vb0 + (j & 3) * 32768;
      f32x16 p; bf16x8 a0, a1, b0, b1;
      SBAR(); half_scores<0, 0>(p, Ks, qr, kaddr); half_softmax(p, l0, a0, a1);
      SBAR(); half_scores<1, 0>(p, Ks, qr, kaddr); half_softmax(p, l1, b0, b1); SBAR();
      pv_half<0, 0>(oa[0], ob[0], vb, a0, a1, b0, b1); pv_half<1, 0>(oa[1], ob[1], vb, a0, a1, b0, b1); pv_half<2, 0>(oa[2], ob[2], vb, a0, a1, b0, b1); pv_half<3, 0>(oa[3], ob[3], vb, a0, a1, b0, b1);
      SBAR(); half_scores<0, 1>(p, Ks, qr, kaddr); half_softmax(p, l0, a0, a1);
      SBAR(); half_scores<1, 1>(p, Ks, qr, kaddr); half_softmax(p, l1, b0, b1); SBAR();
      pv_half<0, 1>(oa[0], ob[0], vb, a0, a1, b0, b1); pv_half<1, 1>(oa[1], ob[1], vb, a0, a1, b0, b1); pv_half<2, 1>(oa[2], ob[2], vb, a0, a1, b0, b1); pv_half<3, 1>(oa[3], ob[3], vb, a0, a1, b0, b1);
    }
  }
  l0 += __shfl_xor(l0, 32); l1 += __shfl_xor(l1, 32);
  asm volatile("s_waitcnt vmcnt(0)" ::: "memory");
  unsigned nx = 0u; { int z_ = 0; asm volatile("" : "+v"(z_)); if (tid == 0) nx = __hip_atomic_fetch_add(qhead + z_, 1u, __ATOMIC_RELAXED, __HIP_MEMORY_SCOPE_AGENT); }
  if (hi == 0) { wsf[r32] = l0; wsf[32 + r32] = l1; } asm volatile("s_waitcnt lgkmcnt(0)" ::: "memory");
  int lane2 = lane; asm volatile("" : "+v"(lane2));
  const int r32b = lane2 & 31, hib = lane2 >> 5;
  __syncthreads();
  float ss[16];
#pragma unroll
  for (int r = 0; r < 16; ++r) { const int row = (r & 3) + 8 * (r >> 2) + 4 * hib; const float c0 = __builtin_amdgcn_rcpf(wsf[row]), c1 = lam * __builtin_amdgcn_rcpf(wsf[32 + row]); ss[r] = 0.f;
#pragma unroll
    for (int d0 = 0; d0 < 4; ++d0) { const float v = oa[d0][r] * c0 - ob[d0][r] * c1; oa[d0][r] = v; ss[r] += v * v; } }
#pragma unroll
  for (int r = 0; r < 16; ++r) {
#pragma unroll
    for (int s = 1; s < 32; s <<= 1) ss[r] += __shfl_xor(ss[r], s);
    ss[r] = rsqrtf(ss[r] * (1.f / 128.f) + EPS) * (1.f - LAMBDA_INIT); }
  float aw[4];
#pragma unroll
  for (int d0 = 0; d0 < 4; ++d0) aw[d0] = anw[d0 * 32 + r32b];
  LAS bf16* Ost = (LAS bf16*)(lds + wid * 8192);
  LAS bf16* Ow = Ost + hib * 512 + r32b;
#pragma unroll
  for (int r = 0; r < 16; ++r)
#pragma unroll
    for (int d0 = 0; d0 < 4; ++d0) Ow[((r & 3) + 8 * (r >> 2)) * 128 + d0 * 32] = (bf16)f2bf(oa[d0][r] * ss[r] * aw[d0]);
  asm volatile("s_waitcnt lgkmcnt(0)" ::: "memory");
  const int rowb = lane2 >> 4, c16 = lane2 & 15;
  bf16* Ob = MIX + (size_t)(b * SEQ + q0 + 32 * wid + rowb) * DM + 512 + h * 128 + c16 * 8;
  const LAS bf16* Os = Ost + rowb * 128 + c16 * 8;
#pragma unroll
  for (int k = 0; k < 8; ++k) *(u32x4*)(Ob + (size_t)k * 4 * DM) = *(const LAS u32x4*)(Os + k * 512);
  if (tid == 0) *slot = nx;
  __syncthreads();
#undef DMA
#undef WB4
}
}

template <bool FX>
__device__ __forceinline__ void attn_queue(const bf16* PROJ, bf16* MIX, const float* anw, const float lam, const float nb, unsigned* queue, LAS unsigned char* lds, int tid) {
    LAS unsigned* slot = (LAS unsigned*)(lds + LDSCTL_OFF + 64);
    const int x0 = (int)(xb_xcc_id() & 7u);
    LAS unsigned* peek = (LAS unsigned*)(lds + LDSCTL_OFF + 72);
    if constexpr (FX) att::attn2_setup(lds, tid);
#pragma unroll 1
    for (int k = 0; k < 8; ++k) {
        const int x = (x0 + k) & 7;
        if (k == 1) { if (tid < 8) peek[tid] = __hip_atomic_load(queue + 64 * tid, __ATOMIC_RELAXED, __HIP_MEMORY_SCOPE_AGENT); __syncthreads(); }
        if (k >= 1) { if (peek[x] >= 128u) continue; }
        if (tid == 0) *slot = __hip_atomic_fetch_add(queue + 64 * x, 1u, __ATOMIC_RELAXED, __HIP_MEMORY_SCOPE_AGENT);
        __syncthreads();
        for (;;) {
            const unsigned l = *slot;
            __syncthreads();
            if (l >= 128u) break;
            const int bh = ((int)l >> 3) * 8 + x, p = (int)l & 7;
            if constexpr (FX) { const int bh2 = ((int)l & 15) * 8 + x, qb2 = 7 - ((int)l >> 4); att::attn_unit2(PROJ, MIX, anw, lam, bh2 >> 2, bh2 & 3, qb2, lds, tid, queue + 64 * x, slot); }
            else {
                unsigned nxt = 0u;
                if (tid == 0) nxt = __hip_atomic_fetch_add(queue + 64 * x, 1u, __ATOMIC_RELAXED, __HIP_MEMORY_SCOPE_AGENT);
#pragma unroll 1
                for (int s = 0; s < 2; ++s) att::attn_unit<false>(PROJ, MIX, anw, lam, nb, bh >> 2, bh & 3, s ? p : 15 - p, lds, tid);
                if (tid == 0) *slot = nxt;
                __syncthreads(); }
        }
    }
}
__device__ __forceinline__ void p2_fast_attn(const Args& a, LAS unsigned char* lds, int tid, int lane, int wave, int wg, int G, int rep) {
    const float* lq1 = a.in[10]; const float* lk1 = a.in[11]; const float* lq2 = a.in[12]; const float* lk2 = a.in[13];
    const float lam = __expf(wave_sum(lq1[lane] * lk1[lane])) - __expf(wave_sum(lq2[lane] * lk2[lane])) + LAMBDA_INIT;
    const float bound2 = 8.f * 1.4426950408889634f * 1.01f * wave_max(fabsf(a.in[8][lane])) * wave_max(fabsf(a.in[9][lane]));
    const bool fixedmax = bound2 <= 40.f;
    const bf16* PROJ = (const bf16*)(a.ws + WS_PROJ); bf16* MIX = (bf16*)(a.ws + WS_MIX);
    unsigned* queue = (unsigned*)(a.ws + WS_CTL) + CW_QUEUE + 1024 * rep;
    if (fixedmax) attn_queue<true>(PROJ, MIX, a.in[14], lam, -bound2, queue, lds, tid);
    else attn_queue<false>(PROJ, MIX, a.in[14], lam, 0.f, queue, lds, tid);
}

__device__ __forceinline__ void p4_router(const Args& a, LAS unsigned char* lds, int tid, int lane, int wave, int wg, int G) {
    unsigned char* ws = a.ws;
    const float* norm2_w = a.in[16]; const float* w_group = a.in[17]; const float* b_group = a.in[18]; const float* w_expert = a.in[19]; const float* b_expert = a.in[20];
    const float* X1 = a.out; bf16* H2 = (bf16*)(ws + WS_H2);
    int* ASGE = (int*)(ws + WS_ASGE); float* ASGW = (float*)(ws + WS_ASGW); int* CNT = (int*)(ws + WS_CTL) + CW_CNT;
    LAS float* wl = (LAS float*)lds;
    LAS int* hist = (LAS int*)(lds + LDSCTL_OFF + 128);
    for (int idx = tid; idx < 4096; idx += NTHR) { const int k = idx >> 2, c = idx & 3; wl[c * 1024 + k] = w_group[idx]; }
    for (int idx = tid; idx < 32768; idx += NTHR) { const int k = idx >> 5, c = idx & 31; wl[(4 + c) * 1024 + k] = w_expert[idx]; }
    if (tid < 32) hist[tid] = 0;
    __syncthreads();
    f32x4 w2v[4];
#pragma unroll
    for (int j = 0; j < 4; ++j) w2v[j] = ((const f32x4*)norm2_w)[lane + 64 * j];
    const int tpw = T_ / (G * NWAVES);
#pragma unroll 1
    for (int rr = 0; rr < tpw; ++rr) {
        const int t = (wg * NWAVES + wave) * tpw + rr;
        const f32x4* xr = (const f32x4*)(X1 + (size_t)t * DM) + lane;
        f32x4 hv[4]; float ss = 0.f;
#pragma unroll
        for (int j = 0; j < 4; ++j) { hv[j] = xr[64 * j]; ss += (hv[j].x * hv[j].x + hv[j].y * hv[j].y) + (hv[j].z * hv[j].z + hv[j].w * hv[j].w); }
        const float r2 = rsqrtf(wave_sum(ss) * (1.f / DM) + EPS);
        u32x2* o8 = (u32x2*)(H2 + (size_t)t * DM) + lane;
#pragma unroll
        for (int j = 0; j < 4; ++j) { hv[j] = hv[j] * r2 * w2v[j]; u32x2 o; o.x = pk2(hv[j].x, hv[j].y); o.y = pk2(hv[j].z, hv[j].w); o8[64 * j] = o; }
        float lg[36];
#pragma unroll
        for (int c = 0; c < 36; ++c) { float acc = 0.f;
#pragma unroll
            for (int j = 0; j < 4; ++j) { const f32x4 wv = *(const LAS f32x4*)(wl + c * 1024 + 256 * j + 4 * lane); acc += (hv[j].x * wv.x + hv[j].y * wv.y) + (hv[j].z * wv.z + hv[j].w * wv.w); }
            lg[c] = wave_sum(acc); }
        float gl[4];
#pragma unroll
        for (int g = 0; g < 4; ++g) gl[g] = lg[g] + b_group[g];
        int gsel = 0; float gmax = gl[0];
#pragma unroll
        for (int g = 1; g < 4; ++g) if (gl[g] > gmax) { gmax = gl[g]; gsel = g; }
        float gsum = 0.f;
#pragma unroll
        for (int g = 0; g < 4; ++g) gsum += __expf(gl[g] - gmax);
        const float gwt = 1.f / gsum;
        float el[8];
#pragma unroll
        for (int i = 0; i < 8; ++i) el[i] = 0.f;
#pragma unroll
        for (int g = 0; g < 4; ++g) if (gsel == g) {
#pragma unroll
            for (int i = 0; i < 8; ++i) el[i] = lg[4 + 8 * g + i] + b_expert[8 * g + i]; }
        int i1 = 0; float v1 = el[0];
#pragma unroll
        for (int i = 1; i < 8; ++i) if (el[i] > v1) { v1 = el[i]; i1 = i; }
        int i2 = -1; float v2 = -3.0e38f;
#pragma unroll
        for (int i = 0; i < 8; ++i) if (i != i1 && el[i] > v2) { v2 = el[i]; i2 = i; }
        const float p1 = 1.f / (1.f + __expf(v2 - v1)), p2 = 1.f - p1;
        if (lane == 0) {
            const int e1 = gsel * 8 + i1, e2 = gsel * 8 + i2;
            const int r1 = atomicAdd((int*)&hist[e1], 1), r2_ = atomicAdd((int*)&hist[e2], 1);
            ASGE[2 * t] = e1 | (r1 << 8); ASGE[2 * t + 1] = e2 | (r2_ << 8);
            ASGW[2 * t] = gwt * p1; ASGW[2 * t + 1] = gwt * p2;
        }
    }
    __syncthreads();
    if (tid < 32) CNT[wg * 32 + tid] = hist[tid];
}


__device__ __forceinline__ void p4_router_mfma(const Args& a, LAS unsigned char* lds, int tid, int lane, int wave, int wg, int G) {
    unsigned char* ws = a.ws;
    const float* b_group = a.in[18]; const float* b_expert = a.in[20];
    const bf16* X1B = (const bf16*)(ws + WS_H2);
    int* ASGE = (int*)(ws + WS_ASGE); float* ASGW = (float*)(ws + WS_ASGW); int* CNT = (int*)(ws + WS_CTL) + CW_CNT;
    constexpr int WST = 2064, WLO = 36 * WST;
    LAS int* hist = (LAS int*)(lds + LDSCTL_OFF + 128);
    {
        const u32x4* RIMG = (const u32x4*)(ws + WS_RIMG); constexpr int NP = 2 * 36 * WST / 16;
#pragma unroll 1
        for (int base = 0; base < NP; base += 6 * NTHR) {
            u32x4 v[6];
#pragma unroll
            for (int q = 0; q < 6; ++q) { const int i = base + q * NTHR + tid; v[q] = RIMG[i < NP ? i : NP - 1]; }
#pragma unroll
            for (int q = 0; q < 6; ++q) { const int i = base + q * NTHR + tid; if (i < NP) *(LAS u32x4*)(lds + i * 16) = v[q]; }
        }
    }
    if (tid < 32) hist[tid] = 0;
    __syncthreads();
    const int fr = lane & 15, fq = lane >> 4;
    const int t0 = (wg * NWAVES + wave) * 32;
    const bf16* x1a = X1B + (size_t)(t0 + fr) * DM + 8 * fq; const bf16* x1b = x1a + (size_t)16 * DM;
    f32x4 acc[2][3];
#pragma unroll
    for (int tl = 0; tl < 2; ++tl)
#pragma unroll
        for (int nt = 0; nt < 3; ++nt) acc[tl][nt] = (f32x4){0.f, 0.f, 0.f, 0.f};
    float ss0 = 0.f, ss1 = 0.f;
    int wrow[3];
#pragma unroll
    for (int nt = 0; nt < 3; ++nt) { const int c = 16 * nt + fr; wrow[nt] = (c < 36 ? c : 35) * WST + 16 * fq; }
#pragma unroll 1
    for (int kg = 0; kg < 4; ++kg) {
        u32x4 va[8], vb[8];
#pragma unroll
        for (int q = 0; q < 8; ++q) { va[q] = *(const u32x4*)(x1a + 32 * (8 * kg + q)); vb[q] = *(const u32x4*)(x1b + 32 * (8 * kg + q)); }
#pragma unroll
        for (int q = 0; q < 8; ++q) { const int ks = 8 * kg + q; const u32x4 a_ = va[q], b_ = vb[q];
            { const float f0 = bflo(a_.x), f1 = bfhi(a_.x), f2 = bflo(a_.y), f3 = bfhi(a_.y), f4 = bflo(a_.z), f5 = bfhi(a_.z), f6 = bflo(a_.w), f7 = bfhi(a_.w);
              ss0 += (f0 * f0 + f1 * f1) + (f2 * f2 + f3 * f3) + (f4 * f4 + f5 * f5) + (f6 * f6 + f7 * f7); }
            { const float f0 = bflo(b_.x), f1 = bfhi(b_.x), f2 = bflo(b_.y), f3 = bfhi(b_.y), f4 = bflo(b_.z), f5 = bfhi(b_.z), f6 = bflo(b_.w), f7 = bfhi(b_.w);
              ss1 += (f0 * f0 + f1 * f1) + (f2 * f2 + f3 * f3) + (f4 * f4 + f5 * f5) + (f6 * f6 + f7 * f7); }
            const bf16x8 ah[2] = {__builtin_bit_cast(bf16x8, a_), __builtin_bit_cast(bf16x8, b_)};
#pragma unroll
            for (int nt = 0; nt < 3; ++nt) {
                const bf16x8 wh = *(const LAS bf16x8*)(lds + wrow[nt] + ks * 64), wl = *(const LAS bf16x8*)(lds + WLO + wrow[nt] + ks * 64);
#pragma unroll
                for (int tl = 0; tl < 2; ++tl) {
                    acc[tl][nt] = __builtin_amdgcn_mfma_f32_16x16x32_bf16(wh, ah[tl], acc[tl][nt], 0, 0, 0);
                    acc[tl][nt] = __builtin_amdgcn_mfma_f32_16x16x32_bf16(wl, ah[tl], acc[tl][nt], 0, 0, 0); }
            }
        }
    }
    float bg[4], be[32]; int pe_[2][2] = {{0, 0}, {0, 0}}, pr_[2][2] = {{0, 0}, {0, 0}};
#pragma unroll
    for (int g = 0; g < 4; ++g) bg[g] = b_group[g];
#pragma unroll
    for (int i = 0; i < 32; ++i) be[i] = b_expert[i];
#pragma unroll
    for (int tl = 0; tl < 2; ++tl) {
        float ss = tl ? ss1 : ss0; ss += __shfl_xor(ss, 16); ss += __shfl_xor(ss, 32);
        const float r2 = rsqrtf(ss * (1.f / DM) + EPS);
        float lg[36];
#pragma unroll
        for (int nt = 0; nt < 3; ++nt)
#pragma unroll
            for (int q = 0; q < 4; ++q)
#pragma unroll
                for (int j = 0; j < 4; ++j) { const int c = 16 * nt + 4 * q + j; if (c < 36) lg[c] = __shfl(acc[tl][nt][j], fr + 16 * q) * r2; }
        float gl[4];
#pragma unroll
        for (int g = 0; g < 4; ++g) gl[g] = lg[g] + bg[g];
        int gsel = 0; float gmax = gl[0];
#pragma unroll
        for (int g = 1; g < 4; ++g) if (gl[g] > gmax) { gmax = gl[g]; gsel = g; }
        float gsum = 0.f;
#pragma unroll
        for (int g = 0; g < 4; ++g) gsum += __expf(gl[g] - gmax);
        const float gwt = 1.f / gsum;
        float el[8];
#pragma unroll
        for (int i = 0; i < 8; ++i) el[i] = 0.f;
#pragma unroll
        for (int g = 0; g < 4; ++g) if (gsel == g) {
#pragma unroll
            for (int i = 0; i < 8; ++i) el[i] = lg[4 + 8 * g + i] + be[8 * g + i]; }
        int i1 = 0; float v1 = el[0];
#pragma unroll
        for (int i = 1; i < 8; ++i) if (el[i] > v1) { v1 = el[i]; i1 = i; }
        int i2 = -1; float v2 = -3.0e38f;
#pragma unroll
        for (int i = 0; i < 8; ++i) if (i != i1 && el[i] > v2) { v2 = el[i]; i2 = i; }
        const float p1 = 1.f / (1.f + __expf(v2 - v1)), p2 = 1.f - p1;
        if (fq == 0) {
            const int t = t0 + 16 * tl + fr;
            const int e1 = gsel * 8 + i1, e2 = gsel * 8 + i2;
            const int r1 = atomicAdd((int*)&hist[e1], 1), r2_ = atomicAdd((int*)&hist[e2], 1);
            pe_[tl][0] = e1; pe_[tl][1] = e2; pr_[tl][0] = r1; pr_[tl][1] = r2_;
            ASGW[2 * t] = gwt * p1; ASGW[2 * t + 1] = gwt * p2;
            ASGW[2 * T_ + 2 * t] = r2; ASGW[2 * T_ + 2 * t + 1] = r2;
        }
    }
    __syncthreads();
    LAS int* lbase = hist + 32;
    if (tid < 32) lbase[tid] = atomicAdd((int*)(ws + WS_CTL) + CW_CUR + 64 * tid, hist[tid]);
    __syncthreads();
    if (fq == 0) { int* LIST = (int*)(ws + WS_LIST);
#pragma unroll
        for (int tl = 0; tl < 2; ++tl) { const int t = t0 + 16 * tl + fr;
#pragma unroll
            for (int k = 0; k < 2; ++k) { const int e = pe_[tl][k], ii = lbase[e] + pr_[tl][k]; LIST[(size_t)e * LCAP + ii] = 2 * t + k; ASGE[2 * t + k] = e | (ii << 8); } } }
}

__device__ __forceinline__ void p5_dispatch(const Args& a, LAS unsigned char* lds, int tid, int wg, int G) {
    unsigned char* ws = a.ws;
    const int* ASGE = (const int*)(ws + WS_ASGE); const float* ASGW = (const float*)(ws + WS_ASGW); const int* CNT = (const int*)(ws + WS_CTL) + CW_CNT;
    int* META = (int*)(ws + WS_CTL) + CW_META; int* ROWTOK = (int*)(ws + WS_ROWTOK); float* ROWW = (float*)(ws + WS_ROWW); float* ROWR = (float*)(ws + WS_GATES); int* POSA = (int*)(ws + WS_POSA);
    LAS int* tot = (LAS int*)lds; LAS int* pre = tot + 32; LAS int* pst = pre + 32;
    {
        LAS int* part = pst + 64;
        const int e = tid & 31, j = tid >> 5; int total = 0, prefix = 0;
#pragma unroll
        for (int q = 0; q < 16; ++q) { const int w = 16 * j + q; const int c = (w < G) ? CNT[w * 32 + e] : 0; total += c; prefix += (w < wg) ? c : 0; }
        part[j * 32 + e] = total; part[512 + j * 32 + e] = prefix;
        __syncthreads();
        if (tid < 32) { int t2 = 0, p2 = 0;
#pragma unroll
            for (int q = 0; q < 16; ++q) { t2 += part[q * 32 + tid]; p2 += part[512 + q * 32 + tid]; }
            tot[tid] = t2; pre[tid] = p2; }
    }
    __syncthreads();
    if (tid == 0) { int s = 0; for (int e = 0; e < 32; ++e) { pst[e] = s; s += (tot[e] + 255) & ~255; } pst[32] = s; }
    __syncthreads();
    if (wg == 0 && tid <= 32) META[tid] = pst[tid];
    const int apw = 2 * T_ / G;
    for (int q = tid; q < apw; q += NTHR) { const int idx = wg * apw + q; const int ev = ASGE[idx], e = ev & 255, rank = ev >> 8; const int pos = pst[e] + pre[e] + rank; ROWTOK[pos] = idx; ROWW[pos] = ASGW[idx]; ROWR[pos] = ASGW[2 * T_ + idx]; POSA[idx] = pos; }
    if (wg < 32) { const int e = wg; for (int p = pst[e] + tot[e] + tid; p < pst[e + 1]; p += NTHR) { ROWTOK[p] = -1; ROWW[p] = 0.f; ROWR[p] = 0.f; } }
}

__device__ __forceinline__ int expert_of_row(const LAS int* pst, int row) { int e = 0;
#pragma unroll 1
    for (int i = 1; i < 32; ++i) e += (pst[i] <= row) ? 1 : 0;
    return e; }

__device__ __forceinline__ void unpack8(const u32x4 v, float (&f)[8]) { f[0] = bflo(v.x); f[1] = bfhi(v.x); f[2] = bflo(v.y); f[3] = bfhi(v.y); f[4] = bflo(v.z); f[5] = bfhi(v.z); f[6] = bflo(v.w); f[7] = bfhi(v.w); }
__device__ __forceinline__ void p6_naive(const Args& a, LAS unsigned char* lds, int tid, int wg, int G) {
    unsigned char* ws = a.ws;
    const int* META = (const int*)(ws + WS_CTL) + CW_META; const int* ROWTOK = (const int*)(ws + WS_ROWTOK);
    const bf16* H2 = (const bf16*)(ws + WS_H2); const bf16* WGU = (const bf16*)(ws + WS_WGU); bf16* HID = (bf16*)(ws + WS_HID);
    LAS int* pst = (LAS int*)lds;
    if (tid <= 32) pst[tid] = META[tid];
    __syncthreads();
    const int npad = pst[32], ntile = (npad / 64) * 8, rg = tid >> 5, cg = tid & 31;
    for (int tile = wg; tile < ntile; tile += G) {
        const int rt = tile >> 3, ct = tile & 7, e = expert_of_row(pst, rt * 64);
        const bf16* ar[4];
#pragma unroll
        for (int i = 0; i < 4; ++i) { const int tk = ROWTOK[rt * 64 + rg * 4 + i]; ar[i] = H2 + (size_t)(tk < 0 ? 0 : (tk >> 1)) * DM; }
        const int c0 = ct * 64 + cg * 2;
        const bf16* bg[2]; const bf16* bu[2];
#pragma unroll
        for (int j = 0; j < 2; ++j) { const int c = c0 + j; bg[j] = WGU + ((size_t)e * 1024 + (c >> 7) * 256 + (c & 127)) * 1024; bu[j] = bg[j] + 128 * 1024; }
        float g[4][2], u[4][2];
#pragma unroll
        for (int i = 0; i < 4; ++i)
#pragma unroll
            for (int j = 0; j < 2; ++j) { g[i][j] = 0.f; u[i][j] = 0.f; }
#pragma unroll 1
        for (int k = 0; k < 1024; k += 8) {
            float af[4][8], gf[2][8], uf[2][8];
#pragma unroll
            for (int i = 0; i < 4; ++i) unpack8(*(const u32x4*)(ar[i] + k), af[i]);
#pragma unroll
            for (int j = 0; j < 2; ++j) { unpack8(*(const u32x4*)(bg[j] + k), gf[j]); unpack8(*(const u32x4*)(bu[j] + k), uf[j]); }
#pragma unroll
            for (int i = 0; i < 4; ++i)
#pragma unroll
                for (int j = 0; j < 2; ++j)
#pragma unroll
                    for (int q = 0; q < 8; ++q) { g[i][j] += af[i][q] * gf[j][q]; u[i][j] += af[i][q] * uf[j][q]; }
        }
#pragma unroll
        for (int i = 0; i < 4; ++i) *(unsigned*)(HID + (size_t)(rt * 64 + rg * 4 + i) * DEXP + c0) = pk2(siluf_(g[i][0]) * u[i][0], siluf_(g[i][1]) * u[i][1]);
    }
}

__device__ __forceinline__ void p7_naive(const Args& a, LAS unsigned char* lds, int tid, int wg, int G) {
    unsigned char* ws = a.ws;
    const int* META = (const int*)(ws + WS_CTL) + CW_META; const int* ROWTOK = (const int*)(ws + WS_ROWTOK); const float* ROWW = (const float*)(ws + WS_ROWW);
    const bf16* HID = (const bf16*)(ws + WS_HID); const bf16* WD = (const bf16*)(ws + WS_WD); bf16* YBUF = (bf16*)(ws + WS_YBUF);
    LAS int* pst = (LAS int*)lds;
    if (tid <= 32) pst[tid] = META[tid];
    __syncthreads();
    const int npad = pst[32], ntile = (npad / 64) * 8, rg = tid >> 5, cg = tid & 31;
    for (int tile = wg; tile < ntile; tile += G) {
        const int rt = tile >> 3, ct = tile & 7, e = expert_of_row(pst, rt * 64);
        const bf16* ar[4]; const bf16* br[4];
#pragma unroll
        for (int i = 0; i < 4; ++i) ar[i] = HID + (size_t)(rt * 64 + rg * 4 + i) * DEXP;
        const int c0 = ct * 128 + cg * 4;
#pragma unroll
        for (int j = 0; j < 4; ++j) br[j] = WD + ((size_t)e * 1024 + c0 + j) * DEXP;
        float acc[4][4];
#pragma unroll
        for (int i = 0; i < 4; ++i)
#pragma unroll
            for (int j = 0; j < 4; ++j) acc[i][j] = 0.f;
#pragma unroll 1
        for (int k = 0; k < DEXP; k += 8) {
            float af[4][8], bfv[4][8];
#pragma unroll
            for (int i = 0; i < 4; ++i) { unpack8(*(const u32x4*)(ar[i] + k), af[i]); unpack8(*(const u32x4*)(br[i] + k), bfv[i]); }
#pragma unroll
            for (int i = 0; i < 4; ++i)
#pragma unroll
                for (int j = 0; j < 4; ++j)
#pragma unroll
                    for (int q = 0; q < 8; ++q) acc[i][j] += af[i][q] * bfv[j][q];
        }
#pragma unroll
        for (int i = 0; i < 4; ++i) { const int pos = rt * 64 + rg * 4 + i; const int tk = ROWTOK[pos];
            if (tk >= 0) { const float w = ROWW[pos]; const int t = tk >> 1, kk = tk & 1;
                u32x2 o; o.x = pk2(acc[i][0] * w, acc[i][1] * w); o.y = pk2(acc[i][2] * w, acc[i][3] * w);
                *(u32x2*)(YBUF + ((size_t)kk * T_ + t) * DM + c0) = o; } }
    }
}

__device__ __forceinline__ void p8_combine(const Args& a, int tid, int wg, int G) {
    const unsigned char* Y = a.ws + WS_YBUF; const bf16* X1B = (const bf16*)(a.ws + WS_H2); float* O = a.out;
    const int* POSA = (const int*)(a.ws + WS_POSA); const float* ASGW = (const float*)(a.ws + WS_ASGW);
    const int lane = tid & 63, gw = wg * NWAVES + __builtin_amdgcn_readfirstlane(tid >> 6), NGW = G * NWAVES;
    u32x2 xb[4]; unsigned y0[4], y1[4]; float w0 = 0.f, w1 = 0.f;
#define P8_LOAD(t_) do { const int t__ = __builtin_amdgcn_readfirstlane(t_); const int p0_ = POSA[2 * t__], p1_ = POSA[2 * t__ + 1]; w0 = ASGW[2 * t__]; w1 = ASGW[2 * t__ + 1]; \
        _Pragma("unroll") for (int q = 0; q < 4; ++q) { xb[q] = *(const u32x2*)(X1B + (size_t)t__ * DM + 4 * lane + 256 * q); y0[q] = *(const unsigned*)(Y + (size_t)p0_ * DM + 4 * lane + 256 * q); \
            y1[q] = *(const unsigned*)(Y + (size_t)p1_ * DM + 4 * lane + 256 * q); } } while (0)
#define P8_F8(w_, i_) __builtin_amdgcn_cvt_f32_fp8((int)(w_), (i_))
    P8_LOAD(gw);
#pragma unroll 1
    for (int t = gw; t < T_; t += NGW) {
        u32x2 cx[4]; unsigned c0[4], c1[4]; const float cw0 = w0, cw1 = w1;
#pragma unroll
        for (int q = 0; q < 4; ++q) { cx[q] = xb[q]; c0[q] = y0[q]; c1[q] = y1[q]; }
        if (t + NGW < T_) P8_LOAD(t + NGW);
#pragma unroll
        for (int q = 0; q < 4; ++q) {
            f32x4 a0;
            a0.x = bflo(cx[q].x) + cw0 * P8_F8(c0[q], 0) + cw1 * P8_F8(c1[q], 0); a0.y = bfhi(cx[q].x) + cw0 * P8_F8(c0[q], 1) + cw1 * P8_F8(c1[q], 1);
            a0.z = bflo(cx[q].y) + cw0 * P8_F8(c0[q], 2) + cw1 * P8_F8(c1[q], 2); a0.w = bfhi(cx[q].y) + cw0 * P8_F8(c0[q], 3) + cw1 * P8_F8(c1[q], 3);
            *(f32x4*)(O + (size_t)t * DM + 4 * lane + 256 * q) = a0;
        }
    }
#undef P8_LOAD
#undef P8_F8
}

#ifndef STAGGER_P1
#define STAGGER_P1 700
#endif
#ifndef STAGGER_P6
#define STAGGER_P6 0
#endif
#ifndef STAGGER_P7
#define STAGGER_P7 0
#endif
__device__ __forceinline__ void phase_stagger(unsigned ticks) {
    const unsigned g = blockIdx.x & 3u;
    if (g != 0u && ticks != 0u) { const unsigned long long t0 = __builtin_amdgcn_s_memrealtime(); while (__builtin_amdgcn_s_memrealtime() - t0 < (unsigned long long)(g * ticks)) __builtin_amdgcn_s_sleep(16); }
}

__device__ __forceinline__ void p6_gemm(const Args& a, LAS unsigned char* lds, int tid, int wg, int G) {
    unsigned char* ws = a.ws;
    LAS int* pst = (LAS int*)(lds + 131072); LAS int* tot = pst + 64;
    if (tid < 32) tot[tid] = ((const int*)(ws + WS_CTL) + CW_CUR)[64 * tid];
    __syncthreads();
    if (tid == 0) { int s_ = 0; for (int e = 0; e < 32; ++e) { pst[e] = s_; s_ += (tot[e] + 255) & ~255; } pst[32] = s_; }
    __syncthreads();
    {
        const int* ASGE = (const int*)(ws + WS_ASGE); int* POSA = (int*)(ws + WS_POSA); const int idx = wg * (2 * T_ / G) + tid;
        if (tid < 2 * T_ / G) { const int ev = ASGE[idx]; POSA[idx] = pst[ev & 255] + (ev >> 8); }
    }
    pg8::MoeGuSched S; S.o.init(pst[32] / 256, 4, G, wg); S.A = (const char*)(ws + WS_X1F); S.Bt = (const char*)(ws + WS_WGU); S.rowtok = (const int*)(ws + WS_ROWTOK); S.pst = pst; S.K = DM / 2;
    LAS int* ltok = (LAS int*)(lds + 131584); LAS float* lrowr = (LAS float*)(lds + 131584 + 9 * 256 * 4);
    {
        const int* LIST = (const int*)(ws + WS_LIST); const float* R2 = (const float*)(ws + WS_ASGW) + 2 * T_;
        int tv[9]; float rv[9]; bool ok[9];
#pragma unroll
        for (int i = 0; i < 9; ++i) { int pm, pn; ok[i] = S.o.map(i, pm, pn); tv[i] = -1; rv[i] = 0.f;
            if (ok[i] && tid < 256) { const int e = pg8::expert_of_row_l(pst, pm * 256), ii = pm * 256 + tid - pst[e]; if (ii < tot[e]) tv[i] = LIST[(size_t)e * LCAP + ii]; } }
#pragma unroll
        for (int i = 0; i < 9; ++i) if (tv[i] >= 0) rv[i] = R2[tv[i]];
#pragma unroll
        for (int i = 0; i < 9; ++i) if (ok[i] && tid < 256) { ltok[i * 256 + tid] = tv[i]; lrowr[i * 256 + tid] = rv[i]; }
        __syncthreads();
    }
    S.ltok = ltok;
    pg8::EpiSwiglu E{(bf16*)(ws + WS_HID), lrowr};
    phase_stagger(STAGGER_P6);
    pg8::gemm_phase<pg8::EpiSwiglu, pg8::MoeGuSched, true, true>(lds, DM / 2, S, E);
}
__device__ __forceinline__ void p7_gemm(const Args& a, LAS unsigned char* lds, int tid, int wg, int G) {
    unsigned char* ws = a.ws;
    LAS int* pst = (LAS int*)(lds + 131072); LAS int* tot = pst + 64;
    if (tid < 32) tot[tid] = ((const int*)(ws + WS_CTL) + CW_CUR)[64 * tid];
    __syncthreads();
    if (tid == 0) { int s_ = 0; for (int e = 0; e < 32; ++e) { pst[e] = s_; s_ += (tot[e] + 255) & ~255; } pst[32] = s_; }
    __syncthreads();
    pg8::MoeDownSched S; S.o.init(pst[32] / 256, 4, G, wg); S.A = (const char*)(ws + WS_HID); S.Bt = (const char*)(ws + WS_WD); S.pst = pst; S.K = DEXP / 2;
    pg8::EpiF8 E{ws + WS_YBUF, DM};
    phase_stagger(STAGGER_P7);
    pg8::gemm_phase<pg8::EpiF8, pg8::MoeDownSched, true, true>(lds, DEXP / 2, S, E);
}

__global__ void __launch_bounds__(NTHR, 2) fwd(Args args) {
    extern __shared__ __attribute__((aligned(16))) unsigned char lds_raw[];
    LAS unsigned char* lds = (LAS unsigned char*)lds_raw;
    const int tid0 = threadIdx.x, wg = blockIdx.x, G = gridDim.x;
#define PH_TID() int tid = threadIdx.x; asm volatile("" : "+v"(tid)); const int lane = tid & 63, wave = __builtin_amdgcn_readfirstlane(tid >> 6); (void)lane; (void)wave
    unsigned char* ws = args.ws;
    unsigned* ctl = (unsigned*)(ws + WS_CTL);
    for (int u = tid0; u < 256; u += NTHR) ((LAS unsigned*)(lds + LDSCTL_OFF))[u] = 0u;
    __syncthreads();
    const int lo = args.ph_lo, hi = args.ph_hi;
    XcdBarrier bar = xcd_barrier_post(ctl + CW_BAR, (volatile LAS unsigned*)(lds + LDSCTL_OFF));
#define IN(k) (lo <= (k) && (k) < hi)
#ifndef PROBE_PHASE
#define PROBE_PHASE -1
#endif
#define REPS(k) ((PROBE_PHASE == (k)) ? 2 : 1)
#define REPSEP(k) do { if (rep + 1 < REPS(k)) xcd_barrier(bar); } while (0)
#define SEAM(k) do { if (IN(k) && IN((k) + 1)) xcd_barrier(bar); } while (0)

    if (IN(0)) { for (int rep = 0; rep < REPS(0); ++rep) { PH_TID(); p0_prologue(args, lds, tid, lane, wave, wg, G);  REPSEP(0); } }
    SEAM(0);
    if (IN(1)) { for (int rep = 0; rep < REPS(1); ++rep) {
        pg8::DenseSched S; S.o.init(T_ / 256, NCOL / 256, G, wg); S.A = (const char*)(ws + WS_H1); S.Bt = (const char*)(ws + WS_W1T); S.K = DM;
        LAS float* lrs = (LAS float*)(lds + 131584);
        { PH_TID(); const float* R1 = (const float*)(ws + WS_R1);
#pragma unroll 1
          for (int i = 0; i < 14; ++i) { int pm, pn; if (S.o.map(i, pm, pn) && tid < 256) lrs[i * 256 + tid] = R1[pm * 256 + tid]; } }
        pg8::EpiProj E{(bf16*)(ws + WS_PROJ), NCOL, args.in[8], args.in[9], lrs};
        if (wg & 1) { PH_TID(); p1_stagger_work(args, lds, lane, wave, wg); }
        asm volatile("s_waitcnt vmcnt(0) lgkmcnt(0)" ::: "memory"); __syncthreads();
        pg8::gemm_phase<pg8::EpiProj, pg8::DenseSched, true>(lds, DM, S, E);
        if (!(wg & 1)) { __syncthreads(); { PH_TID(); p1_stagger_work(args, lds, lane, wave, wg); } }
     REPSEP(1); } }
    SEAM(1);
    if (IN(2)) { for (int rep = 0; rep < REPS(2); ++rep) { { PH_TID(); if (wg < NBATCH * 4 || PROBE_PHASE == 23) { ml::mlstm_item(args, lds, wg & 127, tid); } } __syncthreads(); { PH_TID(); p2_fast_attn(args, lds, tid, lane, wave, wg, G, rep); if (PROBE_PHASE == 21) { __syncthreads(); p2_fast_attn(args, lds, tid, lane, wave, wg, G, 1); } }  REPSEP(2); } }
    SEAM(2);
    if (IN(3)) { for (int rep = 0; rep < REPS(3); ++rep) {
        pg8::DenseSched S; S.o.init(T_ / 256, DM / 256, G, wg); S.A = (const char*)(ws + WS_MIX); S.Bt = (const char*)(ws + WS_W2T); S.K = DM;
        pg8::EpiX1 E{(const bf16*)(ws + WS_H1), (bf16*)(ws + WS_H2), ws + WS_X1F, DM};
        if (wg & 1) { { PH_TID(); convert_gate_up(args, lds, lane, wave, wg, G); } asm volatile("s_waitcnt vmcnt(0) lgkmcnt(0)" ::: "memory"); __syncthreads(); }
        pg8::gemm_phase<pg8::EpiX1, pg8::DenseSched, true>(lds, DM, S, E);
        if (!(wg & 1)) { __syncthreads(); { PH_TID(); convert_gate_up(args, lds, lane, wave, wg, G); } }
     REPSEP(3); } }
    SEAM(3);
    if (IN(4)) { for (int rep = 0; rep < REPS(4); ++rep) { PH_TID(); p4_router_mfma(args, lds, tid, lane, wave, wg, G);  REPSEP(4); } }
    SEAM(4);
    if (IN(6)) { for (int rep = 0; rep < REPS(6); ++rep) { PH_TID(); p6_gemm(args, lds, tid, wg, G);  REPSEP(6); } }
    SEAM(6);
    if (IN(7)) { for (int rep = 0; rep < REPS(7); ++rep) { PH_TID(); p7_gemm(args, lds, tid, wg, G);  REPSEP(7); } }
    SEAM(7);
    if (IN(8)) { PH_TID(); p8_combine(args, tid, wg, G); }
#undef IN
#undef SEAM
}

#ifndef MK_N_LAUNCHES
#define MK_N_LAUNCHES 1
#endif
extern "C" void kernel_launch(void* const* d_in, const int* in_sizes, int n_in, void* d_out, int out_size, void* d_ws, size_t ws_size, hipStream_t stream) {
    static int grid = 0;
    if (grid == 0) {
        if (n_in != 24 || in_sizes[0] != T_ * DM || out_size != T_ * DM || ws_size < WS_END) { fprintf(stderr, "kernel_launch: unexpected shapes (n_in %d, in0 %d, out %d, ws %zu); nothing launched\n", n_in, n_in > 0 ? in_sizes[0] : -1, out_size, ws_size); grid = -1; return; }
        int dev = 0, cus = 0, per_cu = 0;
        if (hipGetDevice(&dev) != hipSuccess || hipDeviceGetAttribute(&cus, hipDeviceAttributeMultiprocessorCount, dev) != hipSuccess) { grid = -1; return; }
        if (hipFuncSetAttribute((const void*)fwd, hipFuncAttributeMaxDynamicSharedMemorySize, LDS_BYTES) != hipSuccess) { fprintf(stderr, "kernel_launch: hipFuncSetAttribute failed\n"); grid = -1; return; }
        if (hipOccupancyMaxActiveBlocksPerMultiprocessor(&per_cu, (const void*)fwd, NTHR, LDS_BYTES) != hipSuccess || per_cu < 1) fprintf(stderr, "kernel_launch: occupancy query reports %d\n", per_cu);
        (void)hipGetLastError();
        grid = cus;
        if (grid != 256) { fprintf(stderr, "kernel_launch: built for 256 CUs, found %d; nothing launched\n", cus); grid = -1; return; }
    }
    if (grid < 0) return;
    if (hipMemsetAsync((char*)d_ws + WS_CTL, 0, CTL_ZERO_BYTES, stream) != hipSuccess) return;
    Args a{};
    for (int i = 0; i < 24; ++i) a.in[i] = (const float*)d_in[i];
    a.out = (float*)d_out; a.ws = (unsigned char*)d_ws;
    if (MK_N_LAUNCHES == 1) { a.ph_lo = 0; a.ph_hi = 9; hipLaunchKernelGGL(fwd, dim3(grid), dim3(NTHR), LDS_BYTES, stream, a); }
    else { for (int p = 0; p < 9; ++p) { a.ph_lo = p; a.ph_hi = p + 1; hipLaunchKernelGGL(fwd, dim3(grid), dim3(NTHR), LDS_BYTES, stream, a); } }
    const hipError_t le = hipPeekAtLastError();
    if (le != hipSuccess) fprintf(stderr, "kernel_launch: launch failed: %s\n", hipGetErrorName(le));
}
```
